# Optimizing an MI355X kernel written in HIP

```python
import math
import jax
import jax.numpy as jnp
from jax import lax
import numpy as np

D_MODEL = 1024
BATCH = 2
SEQ = 8192
DEPTH = 2

N_EVEN = (DEPTH + 1) // 2
N_ODD = DEPTH // 2
RMS_EPS = 1e-6

GDN_HEADS = 8
GDN_DK = 128
GDN_DV = 128
GDN_CONV = 4
GDN_CHUNK = 64
GDN_QK = GDN_HEADS * GDN_DK
GDN_V = GDN_HEADS * GDN_DV

S5_WIDTH = D_MODEL
S5_GROUP = 16
S5_GROUPS = S5_WIDTH // S5_GROUP
S5_STATE = 64
S5_MIN_NEG = 1e-4

EVEN_SIZES = (2 * GDN_QK + GDN_V, GDN_V, GDN_HEADS, GDN_HEADS, S5_WIDTH, S5_WIDTH)
EVEN_PROJ = sum(EVEN_SIZES)
EVEN_MIX = GDN_V + S5_WIDTH

SC_WIDTH = 2 * D_MODEL
SC_CONV = 3

kernel_name = "hybrid_gdn_s5_shortconv_sandwich"


def rms_norm(x, w):
    xf = x.astype(jnp.float32)
    xf = xf * lax.rsqrt(jnp.mean(xf * xf, axis=-1, keepdims=True) + RMS_EPS)
    return (xf * w.astype(jnp.float32)).astype(x.dtype)


def l2_normalize(x):
    return x * lax.rsqrt(jnp.sum(x * x, axis=-1, keepdims=True) + RMS_EPS)


def causal_dwconv(x, w):
    k, c = w.shape
    return lax.conv_general_dilated(
        x, w[:, None, :], window_strides=(1,), padding=[(k - 1, 0)],
        dimension_numbers=("NWC", "WIO", "NWC"), feature_group_count=c)


def split_cols(t, sizes):
    idx = [int(i) for i in np.cumsum(sizes)[:-1]]
    return jnp.split(t, idx, axis=-1)


def gated_delta_rule_chunked(q, k, v, beta, g):
    bsz, s, h, dk = q.shape
    dv = v.shape[-1]
    c = GDN_CHUNK
    n = s // c

    def to_chunks(t):
        t = t.reshape((bsz, n, c, h) + t.shape[3:])
        return jnp.moveaxis(t, 3, 1)

    q, k, v, beta, g = (to_chunks(t) for t in (q, k, v, beta, g))
    gc = jnp.cumsum(g, axis=-1)
    causal = jnp.tril(jnp.ones((c, c), dtype=bool))
    strict = jnp.tril(jnp.ones((c, c), dtype=bool), -1)
    decay = jnp.exp(jnp.where(causal, gc[..., :, None] - gc[..., None, :], -jnp.inf))
    kb = k * beta[..., None]
    lower = jnp.where(strict, jnp.einsum("bhncd,bhnmd->bhncm", kb, k) * decay, 0.0)
    eye = jnp.eye(c, dtype=jnp.float32)
    rhs = jnp.concatenate([v * beta[..., None], kb * jnp.exp(gc)[..., None]], axis=-1)
    sol = lax.linalg.triangular_solve(lower + eye, rhs, left_side=True, lower=True,
                                      unit_diagonal=True)
    u_c, w_c = sol[..., :dv], sol[..., dv:]
    attn = jnp.einsum("bhncd,bhnmd->bhncm", q, k) * decay
    q_dec = q * jnp.exp(gc)[..., None]
    k_dec = k * jnp.exp(gc[..., -1:] - gc)[..., None]
    g_last = jnp.exp(gc[..., -1])

    def step(state, xs):
        q_n, a_n, u_n, w_n, k_n, gl_n = xs
        v_new = u_n - jnp.einsum("bhcd,bhde->bhce", w_n, state)
        o_n = (jnp.einsum("bhcd,bhde->bhce", q_n, state)
               + jnp.einsum("bhcm,bhme->bhce", a_n, v_new))
        state = state * gl_n[..., None, None] + jnp.einsum("bhcd,bhce->bhde", k_n, v_new)
        return state, o_n

    xs = tuple(jnp.moveaxis(t, 2, 0) for t in (q_dec, attn, u_c, w_c, k_dec, g_last))
    state0 = jnp.zeros((bsz, h, dk, dv), jnp.float32)
    _, o = lax.scan(step, state0, xs)
    return o.transpose(1, 0, 3, 2, 4).reshape(bsz, s, h, dv)


def _complex_affine_combine(e1, e2):
    a1r, a1i, b1r, b1i = e1
    a2r, a2i, b2r, b2i = e2
    return (a2r * a1r - a2i * a1i,
            a2r * a1i + a2i * a1r,
            a2r * b1r - a2i * b1i + b2r,
            a2r * b1i + a2i * b1r + b2i)


def s5_ssm(u, lam_re, lam_im, b_re, b_im, c_re, c_im, log_dt, d):
    bsz, s, _ = u.shape
    f32 = jnp.float32
    uf = u.astype(f32).reshape(bsz, s, S5_GROUPS, S5_GROUP)
    lr = jnp.minimum(lam_re.astype(f32), -S5_MIN_NEG)
    li = lam_im.astype(f32)
    dt = jnp.exp(log_dt.astype(f32))[:, None]
    mag = jnp.exp(lr * dt)
    ab_re = mag * jnp.cos(li * dt)
    ab_im = mag * jnp.sin(li * dt)
    den = lr * lr + li * li
    nr, ni = ab_re - 1.0, ab_im
    f_re = (nr * lr + ni * li) / den
    f_im = (ni * lr - nr * li) / den
    br, bi = b_re.astype(f32), b_im.astype(f32)
    bb_re = f_re[..., None] * br - f_im[..., None] * bi
    bb_im = f_re[..., None] * bi + f_im[..., None] * br
    bu_re = jnp.einsum("bsgh,gph->bsgp", uf, bb_re)
    bu_im = jnp.einsum("bsgh,gph->bsgp", uf, bb_im)
    a_re = jnp.broadcast_to(ab_re, (1, s, S5_GROUPS, S5_STATE))
    a_im = jnp.broadcast_to(ab_im, (1, s, S5_GROUPS, S5_STATE))
    _, _, x_re, x_im = lax.associative_scan(
        _complex_affine_combine, (a_re, a_im, bu_re, bu_im), axis=1)
    y = (jnp.einsum("bsgp,ghp->bsgh", x_re, c_re.astype(f32))
         - jnp.einsum("bsgp,ghp->bsgh", x_im, c_im.astype(f32)))
    y = y.reshape(bsz, s, S5_WIDTH) + d.astype(f32) * u.astype(f32)
    return y.astype(u.dtype)


def even_mixer(h, w_in, conv_w, a_log, dt_bias, gdn_norm_w, lam_re, lam_im,
               b_re, b_im, c_re, c_im, log_dt, s5_d, w_glu, w_out):
    bsz, s, _ = h.shape
    f32 = jnp.float32
    proj = h @ w_in
    qkv, z_a, b_raw, a_raw, u, z_b = split_cols(proj, EVEN_SIZES)
    qkv = jax.nn.silu(causal_dwconv(qkv, conv_w))
    q, k, v = split_cols(qkv, (GDN_QK, GDN_QK, GDN_V))
    q = l2_normalize(q.astype(f32).reshape(bsz, s, GDN_HEADS, GDN_DK)) * (GDN_DK ** -0.5)
    k = l2_normalize(k.astype(f32).reshape(bsz, s, GDN_HEADS, GDN_DK))
    v = v.astype(f32).reshape(bsz, s, GDN_HEADS, GDN_DV)
    beta = jax.nn.sigmoid(b_raw.astype(f32))
    g = -jnp.exp(a_log.astype(f32)) * jax.nn.softplus(a_raw.astype(f32) + dt_bias.astype(f32))
    o = gated_delta_rule_chunked(q, k, v, beta, g)
    o = rms_norm(o, gdn_norm_w).reshape(bsz, s, GDN_V).astype(h.dtype)
    y_a = o * jax.nn.silu(z_a)
    y = jax.nn.gelu(s5_ssm(u, lam_re, lam_im, b_re, b_im, c_re, c_im, log_dt, s5_d))
    y = y * jax.nn.sigmoid(y @ w_glu)
    y_b = y * jax.nn.silu(z_b)
    return jnp.concatenate([y_a, y_b], axis=-1) @ w_out


def odd_mixer(h, w_in, conv_w, w_out):
    gb, gc, hv, z = split_cols(h @ w_in, (SC_WIDTH, SC_WIDTH, SC_WIDTH, SC_WIDTH))
    y = gb * causal_dwconv(gc * hv, conv_w)
    return (y * jax.nn.silu(z)) @ w_out


def setup_inputs(seed: int = 0) -> dict:
    key = jax.random.key(seed)
    ks = jax.random.split(key, 24)
    f32 = jnp.float32
    nrm = lambda k, shp, sc: jax.random.normal(k, shp, f32) * sc
    log_lo, log_hi = math.log(1e-3), math.log(1e-1)
    dt0 = jnp.exp(jax.random.uniform(ks[5], (N_EVEN, GDN_HEADS), f32, log_lo, log_hi))
    lam_im0 = jnp.pi * jnp.arange(S5_STATE, dtype=f32)
    return {
        "x": nrm(ks[0], (BATCH, SEQ, D_MODEL), 1.0),
        "norm_pre": 1.0 + nrm(ks[1], (DEPTH, D_MODEL), 0.02),
        "norm_post": 1.0 + nrm(ks[2], (DEPTH, D_MODEL), 0.02),
        "w_in_even": nrm(ks[3], (N_EVEN, D_MODEL, EVEN_PROJ), D_MODEL ** -0.5),
        "conv_qkv": nrm(ks[4], (N_EVEN, GDN_CONV, 2 * GDN_QK + GDN_V), GDN_CONV ** -0.5),
        "a_log": jnp.log(jax.random.uniform(ks[6], (N_EVEN, GDN_HEADS), f32, 1.0, 16.0)),
        "dt_bias": dt0 + jnp.log(-jnp.expm1(-dt0)),
        "gdn_norm_w": 1.0 + nrm(ks[7], (N_EVEN, GDN_DV), 0.02),
        "s5_lam_re": -0.5 + nrm(ks[8], (N_EVEN, S5_GROUPS, S5_STATE), 1e-3),
        "s5_lam_im": lam_im0 + nrm(ks[9], (N_EVEN, S5_GROUPS, S5_STATE), 1e-3),
        "s5_b_re": nrm(ks[10], (N_EVEN, S5_GROUPS, S5_STATE, S5_GROUP), (2 * S5_GROUP) ** -0.5),
        "s5_b_im": nrm(ks[11], (N_EVEN, S5_GROUPS, S5_STATE, S5_GROUP), (2 * S5_GROUP) ** -0.5),
        "s5_c_re": nrm(ks[12], (N_EVEN, S5_GROUPS, S5_GROUP, S5_STATE), S5_STATE ** -0.5),
        "s5_c_im": nrm(ks[13], (N_EVEN, S5_GROUPS, S5_GROUP, S5_STATE), S5_STATE ** -0.5),
        "s5_log_dt": jax.random.uniform(ks[14], (N_EVEN, S5_GROUPS), f32, log_lo, log_hi),
        "s5_d": nrm(ks[15], (N_EVEN, S5_WIDTH), 1.0),
        "w_glu": nrm(ks[16], (N_EVEN, S5_WIDTH, S5_WIDTH), S5_WIDTH ** -0.5),
        "w_out_even": nrm(ks[17], (N_EVEN, EVEN_MIX, D_MODEL), EVEN_MIX ** -0.5),
        "w_in_odd": nrm(ks[18], (N_ODD, D_MODEL, 4 * SC_WIDTH), D_MODEL ** -0.5),
        "conv_short": nrm(ks[19], (N_ODD, SC_CONV, SC_WIDTH), SC_CONV ** -0.5),
        "w_out_odd": nrm(ks[20], (N_ODD, SC_WIDTH, D_MODEL), SC_WIDTH ** -0.5),
    }


def reference(x, norm_pre, norm_post, w_in_even, conv_qkv, a_log, dt_bias, gdn_norm_w,
              s5_lam_re, s5_lam_im, s5_b_re, s5_b_im, s5_c_re, s5_c_im, s5_log_dt, s5_d,
              w_glu, w_out_even, w_in_odd, conv_short, w_out_odd):
    for layer in range(DEPTH):
        i = layer // 2
        h = rms_norm(x, norm_pre[layer])
        if layer % 2 == 0:
            y = even_mixer(h, w_in_even[i], conv_qkv[i], a_log[i], dt_bias[i], gdn_norm_w[i],
                           s5_lam_re[i], s5_lam_im[i], s5_b_re[i], s5_b_im[i],
                           s5_c_re[i], s5_c_im[i], s5_log_dt[i], s5_d[i],
                           w_glu[i], w_out_even[i])
        else:
            y = odd_mixer(h, w_in_odd[i], conv_short[i], w_out_odd[i])
        x = x + rms_norm(y, norm_post[layer]).astype(x.dtype)
    return x
```

```cpp
#include <hip/hip_runtime.h>
#include <hip/hip_cooperative_groups.h>
#include <cstdio>
namespace cg = cooperative_groups;

#define LAS __attribute__((address_space(3)))
typedef unsigned short bf16_t;
typedef short bf16x8 __attribute__((ext_vector_type(8)));
typedef float f32x4 __attribute__((ext_vector_type(4)));
typedef float f32x16 __attribute__((ext_vector_type(16)));
typedef unsigned u32x4 __attribute__((ext_vector_type(4)));
typedef unsigned u32x2 __attribute__((ext_vector_type(2)));

constexpr int TOK = 16384, DM = 1024, SEQ = 8192;
constexpr int NP1 = 6400;
constexpr int NIT = 2048;

constexpr size_t OFF_WT1 = 0;
constexpr size_t OFF_WTG = OFF_WT1 + (size_t)NP1 * 1024 * 2;
constexpr size_t OFF_WTO0 = OFF_WTG + (size_t)1024 * 1024 * 2;
constexpr size_t OFF_WT2 = OFF_WTO0 + (size_t)1024 * 2048 * 2;
constexpr size_t OFF_WTO1 = OFF_WT2 + (size_t)8192 * 1024 * 2;
constexpr size_t OFF_H = OFF_WTO1 + (size_t)1024 * 2048 * 2;
constexpr size_t OFF_QKV = OFF_H + (size_t)TOK * 1024 * 2;
constexpr size_t OFF_UU = OFF_QKV + (size_t)TOK * 3072 * 2;
constexpr size_t OFF_WB = OFF_UU + (size_t)TOK * 1024 * 2;
constexpr size_t OFF_ATT = OFF_WB + (size_t)NIT * 8192 * 2;
constexpr size_t OFF_HALO = OFF_ATT + (size_t)NIT * 4096 * 2;
constexpr size_t OFF_BA = OFF_HALO + (size_t)256 * 3 * 3072 * 2;
constexpr size_t OFF_GL = OFF_BA + (size_t)TOK * 16 * 4;
constexpr size_t WS_END = OFF_GL + (size_t)NIT * 4;
constexpr size_t OFF_YMIX = OFF_QKV;
constexpr size_t OFF_P = OFF_QKV;
constexpr size_t OFF_Q = OFF_QKV + (size_t)TOK * 2048 * 2;
static_assert(OFF_Q + (size_t)TOK * 2048 * 2 <= OFF_WB, "Q overlaps live data");
static_assert(WS_END <= (size_t)256 * 1024 * 1024, "workspace too big");

constexpr int LDS_BYTES = 144 * 1024;

struct Prm {
    const float* in[21];
    float* out;
    unsigned char* ws;
    int ph_lo, ph_hi;
};

__device__ __forceinline__ float bf2f(bf16_t b) { return __uint_as_float(((unsigned)b) << 16); }
__device__ __forceinline__ bf16_t f2bf(float f) { unsigned u = __float_as_uint(f); u += 0x7FFFu + ((u >> 16) & 1u); return (bf16_t)(u >> 16); }
__device__ __forceinline__ unsigned pk2(float lo, float hi) { unsigned r; asm volatile("v_cvt_pk_bf16_f32 %0, %1, %2" : "=v"(r) : "v"(lo), "v"(hi)); return r; }
__device__ __forceinline__ float lo2f(unsigned u) { return __uint_as_float(u << 16); }
__device__ __forceinline__ float hi2f(unsigned u) { return __uint_as_float(u & 0xFFFF0000u); }
__device__ __forceinline__ float sigmoidf_(float x) { return 1.0f / (1.0f + __expf(-x)); }
__device__ __forceinline__ float siluf_(float x) { return x / (1.0f + __expf(-x)); }
__device__ __forceinline__ float wave_sum(float v) {
#pragma unroll
    for (int o = 32; o >= 1; o >>= 1) v += __shfl_xor(v, o);
    return v;
}
__device__ __forceinline__ u32x4 pack8(f32x4 a, f32x4 b) { u32x4 r; r.x = pk2(a[0], a[1]); r.y = pk2(a[2], a[3]); r.z = pk2(b[0], b[1]); r.w = pk2(b[2], b[3]); return r; }

namespace pg8 {
constexpr int BM = 256, BK = 64, HALF = 128, HTB = HALF * BK * 2, STAGE_BYTES = 8 * HTB, NXCD = 8, WGM = 8;
__device__ __forceinline__ int lds_byte(int r, int c) { const int st = (r >> 4) * 2 + (c >> 5), rr = r & 15, cc = c & 31, ob = rr * 64 + cc * 2; return st * 1024 + (ob ^ (((ob >> 9) & 1) << 5)); }
__device__ __forceinline__ void stage_rc(int b, int& R, int& C) { const int st = b / 1024, sb = b % 1024, swz = sb ^ (((sb >> 9) & 1) << 5); R = (st >> 1) * 16 + swz / 64; C = (st & 1) * 32 + (swz % 64) / 2; }
__device__ __forceinline__ int perm32(int rho) { const int n = rho >> 4, i = rho & 15; return 8 * (i >> 2) + 4 * n + (i & 3); }
struct Unit { int pm, pn; };
struct Gemm { const bf16_t* A; const bf16_t* Bt; int M, N, K; };
struct StaticOrder {
    int nM, nN, nwg, G, c;
    __device__ void init(int M, int N, int G_, int c_) { nM = M / BM; nN = N / BM; nwg = nM * nN; G = G_; c = c_; }
    __device__ bool next(int i, Unit& u) const {
        const long L = (long)i * G + c; if (L >= nwg) return false;
        int wgid = (int)L; { const int q = nwg / NXCD, r = nwg % NXCD, xcd = wgid % NXCD, off = wgid / NXCD; wgid = (xcd < r ? xcd * (q + 1) : r * (q + 1) + (xcd - r) * q) + off; }
        const int nig = WGM * nN, gid = wgid / nig, fm = gid * WGM, gsz = (nM - fm) < WGM ? (nM - fm) : WGM;
        u.pm = fm + ((wgid % nig) % gsz); u.pn = (wgid % nig) / gsz; return true;
    }
};

template <class Epi>
__device__ __forceinline__ void gemm_phase(LAS unsigned char* lds, const Gemm g, const StaticOrder& S, const Epi& E) {
    const int tid = threadIdx.x, wid = __builtin_amdgcn_readfirstlane(tid >> 6), lane = tid & 63, wr = wid >> 2, wc = wid & 3, fr = lane & 15, fq = lane >> 4;
    const int K = g.K, nt = K / BK;
    unsigned voffA[2], voffB[2];
#pragma unroll
    for (int i = 0; i < 2; ++i) { int R, C; stage_rc(tid * 16 + i * 8192, R, C); const int Rb = Epi::PERM ? ((R & ~31) + perm32(R & 31)) : R;
        voffA[i] = (unsigned)(R * K + C) * 2u; voffB[i] = (unsigned)(Rb * K + C) * 2u; }
    const size_t kstep = (size_t)(BK * 2);
    const size_t hstep = (size_t)HALF * K * 2;
    const size_t tstep = 2 * hstep;
    const unsigned ldsw = (unsigned)wid * 1024u;
    const int aoff = lds_byte(wr * 64 + fr, fq * 8), boff = lds_byte(wc * 32 + fr, fq * 8);
#define PG8_SA(b, h) (((b) * 2 + (h)) * HTB)
#define PG8_SB(b, h) ((4 + (b) * 2 + (h)) * HTB)
#define PG8_STAGE(bufoff, gbase, voff) do { _Pragma("unroll") for (int _i = 0; _i < 2; ++_i) \
        __builtin_amdgcn_global_load_lds((const unsigned*)((const char*)(gbase) + (voff)[_i]), (LAS unsigned*)(lds + (bufoff) + ldsw + _i * 8192), 16, 0, 0); } while (0)
#define PG8_LDA(dst, b, h) do { _Pragma("unroll") for (int m = 0; m < 4; ++m) _Pragma("unroll") for (int k = 0; k < 2; ++k) dst[m][k] = *(const LAS bf16x8*)(lds + PG8_SA(b, h) + aoff + m * 2048 + k * 1024); } while (0)
#define PG8_LDB(dst, b, h) do { _Pragma("unroll") for (int n = 0; n < 2; ++n) _Pragma("unroll") for (int k = 0; k < 2; ++k) dst[n][k] = *(const LAS bf16x8*)(lds + PG8_SB(b, h) + boff + n * 2048 + k * 1024); } while (0)
#define PG8_MMA(ai, bj, At, Bt) do { __builtin_amdgcn_s_setprio(1); _Pragma("unroll") for (int m = 0; m < 4; ++m) _Pragma("unroll") for (int n = 0; n < 2; ++n) _Pragma("unroll") for (int k = 0; k < 2; ++k) \
        acc[ai][bj][m][n] = __builtin_amdgcn_mfma_f32_16x16x32_bf16(Bt[n][k], At[m][k], acc[ai][bj][m][n], 0, 0, 0); __builtin_amdgcn_s_setprio(0); } while (0)
#define PG8_WAIT_V(n) asm volatile("s_waitcnt vmcnt(" #n ")" ::: "memory")
#define PG8_WAIT_L(n) asm volatile("s_waitcnt lgkmcnt(" #n ")" ::: "memory")
#define PG8_BAR __builtin_amdgcn_s_barrier()
#define PG8_SCHED __builtin_amdgcn_sched_barrier(0)
    Unit cur, nxt; int ui = 0;
    if (!S.next(0, cur)) return;
    f32x4 acc[2][2][4][2];
#pragma unroll
    for (int a = 0; a < 2; ++a)
#pragma unroll
        for (int b = 0; b < 2; ++b)
#pragma unroll
            for (int m = 0; m < 4; ++m)
#pragma unroll
                for (int n = 0; n < 2; ++n) acc[a][b][m][n] = (f32x4){0.f, 0.f, 0.f, 0.f};
    bf16x8 At[4][2], B0[2][2], B1[2][2];
    const char* cA = (const char*)g.A + (size_t)cur.pm * tstep; const char* cB = (const char*)g.Bt + (size_t)cur.pn * tstep;
    PG8_STAGE(PG8_SB(0, 0), cB, voffB); PG8_STAGE(PG8_SA(0, 0), cA, voffA); PG8_STAGE(PG8_SB(0, 1), cB + hstep, voffB); PG8_STAGE(PG8_SA(0, 1), cA + hstep, voffA);
    if (wr == 1) PG8_BAR;
    PG8_WAIT_V(4); PG8_BAR;
    PG8_STAGE(PG8_SB(1, 0), cB + kstep, voffB); PG8_STAGE(PG8_SA(1, 0), cA + kstep, voffA); PG8_STAGE(PG8_SB(1, 1), cB + hstep + kstep, voffB);
    PG8_WAIT_V(6); PG8_BAR;
    for (;;) {
        const bool has_next = S.next(ui + 1, nxt);
        const char* nA = has_next ? (const char*)g.A + (size_t)nxt.pm * tstep : cA; const char* nB = has_next ? (const char*)g.Bt + (size_t)nxt.pn * tstep : cB;
        for (int t = 0; t < nt; t += 2) {
            const bool last = (t == nt - 2);
            const char* a1 = cA + (size_t)(t + 1) * kstep;
            const char* a2 = last ? nA : cA + (size_t)(t + 2) * kstep; const char* b2 = last ? nB : cB + (size_t)(t + 2) * kstep;
            const char* a3 = a2 + kstep; const char* b3 = b2 + kstep;
            PG8_LDB(B0, 0, 0); PG8_SCHED; PG8_LDA(At, 0, 0); PG8_STAGE(PG8_SA(1, 1), a1 + hstep, voffA);
            PG8_WAIT_L(8); PG8_BAR; PG8_WAIT_L(0); PG8_MMA(0, 0, At, B0); PG8_BAR; PG8_SCHED;
            PG8_LDB(B1, 0, 1); PG8_STAGE(PG8_SB(0, 0), b2, voffB);
            PG8_BAR; PG8_WAIT_L(0); PG8_MMA(0, 1, At, B1); PG8_BAR;
            PG8_LDA(At, 0, 1); PG8_STAGE(PG8_SA(0, 0), a2, voffA);
            PG8_BAR; PG8_WAIT_L(0); PG8_MMA(1, 0, At, B0); PG8_BAR; PG8_SCHED;
            PG8_STAGE(PG8_SB(0, 1), b2 + hstep, voffB);
            PG8_WAIT_V(6); PG8_BAR; PG8_MMA(1, 1, At, B1); PG8_BAR;
            PG8_LDB(B0, 1, 0); PG8_SCHED; PG8_LDA(At, 1, 0); PG8_STAGE(PG8_SA(0, 1), a2 + hstep, voffA);
            PG8_WAIT_L(8); PG8_BAR; PG8_WAIT_L(0); PG8_MMA(0, 0, At, B0); PG8_BAR; PG8_SCHED;
            PG8_LDB(B1, 1, 1); PG8_STAGE(PG8_SB(1, 0), b3, voffB);
            PG8_BAR; PG8_WAIT_L(0); PG8_MMA(0, 1, At, B1); PG8_BAR;
            PG8_LDA(At, 1, 1); PG8_STAGE(PG8_SA(1, 0), a3, voffA);
            PG8_BAR; PG8_WAIT_L(0); PG8_MMA(1, 0, At, B0); PG8_BAR; PG8_SCHED;
            PG8_STAGE(PG8_SB(1, 1), b3 + hstep, voffB);
            PG8_WAIT_V(6); PG8_BAR; PG8_MMA(1, 1, At, B1); PG8_BAR;
        }
        E(acc, cur, wr, wc, fr, fq);
        if (!has_next) break;
#pragma unroll
        for (int a = 0; a < 2; ++a)
#pragma unroll
            for (int b = 0; b < 2; ++b)
#pragma unroll
                for (int m = 0; m < 4; ++m)
#pragma unroll
                    for (int n = 0; n < 2; ++n) acc[a][b][m][n] = (f32x4){0.f, 0.f, 0.f, 0.f};
        cur = nxt; cA = nA; cB = nB; ++ui;
    }
    PG8_WAIT_V(0);
    if (wr == 0) PG8_BAR;
    PG8_BAR;
#undef PG8_SA
#undef PG8_SB
#undef PG8_STAGE
#undef PG8_LDA
#undef PG8_LDB
#undef PG8_MMA
#undef PG8_WAIT_V
#undef PG8_WAIT_L
#undef PG8_BAR
#undef PG8_SCHED
}
}
using pg8::Unit;

struct Epi1 {
    static constexpr bool PERM = true;
    bf16_t* QKV; bf16_t* SZA; bf16_t* UU; bf16_t* SZB; float* BA; bf16_t* HALO;
    __device__ __forceinline__ void operator()(const f32x4 (&acc)[2][2][4][2], const Unit& u, int wr, int wc, int fr_, int fq_) const {
        int lane = (int)(threadIdx.x & 63); asm volatile("" : "+v"(lane));
        const int fr = lane & 15, fq = lane >> 4; (void)fr_; (void)fq_;
        const int row0 = u.pm * 256 + wr * 64 + fr, pn = u.pn;
#pragma unroll
        for (int ai = 0; ai < 2; ++ai)
#pragma unroll
            for (int m = 0; m < 4; ++m) {
                const size_t row = (size_t)(row0 + ai * 128 + m * 16);
#pragma unroll
                for (int bj = 0; bj < 2; ++bj) {
                    const int colt = 128 * bj + 32 * wc + 8 * fq;
                    f32x4 v0 = acc[ai][bj][m][0], v1 = acc[ai][bj][m][1];
                    if (pn < 12) {
                        const int c = pn * 256 + colt; const u32x4 pk = pack8(v0, v1);
                        *(u32x4*)(QKV + row * 3072 + c) = pk;
                        if (m == 3 && fr >= 13) *(u32x4*)(HALO + ((row >> 6) * 3 + (fr - 13)) * 3072 + c) = pk;
                    } else if (pn < 16) {
#pragma unroll
                        for (int e = 0; e < 4; ++e) { v0[e] = siluf_(v0[e]); v1[e] = siluf_(v1[e]); }
                        *(u32x4*)(SZA + row * 1024 + (pn - 12) * 256 + colt) = pack8(v0, v1);
                    } else if (pn < 20) {
                        *(u32x4*)(UU + row * 1024 + (pn - 16) * 256 + colt) = pack8(v0, v1);
                    } else if (pn < 24) {
#pragma unroll
                        for (int e = 0; e < 4; ++e) { v0[e] = siluf_(v0[e]); v1[e] = siluf_(v1[e]); }
                        *(u32x4*)(SZB + row * 1024 + (pn - 20) * 256 + colt) = pack8(v0, v1);
                    } else if (colt < 16) {
                        *(f32x4*)(BA + row * 16 + colt) = v0; *(f32x4*)(BA + row * 16 + colt + 4) = v1;
                    }
                }
            }
    }
};
struct EpiGlu {
    static constexpr bool PERM = true;
    const bf16_t* Y5; const bf16_t* SZB; bf16_t* YMIX;
    __device__ __forceinline__ void operator()(const f32x4 (&acc)[2][2][4][2], const Unit& u, int wr, int wc, int fr, int fq) const {
        const int row0 = u.pm * 256 + wr * 64 + fr;
#pragma unroll
        for (int ai = 0; ai < 2; ++ai)
#pragma unroll
            for (int m = 0; m < 4; ++m) {
                const size_t row = (size_t)(row0 + ai * 128 + m * 16);
#pragma unroll
                for (int bj = 0; bj < 2; ++bj) {
                    const int c = u.pn * 256 + 128 * bj + 32 * wc + 8 * fq;
                    const u32x4 y = *(const u32x4*)(Y5 + row * 1024 + c), z = *(const u32x4*)(SZB + row * 1024 + c);
                    const f32x4 a0 = acc[ai][bj][m][0], a1 = acc[ai][bj][m][1];
                    u32x4 o;
                    o.x = pk2(lo2f(y.x) * sigmoidf_(a0[0]) * lo2f(z.x), hi2f(y.x) * sigmoidf_(a0[1]) * hi2f(z.x));
                    o.y = pk2(lo2f(y.y) * sigmoidf_(a0[2]) * lo2f(z.y), hi2f(y.y) * sigmoidf_(a0[3]) * hi2f(z.y));
                    o.z = pk2(lo2f(y.z) * sigmoidf_(a1[0]) * lo2f(z.z), hi2f(y.z) * sigmoidf_(a1[1]) * hi2f(z.z));
                    o.w = pk2(lo2f(y.w) * sigmoidf_(a1[2]) * lo2f(z.w), hi2f(y.w) * sigmoidf_(a1[3]) * hi2f(z.w));
                    *(u32x4*)(YMIX + row * 2048 + 1024 + c) = o;
                }
            }
    }
};
struct EpiF32 {
    static constexpr bool PERM = false;
    float* C;
    __device__ __forceinline__ void operator()(const f32x4 (&acc)[2][2][4][2], const Unit& u, int wr, int wc, int fr, int fq) const {
        const int row0 = u.pm * 256 + wr * 64 + fr, col0 = u.pn * 256 + wc * 32 + 4 * fq;
#pragma unroll
        for (int ai = 0; ai < 2; ++ai)
#pragma unroll
            for (int m = 0; m < 4; ++m) { float* rowp = C + (size_t)(row0 + ai * 128 + m * 16) * 1024 + col0;
#pragma unroll
                for (int bj = 0; bj < 2; ++bj)
#pragma unroll
                    for (int n = 0; n < 2; ++n) *(f32x4*)(rowp + bj * 128 + n * 16) = acc[ai][bj][m][n]; }
    }
};
struct Epi2 {
    static constexpr bool PERM = false;
    bf16_t* P; bf16_t* Q;
    __device__ __forceinline__ void operator()(const f32x4 (&acc)[2][2][4][2], const Unit& u, int wr, int wc, int fr, int fq) const {
        const int row0 = u.pm * 256 + wr * 64 + fr, ch = u.pn * 64 + 16 * wc + 4 * fq;
#pragma unroll
        for (int ai = 0; ai < 2; ++ai)
#pragma unroll
            for (int m = 0; m < 4; ++m) {
                const size_t row = (size_t)(row0 + ai * 128 + m * 16);
                const f32x4 gb = acc[ai][0][m][0], gc = acc[ai][0][m][1], hv = acc[ai][1][m][0], z = acc[ai][1][m][1];
                u32x2 pp, qq;
                pp.x = pk2(gc[0] * hv[0], gc[1] * hv[1]); pp.y = pk2(gc[2] * hv[2], gc[3] * hv[3]);
                qq.x = pk2(gb[0] * siluf_(z[0]), gb[1] * siluf_(z[1])); qq.y = pk2(gb[2] * siluf_(z[2]), gb[3] * siluf_(z[3]));
                *(u32x2*)(P + row * 2048 + ch) = pp; *(u32x2*)(Q + row * 2048 + ch) = qq;
            }
    }
};

__device__ __forceinline__ int src_col(int mode, int n, int& pn_unused) {
    (void)pn_unused;
    if (mode == 0) return n;
    if (mode == 1) { if (n < 4096) return n; if (n < 6144) return n + 16; if (n < 6160) return n - 2048; return -1; }
    const int pn = n >> 8, col = n & 255, bj = col >> 7, wc = (col >> 5) & 3, nn = (col >> 4) & 1, lo = col & 15;
    return (2 * bj + nn) * 2048 + pn * 64 + 16 * wc + lo;
}
__device__ void phase_convert(const Prm& p, unsigned char* lds) {
    float* tile = (float*)lds;
    const int tid = threadIdx.x;
    for (int tix = blockIdx.x; tix < 4928; tix += gridDim.x) {
        int tl = tix, K, Nsrc, mode; const float* W; bf16_t* Wt;
        if (tl < 1600) { W = p.in[3]; Wt = (bf16_t*)(p.ws + OFF_WT1); K = 1024; Nsrc = 6160; mode = 1; }
        else if ((tl -= 1600) < 256) { W = p.in[16]; Wt = (bf16_t*)(p.ws + OFF_WTG); K = 1024; Nsrc = 1024; mode = 0; }
        else if ((tl -= 256) < 512) { W = p.in[17]; Wt = (bf16_t*)(p.ws + OFF_WTO0); K = 2048; Nsrc = 1024; mode = 0; }
        else if ((tl -= 512) < 2048) { W = p.in[18]; Wt = (bf16_t*)(p.ws + OFF_WT2); K = 1024; Nsrc = 8192; mode = 2; }
        else { tl -= 2048; W = p.in[20]; Wt = (bf16_t*)(p.ws + OFF_WTO1); K = 2048; Nsrc = 1024; mode = 0; }
        const int ntk = K / 64, n0 = (tl / ntk) * 64, k0 = (tl % ntk) * 64;
        { const int j = tid & 63; int dummy = 0; const int sc = src_col(mode, n0 + j, dummy);
#pragma unroll
          for (int i = 0; i < 8; ++i) { const int k = (tid >> 6) + 8 * i; tile[k * 65 + j] = sc >= 0 ? W[(size_t)(k0 + k) * Nsrc + sc] : 0.0f; } }
        __syncthreads();
        { const int r = tid >> 3, c8 = (tid & 7) * 8; u32x4 o;
          o.x = pk2(tile[(c8 + 0) * 65 + r], tile[(c8 + 1) * 65 + r]); o.y = pk2(tile[(c8 + 2) * 65 + r], tile[(c8 + 3) * 65 + r]);
          o.z = pk2(tile[(c8 + 4) * 65 + r], tile[(c8 + 5) * 65 + r]); o.w = pk2(tile[(c8 + 6) * 65 + r], tile[(c8 + 7) * 65 + r]);
          *(u32x4*)(Wt + (size_t)(n0 + r) * K + k0 + c8) = o; }
        __syncthreads();
    }
}
__device__ void phase_rmsnorm_x(const float* x, const float* w, bf16_t* H) {
    const int lane = threadIdx.x & 63, nw = gridDim.x * 8;
    for (int row = blockIdx.x * 8 + (threadIdx.x >> 6); row < TOK; row += nw) {
        const f32x4* xr = (const f32x4*)(x + (size_t)row * 1024);
        f32x4 v[4]; float ss = 0.f;
#pragma unroll
        for (int i = 0; i < 4; ++i) { v[i] = xr[lane + 64 * i]; ss += v[i][0] * v[i][0] + v[i][1] * v[i][1] + v[i][2] * v[i][2] + v[i][3] * v[i][3]; }
        ss = wave_sum(ss);
        const float rstd = rsqrtf(ss * (1.0f / 1024.0f) + 1e-6f);
#pragma unroll
        for (int i = 0; i < 4; ++i) { const f32x4 w4 = ((const f32x4*)w)[lane + 64 * i]; u32x2 o;
            o.x = pk2(v[i][0] * rstd * w4[0], v[i][1] * rstd * w4[1]); o.y = pk2(v[i][2] * rstd * w4[2], v[i][3] * rstd * w4[3]);
            *(u32x2*)(H + (size_t)row * 1024 + (lane + 64 * i) * 4) = o; }
    }
}
template <bool NEXT>
__device__ void phase_post(const float* base, const float* Y, const float* wpost, float* OUT, const float* wpre, bf16_t* H) {
    const int lane = threadIdx.x & 63, nw = gridDim.x * 8;
    for (int row = blockIdx.x * 8 + (threadIdx.x >> 6); row < TOK; row += nw) {
        const f32x4* yr = (const f32x4*)(Y + (size_t)row * 1024); const f32x4* br = (const f32x4*)(base + (size_t)row * 1024);
        f32x4 v[4], xb[4]; float ss = 0.f;
#pragma unroll
        for (int i = 0; i < 4; ++i) { v[i] = yr[lane + 64 * i]; xb[i] = br[lane + 64 * i]; ss += v[i][0] * v[i][0] + v[i][1] * v[i][1] + v[i][2] * v[i][2] + v[i][3] * v[i][3]; }
        ss = wave_sum(ss);
        const float rstd = rsqrtf(ss * (1.0f / 1024.0f) + 1e-6f);
        float s2 = 0.f;
#pragma unroll
        for (int i = 0; i < 4; ++i) { const f32x4 w4 = ((const f32x4*)wpost)[lane + 64 * i];
#pragma unroll
            for (int e = 0; e < 4; ++e) { v[i][e] = xb[i][e] + v[i][e] * rstd * w4[e]; s2 += v[i][e] * v[i][e]; }
            ((f32x4*)(OUT + (size_t)row * 1024))[lane + 64 * i] = v[i]; }
        if (NEXT) {
            s2 = wave_sum(s2);
            const float r2 = rsqrtf(s2 * (1.0f / 1024.0f) + 1e-6f);
#pragma unroll
            for (int i = 0; i < 4; ++i) { const f32x4 w4 = ((const f32x4*)wpre)[lane + 64 * i]; u32x2 o;
                o.x = pk2(v[i][0] * r2 * w4[0], v[i][1] * r2 * w4[1]); o.y = pk2(v[i][2] * r2 * w4[2], v[i][3] * r2 * w4[3]);
                *(u32x2*)(H + (size_t)row * 1024 + (lane + 64 * i) * 4) = o; }
        }
    }
}


__device__ __forceinline__ void sincos_d(double x, double& s, double& c) {
    const double k = rint(x * 0.6366197723675814);
    const double r = fma(-k, 6.123233995736766e-17, fma(-k, 1.5707963267948966, x)), r2 = r * r;
    double sp = -7.647163731819816e-13; sp = fma(sp, r2, 1.6059043836821613e-10); sp = fma(sp, r2, -2.505210838544172e-8); sp = fma(sp, r2, 2.7557319223985893e-6);
    sp = fma(sp, r2, -1.984126984126984e-4); sp = fma(sp, r2, 8.333333333333333e-3); sp = fma(sp, r2, -1.6666666666666666e-1); sp = fma(sp * r2, r, r);
    double cp = 4.779477332387385e-14; cp = fma(cp, r2, -1.1470745597729725e-11); cp = fma(cp, r2, 2.08767569878681e-9); cp = fma(cp, r2, -2.755731922398589e-7);
    cp = fma(cp, r2, 2.48015873015873e-5); cp = fma(cp, r2, -1.388888888888889e-3); cp = fma(cp, r2, 4.1666666666666664e-2); cp = fma(cp, r2, -0.5); cp = fma(cp, r2, 1.0);
    const int q = ((int)k) & 3;
    const double s0 = (q & 1) ? cp : sp, c0 = (q & 1) ? sp : cp;
    s = (q & 2) ? -s0 : s0; c = ((q + 1) & 2) ? -c0 : c0;
}
__device__ __forceinline__ double exp_d(double x) {
    const double n = rint(x * 1.4426950408889634);
    const double r = fma(-n, 2.3190468138462996e-17, fma(-n, 0.6931471805599453, x));
    double p = 1.6059043836821613e-10; p = fma(p, r, 2.08767569878681e-9); p = fma(p, r, 2.505210838544172e-8); p = fma(p, r, 2.755731922398589e-7); p = fma(p, r, 2.7557319223985893e-6);
    p = fma(p, r, 2.48015873015873e-5); p = fma(p, r, 1.984126984126984e-4); p = fma(p, r, 1.388888888888889e-3); p = fma(p, r, 8.333333333333333e-3); p = fma(p, r, 4.1666666666666664e-2);
    p = fma(p, r, 1.6666666666666666e-1); p = fma(p, r, 0.5); p = fma(p, r, 1.0); p = fma(p, r, 1.0);
    return ldexp(p, (int)n);
}
__device__ __forceinline__ float bcast_lo(float v) { auto r = __builtin_amdgcn_permlane32_swap(__float_as_uint(v), __float_as_uint(v), false, false); return __uint_as_float(r[0]); }
__device__ __forceinline__ float bcast_hi(float v) { auto r = __builtin_amdgcn_permlane32_swap(__float_as_uint(v), __float_as_uint(v), false, false); return __uint_as_float(r[1]); }

struct S5C {
    float ar[2][4], ai[2][4];
    float a512r[2], a512i[2];
    bf16x8 BB[4];
    bf16x8 CC[4];
    float dco;
};

template <bool OUT>
__device__ __forceinline__ void s5_chunk(const S5C& C, bf16_t* UU, int b, int g, int chunk, float (&st)[2][2], bf16_t* sX, int lane) {
    const int n = lane & 31, hh = lane >> 5, fr = lane & 15, fq = lane >> 4;
    const size_t tok0 = (size_t)b * SEQ + (size_t)chunk * 512;
    bf16x8 ua = *(const bf16x8*)(UU + (tok0 + n) * 1024 + 16 * g + 8 * hh);
    bf16_t uo[8];
    if (OUT) {
#pragma unroll
        for (int mt = 0; mt < 2; ++mt)
#pragma unroll
            for (int j = 0; j < 4; ++j) uo[mt * 4 + j] = UU[(tok0 + 16 * mt + 4 * fq + j) * 1024 + 16 * g + fr];
    }
    for (int blk = 0; blk < 16; ++blk) {
        const size_t t0 = tok0 + (size_t)blk * 32;
        const bf16x8 ucur = ua;
        bf16_t ucuro[8];
        if (OUT) {
#pragma unroll
            for (int i = 0; i < 8; ++i) ucuro[i] = uo[i];
        }
        if (blk < 15) {
            ua = *(const bf16x8*)(UU + (t0 + 32 + n) * 1024 + 16 * g + 8 * hh);
            if (OUT) {
#pragma unroll
                for (int mt = 0; mt < 2; ++mt)
#pragma unroll
                    for (int j = 0; j < 4; ++j) uo[mt * 4 + j] = UU[(t0 + 32 + 16 * mt + 4 * fq + j) * 1024 + 16 * g + fr];
            }
        }
        f32x16 acc[4];
#pragma unroll
        for (int tl = 0; tl < 4; ++tl) {
            f32x16 z;
#pragma unroll
            for (int i = 0; i < 16; ++i) z[i] = 0.f;
            acc[tl] = __builtin_amdgcn_mfma_f32_32x32x16_bf16(ucur, C.BB[tl], z, 0, 0, 0);
        }
#pragma unroll
        for (int tp = 0; tp < 2; ++tp) {
            f32x16& re = acc[2 * tp]; f32x16& im = acc[2 * tp + 1];
            const float a1r = C.ar[tp][0], a1i = C.ai[tp][0];
#pragma unroll
            for (int q = 0; q < 4; ++q)
#pragma unroll
                for (int r = 1; r < 4; ++r) {
                    const float pr = re[4 * q + r - 1], pi = im[4 * q + r - 1];
                    re[4 * q + r] += a1r * pr - a1i * pi; im[4 * q + r] += a1r * pi + a1i * pr;
                }
            float cr = st[tp][0], ci = st[tp][1];
            const float a4r = C.ar[tp][3], a4i = C.ai[tp][3];
#pragma unroll
            for (int q = 0; q < 4; ++q) {
                const float tr = re[4 * q + 3] + a4r * cr - a4i * ci, ti = im[4 * q + 3] + a4r * ci + a4i * cr;
                const float o0r = bcast_lo(tr), o0i = bcast_lo(ti);
                const float xr = hh ? o0r : cr, xi = hh ? o0i : ci;
                if (OUT) {
#pragma unroll
                    for (int r = 0; r < 4; ++r) { const float kr = C.ar[tp][r], ki = C.ai[tp][r];
                        re[4 * q + r] += kr * xr - ki * xi; im[4 * q + r] += kr * xi + ki * xr; }
                } else {
                    re[4 * q + 3] += a4r * xr - a4i * xi; im[4 * q + 3] += a4r * xi + a4i * xr;
                }
                cr = bcast_hi(re[4 * q + 3]); ci = bcast_hi(im[4 * q + 3]);
            }
            st[tp][0] = cr; st[tp][1] = ci;
        }
        if (OUT) {
            asm volatile("s_waitcnt lgkmcnt(0)" ::: "memory");
#pragma unroll
            for (int tp = 0; tp < 2; ++tp)
#pragma unroll
                for (int i = 0; i < 16; ++i) {
                    const int t = 8 * (i >> 2) + 4 * hh + (i & 3);
                    *(unsigned*)(sX + t * 136 + 2 * (n + 32 * tp)) = pk2(acc[2 * tp][i], acc[2 * tp + 1][i]);
                }
            asm volatile("s_waitcnt lgkmcnt(0)" ::: "memory");
            __builtin_amdgcn_wave_barrier();
#pragma unroll
            for (int mt = 0; mt < 2; ++mt) {
                f32x4 y = (f32x4){0.f, 0.f, 0.f, 0.f};
#pragma unroll
                for (int ks = 0; ks < 4; ++ks) {
                    const bf16x8 xa = *(const bf16x8*)(sX + (16 * mt + fr) * 136 + 32 * ks + 8 * fq);
                    y = __builtin_amdgcn_mfma_f32_16x16x32_bf16(xa, C.CC[ks], y, 0, 0, 0);
                }
#pragma unroll
                for (int j = 0; j < 4; ++j) {
                    float v = y[j] + C.dco * bf2f(ucuro[mt * 4 + j]);
                    const float inner = 0.7978845608028654f * (v + 0.044715f * v * v * v);
                    v = v / (1.0f + __expf(-2.0f * inner));
                    UU[(t0 + 16 * mt + 4 * fq + j) * 1024 + 16 * g + fr] = f2bf(v);
                }
            }
            asm volatile("s_waitcnt lgkmcnt(0)" ::: "memory");
            __builtin_amdgcn_wave_barrier();
        }
    }
}

__device__ void phase_s5(const Prm& p, unsigned char* lds, int bg) {
    const int b = bg >> 6, g = bg & 63;
    const int tid = threadIdx.x, wv = tid >> 6, lane = tid & 63, n = lane & 31, hh = lane >> 5, fr = lane & 15, fq = lane >> 4;
    bf16_t* sX = (bf16_t*)(lds + wv * 8704);
    float* sXE = (float*)(lds + 8 * 8704);
    bf16_t* UU = (bf16_t*)(p.ws + OFF_UU);
    const float* lam_re = p.in[8]; const float* lam_im = p.in[9]; const float* b_re = p.in[10]; const float* b_im = p.in[11];
    const float* c_re = p.in[12]; const float* c_im = p.in[13];
    S5C C;
    const double dt = exp_d((double)p.in[14][g]);
    float fre[2], fim[2];
#pragma unroll
    for (int tp = 0; tp < 2; ++tp) {
        const int pp = n + 32 * tp;
        const double lr = (double)fminf(lam_re[g * 64 + pp], -1e-4f), li = (double)lam_im[g * 64 + pp];
#pragma unroll
        for (int k = 0; k < 4; ++k) { double sn, cs; sincos_d(li * dt * (k + 1), sn, cs); const double mag = exp_d(lr * dt * (k + 1)); C.ar[tp][k] = (float)(mag * cs); C.ai[tp][k] = (float)(mag * sn); }
        { double sn, cs; sincos_d(li * dt * 512.0, sn, cs); const double mag = exp_d(lr * dt * 512.0); C.a512r[tp] = (float)(mag * cs); C.a512i[tp] = (float)(mag * sn); }
        double sn, cs; sincos_d(li * dt, sn, cs);
        const double mag = exp_d(lr * dt), abr = mag * cs, abi = mag * sn;
        const double den = lr * lr + li * li, nr = abr - 1.0, ni = abi;
        fre[tp] = (float)((nr * lr + ni * li) / den); fim[tp] = (float)((ni * lr - nr * li) / den);
    }
#pragma unroll
    for (int tl = 0; tl < 4; ++tl) {
        const int tp = tl >> 1, ri = tl & 1, pp = n + 32 * tp;
#pragma unroll
        for (int j = 0; j < 8; ++j) {
            const int ch = 8 * hh + j;
            const float br = b_re[(g * 64 + pp) * 16 + ch], bi = b_im[(g * 64 + pp) * 16 + ch];
            const float v = ri == 0 ? fre[tp] * br - fim[tp] * bi : fre[tp] * bi + fim[tp] * br;
            C.BB[tl][j] = (short)f2bf(v);
        }
    }
#pragma unroll
    for (int ks = 0; ks < 4; ++ks)
#pragma unroll
        for (int j = 0; j < 8; ++j) {
            const int k = 32 * ks + 8 * fq + j, pp = k >> 1, ri = k & 1;
            const float v = ri == 0 ? c_re[(g * 16 + fr) * 64 + pp] : -c_im[(g * 16 + fr) * 64 + pp];
            C.CC[ks][j] = (short)f2bf(v);
        }
    C.dco = p.in[15][16 * g + fr];
    for (int rd = 0; rd < 2; ++rd) {
        const int chunk = wv + 8 * rd;
        float st[2][2] = {{0.f, 0.f}, {0.f, 0.f}};
        s5_chunk<false>(C, UU, b, g, chunk, st, sX, lane);
        if (hh == 0) {
#pragma unroll
            for (int tp = 0; tp < 2; ++tp) { sXE[(chunk * 64 + n + 32 * tp) * 2 + 0] = st[tp][0]; sXE[(chunk * 64 + n + 32 * tp) * 2 + 1] = st[tp][1]; }
        }
    }
    __syncthreads();
    for (int rd = 0; rd < 2; ++rd) {
        const int chunk = wv + 8 * rd;
        float st[2][2] = {{0.f, 0.f}, {0.f, 0.f}};
        for (int c2 = 0; c2 < chunk; ++c2) {
#pragma unroll
            for (int tp = 0; tp < 2; ++tp) {
                const float er = sXE[(c2 * 64 + n + 32 * tp) * 2 + 0], ei = sXE[(c2 * 64 + n + 32 * tp) * 2 + 1];
                const float nr = C.a512r[tp] * st[tp][0] - C.a512i[tp] * st[tp][1] + er, ni = C.a512r[tp] * st[tp][1] + C.a512i[tp] * st[tp][0] + ei;
                st[tp][0] = nr; st[tp][1] = ni;
            }
        }
        s5_chunk<true>(C, UU, b, g, chunk, st, sX, lane);
    }
    __syncthreads();
}

__device__ void phase_gdn_prep(const Prm& p, unsigned char* lds, int it0, int nrounds) {
    const int tid0 = threadIdx.x, hb = tid0 >> 8;
    unsigned char* base = lds + hb * 72704;
    bf16_t* sQ = (bf16_t*)base;
    bf16_t* sK = (bf16_t*)(base + 17408);
    bf16_t* sV = (bf16_t*)(base + 2 * 17408);
    float* sL = (float*)(base + 3 * 17408);
    float* sBeta = (float*)(base + 4 * 17408);
    float* sGc = sBeta + 64; float* sEg = sGc + 64; float* sBE = sEg + 64;
    bf16_t* QKV = (bf16_t*)(p.ws + OFF_QKV); const bf16_t* HALO = (const bf16_t*)(p.ws + OFF_HALO);
    const float* BA = (const float*)(p.ws + OFF_BA); float* GL = (float*)(p.ws + OFF_GL);
    bf16_t* WB = (bf16_t*)(p.ws + OFF_WB); bf16_t* ATT = (bf16_t*)(p.ws + OFF_ATT);
    const float* convw = p.in[4];
    for (int rd = 0; rd < nrounds; ++rd) {
        int tid = tid0; asm volatile("" : "+v"(tid));
        const int ht = tid & 255, hw = (tid >> 6) & 3, lane = tid & 63, fr = lane & 15, fq = lane >> 4;
        const int it = it0 + rd * 2 + hb;
        const int b = it >> 10, h = (it >> 7) & 7, nc = it & 127;
        const size_t tokb = (size_t)b * SEQ + (size_t)nc * 64;
        {
            const int t = ht >> 2, cg4 = ht & 3;
#pragma unroll 1
            for (int s = 0; s < 3; ++s) {
                const int col = s * 1024 + h * 128 + cg4 * 32;
                float o[32]; float ss = 0.f;
#pragma unroll
                for (int c8 = 0; c8 < 4; ++c8) {
                    float a[8];
#pragma unroll
                    for (int e = 0; e < 8; ++e) a[e] = 0.f;
#pragma unroll
                    for (int d = 0; d < 4; ++d) {
                        const int tt = t - d;
                        u32x4 xv = (u32x4){0u, 0u, 0u, 0u};
                        if (tt >= 0) xv = *(const u32x4*)(QKV + (tokb + tt) * 3072 + col + c8 * 8);
                        else if (nc > 0) xv = *(const u32x4*)(HALO + ((size_t)(b * 128 + nc - 1) * 3 + (3 + tt)) * 3072 + col + c8 * 8);
                        const f32x4 w0 = *(const f32x4*)(convw + (3 - d) * 3072 + col + c8 * 8), w1 = *(const f32x4*)(convw + (3 - d) * 3072 + col + c8 * 8 + 4);
                        a[0] += w0[0] * lo2f(xv.x); a[1] += w0[1] * hi2f(xv.x); a[2] += w0[2] * lo2f(xv.y); a[3] += w0[3] * hi2f(xv.y);
                        a[4] += w1[0] * lo2f(xv.z); a[5] += w1[1] * hi2f(xv.z); a[6] += w1[2] * lo2f(xv.w); a[7] += w1[3] * hi2f(xv.w);
                    }
#pragma unroll
                    for (int e = 0; e < 8; ++e) { const float v = siluf_(a[e]); o[c8 * 8 + e] = v; ss += v * v; }
                    __builtin_amdgcn_sched_barrier(0);
                }
                float sc = 1.0f;
                if (s < 2) { ss += __shfl_xor(ss, 1); ss += __shfl_xor(ss, 2); sc = rsqrtf(ss + 1e-6f) * (s == 0 ? 0.08838834764831845f : 1.0f); }
                bf16_t* dst = (s == 0 ? sQ : (s == 1 ? sK : sV)) + t * 136 + cg4 * 32;
#pragma unroll
                for (int c8 = 0; c8 < 4; ++c8) { u32x4 pk;
                    pk.x = pk2(o[c8 * 8 + 0] * sc, o[c8 * 8 + 1] * sc); pk.y = pk2(o[c8 * 8 + 2] * sc, o[c8 * 8 + 3] * sc);
                    pk.z = pk2(o[c8 * 8 + 4] * sc, o[c8 * 8 + 5] * sc); pk.w = pk2(o[c8 * 8 + 6] * sc, o[c8 * 8 + 7] * sc);
                    *(u32x4*)(dst + c8 * 8) = pk; }
            }
        }
        if (hw == 0) {
            const size_t tg = tokb + lane;
            const float braw = BA[tg * 16 + h], araw = BA[tg * 16 + 8 + h];
            const float beta = 1.0f / (1.0f + expf(-braw));
            const float xx = araw + p.in[6][h];
            const float sp = xx > 20.f ? xx : log1pf(expf(xx));
            float gg = -expf(p.in[5][h]) * sp;
#pragma unroll
            for (int off = 1; off < 64; off <<= 1) { const float o = __shfl_up(gg, off); if (lane >= off) gg += o; }
            sBeta[lane] = beta; sGc[lane] = gg; sEg[lane] = expf(gg); sBE[lane] = beta * expf(gg);
            if (lane == 63) GL[it] = expf(gg);
        }
        __syncthreads();
        {
            bf16x8 aK[4], aQ[4];
#pragma unroll
            for (int ks = 0; ks < 4; ++ks) { aK[ks] = *(const bf16x8*)(sK + (16 * hw + fr) * 136 + 32 * ks + 8 * fq); aQ[ks] = *(const bf16x8*)(sQ + (16 * hw + fr) * 136 + 32 * ks + 8 * fq); }
#pragma unroll
            for (int nt = 0; nt < 4; ++nt) {
                f32x4 kk = (f32x4){0.f, 0.f, 0.f, 0.f}, qk = (f32x4){0.f, 0.f, 0.f, 0.f};
#pragma unroll
                for (int ks = 0; ks < 4; ++ks) {
                    const bf16x8 bK = *(const bf16x8*)(sK + (16 * nt + fr) * 136 + 32 * ks + 8 * fq);
                    kk = __builtin_amdgcn_mfma_f32_16x16x32_bf16(aK[ks], bK, kk, 0, 0, 0);
                    qk = __builtin_amdgcn_mfma_f32_16x16x32_bf16(aQ[ks], bK, qk, 0, 0, 0);
                }
                const int mcol = 16 * nt + fr; const float gm = sGc[mcol];
#pragma unroll
                for (int j = 0; j < 4; ++j) {
                    const int c = 16 * hw + 4 * fq + j;
                    const float dec = __expf(fminf(sGc[c] - gm, 0.f));
                    sL[c * 68 + mcol] = (mcol < c) ? kk[j] * sBeta[c] * dec : 0.f;
                    ATT[(size_t)it * 4096 + c * 64 + mcol] = f2bf((mcol <= c) ? qk[j] * dec : 0.f);
                }
            }
        }
        __syncthreads();
        {
            float x[64];
            const bool isU = ht < 128; const int jc = ht & 127;
            const bf16_t* src = isU ? sV : sK;
            const float* fac = isU ? sBeta : sBE;
#pragma unroll
            for (int c = 0; c < 64; ++c) {
                const float r = bf2f(src[c * 136 + jc]) * fac[c];
                float a0 = r, a1 = 0.f, a2 = 0.f, a3 = 0.f;
#pragma unroll
                for (int m4 = 0; m4 < c; m4 += 4) {
                    const f32x4 l = *(const f32x4*)(sL + c * 68 + m4);
                    a0 -= l[0] * x[m4];
                    if (m4 + 1 < c) a1 -= l[1] * x[m4 + 1];
                    if (m4 + 2 < c) a2 -= l[2] * x[m4 + 2];
                    if (m4 + 3 < c) a3 -= l[3] * x[m4 + 3];
                }
                x[c] = (a0 + a1) + (a2 + a3);
                __builtin_amdgcn_sched_barrier(0);
            }
            if (isU) {
#pragma unroll
                for (int c = 0; c < 64; ++c) QKV[(tokb + c) * 3072 + 2048 + h * 128 + jc] = f2bf(x[c]);
            } else {
#pragma unroll
                for (int c = 0; c < 64; ++c) WB[(size_t)it * 8192 + c * 128 + jc] = f2bf(-x[c]);
            }
        }
        {
            const int c = ht >> 2, ds = (ht & 3) * 32; const float eg = sEg[c];
#pragma unroll
            for (int c8 = 0; c8 < 4; ++c8) {
                const u32x4 v = *(const u32x4*)(sQ + c * 136 + ds + c8 * 8); u32x4 o;
                o.x = pk2(lo2f(v.x) * eg, hi2f(v.x) * eg); o.y = pk2(lo2f(v.y) * eg, hi2f(v.y) * eg); o.z = pk2(lo2f(v.z) * eg, hi2f(v.z) * eg); o.w = pk2(lo2f(v.w) * eg, hi2f(v.w) * eg);
                *(u32x4*)(QKV + (tokb + c) * 3072 + h * 128 + ds + c8 * 8) = o;
            }
            const int d = ht >> 1, cs = (ht & 1) * 32; const float gl = sGc[63];
#pragma unroll
            for (int c8 = 0; c8 < 4; ++c8) {
                float v[8];
#pragma unroll
                for (int e = 0; e < 8; ++e) { const int cc = cs + c8 * 8 + e; v[e] = bf2f(sK[cc * 136 + d]) * __expf(gl - sGc[cc]); }
                u32x4 o; o.x = pk2(v[0], v[1]); o.y = pk2(v[2], v[3]); o.z = pk2(v[4], v[5]); o.w = pk2(v[6], v[7]);
                *(u32x4*)(QKV + (tokb + (d >> 1)) * 3072 + 1024 + h * 128 + (d & 1) * 64 + cs + c8 * 8) = o;
            }
        }
        __syncthreads();
    }
}

__device__ __forceinline__ bf16x8 ld_perm(const bf16_t* rowp, int k16, int hh) {
    const u32x2 a = *(const u32x2*)(rowp + k16 + 4 * hh), b = *(const u32x2*)(rowp + k16 + 8 + 4 * hh);
    u32x4 r; r.x = a.x; r.y = a.y; r.z = b.x; r.w = b.y;
    return __builtin_bit_cast(bf16x8, r);
}
__device__ __forceinline__ bf16x8 pack_acc(const f32x16& v, int s) {
    u32x4 r; r.x = pk2(v[8 * s + 0], v[8 * s + 1]); r.y = pk2(v[8 * s + 2], v[8 * s + 3]); r.z = pk2(v[8 * s + 4], v[8 * s + 5]); r.w = pk2(v[8 * s + 6], v[8 * s + 7]);
    return __builtin_bit_cast(bf16x8, r);
}
constexpr int SC_STAGE = 62464;
__device__ void phase_gdn_scan(const Prm& p, unsigned char* lds, int bh) {
    const int tid = threadIdx.x, wv = tid >> 6, lane = tid & 63, n = lane & 31, hh = lane >> 5;
    const int b = bh >> 3, h = bh & 7;
    const bf16_t* QKV = (const bf16_t*)(p.ws + OFF_QKV); const bf16_t* WB = (const bf16_t*)(p.ws + OFF_WB); const bf16_t* ATT = (const bf16_t*)(p.ws + OFF_ATT);
    const float* GL = (const float*)(p.ws + OFF_GL); bf16_t* O = (bf16_t*)(p.ws + OFF_H);
    const int itb = bh * 128;
    auto stage = [&](int nc, int sb) {
        const int lt = tid - 256; unsigned char* sbp = lds + sb * SC_STAGE;
        const size_t tokb = (size_t)b * SEQ + (size_t)nc * 64; const int it = itb + nc;
        u32x4 rw[4], rq[4], rk[4], ra[2];
#pragma unroll
        for (int i = 0; i < 4; ++i) { const int ch = lt + 256 * i, r = ch >> 4, c8 = (ch & 15) * 8;
            rw[i] = *(const u32x4*)(WB + (size_t)it * 8192 + r * 128 + c8);
            rq[i] = *(const u32x4*)(QKV + (tokb + r) * 3072 + h * 128 + c8);
            rk[i] = *(const u32x4*)(QKV + (tokb + r) * 3072 + 1024 + h * 128 + c8); }
#pragma unroll
        for (int i = 0; i < 2; ++i) { const int ch = lt + 256 * i, r = ch >> 3, c8 = (ch & 7) * 8; ra[i] = *(const u32x4*)(ATT + (size_t)it * 4096 + r * 64 + c8); }
#pragma unroll
        for (int i = 0; i < 4; ++i) { const int ch = lt + 256 * i, r = ch >> 4, c8 = (ch & 15) * 8;
            *(u32x4*)(sbp + (r * 136 + c8) * 2) = rw[i];
            *(u32x4*)(sbp + 17408 + (r * 136 + c8) * 2) = rq[i];
            const int d = 2 * r + (c8 >> 6), c0 = c8 & 63;
            *(u32x4*)(sbp + 34816 + (d * 72 + c0) * 2) = rk[i]; }
#pragma unroll
        for (int i = 0; i < 2; ++i) { const int ch = lt + 256 * i, r = ch >> 3, c8 = (ch & 7) * 8; *(u32x4*)(sbp + 53248 + (r * 72 + c8) * 2) = ra[i]; }
    };
    if (wv >= 4) stage(0, 0);
    __syncthreads();
    f32x16 S[4];
#pragma unroll
    for (int dt = 0; dt < 4; ++dt)
#pragma unroll
        for (int i = 0; i < 16; ++i) S[dt][i] = 0.f;
    const int e = 32 * wv + n;
    for (int nc = 0; nc < 128; ++nc) {
        const int sb = nc & 1;
        if (wv >= 4) { if (nc + 1 < 128) stage(nc + 1, sb ^ 1); }
        else {
            const unsigned char* sbp = lds + sb * SC_STAGE;
            const bf16_t* sW = (const bf16_t*)sbp; const bf16_t* sQD = (const bf16_t*)(sbp + 17408);
            const bf16_t* sKT = (const bf16_t*)(sbp + 34816); const bf16_t* sAT = (const bf16_t*)(sbp + 53248);
            const size_t tokb = (size_t)b * SEQ + (size_t)nc * 64;
            const float gl = GL[itb + nc];
            int lz = 4 * hh * 3072 + e; asm volatile("" : "+v"(lz));
            const bf16_t* ubase = QKV + tokb * 3072 + 2048 + h * 128;
            bf16_t uraw[32];
#pragma unroll
            for (int i = 0; i < 32; ++i) uraw[i] = ubase[(unsigned)(lz + (32 * (i >> 4) + 8 * ((i & 15) >> 2) + (i & 3)) * 3072)];
            f32x16 V[2], Oa[2];
#pragma unroll
            for (int ct = 0; ct < 2; ++ct)
#pragma unroll
                for (int i = 0; i < 16; ++i) { V[ct][i] = 0.f; Oa[ct][i] = 0.f; }
#pragma unroll
            for (int ks = 0; ks < 8; ++ks) {
                const bf16x8 sb8 = pack_acc(S[ks >> 1], ks & 1);
#pragma unroll
                for (int ct = 0; ct < 2; ++ct) {
                    V[ct] = __builtin_amdgcn_mfma_f32_32x32x16_bf16(ld_perm(sW + (32 * ct + n) * 136, 16 * ks, hh), sb8, V[ct], 0, 0, 0);
                    Oa[ct] = __builtin_amdgcn_mfma_f32_32x32x16_bf16(ld_perm(sQD + (32 * ct + n) * 136, 16 * ks, hh), sb8, Oa[ct], 0, 0, 0);
                }
            }
#pragma unroll
            for (int ct = 0; ct < 2; ++ct)
#pragma unroll
                for (int i = 0; i < 16; ++i) V[ct][i] += bf2f(uraw[ct * 16 + i]);
            bf16x8 Vb[4];
#pragma unroll
            for (int k2 = 0; k2 < 4; ++k2) Vb[k2] = pack_acc(V[k2 >> 1], k2 & 1);
#pragma unroll
            for (int ct = 0; ct < 2; ++ct)
#pragma unroll
                for (int k2 = 0; k2 < 4; ++k2)
                    Oa[ct] = __builtin_amdgcn_mfma_f32_32x32x16_bf16(ld_perm(sAT + (32 * ct + n) * 72, 16 * k2, hh), Vb[k2], Oa[ct], 0, 0, 0);
            bf16_t* obase = O + tokb * 1024 + h * 128;
            int oz = 4 * hh * 1024 + e; asm volatile("" : "+v"(oz));
#pragma unroll
            for (int i = 0; i < 32; ++i) obase[(unsigned)(oz + (32 * (i >> 4) + 8 * ((i & 15) >> 2) + (i & 3)) * 1024)] = f2bf(Oa[i >> 4][i & 15]);
#pragma unroll
            for (int dt = 0; dt < 4; ++dt) {
#pragma unroll
                for (int i = 0; i < 16; ++i) S[dt][i] *= gl;
#pragma unroll
                for (int k2 = 0; k2 < 4; ++k2)
                    S[dt] = __builtin_amdgcn_mfma_f32_32x32x16_bf16(ld_perm(sKT + (32 * dt + n) * 72, 16 * k2, hh), Vb[k2], S[dt], 0, 0, 0);
            }
        }
        __syncthreads();
    }
}

__device__ void phase_ya(const Prm& p) {
    const bf16_t* O = (const bf16_t*)(p.ws + OFF_H); const bf16_t* SZA = (const bf16_t*)p.out; bf16_t* YMIX = (bf16_t*)(p.ws + OFF_YMIX);
    const float* gw = p.in[7];
    const int nth = gridDim.x * 512;
    for (int idx = blockIdx.x * 512 + threadIdx.x; idx < TOK * 128; idx += nth) {
        const size_t t = (size_t)(idx >> 7); const int c8 = (idx & 127) * 8;
        const u32x4 o = *(const u32x4*)(O + t * 1024 + c8), z = *(const u32x4*)(SZA + t * 1024 + c8);
        float v[8] = {lo2f(o.x), hi2f(o.x), lo2f(o.y), hi2f(o.y), lo2f(o.z), hi2f(o.z), lo2f(o.w), hi2f(o.w)};
        const float zz[8] = {lo2f(z.x), hi2f(z.x), lo2f(z.y), hi2f(z.y), lo2f(z.z), hi2f(z.z), lo2f(z.w), hi2f(z.w)};
        float ss = 0.f;
#pragma unroll
        for (int e = 0; e < 8; ++e) ss += v[e] * v[e];
        ss += __shfl_xor(ss, 1); ss += __shfl_xor(ss, 2); ss += __shfl_xor(ss, 4); ss += __shfl_xor(ss, 8);
        const float rstd = rsqrtf(ss * (1.0f / 128.0f) + 1e-6f);
        const f32x4 w0 = *(const f32x4*)(gw + (c8 & 127)), w1 = *(const f32x4*)(gw + (c8 & 127) + 4);
        u32x4 r;
        r.x = pk2(v[0] * rstd * w0[0] * zz[0], v[1] * rstd * w0[1] * zz[1]); r.y = pk2(v[2] * rstd * w0[2] * zz[2], v[3] * rstd * w0[3] * zz[3]);
        r.z = pk2(v[4] * rstd * w1[0] * zz[4], v[5] * rstd * w1[1] * zz[5]); r.w = pk2(v[6] * rstd * w1[2] * zz[6], v[7] * rstd * w1[3] * zz[7]);
        *(u32x4*)(YMIX + t * 2048 + c8) = r;
    }
}
__device__ void phase_conv3(const Prm& p) {
    const bf16_t* P = (const bf16_t*)(p.ws + OFF_P); bf16_t* Q = (bf16_t*)(p.ws + OFF_Q); const float* cw = p.in[19];
    const int nth = gridDim.x * 512;
    for (int idx = blockIdx.x * 512 + threadIdx.x; idx < TOK * 256; idx += nth) {
        const int t = idx >> 8, c8 = (idx & 255) * 8, ts = t & (SEQ - 1);
        const u32x4 z4 = (u32x4){0u, 0u, 0u, 0u};
        const u32x4 p0 = *(const u32x4*)(P + (size_t)t * 2048 + c8);
        const u32x4 p1 = ts >= 1 ? *(const u32x4*)(P + (size_t)(t - 1) * 2048 + c8) : z4;
        const u32x4 p2 = ts >= 2 ? *(const u32x4*)(P + (size_t)(t - 2) * 2048 + c8) : z4;
        const u32x4 q = *(const u32x4*)(Q + (size_t)t * 2048 + c8);
        float r[8];
        const unsigned pa[4] = {p0.x, p0.y, p0.z, p0.w}, pb[4] = {p1.x, p1.y, p1.z, p1.w}, pc[4] = {p2.x, p2.y, p2.z, p2.w}, qa[4] = {q.x, q.y, q.z, q.w};
#pragma unroll
        for (int e = 0; e < 4; ++e) {
            const int c = c8 + 2 * e;
            r[2 * e] = lo2f(qa[e]) * (cw[c] * lo2f(pc[e]) + cw[2048 + c] * lo2f(pb[e]) + cw[4096 + c] * lo2f(pa[e]));
            r[2 * e + 1] = hi2f(qa[e]) * (cw[c + 1] * hi2f(pc[e]) + cw[2048 + c + 1] * hi2f(pb[e]) + cw[4096 + c + 1] * hi2f(pa[e]));
        }
        u32x4 o; o.x = pk2(r[0], r[1]); o.y = pk2(r[2], r[3]); o.z = pk2(r[4], r[5]); o.w = pk2(r[6], r[7]);
        *(u32x4*)(Q + (size_t)t * 2048 + c8) = o;
    }
}

constexpr int NPHASE = 11;
#ifndef PHM
#define PHM 0x7FF
#endif
__global__ void __launch_bounds__(512, 2) mega(Prm p) {
    extern __shared__ __attribute__((aligned(16))) unsigned char shm[];
    LAS unsigned char* lds3 = (LAS unsigned char*)shm;
    unsigned char* ws = p.ws;
#define PH_BEGIN(i) if (p.ph_lo <= (i) && (i) < p.ph_hi) { if ((i) > p.ph_lo) cg::this_grid().sync(); pg8::StaticOrder S; (void)S;
#define PH_END }
    PH_BEGIN(0)
        phase_convert(p, shm);
        phase_rmsnorm_x(p.in[0], p.in[1], (bf16_t*)(ws + OFF_H));
    PH_END
    PH_BEGIN(1)
        pg8::Gemm g{(const bf16_t*)(ws + OFF_H), (const bf16_t*)(ws + OFF_WT1), TOK, NP1, 1024};
        Epi1 E{(bf16_t*)(ws + OFF_QKV), (bf16_t*)p.out, (bf16_t*)(ws + OFF_UU), (bf16_t*)p.out + (size_t)TOK * 1024, (float*)(ws + OFF_BA), (bf16_t*)(ws + OFF_HALO)};
        S.init(TOK, NP1, gridDim.x, blockIdx.x); pg8::gemm_phase(lds3, g, S, E);
    PH_END
    PH_BEGIN(2)
        if (blockIdx.x < 128) phase_s5(p, shm, blockIdx.x);
        else phase_gdn_prep(p, shm, (blockIdx.x - 128) * 16, 8);
    PH_END
    PH_BEGIN(3)
        if (blockIdx.x < 16) phase_gdn_scan(p, shm, blockIdx.x);
    PH_END
    PH_BEGIN(4)
        phase_ya(p);
        pg8::Gemm g{(const bf16_t*)(ws + OFF_UU), (const bf16_t*)(ws + OFF_WTG), TOK, 1024, 1024};
        EpiGlu E{(const bf16_t*)(ws + OFF_UU), (const bf16_t*)p.out + (size_t)TOK * 1024, (bf16_t*)(ws + OFF_YMIX)};
        S.init(TOK, 1024, gridDim.x, blockIdx.x); pg8::gemm_phase(lds3, g, S, E);
    PH_END
    PH_BEGIN(5)
        pg8::Gemm g{(const bf16_t*)(ws + OFF_YMIX), (const bf16_t*)(ws + OFF_WTO0), TOK, 1024, 2048};
        EpiF32 E{p.out};
        S.init(TOK, 1024, gridDim.x, blockIdx.x); pg8::gemm_phase(lds3, g, S, E);
    PH_END
    PH_BEGIN(6)
        phase_post<true>(p.in[0], p.out, p.in[2], p.out, p.in[1] + 1024, (bf16_t*)(ws + OFF_H));
    PH_END
    PH_BEGIN(7)
        pg8::Gemm g{(const bf16_t*)(ws + OFF_H), (const bf16_t*)(ws + OFF_WT2), TOK, 8192, 1024};
        Epi2 E{(bf16_t*)(ws + OFF_P), (bf16_t*)(ws + OFF_Q)};
        S.init(TOK, 8192, gridDim.x, blockIdx.x); pg8::gemm_phase(lds3, g, S, E);
    PH_END
    PH_BEGIN(8)
        phase_conv3(p);
    PH_END
    PH_BEGIN(9)
        pg8::Gemm g{(const bf16_t*)(ws + OFF_Q), (const bf16_t*)(ws + OFF_WTO1), TOK, 1024, 2048};
        EpiF32 E{(float*)(ws + OFF_P)};
        S.init(TOK, 1024, gridDim.x, blockIdx.x); pg8::gemm_phase(lds3, g, S, E);
    PH_END
    PH_BEGIN(10)
        phase_post<false>(p.out, (const float*)(ws + OFF_P), p.in[2] + 1024, p.out, nullptr, nullptr);
    PH_END
}

#ifndef N_LAUNCH_MODE
#define N_LAUNCH_MODE 1
#endif

extern "C" void kernel_launch(void* const* d_in, const int* in_sizes, int n_in, void* d_out, int out_size, void* d_ws, size_t ws_size, hipStream_t stream) {
    static int ready = 0;
    if (!ready) {
        if (n_in != 21 || ws_size < WS_END || out_size != TOK * DM) { fprintf(stderr, "kernel_launch: unexpected shapes (n_in %d ws %zu out %d)\n", n_in, ws_size, out_size); ready = -1; return; }
        if (hipFuncSetAttribute((const void*)mega, hipFuncAttributeMaxDynamicSharedMemorySize, LDS_BYTES) != hipSuccess) { fprintf(stderr, "kernel_launch: hipFuncSetAttribute failed\n"); ready = -1; return; }
        ready = 1;
    }
    if (ready < 0) return;
    Prm p{};
    for (int i = 0; i < 21; ++i) p.in[i] = (const float*)d_in[i];
    p.out = (float*)d_out; p.ws = (unsigned char*)d_ws;
#if N_LAUNCH_MODE == 1
    p.ph_lo = 0; p.ph_hi = NPHASE;
    void* args[] = {&p};
    hipError_t e = hipLaunchCooperativeKernel((const void*)mega, dim3(256), dim3(512), args, LDS_BYTES, stream);
    if (e != hipSuccess) fprintf(stderr, "cooperative launch failed: %s\n", hipGetErrorString(e));
#else
    for (int ph = 0; ph < NPHASE; ++ph) {
        p.ph_lo = ph; p.ph_hi = ph + 1;
        hipLaunchKernelGGL(mega, dim3(256), dim3(512), LDS_BYTES, stream, p);
    }
#endif
}
```

```cpp
#include <hip/hip_runtime.h>
#include <hip/hip_cooperative_groups.h>
#include <cstdio>
namespace cg = cooperative_groups;

#define LAS __attribute__((address_space(3)))
typedef unsigned short bf16_t;
typedef short bf16x8 __attribute__((ext_vector_type(8)));
typedef float f32x4 __attribute__((ext_vector_type(4)));
typedef float f32x16 __attribute__((ext_vector_type(16)));
typedef unsigned u32x4 __attribute__((ext_vector_type(4)));
typedef unsigned u32x2 __attribute__((ext_vector_type(2)));

constexpr int TOK = 16384, DM = 1024, SEQ = 8192;
constexpr int NP1 = 6400;
constexpr int NIT = 2048;

constexpr size_t OFF_WT1 = 0;
constexpr size_t OFF_WTG = OFF_WT1 + (size_t)NP1 * 1024 * 2;
constexpr size_t OFF_WTO0 = OFF_WTG + (size_t)1024 * 1024 * 2;
constexpr size_t OFF_WT2 = OFF_WTO0 + (size_t)1024 * 2048 * 2;
constexpr size_t OFF_WTO1 = OFF_WT2 + (size_t)8192 * 1024 * 2;
constexpr size_t OFF_H = OFF_WTO1 + (size_t)1024 * 2048 * 2;
constexpr size_t OFF_QKV = OFF_H + (size_t)TOK * 1024 * 2;
constexpr size_t OFF_UU = OFF_QKV + (size_t)TOK * 3072 * 2;
constexpr size_t OFF_WB = OFF_UU + (size_t)TOK * 1024 * 2;
constexpr size_t OFF_ATT = OFF_WB + (size_t)NIT * 8192 * 2;
constexpr size_t OFF_HALO = OFF_ATT + (size_t)NIT * 4096 * 2;
constexpr size_t OFF_BA = OFF_HALO + (size_t)256 * 3 * 3072 * 2;
constexpr size_t OFF_GL = OFF_BA + (size_t)TOK * 16 * 4;
constexpr size_t OFF_BAR = OFF_GL + (size_t)NIT * 4;
constexpr size_t WS_END = OFF_BAR + 16384;
constexpr size_t OFF_YMIX = OFF_QKV;
constexpr size_t OFF_P = OFF_QKV;
constexpr size_t OFF_Q = OFF_QKV + (size_t)TOK * 2048 * 2;
static_assert(OFF_Q + (size_t)TOK * 2048 * 2 <= OFF_WB, "Q overlaps live data");
static_assert(WS_END <= (size_t)256 * 1024 * 1024, "workspace too big");

constexpr int LDS_BYTES = 157696;

struct Prm {
    const float* in[21];
    float* out;
    unsigned char* ws;
    int ph_lo, ph_hi;
};

__device__ __forceinline__ float bf2f(bf16_t b) { return __uint_as_float(((unsigned)b) << 16); }
__device__ __forceinline__ bf16_t f2bf(float f) { unsigned u = __float_as_uint(f); u += 0x7FFFu + ((u >> 16) & 1u); return (bf16_t)(u >> 16); }
typedef __bf16 bf16v2_t __attribute__((ext_vector_type(2)));
typedef float f32x2_t __attribute__((ext_vector_type(2)));
__device__ __forceinline__ unsigned pk2(float lo, float hi) { const f32x2_t v = {lo, hi}; return __builtin_bit_cast(unsigned, __builtin_convertvector(v, bf16v2_t)); }
__device__ __forceinline__ float lo2f(unsigned u) { return __uint_as_float(u << 16); }
__device__ __forceinline__ float hi2f(unsigned u) { return __uint_as_float(u & 0xFFFF0000u); }
__device__ __forceinline__ float sigmoidf_(float x) { return 1.0f / (1.0f + __expf(-x)); }
__device__ __forceinline__ float siluf_(float x) { return x / (1.0f + __expf(-x)); }
__device__ __forceinline__ float wave_sum(float v) {
#pragma unroll
    for (int o = 32; o >= 1; o >>= 1) v += __shfl_xor(v, o);
    return v;
}
__device__ __forceinline__ u32x4 pack8(f32x4 a, f32x4 b) { u32x4 r; r.x = pk2(a[0], a[1]); r.y = pk2(a[2], a[3]); r.z = pk2(b[0], b[1]); r.w = pk2(b[2], b[3]); return r; }

namespace pg8 {
constexpr int BM = 256, BK = 64, HALF = 128, HTB = HALF * BK * 2, STAGE_BYTES = 8 * HTB, NXCD = 8, WGM = 8;
__device__ __forceinline__ int lds_byte(int r, int c) { const int st = (r >> 4) * 2 + (c >> 5), rr = r & 15, cc = c & 31, ob = rr * 64 + cc * 2; return st * 1024 + (ob ^ (((ob >> 9) & 1) << 5)); }
__device__ __forceinline__ void stage_rc(int b, int& R, int& C) { const int st = b / 1024, sb = b % 1024, swz = sb ^ (((sb >> 9) & 1) << 5); R = (st >> 1) * 16 + swz / 64; C = (st & 1) * 32 + (swz % 64) / 2; }
__device__ __forceinline__ int perm32(int rho) { const int n = rho >> 4, i = rho & 15; return 8 * (i >> 2) + 4 * n + (i & 3); }
struct Unit { int pm, pn; };
struct Gemm { const bf16_t* A; const bf16_t* Bt; int M, N, K; };
struct StaticOrder {
    int nM, nN, nwg, G, c;
    __device__ void init(int M, int N, int G_, int c_) { nM = M / BM; nN = N / BM; nwg = nM * nN; G = G_; c = c_; }
    __device__ bool next(int i, Unit& u) const {
        const long L = (long)i * G + c; if (L >= nwg) return false;
        int wgid = (int)L; { const int q = nwg / NXCD, r = nwg % NXCD, xcd = wgid % NXCD, off = wgid / NXCD; wgid = (xcd < r ? xcd * (q + 1) : r * (q + 1) + (xcd - r) * q) + off; }
        const int nig = WGM * nN, gid = wgid / nig, fm = gid * WGM, gsz = (nM - fm) < WGM ? (nM - fm) : WGM;
        u.pm = fm + ((wgid % nig) % gsz); u.pn = (wgid % nig) / gsz; return true;
    }
};

template <class Epi>
__device__ __forceinline__ void gemm_phase(LAS unsigned char* lds, const Gemm g, const StaticOrder& S, const Epi& E) {
    const int tid = threadIdx.x, wid = __builtin_amdgcn_readfirstlane(tid >> 6), lane = tid & 63, wr = wid >> 2, wc = wid & 3, fr = lane & 15, fq = lane >> 4;
    const int K = g.K, nt = K / BK;
    unsigned voffA[2], voffB[2];
#pragma unroll
    for (int i = 0; i < 2; ++i) { int R, C; stage_rc(tid * 16 + i * 8192, R, C); const int Rb = Epi::PERM ? ((R & ~31) + perm32(R & 31)) : R;
        voffA[i] = (unsigned)(R * K + C) * 2u; voffB[i] = (unsigned)(Rb * K + C) * 2u; }
    const size_t kstep = (size_t)(BK * 2);
    const size_t hstep = (size_t)HALF * K * 2;
    const size_t tstep = 2 * hstep;
    const unsigned ldsw = (unsigned)wid * 1024u;
    const int aoff = lds_byte(wr * 64 + fr, fq * 8), boff = lds_byte(wc * 32 + fr, fq * 8);
#define PG8_SA(b, h) (((b) * 2 + (h)) * HTB)
#define PG8_SB(b, h) ((4 + (b) * 2 + (h)) * HTB)
#define PG8_STAGE(bufoff, gbase, voff) do { _Pragma("unroll") for (int _i = 0; _i < 2; ++_i) \
        __builtin_amdgcn_global_load_lds((const unsigned*)((const char*)(gbase) + (voff)[_i]), (LAS unsigned*)(lds + (bufoff) + ldsw + _i * 8192), 16, 0, 0); } while (0)
#define PG8_LDA(dst, b, h) do { _Pragma("unroll") for (int m = 0; m < 4; ++m) _Pragma("unroll") for (int k = 0; k < 2; ++k) dst[m][k] = *(const LAS bf16x8*)(lds + PG8_SA(b, h) + aoff + m * 2048 + k * 1024); } while (0)
#define PG8_LDB(dst, b, h) do { _Pragma("unroll") for (int n = 0; n < 2; ++n) _Pragma("unroll") for (int k = 0; k < 2; ++k) dst[n][k] = *(const LAS bf16x8*)(lds + PG8_SB(b, h) + boff + n * 2048 + k * 1024); } while (0)
#define PG8_MMA(ai, bj, At, Bt) do { __builtin_amdgcn_s_setprio(1); _Pragma("unroll") for (int m = 0; m < 4; ++m) _Pragma("unroll") for (int n = 0; n < 2; ++n) _Pragma("unroll") for (int k = 0; k < 2; ++k) \
        acc[ai][bj][m][n] = __builtin_amdgcn_mfma_f32_16x16x32_bf16(Bt[n][k], At[m][k], acc[ai][bj][m][n], 0, 0, 0); __builtin_amdgcn_s_setprio(0); } while (0)
#define PG8_WAIT_V(n) asm volatile("s_waitcnt vmcnt(" #n ")" ::: "memory")
#define PG8_WAIT_L(n) asm volatile("s_waitcnt lgkmcnt(" #n ")" ::: "memory")
#define PG8_BAR __builtin_amdgcn_s_barrier()
#define PG8_SCHED __builtin_amdgcn_sched_barrier(0)
    Unit cur, nxt; int ui = 0;
    if (!S.next(0, cur)) return;
    f32x4 acc[2][2][4][2];
#pragma unroll
    for (int a = 0; a < 2; ++a)
#pragma unroll
        for (int b = 0; b < 2; ++b)
#pragma unroll
            for (int m = 0; m < 4; ++m)
#pragma unroll
                for (int n = 0; n < 2; ++n) acc[a][b][m][n] = (f32x4){0.f, 0.f, 0.f, 0.f};
    bf16x8 At[4][2], B0[2][2], B1[2][2];
    const char* cA = (const char*)g.A + (size_t)cur.pm * tstep; const char* cB = (const char*)g.Bt + (size_t)cur.pn * tstep;
    PG8_STAGE(PG8_SB(0, 0), cB, voffB); PG8_STAGE(PG8_SA(0, 0), cA, voffA); PG8_STAGE(PG8_SB(0, 1), cB + hstep, voffB); PG8_STAGE(PG8_SA(0, 1), cA + hstep, voffA);
    if (wr == 1) PG8_BAR;
    PG8_WAIT_V(4); PG8_BAR;
    PG8_STAGE(PG8_SB(1, 0), cB + kstep, voffB); PG8_STAGE(PG8_SA(1, 0), cA + kstep, voffA); PG8_STAGE(PG8_SB(1, 1), cB + hstep + kstep, voffB);
    PG8_WAIT_V(6); PG8_BAR;
    for (;;) {
        const bool has_next = S.next(ui + 1, nxt);
        const char* nA = has_next ? (const char*)g.A + (size_t)nxt.pm * tstep : cA; const char* nB = has_next ? (const char*)g.Bt + (size_t)nxt.pn * tstep : cB;
        for (int t = 0; t < nt; t += 2) {
            const bool last = (t == nt - 2);
            const char* a1 = cA + (size_t)(t + 1) * kstep;
            const char* a2 = last ? nA : cA + (size_t)(t + 2) * kstep; const char* b2 = last ? nB : cB + (size_t)(t + 2) * kstep;
            const char* a3 = a2 + kstep; const char* b3 = b2 + kstep;
            PG8_LDB(B0, 0, 0); PG8_SCHED; PG8_LDA(At, 0, 0); PG8_STAGE(PG8_SA(1, 1), a1 + hstep, voffA);
            PG8_WAIT_L(8); PG8_BAR; PG8_WAIT_L(0); PG8_MMA(0, 0, At, B0); PG8_BAR; PG8_SCHED;
            PG8_LDB(B1, 0, 1); PG8_STAGE(PG8_SB(0, 0), b2, voffB);
            PG8_BAR; PG8_WAIT_L(0); PG8_MMA(0, 1, At, B1); PG8_BAR;
            PG8_LDA(At, 0, 1); PG8_STAGE(PG8_SA(0, 0), a2, voffA);
            PG8_BAR; PG8_WAIT_L(0); PG8_MMA(1, 0, At, B0); PG8_BAR; PG8_SCHED;
            PG8_STAGE(PG8_SB(0, 1), b2 + hstep, voffB);
            PG8_WAIT_V(6); PG8_BAR; PG8_MMA(1, 1, At, B1); PG8_BAR;
            PG8_LDB(B0, 1, 0); PG8_SCHED; PG8_LDA(At, 1, 0); PG8_STAGE(PG8_SA(0, 1), a2 + hstep, voffA);
            PG8_WAIT_L(8); PG8_BAR; PG8_WAIT_L(0); PG8_MMA(0, 0, At, B0); PG8_BAR; PG8_SCHED;
            PG8_LDB(B1, 1, 1); PG8_STAGE(PG8_SB(1, 0), b3, voffB);
            PG8_BAR; PG8_WAIT_L(0); PG8_MMA(0, 1, At, B1); PG8_BAR;
            PG8_LDA(At, 1, 1); PG8_STAGE(PG8_SA(1, 0), a3, voffA);
            PG8_BAR; PG8_WAIT_L(0); PG8_MMA(1, 0, At, B0); PG8_BAR; PG8_SCHED;
            PG8_STAGE(PG8_SB(1, 1), b3 + hstep, voffB);
            PG8_WAIT_V(6); PG8_BAR; PG8_MMA(1, 1, At, B1); PG8_BAR;
        }
        E(acc, cur, wr, wc, fr, fq);
        if (!has_next) break;
#pragma unroll
        for (int a = 0; a < 2; ++a)
#pragma unroll
            for (int b = 0; b < 2; ++b)
#pragma unroll
                for (int m = 0; m < 4; ++m)
#pragma unroll
                    for (int n = 0; n < 2; ++n) acc[a][b][m][n] = (f32x4){0.f, 0.f, 0.f, 0.f};
        cur = nxt; cA = nA; cB = nB; ++ui;
    }
    PG8_WAIT_V(0);
    if (wr == 0) PG8_BAR;
    PG8_BAR;
#undef PG8_SA
#undef PG8_SB
#undef PG8_STAGE
#undef PG8_LDA
#undef PG8_LDB
#undef PG8_MMA
#undef PG8_WAIT_V
#undef PG8_WAIT_L
#undef PG8_BAR
#undef PG8_SCHED
}
}
using pg8::Unit;

struct Epi1 {
    static constexpr bool PERM = true;
    bf16_t* QKV; bf16_t* SZA; bf16_t* UU; bf16_t* SZB; float* BA; bf16_t* HALO;
    __device__ __forceinline__ void operator()(const f32x4 (&acc)[2][2][4][2], const Unit& u, int wr, int wc, int fr_, int fq_) const {
        int lane = (int)(threadIdx.x & 63); asm volatile("" : "+v"(lane));
        const int fr = lane & 15, fq = lane >> 4; (void)fr_; (void)fq_;
        const int row0 = u.pm * 256 + wr * 64 + fr, pn = u.pn;
#pragma unroll
        for (int ai = 0; ai < 2; ++ai)
#pragma unroll
            for (int m = 0; m < 4; ++m) {
                const size_t row = (size_t)(row0 + ai * 128 + m * 16);
#pragma unroll
                for (int bj = 0; bj < 2; ++bj) {
                    const int colt = 128 * bj + 32 * wc + 8 * fq;
                    f32x4 v0 = acc[ai][bj][m][0], v1 = acc[ai][bj][m][1];
                    if (pn < 12) {
                        const int c = pn * 256 + colt; const u32x4 pk = pack8(v0, v1);
                        *(u32x4*)(QKV + row * 3072 + c) = pk;
                        if (m == 3 && fr >= 13) *(u32x4*)(HALO + ((row >> 6) * 3 + (fr - 13)) * 3072 + c) = pk;
                    } else if (pn < 16) {
#pragma unroll
                        for (int e = 0; e < 4; ++e) { v0[e] = siluf_(v0[e]); v1[e] = siluf_(v1[e]); }
                        *(u32x4*)(SZA + row * 1024 + (pn - 12) * 256 + colt) = pack8(v0, v1);
                    } else if (pn < 20) {
                        *(u32x4*)(UU + row * 1024 + (pn - 16) * 256 + colt) = pack8(v0, v1);
                    } else if (pn < 24) {
#pragma unroll
                        for (int e = 0; e < 4; ++e) { v0[e] = siluf_(v0[e]); v1[e] = siluf_(v1[e]); }
                        *(u32x4*)(SZB + row * 1024 + (pn - 20) * 256 + colt) = pack8(v0, v1);
                    } else if (colt < 16) {
                        *(f32x4*)(BA + row * 16 + colt) = v0; *(f32x4*)(BA + row * 16 + colt + 4) = v1;
                    }
                }
            }
    }
};
struct EpiGlu {
    static constexpr bool PERM = true;
    const bf16_t* Y5; const bf16_t* SZB; bf16_t* YMIX;
    __device__ __forceinline__ void operator()(const f32x4 (&acc)[2][2][4][2], const Unit& u, int wr, int wc, int fr, int fq) const {
        const int row0 = u.pm * 256 + wr * 64 + fr;
#pragma unroll
        for (int ai = 0; ai < 2; ++ai)
#pragma unroll
            for (int m = 0; m < 4; ++m) {
                const size_t row = (size_t)(row0 + ai * 128 + m * 16);
#pragma unroll
                for (int bj = 0; bj < 2; ++bj) {
                    const int c = u.pn * 256 + 128 * bj + 32 * wc + 8 * fq;
                    const u32x4 y = *(const u32x4*)(Y5 + row * 1024 + c), z = *(const u32x4*)(SZB + row * 1024 + c);
                    const f32x4 a0 = acc[ai][bj][m][0], a1 = acc[ai][bj][m][1];
                    u32x4 o;
                    o.x = pk2(lo2f(y.x) * sigmoidf_(a0[0]) * lo2f(z.x), hi2f(y.x) * sigmoidf_(a0[1]) * hi2f(z.x));
                    o.y = pk2(lo2f(y.y) * sigmoidf_(a0[2]) * lo2f(z.y), hi2f(y.y) * sigmoidf_(a0[3]) * hi2f(z.y));
                    o.z = pk2(lo2f(y.z) * sigmoidf_(a1[0]) * lo2f(z.z), hi2f(y.z) * sigmoidf_(a1[1]) * hi2f(z.z));
                    o.w = pk2(lo2f(y.w) * sigmoidf_(a1[2]) * lo2f(z.w), hi2f(y.w) * sigmoidf_(a1[3]) * hi2f(z.w));
                    *(u32x4*)(YMIX + row * 2048 + 1024 + c) = o;
                }
            }
    }
};
struct EpiF32 {
    static constexpr bool PERM = false;
    float* C;
    __device__ __forceinline__ void operator()(const f32x4 (&acc)[2][2][4][2], const Unit& u, int wr, int wc, int fr, int fq) const {
        const int row0 = u.pm * 256 + wr * 64 + fr, col0 = u.pn * 256 + wc * 32 + 4 * fq;
#pragma unroll
        for (int ai = 0; ai < 2; ++ai)
#pragma unroll
            for (int m = 0; m < 4; ++m) { float* rowp = C + (size_t)(row0 + ai * 128 + m * 16) * 1024 + col0;
#pragma unroll
                for (int bj = 0; bj < 2; ++bj)
#pragma unroll
                    for (int n = 0; n < 2; ++n) *(f32x4*)(rowp + bj * 128 + n * 16) = acc[ai][bj][m][n]; }
    }
};
struct Epi2 {
    static constexpr bool PERM = false;
    bf16_t* P; bf16_t* Q;
    __device__ __forceinline__ void operator()(const f32x4 (&acc)[2][2][4][2], const Unit& u, int wr, int wc, int fr, int fq) const {
        const int row0 = u.pm * 256 + wr * 64 + fr, ch = u.pn * 64 + 16 * wc + 4 * fq;
#pragma unroll
        for (int ai = 0; ai < 2; ++ai)
#pragma unroll
            for (int m = 0; m < 4; ++m) {
                const size_t row = (size_t)(row0 + ai * 128 + m * 16);
                const f32x4 gb = acc[ai][0][m][0], gc = acc[ai][0][m][1], hv = acc[ai][1][m][0], z = acc[ai][1][m][1];
                u32x2 pp, qq;
                pp.x = pk2(gc[0] * hv[0], gc[1] * hv[1]); pp.y = pk2(gc[2] * hv[2], gc[3] * hv[3]);
                qq.x = pk2(gb[0] * siluf_(z[0]), gb[1] * siluf_(z[1])); qq.y = pk2(gb[2] * siluf_(z[2]), gb[3] * siluf_(z[3]));
                *(u32x2*)(P + row * 2048 + ch) = pp; *(u32x2*)(Q + row * 2048 + ch) = qq;
            }
    }
};

__device__ __forceinline__ int src_col(int mode, int n, int& pn_unused) {
    (void)pn_unused;
    if (mode == 0) return n;
    if (mode == 1) { if (n < 4096) return n; if (n < 6144) return n + 16; if (n < 6160) return n - 2048; return -1; }
    const int pn = n >> 8, col = n & 255, bj = col >> 7, wc = (col >> 5) & 3, nn = (col >> 4) & 1, lo = col & 15;
    return (2 * bj + nn) * 2048 + pn * 64 + 16 * wc + lo;
}
__device__ __forceinline__ void phase_convert(const Prm& p, unsigned char* lds) {
    float* tile = (float*)lds;
    const int tid = threadIdx.x;
    for (int tix = blockIdx.x; tix < 4928; tix += gridDim.x) {
        int tl = tix, K, Nsrc, mode; const float* W; bf16_t* Wt;
        if (tl < 1600) { W = p.in[3]; Wt = (bf16_t*)(p.ws + OFF_WT1); K = 1024; Nsrc = 6160; mode = 1; }
        else if ((tl -= 1600) < 256) { W = p.in[16]; Wt = (bf16_t*)(p.ws + OFF_WTG); K = 1024; Nsrc = 1024; mode = 0; }
        else if ((tl -= 256) < 512) { W = p.in[17]; Wt = (bf16_t*)(p.ws + OFF_WTO0); K = 2048; Nsrc = 1024; mode = 0; }
        else if ((tl -= 512) < 2048) { W = p.in[18]; Wt = (bf16_t*)(p.ws + OFF_WT2); K = 1024; Nsrc = 8192; mode = 2; }
        else { tl -= 2048; W = p.in[20]; Wt = (bf16_t*)(p.ws + OFF_WTO1); K = 2048; Nsrc = 1024; mode = 0; }
        const int ntk = K / 64, n0 = (tl / ntk) * 64, k0 = (tl % ntk) * 64;
        { const int j = tid & 63; int dummy = 0; const int sc = src_col(mode, n0 + j, dummy);
#pragma unroll
          for (int i = 0; i < 8; ++i) { const int k = (tid >> 6) + 8 * i; tile[k * 65 + j] = sc >= 0 ? W[(size_t)(k0 + k) * Nsrc + sc] : 0.0f; } }
        __syncthreads();
        { const int r = tid >> 3, c8 = (tid & 7) * 8; u32x4 o;
          o.x = pk2(tile[(c8 + 0) * 65 + r], tile[(c8 + 1) * 65 + r]); o.y = pk2(tile[(c8 + 2) * 65 + r], tile[(c8 + 3) * 65 + r]);
          o.z = pk2(tile[(c8 + 4) * 65 + r], tile[(c8 + 5) * 65 + r]); o.w = pk2(tile[(c8 + 6) * 65 + r], tile[(c8 + 7) * 65 + r]);
          *(u32x4*)(Wt + (size_t)(n0 + r) * K + k0 + c8) = o; }
        __syncthreads();
    }
}
__device__ __forceinline__ void phase_rmsnorm_x(const float* x, const float* w, bf16_t* H) {
    const int lane = threadIdx.x & 63, nw = gridDim.x * 8;
    for (int row = blockIdx.x * 8 + (threadIdx.x >> 6); row < TOK; row += nw) {
        const f32x4* xr = (const f32x4*)(x + (size_t)row * 1024);
        f32x4 v[4]; float ss = 0.f;
#pragma unroll
        for (int i = 0; i < 4; ++i) { v[i] = xr[lane + 64 * i]; ss += v[i][0] * v[i][0] + v[i][1] * v[i][1] + v[i][2] * v[i][2] + v[i][3] * v[i][3]; }
        ss = wave_sum(ss);
        const float rstd = rsqrtf(ss * (1.0f / 1024.0f) + 1e-6f);
#pragma unroll
        for (int i = 0; i < 4; ++i) { const f32x4 w4 = ((const f32x4*)w)[lane + 64 * i]; u32x2 o;
            o.x = pk2(v[i][0] * rstd * w4[0], v[i][1] * rstd * w4[1]); o.y = pk2(v[i][2] * rstd * w4[2], v[i][3] * rstd * w4[3]);
            *(u32x2*)(H + (size_t)row * 1024 + (lane + 64 * i) * 4) = o; }
    }
}
template <bool NEXT>
__device__ __forceinline__ void phase_post(const float* base, const float* Y, const float* wpost, float* OUT, const float* wpre, bf16_t* H) {
    const int lane = threadIdx.x & 63, nw = gridDim.x * 8;
    for (int row = blockIdx.x * 8 + (threadIdx.x >> 6); row < TOK; row += nw) {
        const f32x4* yr = (const f32x4*)(Y + (size_t)row * 1024); const f32x4* br = (const f32x4*)(base + (size_t)row * 1024);
        f32x4 v[4], xb[4]; float ss = 0.f;
#pragma unroll
        for (int i = 0; i < 4; ++i) { v[i] = yr[lane + 64 * i]; xb[i] = br[lane + 64 * i]; ss += v[i][0] * v[i][0] + v[i][1] * v[i][1] + v[i][2] * v[i][2] + v[i][3] * v[i][3]; }
        ss = wave_sum(ss);
        const float rstd = rsqrtf(ss * (1.0f / 1024.0f) + 1e-6f);
        float s2 = 0.f;
#pragma unroll
        for (int i = 0; i < 4; ++i) { const f32x4 w4 = ((const f32x4*)wpost)[lane + 64 * i];
#pragma unroll
            for (int e = 0; e < 4; ++e) { v[i][e] = xb[i][e] + v[i][e] * rstd * w4[e]; s2 += v[i][e] * v[i][e]; }
            ((f32x4*)(OUT + (size_t)row * 1024))[lane + 64 * i] = v[i]; }
        if (NEXT) {
            s2 = wave_sum(s2);
            const float r2 = rsqrtf(s2 * (1.0f / 1024.0f) + 1e-6f);
#pragma unroll
            for (int i = 0; i < 4; ++i) { const f32x4 w4 = ((const f32x4*)wpre)[lane + 64 * i]; u32x2 o;
                o.x = pk2(v[i][0] * r2 * w4[0], v[i][1] * r2 * w4[1]); o.y = pk2(v[i][2] * r2 * w4[2], v[i][3] * r2 * w4[3]);
                *(u32x2*)(H + (size_t)row * 1024 + (lane + 64 * i) * 4) = o; }
        }
    }
}


__device__ __forceinline__ void sincos_d(double x, double& s, double& c) {
    const double k = rint(x * 0.6366197723675814);
    const double r = fma(-k, 6.123233995736766e-17, fma(-k, 1.5707963267948966, x)), r2 = r * r;
    double sp = -7.647163731819816e-13; sp = fma(sp, r2, 1.6059043836821613e-10); sp = fma(sp, r2, -2.505210838544172e-8); sp = fma(sp, r2, 2.7557319223985893e-6);
    sp = fma(sp, r2, -1.984126984126984e-4); sp = fma(sp, r2, 8.333333333333333e-3); sp = fma(sp, r2, -1.6666666666666666e-1); sp = fma(sp * r2, r, r);
    double cp = 4.779477332387385e-14; cp = fma(cp, r2, -1.1470745597729725e-11); cp = fma(cp, r2, 2.08767569878681e-9); cp = fma(cp, r2, -2.755731922398589e-7);
    cp = fma(cp, r2, 2.48015873015873e-5); cp = fma(cp, r2, -1.388888888888889e-3); cp = fma(cp, r2, 4.1666666666666664e-2); cp = fma(cp, r2, -0.5); cp = fma(cp, r2, 1.0);
    const int q = ((int)k) & 3;
    const double s0 = (q & 1) ? cp : sp, c0 = (q & 1) ? sp : cp;
    s = (q & 2) ? -s0 : s0; c = ((q + 1) & 2) ? -c0 : c0;
}
__device__ __forceinline__ double exp_d(double x) {
    const double n = rint(x * 1.4426950408889634);
    const double r = fma(-n, 2.3190468138462996e-17, fma(-n, 0.6931471805599453, x));
    double p = 1.6059043836821613e-10; p = fma(p, r, 2.08767569878681e-9); p = fma(p, r, 2.505210838544172e-8); p = fma(p, r, 2.755731922398589e-7); p = fma(p, r, 2.7557319223985893e-6);
    p = fma(p, r, 2.48015873015873e-5); p = fma(p, r, 1.984126984126984e-4); p = fma(p, r, 1.388888888888889e-3); p = fma(p, r, 8.333333333333333e-3); p = fma(p, r, 4.1666666666666664e-2);
    p = fma(p, r, 1.6666666666666666e-1); p = fma(p, r, 0.5); p = fma(p, r, 1.0); p = fma(p, r, 1.0);
    return ldexp(p, (int)n);
}
__device__ __forceinline__ float bcast_lo(float v) { auto r = __builtin_amdgcn_permlane32_swap(__float_as_uint(v), __float_as_uint(v), false, false); return __uint_as_float(r[0]); }
__device__ __forceinline__ float bcast_hi(float v) { auto r = __builtin_amdgcn_permlane32_swap(__float_as_uint(v), __float_as_uint(v), false, false); return __uint_as_float(r[1]); }

struct S5C {
    float ar[2][4], ai[2][4];
    float a512r[2], a512i[2];
    bf16x8 BB[4];
    bf16x8 CC[4];
    float dco;
};

template <bool OUT>
__device__ __forceinline__ void s5_chunk(const S5C& C, bf16_t* UU, int b, int g, int chunk, float (&st)[2][2], bf16_t* sX, int lane) {
    const int n = lane & 31, hh = lane >> 5, fr = lane & 15, fq = lane >> 4;
    const size_t tok0 = (size_t)b * SEQ + (size_t)chunk * 512;
    bf16x8 ua = *(const bf16x8*)(UU + (tok0 + n) * 1024 + 16 * g + 8 * hh);
    bf16_t uo[8];
    if (OUT) {
#pragma unroll
        for (int mt = 0; mt < 2; ++mt)
#pragma unroll
            for (int j = 0; j < 4; ++j) uo[mt * 4 + j] = UU[(tok0 + 16 * mt + 4 * fq + j) * 1024 + 16 * g + fr];
    }
    for (int blk = 0; blk < 16; ++blk) {
        const size_t t0 = tok0 + (size_t)blk * 32;
        const bf16x8 ucur = ua;
        bf16_t ucuro[8];
        if (OUT) {
#pragma unroll
            for (int i = 0; i < 8; ++i) ucuro[i] = uo[i];
        }
        if (blk < 15) {
            ua = *(const bf16x8*)(UU + (t0 + 32 + n) * 1024 + 16 * g + 8 * hh);
            if (OUT) {
#pragma unroll
                for (int mt = 0; mt < 2; ++mt)
#pragma unroll
                    for (int j = 0; j < 4; ++j) uo[mt * 4 + j] = UU[(t0 + 32 + 16 * mt + 4 * fq + j) * 1024 + 16 * g + fr];
            }
        }
        f32x16 acc[4];
#pragma unroll
        for (int tl = 0; tl < 4; ++tl) {
            f32x16 z;
#pragma unroll
            for (int i = 0; i < 16; ++i) z[i] = 0.f;
            acc[tl] = __builtin_amdgcn_mfma_f32_32x32x16_bf16(ucur, C.BB[tl], z, 0, 0, 0);
        }
#pragma unroll
        for (int tp = 0; tp < 2; ++tp) {
            f32x16& re = acc[2 * tp]; f32x16& im = acc[2 * tp + 1];
            const float a1r = C.ar[tp][0], a1i = C.ai[tp][0];
#pragma unroll
            for (int q = 0; q < 4; ++q)
#pragma unroll
                for (int r = 1; r < 4; ++r) {
                    const float pr = re[4 * q + r - 1], pi = im[4 * q + r - 1];
                    re[4 * q + r] += a1r * pr - a1i * pi; im[4 * q + r] += a1r * pi + a1i * pr;
                }
            float cr = st[tp][0], ci = st[tp][1];
            const float a4r = C.ar[tp][3], a4i = C.ai[tp][3];
#pragma unroll
            for (int q = 0; q < 4; ++q) {
                const float tr = re[4 * q + 3] + a4r * cr - a4i * ci, ti = im[4 * q + 3] + a4r * ci + a4i * cr;
                const float o0r = bcast_lo(tr), o0i = bcast_lo(ti);
                const float xr = hh ? o0r : cr, xi = hh ? o0i : ci;
                if (OUT) {
#pragma unroll
                    for (int r = 0; r < 4; ++r) { const float kr = C.ar[tp][r], ki = C.ai[tp][r];
                        re[4 * q + r] += kr * xr - ki * xi; im[4 * q + r] += kr * xi + ki * xr; }
                } else {
                    re[4 * q + 3] += a4r * xr - a4i * xi; im[4 * q + 3] += a4r * xi + a4i * xr;
                }
                cr = bcast_hi(re[4 * q + 3]); ci = bcast_hi(im[4 * q + 3]);
            }
            st[tp][0] = cr; st[tp][1] = ci;
        }
        if (OUT) {
            asm volatile("s_waitcnt lgkmcnt(0)" ::: "memory");
#pragma unroll
            for (int tp = 0; tp < 2; ++tp)
#pragma unroll
                for (int i = 0; i < 16; ++i) {
                    const int t = 8 * (i >> 2) + 4 * hh + (i & 3);
                    *(unsigned*)(sX + t * 136 + 2 * (n + 32 * tp)) = pk2(acc[2 * tp][i], acc[2 * tp + 1][i]);
                }
            asm volatile("s_waitcnt lgkmcnt(0)" ::: "memory");
            __builtin_amdgcn_wave_barrier();
#pragma unroll
            for (int mt = 0; mt < 2; ++mt) {
                f32x4 y = (f32x4){0.f, 0.f, 0.f, 0.f};
#pragma unroll
                for (int ks = 0; ks < 4; ++ks) {
                    const bf16x8 xa = *(const bf16x8*)(sX + (16 * mt + fr) * 136 + 32 * ks + 8 * fq);
                    y = __builtin_amdgcn_mfma_f32_16x16x32_bf16(xa, C.CC[ks], y, 0, 0, 0);
                }
#pragma unroll
                for (int j = 0; j < 4; ++j) {
                    float v = y[j] + C.dco * bf2f(ucuro[mt * 4 + j]);
                    const float inner = 0.7978845608028654f * (v + 0.044715f * v * v * v);
                    v = v / (1.0f + __expf(-2.0f * inner));
                    UU[(t0 + 16 * mt + 4 * fq + j) * 1024 + 16 * g + fr] = f2bf(v);
                }
            }
            asm volatile("s_waitcnt lgkmcnt(0)" ::: "memory");
            __builtin_amdgcn_wave_barrier();
        }
    }
}

__device__ __forceinline__ void phase_s5(const Prm& p, unsigned char* lds, int bg) {
    const int b = bg >> 6, g = bg & 63;
    const int tid = threadIdx.x, wv = tid >> 6, lane = tid & 63, n = lane & 31, hh = lane >> 5, fr = lane & 15, fq = lane >> 4;
    bf16_t* sX = (bf16_t*)(lds + wv * 8704);
    float* sXE = (float*)(lds + 8 * 8704);
    bf16_t* UU = (bf16_t*)(p.ws + OFF_UU);
    const float* lam_re = p.in[8]; const float* lam_im = p.in[9]; const float* b_re = p.in[10]; const float* b_im = p.in[11];
    const float* c_re = p.in[12]; const float* c_im = p.in[13];
    S5C C;
    const double dt = exp_d((double)p.in[14][g]);
    float fre[2], fim[2];
#pragma unroll
    for (int tp = 0; tp < 2; ++tp) {
        const int pp = n + 32 * tp;
        const double lr = (double)fminf(lam_re[g * 64 + pp], -1e-4f), li = (double)lam_im[g * 64 + pp];
#pragma unroll
        for (int k = 0; k < 4; ++k) { double sn, cs; sincos_d(li * dt * (k + 1), sn, cs); const double mag = exp_d(lr * dt * (k + 1)); C.ar[tp][k] = (float)(mag * cs); C.ai[tp][k] = (float)(mag * sn); }
        { double sn, cs; sincos_d(li * dt * 512.0, sn, cs); const double mag = exp_d(lr * dt * 512.0); C.a512r[tp] = (float)(mag * cs); C.a512i[tp] = (float)(mag * sn); }
        double sn, cs; sincos_d(li * dt, sn, cs);
        const double mag = exp_d(lr * dt), abr = mag * cs, abi = mag * sn;
        const double den = lr * lr + li * li, nr = abr - 1.0, ni = abi;
        fre[tp] = (float)((nr * lr + ni * li) / den); fim[tp] = (float)((ni * lr - nr * li) / den);
    }
#pragma unroll
    for (int tl = 0; tl < 4; ++tl) {
        const int tp = tl >> 1, ri = tl & 1, pp = n + 32 * tp;
#pragma unroll
        for (int j = 0; j < 8; ++j) {
            const int ch = 8 * hh + j;
            const float br = b_re[(g * 64 + pp) * 16 + ch], bi = b_im[(g * 64 + pp) * 16 + ch];
            const float v = ri == 0 ? fre[tp] * br - fim[tp] * bi : fre[tp] * bi + fim[tp] * br;
            C.BB[tl][j] = (short)f2bf(v);
        }
    }
#pragma unroll
    for (int ks = 0; ks < 4; ++ks)
#pragma unroll
        for (int j = 0; j < 8; ++j) {
            const int k = 32 * ks + 8 * fq + j, pp = k >> 1, ri = k & 1;
            const float v = ri == 0 ? c_re[(g * 16 + fr) * 64 + pp] : -c_im[(g * 16 + fr) * 64 + pp];
            C.CC[ks][j] = (short)f2bf(v);
        }
    C.dco = p.in[15][16 * g + fr];
    for (int rd = 0; rd < 2; ++rd) {
        const int chunk = wv + 8 * rd;
        float st[2][2] = {{0.f, 0.f}, {0.f, 0.f}};
        s5_chunk<false>(C, UU, b, g, chunk, st, sX, lane);
        if (hh == 0) {
#pragma unroll
            for (int tp = 0; tp < 2; ++tp) { sXE[(chunk * 64 + n + 32 * tp) * 2 + 0] = st[tp][0]; sXE[(chunk * 64 + n + 32 * tp) * 2 + 1] = st[tp][1]; }
        }
    }
    __syncthreads();
    for (int rd = 0; rd < 2; ++rd) {
        const int chunk = wv + 8 * rd;
        float st[2][2] = {{0.f, 0.f}, {0.f, 0.f}};
        for (int c2 = 0; c2 < chunk; ++c2) {
#pragma unroll
            for (int tp = 0; tp < 2; ++tp) {
                const float er = sXE[(c2 * 64 + n + 32 * tp) * 2 + 0], ei = sXE[(c2 * 64 + n + 32 * tp) * 2 + 1];
                const float nr = C.a512r[tp] * st[tp][0] - C.a512i[tp] * st[tp][1] + er, ni = C.a512r[tp] * st[tp][1] + C.a512i[tp] * st[tp][0] + ei;
                st[tp][0] = nr; st[tp][1] = ni;
            }
        }
        s5_chunk<true>(C, UU, b, g, chunk, st, sX, lane);
    }
    __syncthreads();
}

__device__ __forceinline__ void phase_gdn_prep(const Prm& p, unsigned char* lds, int it0, int nrounds) {
    const int tid0 = threadIdx.x, hb = tid0 >> 8;
    unsigned char* base = lds + hb * 72704;
    bf16_t* sQ = (bf16_t*)base;
    bf16_t* sK = (bf16_t*)(base + 17408);
    bf16_t* sV = (bf16_t*)(base + 2 * 17408);
    float* sL = (float*)(base + 3 * 17408);
    float* sBeta = (float*)(base + 4 * 17408);
    float* sGc = sBeta + 64; float* sEg = sGc + 64; float* sBE = sEg + 64;
    bf16_t* QKV = (bf16_t*)(p.ws + OFF_QKV); const bf16_t* HALO = (const bf16_t*)(p.ws + OFF_HALO);
    const float* BA = (const float*)(p.ws + OFF_BA); float* GL = (float*)(p.ws + OFF_GL);
    bf16_t* WB = (bf16_t*)(p.ws + OFF_WB); bf16_t* ATT = (bf16_t*)(p.ws + OFF_ATT);
    const float* convw = p.in[4];
    for (int rd = 0; rd < nrounds; ++rd) {
        int tid = tid0; asm volatile("" : "+v"(tid));
        const int ht = tid & 255, hw = (tid >> 6) & 3, lane = tid & 63, fr = lane & 15, fq = lane >> 4;
        const int it = it0 + rd * 2 + hb;
        const int b = it >> 10, h = (it >> 7) & 7, nc = it & 127;
        const size_t tokb = (size_t)b * SEQ + (size_t)nc * 64;
        {
            const int t = ht >> 2, cg4 = ht & 3;
#pragma unroll 1
            for (int s = 0; s < 3; ++s) {
                const int col = s * 1024 + h * 128 + cg4 * 32;
                float o[32]; float ss = 0.f;
#pragma unroll
                for (int c8 = 0; c8 < 4; ++c8) {
                    float a[8];
#pragma unroll
                    for (int e = 0; e < 8; ++e) a[e] = 0.f;
#pragma unroll
                    for (int d = 0; d < 4; ++d) {
                        const int tt = t - d;
                        u32x4 xv = (u32x4){0u, 0u, 0u, 0u};
                        if (tt >= 0) xv = *(const u32x4*)(QKV + (tokb + tt) * 3072 + col + c8 * 8);
                        else if (nc > 0) xv = *(const u32x4*)(HALO + ((size_t)(b * 128 + nc - 1) * 3 + (3 + tt)) * 3072 + col + c8 * 8);
                        const f32x4 w0 = *(const f32x4*)(convw + (3 - d) * 3072 + col + c8 * 8), w1 = *(const f32x4*)(convw + (3 - d) * 3072 + col + c8 * 8 + 4);
                        a[0] += w0[0] * lo2f(xv.x); a[1] += w0[1] * hi2f(xv.x); a[2] += w0[2] * lo2f(xv.y); a[3] += w0[3] * hi2f(xv.y);
                        a[4] += w1[0] * lo2f(xv.z); a[5] += w1[1] * hi2f(xv.z); a[6] += w1[2] * lo2f(xv.w); a[7] += w1[3] * hi2f(xv.w);
                    }
#pragma unroll
                    for (int e = 0; e < 8; ++e) { const float v = siluf_(a[e]); o[c8 * 8 + e] = v; ss += v * v; }
                    __builtin_amdgcn_sched_barrier(0);
                }
                float sc = 1.0f;
                if (s < 2) { ss += __shfl_xor(ss, 1); ss += __shfl_xor(ss, 2); sc = rsqrtf(ss + 1e-6f) * (s == 0 ? 0.08838834764831845f : 1.0f); }
                bf16_t* dst = (s == 0 ? sQ : (s == 1 ? sK : sV)) + t * 136 + cg4 * 32;
#pragma unroll
                for (int c8 = 0; c8 < 4; ++c8) { u32x4 pk;
                    pk.x = pk2(o[c8 * 8 + 0] * sc, o[c8 * 8 + 1] * sc); pk.y = pk2(o[c8 * 8 + 2] * sc, o[c8 * 8 + 3] * sc);
                    pk.z = pk2(o[c8 * 8 + 4] * sc, o[c8 * 8 + 5] * sc); pk.w = pk2(o[c8 * 8 + 6] * sc, o[c8 * 8 + 7] * sc);
                    *(u32x4*)(dst + c8 * 8) = pk; }
            }
        }
        if (hw == 0) {
            const size_t tg = tokb + lane;
            const float braw = BA[tg * 16 + h], araw = BA[tg * 16 + 8 + h];
            const float beta = 1.0f / (1.0f + expf(-braw));
            const float xx = araw + p.in[6][h];
            const float sp = xx > 20.f ? xx : log1pf(expf(xx));
            float gg = -expf(p.in[5][h]) * sp;
#pragma unroll
            for (int off = 1; off < 64; off <<= 1) { const float o = __shfl_up(gg, off); if (lane >= off) gg += o; }
            sBeta[lane] = beta; sGc[lane] = gg; sEg[lane] = expf(gg); sBE[lane] = beta * expf(gg);
            if (lane == 63) GL[it] = expf(gg);
        }
        __syncthreads();
        {
            bf16x8 aK[4], aQ[4];
#pragma unroll
            for (int ks = 0; ks < 4; ++ks) { aK[ks] = *(const bf16x8*)(sK + (16 * hw + fr) * 136 + 32 * ks + 8 * fq); aQ[ks] = *(const bf16x8*)(sQ + (16 * hw + fr) * 136 + 32 * ks + 8 * fq); }
#pragma unroll
            for (int nt = 0; nt < 4; ++nt) {
                f32x4 kk = (f32x4){0.f, 0.f, 0.f, 0.f}, qk = (f32x4){0.f, 0.f, 0.f, 0.f};
#pragma unroll
                for (int ks = 0; ks < 4; ++ks) {
                    const bf16x8 bK = *(const bf16x8*)(sK + (16 * nt + fr) * 136 + 32 * ks + 8 * fq);
                    kk = __builtin_amdgcn_mfma_f32_16x16x32_bf16(aK[ks], bK, kk, 0, 0, 0);
                    qk = __builtin_amdgcn_mfma_f32_16x16x32_bf16(aQ[ks], bK, qk, 0, 0, 0);
                }
                const int mcol = 16 * nt + fr; const float gm = sGc[mcol];
#pragma unroll
                for (int j = 0; j < 4; ++j) {
                    const int c = 16 * hw + 4 * fq + j;
                    const float dec = __expf(fminf(sGc[c] - gm, 0.f));
                    sL[c * 68 + mcol] = (mcol < c) ? kk[j] * sBeta[c] * dec : 0.f;
                    ATT[(size_t)it * 4096 + c * 64 + mcol] = f2bf((mcol <= c) ? qk[j] * dec : 0.f);
                }
            }
        }
        __syncthreads();
        {
            float x[64];
            const bool isU = ht < 128; const int jc = ht & 127;
            const bf16_t* src = isU ? sV : sK;
            const float* fac = isU ? sBeta : sBE;
#pragma unroll
            for (int c = 0; c < 64; ++c) {
                const float r = bf2f(src[c * 136 + jc]) * fac[c];
                float a0 = r, a1 = 0.f, a2 = 0.f, a3 = 0.f;
#pragma unroll
                for (int m4 = 0; m4 < c; m4 += 4) {
                    const f32x4 l = *(const f32x4*)(sL + c * 68 + m4);
                    a0 -= l[0] * x[m4];
                    if (m4 + 1 < c) a1 -= l[1] * x[m4 + 1];
                    if (m4 + 2 < c) a2 -= l[2] * x[m4 + 2];
                    if (m4 + 3 < c) a3 -= l[3] * x[m4 + 3];
                }
                x[c] = (a0 + a1) + (a2 + a3);
                __builtin_amdgcn_sched_barrier(0);
            }
            if (isU) {
                const int wvv = jc >> 5, nn = jc & 31;
#pragma unroll
                for (int hh2 = 0; hh2 < 2; ++hh2)
#pragma unroll
                    for (int j = 0; j < 4; ++j) {
                        const int cb = 32 * (j >> 1) + 16 * (j & 1) + 4 * hh2;
                        u32x4 o; o.x = pk2(x[cb + 0], x[cb + 1]); o.y = pk2(x[cb + 2], x[cb + 3]); o.z = pk2(x[cb + 8], x[cb + 9]); o.w = pk2(x[cb + 10], x[cb + 11]);
                        const int L = ((wvv * 4 + j) * 64 + hh2 * 32 + nn) * 8;
                        *(u32x4*)(QKV + (tokb + (L >> 7)) * 3072 + 2048 + h * 128 + (L & 127)) = o;
                    }
            } else {
#pragma unroll
                for (int c = 0; c < 64; ++c) WB[(size_t)it * 8192 + c * 128 + jc] = f2bf(-x[c]);
            }
        }
        {
            const int c = ht >> 2, ds = (ht & 3) * 32; const float eg = sEg[c];
#pragma unroll
            for (int c8 = 0; c8 < 4; ++c8) {
                const u32x4 v = *(const u32x4*)(sQ + c * 136 + ds + c8 * 8); u32x4 o;
                o.x = pk2(lo2f(v.x) * eg, hi2f(v.x) * eg); o.y = pk2(lo2f(v.y) * eg, hi2f(v.y) * eg); o.z = pk2(lo2f(v.z) * eg, hi2f(v.z) * eg); o.w = pk2(lo2f(v.w) * eg, hi2f(v.w) * eg);
                *(u32x4*)(QKV + (tokb + c) * 3072 + h * 128 + ds + c8 * 8) = o;
            }
            const int d = ht >> 1, cs = (ht & 1) * 32; const float gl = sGc[63];
#pragma unroll
            for (int c8 = 0; c8 < 4; ++c8) {
                float v[8];
#pragma unroll
                for (int e = 0; e < 8; ++e) { const int cc = cs + c8 * 8 + e; v[e] = bf2f(sK[cc * 136 + d]) * __expf(gl - sGc[cc]); }
                u32x4 o; o.x = pk2(v[0], v[1]); o.y = pk2(v[2], v[3]); o.z = pk2(v[4], v[5]); o.w = pk2(v[6], v[7]);
                *(u32x4*)(QKV + (tokb + (d >> 1)) * 3072 + 1024 + h * 128 + (d & 1) * 64 + cs + c8 * 8) = o;
            }
        }
        __syncthreads();
    }
}

__device__ __forceinline__ bf16x8 ld_perm(const unsigned char* p) { return *(const bf16x8*)p; }
__device__ __forceinline__ bf16x8 pack_acc(const f32x16& v, int s) {
    u32x4 r; r.x = pk2(v[8 * s + 0], v[8 * s + 1]); r.y = pk2(v[8 * s + 2], v[8 * s + 3]); r.z = pk2(v[8 * s + 4], v[8 * s + 5]); r.w = pk2(v[8 * s + 6], v[8 * s + 7]);
    return __builtin_bit_cast(bf16x8, r);
}
constexpr int SC_RW = 272, SC_RK = 144;
constexpr int SC_QD = 64 * SC_RW, SC_KT = 2 * 64 * SC_RW, SC_AT = SC_KT + 128 * SC_RK, SC_U = SC_AT + 64 * SC_RK, SC_STAGE = SC_U + 16384;
static_assert(2 * SC_STAGE <= LDS_BYTES && SC_U % 16 == 0 && SC_STAGE % 16 == 0, "scan LDS layout");
__device__ __forceinline__ u32x4 hswap(u32x4 v, int sw) { u32x4 r; r.x = sw ? v.z : v.x; r.y = sw ? v.w : v.y; r.z = sw ? v.x : v.z; r.w = sw ? v.y : v.w; return r; }
struct ScanRegs { u32x4 rw[4], rq[4], rk[4], ru[4], ra[2]; };
__device__ __forceinline__ void scan_load(ScanRegs& R, const bf16_t* QKV, const bf16_t* WB, const bf16_t* ATT, int b, int h, int it, int nc, int lt) {
    const size_t tokb = (size_t)b * SEQ + (size_t)nc * 64;
#pragma unroll
    for (int i = 0; i < 4; ++i) { const int ch = lt + 256 * i, r = ch >> 4, c8 = (ch & 15) * 8;
        R.rw[i] = *(const u32x4*)(WB + (size_t)it * 8192 + r * 128 + c8);
        const bf16_t* qp = QKV + (tokb + r) * 3072 + h * 128 + c8;
        R.rq[i] = *(const u32x4*)(qp); R.rk[i] = *(const u32x4*)(qp + 1024); R.ru[i] = *(const u32x4*)(qp + 2048); }
#pragma unroll
    for (int i = 0; i < 2; ++i) { const int ch = lt + 256 * i; R.ra[i] = *(const u32x4*)(ATT + (size_t)it * 4096 + ch * 8); }
}
__device__ __forceinline__ void st16p(unsigned char* rowp, int g, u32x4 v) {
    unsigned char* p = rowp + 32 * (g >> 1) + 8 * (g & 1);
    *(u32x2*)p = (u32x2){v.x, v.y}; *(u32x2*)(p + 16) = (u32x2){v.z, v.w};
}
__device__ __forceinline__ void scan_store(const ScanRegs& R, unsigned char* sbp, int lt) {
#pragma unroll
    for (int i = 0; i < 4; ++i) { const int ch = lt + 256 * i, r = ch >> 4, g = ch & 15;
        st16p(sbp + r * SC_RW, g, R.rw[i]);
        st16p(sbp + SC_QD + r * SC_RW, g, R.rq[i]);
        const int d = 2 * r + (g >> 3), gk = g & 7;
        st16p(sbp + SC_KT + d * SC_RK, gk, R.rk[i]);
        *(u32x4*)(sbp + SC_U + ch * 16) = R.ru[i]; }
#pragma unroll
    for (int i = 0; i < 2; ++i) { const int ch = lt + 256 * i, r = ch >> 3, g = ch & 7; st16p(sbp + SC_AT + r * SC_RK, g, R.ra[i]); }
}
#define SCAN_BAR() do { asm volatile("s_waitcnt lgkmcnt(0)" ::: "memory"); __builtin_amdgcn_s_barrier(); asm volatile("" ::: "memory"); } while (0)
__device__ __forceinline__ void phase_gdn_scan(const Prm& p, unsigned char* lds, int bh) {
    const int tid = threadIdx.x, wv = tid >> 6, lane = tid & 63, n = lane & 31, hh = lane >> 5;
    const int b = bh >> 3, h = bh & 7;
    const bf16_t* QKV = (const bf16_t*)(p.ws + OFF_QKV); const bf16_t* WB = (const bf16_t*)(p.ws + OFF_WB); const bf16_t* ATT = (const bf16_t*)(p.ws + OFF_ATT);
    const float* GL = (const float*)(p.ws + OFF_GL); bf16_t* O = (bf16_t*)(p.ws + OFF_H);
    const int itb = bh * 128;
    if (wv >= 4) {
        const int lt = tid - 256;
        ScanRegs RA, RB;
        scan_load(RA, QKV, WB, ATT, b, h, itb, 0, lt);
        scan_store(RA, lds, lt);
        __builtin_amdgcn_sched_barrier(0);
        scan_load(RA, QKV, WB, ATT, b, h, itb + 1, 1, lt);
        __builtin_amdgcn_sched_barrier(0);
        scan_load(RB, QKV, WB, ATT, b, h, itb + 2, 2, lt);
        __builtin_amdgcn_sched_barrier(0);
        SCAN_BAR();
        for (int nc = 0; nc < 128; nc += 2) {
            __builtin_amdgcn_sched_barrier(0);
            scan_store(RA, lds + SC_STAGE, lt);
            __builtin_amdgcn_sched_barrier(0);
            { const int c3 = nc + 3 < 128 ? nc + 3 : 127; scan_load(RA, QKV, WB, ATT, b, h, itb + c3, c3, lt); }
            __builtin_amdgcn_sched_barrier(0);
            SCAN_BAR();
            __builtin_amdgcn_sched_barrier(0);
            scan_store(RB, lds, lt);
            __builtin_amdgcn_sched_barrier(0);
            { const int c4 = nc + 4 < 128 ? nc + 4 : 127; scan_load(RB, QKV, WB, ATT, b, h, itb + c4, c4, lt); }
            SCAN_BAR();
        }
    } else {
        const float gl0 = GL[itb + lane], gl1 = GL[itb + 64 + lane];
        f32x16 S[4];
#pragma unroll
        for (int dt = 0; dt < 4; ++dt)
#pragma unroll
            for (int i = 0; i < 16; ++i) S[dt][i] = 0.f;
        const int e = 32 * wv + n;
        SCAN_BAR();
        for (int nc = 0; nc < 128; ++nc) {
            const unsigned char* sbp = lds + (nc & 1) * SC_STAGE;
            const float gl = __builtin_bit_cast(float, __builtin_amdgcn_readlane(__builtin_bit_cast(int, nc < 64 ? gl0 : gl1), nc & 63));
            const unsigned char* pw = sbp + n * SC_RW + 16 * hh;
            const unsigned char* pk = sbp + SC_KT + n * SC_RK + 16 * hh;
            f32x16 V[2], Oa[2];
#pragma unroll
            for (int j = 0; j < 4; ++j) {
                const u32x4 uu = *(const u32x4*)(sbp + SC_U + ((wv * 4 + j) * 64 + lane) * 16);
                f32x16& vv = V[j >> 1]; const int o8 = 8 * (j & 1);
                vv[o8 + 0] = lo2f(uu.x); vv[o8 + 1] = hi2f(uu.x); vv[o8 + 2] = lo2f(uu.y); vv[o8 + 3] = hi2f(uu.y);
                vv[o8 + 4] = lo2f(uu.z); vv[o8 + 5] = hi2f(uu.z); vv[o8 + 6] = lo2f(uu.w); vv[o8 + 7] = hi2f(uu.w);
            }
#pragma unroll
            for (int ct = 0; ct < 2; ++ct)
#pragma unroll
                for (int i = 0; i < 16; ++i) Oa[ct][i] = 0.f;
            bf16x8 fa[2][4];
#define LD_WQ(dst, ks_) do { dst[0] = ld_perm(pw + 32 * (ks_)); dst[1] = ld_perm(pw + 32 * SC_RW + 32 * (ks_)); \
                             dst[2] = ld_perm(pw + SC_QD + 32 * (ks_)); dst[3] = ld_perm(pw + SC_QD + 32 * SC_RW + 32 * (ks_)); } while (0)
            LD_WQ(fa[0], 0);
#pragma unroll
            for (int ks = 0; ks < 8; ++ks) {
                if (ks < 7) LD_WQ(fa[(ks + 1) & 1], ks + 1);
                const bf16x8 sb8 = pack_acc(S[ks >> 1], ks & 1);
                __builtin_amdgcn_sched_barrier(0);
                V[0] = __builtin_amdgcn_mfma_f32_32x32x16_bf16(fa[ks & 1][0], sb8, V[0], 0, 0, 0);
                Oa[0] = __builtin_amdgcn_mfma_f32_32x32x16_bf16(fa[ks & 1][2], sb8, Oa[0], 0, 0, 0);
                V[1] = __builtin_amdgcn_mfma_f32_32x32x16_bf16(fa[ks & 1][1], sb8, V[1], 0, 0, 0);
                Oa[1] = __builtin_amdgcn_mfma_f32_32x32x16_bf16(fa[ks & 1][3], sb8, Oa[1], 0, 0, 0);
                __builtin_amdgcn_sched_barrier(0);
            }
#undef LD_WQ
            bf16x8 fb[2][6];
#define LD_AK(dst, k2_) do { dst[0] = ld_perm(pk + (SC_AT - SC_KT) + 32 * (k2_)); dst[1] = ld_perm(pk + (SC_AT - SC_KT) + 32 * SC_RK + 32 * (k2_)); \
                             dst[2] = ld_perm(pk + 32 * (k2_)); dst[3] = ld_perm(pk + 32 * SC_RK + 32 * (k2_)); \
                             dst[4] = ld_perm(pk + 64 * SC_RK + 32 * (k2_)); dst[5] = ld_perm(pk + 96 * SC_RK + 32 * (k2_)); } while (0)
            LD_AK(fb[0], 0);
            bf16x8 Vb[4];
#pragma unroll
            for (int k2 = 0; k2 < 4; ++k2) Vb[k2] = pack_acc(V[k2 >> 1], k2 & 1);
#pragma unroll
            for (int dt = 0; dt < 4; ++dt) S[dt] *= gl;
#pragma unroll
            for (int k2 = 0; k2 < 4; ++k2) {
                if (k2 < 3) LD_AK(fb[(k2 + 1) & 1], k2 + 1);
                __builtin_amdgcn_sched_barrier(0);
                Oa[0] = __builtin_amdgcn_mfma_f32_32x32x16_bf16(fb[k2 & 1][0], Vb[k2], Oa[0], 0, 0, 0);
                S[0] = __builtin_amdgcn_mfma_f32_32x32x16_bf16(fb[k2 & 1][2], Vb[k2], S[0], 0, 0, 0);
                Oa[1] = __builtin_amdgcn_mfma_f32_32x32x16_bf16(fb[k2 & 1][1], Vb[k2], Oa[1], 0, 0, 0);
                S[1] = __builtin_amdgcn_mfma_f32_32x32x16_bf16(fb[k2 & 1][3], Vb[k2], S[1], 0, 0, 0);
                S[2] = __builtin_amdgcn_mfma_f32_32x32x16_bf16(fb[k2 & 1][4], Vb[k2], S[2], 0, 0, 0);
                S[3] = __builtin_amdgcn_mfma_f32_32x32x16_bf16(fb[k2 & 1][5], Vb[k2], S[3], 0, 0, 0);
                __builtin_amdgcn_sched_barrier(0);
            }
#undef LD_AK
            bf16_t* obase = O + (size_t)(itb + nc) * 8192 + e * 64 + 4 * hh;
#pragma unroll
            for (int ct = 0; ct < 2; ++ct)
#pragma unroll
                for (int q = 0; q < 4; ++q) {
                    u32x2 o2; o2.x = pk2(Oa[ct][4 * q + 0], Oa[ct][4 * q + 1]); o2.y = pk2(Oa[ct][4 * q + 2], Oa[ct][4 * q + 3]);
                    *(u32x2*)(obase + 32 * ct + 8 * q) = o2;
                }
            SCAN_BAR();
        }
    }
    __syncthreads();
}

__device__ __forceinline__ void phase_ya(const Prm& p, unsigned char* lds) {
    const bf16_t* OT = (const bf16_t*)(p.ws + OFF_H); const bf16_t* SZA = (const bf16_t*)p.out; bf16_t* YMIX = (bf16_t*)(p.ws + OFF_YMIX);
    const float* gw = p.in[7];
    bf16_t* sT = (bf16_t*)lds;
    float* sPart = (float*)(lds + 16384);
    const int tid = threadIdx.x, w = tid >> 6, c = tid & 63;
    for (int it = blockIdx.x; it < NIT; it += gridDim.x) {
        const int b = it >> 10, h = (it >> 7) & 7, nc = it & 127;
        const size_t tok = (size_t)b * SEQ + (size_t)nc * 64 + c;
#pragma unroll
        for (int i = 0; i < 2; ++i) { const int ch = tid + 512 * i; *(u32x4*)(sT + ch * 8) = *(const u32x4*)(OT + (size_t)it * 8192 + ch * 8); }
        const u32x4 z0 = *(const u32x4*)(SZA + tok * 1024 + h * 128 + 16 * w), z1 = *(const u32x4*)(SZA + tok * 1024 + h * 128 + 16 * w + 8);
        __syncthreads();
        float o[16]; float ss = 0.f;
#pragma unroll
        for (int j = 0; j < 16; ++j) { o[j] = bf2f(sT[(16 * w + j) * 64 + c]); ss += o[j] * o[j]; }
        sPart[w * 64 + c] = ss;
        __syncthreads();
        float tot = 0.f;
#pragma unroll
        for (int k = 0; k < 8; ++k) tot += sPart[k * 64 + c];
        const float rstd = rsqrtf(tot * (1.0f / 128.0f) + 1e-6f);
        const unsigned zz[8] = {z0.x, z0.y, z0.z, z0.w, z1.x, z1.y, z1.z, z1.w};
        unsigned r[8];
#pragma unroll
        for (int j = 0; j < 8; ++j)
            r[j] = pk2(o[2 * j] * rstd * gw[16 * w + 2 * j] * lo2f(zz[j]), o[2 * j + 1] * rstd * gw[16 * w + 2 * j + 1] * hi2f(zz[j]));
        *(u32x4*)(YMIX + tok * 2048 + h * 128 + 16 * w) = (u32x4){r[0], r[1], r[2], r[3]};
        *(u32x4*)(YMIX + tok * 2048 + h * 128 + 16 * w + 8) = (u32x4){r[4], r[5], r[6], r[7]};
        __syncthreads();
    }
}
__device__ __forceinline__ void phase_conv3(const Prm& p) {
    const bf16_t* P = (const bf16_t*)(p.ws + OFF_P); bf16_t* Q = (bf16_t*)(p.ws + OFF_Q); const float* cw = p.in[19];
    const int nth = gridDim.x * 512;
    for (int idx = blockIdx.x * 512 + threadIdx.x; idx < TOK * 256; idx += nth) {
        const int t = idx >> 8, c8 = (idx & 255) * 8, ts = t & (SEQ - 1);
        const u32x4 z4 = (u32x4){0u, 0u, 0u, 0u};
        const u32x4 p0 = *(const u32x4*)(P + (size_t)t * 2048 + c8);
        const u32x4 p1 = ts >= 1 ? *(const u32x4*)(P + (size_t)(t - 1) * 2048 + c8) : z4;
        const u32x4 p2 = ts >= 2 ? *(const u32x4*)(P + (size_t)(t - 2) * 2048 + c8) : z4;
        const u32x4 q = *(const u32x4*)(Q + (size_t)t * 2048 + c8);
        float r[8];
        const unsigned pa[4] = {p0.x, p0.y, p0.z, p0.w}, pb[4] = {p1.x, p1.y, p1.z, p1.w}, pc[4] = {p2.x, p2.y, p2.z, p2.w}, qa[4] = {q.x, q.y, q.z, q.w};
#pragma unroll
        for (int e = 0; e < 4; ++e) {
            const int c = c8 + 2 * e;
            r[2 * e] = lo2f(qa[e]) * (cw[c] * lo2f(pc[e]) + cw[2048 + c] * lo2f(pb[e]) + cw[4096 + c] * lo2f(pa[e]));
            r[2 * e + 1] = hi2f(qa[e]) * (cw[c + 1] * hi2f(pc[e]) + cw[2048 + c + 1] * hi2f(pb[e]) + cw[4096 + c + 1] * hi2f(pa[e]));
        }
        u32x4 o; o.x = pk2(r[0], r[1]); o.y = pk2(r[2], r[3]); o.z = pk2(r[4], r[5]); o.w = pk2(r[6], r[7]);
        *(u32x4*)(Q + (size_t)t * 2048 + c8) = o;
    }
}

#define XB_TMO      128
#define XB_XCNT(j)  (256  + 64 * (j))
#define XB_XSUB(j)  (1280 + 64 * (j))
#define XB_XGEN(j)  (2304 + 64 * (j))
#define XB_TOP      3328
#define XB_TOPGEN   3392
#define XCD_BAR_WORDS 3456
#define XB_SPIN_CAP (1u << 18)

__device__ __forceinline__ unsigned xb_ld(unsigned* p)              { return __hip_atomic_load(p, __ATOMIC_RELAXED, __HIP_MEMORY_SCOPE_AGENT); }
__device__ __forceinline__ unsigned xb_add(unsigned* p, unsigned v) { return __hip_atomic_fetch_add(p, v, __ATOMIC_RELAXED, __HIP_MEMORY_SCOPE_AGENT); }
__device__ __forceinline__ unsigned xb_xcc_id() { return (unsigned)__builtin_amdgcn_s_getreg((3 << 11) | 20) & 0xFu; }
#define XB_SPIN(cond, bar) do { unsigned _sp = 0; while (cond) { __builtin_amdgcn_s_sleep(1); \
    if ((++_sp & 255u) == 0u) { if (xb_ld(&(bar)[XB_TMO])) break; if (_sp > XB_SPIN_CAP) { atomicAdd(&(bar)[XB_TMO], 1u); break; } } } } while (0)

struct XcdBarrier {
    unsigned* bar; unsigned x;
    volatile LAS unsigned* st;
};

__device__ __forceinline__ XcdBarrier xcd_barrier_post(unsigned* bar, volatile LAS unsigned* st) {
    XcdBarrier b; b.bar = bar; b.x = xb_xcc_id(); b.st = st;
    if (threadIdx.x == 0) (void)xb_add(&bar[XB_XCNT(b.x)], 1u);
    return b;
}
__device__ __forceinline__ void xcd_barrier_complete(unsigned* bar, unsigned x, unsigned& nloc, unsigned& nx) {
    const unsigned G = gridDim.x * gridDim.y * gridDim.z;
    unsigned sum, cnt, mine, sp = 0u;
    for (;;) {
        sum = 0u; cnt = 0u; mine = 0u;
#pragma unroll
        for (unsigned j = 0; j < 16; ++j) { const unsigned c = xb_ld(&bar[XB_XCNT(j)]); sum += c; cnt += (c > 0u) ? 1u : 0u; mine = (j == x) ? c : mine; }
        if (sum == G) break;
        __builtin_amdgcn_s_sleep(1);
        if ((++sp & 255u) == 0u) { if (xb_ld(&bar[XB_TMO])) break; if (sp > XB_SPIN_CAP) { atomicAdd(&bar[XB_TMO], 1u); break; } }
    }
    nloc = mine > 0u ? mine : 1u; nx = cnt > 0u ? cnt : 1u;
}

__device__ __forceinline__ void xcd_barrier(const XcdBarrier& b) {
    asm volatile("s_waitcnt vmcnt(0)" ::: "memory");
    __syncthreads();
    if (threadIdx.x == 0) {
        unsigned* bar = b.bar;
        __builtin_amdgcn_s_waitcnt(0);
        unsigned nloc = b.st[0], nx = b.st[1];
        if (nloc == 0u) { xcd_barrier_complete(bar, b.x, nloc, nx); b.st[0] = nloc; b.st[1] = nx; }
        const unsigned old = xb_add(&bar[XB_XSUB(b.x)], 1u);
        const unsigned gen = old / nloc;
        if (old + 1u == (gen + 1u) * nloc) {
            __builtin_amdgcn_fence(__ATOMIC_RELEASE, "agent");
            asm volatile("s_waitcnt vmcnt(0)" ::: "memory");
            const unsigned og = xb_add(&bar[XB_TOP], 1u);
            const unsigned tg = og / nx;
            if (og + 1u == (tg + 1u) * nx) xb_add(&bar[XB_TOPGEN], 1u);
            else XB_SPIN(xb_ld(&bar[XB_TOPGEN]) == tg, bar);
            __builtin_amdgcn_fence(__ATOMIC_ACQUIRE, "agent");
            xb_add(&bar[XB_XGEN(b.x)], 1u);
            asm volatile("s_waitcnt vmcnt(0)" ::: "memory");
        } else {
            XB_SPIN(xb_ld(&bar[XB_XGEN(b.x)]) == gen, bar);
            __builtin_amdgcn_fence(__ATOMIC_ACQUIRE, "agent");
            asm volatile("s_waitcnt vmcnt(0)" ::: "memory");
        }
    }
    __syncthreads();
}

constexpr int NPHASE = 11;
#define REP_GEMM 1
#define REP_SYNC 1
#define REP_SCAN 1
#define REP_P0 1
#ifndef PHM
#define PHM 0x7FF
#endif
__global__ void __launch_bounds__(512, 2) mega(Prm p) {
    extern __shared__ __attribute__((aligned(16))) unsigned char shm[];
    LAS unsigned char* lds3 = (LAS unsigned char*)shm;
    unsigned char* ws = p.ws;
    volatile LAS unsigned* xst = (volatile LAS unsigned*)(lds3 + LDS_BYTES);
    if (threadIdx.x == 0) { xst[0] = 0u; xst[1] = 0u; }
    __syncthreads();
    XcdBarrier xb{};
    const bool multi = (p.ph_hi - p.ph_lo) > 1;
    if (multi) xb = xcd_barrier_post((unsigned*)(ws + OFF_BAR), xst);
    if (p.ph_lo < 0) cg::this_grid().sync();
#define PH_BEGIN(i) if (((PHM >> (i)) & 1) && p.ph_lo <= (i) && (i) < p.ph_hi) { if ((i) > p.ph_lo) { xcd_barrier(xb); if (REP_SYNC > 1) xcd_barrier(xb); } pg8::StaticOrder S; (void)S;
#define PH_END }
    PH_BEGIN(0)
        for (int rep = 0; rep < REP_P0; ++rep) {
        phase_convert(p, shm);
        phase_rmsnorm_x(p.in[0], p.in[1], (bf16_t*)(ws + OFF_H)); __syncthreads(); }
    PH_END
    PH_BEGIN(1)
        pg8::Gemm g{(const bf16_t*)(ws + OFF_H), (const bf16_t*)(ws + OFF_WT1), TOK, NP1, 1024};
        Epi1 E{(bf16_t*)(ws + OFF_QKV), (bf16_t*)p.out, (bf16_t*)(ws + OFF_UU), (bf16_t*)p.out + (size_t)TOK * 1024, (float*)(ws + OFF_BA), (bf16_t*)(ws + OFF_HALO)};
        S.init(TOK, NP1, gridDim.x, blockIdx.x); for (int rep = 0; rep < REP_GEMM; ++rep) { pg8::gemm_phase(lds3, g, S, E); __syncthreads(); }
    PH_END
    PH_BEGIN(2)
        if (blockIdx.x < 128) phase_s5(p, shm, blockIdx.x);
        else phase_gdn_prep(p, shm, (blockIdx.x - 128) * 16, 8);
    PH_END
    PH_BEGIN(3)
        if (blockIdx.x < 16) phase_gdn_scan(p, shm, blockIdx.x);
#if REP_SCAN > 1
        __syncthreads();
        if (blockIdx.x < 16) phase_gdn_scan(p, shm, blockIdx.x);
#endif
    PH_END
    PH_BEGIN(4)
        phase_ya(p, shm);
        pg8::Gemm g{(const bf16_t*)(ws + OFF_UU), (const bf16_t*)(ws + OFF_WTG), TOK, 1024, 1024};
        EpiGlu E{(const bf16_t*)(ws + OFF_UU), (const bf16_t*)p.out + (size_t)TOK * 1024, (bf16_t*)(ws + OFF_YMIX)};
        S.init(TOK, 1024, gridDim.x, blockIdx.x); for (int rep = 0; rep < REP_GEMM; ++rep) { pg8::gemm_phase(lds3, g, S, E); __syncthreads(); }
    PH_END
    PH_BEGIN(5)
        pg8::Gemm g{(const bf16_t*)(ws + OFF_YMIX), (const bf16_t*)(ws + OFF_WTO0), TOK, 1024, 2048};
        EpiF32 E{p.out};
        S.init(TOK, 1024, gridDim.x, blockIdx.x); for (int rep = 0; rep < REP_GEMM; ++rep) { pg8::gemm_phase(lds3, g, S, E); __syncthreads(); }
    PH_END
    PH_BEGIN(6)
        phase_post<true>(p.in[0], p.out, p.in[2], p.out, p.in[1] + 1024, (bf16_t*)(ws + OFF_H));
    PH_END
    PH_BEGIN(7)
        pg8::Gemm g{(const bf16_t*)(ws + OFF_H), (const bf16_t*)(ws + OFF_WT2), TOK, 8192, 1024};
        Epi2 E{(bf16_t*)(ws + OFF_P), (bf16_t*)(ws + OFF_Q)};
        S.init(TOK, 8192, gridDim.x, blockIdx.x); for (int rep = 0; rep < REP_GEMM; ++rep) { pg8::gemm_phase(lds3, g, S, E); __syncthreads(); }
    PH_END
    PH_BEGIN(8)
        phase_conv3(p);
    PH_END
    PH_BEGIN(9)
        pg8::Gemm g{(const bf16_t*)(ws + OFF_Q), (const bf16_t*)(ws + OFF_WTO1), TOK, 1024, 2048};
        EpiF32 E{(float*)(ws + OFF_P)};
        S.init(TOK, 1024, gridDim.x, blockIdx.x); for (int rep = 0; rep < REP_GEMM; ++rep) { pg8::gemm_phase(lds3, g, S, E); __syncthreads(); }
    PH_END
    PH_BEGIN(10)
        phase_post<false>(p.out, (const float*)(ws + OFF_P), p.in[2] + 1024, p.out, nullptr, nullptr);
    PH_END
}

#ifndef N_LAUNCH_MODE
#define N_LAUNCH_MODE 1
#endif

extern "C" void kernel_launch(void* const* d_in, const int* in_sizes, int n_in, void* d_out, int out_size, void* d_ws, size_t ws_size, hipStream_t stream) {
    static int ready = 0;
    if (!ready) {
        if (n_in != 21 || ws_size < WS_END || out_size != TOK * DM) { fprintf(stderr, "kernel_launch: unexpected shapes (n_in %d ws %zu out %d)\n", n_in, ws_size, out_size); ready = -1; return; }
        if (hipFuncSetAttribute((const void*)mega, hipFuncAttributeMaxDynamicSharedMemorySize, LDS_BYTES + 16) != hipSuccess) { fprintf(stderr, "kernel_launch: hipFuncSetAttribute failed\n"); ready = -1; return; }
        ready = 1;
    }
    if (ready < 0) return;
    Prm p{};
    for (int i = 0; i < 21; ++i) p.in[i] = (const float*)d_in[i];
    p.out = (float*)d_out; p.ws = (unsigned char*)d_ws;
#if N_LAUNCH_MODE == 1
    p.ph_lo = 0; p.ph_hi = NPHASE;
    void* args[] = {&p};
    if (hipMemsetAsync((unsigned char*)d_ws + OFF_BAR, 0, 16384, stream) != hipSuccess) { fprintf(stderr, "memset failed\n"); return; }
    hipError_t e = hipLaunchCooperativeKernel((const void*)mega, dim3(256), dim3(512), args, LDS_BYTES + 16, stream);
    if (e != hipSuccess) fprintf(stderr, "cooperative launch failed: %s\n", hipGetErrorString(e));
#else
    for (int ph = 0; ph < NPHASE; ++ph) {
        p.ph_lo = ph; p.ph_hi = ph + 1;
        hipLaunchKernelGGL(mega, dim3(256), dim3(512), LDS_BYTES + 16, stream, p);
    }
#endif
}
```

```cpp
#include <hip/hip_runtime.h>
#include <hip/hip_cooperative_groups.h>
#include <cstdio>
namespace cg = cooperative_groups;

#define LAS __attribute__((address_space(3)))
typedef unsigned short bf16_t;
typedef short bf16x8 __attribute__((ext_vector_type(8)));
typedef float f32x4 __attribute__((ext_vector_type(4)));
typedef float f32x16 __attribute__((ext_vector_type(16)));
typedef unsigned u32x4 __attribute__((ext_vector_type(4)));
typedef unsigned u32x2 __attribute__((ext_vector_type(2)));

constexpr int TOK = 16384, DM = 1024, SEQ = 8192;
constexpr int NP1 = 6400;
constexpr int NIT = 2048;

constexpr size_t OFF_WT1 = 0;
constexpr size_t OFF_WTG = OFF_WT1 + (size_t)NP1 * 1024 * 2;
constexpr size_t OFF_WTO0 = OFF_WTG + (size_t)1024 * 1024 * 2;
constexpr size_t OFF_WT2 = OFF_WTO0 + (size_t)1024 * 2048 * 2;
constexpr size_t OFF_WTO1 = OFF_WT2 + (size_t)8192 * 1024 * 2;
constexpr size_t OFF_H = OFF_WTO1 + (size_t)1024 * 2048 * 2;
constexpr size_t OFF_QKV = OFF_H + (size_t)TOK * 1024 * 2;
constexpr size_t OFF_UU = OFF_QKV + (size_t)TOK * 3072 * 2;
constexpr size_t OFF_WB = OFF_UU + (size_t)TOK * 1024 * 2;
constexpr size_t OFF_ATT = OFF_WB + (size_t)NIT * 8192 * 2;
constexpr size_t OFF_HALO = OFF_ATT + (size_t)NIT * 4096 * 2;
constexpr size_t OFF_BA = OFF_HALO + (size_t)256 * 3 * 3072 * 2;
constexpr size_t OFF_GL = OFF_BA + (size_t)TOK * 16 * 4;
constexpr size_t OFF_BAR = OFF_GL + (size_t)NIT * 4;
constexpr size_t WS_END = OFF_BAR + 16384;
constexpr size_t OFF_YMIX = OFF_QKV;
constexpr size_t OFF_P = OFF_QKV;
constexpr size_t OFF_Q = OFF_QKV + (size_t)TOK * 2048 * 2;
static_assert(OFF_Q + (size_t)TOK * 2048 * 2 <= OFF_WB, "Q overlaps live data");
static_assert(WS_END <= (size_t)256 * 1024 * 1024, "workspace too big");

constexpr int LDS_BYTES = 157696;

struct Prm {
    const float* in[21];
    float* out;
    unsigned char* ws;
    int ph_lo, ph_hi;
};

__device__ __forceinline__ float bf2f(bf16_t b) { return __uint_as_float(((unsigned)b) << 16); }
__device__ __forceinline__ bf16_t f2bf(float f) { unsigned u = __float_as_uint(f); u += 0x7FFFu + ((u >> 16) & 1u); return (bf16_t)(u >> 16); }
typedef __bf16 bf16v2_t __attribute__((ext_vector_type(2)));
typedef float f32x2_t __attribute__((ext_vector_type(2)));
__device__ __forceinline__ unsigned pk2(float lo, float hi) { const f32x2_t v = {lo, hi}; return __builtin_bit_cast(unsigned, __builtin_convertvector(v, bf16v2_t)); }
__device__ __forceinline__ float lo2f(unsigned u) { return __uint_as_float(u << 16); }
__device__ __forceinline__ float hi2f(unsigned u) { return __uint_as_float(u & 0xFFFF0000u); }
__device__ __forceinline__ float sigmoidf_(float x) { return 1.0f / (1.0f + __expf(-x)); }
__device__ __forceinline__ float siluf_(float x) { return x / (1.0f + __expf(-x)); }
__device__ __forceinline__ float wave_sum(float v) {
#pragma unroll
    for (int o = 32; o >= 1; o >>= 1) v += __shfl_xor(v, o);
    return v;
}
__device__ __forceinline__ u32x4 pack8(f32x4 a, f32x4 b) { u32x4 r; r.x = pk2(a[0], a[1]); r.y = pk2(a[2], a[3]); r.z = pk2(b[0], b[1]); r.w = pk2(b[2], b[3]); return r; }

namespace pg8 {
constexpr int BM = 256, BK = 64, HALF = 128, HTB = HALF * BK * 2, STAGE_BYTES = 8 * HTB, NXCD = 8, WGM = 8;
__device__ __forceinline__ int lds_byte(int r, int c) { const int st = (r >> 4) * 2 + (c >> 5), rr = r & 15, cc = c & 31, ob = rr * 64 + cc * 2; return st * 1024 + (ob ^ (((ob >> 9) & 1) << 5)); }
__device__ __forceinline__ void stage_rc(int b, int& R, int& C) { const int st = b / 1024, sb = b % 1024, swz = sb ^ (((sb >> 9) & 1) << 5); R = (st >> 1) * 16 + swz / 64; C = (st & 1) * 32 + (swz % 64) / 2; }
__device__ __forceinline__ int perm32(int rho) { const int n = rho >> 4, i = rho & 15; return 8 * (i >> 2) + 4 * n + (i & 3); }
struct Unit { int pm, pn; };
struct Gemm { const bf16_t* A; const bf16_t* Bt; int M, N, K; const bf16_t* A2; int lda, ks; };
struct StaticOrder {
    int nM, nN, nwg, G, c;
    __device__ void init(int M, int N, int G_, int c_) { nM = M / BM; nN = N / BM; nwg = nM * nN; G = G_; c = c_; }
    __device__ bool next(int i, Unit& u) const {
        const long L = (long)i * G + c; if (L >= nwg) return false;
        int wgid = (int)L; { const int q = nwg / NXCD, r = nwg % NXCD, xcd = wgid % NXCD, off = wgid / NXCD; wgid = (xcd < r ? xcd * (q + 1) : r * (q + 1) + (xcd - r) * q) + off; }
        const int nig = WGM * nN, gid = wgid / nig, fm = gid * WGM, gsz = (nM - fm) < WGM ? (nM - fm) : WGM;
        u.pm = fm + ((wgid % nig) % gsz); u.pn = (wgid % nig) / gsz; return true;
    }
};

template <class Epi>
__device__ __forceinline__ void gemm_phase(LAS unsigned char* lds, const Gemm g, const StaticOrder& S, const Epi& E) {
    const int tid = threadIdx.x, wid = __builtin_amdgcn_readfirstlane(tid >> 6), lane = tid & 63, wr = wid >> 2, wc = wid & 3, fr = lane & 15, fq = lane >> 4;
    const int K = g.K, nt = K / BK;
    unsigned voffA[2], voffB[2];
#pragma unroll
    for (int i = 0; i < 2; ++i) { int R, C; stage_rc(tid * 16 + i * 8192, R, C); const int Rb = Epi::PERM ? ((R & ~31) + perm32(R & 31)) : R;
        voffA[i] = (unsigned)(R * g.lda + C) * 2u; voffB[i] = (unsigned)(Rb * K + C) * 2u; }
    const size_t kstep = (size_t)(BK * 2);
    const size_t hstep = (size_t)HALF * K * 2;
    const size_t tstep = 2 * hstep;
    const size_t hstepA = (size_t)HALF * g.lda * 2, tstepA = 2 * hstepA;
    const int ks = g.ks; const ptrdiff_t a2off = (const char*)g.A2 - (const char*)g.A - (ptrdiff_t)ks * (ptrdiff_t)kstep;
    const unsigned ldsw = (unsigned)wid * 1024u;
    const int aoff = lds_byte(wr * 64 + fr, fq * 8), boff = lds_byte(wc * 32 + fr, fq * 8);
#define PG8_SA(b, h) (((b) * 2 + (h)) * HTB)
#define PG8_SB(b, h) ((4 + (b) * 2 + (h)) * HTB)
#define PG8_STAGE(bufoff, gbase, voff) do { _Pragma("unroll") for (int _i = 0; _i < 2; ++_i) \
        __builtin_amdgcn_global_load_lds((const unsigned*)((const char*)(gbase) + (voff)[_i]), (LAS unsigned*)(lds + (bufoff) + ldsw + _i * 8192), 16, 0, 0); } while (0)
#define PG8_LDA(dst, b, h) do { _Pragma("unroll") for (int m = 0; m < 4; ++m) _Pragma("unroll") for (int k = 0; k < 2; ++k) dst[m][k] = *(const LAS bf16x8*)(lds + PG8_SA(b, h) + aoff + m * 2048 + k * 1024); } while (0)
#define PG8_LDB(dst, b, h) do { _Pragma("unroll") for (int n = 0; n < 2; ++n) _Pragma("unroll") for (int k = 0; k < 2; ++k) dst[n][k] = *(const LAS bf16x8*)(lds + PG8_SB(b, h) + boff + n * 2048 + k * 1024); } while (0)
#define PG8_MMA(ai, bj, At, Bt) do { __builtin_amdgcn_s_setprio(1); _Pragma("unroll") for (int m = 0; m < 4; ++m) _Pragma("unroll") for (int n = 0; n < 2; ++n) _Pragma("unroll") for (int k = 0; k < 2; ++k) \
        acc[ai][bj][m][n] = __builtin_amdgcn_mfma_f32_16x16x32_bf16(Bt[n][k], At[m][k], acc[ai][bj][m][n], 0, 0, 0); __builtin_amdgcn_s_setprio(0); } while (0)
#define PG8_WAIT_V(n) asm volatile("s_waitcnt vmcnt(" #n ")" ::: "memory")
#define PG8_WAIT_L(n) asm volatile("s_waitcnt lgkmcnt(" #n ")" ::: "memory")
#define PG8_BAR __builtin_amdgcn_s_barrier()
#define PG8_SCHED __builtin_amdgcn_sched_barrier(0)
    Unit cur, nxt; int ui = 0;
    if (!S.next(0, cur)) return;
    f32x4 acc[2][2][4][2];
#pragma unroll
    for (int a = 0; a < 2; ++a)
#pragma unroll
        for (int b = 0; b < 2; ++b)
#pragma unroll
            for (int m = 0; m < 4; ++m)
#pragma unroll
                for (int n = 0; n < 2; ++n) acc[a][b][m][n] = (f32x4){0.f, 0.f, 0.f, 0.f};
    bf16x8 At[4][2], B0[2][2], B1[2][2];
    const char* cA = (const char*)g.A + (size_t)cur.pm * tstepA; const char* cB = (const char*)g.Bt + (size_t)cur.pn * tstep;
    PG8_STAGE(PG8_SB(0, 0), cB, voffB); PG8_STAGE(PG8_SA(0, 0), cA, voffA); PG8_STAGE(PG8_SB(0, 1), cB + hstep, voffB); PG8_STAGE(PG8_SA(0, 1), cA + hstepA, voffA);
    if (wr == 1) PG8_BAR;
    PG8_WAIT_V(4); PG8_BAR;
    PG8_STAGE(PG8_SB(1, 0), cB + kstep, voffB); PG8_STAGE(PG8_SA(1, 0), cA + kstep, voffA); PG8_STAGE(PG8_SB(1, 1), cB + hstep + kstep, voffB);
    PG8_WAIT_V(6); PG8_BAR;
    for (;;) {
        const bool has_next = S.next(ui + 1, nxt);
        const char* nA = has_next ? (const char*)g.A + (size_t)nxt.pm * tstepA : cA; const char* nB = has_next ? (const char*)g.Bt + (size_t)nxt.pn * tstep : cB;
        for (int t = 0; t < nt; t += 2) {
            const bool last = (t == nt - 2);
            const char* a1 = cA + (size_t)(t + 1) * kstep + ((t + 1) >= ks ? a2off : 0);
            const char* a2 = last ? nA : cA + (size_t)(t + 2) * kstep + ((t + 2) >= ks ? a2off : 0); const char* b2 = last ? nB : cB + (size_t)(t + 2) * kstep;
            const char* a3 = last ? nA + kstep : cA + (size_t)(t + 3) * kstep + ((t + 3) >= ks ? a2off : 0); const char* b3 = b2 + kstep;
            PG8_LDB(B0, 0, 0); PG8_SCHED; PG8_LDA(At, 0, 0); PG8_STAGE(PG8_SA(1, 1), a1 + hstepA, voffA);
            PG8_WAIT_L(8); PG8_BAR; PG8_WAIT_L(0); PG8_MMA(0, 0, At, B0); PG8_BAR; PG8_SCHED;
            PG8_LDB(B1, 0, 1); PG8_STAGE(PG8_SB(0, 0), b2, voffB);
            PG8_BAR; PG8_WAIT_L(0); PG8_MMA(0, 1, At, B1); PG8_BAR;
            PG8_LDA(At, 0, 1); PG8_STAGE(PG8_SA(0, 0), a2, voffA);
            PG8_BAR; PG8_WAIT_L(0); PG8_MMA(1, 0, At, B0); PG8_BAR; PG8_SCHED;
            PG8_STAGE(PG8_SB(0, 1), b2 + hstep, voffB);
            PG8_WAIT_V(6); PG8_BAR; PG8_MMA(1, 1, At, B1); PG8_BAR;
            PG8_LDB(B0, 1, 0); PG8_SCHED; PG8_LDA(At, 1, 0); PG8_STAGE(PG8_SA(0, 1), a2 + hstepA, voffA);
            PG8_WAIT_L(8); PG8_BAR; PG8_WAIT_L(0); PG8_MMA(0, 0, At, B0); PG8_BAR; PG8_SCHED;
            PG8_LDB(B1, 1, 1); PG8_STAGE(PG8_SB(1, 0), b3, voffB);
            PG8_BAR; PG8_WAIT_L(0); PG8_MMA(0, 1, At, B1); PG8_BAR;
            PG8_LDA(At, 1, 1); PG8_STAGE(PG8_SA(1, 0), a3, voffA);
            PG8_BAR; PG8_WAIT_L(0); PG8_MMA(1, 0, At, B0); PG8_BAR; PG8_SCHED;
            PG8_STAGE(PG8_SB(1, 1), b3 + hstep, voffB);
            PG8_WAIT_V(6); PG8_BAR; PG8_MMA(1, 1, At, B1); PG8_BAR;
        }
        E(acc, cur, wr, wc, fr, fq);
        if (!has_next) break;
#pragma unroll
        for (int a = 0; a < 2; ++a)
#pragma unroll
            for (int b = 0; b < 2; ++b)
#pragma unroll
                for (int m = 0; m < 4; ++m)
#pragma unroll
                    for (int n = 0; n < 2; ++n) acc[a][b][m][n] = (f32x4){0.f, 0.f, 0.f, 0.f};
        cur = nxt; cA = nA; cB = nB; ++ui;
    }
    PG8_WAIT_V(0);
    if (wr == 0) PG8_BAR;
    PG8_BAR;
#undef PG8_SA
#undef PG8_SB
#undef PG8_STAGE
#undef PG8_LDA
#undef PG8_LDB
#undef PG8_MMA
#undef PG8_WAIT_V
#undef PG8_WAIT_L
#undef PG8_BAR
#undef PG8_SCHED
}
}
using pg8::Unit;

struct Epi1 {
    static constexpr bool PERM = true;
    bf16_t* QKV; bf16_t* SZA; bf16_t* UU; bf16_t* SZB; float* BA; bf16_t* HALO;
    __device__ __forceinline__ void operator()(const f32x4 (&acc)[2][2][4][2], const Unit& u, int wr, int wc, int fr_, int fq_) const {
        int lane = (int)(threadIdx.x & 63); asm volatile("" : "+v"(lane));
        const int fr = lane & 15, fq = lane >> 4; (void)fr_; (void)fq_;
        const int row0 = u.pm * 256 + wr * 64 + fr, pn = u.pn;
#pragma unroll
        for (int ai = 0; ai < 2; ++ai)
#pragma unroll
            for (int m = 0; m < 4; ++m) {
                const size_t row = (size_t)(row0 + ai * 128 + m * 16);
#pragma unroll
                for (int bj = 0; bj < 2; ++bj) {
                    const int colt = 128 * bj + 32 * wc + 8 * fq;
                    f32x4 v0 = acc[ai][bj][m][0], v1 = acc[ai][bj][m][1];
                    if (pn < 12) {
                        const int c = pn * 256 + colt; const u32x4 pk = pack8(v0, v1);
                        *(u32x4*)(QKV + row * 3072 + c) = pk;
                        if (m == 3 && fr >= 13) *(u32x4*)(HALO + ((row >> 6) * 3 + (fr - 13)) * 3072 + c) = pk;
                    } else if (pn < 16) {
#pragma unroll
                        for (int e = 0; e < 4; ++e) { v0[e] = siluf_(v0[e]); v1[e] = siluf_(v1[e]); }
                        *(u32x4*)(SZA + row * 1024 + (pn - 12) * 256 + colt) = pack8(v0, v1);
                    } else if (pn < 20) {
                        *(u32x4*)(UU + row * 1024 + (pn - 16) * 256 + colt) = pack8(v0, v1);
                    } else if (pn < 24) {
#pragma unroll
                        for (int e = 0; e < 4; ++e) { v0[e] = siluf_(v0[e]); v1[e] = siluf_(v1[e]); }
                        *(u32x4*)(SZB + row * 1024 + (pn - 20) * 256 + colt) = pack8(v0, v1);
                    } else if (colt < 16) {
                        *(f32x4*)(BA + row * 16 + colt) = v0; *(f32x4*)(BA + row * 16 + colt + 4) = v1;
                    }
                }
            }
    }
};
struct EpiGlu {
    static constexpr bool PERM = true;
    const bf16_t* Y5; bf16_t* SZB;
    __device__ __forceinline__ void operator()(const f32x4 (&acc)[2][2][4][2], const Unit& u, int wr, int wc, int fr, int fq) const {
        const int row0 = u.pm * 256 + wr * 64 + fr;
#pragma unroll
        for (int ai = 0; ai < 2; ++ai)
#pragma unroll
            for (int m = 0; m < 4; ++m) {
                const size_t row = (size_t)(row0 + ai * 128 + m * 16);
#pragma unroll
                for (int bj = 0; bj < 2; ++bj) {
                    const int c = u.pn * 256 + 128 * bj + 32 * wc + 8 * fq;
                    const u32x4 y = *(const u32x4*)(Y5 + row * 1024 + c), z = *(const u32x4*)(SZB + row * 1024 + c);
                    const f32x4 a0 = acc[ai][bj][m][0], a1 = acc[ai][bj][m][1];
                    u32x4 o;
                    o.x = pk2(lo2f(y.x) * sigmoidf_(a0[0]) * lo2f(z.x), hi2f(y.x) * sigmoidf_(a0[1]) * hi2f(z.x));
                    o.y = pk2(lo2f(y.y) * sigmoidf_(a0[2]) * lo2f(z.y), hi2f(y.y) * sigmoidf_(a0[3]) * hi2f(z.y));
                    o.z = pk2(lo2f(y.z) * sigmoidf_(a1[0]) * lo2f(z.z), hi2f(y.z) * sigmoidf_(a1[1]) * hi2f(z.z));
                    o.w = pk2(lo2f(y.w) * sigmoidf_(a1[2]) * lo2f(z.w), hi2f(y.w) * sigmoidf_(a1[3]) * hi2f(z.w));
                    *(u32x4*)(SZB + row * 1024 + c) = o;
                }
            }
    }
};
struct EpiF32 {
    static constexpr bool PERM = false;
    float* C;
    __device__ __forceinline__ void operator()(const f32x4 (&acc)[2][2][4][2], const Unit& u, int wr, int wc, int fr, int fq) const {
        const int row0 = u.pm * 256 + wr * 64 + fr, col0 = u.pn * 256 + wc * 32 + 4 * fq;
#pragma unroll
        for (int ai = 0; ai < 2; ++ai)
#pragma unroll
            for (int m = 0; m < 4; ++m) { float* rowp = C + (size_t)(row0 + ai * 128 + m * 16) * 1024 + col0;
#pragma unroll
                for (int bj = 0; bj < 2; ++bj)
#pragma unroll
                    for (int n = 0; n < 2; ++n) *(f32x4*)(rowp + bj * 128 + n * 16) = acc[ai][bj][m][n]; }
    }
};
struct Epi2 {
    static constexpr bool PERM = false;
    bf16_t* P; bf16_t* Q;
    __device__ __forceinline__ void operator()(const f32x4 (&acc)[2][2][4][2], const Unit& u, int wr, int wc, int fr, int fq) const {
        const int row0 = u.pm * 256 + wr * 64 + fr, ch = u.pn * 64 + 16 * wc + 4 * fq;
#pragma unroll
        for (int ai = 0; ai < 2; ++ai)
#pragma unroll
            for (int m = 0; m < 4; ++m) {
                const size_t row = (size_t)(row0 + ai * 128 + m * 16);
                const f32x4 gb = acc[ai][0][m][0], gc = acc[ai][0][m][1], hv = acc[ai][1][m][0], z = acc[ai][1][m][1];
                u32x2 pp, qq;
                pp.x = pk2(gc[0] * hv[0], gc[1] * hv[1]); pp.y = pk2(gc[2] * hv[2], gc[3] * hv[3]);
                qq.x = pk2(gb[0] * siluf_(z[0]), gb[1] * siluf_(z[1])); qq.y = pk2(gb[2] * siluf_(z[2]), gb[3] * siluf_(z[3]));
                *(u32x2*)(P + row * 2048 + ch) = pp; *(u32x2*)(Q + row * 2048 + ch) = qq;
            }
    }
};

__device__ __forceinline__ int src_col(int mode, int n, int& pn_unused) {
    (void)pn_unused;
    if (mode == 0) return n;
    if (mode == 1) { if (n < 4096) return n; if (n < 6144) return n + 16; if (n < 6160) return n - 2048; return -1; }
    const int pn = n >> 8, col = n & 255, bj = col >> 7, wc = (col >> 5) & 3, nn = (col >> 4) & 1, lo = col & 15;
    return (2 * bj + nn) * 2048 + pn * 64 + 16 * wc + lo;
}
__device__ __forceinline__ void phase_convert(const Prm& p, unsigned char* lds, int t_begin, int t_end, int nblk, int bidx) {
    float* tile = (float*)lds;
    const int tid = threadIdx.x;
    for (int tix = t_begin + bidx; tix < t_end; tix += nblk) {
        int tl = tix, K, Nsrc, mode; const float* W; bf16_t* Wt;
        if (tl < 1600) { W = p.in[3]; Wt = (bf16_t*)(p.ws + OFF_WT1); K = 1024; Nsrc = 6160; mode = 1; }
        else if ((tl -= 1600) < 256) { W = p.in[16]; Wt = (bf16_t*)(p.ws + OFF_WTG); K = 1024; Nsrc = 1024; mode = 0; }
        else if ((tl -= 256) < 512) { W = p.in[17]; Wt = (bf16_t*)(p.ws + OFF_WTO0); K = 2048; Nsrc = 1024; mode = 0; }
        else if ((tl -= 512) < 2048) { W = p.in[18]; Wt = (bf16_t*)(p.ws + OFF_WT2); K = 1024; Nsrc = 8192; mode = 2; }
        else { tl -= 2048; W = p.in[20]; Wt = (bf16_t*)(p.ws + OFF_WTO1); K = 2048; Nsrc = 1024; mode = 0; }
        const int ntk = K / 64, n0 = (tl / ntk) * 64, k0 = (tl % ntk) * 64;
        { const int j = tid & 63; int dummy = 0; const int sc = src_col(mode, n0 + j, dummy);
#pragma unroll
          for (int i = 0; i < 8; ++i) { const int k = (tid >> 6) + 8 * i; tile[k * 65 + j] = sc >= 0 ? W[(size_t)(k0 + k) * Nsrc + sc] : 0.0f; } }
        __syncthreads();
        { const int r = tid >> 3, c8 = (tid & 7) * 8; u32x4 o;
          o.x = pk2(tile[(c8 + 0) * 65 + r], tile[(c8 + 1) * 65 + r]); o.y = pk2(tile[(c8 + 2) * 65 + r], tile[(c8 + 3) * 65 + r]);
          o.z = pk2(tile[(c8 + 4) * 65 + r], tile[(c8 + 5) * 65 + r]); o.w = pk2(tile[(c8 + 6) * 65 + r], tile[(c8 + 7) * 65 + r]);
          *(u32x4*)(Wt + (size_t)(n0 + r) * K + k0 + c8) = o; }
        __syncthreads();
    }
}
__device__ __forceinline__ void phase_rmsnorm_x(const float* x, const float* w, bf16_t* H) {
    const int lane = threadIdx.x & 63, nw = gridDim.x * 8;
    for (int row = blockIdx.x * 8 + (threadIdx.x >> 6); row < TOK; row += nw) {
        const f32x4* xr = (const f32x4*)(x + (size_t)row * 1024);
        f32x4 v[4]; float ss = 0.f;
#pragma unroll
        for (int i = 0; i < 4; ++i) { v[i] = xr[lane + 64 * i]; ss += v[i][0] * v[i][0] + v[i][1] * v[i][1] + v[i][2] * v[i][2] + v[i][3] * v[i][3]; }
        ss = wave_sum(ss);
        const float rstd = rsqrtf(ss * (1.0f / 1024.0f) + 1e-6f);
#pragma unroll
        for (int i = 0; i < 4; ++i) { const f32x4 w4 = ((const f32x4*)w)[lane + 64 * i]; u32x2 o;
            o.x = pk2(v[i][0] * rstd * w4[0], v[i][1] * rstd * w4[1]); o.y = pk2(v[i][2] * rstd * w4[2], v[i][3] * rstd * w4[3]);
            *(u32x2*)(H + (size_t)row * 1024 + (lane + 64 * i) * 4) = o; }
    }
}
template <bool NEXT>
__device__ __forceinline__ void phase_post(const float* base, const float* Y, const float* wpost, float* OUT, const float* wpre, bf16_t* H) {
    const int lane = threadIdx.x & 63, nw = gridDim.x * 8;
    for (int row = blockIdx.x * 8 + (threadIdx.x >> 6); row < TOK; row += nw) {
        const f32x4* yr = (const f32x4*)(Y + (size_t)row * 1024); const f32x4* br = (const f32x4*)(base + (size_t)row * 1024);
        f32x4 v[4], xb[4]; float ss = 0.f;
#pragma unroll
        for (int i = 0; i < 4; ++i) { v[i] = yr[lane + 64 * i]; xb[i] = br[lane + 64 * i]; ss += v[i][0] * v[i][0] + v[i][1] * v[i][1] + v[i][2] * v[i][2] + v[i][3] * v[i][3]; }
        ss = wave_sum(ss);
        const float rstd = rsqrtf(ss * (1.0f / 1024.0f) + 1e-6f);
        float s2 = 0.f;
#pragma unroll
        for (int i = 0; i < 4; ++i) { const f32x4 w4 = ((const f32x4*)wpost)[lane + 64 * i];
#pragma unroll
            for (int e = 0; e < 4; ++e) { v[i][e] = xb[i][e] + v[i][e] * rstd * w4[e]; s2 += v[i][e] * v[i][e]; }
            ((f32x4*)(OUT + (size_t)row * 1024))[lane + 64 * i] = v[i]; }
        if (NEXT) {
            s2 = wave_sum(s2);
            const float r2 = rsqrtf(s2 * (1.0f / 1024.0f) + 1e-6f);
#pragma unroll
            for (int i = 0; i < 4; ++i) { const f32x4 w4 = ((const f32x4*)wpre)[lane + 64 * i]; u32x2 o;
                o.x = pk2(v[i][0] * r2 * w4[0], v[i][1] * r2 * w4[1]); o.y = pk2(v[i][2] * r2 * w4[2], v[i][3] * r2 * w4[3]);
                *(u32x2*)(H + (size_t)row * 1024 + (lane + 64 * i) * 4) = o; }
        }
    }
}


__device__ __forceinline__ void sincos_d(double x, double& s, double& c) {
    const double k = rint(x * 0.6366197723675814);
    const double r = fma(-k, 6.123233995736766e-17, fma(-k, 1.5707963267948966, x)), r2 = r * r;
    double sp = -7.647163731819816e-13; sp = fma(sp, r2, 1.6059043836821613e-10); sp = fma(sp, r2, -2.505210838544172e-8); sp = fma(sp, r2, 2.7557319223985893e-6);
    sp = fma(sp, r2, -1.984126984126984e-4); sp = fma(sp, r2, 8.333333333333333e-3); sp = fma(sp, r2, -1.6666666666666666e-1); sp = fma(sp * r2, r, r);
    double cp = 4.779477332387385e-14; cp = fma(cp, r2, -1.1470745597729725e-11); cp = fma(cp, r2, 2.08767569878681e-9); cp = fma(cp, r2, -2.755731922398589e-7);
    cp = fma(cp, r2, 2.48015873015873e-5); cp = fma(cp, r2, -1.388888888888889e-3); cp = fma(cp, r2, 4.1666666666666664e-2); cp = fma(cp, r2, -0.5); cp = fma(cp, r2, 1.0);
    const int q = ((int)k) & 3;
    const double s0 = (q & 1) ? cp : sp, c0 = (q & 1) ? sp : cp;
    s = (q & 2) ? -s0 : s0; c = ((q + 1) & 2) ? -c0 : c0;
}
__device__ __forceinline__ double exp_d(double x) {
    const double n = rint(x * 1.4426950408889634);
    const double r = fma(-n, 2.3190468138462996e-17, fma(-n, 0.6931471805599453, x));
    double p = 1.6059043836821613e-10; p = fma(p, r, 2.08767569878681e-9); p = fma(p, r, 2.505210838544172e-8); p = fma(p, r, 2.755731922398589e-7); p = fma(p, r, 2.7557319223985893e-6);
    p = fma(p, r, 2.48015873015873e-5); p = fma(p, r, 1.984126984126984e-4); p = fma(p, r, 1.388888888888889e-3); p = fma(p, r, 8.333333333333333e-3); p = fma(p, r, 4.1666666666666664e-2);
    p = fma(p, r, 1.6666666666666666e-1); p = fma(p, r, 0.5); p = fma(p, r, 1.0); p = fma(p, r, 1.0);
    return ldexp(p, (int)n);
}
__device__ __forceinline__ float bcast_lo(float v) { auto r = __builtin_amdgcn_permlane32_swap(__float_as_uint(v), __float_as_uint(v), false, false); return __uint_as_float(r[0]); }
__device__ __forceinline__ float bcast_hi(float v) { auto r = __builtin_amdgcn_permlane32_swap(__float_as_uint(v), __float_as_uint(v), false, false); return __uint_as_float(r[1]); }

struct S5C {
    float ar[2][4], ai[2][4];
    float a512r[2], a512i[2];
    bf16x8 BB[4];
    bf16x8 CC[4];
    float dco;
};

template <bool OUT>
__device__ __forceinline__ void s5_chunk(const S5C& C, bf16_t* UU, int b, int g, int chunk, float (&st)[2][2], bf16_t* sX, int lane) {
    const int n = lane & 31, hh = lane >> 5, fr = lane & 15, fq = lane >> 4;
    const size_t tok0 = (size_t)b * SEQ + (size_t)chunk * 512;
    bf16x8 ua = *(const bf16x8*)(UU + (tok0 + n) * 1024 + 16 * g + 8 * hh);
    bf16_t uo[8];
    if (OUT) {
#pragma unroll
        for (int mt = 0; mt < 2; ++mt)
#pragma unroll
            for (int j = 0; j < 4; ++j) uo[mt * 4 + j] = UU[(tok0 + 16 * mt + 4 * fq + j) * 1024 + 16 * g + fr];
    }
    for (int blk = 0; blk < 16; ++blk) {
        const size_t t0 = tok0 + (size_t)blk * 32;
        const bf16x8 ucur = ua;
        bf16_t ucuro[8];
        if (OUT) {
#pragma unroll
            for (int i = 0; i < 8; ++i) ucuro[i] = uo[i];
        }
        if (blk < 15) {
            ua = *(const bf16x8*)(UU + (t0 + 32 + n) * 1024 + 16 * g + 8 * hh);
            if (OUT) {
#pragma unroll
                for (int mt = 0; mt < 2; ++mt)
#pragma unroll
                    for (int j = 0; j < 4; ++j) uo[mt * 4 + j] = UU[(t0 + 32 + 16 * mt + 4 * fq + j) * 1024 + 16 * g + fr];
            }
        }
        f32x16 acc[4];
#pragma unroll
        for (int tl = 0; tl < 4; ++tl) {
            f32x16 z;
#pragma unroll
            for (int i = 0; i < 16; ++i) z[i] = 0.f;
            acc[tl] = __builtin_amdgcn_mfma_f32_32x32x16_bf16(ucur, C.BB[tl], z, 0, 0, 0);
        }
#pragma unroll
        for (int tp = 0; tp < 2; ++tp) {
            f32x16& re = acc[2 * tp]; f32x16& im = acc[2 * tp + 1];
            const float a1r = C.ar[tp][0], a1i = C.ai[tp][0];
#pragma unroll
            for (int q = 0; q < 4; ++q)
#pragma unroll
                for (int r = 1; r < 4; ++r) {
                    const float pr = re[4 * q + r - 1], pi = im[4 * q + r - 1];
                    re[4 * q + r] += a1r * pr - a1i * pi; im[4 * q + r] += a1r * pi + a1i * pr;
                }
            float cr = st[tp][0], ci = st[tp][1];
            const float a4r = C.ar[tp][3], a4i = C.ai[tp][3];
#pragma unroll
            for (int q = 0; q < 4; ++q) {
                const float tr = re[4 * q + 3] + a4r * cr - a4i * ci, ti = im[4 * q + 3] + a4r * ci + a4i * cr;
                const float o0r = bcast_lo(tr), o0i = bcast_lo(ti);
                const float xr = hh ? o0r : cr, xi = hh ? o0i : ci;
                if (OUT) {
#pragma unroll
                    for (int r = 0; r < 4; ++r) { const float kr = C.ar[tp][r], ki = C.ai[tp][r];
                        re[4 * q + r] += kr * xr - ki * xi; im[4 * q + r] += kr * xi + ki * xr; }
                } else {
                    re[4 * q + 3] += a4r * xr - a4i * xi; im[4 * q + 3] += a4r * xi + a4i * xr;
                }
                cr = bcast_hi(re[4 * q + 3]); ci = bcast_hi(im[4 * q + 3]);
            }
            st[tp][0] = cr; st[tp][1] = ci;
        }
        if (OUT) {
            asm volatile("s_waitcnt lgkmcnt(0)" ::: "memory");
#pragma unroll
            for (int tp = 0; tp < 2; ++tp)
#pragma unroll
                for (int i = 0; i < 16; ++i) {
                    const int t = 8 * (i >> 2) + 4 * hh + (i & 3);
                    *(unsigned*)(sX + t * 136 + 2 * (n + 32 * tp)) = pk2(acc[2 * tp][i], acc[2 * tp + 1][i]);
                }
            asm volatile("s_waitcnt lgkmcnt(0)" ::: "memory");
            __builtin_amdgcn_wave_barrier();
#pragma unroll
            for (int mt = 0; mt < 2; ++mt) {
                f32x4 y = (f32x4){0.f, 0.f, 0.f, 0.f};
#pragma unroll
                for (int ks = 0; ks < 4; ++ks) {
                    const bf16x8 xa = *(const bf16x8*)(sX + (16 * mt + fr) * 136 + 32 * ks + 8 * fq);
                    y = __builtin_amdgcn_mfma_f32_16x16x32_bf16(xa, C.CC[ks], y, 0, 0, 0);
                }
#pragma unroll
                for (int j = 0; j < 4; ++j) {
                    float v = y[j] + C.dco * bf2f(ucuro[mt * 4 + j]);
                    const float inner = 0.7978845608028654f * (v + 0.044715f * v * v * v);
                    v = v / (1.0f + __expf(-2.0f * inner));
                    UU[(t0 + 16 * mt + 4 * fq + j) * 1024 + 16 * g + fr] = f2bf(v);
                }
            }
            asm volatile("s_waitcnt lgkmcnt(0)" ::: "memory");
            __builtin_amdgcn_wave_barrier();
        }
    }
}

__device__ __forceinline__ void phase_s5(const Prm& p, unsigned char* lds, int bg) {
    const int b = bg >> 6, g = bg & 63;
    const int tid = threadIdx.x, wv = tid >> 6, lane = tid & 63, n = lane & 31, hh = lane >> 5, fr = lane & 15, fq = lane >> 4;
    bf16_t* sX = (bf16_t*)(lds + wv * 8704);
    float* sXE = (float*)(lds + 8 * 8704);
    bf16_t* UU = (bf16_t*)(p.ws + OFF_UU);
    const float* lam_re = p.in[8]; const float* lam_im = p.in[9]; const float* b_re = p.in[10]; const float* b_im = p.in[11];
    const float* c_re = p.in[12]; const float* c_im = p.in[13];
    S5C C;
    const double dt = exp_d((double)p.in[14][g]);
    float fre[2], fim[2];
#pragma unroll
    for (int tp = 0; tp < 2; ++tp) {
        const int pp = n + 32 * tp;
        const double lr = (double)fminf(lam_re[g * 64 + pp], -1e-4f), li = (double)lam_im[g * 64 + pp];
#pragma unroll
        for (int k = 0; k < 4; ++k) { double sn, cs; sincos_d(li * dt * (k + 1), sn, cs); const double mag = exp_d(lr * dt * (k + 1)); C.ar[tp][k] = (float)(mag * cs); C.ai[tp][k] = (float)(mag * sn); }
        { double sn, cs; sincos_d(li * dt * 512.0, sn, cs); const double mag = exp_d(lr * dt * 512.0); C.a512r[tp] = (float)(mag * cs); C.a512i[tp] = (float)(mag * sn); }
        double sn, cs; sincos_d(li * dt, sn, cs);
        const double mag = exp_d(lr * dt), abr = mag * cs, abi = mag * sn;
        const double den = lr * lr + li * li, nr = abr - 1.0, ni = abi;
        fre[tp] = (float)((nr * lr + ni * li) / den); fim[tp] = (float)((ni * lr - nr * li) / den);
    }
#pragma unroll
    for (int tl = 0; tl < 4; ++tl) {
        const int tp = tl >> 1, ri = tl & 1, pp = n + 32 * tp;
#pragma unroll
        for (int j = 0; j < 8; ++j) {
            const int ch = 8 * hh + j;
            const float br = b_re[(g * 64 + pp) * 16 + ch], bi = b_im[(g * 64 + pp) * 16 + ch];
            const float v = ri == 0 ? fre[tp] * br - fim[tp] * bi : fre[tp] * bi + fim[tp] * br;
            C.BB[tl][j] = (short)f2bf(v);
        }
    }
#pragma unroll
    for (int ks = 0; ks < 4; ++ks)
#pragma unroll
        for (int j = 0; j < 8; ++j) {
            const int k = 32 * ks + 8 * fq + j, pp = k >> 1, ri = k & 1;
            const float v = ri == 0 ? c_re[(g * 16 + fr) * 64 + pp] : -c_im[(g * 16 + fr) * 64 + pp];
            C.CC[ks][j] = (short)f2bf(v);
        }
    C.dco = p.in[15][16 * g + fr];
    for (int rd = 0; rd < 2; ++rd) {
        const int chunk = wv + 8 * rd;
        float st[2][2] = {{0.f, 0.f}, {0.f, 0.f}};
        s5_chunk<false>(C, UU, b, g, chunk, st, sX, lane);
        if (hh == 0) {
#pragma unroll
            for (int tp = 0; tp < 2; ++tp) { sXE[(chunk * 64 + n + 32 * tp) * 2 + 0] = st[tp][0]; sXE[(chunk * 64 + n + 32 * tp) * 2 + 1] = st[tp][1]; }
        }
    }
    __syncthreads();
    for (int rd = 0; rd < 2; ++rd) {
        const int chunk = wv + 8 * rd;
        float st[2][2] = {{0.f, 0.f}, {0.f, 0.f}};
        for (int c2 = 0; c2 < chunk; ++c2) {
#pragma unroll
            for (int tp = 0; tp < 2; ++tp) {
                const float er = sXE[(c2 * 64 + n + 32 * tp) * 2 + 0], ei = sXE[(c2 * 64 + n + 32 * tp) * 2 + 1];
                const float nr = C.a512r[tp] * st[tp][0] - C.a512i[tp] * st[tp][1] + er, ni = C.a512r[tp] * st[tp][1] + C.a512i[tp] * st[tp][0] + ei;
                st[tp][0] = nr; st[tp][1] = ni;
            }
        }
        s5_chunk<true>(C, UU, b, g, chunk, st, sX, lane);
    }
    __syncthreads();
}

__device__ __forceinline__ void phase_gdn_prep(const Prm& p, unsigned char* lds, int it0, int nrounds) {
    const int tid0 = threadIdx.x, hb = tid0 >> 8;
    unsigned char* base = lds + hb * 76800;
    bf16_t* sQ = (bf16_t*)base;
    bf16_t* sK = (bf16_t*)(base + 17408);
    bf16_t* sV = (bf16_t*)(base + 2 * 17408);
    float* sL = (float*)(base + 3 * 17408);
    float* sBeta = (float*)(base + 4 * 17408);
    float* sGc = sBeta + 64; float* sEg = sGc + 64; float* sBE = sEg + 64;
    float* sCW = sBE + 64;
    bf16_t* QKV = (bf16_t*)(p.ws + OFF_QKV); const bf16_t* HALO = (const bf16_t*)(p.ws + OFF_HALO);
    const float* BA = (const float*)(p.ws + OFF_BA); float* GL = (float*)(p.ws + OFF_GL);
    bf16_t* WB = (bf16_t*)(p.ws + OFF_WB); bf16_t* ATT = (bf16_t*)(p.ws + OFF_ATT);
    const float* convw = p.in[4];
    for (int rd = 0; rd < nrounds; ++rd) {
        int tid = tid0; asm volatile("" : "+v"(tid));
        const int ht = tid & 255, hw = (tid >> 6) & 3, lane = tid & 63, fr = lane & 15, fq = lane >> 4;
        const int it = it0 + rd * 2 + hb;
        const int b = it >> 10, h = (it >> 7) & 7, nc = it & 127;
        const size_t tokb = (size_t)b * SEQ + (size_t)nc * 64;
#pragma unroll
        for (int i = 0; i < 6; ++i) { const int idx = ht + 256 * i, s3 = idx >> 9, tap = (idx >> 7) & 3, ch = idx & 127; sCW[idx] = convw[tap * 3072 + s3 * 1024 + h * 128 + ch]; }
        __syncthreads();
        {
            const int t = ht >> 2, cg4 = ht & 3;
#pragma unroll 1
            for (int s = 0; s < 3; ++s) {
                const int col = s * 1024 + h * 128 + cg4 * 32;
                float o[32]; float ss = 0.f;
#pragma unroll
                for (int c8 = 0; c8 < 4; ++c8) {
                    float a[8];
#pragma unroll
                    for (int e = 0; e < 8; ++e) a[e] = 0.f;
#pragma unroll
                    for (int d = 0; d < 4; ++d) {
                        const int tt = t - d;
                        u32x4 xv = (u32x4){0u, 0u, 0u, 0u};
                        if (tt >= 0) xv = *(const u32x4*)(QKV + (tokb + tt) * 3072 + col + c8 * 8);
                        else if (nc > 0) xv = *(const u32x4*)(HALO + ((size_t)(b * 128 + nc - 1) * 3 + (3 + tt)) * 3072 + col + c8 * 8);
                        const f32x4 w0 = *(const f32x4*)(sCW + s * 512 + (3 - d) * 128 + cg4 * 32 + c8 * 8), w1 = *(const f32x4*)(sCW + s * 512 + (3 - d) * 128 + cg4 * 32 + c8 * 8 + 4);
                        a[0] += w0[0] * lo2f(xv.x); a[1] += w0[1] * hi2f(xv.x); a[2] += w0[2] * lo2f(xv.y); a[3] += w0[3] * hi2f(xv.y);
                        a[4] += w1[0] * lo2f(xv.z); a[5] += w1[1] * hi2f(xv.z); a[6] += w1[2] * lo2f(xv.w); a[7] += w1[3] * hi2f(xv.w);
                    }
#pragma unroll
                    for (int e = 0; e < 8; ++e) { const float v = siluf_(a[e]); o[c8 * 8 + e] = v; ss += v * v; }
                }
                float sc = 1.0f;
                if (s < 2) { ss += __shfl_xor(ss, 1); ss += __shfl_xor(ss, 2); sc = rsqrtf(ss + 1e-6f) * (s == 0 ? 0.08838834764831845f : 1.0f); }
                bf16_t* dst = (s == 0 ? sQ : (s == 1 ? sK : sV)) + t * 136 + cg4 * 32;
#pragma unroll
                for (int c8 = 0; c8 < 4; ++c8) { u32x4 pk;
                    pk.x = pk2(o[c8 * 8 + 0] * sc, o[c8 * 8 + 1] * sc); pk.y = pk2(o[c8 * 8 + 2] * sc, o[c8 * 8 + 3] * sc);
                    pk.z = pk2(o[c8 * 8 + 4] * sc, o[c8 * 8 + 5] * sc); pk.w = pk2(o[c8 * 8 + 6] * sc, o[c8 * 8 + 7] * sc);
                    *(u32x4*)(dst + c8 * 8) = pk; }
            }
        }
        if (hw == 0) {
            const size_t tg = tokb + lane;
            const float braw = BA[tg * 16 + h], araw = BA[tg * 16 + 8 + h];
            const float beta = 1.0f / (1.0f + expf(-braw));
            const float xx = araw + p.in[6][h];
            const float sp = xx > 20.f ? xx : log1pf(expf(xx));
            float gg = -expf(p.in[5][h]) * sp;
#pragma unroll
            for (int off = 1; off < 64; off <<= 1) { const float o = __shfl_up(gg, off); if (lane >= off) gg += o; }
            sBeta[lane] = beta; sGc[lane] = gg; sEg[lane] = expf(gg); sBE[lane] = beta * expf(gg);
            if (lane == 63) GL[it] = expf(gg);
        }
        __syncthreads();
        {
            bf16x8 aK[4], aQ[4];
#pragma unroll
            for (int ks = 0; ks < 4; ++ks) { aK[ks] = *(const bf16x8*)(sK + (16 * hw + fr) * 136 + 32 * ks + 8 * fq); aQ[ks] = *(const bf16x8*)(sQ + (16 * hw + fr) * 136 + 32 * ks + 8 * fq); }
#pragma unroll
            for (int nt = 0; nt < 4; ++nt) {
                f32x4 kk = (f32x4){0.f, 0.f, 0.f, 0.f}, qk = (f32x4){0.f, 0.f, 0.f, 0.f};
#pragma unroll
                for (int ks = 0; ks < 4; ++ks) {
                    const bf16x8 bK = *(const bf16x8*)(sK + (16 * nt + fr) * 136 + 32 * ks + 8 * fq);
                    kk = __builtin_amdgcn_mfma_f32_16x16x32_bf16(aK[ks], bK, kk, 0, 0, 0);
                    qk = __builtin_amdgcn_mfma_f32_16x16x32_bf16(aQ[ks], bK, qk, 0, 0, 0);
                }
                const int mcol = 16 * nt + fr; const float gm = sGc[mcol];
#pragma unroll
                for (int j = 0; j < 4; ++j) {
                    const int c = 16 * hw + 4 * fq + j;
                    const float dec = __expf(fminf(sGc[c] - gm, 0.f));
                    sL[c * 68 + mcol] = (mcol < c) ? kk[j] * sBeta[c] * dec : 0.f;
                    ATT[(size_t)it * 4096 + c * 64 + mcol] = f2bf((mcol <= c) ? qk[j] * dec : 0.f);
                }
            }
        }
        __syncthreads();
        {
            float x[64];
            const bool isU = ht < 128; const int jc = ht & 127;
            const bf16_t* src = isU ? sV : sK;
            const float* fac = isU ? sBeta : sBE;
#pragma unroll
            for (int cb = 0; cb < 16; ++cb) {
                float a[4];
#pragma unroll
                for (int r = 0; r < 4; ++r) a[r] = bf2f(src[(4 * cb + r) * 136 + jc]) * fac[4 * cb + r];
#pragma unroll
                for (int m4 = 0; m4 < cb; ++m4)
#pragma unroll
                    for (int r = 0; r < 4; ++r) {
                        const f32x4 l = *(const f32x4*)(sL + (4 * cb + r) * 68 + 4 * m4);
                        a[r] -= l[0] * x[4 * m4] + l[1] * x[4 * m4 + 1] + l[2] * x[4 * m4 + 2] + l[3] * x[4 * m4 + 3];
                    }
                const f32x4 d1 = *(const f32x4*)(sL + (4 * cb + 1) * 68 + 4 * cb), d2 = *(const f32x4*)(sL + (4 * cb + 2) * 68 + 4 * cb), d3 = *(const f32x4*)(sL + (4 * cb + 3) * 68 + 4 * cb);
                x[4 * cb] = a[0];
                x[4 * cb + 1] = a[1] - d1[0] * x[4 * cb];
                x[4 * cb + 2] = a[2] - d2[0] * x[4 * cb] - d2[1] * x[4 * cb + 1];
                x[4 * cb + 3] = a[3] - d3[0] * x[4 * cb] - d3[1] * x[4 * cb + 1] - d3[2] * x[4 * cb + 2];
            }
            if (isU) {
                const int wvv = jc >> 5, nn = jc & 31;
#pragma unroll
                for (int hh2 = 0; hh2 < 2; ++hh2)
#pragma unroll
                    for (int j = 0; j < 4; ++j) {
                        const int cb = 32 * (j >> 1) + 16 * (j & 1) + 4 * hh2;
                        u32x4 o; o.x = pk2(x[cb + 0], x[cb + 1]); o.y = pk2(x[cb + 2], x[cb + 3]); o.z = pk2(x[cb + 8], x[cb + 9]); o.w = pk2(x[cb + 10], x[cb + 11]);
                        const int L = ((wvv * 4 + j) * 64 + hh2 * 32 + nn) * 8;
                        *(u32x4*)(QKV + (tokb + (L >> 7)) * 3072 + 2048 + h * 128 + (L & 127)) = o;
                    }
            }
            __syncthreads();
            if (!isU) {
                bf16_t* sW2 = (bf16_t*)sL;
#pragma unroll
                for (int c = 0; c < 64; ++c) sW2[c * 136 + jc] = f2bf(-x[c]);
            }
        }
        __syncthreads();
        {
            const bf16_t* sW2 = (const bf16_t*)sL;
#pragma unroll
            for (int i = 0; i < 4; ++i) { const int ch = ht + 256 * i, r = ch >> 4, c8 = (ch & 15) * 8; *(u32x4*)(WB + (size_t)it * 8192 + r * 128 + c8) = *(const u32x4*)(sW2 + r * 136 + c8); }
        }
        {
            const int c = ht >> 2, ds = (ht & 3) * 32; const float eg = sEg[c];
#pragma unroll
            for (int c8 = 0; c8 < 4; ++c8) {
                const u32x4 v = *(const u32x4*)(sQ + c * 136 + ds + c8 * 8); u32x4 o;
                o.x = pk2(lo2f(v.x) * eg, hi2f(v.x) * eg); o.y = pk2(lo2f(v.y) * eg, hi2f(v.y) * eg); o.z = pk2(lo2f(v.z) * eg, hi2f(v.z) * eg); o.w = pk2(lo2f(v.w) * eg, hi2f(v.w) * eg);
                *(u32x4*)(QKV + (tokb + c) * 3072 + h * 128 + ds + c8 * 8) = o;
            }
            const int d = ht >> 1, cs = (ht & 1) * 32; const float gl = sGc[63];
#pragma unroll
            for (int c8 = 0; c8 < 4; ++c8) {
                float v[8];
#pragma unroll
                for (int e = 0; e < 8; ++e) { const int cc = cs + c8 * 8 + e; v[e] = bf2f(sK[cc * 136 + d]) * __expf(gl - sGc[cc]); }
                u32x4 o; o.x = pk2(v[0], v[1]); o.y = pk2(v[2], v[3]); o.z = pk2(v[4], v[5]); o.w = pk2(v[6], v[7]);
                *(u32x4*)(QKV + (tokb + (d >> 1)) * 3072 + 1024 + h * 128 + (d & 1) * 64 + cs + c8 * 8) = o;
            }
        }
        __syncthreads();
    }
}

__device__ __forceinline__ bf16x8 ld_perm(const unsigned char* p) { return *(const bf16x8*)p; }
__device__ __forceinline__ bf16x8 pack_acc(const f32x16& v, int s) {
    u32x4 r; r.x = pk2(v[8 * s + 0], v[8 * s + 1]); r.y = pk2(v[8 * s + 2], v[8 * s + 3]); r.z = pk2(v[8 * s + 4], v[8 * s + 5]); r.w = pk2(v[8 * s + 6], v[8 * s + 7]);
    return __builtin_bit_cast(bf16x8, r);
}
constexpr int SC_RW = 272, SC_RK = 144;
constexpr int SC_QD = 64 * SC_RW, SC_KT = 2 * 64 * SC_RW, SC_AT = SC_KT + 128 * SC_RK, SC_U = SC_AT + 64 * SC_RK, SC_STAGE = SC_U + 16384;
static_assert(2 * SC_STAGE <= LDS_BYTES && SC_U % 16 == 0 && SC_STAGE % 16 == 0, "scan LDS layout");
__device__ __forceinline__ u32x4 hswap(u32x4 v, int sw) { u32x4 r; r.x = sw ? v.z : v.x; r.y = sw ? v.w : v.y; r.z = sw ? v.x : v.z; r.w = sw ? v.y : v.w; return r; }
struct ScanRegs { u32x4 rw[4], rq[4], rk[4], ru[4], ra[2]; };
__device__ __forceinline__ void scan_load(ScanRegs& R, const bf16_t* QKV, const bf16_t* WB, const bf16_t* ATT, int b, int h, int it, int nc, int lt) {
    const size_t tokb = (size_t)b * SEQ + (size_t)nc * 64;
#pragma unroll
    for (int i = 0; i < 4; ++i) { const int ch = lt + 256 * i, r = ch >> 4, c8 = (ch & 15) * 8;
        R.rw[i] = *(const u32x4*)(WB + (size_t)it * 8192 + r * 128 + c8);
        const bf16_t* qp = QKV + (tokb + r) * 3072 + h * 128 + c8;
        R.rq[i] = *(const u32x4*)(qp); R.rk[i] = *(const u32x4*)(qp + 1024); R.ru[i] = *(const u32x4*)(qp + 2048); }
#pragma unroll
    for (int i = 0; i < 2; ++i) { const int ch = lt + 256 * i; R.ra[i] = *(const u32x4*)(ATT + (size_t)it * 4096 + ch * 8); }
}
__device__ __forceinline__ void st16p(unsigned char* rowp, int g, u32x4 v) {
    unsigned char* p = rowp + 32 * (g >> 1) + 8 * (g & 1);
    *(u32x2*)p = (u32x2){v.x, v.y}; *(u32x2*)(p + 16) = (u32x2){v.z, v.w};
}
__device__ __forceinline__ void scan_store(const ScanRegs& R, unsigned char* sbp, int lt) {
#pragma unroll
    for (int i = 0; i < 4; ++i) { const int ch = lt + 256 * i, r = ch >> 4, g = ch & 15;
        st16p(sbp + r * SC_RW, g, R.rw[i]);
        st16p(sbp + SC_QD + r * SC_RW, g, R.rq[i]);
        const int d = 2 * r + (g >> 3), gk = g & 7;
        st16p(sbp + SC_KT + d * SC_RK, gk, R.rk[i]);
        *(u32x4*)(sbp + SC_U + ch * 16) = R.ru[i]; }
#pragma unroll
    for (int i = 0; i < 2; ++i) { const int ch = lt + 256 * i, r = ch >> 3, g = ch & 7; st16p(sbp + SC_AT + r * SC_RK, g, R.ra[i]); }
}
#define SCAN_BAR() do { asm volatile("s_waitcnt lgkmcnt(0)" ::: "memory"); __builtin_amdgcn_s_barrier(); asm volatile("" ::: "memory"); } while (0)
template <int MODE>
__device__ __forceinline__ void phase_gdn_scan(const Prm& p, unsigned char* lds, int bh) {
    const int tid = threadIdx.x, wv = tid >> 6, lane = tid & 63, n = lane & 31, hh = lane >> 5;
    const int b = bh >> 3, h = bh & 7;
    const bf16_t* QKV = (const bf16_t*)(p.ws + OFF_QKV); const bf16_t* WB = (const bf16_t*)(p.ws + OFF_WB); const bf16_t* ATT = (const bf16_t*)(p.ws + OFF_ATT);
    const float* GL = (const float*)(p.ws + OFF_GL); bf16_t* O = (bf16_t*)(p.ws + (MODE == 0 ? OFF_H : OFF_WT1));
    const int itb = bh * 128;
    if (wv >= 4) {
        const int lt = tid - 256;
        ScanRegs RA, RB;
        scan_load(RA, QKV, WB, ATT, b, h, itb, 0, lt);
        scan_store(RA, lds, lt);
        __builtin_amdgcn_sched_barrier(0);
        scan_load(RA, QKV, WB, ATT, b, h, itb + 1, 1, lt);
        __builtin_amdgcn_sched_barrier(0);
        scan_load(RB, QKV, WB, ATT, b, h, itb + 2, 2, lt);
        __builtin_amdgcn_sched_barrier(0);
        SCAN_BAR();
        for (int nc = 0; nc < 128; nc += 2) {
            if (MODE == 1) { SCAN_BAR(); SCAN_BAR(); continue; }
            __builtin_amdgcn_sched_barrier(0);
            scan_store(RA, lds + SC_STAGE, lt);
            __builtin_amdgcn_sched_barrier(0);
            { const int c3 = nc + 3 < 128 ? nc + 3 : 127; scan_load(RA, QKV, WB, ATT, b, h, itb + c3, c3, lt); }
            __builtin_amdgcn_sched_barrier(0);
            SCAN_BAR();
            __builtin_amdgcn_sched_barrier(0);
            scan_store(RB, lds, lt);
            __builtin_amdgcn_sched_barrier(0);
            { const int c4 = nc + 4 < 128 ? nc + 4 : 127; scan_load(RB, QKV, WB, ATT, b, h, itb + c4, c4, lt); }
            SCAN_BAR();
        }
    } else {
        const float gl0 = GL[itb + lane], gl1 = GL[itb + 64 + lane];
        f32x16 S[4];
#pragma unroll
        for (int dt = 0; dt < 4; ++dt)
#pragma unroll
            for (int i = 0; i < 16; ++i) S[dt][i] = 0.f;
        const int e = 32 * wv + n;
        SCAN_BAR();
        for (int nc = 0; nc < 128; ++nc) {
            if (MODE == 2) { SCAN_BAR(); continue; }
            const unsigned char* sbp = lds + (nc & 1) * SC_STAGE;
            const float gl = __builtin_bit_cast(float, __builtin_amdgcn_readlane(__builtin_bit_cast(int, nc < 64 ? gl0 : gl1), nc & 63));
            const unsigned char* pw = sbp + n * SC_RW + 16 * hh;
            const unsigned char* pk = sbp + SC_KT + n * SC_RK + 16 * hh;
            f32x16 V[2], Oa[2];
#pragma unroll
            for (int j = 0; j < 4; ++j) {
                const u32x4 uu = *(const u32x4*)(sbp + SC_U + ((wv * 4 + j) * 64 + lane) * 16);
                f32x16& vv = V[j >> 1]; const int o8 = 8 * (j & 1);
                vv[o8 + 0] = lo2f(uu.x); vv[o8 + 1] = hi2f(uu.x); vv[o8 + 2] = lo2f(uu.y); vv[o8 + 3] = hi2f(uu.y);
                vv[o8 + 4] = lo2f(uu.z); vv[o8 + 5] = hi2f(uu.z); vv[o8 + 6] = lo2f(uu.w); vv[o8 + 7] = hi2f(uu.w);
            }
#pragma unroll
            for (int ct = 0; ct < 2; ++ct)
#pragma unroll
                for (int i = 0; i < 16; ++i) Oa[ct][i] = 0.f;
            bf16x8 fa[2][4];
#define LD_WQ(dst, ks_) do { dst[0] = ld_perm(pw + 32 * (ks_)); dst[1] = ld_perm(pw + 32 * SC_RW + 32 * (ks_)); \
                             dst[2] = ld_perm(pw + SC_QD + 32 * (ks_)); dst[3] = ld_perm(pw + SC_QD + 32 * SC_RW + 32 * (ks_)); } while (0)
            LD_WQ(fa[0], 0);
#pragma unroll
            for (int ks = 0; ks < 8; ++ks) {
                if (ks < 7) LD_WQ(fa[(ks + 1) & 1], ks + 1);
                const bf16x8 sb8 = pack_acc(S[ks >> 1], ks & 1);
                __builtin_amdgcn_sched_barrier(0);
                V[0] = __builtin_amdgcn_mfma_f32_32x32x16_bf16(fa[ks & 1][0], sb8, V[0], 0, 0, 0);
                Oa[0] = __builtin_amdgcn_mfma_f32_32x32x16_bf16(fa[ks & 1][2], sb8, Oa[0], 0, 0, 0);
                V[1] = __builtin_amdgcn_mfma_f32_32x32x16_bf16(fa[ks & 1][1], sb8, V[1], 0, 0, 0);
                Oa[1] = __builtin_amdgcn_mfma_f32_32x32x16_bf16(fa[ks & 1][3], sb8, Oa[1], 0, 0, 0);
                __builtin_amdgcn_sched_barrier(0);
            }
#undef LD_WQ
            bf16x8 fb[2][6];
#define LD_AK(dst, k2_) do { dst[0] = ld_perm(pk + (SC_AT - SC_KT) + 32 * (k2_)); dst[1] = ld_perm(pk + (SC_AT - SC_KT) + 32 * SC_RK + 32 * (k2_)); \
                             dst[2] = ld_perm(pk + 32 * (k2_)); dst[3] = ld_perm(pk + 32 * SC_RK + 32 * (k2_)); \
                             dst[4] = ld_perm(pk + 64 * SC_RK + 32 * (k2_)); dst[5] = ld_perm(pk + 96 * SC_RK + 32 * (k2_)); } while (0)
            LD_AK(fb[0], 0);
            bf16x8 Vb[4];
#pragma unroll
            for (int k2 = 0; k2 < 4; ++k2) Vb[k2] = pack_acc(V[k2 >> 1], k2 & 1);
#pragma unroll
            for (int dt = 0; dt < 4; ++dt) S[dt] *= gl;
#pragma unroll
            for (int k2 = 0; k2 < 4; ++k2) {
                if (k2 < 3) LD_AK(fb[(k2 + 1) & 1], k2 + 1);
                __builtin_amdgcn_sched_barrier(0);
                Oa[0] = __builtin_amdgcn_mfma_f32_32x32x16_bf16(fb[k2 & 1][0], Vb[k2], Oa[0], 0, 0, 0);
                S[0] = __builtin_amdgcn_mfma_f32_32x32x16_bf16(fb[k2 & 1][2], Vb[k2], S[0], 0, 0, 0);
                Oa[1] = __builtin_amdgcn_mfma_f32_32x32x16_bf16(fb[k2 & 1][1], Vb[k2], Oa[1], 0, 0, 0);
                S[1] = __builtin_amdgcn_mfma_f32_32x32x16_bf16(fb[k2 & 1][3], Vb[k2], S[1], 0, 0, 0);
                S[2] = __builtin_amdgcn_mfma_f32_32x32x16_bf16(fb[k2 & 1][4], Vb[k2], S[2], 0, 0, 0);
                S[3] = __builtin_amdgcn_mfma_f32_32x32x16_bf16(fb[k2 & 1][5], Vb[k2], S[3], 0, 0, 0);
                __builtin_amdgcn_sched_barrier(0);
            }
#undef LD_AK
            bf16_t* obase = O + (MODE == 0 ? (size_t)(itb + nc) * 8192 : (size_t)bh * 8192) + e * 64 + 4 * hh;
#pragma unroll
            for (int ct = 0; ct < 2; ++ct)
#pragma unroll
                for (int q = 0; q < 4; ++q) {
                    u32x2 o2; o2.x = pk2(Oa[ct][4 * q + 0], Oa[ct][4 * q + 1]); o2.y = pk2(Oa[ct][4 * q + 2], Oa[ct][4 * q + 3]);
                    *(u32x2*)(obase + 32 * ct + 8 * q) = o2;
                }
            SCAN_BAR();
        }
    }
    __syncthreads();
}

__device__ __forceinline__ void phase_ya(const Prm& p, unsigned char* lds) {
    const bf16_t* OT = (const bf16_t*)(p.ws + OFF_H); bf16_t* SZA = (bf16_t*)p.out;
    const float* gw = p.in[7];
    bf16_t* sT = (bf16_t*)lds;
    float* sPart = (float*)(lds + 16384);
    const int tid = threadIdx.x, w = tid >> 6, c = tid & 63;
    for (int it = blockIdx.x; it < NIT; it += gridDim.x) {
        const int b = it >> 10, h = (it >> 7) & 7, nc = it & 127;
        const size_t tok = (size_t)b * SEQ + (size_t)nc * 64 + c;
#pragma unroll
        for (int i = 0; i < 2; ++i) { const int ch = tid + 512 * i; *(u32x4*)(sT + ch * 8) = *(const u32x4*)(OT + (size_t)it * 8192 + ch * 8); }
        const u32x4 z0 = *(const u32x4*)(SZA + tok * 1024 + h * 128 + 16 * w), z1 = *(const u32x4*)(SZA + tok * 1024 + h * 128 + 16 * w + 8);
        __syncthreads();
        float o[16]; float ss = 0.f;
#pragma unroll
        for (int j = 0; j < 16; ++j) { o[j] = bf2f(sT[(16 * w + j) * 64 + c]); ss += o[j] * o[j]; }
        sPart[w * 64 + c] = ss;
        __syncthreads();
        float tot = 0.f;
#pragma unroll
        for (int k = 0; k < 8; ++k) tot += sPart[k * 64 + c];
        const float rstd = rsqrtf(tot * (1.0f / 128.0f) + 1e-6f);
        const unsigned zz[8] = {z0.x, z0.y, z0.z, z0.w, z1.x, z1.y, z1.z, z1.w};
        unsigned r[8];
#pragma unroll
        for (int j = 0; j < 8; ++j)
            r[j] = pk2(o[2 * j] * rstd * gw[16 * w + 2 * j] * lo2f(zz[j]), o[2 * j + 1] * rstd * gw[16 * w + 2 * j + 1] * hi2f(zz[j]));
        *(u32x4*)(SZA + tok * 1024 + h * 128 + 16 * w) = (u32x4){r[0], r[1], r[2], r[3]};
        *(u32x4*)(SZA + tok * 1024 + h * 128 + 16 * w + 8) = (u32x4){r[4], r[5], r[6], r[7]};
        __syncthreads();
    }
}
__device__ __forceinline__ void phase_conv3(const Prm& p) {
    const bf16_t* P = (const bf16_t*)(p.ws + OFF_P); bf16_t* Q = (bf16_t*)(p.ws + OFF_Q); const float* cw = p.in[19];
    const int nth = gridDim.x * 512;
    for (int idx = blockIdx.x * 512 + threadIdx.x; idx < TOK * 256; idx += nth) {
        const int t = idx >> 8, c8 = (idx & 255) * 8, ts = t & (SEQ - 1);
        const u32x4 z4 = (u32x4){0u, 0u, 0u, 0u};
        const u32x4 p0 = *(const u32x4*)(P + (size_t)t * 2048 + c8);
        const u32x4 p1 = ts >= 1 ? *(const u32x4*)(P + (size_t)(t - 1) * 2048 + c8) : z4;
        const u32x4 p2 = ts >= 2 ? *(const u32x4*)(P + (size_t)(t - 2) * 2048 + c8) : z4;
        const u32x4 q = *(const u32x4*)(Q + (size_t)t * 2048 + c8);
        float r[8];
        const unsigned pa[4] = {p0.x, p0.y, p0.z, p0.w}, pb[4] = {p1.x, p1.y, p1.z, p1.w}, pc[4] = {p2.x, p2.y, p2.z, p2.w}, qa[4] = {q.x, q.y, q.z, q.w};
#pragma unroll
        for (int e = 0; e < 4; ++e) {
            const int c = c8 + 2 * e;
            r[2 * e] = lo2f(qa[e]) * (cw[c] * lo2f(pc[e]) + cw[2048 + c] * lo2f(pb[e]) + cw[4096 + c] * lo2f(pa[e]));
            r[2 * e + 1] = hi2f(qa[e]) * (cw[c + 1] * hi2f(pc[e]) + cw[2048 + c + 1] * hi2f(pb[e]) + cw[4096 + c + 1] * hi2f(pa[e]));
        }
        u32x4 o; o.x = pk2(r[0], r[1]); o.y = pk2(r[2], r[3]); o.z = pk2(r[4], r[5]); o.w = pk2(r[6], r[7]);
        *(u32x4*)(Q + (size_t)t * 2048 + c8) = o;
    }
}

#define XB_TMO      128
#define XB_XCNT(j)  (256  + 64 * (j))
#define XB_XSUB(j)  (1280 + 64 * (j))
#define XB_XGEN(j)  (2304 + 64 * (j))
#define XB_TOP      3328
#define XB_TOPGEN   3392
#define XCD_BAR_WORDS 3456
#define XB_SPIN_CAP (1u << 18)

__device__ __forceinline__ unsigned xb_ld(unsigned* p)              { return __hip_atomic_load(p, __ATOMIC_RELAXED, __HIP_MEMORY_SCOPE_AGENT); }
__device__ __forceinline__ unsigned xb_add(unsigned* p, unsigned v) { return __hip_atomic_fetch_add(p, v, __ATOMIC_RELAXED, __HIP_MEMORY_SCOPE_AGENT); }
__device__ __forceinline__ unsigned xb_xcc_id() { return (unsigned)__builtin_amdgcn_s_getreg((3 << 11) | 20) & 0xFu; }
#define XB_SPIN(cond, bar) do { unsigned _sp = 0; while (cond) { __builtin_amdgcn_s_sleep(1); \
    if ((++_sp & 255u) == 0u) { if (xb_ld(&(bar)[XB_TMO])) break; if (_sp > XB_SPIN_CAP) { atomicAdd(&(bar)[XB_TMO], 1u); break; } } } } while (0)

struct XcdBarrier {
    unsigned* bar; unsigned x;
    volatile LAS unsigned* st;
};

__device__ __forceinline__ XcdBarrier xcd_barrier_post(unsigned* bar, volatile LAS unsigned* st) {
    XcdBarrier b; b.bar = bar; b.x = xb_xcc_id(); b.st = st;
    if (threadIdx.x == 0) (void)xb_add(&bar[XB_XCNT(b.x)], 1u);
    return b;
}
__device__ __forceinline__ void xcd_barrier_complete(unsigned* bar, unsigned x, unsigned& nloc, unsigned& nx) {
    const unsigned G = gridDim.x * gridDim.y * gridDim.z;
    unsigned sum, cnt, mine, sp = 0u;
    for (;;) {
        sum = 0u; cnt = 0u; mine = 0u;
#pragma unroll
        for (unsigned j = 0; j < 16; ++j) { const unsigned c = xb_ld(&bar[XB_XCNT(j)]); sum += c; cnt += (c > 0u) ? 1u : 0u; mine = (j == x) ? c : mine; }
        if (sum == G) break;
        __builtin_amdgcn_s_sleep(1);
        if ((++sp & 255u) == 0u) { if (xb_ld(&bar[XB_TMO])) break; if (sp > XB_SPIN_CAP) { atomicAdd(&bar[XB_TMO], 1u); break; } }
    }
    nloc = mine > 0u ? mine : 1u; nx = cnt > 0u ? cnt : 1u;
}

__device__ __forceinline__ void xcd_barrier(const XcdBarrier& b) {
    asm volatile("s_waitcnt vmcnt(0)" ::: "memory");
    __syncthreads();
    if (threadIdx.x == 0) {
        unsigned* bar = b.bar;
        __builtin_amdgcn_s_waitcnt(0);
        unsigned nloc = b.st[0], nx = b.st[1];
        if (nloc == 0u) { xcd_barrier_complete(bar, b.x, nloc, nx); b.st[0] = nloc; b.st[1] = nx; }
        const unsigned old = xb_add(&bar[XB_XSUB(b.x)], 1u);
        const unsigned gen = old / nloc;
        if (old + 1u == (gen + 1u) * nloc) {
            __builtin_amdgcn_fence(__ATOMIC_RELEASE, "agent");
            asm volatile("s_waitcnt vmcnt(0)" ::: "memory");
            const unsigned og = xb_add(&bar[XB_TOP], 1u);
            const unsigned tg = og / nx;
            if (og + 1u == (tg + 1u) * nx) xb_add(&bar[XB_TOPGEN], 1u);
            else XB_SPIN(xb_ld(&bar[XB_TOPGEN]) == tg, bar);
            __builtin_amdgcn_fence(__ATOMIC_ACQUIRE, "agent");
            xb_add(&bar[XB_XGEN(b.x)], 1u);
            asm volatile("s_waitcnt vmcnt(0)" ::: "memory");
        } else {
            XB_SPIN(xb_ld(&bar[XB_XGEN(b.x)]) == gen, bar);
            __builtin_amdgcn_fence(__ATOMIC_ACQUIRE, "agent");
            asm volatile("s_waitcnt vmcnt(0)" ::: "memory");
        }
    }
    __syncthreads();
}

constexpr int NPHASE = 11;
#define REP_GEMM 1
#define REP_SYNC 1
#define REP_SCAN 1
#define SCAN_PROBE 1
#define REP_P0 1
#ifndef PHM
#define PHM 0x7FF
#endif
__global__ void __launch_bounds__(512, 2) mega(Prm p) {
    extern __shared__ __attribute__((aligned(16))) unsigned char shm[];
    LAS unsigned char* lds3 = (LAS unsigned char*)shm;
    unsigned char* ws = p.ws;
    volatile LAS unsigned* xst = (volatile LAS unsigned*)(lds3 + LDS_BYTES);
    if (threadIdx.x == 0) { xst[0] = 0u; xst[1] = 0u; }
    __syncthreads();
    XcdBarrier xb{};
    const bool multi = (p.ph_hi - p.ph_lo) > 1;
    if (multi) xb = xcd_barrier_post((unsigned*)(ws + OFF_BAR), xst);
    if (p.ph_lo < 0) cg::this_grid().sync();
#define PH_BEGIN(i) if (((PHM >> (i)) & 1) && p.ph_lo <= (i) && (i) < p.ph_hi) { if ((i) > p.ph_lo) { xcd_barrier(xb); if (REP_SYNC > 1) xcd_barrier(xb); } pg8::StaticOrder S; (void)S;
#define PH_END }
    PH_BEGIN(0)
        for (int rep = 0; rep < REP_P0; ++rep) {
        phase_convert(p, shm, 0, 1856, gridDim.x, blockIdx.x);
        phase_rmsnorm_x(p.in[0], p.in[1], (bf16_t*)(ws + OFF_H)); __syncthreads(); }
    PH_END
    PH_BEGIN(1)
        pg8::Gemm g{(const bf16_t*)(ws + OFF_H), (const bf16_t*)(ws + OFF_WT1), TOK, NP1, 1024, (const bf16_t*)(ws + OFF_H), 1024, 64};
        Epi1 E{(bf16_t*)(ws + OFF_QKV), (bf16_t*)p.out, (bf16_t*)(ws + OFF_UU), (bf16_t*)p.out + (size_t)TOK * 1024, (float*)(ws + OFF_BA), (bf16_t*)(ws + OFF_HALO)};
        S.init(TOK, NP1, gridDim.x, blockIdx.x); for (int rep = 0; rep < REP_GEMM; ++rep) { pg8::gemm_phase(lds3, g, S, E); __syncthreads(); }
    PH_END
    PH_BEGIN(2)
        if (blockIdx.x < 128) phase_s5(p, shm, blockIdx.x);
        {
            unsigned* ctr = (unsigned*)(ws + OFF_BAR) + 3600;
            volatile LAS unsigned* sIt = xst + 2;
            for (;;) {
                if (threadIdx.x == 0) sIt[0] = __hip_atomic_fetch_add(ctr, 2u, __ATOMIC_RELAXED, __HIP_MEMORY_SCOPE_AGENT);
                __syncthreads();
                const unsigned it0 = sIt[0];
                __syncthreads();
                if (it0 >= (unsigned)NIT) break;
                phase_gdn_prep(p, shm, (int)it0, 1);
            }
        }
    PH_END
    PH_BEGIN(3)
        if (blockIdx.x < 16) phase_gdn_scan<0>(p, shm, blockIdx.x);
        else {
            pg8::Gemm g{(const bf16_t*)(ws + OFF_UU), (const bf16_t*)(ws + OFF_WTG), TOK, 1024, 1024, (const bf16_t*)(ws + OFF_UU), 1024, 64};
            EpiGlu E{(const bf16_t*)(ws + OFF_UU), (bf16_t*)p.out + (size_t)TOK * 1024};
            S.init(TOK, 1024, gridDim.x - 16, blockIdx.x - 16); pg8::gemm_phase(lds3, g, S, E);
            __syncthreads();
            phase_convert(p, shm, 1856, 4928, gridDim.x - 16, blockIdx.x - 16);
        }
#if REP_SCAN > 1
        __syncthreads();
        if (blockIdx.x < 16) phase_gdn_scan<SCAN_PROBE>(p, shm, blockIdx.x);
#endif
    PH_END
    PH_BEGIN(4)
        phase_ya(p, shm);
    PH_END
    PH_BEGIN(5)
        pg8::Gemm g{(const bf16_t*)p.out, (const bf16_t*)(ws + OFF_WTO0), TOK, 1024, 2048, (const bf16_t*)p.out + (size_t)TOK * 1024, 1024, 16};
        EpiF32 E{(float*)(ws + OFF_QKV)};
        S.init(TOK, 1024, gridDim.x, blockIdx.x); for (int rep = 0; rep < REP_GEMM; ++rep) { pg8::gemm_phase(lds3, g, S, E); __syncthreads(); }
    PH_END
    PH_BEGIN(6)
        phase_post<true>(p.in[0], (const float*)(ws + OFF_QKV), p.in[2], p.out, p.in[1] + 1024, (bf16_t*)(ws + OFF_H));
    PH_END
    PH_BEGIN(7)
        pg8::Gemm g{(const bf16_t*)(ws + OFF_H), (const bf16_t*)(ws + OFF_WT2), TOK, 8192, 1024, (const bf16_t*)(ws + OFF_H), 1024, 64};
        Epi2 E{(bf16_t*)(ws + OFF_P), (bf16_t*)(ws + OFF_Q)};
        S.init(TOK, 8192, gridDim.x, blockIdx.x); for (int rep = 0; rep < REP_GEMM; ++rep) { pg8::gemm_phase(lds3, g, S, E); __syncthreads(); }
    PH_END
    PH_BEGIN(8)
        phase_conv3(p);
    PH_END
    PH_BEGIN(9)
        pg8::Gemm g{(const bf16_t*)(ws + OFF_Q), (const bf16_t*)(ws + OFF_WTO1), TOK, 1024, 2048, (const bf16_t*)(ws + OFF_Q), 2048, 64};
        EpiF32 E{(float*)(ws + OFF_P)};
        S.init(TOK, 1024, gridDim.x, blockIdx.x); for (int rep = 0; rep < REP_GEMM; ++rep) { pg8::gemm_phase(lds3, g, S, E); __syncthreads(); }
    PH_END
    PH_BEGIN(10)
        phase_post<false>(p.out, (const float*)(ws + OFF_P), p.in[2] + 1024, p.out, nullptr, nullptr);
    PH_END
}

#ifndef N_LAUNCH_MODE
#define N_LAUNCH_MODE 1
#endif

extern "C" void kernel_launch(void* const* d_in, const int* in_sizes, int n_in, void* d_out, int out_size, void* d_ws, size_t ws_size, hipStream_t stream) {
    static int ready = 0;
    if (!ready) {
        if (n_in != 21 || ws_size < WS_END || out_size != TOK * DM) { fprintf(stderr, "kernel_launch: unexpected shapes (n_in %d ws %zu out %d)\n", n_in, ws_size, out_size); ready = -1; return; }
        if (hipFuncSetAttribute((const void*)mega, hipFuncAttributeMaxDynamicSharedMemorySize, LDS_BYTES + 16) != hipSuccess) { fprintf(stderr, "kernel_launch: hipFuncSetAttribute failed\n"); ready = -1; return; }
        ready = 1;
    }
    if (ready < 0) return;
    Prm p{};
    for (int i = 0; i < 21; ++i) p.in[i] = (const float*)d_in[i];
    p.out = (float*)d_out; p.ws = (unsigned char*)d_ws;
#if N_LAUNCH_MODE == 1
    p.ph_lo = 0; p.ph_hi = NPHASE;
    void* args[] = {&p};
    if (hipMemsetAsync((unsigned char*)d_ws + OFF_BAR, 0, 16384, stream) != hipSuccess) { fprintf(stderr, "memset failed\n"); return; }
    hipError_t e = hipLaunchCooperativeKernel((const void*)mega, dim3(256), dim3(512), args, LDS_BYTES + 16, stream);
    if (e != hipSuccess) fprintf(stderr, "cooperative launch failed: %s\n", hipGetErrorString(e));
#else
    for (int ph = 0; ph < NPHASE; ++ph) {
        p.ph_lo = ph; p.ph_hi = ph + 1;
        hipLaunchKernelGGL(mega, dim3(256), dim3(512), LDS_BYTES + 16, stream, p);
    }
#endif
}
```

```cpp
#include <hip/hip_runtime.h>
#include <hip/hip_cooperative_groups.h>
#include <cstdio>
namespace cg = cooperative_groups;

#define LAS __attribute__((address_space(3)))
typedef unsigned short bf16_t;
typedef short bf16x8 __attribute__((ext_vector_type(8)));
typedef float f32x4 __attribute__((ext_vector_type(4)));
typedef float f32x16 __attribute__((ext_vector_type(16)));
typedef unsigned u32x4 __attribute__((ext_vector_type(4)));
typedef unsigned u32x2 __attribute__((ext_vector_type(2)));

constexpr int TOK = 16384, DM = 1024, SEQ = 8192;
constexpr int NP1 = 6400;
constexpr int NIT = 2048;

constexpr size_t OFF_WT1 = 0;
constexpr size_t OFF_WTG = OFF_WT1 + (size_t)NP1 * 1024 * 2;
constexpr size_t OFF_WTO0 = OFF_WTG + (size_t)1024 * 1024 * 2;
constexpr size_t OFF_WT2 = OFF_WTO0 + (size_t)1024 * 2048 * 2;
constexpr size_t OFF_WTO1 = OFF_WT2 + (size_t)8192 * 1024 * 2;
constexpr size_t OFF_H = OFF_WTO1 + (size_t)1024 * 2048 * 2;
constexpr size_t OFF_QKV = OFF_H + (size_t)TOK * 1024 * 2;
constexpr size_t OFF_UU = OFF_QKV + (size_t)TOK * 3072 * 2;
constexpr size_t OFF_WB = OFF_UU + (size_t)TOK * 1024 * 2;
constexpr size_t OFF_ATT = OFF_WB + (size_t)NIT * 8192 * 2;
constexpr size_t OFF_HALO = OFF_ATT + (size_t)NIT * 4096 * 2;
constexpr size_t OFF_BA = OFF_HALO + (size_t)256 * 3 * 3072 * 2;
constexpr size_t OFF_GL = OFF_BA + (size_t)TOK * 16 * 4;
constexpr size_t OFF_BAR = OFF_GL + (size_t)NIT * 4;
constexpr size_t WS_END = OFF_BAR + 16384;
constexpr size_t OFF_YMIX = OFF_QKV;
constexpr size_t OFF_P = OFF_QKV;
constexpr size_t OFF_Q = OFF_QKV + (size_t)TOK * 2048 * 2;
static_assert(OFF_Q + (size_t)TOK * 2048 * 2 <= OFF_WB, "Q overlaps live data");
static_assert(WS_END <= (size_t)256 * 1024 * 1024, "workspace too big");

constexpr int LDS_BYTES = 157696;

struct Prm {
    const float* in[21];
    float* out;
    unsigned char* ws;
    int ph_lo, ph_hi;
};

__device__ __forceinline__ float bf2f(bf16_t b) { return __uint_as_float(((unsigned)b) << 16); }
__device__ __forceinline__ bf16_t f2bf(float f) { unsigned u = __float_as_uint(f); u += 0x7FFFu + ((u >> 16) & 1u); return (bf16_t)(u >> 16); }
typedef __bf16 bf16v2_t __attribute__((ext_vector_type(2)));
typedef float f32x2_t __attribute__((ext_vector_type(2)));
__device__ __forceinline__ unsigned pk2(float lo, float hi) { const f32x2_t v = {lo, hi}; return __builtin_bit_cast(unsigned, __builtin_convertvector(v, bf16v2_t)); }
__device__ __forceinline__ float lo2f(unsigned u) { return __uint_as_float(u << 16); }
__device__ __forceinline__ float hi2f(unsigned u) { return __uint_as_float(u & 0xFFFF0000u); }
__device__ __forceinline__ float sigmoidf_(float x) { return 1.0f / (1.0f + __expf(-x)); }
__device__ __forceinline__ float siluf_(float x) { return x / (1.0f + __expf(-x)); }
__device__ __forceinline__ float wave_sum(float v) {
#pragma unroll
    for (int o = 32; o >= 1; o >>= 1) v += __shfl_xor(v, o);
    return v;
}
__device__ __forceinline__ u32x4 pack8(f32x4 a, f32x4 b) { u32x4 r; r.x = pk2(a[0], a[1]); r.y = pk2(a[2], a[3]); r.z = pk2(b[0], b[1]); r.w = pk2(b[2], b[3]); return r; }

namespace pg8 {
constexpr int BM = 256, BK = 64, HALF = 128, HTB = HALF * BK * 2, STAGE_BYTES = 8 * HTB, NXCD = 8, WGM = 8;
__device__ __forceinline__ int lds_byte(int r, int c) { const int st = (r >> 4) * 2 + (c >> 5), rr = r & 15, cc = c & 31, ob = rr * 64 + cc * 2; return st * 1024 + (ob ^ (((ob >> 9) & 1) << 5)); }
__device__ __forceinline__ void stage_rc(int b, int& R, int& C) { const int st = b / 1024, sb = b % 1024, swz = sb ^ (((sb >> 9) & 1) << 5); R = (st >> 1) * 16 + swz / 64; C = (st & 1) * 32 + (swz % 64) / 2; }
__device__ __forceinline__ int perm32(int rho) { const int n = rho >> 4, i = rho & 15; return 8 * (i >> 2) + 4 * n + (i & 3); }
struct Unit { int pm, pn; };
struct Gemm { const bf16_t* A; const bf16_t* Bt; int M, N, K; const bf16_t* A2; int lda, ks; };
struct StaticOrder {
    int nM, nN, nwg, G, c;
    __device__ void init(int M, int N, int G_, int c_) { nM = M / BM; nN = N / BM; nwg = nM * nN; G = G_; c = c_; }
    __device__ bool next(int i, Unit& u) const {
        const long L = (long)i * G + c; if (L >= nwg) return false;
        int wgid = (int)L; { const int q = nwg / NXCD, r = nwg % NXCD, xcd = wgid % NXCD, off = wgid / NXCD; wgid = (xcd < r ? xcd * (q + 1) : r * (q + 1) + (xcd - r) * q) + off; }
        const int nig = WGM * nN, gid = wgid / nig, fm = gid * WGM, gsz = (nM - fm) < WGM ? (nM - fm) : WGM;
        u.pm = fm + ((wgid % nig) % gsz); u.pn = (wgid % nig) / gsz; return true;
    }
};

template <class Epi>
__device__ __forceinline__ void gemm_phase(LAS unsigned char* lds, const Gemm g, const StaticOrder& S, const Epi& E) {
    const int tid = threadIdx.x, wid = __builtin_amdgcn_readfirstlane(tid >> 6), lane = tid & 63, wr = wid >> 2, wc = wid & 3, fr = lane & 15, fq = lane >> 4;
    const int K = g.K, nt = K / BK;
    unsigned voffA[2], voffB[2];
#pragma unroll
    for (int i = 0; i < 2; ++i) { int R, C; stage_rc(tid * 16 + i * 8192, R, C); const int Rb = Epi::PERM ? ((R & ~31) + perm32(R & 31)) : R;
        voffA[i] = (unsigned)(R * g.lda + C) * 2u; voffB[i] = (unsigned)(Rb * K + C) * 2u; }
    const size_t kstep = (size_t)(BK * 2);
    const size_t hstep = (size_t)HALF * K * 2;
    const size_t tstep = 2 * hstep;
    const size_t hstepA = (size_t)HALF * g.lda * 2, tstepA = 2 * hstepA;
    const int ks = g.ks; const ptrdiff_t a2off = (const char*)g.A2 - (const char*)g.A - (ptrdiff_t)ks * (ptrdiff_t)kstep;
    const unsigned ldsw = (unsigned)wid * 1024u;
    const int aoff = lds_byte(wr * 64 + fr, fq * 8), boff = lds_byte(wc * 32 + fr, fq * 8);
#define PG8_SA(b, h) (((b) * 2 + (h)) * HTB)
#define PG8_SB(b, h) ((4 + (b) * 2 + (h)) * HTB)
#define PG8_STAGE(bufoff, gbase, voff) do { _Pragma("unroll") for (int _i = 0; _i < 2; ++_i) \
        __builtin_amdgcn_global_load_lds((const unsigned*)((const char*)(gbase) + (voff)[_i]), (LAS unsigned*)(lds + (bufoff) + ldsw + _i * 8192), 16, 0, 0); } while (0)
#define PG8_LDA(dst, b, h) do { _Pragma("unroll") for (int m = 0; m < 4; ++m) _Pragma("unroll") for (int k = 0; k < 2; ++k) dst[m][k] = *(const LAS bf16x8*)(lds + PG8_SA(b, h) + aoff + m * 2048 + k * 1024); } while (0)
#define PG8_LDB(dst, b, h) do { _Pragma("unroll") for (int n = 0; n < 2; ++n) _Pragma("unroll") for (int k = 0; k < 2; ++k) dst[n][k] = *(const LAS bf16x8*)(lds + PG8_SB(b, h) + boff + n * 2048 + k * 1024); } while (0)
#define PG8_MMA(ai, bj, At, Bt) do { __builtin_amdgcn_s_setprio(1); _Pragma("unroll") for (int m = 0; m < 4; ++m) _Pragma("unroll") for (int n = 0; n < 2; ++n) _Pragma("unroll") for (int k = 0; k < 2; ++k) \
        acc[ai][bj][m][n] = __builtin_amdgcn_mfma_f32_16x16x32_bf16(Bt[n][k], At[m][k], acc[ai][bj][m][n], 0, 0, 0); __builtin_amdgcn_s_setprio(0); } while (0)
#define PG8_WAIT_V(n) asm volatile("s_waitcnt vmcnt(" #n ")" ::: "memory")
#define PG8_WAIT_L(n) asm volatile("s_waitcnt lgkmcnt(" #n ")" ::: "memory")
#define PG8_BAR __builtin_amdgcn_s_barrier()
#define PG8_SCHED __builtin_amdgcn_sched_barrier(0)
    Unit cur, nxt; int ui = 0;
    if (!S.next(0, cur)) return;
    f32x4 acc[2][2][4][2];
#pragma unroll
    for (int a = 0; a < 2; ++a)
#pragma unroll
        for (int b = 0; b < 2; ++b)
#pragma unroll
            for (int m = 0; m < 4; ++m)
#pragma unroll
                for (int n = 0; n < 2; ++n) acc[a][b][m][n] = (f32x4){0.f, 0.f, 0.f, 0.f};
    bf16x8 At[4][2], B0[2][2], B1[2][2];
    const char* cA = (const char*)g.A + (size_t)cur.pm * tstepA; const char* cB = (const char*)g.Bt + (size_t)cur.pn * tstep;
    PG8_STAGE(PG8_SB(0, 0), cB, voffB); PG8_STAGE(PG8_SA(0, 0), cA, voffA); PG8_STAGE(PG8_SB(0, 1), cB + hstep, voffB); PG8_STAGE(PG8_SA(0, 1), cA + hstepA, voffA);
    if (wr == 1) PG8_BAR;
    PG8_WAIT_V(4); PG8_BAR;
    PG8_STAGE(PG8_SB(1, 0), cB + kstep, voffB); PG8_STAGE(PG8_SA(1, 0), cA + kstep, voffA); PG8_STAGE(PG8_SB(1, 1), cB + hstep + kstep, voffB);
    PG8_WAIT_V(6); PG8_BAR;
    for (;;) {
        const bool has_next = S.next(ui + 1, nxt);
        const char* nA = has_next ? (const char*)g.A + (size_t)nxt.pm * tstepA : cA; const char* nB = has_next ? (const char*)g.Bt + (size_t)nxt.pn * tstep : cB;
        for (int t = 0; t < nt; t += 2) {
            const bool last = (t == nt - 2);
            const char* a1 = cA + (size_t)(t + 1) * kstep + ((t + 1) >= ks ? a2off : 0);
            const char* a2 = last ? nA : cA + (size_t)(t + 2) * kstep + ((t + 2) >= ks ? a2off : 0); const char* b2 = last ? nB : cB + (size_t)(t + 2) * kstep;
            const char* a3 = last ? nA + kstep : cA + (size_t)(t + 3) * kstep + ((t + 3) >= ks ? a2off : 0); const char* b3 = b2 + kstep;
            PG8_LDB(B0, 0, 0); PG8_SCHED; PG8_LDA(At, 0, 0); PG8_STAGE(PG8_SA(1, 1), a1 + hstepA, voffA);
            PG8_WAIT_L(8); PG8_BAR; PG8_WAIT_L(0); PG8_MMA(0, 0, At, B0); PG8_BAR; PG8_SCHED;
            PG8_LDB(B1, 0, 1); PG8_STAGE(PG8_SB(0, 0), b2, voffB);
            PG8_BAR; PG8_WAIT_L(0); PG8_MMA(0, 1, At, B1); PG8_BAR;
            PG8_LDA(At, 0, 1); PG8_STAGE(PG8_SA(0, 0), a2, voffA);
            PG8_BAR; PG8_WAIT_L(0); PG8_MMA(1, 0, At, B0); PG8_BAR; PG8_SCHED;
            PG8_STAGE(PG8_SB(0, 1), b2 + hstep, voffB);
            PG8_WAIT_V(6); PG8_BAR; PG8_MMA(1, 1, At, B1); PG8_BAR;
            PG8_LDB(B0, 1, 0); PG8_SCHED; PG8_LDA(At, 1, 0); PG8_STAGE(PG8_SA(0, 1), a2 + hstepA, voffA);
            PG8_WAIT_L(8); PG8_BAR; PG8_WAIT_L(0); PG8_MMA(0, 0, At, B0); PG8_BAR; PG8_SCHED;
            PG8_LDB(B1, 1, 1); PG8_STAGE(PG8_SB(1, 0), b3, voffB);
            PG8_BAR; PG8_WAIT_L(0); PG8_MMA(0, 1, At, B1); PG8_BAR;
            PG8_LDA(At, 1, 1); PG8_STAGE(PG8_SA(1, 0), a3, voffA);
            PG8_BAR; PG8_WAIT_L(0); PG8_MMA(1, 0, At, B0); PG8_BAR; PG8_SCHED;
            PG8_STAGE(PG8_SB(1, 1), b3 + hstep, voffB);
            PG8_WAIT_V(6); PG8_BAR; PG8_MMA(1, 1, At, B1); PG8_BAR;
        }
        E(acc, cur, wr, wc, fr, fq);
        if (!has_next) break;
#pragma unroll
        for (int a = 0; a < 2; ++a)
#pragma unroll
            for (int b = 0; b < 2; ++b)
#pragma unroll
                for (int m = 0; m < 4; ++m)
#pragma unroll
                    for (int n = 0; n < 2; ++n) acc[a][b][m][n] = (f32x4){0.f, 0.f, 0.f, 0.f};
        cur = nxt; cA = nA; cB = nB; ++ui;
    }
    PG8_WAIT_V(0);
    if (wr == 0) PG8_BAR;
    PG8_BAR;
#undef PG8_SA
#undef PG8_SB
#undef PG8_STAGE
#undef PG8_LDA
#undef PG8_LDB
#undef PG8_MMA
#undef PG8_WAIT_V
#undef PG8_WAIT_L
#undef PG8_BAR
#undef PG8_SCHED
}
}
using pg8::Unit;

struct Epi1 {
    static constexpr bool PERM = true;
    bf16_t* QKV; bf16_t* SZA; bf16_t* UU; bf16_t* SZB; float* BA; bf16_t* HALO;
    __device__ __forceinline__ void operator()(const f32x4 (&acc)[2][2][4][2], const Unit& u, int wr, int wc, int fr_, int fq_) const {
        int lane = (int)(threadIdx.x & 63); asm volatile("" : "+v"(lane));
        const int fr = lane & 15, fq = lane >> 4; (void)fr_; (void)fq_;
        const int row0 = u.pm * 256 + wr * 64 + fr, pn = u.pn;
#pragma unroll
        for (int ai = 0; ai < 2; ++ai)
#pragma unroll
            for (int m = 0; m < 4; ++m) {
                const size_t row = (size_t)(row0 + ai * 128 + m * 16);
#pragma unroll
                for (int bj = 0; bj < 2; ++bj) {
                    const int colt = 128 * bj + 32 * wc + 8 * fq;
                    f32x4 v0 = acc[ai][bj][m][0], v1 = acc[ai][bj][m][1];
                    if (pn < 12) {
                        const int c = pn * 256 + colt; const u32x4 pk = pack8(v0, v1);
                        *(u32x4*)(QKV + row * 3072 + c) = pk;
                        if (m == 3 && fr >= 13) *(u32x4*)(HALO + ((row >> 6) * 3 + (fr - 13)) * 3072 + c) = pk;
                    } else if (pn < 16) {
#pragma unroll
                        for (int e = 0; e < 4; ++e) { v0[e] = siluf_(v0[e]); v1[e] = siluf_(v1[e]); }
                        *(u32x4*)(SZA + row * 1024 + (pn - 12) * 256 + colt) = pack8(v0, v1);
                    } else if (pn < 20) {
                        *(u32x4*)(UU + row * 1024 + (pn - 16) * 256 + colt) = pack8(v0, v1);
                    } else if (pn < 24) {
#pragma unroll
                        for (int e = 0; e < 4; ++e) { v0[e] = siluf_(v0[e]); v1[e] = siluf_(v1[e]); }
                        *(u32x4*)(SZB + row * 1024 + (pn - 20) * 256 + colt) = pack8(v0, v1);
                    } else if (colt < 16) {
                        *(f32x4*)(BA + row * 16 + colt) = v0; *(f32x4*)(BA + row * 16 + colt + 4) = v1;
                    }
                }
            }
    }
};
struct EpiGlu {
    static constexpr bool PERM = true;
    const bf16_t* Y5; bf16_t* SZB;
    __device__ __forceinline__ void operator()(const f32x4 (&acc)[2][2][4][2], const Unit& u, int wr, int wc, int fr, int fq) const {
        const int row0 = u.pm * 256 + wr * 64 + fr;
#pragma unroll
        for (int ai = 0; ai < 2; ++ai)
#pragma unroll
            for (int m = 0; m < 4; ++m) {
                const size_t row = (size_t)(row0 + ai * 128 + m * 16);
#pragma unroll
                for (int bj = 0; bj < 2; ++bj) {
                    const int c = u.pn * 256 + 128 * bj + 32 * wc + 8 * fq;
                    const u32x4 y = *(const u32x4*)(Y5 + row * 1024 + c), z = *(const u32x4*)(SZB + row * 1024 + c);
                    const f32x4 a0 = acc[ai][bj][m][0], a1 = acc[ai][bj][m][1];
                    u32x4 o;
                    o.x = pk2(lo2f(y.x) * sigmoidf_(a0[0]) * lo2f(z.x), hi2f(y.x) * sigmoidf_(a0[1]) * hi2f(z.x));
                    o.y = pk2(lo2f(y.y) * sigmoidf_(a0[2]) * lo2f(z.y), hi2f(y.y) * sigmoidf_(a0[3]) * hi2f(z.y));
                    o.z = pk2(lo2f(y.z) * sigmoidf_(a1[0]) * lo2f(z.z), hi2f(y.z) * sigmoidf_(a1[1]) * hi2f(z.z));
                    o.w = pk2(lo2f(y.w) * sigmoidf_(a1[2]) * lo2f(z.w), hi2f(y.w) * sigmoidf_(a1[3]) * hi2f(z.w));
                    *(u32x4*)(SZB + row * 1024 + c) = o;
                }
            }
    }
};
struct EpiF32 {
    static constexpr bool PERM = false;
    float* C;
    __device__ __forceinline__ void operator()(const f32x4 (&acc)[2][2][4][2], const Unit& u, int wr, int wc, int fr, int fq) const {
        const int row0 = u.pm * 256 + wr * 64 + fr, col0 = u.pn * 256 + wc * 32 + 4 * fq;
#pragma unroll
        for (int ai = 0; ai < 2; ++ai)
#pragma unroll
            for (int m = 0; m < 4; ++m) { float* rowp = C + (size_t)(row0 + ai * 128 + m * 16) * 1024 + col0;
#pragma unroll
                for (int bj = 0; bj < 2; ++bj)
#pragma unroll
                    for (int n = 0; n < 2; ++n) *(f32x4*)(rowp + bj * 128 + n * 16) = acc[ai][bj][m][n]; }
    }
};
struct Epi2 {
    static constexpr bool PERM = false;
    bf16_t* P; bf16_t* Q;
    __device__ __forceinline__ void operator()(const f32x4 (&acc)[2][2][4][2], const Unit& u, int wr, int wc, int fr, int fq) const {
        const int row0 = u.pm * 256 + wr * 64 + fr, ch = u.pn * 64 + 16 * wc + 4 * fq;
#pragma unroll
        for (int ai = 0; ai < 2; ++ai)
#pragma unroll
            for (int m = 0; m < 4; ++m) {
                const size_t row = (size_t)(row0 + ai * 128 + m * 16);
                const f32x4 gb = acc[ai][0][m][0], gc = acc[ai][0][m][1], hv = acc[ai][1][m][0], z = acc[ai][1][m][1];
                u32x2 pp, qq;
                pp.x = pk2(gc[0] * hv[0], gc[1] * hv[1]); pp.y = pk2(gc[2] * hv[2], gc[3] * hv[3]);
                qq.x = pk2(gb[0] * siluf_(z[0]), gb[1] * siluf_(z[1])); qq.y = pk2(gb[2] * siluf_(z[2]), gb[3] * siluf_(z[3]));
                *(u32x2*)(P + row * 2048 + ch) = pp; *(u32x2*)(Q + row * 2048 + ch) = qq;
            }
    }
};

__device__ __forceinline__ int src_col(int mode, int n, int& pn_unused) {
    (void)pn_unused;
    if (mode == 0) return n;
    if (mode == 1) { if (n < 4096) return n; if (n < 6144) return n + 16; if (n < 6160) return n - 2048; return -1; }
    const int pn = n >> 8, col = n & 255, bj = col >> 7, wc = (col >> 5) & 3, nn = (col >> 4) & 1, lo = col & 15;
    return (2 * bj + nn) * 2048 + pn * 64 + 16 * wc + lo;
}
__device__ __forceinline__ void phase_convert(const Prm& p, unsigned char* lds, int t_begin, int t_end, int nblk, int bidx) {
    float* tile = (float*)lds;
    const int tid = threadIdx.x;
    for (int tix = t_begin + bidx; tix < t_end; tix += nblk) {
        int tl = tix, K, Nsrc, mode; const float* W; bf16_t* Wt;
        if (tl < 1600) { W = p.in[3]; Wt = (bf16_t*)(p.ws + OFF_WT1); K = 1024; Nsrc = 6160; mode = 1; }
        else if ((tl -= 1600) < 256) { W = p.in[16]; Wt = (bf16_t*)(p.ws + OFF_WTG); K = 1024; Nsrc = 1024; mode = 0; }
        else if ((tl -= 256) < 512) { W = p.in[17]; Wt = (bf16_t*)(p.ws + OFF_WTO0); K = 2048; Nsrc = 1024; mode = 0; }
        else if ((tl -= 512) < 2048) { W = p.in[18]; Wt = (bf16_t*)(p.ws + OFF_WT2); K = 1024; Nsrc = 8192; mode = 2; }
        else { tl -= 2048; W = p.in[20]; Wt = (bf16_t*)(p.ws + OFF_WTO1); K = 2048; Nsrc = 1024; mode = 0; }
        const int ntk = K / 64, n0 = (tl / ntk) * 64, k0 = (tl % ntk) * 64;
        { const int j = tid & 63; int dummy = 0; const int sc = src_col(mode, n0 + j, dummy);
#pragma unroll
          for (int i = 0; i < 8; ++i) { const int k = (tid >> 6) + 8 * i; tile[k * 65 + j] = sc >= 0 ? W[(size_t)(k0 + k) * Nsrc + sc] : 0.0f; } }
        __syncthreads();
        { const int r = tid >> 3, c8 = (tid & 7) * 8; u32x4 o;
          o.x = pk2(tile[(c8 + 0) * 65 + r], tile[(c8 + 1) * 65 + r]); o.y = pk2(tile[(c8 + 2) * 65 + r], tile[(c8 + 3) * 65 + r]);
          o.z = pk2(tile[(c8 + 4) * 65 + r], tile[(c8 + 5) * 65 + r]); o.w = pk2(tile[(c8 + 6) * 65 + r], tile[(c8 + 7) * 65 + r]);
          *(u32x4*)(Wt + (size_t)(n0 + r) * K + k0 + c8) = o; }
        __syncthreads();
    }
}
__device__ __forceinline__ void phase_rmsnorm_x(const float* x, const float* w, bf16_t* H) {
    const int lane = threadIdx.x & 63, nw = gridDim.x * 8;
    for (int row = blockIdx.x * 8 + (threadIdx.x >> 6); row < TOK; row += nw) {
        const f32x4* xr = (const f32x4*)(x + (size_t)row * 1024);
        f32x4 v[4]; float ss = 0.f;
#pragma unroll
        for (int i = 0; i < 4; ++i) { v[i] = xr[lane + 64 * i]; ss += v[i][0] * v[i][0] + v[i][1] * v[i][1] + v[i][2] * v[i][2] + v[i][3] * v[i][3]; }
        ss = wave_sum(ss);
        const float rstd = rsqrtf(ss * (1.0f / 1024.0f) + 1e-6f);
#pragma unroll
        for (int i = 0; i < 4; ++i) { const f32x4 w4 = ((const f32x4*)w)[lane + 64 * i]; u32x2 o;
            o.x = pk2(v[i][0] * rstd * w4[0], v[i][1] * rstd * w4[1]); o.y = pk2(v[i][2] * rstd * w4[2], v[i][3] * rstd * w4[3]);
            *(u32x2*)(H + (size_t)row * 1024 + (lane + 64 * i) * 4) = o; }
    }
}
template <bool NEXT>
__device__ __forceinline__ void phase_post(const float* base, const float* Y, const float* wpost, float* OUT, const float* wpre, bf16_t* H) {
    const int lane = threadIdx.x & 63, nw = gridDim.x * 8;
    for (int row = blockIdx.x * 8 + (threadIdx.x >> 6); row < TOK; row += nw) {
        const f32x4* yr = (const f32x4*)(Y + (size_t)row * 1024); const f32x4* br = (const f32x4*)(base + (size_t)row * 1024);
        f32x4 v[4], xb[4]; float ss = 0.f;
#pragma unroll
        for (int i = 0; i < 4; ++i) { v[i] = yr[lane + 64 * i]; xb[i] = br[lane + 64 * i]; ss += v[i][0] * v[i][0] + v[i][1] * v[i][1] + v[i][2] * v[i][2] + v[i][3] * v[i][3]; }
        ss = wave_sum(ss);
        const float rstd = rsqrtf(ss * (1.0f / 1024.0f) + 1e-6f);
        float s2 = 0.f;
#pragma unroll
        for (int i = 0; i < 4; ++i) { const f32x4 w4 = ((const f32x4*)wpost)[lane + 64 * i];
#pragma unroll
            for (int e = 0; e < 4; ++e) { v[i][e] = xb[i][e] + v[i][e] * rstd * w4[e]; s2 += v[i][e] * v[i][e]; }
            ((f32x4*)(OUT + (size_t)row * 1024))[lane + 64 * i] = v[i]; }
        if (NEXT) {
            s2 = wave_sum(s2);
            const float r2 = rsqrtf(s2 * (1.0f / 1024.0f) + 1e-6f);
#pragma unroll
            for (int i = 0; i < 4; ++i) { const f32x4 w4 = ((const f32x4*)wpre)[lane + 64 * i]; u32x2 o;
                o.x = pk2(v[i][0] * r2 * w4[0], v[i][1] * r2 * w4[1]); o.y = pk2(v[i][2] * r2 * w4[2], v[i][3] * r2 * w4[3]);
                *(u32x2*)(H + (size_t)row * 1024 + (lane + 64 * i) * 4) = o; }
        }
    }
}


__device__ __forceinline__ void sincos_d(double x, double& s, double& c) {
    const double k = rint(x * 0.6366197723675814);
    const double r = fma(-k, 6.123233995736766e-17, fma(-k, 1.5707963267948966, x)), r2 = r * r;
    double sp = -7.647163731819816e-13; sp = fma(sp, r2, 1.6059043836821613e-10); sp = fma(sp, r2, -2.505210838544172e-8); sp = fma(sp, r2, 2.7557319223985893e-6);
    sp = fma(sp, r2, -1.984126984126984e-4); sp = fma(sp, r2, 8.333333333333333e-3); sp = fma(sp, r2, -1.6666666666666666e-1); sp = fma(sp * r2, r, r);
    double cp = 4.779477332387385e-14; cp = fma(cp, r2, -1.1470745597729725e-11); cp = fma(cp, r2, 2.08767569878681e-9); cp = fma(cp, r2, -2.755731922398589e-7);
    cp = fma(cp, r2, 2.48015873015873e-5); cp = fma(cp, r2, -1.388888888888889e-3); cp = fma(cp, r2, 4.1666666666666664e-2); cp = fma(cp, r2, -0.5); cp = fma(cp, r2, 1.0);
    const int q = ((int)k) & 3;
    const double s0 = (q & 1) ? cp : sp, c0 = (q & 1) ? sp : cp;
    s = (q & 2) ? -s0 : s0; c = ((q + 1) & 2) ? -c0 : c0;
}
__device__ __forceinline__ double exp_d(double x) {
    const double n = rint(x * 1.4426950408889634);
    const double r = fma(-n, 2.3190468138462996e-17, fma(-n, 0.6931471805599453, x));
    double p = 1.6059043836821613e-10; p = fma(p, r, 2.08767569878681e-9); p = fma(p, r, 2.505210838544172e-8); p = fma(p, r, 2.755731922398589e-7); p = fma(p, r, 2.7557319223985893e-6);
    p = fma(p, r, 2.48015873015873e-5); p = fma(p, r, 1.984126984126984e-4); p = fma(p, r, 1.388888888888889e-3); p = fma(p, r, 8.333333333333333e-3); p = fma(p, r, 4.1666666666666664e-2);
    p = fma(p, r, 1.6666666666666666e-1); p = fma(p, r, 0.5); p = fma(p, r, 1.0); p = fma(p, r, 1.0);
    return ldexp(p, (int)n);
}
__device__ __forceinline__ float bcast_lo(float v) { auto r = __builtin_amdgcn_permlane32_swap(__float_as_uint(v), __float_as_uint(v), false, false); return __uint_as_float(r[0]); }
__device__ __forceinline__ float bcast_hi(float v) { auto r = __builtin_amdgcn_permlane32_swap(__float_as_uint(v), __float_as_uint(v), false, false); return __uint_as_float(r[1]); }

struct S5C {
    float ar[2][4], ai[2][4];
    float a512r[2], a512i[2];
    bf16x8 BB[4];
    bf16x8 CC[4];
    float dco;
};

template <bool OUT>
__device__ __forceinline__ void s5_chunk(const S5C& C, bf16_t* UU, int b, int g, int chunk, float (&st)[2][2], bf16_t* sX, int lane) {
    const int n = lane & 31, hh = lane >> 5, fr = lane & 15, fq = lane >> 4;
    const size_t tok0 = (size_t)b * SEQ + (size_t)chunk * 512;
    bf16x8 ua = *(const bf16x8*)(UU + (tok0 + n) * 1024 + 16 * g + 8 * hh);
    bf16_t uo[8];
    if (OUT) {
#pragma unroll
        for (int mt = 0; mt < 2; ++mt)
#pragma unroll
            for (int j = 0; j < 4; ++j) uo[mt * 4 + j] = UU[(tok0 + 16 * mt + 4 * fq + j) * 1024 + 16 * g + fr];
    }
    for (int blk = 0; blk < 16; ++blk) {
        const size_t t0 = tok0 + (size_t)blk * 32;
        const bf16x8 ucur = ua;
        bf16_t ucuro[8];
        if (OUT) {
#pragma unroll
            for (int i = 0; i < 8; ++i) ucuro[i] = uo[i];
        }
        if (blk < 15) {
            ua = *(const bf16x8*)(UU + (t0 + 32 + n) * 1024 + 16 * g + 8 * hh);
            if (OUT) {
#pragma unroll
                for (int mt = 0; mt < 2; ++mt)
#pragma unroll
                    for (int j = 0; j < 4; ++j) uo[mt * 4 + j] = UU[(t0 + 32 + 16 * mt + 4 * fq + j) * 1024 + 16 * g + fr];
            }
        }
        f32x16 acc[4];
#pragma unroll
        for (int tl = 0; tl < 4; ++tl) {
            f32x16 z;
#pragma unroll
            for (int i = 0; i < 16; ++i) z[i] = 0.f;
            acc[tl] = __builtin_amdgcn_mfma_f32_32x32x16_bf16(ucur, C.BB[tl], z, 0, 0, 0);
        }
#pragma unroll
        for (int tp = 0; tp < 2; ++tp) {
            f32x16& re = acc[2 * tp]; f32x16& im = acc[2 * tp + 1];
            const float a1r = C.ar[tp][0], a1i = C.ai[tp][0];
#pragma unroll
            for (int q = 0; q < 4; ++q)
#pragma unroll
                for (int r = 1; r < 4; ++r) {
                    const float pr = re[4 * q + r - 1], pi = im[4 * q + r - 1];
                    re[4 * q + r] += a1r * pr - a1i * pi; im[4 * q + r] += a1r * pi + a1i * pr;
                }
            float cr = st[tp][0], ci = st[tp][1];
            const float a4r = C.ar[tp][3], a4i = C.ai[tp][3];
#pragma unroll
            for (int q = 0; q < 4; ++q) {
                const float tr = re[4 * q + 3] + a4r * cr - a4i * ci, ti = im[4 * q + 3] + a4r * ci + a4i * cr;
                const float o0r = bcast_lo(tr), o0i = bcast_lo(ti);
                const float xr = hh ? o0r : cr, xi = hh ? o0i : ci;
                if (OUT) {
#pragma unroll
                    for (int r = 0; r < 4; ++r) { const float kr = C.ar[tp][r], ki = C.ai[tp][r];
                        re[4 * q + r] += kr * xr - ki * xi; im[4 * q + r] += kr * xi + ki * xr; }
                } else {
                    re[4 * q + 3] += a4r * xr - a4i * xi; im[4 * q + 3] += a4r * xi + a4i * xr;
                }
                cr = bcast_hi(re[4 * q + 3]); ci = bcast_hi(im[4 * q + 3]);
            }
            st[tp][0] = cr; st[tp][1] = ci;
        }
        if (OUT) {
            asm volatile("s_waitcnt lgkmcnt(0)" ::: "memory");
#pragma unroll
            for (int tp = 0; tp < 2; ++tp)
#pragma unroll
                for (int i = 0; i < 16; ++i) {
                    const int t = 8 * (i >> 2) + 4 * hh + (i & 3);
                    *(unsigned*)(sX + t * 136 + 2 * (n + 32 * tp)) = pk2(acc[2 * tp][i], acc[2 * tp + 1][i]);
                }
            asm volatile("s_waitcnt lgkmcnt(0)" ::: "memory");
            __builtin_amdgcn_wave_barrier();
#pragma unroll
            for (int mt = 0; mt < 2; ++mt) {
                f32x4 y = (f32x4){0.f, 0.f, 0.f, 0.f};
#pragma unroll
                for (int ks = 0; ks < 4; ++ks) {
                    const bf16x8 xa = *(const bf16x8*)(sX + (16 * mt + fr) * 136 + 32 * ks + 8 * fq);
                    y = __builtin_amdgcn_mfma_f32_16x16x32_bf16(xa, C.CC[ks], y, 0, 0, 0);
                }
#pragma unroll
                for (int j = 0; j < 4; ++j) {
                    float v = y[j] + C.dco * bf2f(ucuro[mt * 4 + j]);
                    const float inner = 0.7978845608028654f * (v + 0.044715f * v * v * v);
                    v = v / (1.0f + __expf(-2.0f * inner));
                    UU[(t0 + 16 * mt + 4 * fq + j) * 1024 + 16 * g + fr] = f2bf(v);
                }
            }
            asm volatile("s_waitcnt lgkmcnt(0)" ::: "memory");
            __builtin_amdgcn_wave_barrier();
        }
    }
}

__device__ __forceinline__ void phase_s5(const Prm& p, unsigned char* lds, int bg) {
    const int b = bg >> 6, g = bg & 63;
    const int tid = threadIdx.x, wv = tid >> 6, lane = tid & 63, n = lane & 31, hh = lane >> 5, fr = lane & 15, fq = lane >> 4;
    bf16_t* sX = (bf16_t*)(lds + wv * 8704);
    float* sXE = (float*)(lds + 8 * 8704);
    bf16_t* UU = (bf16_t*)(p.ws + OFF_UU);
    const float* lam_re = p.in[8]; const float* lam_im = p.in[9]; const float* b_re = p.in[10]; const float* b_im = p.in[11];
    const float* c_re = p.in[12]; const float* c_im = p.in[13];
    S5C C;
    const double dt = exp_d((double)p.in[14][g]);
    float fre[2], fim[2];
#pragma unroll
    for (int tp = 0; tp < 2; ++tp) {
        const int pp = n + 32 * tp;
        const double lr = (double)fminf(lam_re[g * 64 + pp], -1e-4f), li = (double)lam_im[g * 64 + pp];
#pragma unroll
        for (int k = 0; k < 4; ++k) { double sn, cs; sincos_d(li * dt * (k + 1), sn, cs); const double mag = exp_d(lr * dt * (k + 1)); C.ar[tp][k] = (float)(mag * cs); C.ai[tp][k] = (float)(mag * sn); }
        { double sn, cs; sincos_d(li * dt * 512.0, sn, cs); const double mag = exp_d(lr * dt * 512.0); C.a512r[tp] = (float)(mag * cs); C.a512i[tp] = (float)(mag * sn); }
        double sn, cs; sincos_d(li * dt, sn, cs);
        const double mag = exp_d(lr * dt), abr = mag * cs, abi = mag * sn;
        const double den = lr * lr + li * li, nr = abr - 1.0, ni = abi;
        fre[tp] = (float)((nr * lr + ni * li) / den); fim[tp] = (float)((ni * lr - nr * li) / den);
    }
#pragma unroll
    for (int tl = 0; tl < 4; ++tl) {
        const int tp = tl >> 1, ri = tl & 1, pp = n + 32 * tp;
#pragma unroll
        for (int j = 0; j < 8; ++j) {
            const int ch = 8 * hh + j;
            const float br = b_re[(g * 64 + pp) * 16 + ch], bi = b_im[(g * 64 + pp) * 16 + ch];
            const float v = ri == 0 ? fre[tp] * br - fim[tp] * bi : fre[tp] * bi + fim[tp] * br;
            C.BB[tl][j] = (short)f2bf(v);
        }
    }
#pragma unroll
    for (int ks = 0; ks < 4; ++ks)
#pragma unroll
        for (int j = 0; j < 8; ++j) {
            const int k = 32 * ks + 8 * fq + j, pp = k >> 1, ri = k & 1;
            const float v = ri == 0 ? c_re[(g * 16 + fr) * 64 + pp] : -c_im[(g * 16 + fr) * 64 + pp];
            C.CC[ks][j] = (short)f2bf(v);
        }
    C.dco = p.in[15][16 * g + fr];
    for (int rd = 0; rd < 2; ++rd) {
        const int chunk = wv + 8 * rd;
        float st[2][2] = {{0.f, 0.f}, {0.f, 0.f}};
        s5_chunk<false>(C, UU, b, g, chunk, st, sX, lane);
        if (hh == 0) {
#pragma unroll
            for (int tp = 0; tp < 2; ++tp) { sXE[(chunk * 64 + n + 32 * tp) * 2 + 0] = st[tp][0]; sXE[(chunk * 64 + n + 32 * tp) * 2 + 1] = st[tp][1]; }
        }
    }
    __syncthreads();
    for (int rd = 0; rd < 2; ++rd) {
        const int chunk = wv + 8 * rd;
        float st[2][2] = {{0.f, 0.f}, {0.f, 0.f}};
        for (int c2 = 0; c2 < chunk; ++c2) {
#pragma unroll
            for (int tp = 0; tp < 2; ++tp) {
                const float er = sXE[(c2 * 64 + n + 32 * tp) * 2 + 0], ei = sXE[(c2 * 64 + n + 32 * tp) * 2 + 1];
                const float nr = C.a512r[tp] * st[tp][0] - C.a512i[tp] * st[tp][1] + er, ni = C.a512r[tp] * st[tp][1] + C.a512i[tp] * st[tp][0] + ei;
                st[tp][0] = nr; st[tp][1] = ni;
            }
        }
        s5_chunk<true>(C, UU, b, g, chunk, st, sX, lane);
    }
    __syncthreads();
}

__device__ __forceinline__ void phase_gdn_prep(const Prm& p, unsigned char* lds, int it0, int nrounds) {
    const int tid0 = threadIdx.x, hb = tid0 >> 8;
    unsigned char* base = lds + hb * 76800;
    bf16_t* sQ = (bf16_t*)base;
    bf16_t* sK = (bf16_t*)(base + 17408);
    bf16_t* sV = (bf16_t*)(base + 2 * 17408);
    float* sL = (float*)(base + 3 * 17408);
    float* sBeta = (float*)(base + 4 * 17408);
    float* sGc = sBeta + 64; float* sEg = sGc + 64; float* sBE = sEg + 64;
    float* sCW = sBE + 64;
    bf16_t* QKV = (bf16_t*)(p.ws + OFF_QKV); const bf16_t* HALO = (const bf16_t*)(p.ws + OFF_HALO);
    const float* BA = (const float*)(p.ws + OFF_BA); float* GL = (float*)(p.ws + OFF_GL);
    bf16_t* WB = (bf16_t*)(p.ws + OFF_WB); bf16_t* ATT = (bf16_t*)(p.ws + OFF_ATT);
    const float* convw = p.in[4];
    for (int rd = 0; rd < nrounds; ++rd) {
        int tid = tid0; asm volatile("" : "+v"(tid));
        const int ht = tid & 255, hw = (tid >> 6) & 3, lane = tid & 63, fr = lane & 15, fq = lane >> 4;
        const int it = it0 + rd * 2 + hb;
        const int b = it >> 10, h = (it >> 7) & 7, nc = it & 127;
        const size_t tokb = (size_t)b * SEQ + (size_t)nc * 64;
#pragma unroll
        for (int i = 0; i < 6; ++i) { const int idx = ht + 256 * i, s3 = idx >> 9, tap = (idx >> 7) & 3, ch = idx & 127; sCW[idx] = convw[tap * 3072 + s3 * 1024 + h * 128 + ch]; }
        __syncthreads();
        {
            const int t = ht >> 2, cg4 = ht & 3;
#pragma unroll 1
            for (int s = 0; s < 3; ++s) {
                const int col = s * 1024 + h * 128 + cg4 * 32;
                float o[32]; float ss = 0.f;
#pragma unroll
                for (int c8 = 0; c8 < 4; ++c8) {
                    float a[8];
#pragma unroll
                    for (int e = 0; e < 8; ++e) a[e] = 0.f;
#pragma unroll
                    for (int d = 0; d < 4; ++d) {
                        const int tt = t - d;
                        u32x4 xv = (u32x4){0u, 0u, 0u, 0u};
                        if (tt >= 0) xv = *(const u32x4*)(QKV + (tokb + tt) * 3072 + col + c8 * 8);
                        else if (nc > 0) xv = *(const u32x4*)(HALO + ((size_t)(b * 128 + nc - 1) * 3 + (3 + tt)) * 3072 + col + c8 * 8);
                        const f32x4 w0 = *(const f32x4*)(sCW + s * 512 + (3 - d) * 128 + cg4 * 32 + c8 * 8), w1 = *(const f32x4*)(sCW + s * 512 + (3 - d) * 128 + cg4 * 32 + c8 * 8 + 4);
                        a[0] += w0[0] * lo2f(xv.x); a[1] += w0[1] * hi2f(xv.x); a[2] += w0[2] * lo2f(xv.y); a[3] += w0[3] * hi2f(xv.y);
                        a[4] += w1[0] * lo2f(xv.z); a[5] += w1[1] * hi2f(xv.z); a[6] += w1[2] * lo2f(xv.w); a[7] += w1[3] * hi2f(xv.w);
                    }
#pragma unroll
                    for (int e = 0; e < 8; ++e) { const float v = siluf_(a[e]); o[c8 * 8 + e] = v; ss += v * v; }
                }
                float sc = 1.0f;
                if (s < 2) { ss += __shfl_xor(ss, 1); ss += __shfl_xor(ss, 2); sc = rsqrtf(ss + 1e-6f) * (s == 0 ? 0.08838834764831845f : 1.0f); }
                bf16_t* dst = (s == 0 ? sQ : (s == 1 ? sK : sV)) + t * 136 + cg4 * 32;
#pragma unroll
                for (int c8 = 0; c8 < 4; ++c8) { u32x4 pk;
                    pk.x = pk2(o[c8 * 8 + 0] * sc, o[c8 * 8 + 1] * sc); pk.y = pk2(o[c8 * 8 + 2] * sc, o[c8 * 8 + 3] * sc);
                    pk.z = pk2(o[c8 * 8 + 4] * sc, o[c8 * 8 + 5] * sc); pk.w = pk2(o[c8 * 8 + 6] * sc, o[c8 * 8 + 7] * sc);
                    *(u32x4*)(dst + c8 * 8) = pk; }
            }
        }
        if (hw == 0) {
            const size_t tg = tokb + lane;
            const float braw = BA[tg * 16 + h], araw = BA[tg * 16 + 8 + h];
            const float beta = 1.0f / (1.0f + expf(-braw));
            const float xx = araw + p.in[6][h];
            const float sp = xx > 20.f ? xx : log1pf(expf(xx));
            float gg = -expf(p.in[5][h]) * sp;
#pragma unroll
            for (int off = 1; off < 64; off <<= 1) { const float o = __shfl_up(gg, off); if (lane >= off) gg += o; }
            sBeta[lane] = beta; sGc[lane] = gg; sEg[lane] = expf(gg); sBE[lane] = beta * expf(gg);
            if (lane == 63) GL[it] = expf(gg);
        }
        __syncthreads();
        {
            bf16x8 aK[4], aQ[4];
#pragma unroll
            for (int ks = 0; ks < 4; ++ks) { aK[ks] = *(const bf16x8*)(sK + (16 * hw + fr) * 136 + 32 * ks + 8 * fq); aQ[ks] = *(const bf16x8*)(sQ + (16 * hw + fr) * 136 + 32 * ks + 8 * fq); }
#pragma unroll
            for (int nt = 0; nt < 4; ++nt) {
                f32x4 kk = (f32x4){0.f, 0.f, 0.f, 0.f}, qk = (f32x4){0.f, 0.f, 0.f, 0.f};
#pragma unroll
                for (int ks = 0; ks < 4; ++ks) {
                    const bf16x8 bK = *(const bf16x8*)(sK + (16 * nt + fr) * 136 + 32 * ks + 8 * fq);
                    kk = __builtin_amdgcn_mfma_f32_16x16x32_bf16(aK[ks], bK, kk, 0, 0, 0);
                    qk = __builtin_amdgcn_mfma_f32_16x16x32_bf16(aQ[ks], bK, qk, 0, 0, 0);
                }
                const int mcol = 16 * nt + fr; const float gm = sGc[mcol];
#pragma unroll
                for (int j = 0; j < 4; ++j) {
                    const int c = 16 * hw + 4 * fq + j;
                    const float dec = __expf(fminf(sGc[c] - gm, 0.f));
                    sL[c * 68 + mcol] = (mcol < c) ? kk[j] * sBeta[c] * dec : 0.f;
                    ATT[(size_t)it * 4096 + c * 64 + mcol] = f2bf((mcol <= c) ? qk[j] * dec : 0.f);
                }
            }
        }
        __syncthreads();
        {
            float x[64];
            const bool isU = ht < 128; const int jc = ht & 127;
            const bf16_t* src = isU ? sV : sK;
            const float* fac = isU ? sBeta : sBE;
#pragma unroll
            for (int cb = 0; cb < 16; ++cb) {
                float a[4];
#pragma unroll
                for (int r = 0; r < 4; ++r) a[r] = bf2f(src[(4 * cb + r) * 136 + jc]) * fac[4 * cb + r];
#pragma unroll
                for (int m4 = 0; m4 < cb; ++m4)
#pragma unroll
                    for (int r = 0; r < 4; ++r) {
                        const f32x4 l = *(const f32x4*)(sL + (4 * cb + r) * 68 + 4 * m4);
                        a[r] -= l[0] * x[4 * m4] + l[1] * x[4 * m4 + 1] + l[2] * x[4 * m4 + 2] + l[3] * x[4 * m4 + 3];
                    }
                const f32x4 d1 = *(const f32x4*)(sL + (4 * cb + 1) * 68 + 4 * cb), d2 = *(const f32x4*)(sL + (4 * cb + 2) * 68 + 4 * cb), d3 = *(const f32x4*)(sL + (4 * cb + 3) * 68 + 4 * cb);
                x[4 * cb] = a[0];
                x[4 * cb + 1] = a[1] - d1[0] * x[4 * cb];
                x[4 * cb + 2] = a[2] - d2[0] * x[4 * cb] - d2[1] * x[4 * cb + 1];
                x[4 * cb + 3] = a[3] - d3[0] * x[4 * cb] - d3[1] * x[4 * cb + 1] - d3[2] * x[4 * cb + 2];
            }
            if (isU) {
                const int w8 = jc >> 4, nn = jc & 15;
#pragma unroll
                for (int rq = 0; rq < 4; ++rq)
#pragma unroll
                    for (int pc = 0; pc < 2; ++pc) {
                        const int c0 = 32 * pc + 4 * rq;
                        u32x4 o; o.x = pk2(x[c0 + 0], x[c0 + 1]); o.y = pk2(x[c0 + 2], x[c0 + 3]); o.z = pk2(x[c0 + 16], x[c0 + 17]); o.w = pk2(x[c0 + 18], x[c0 + 19]);
                        const int L = ((w8 * 2 + pc) * 64 + rq * 16 + nn) * 8;
                        *(u32x4*)(QKV + (tokb + (L >> 7)) * 3072 + 2048 + h * 128 + (L & 127)) = o;
                    }
            }
            __syncthreads();
            if (!isU) {
                bf16_t* sW2 = (bf16_t*)sL;
#pragma unroll
                for (int c = 0; c < 64; ++c) sW2[c * 136 + jc] = f2bf(-x[c]);
            }
        }
        __syncthreads();
        {
            const bf16_t* sW2 = (const bf16_t*)sL;
#pragma unroll
            for (int i = 0; i < 4; ++i) { const int ch = ht + 256 * i, r = ch >> 4, c8 = (ch & 15) * 8; *(u32x4*)(WB + (size_t)it * 8192 + r * 128 + c8) = *(const u32x4*)(sW2 + r * 136 + c8); }
        }
        {
            const int c = ht >> 2, ds = (ht & 3) * 32; const float eg = sEg[c];
#pragma unroll
            for (int c8 = 0; c8 < 4; ++c8) {
                const u32x4 v = *(const u32x4*)(sQ + c * 136 + ds + c8 * 8); u32x4 o;
                o.x = pk2(lo2f(v.x) * eg, hi2f(v.x) * eg); o.y = pk2(lo2f(v.y) * eg, hi2f(v.y) * eg); o.z = pk2(lo2f(v.z) * eg, hi2f(v.z) * eg); o.w = pk2(lo2f(v.w) * eg, hi2f(v.w) * eg);
                *(u32x4*)(QKV + (tokb + c) * 3072 + h * 128 + ds + c8 * 8) = o;
            }
            const int d = ht >> 1, cs = (ht & 1) * 32; const float gl = sGc[63];
#pragma unroll
            for (int c8 = 0; c8 < 4; ++c8) {
                float v[8];
#pragma unroll
                for (int e = 0; e < 8; ++e) { const int cc = cs + c8 * 8 + e; v[e] = bf2f(sK[cc * 136 + d]) * __expf(gl - sGc[cc]); }
                u32x4 o; o.x = pk2(v[0], v[1]); o.y = pk2(v[2], v[3]); o.z = pk2(v[4], v[5]); o.w = pk2(v[6], v[7]);
                *(u32x4*)(QKV + (tokb + (d >> 1)) * 3072 + 1024 + h * 128 + (d & 1) * 64 + cs + c8 * 8) = o;
            }
        }
        __syncthreads();
    }
}

constexpr int SC_RW = 288, SC_RK = 160;
constexpr int SC_QD = 64 * SC_RW, SC_KT = 2 * 64 * SC_RW, SC_AT = SC_KT + 128 * SC_RK, SC_U = SC_AT + 64 * SC_RK, SC_STAGE = SC_U + 8192;
static_assert(2 * SC_STAGE <= LDS_BYTES && SC_U % 16 == 0 && SC_STAGE % 16 == 0, "scan LDS layout");
struct ScanRegs { u32x4 rw[4], rq[4], rk[4], ru[2], ra[2]; };
__device__ __forceinline__ void scan_load(ScanRegs& R, const bf16_t* QKV, const bf16_t* WB, const bf16_t* ATT, int b, int h, int jh, int it, int nc, int lt) {
    const size_t tokb = (size_t)b * SEQ + (size_t)nc * 64;
#pragma unroll
    for (int i = 0; i < 4; ++i) { const int ch = lt + 256 * i, r = ch >> 4, c8 = (ch & 15) * 8;
        R.rw[i] = *(const u32x4*)(WB + (size_t)it * 8192 + r * 128 + c8);
        const bf16_t* qp = QKV + (tokb + r) * 3072 + h * 128 + c8;
        R.rq[i] = *(const u32x4*)(qp); R.rk[i] = *(const u32x4*)(qp + 1024); }
#pragma unroll
    for (int i = 0; i < 2; ++i) { const int ch = lt + 256 * i; R.ra[i] = *(const u32x4*)(ATT + (size_t)it * 4096 + ch * 8);
        const int L = jh * 4096 + ch * 8; R.ru[i] = *(const u32x4*)(QKV + (tokb + (L >> 7)) * 3072 + 2048 + h * 128 + (L & 127)); }
}
__device__ __forceinline__ void st32p(unsigned char* rowp, int g, u32x4 v) {
    const int pt = g & 3; unsigned char* p = rowp + 64 * (g >> 2) + 32 * (pt & 1) + 8 * (pt >> 1);
    *(u32x2*)p = (u32x2){v.x, v.y}; *(u32x2*)(p + 16) = (u32x2){v.z, v.w};
}
__device__ __forceinline__ void scan_store(const ScanRegs& R, unsigned char* sbp, int lt) {
#pragma unroll
    for (int i = 0; i < 4; ++i) { const int ch = lt + 256 * i, r = ch >> 4, g = ch & 15;
        st32p(sbp + r * SC_RW, g, R.rw[i]);
        st32p(sbp + SC_QD + r * SC_RW, g, R.rq[i]);
        const int d = 2 * r + (g >> 3), gk = g & 7;
        st32p(sbp + SC_KT + d * SC_RK, gk, R.rk[i]); }
#pragma unroll
    for (int i = 0; i < 2; ++i) { const int ch = lt + 256 * i, r = ch >> 3, g = ch & 7; st32p(sbp + SC_AT + r * SC_RK, g, R.ra[i]); *(u32x4*)(sbp + SC_U + ch * 16) = R.ru[i]; }
}
__device__ __forceinline__ bf16x8 pack2(const f32x4& a, const f32x4& b) {
    u32x4 r; r.x = pk2(a[0], a[1]); r.y = pk2(a[2], a[3]); r.z = pk2(b[0], b[1]); r.w = pk2(b[2], b[3]); return __builtin_bit_cast(bf16x8, r);
}
#define SCAN_BAR() do { asm volatile("s_waitcnt lgkmcnt(0)" ::: "memory"); __builtin_amdgcn_s_barrier(); asm volatile("" ::: "memory"); } while (0)
#define MF16(a, b, c) __builtin_amdgcn_mfma_f32_16x16x32_bf16(a, b, c, 0, 0, 0)
__device__ __forceinline__ void phase_gdn_scan(const Prm& p, unsigned char* lds, int blk) {
    const int tid = threadIdx.x, wv = tid >> 6, lane = tid & 63, n = lane & 15, kq = lane >> 4;
    const int bh = blk >> 1, jh = blk & 1, b = bh >> 3, h = bh & 7;
    const bf16_t* QKV = (const bf16_t*)(p.ws + OFF_QKV); const bf16_t* WB = (const bf16_t*)(p.ws + OFF_WB); const bf16_t* ATT = (const bf16_t*)(p.ws + OFF_ATT);
    const float* GL = (const float*)(p.ws + OFF_GL); bf16_t* O = (bf16_t*)(p.ws + OFF_H);
    const int itb = bh * 128;
    if (wv >= 4) {
        const int lt = tid - 256;
        ScanRegs RA, RB;
        scan_load(RA, QKV, WB, ATT, b, h, jh, itb, 0, lt);
        scan_store(RA, lds, lt);
        __builtin_amdgcn_sched_barrier(0);
        scan_load(RA, QKV, WB, ATT, b, h, jh, itb + 1, 1, lt);
        __builtin_amdgcn_sched_barrier(0);
        scan_load(RB, QKV, WB, ATT, b, h, jh, itb + 2, 2, lt);
        __builtin_amdgcn_sched_barrier(0);
        SCAN_BAR();
        for (int nc = 0; nc < 128; nc += 2) {
            __builtin_amdgcn_sched_barrier(0);
            scan_store(RA, lds + SC_STAGE, lt);
            __builtin_amdgcn_sched_barrier(0);
            { const int c3 = nc + 3 < 128 ? nc + 3 : 127; scan_load(RA, QKV, WB, ATT, b, h, jh, itb + c3, c3, lt); }
            __builtin_amdgcn_sched_barrier(0);
            SCAN_BAR();
            __builtin_amdgcn_sched_barrier(0);
            scan_store(RB, lds, lt);
            __builtin_amdgcn_sched_barrier(0);
            { const int c4 = nc + 4 < 128 ? nc + 4 : 127; scan_load(RB, QKV, WB, ATT, b, h, jh, itb + c4, c4, lt); }
            SCAN_BAR();
        }
    } else {
        const float gl0 = GL[itb + lane], gl1 = GL[itb + 64 + lane];
        f32x4 S[8];
#pragma unroll
        for (int dt = 0; dt < 8; ++dt) S[dt] = (f32x4){0.f, 0.f, 0.f, 0.f};
        const int e = 64 * jh + 16 * wv + n;
        SCAN_BAR();
        for (int nc = 0; nc < 128; ++nc) {
            const unsigned char* sbp = lds + (nc & 1) * SC_STAGE;
            const float gl = __builtin_bit_cast(float, __builtin_amdgcn_readlane(__builtin_bit_cast(int, nc < 64 ? gl0 : gl1), nc & 63));
            const unsigned char* pw = sbp + n * SC_RW + 16 * kq;
            const unsigned char* pk = sbp + SC_KT + n * SC_RK + 16 * kq;
            f32x4 V[4], Oa[4];
#pragma unroll
            for (int pc = 0; pc < 2; ++pc) {
                const u32x4 uu = *(const u32x4*)(sbp + SC_U + ((wv * 2 + pc) * 64 + lane) * 16);
                V[2 * pc] = (f32x4){lo2f(uu.x), hi2f(uu.x), lo2f(uu.y), hi2f(uu.y)}; V[2 * pc + 1] = (f32x4){lo2f(uu.z), hi2f(uu.z), lo2f(uu.w), hi2f(uu.w)};
            }
#pragma unroll
            for (int ct = 0; ct < 4; ++ct) Oa[ct] = (f32x4){0.f, 0.f, 0.f, 0.f};
            bf16x8 fa[2][8];
#define LD_WQ(dst, ks_) do { _Pragma("unroll") for (int mt = 0; mt < 4; ++mt) { dst[mt] = *(const bf16x8*)(pw + mt * 16 * SC_RW + 64 * (ks_)); dst[4 + mt] = *(const bf16x8*)(pw + SC_QD + mt * 16 * SC_RW + 64 * (ks_)); } } while (0)
            LD_WQ(fa[0], 0);
#pragma unroll
            for (int ks = 0; ks < 4; ++ks) {
                if (ks < 3) LD_WQ(fa[(ks + 1) & 1], ks + 1);
                const bf16x8 sb8 = pack2(S[2 * ks], S[2 * ks + 1]);
                __builtin_amdgcn_sched_barrier(0);
#pragma unroll
                for (int mt = 0; mt < 4; ++mt) { V[mt] = MF16(fa[ks & 1][mt], sb8, V[mt]); Oa[mt] = MF16(fa[ks & 1][4 + mt], sb8, Oa[mt]); }
                __builtin_amdgcn_sched_barrier(0);
            }
#undef LD_WQ
            bf16x8 fb[2][12];
#define LD_AK(dst, k2_) do { _Pragma("unroll") for (int mt = 0; mt < 4; ++mt) dst[mt] = *(const bf16x8*)(pk + (SC_AT - SC_KT) + mt * 16 * SC_RK + 64 * (k2_)); \
                             _Pragma("unroll") for (int dt = 0; dt < 8; ++dt) dst[4 + dt] = *(const bf16x8*)(pk + dt * 16 * SC_RK + 64 * (k2_)); } while (0)
            LD_AK(fb[0], 0);
            bf16x8 Vb[2];
            Vb[0] = pack2(V[0], V[1]); Vb[1] = pack2(V[2], V[3]);
#pragma unroll
            for (int dt = 0; dt < 8; ++dt) S[dt] *= gl;
#pragma unroll
            for (int k2 = 0; k2 < 2; ++k2) {
                if (k2 < 1) LD_AK(fb[1], 1);
                __builtin_amdgcn_sched_barrier(0);
#pragma unroll
                for (int mt = 0; mt < 4; ++mt) Oa[mt] = MF16(fb[k2][mt], Vb[k2], Oa[mt]);
#pragma unroll
                for (int dt = 0; dt < 8; ++dt) S[dt] = MF16(fb[k2][4 + dt], Vb[k2], S[dt]);
                __builtin_amdgcn_sched_barrier(0);
            }
#undef LD_AK
            bf16_t* obase = O + (size_t)(itb + nc) * 8192 + e * 64 + 4 * kq;
#pragma unroll
            for (int ct = 0; ct < 4; ++ct) { u32x2 o2; o2.x = pk2(Oa[ct][0], Oa[ct][1]); o2.y = pk2(Oa[ct][2], Oa[ct][3]); *(u32x2*)(obase + 16 * ct) = o2; }
            SCAN_BAR();
        }
    }
    __syncthreads();
}

__device__ __forceinline__ void phase_ya(const Prm& p, unsigned char* lds) {
    const bf16_t* OT = (const bf16_t*)(p.ws + OFF_H); bf16_t* SZA = (bf16_t*)p.out;
    const float* gw = p.in[7];
    bf16_t* sT = (bf16_t*)lds;
    float* sPart = (float*)(lds + 16384);
    const int tid = threadIdx.x, w = tid >> 6, c = tid & 63;
    for (int it = blockIdx.x; it < NIT; it += gridDim.x) {
        const int b = it >> 10, h = (it >> 7) & 7, nc = it & 127;
        const size_t tok = (size_t)b * SEQ + (size_t)nc * 64 + c;
#pragma unroll
        for (int i = 0; i < 2; ++i) { const int ch = tid + 512 * i; *(u32x4*)(sT + ch * 8) = *(const u32x4*)(OT + (size_t)it * 8192 + ch * 8); }
        const u32x4 z0 = *(const u32x4*)(SZA + tok * 1024 + h * 128 + 16 * w), z1 = *(const u32x4*)(SZA + tok * 1024 + h * 128 + 16 * w + 8);
        __syncthreads();
        float o[16]; float ss = 0.f;
#pragma unroll
        for (int j = 0; j < 16; ++j) { o[j] = bf2f(sT[(16 * w + j) * 64 + c]); ss += o[j] * o[j]; }
        sPart[w * 64 + c] = ss;
        __syncthreads();
        float tot = 0.f;
#pragma unroll
        for (int k = 0; k < 8; ++k) tot += sPart[k * 64 + c];
        const float rstd = rsqrtf(tot * (1.0f / 128.0f) + 1e-6f);
        const unsigned zz[8] = {z0.x, z0.y, z0.z, z0.w, z1.x, z1.y, z1.z, z1.w};
        unsigned r[8];
#pragma unroll
        for (int j = 0; j < 8; ++j)
            r[j] = pk2(o[2 * j] * rstd * gw[16 * w + 2 * j] * lo2f(zz[j]), o[2 * j + 1] * rstd * gw[16 * w + 2 * j + 1] * hi2f(zz[j]));
        *(u32x4*)(SZA + tok * 1024 + h * 128 + 16 * w) = (u32x4){r[0], r[1], r[2], r[3]};
        *(u32x4*)(SZA + tok * 1024 + h * 128 + 16 * w + 8) = (u32x4){r[4], r[5], r[6], r[7]};
        __syncthreads();
    }
}
__device__ __forceinline__ void phase_conv3(const Prm& p) {
    const bf16_t* P = (const bf16_t*)(p.ws + OFF_P); bf16_t* Q = (bf16_t*)(p.ws + OFF_Q); const float* cw = p.in[19];
    const int nth = gridDim.x * 512;
    for (int idx = blockIdx.x * 512 + threadIdx.x; idx < TOK * 256; idx += nth) {
        const int t = idx >> 8, c8 = (idx & 255) * 8, ts = t & (SEQ - 1);
        const u32x4 z4 = (u32x4){0u, 0u, 0u, 0u};
        const u32x4 p0 = *(const u32x4*)(P + (size_t)t * 2048 + c8);
        const u32x4 p1 = ts >= 1 ? *(const u32x4*)(P + (size_t)(t - 1) * 2048 + c8) : z4;
        const u32x4 p2 = ts >= 2 ? *(const u32x4*)(P + (size_t)(t - 2) * 2048 + c8) : z4;
        const u32x4 q = *(const u32x4*)(Q + (size_t)t * 2048 + c8);
        float r[8];
        const unsigned pa[4] = {p0.x, p0.y, p0.z, p0.w}, pb[4] = {p1.x, p1.y, p1.z, p1.w}, pc[4] = {p2.x, p2.y, p2.z, p2.w}, qa[4] = {q.x, q.y, q.z, q.w};
#pragma unroll
        for (int e = 0; e < 4; ++e) {
            const int c = c8 + 2 * e;
            r[2 * e] = lo2f(qa[e]) * (cw[c] * lo2f(pc[e]) + cw[2048 + c] * lo2f(pb[e]) + cw[4096 + c] * lo2f(pa[e]));
            r[2 * e + 1] = hi2f(qa[e]) * (cw[c + 1] * hi2f(pc[e]) + cw[2048 + c + 1] * hi2f(pb[e]) + cw[4096 + c + 1] * hi2f(pa[e]));
        }
        u32x4 o; o.x = pk2(r[0], r[1]); o.y = pk2(r[2], r[3]); o.z = pk2(r[4], r[5]); o.w = pk2(r[6], r[7]);
        *(u32x4*)(Q + (size_t)t * 2048 + c8) = o;
    }
}

#define XB_TMO      128
#define XB_XCNT(j)  (256  + 64 * (j))
#define XB_XSUB(j)  (1280 + 64 * (j))
#define XB_XGEN(j)  (2304 + 64 * (j))
#define XB_TOP      3328
#define XB_TOPGEN   3392
#define XCD_BAR_WORDS 3456
#define XB_SPIN_CAP (1u << 18)

__device__ __forceinline__ unsigned xb_ld(unsigned* p)              { return __hip_atomic_load(p, __ATOMIC_RELAXED, __HIP_MEMORY_SCOPE_AGENT); }
__device__ __forceinline__ unsigned xb_add(unsigned* p, unsigned v) { return __hip_atomic_fetch_add(p, v, __ATOMIC_RELAXED, __HIP_MEMORY_SCOPE_AGENT); }
__device__ __forceinline__ unsigned xb_xcc_id() { return (unsigned)__builtin_amdgcn_s_getreg((3 << 11) | 20) & 0xFu; }
#define XB_SPIN(cond, bar) do { unsigned _sp = 0; while (cond) { __builtin_amdgcn_s_sleep(1); \
    if ((++_sp & 255u) == 0u) { if (xb_ld(&(bar)[XB_TMO])) break; if (_sp > XB_SPIN_CAP) { atomicAdd(&(bar)[XB_TMO], 1u); break; } } } } while (0)

struct XcdBarrier {
    unsigned* bar; unsigned x;
    volatile LAS unsigned* st;
};

__device__ __forceinline__ XcdBarrier xcd_barrier_post(unsigned* bar, volatile LAS unsigned* st) {
    XcdBarrier b; b.bar = bar; b.x = xb_xcc_id(); b.st = st;
    if (threadIdx.x == 0) (void)xb_add(&bar[XB_XCNT(b.x)], 1u);
    return b;
}
__device__ __forceinline__ void xcd_barrier_complete(unsigned* bar, unsigned x, unsigned& nloc, unsigned& nx) {
    const unsigned G = gridDim.x * gridDim.y * gridDim.z;
    unsigned sum, cnt, mine, sp = 0u;
    for (;;) {
        sum = 0u; cnt = 0u; mine = 0u;
#pragma unroll
        for (unsigned j = 0; j < 16; ++j) { const unsigned c = xb_ld(&bar[XB_XCNT(j)]); sum += c; cnt += (c > 0u) ? 1u : 0u; mine = (j == x) ? c : mine; }
        if (sum == G) break;
        __builtin_amdgcn_s_sleep(1);
        if ((++sp & 255u) == 0u) { if (xb_ld(&bar[XB_TMO])) break; if (sp > XB_SPIN_CAP) { atomicAdd(&bar[XB_TMO], 1u); break; } }
    }
    nloc = mine > 0u ? mine : 1u; nx = cnt > 0u ? cnt : 1u;
}

__device__ __forceinline__ void xcd_barrier(const XcdBarrier& b) {
    asm volatile("s_waitcnt vmcnt(0)" ::: "memory");
    __syncthreads();
    if (threadIdx.x == 0) {
        unsigned* bar = b.bar;
        __builtin_amdgcn_s_waitcnt(0);
        unsigned nloc = b.st[0], nx = b.st[1];
        if (nloc == 0u) { xcd_barrier_complete(bar, b.x, nloc, nx); b.st[0] = nloc; b.st[1] = nx; }
        const unsigned old = xb_add(&bar[XB_XSUB(b.x)], 1u);
        const unsigned gen = old / nloc;
        if (old + 1u == (gen + 1u) * nloc) {
            __builtin_amdgcn_fence(__ATOMIC_RELEASE, "agent");
            asm volatile("s_waitcnt vmcnt(0)" ::: "memory");
            const unsigned og = xb_add(&bar[XB_TOP], 1u);
            const unsigned tg = og / nx;
            if (og + 1u == (tg + 1u) * nx) xb_add(&bar[XB_TOPGEN], 1u);
            else XB_SPIN(xb_ld(&bar[XB_TOPGEN]) == tg, bar);
            __builtin_amdgcn_fence(__ATOMIC_ACQUIRE, "agent");
            xb_add(&bar[XB_XGEN(b.x)], 1u);
            asm volatile("s_waitcnt vmcnt(0)" ::: "memory");
        } else {
            XB_SPIN(xb_ld(&bar[XB_XGEN(b.x)]) == gen, bar);
            __builtin_amdgcn_fence(__ATOMIC_ACQUIRE, "agent");
            asm volatile("s_waitcnt vmcnt(0)" ::: "memory");
        }
    }
    __syncthreads();
}

constexpr int NPHASE = 11;
#define REP_GEMM 1
#define REP_SYNC 1
#define REP_SCAN 1
#define SCAN_PROBE 1
#define REP_P0 1
#ifndef PHM
#define PHM 0x7FF
#endif
__global__ void __launch_bounds__(512, 2) mega(Prm p) {
    extern __shared__ __attribute__((aligned(16))) unsigned char shm[];
    LAS unsigned char* lds3 = (LAS unsigned char*)shm;
    unsigned char* ws = p.ws;
    volatile LAS unsigned* xst = (volatile LAS unsigned*)(lds3 + LDS_BYTES);
    if (threadIdx.x == 0) { xst[0] = 0u; xst[1] = 0u; }
    __syncthreads();
    XcdBarrier xb{};
    const bool multi = (p.ph_hi - p.ph_lo) > 1;
    if (multi) xb = xcd_barrier_post((unsigned*)(ws + OFF_BAR), xst);
    if (p.ph_lo < 0) cg::this_grid().sync();
#define PH_BEGIN(i) if (((PHM >> (i)) & 1) && p.ph_lo <= (i) && (i) < p.ph_hi) { if ((i) > p.ph_lo) { xcd_barrier(xb); if (REP_SYNC > 1) xcd_barrier(xb); } pg8::StaticOrder S; (void)S;
#define PH_END }
    PH_BEGIN(0)
        for (int rep = 0; rep < REP_P0; ++rep) {
        phase_convert(p, shm, 0, 1856, gridDim.x, blockIdx.x);
        phase_rmsnorm_x(p.in[0], p.in[1], (bf16_t*)(ws + OFF_H)); __syncthreads(); }
    PH_END
    PH_BEGIN(1)
        pg8::Gemm g{(const bf16_t*)(ws + OFF_H), (const bf16_t*)(ws + OFF_WT1), TOK, NP1, 1024, (const bf16_t*)(ws + OFF_H), 1024, 64};
        Epi1 E{(bf16_t*)(ws + OFF_QKV), (bf16_t*)p.out, (bf16_t*)(ws + OFF_UU), (bf16_t*)p.out + (size_t)TOK * 1024, (float*)(ws + OFF_BA), (bf16_t*)(ws + OFF_HALO)};
        S.init(TOK, NP1, gridDim.x, blockIdx.x); for (int rep = 0; rep < REP_GEMM; ++rep) { pg8::gemm_phase(lds3, g, S, E); __syncthreads(); }
    PH_END
    PH_BEGIN(2)
        {
            unsigned* ctr = (unsigned*)(ws + OFF_BAR) + 3600;
            volatile LAS unsigned* sIt = xst + 2;
            for (;;) {
                if (threadIdx.x == 0) sIt[0] = __hip_atomic_fetch_add(ctr, 2u, __ATOMIC_RELAXED, __HIP_MEMORY_SCOPE_AGENT);
                __syncthreads();
                const unsigned it0 = sIt[0];
                __syncthreads();
                if (it0 >= (unsigned)NIT) break;
                phase_gdn_prep(p, shm, (int)it0, 1);
            }
        }
    PH_END
    PH_BEGIN(3)
        if (blockIdx.x < 32) phase_gdn_scan(p, shm, blockIdx.x);
        else {
            const int ob = blockIdx.x - 32, nob = gridDim.x - 32;
            if (ob < 128) phase_s5(p, shm, ob);
            {
                unsigned* cnt = (unsigned*)(ws + OFF_BAR) + 3700;
                asm volatile("s_waitcnt vmcnt(0)" ::: "memory");
                __syncthreads();
                if (threadIdx.x == 0) {
                    __builtin_amdgcn_fence(__ATOMIC_RELEASE, "agent");
                    asm volatile("s_waitcnt vmcnt(0)" ::: "memory");
                    __hip_atomic_fetch_add(cnt, 1u, __ATOMIC_RELAXED, __HIP_MEMORY_SCOPE_AGENT);
                    unsigned sp = 0;
                    while (__hip_atomic_load(cnt, __ATOMIC_RELAXED, __HIP_MEMORY_SCOPE_AGENT) < (unsigned)nob) { __builtin_amdgcn_s_sleep(2); if (++sp > (1u << 22)) break; }
                    __builtin_amdgcn_fence(__ATOMIC_ACQUIRE, "agent");
                    asm volatile("s_waitcnt vmcnt(0)" ::: "memory");
                }
                __syncthreads();
            }
            pg8::Gemm g{(const bf16_t*)(ws + OFF_UU), (const bf16_t*)(ws + OFF_WTG), TOK, 1024, 1024, (const bf16_t*)(ws + OFF_UU), 1024, 64};
            EpiGlu E{(const bf16_t*)(ws + OFF_UU), (bf16_t*)p.out + (size_t)TOK * 1024};
            S.init(TOK, 1024, nob, ob); pg8::gemm_phase(lds3, g, S, E);
            __syncthreads();
            if (ob >= 32) phase_convert(p, shm, 1856, 4928, nob - 32, ob - 32);
        }
    PH_END
    PH_BEGIN(4)
        phase_ya(p, shm);
    PH_END
    PH_BEGIN(5)
        pg8::Gemm g{(const bf16_t*)p.out, (const bf16_t*)(ws + OFF_WTO0), TOK, 1024, 2048, (const bf16_t*)p.out + (size_t)TOK * 1024, 1024, 16};
        EpiF32 E{(float*)(ws + OFF_QKV)};
        S.init(TOK, 1024, gridDim.x, blockIdx.x); for (int rep = 0; rep < REP_GEMM; ++rep) { pg8::gemm_phase(lds3, g, S, E); __syncthreads(); }
    PH_END
    PH_BEGIN(6)
        phase_post<true>(p.in[0], (const float*)(ws + OFF_QKV), p.in[2], p.out, p.in[1] + 1024, (bf16_t*)(ws + OFF_H));
    PH_END
    PH_BEGIN(7)
        pg8::Gemm g{(const bf16_t*)(ws + OFF_H), (const bf16_t*)(ws + OFF_WT2), TOK, 8192, 1024, (const bf16_t*)(ws + OFF_H), 1024, 64};
        Epi2 E{(bf16_t*)(ws + OFF_P), (bf16_t*)(ws + OFF_Q)};
        S.init(TOK, 8192, gridDim.x, blockIdx.x); for (int rep = 0; rep < REP_GEMM; ++rep) { pg8::gemm_phase(lds3, g, S, E); __syncthreads(); }
    PH_END
    PH_BEGIN(8)
        phase_conv3(p);
    PH_END
    PH_BEGIN(9)
        pg8::Gemm g{(const bf16_t*)(ws + OFF_Q), (const bf16_t*)(ws + OFF_WTO1), TOK, 1024, 2048, (const bf16_t*)(ws + OFF_Q), 2048, 64};
        EpiF32 E{(float*)(ws + OFF_P)};
        S.init(TOK, 1024, gridDim.x, blockIdx.x); for (int rep = 0; rep < REP_GEMM; ++rep) { pg8::gemm_phase(lds3, g, S, E); __syncthreads(); }
    PH_END
    PH_BEGIN(10)
        phase_post<false>(p.out, (const float*)(ws + OFF_P), p.in[2] + 1024, p.out, nullptr, nullptr);
    PH_END
}

#ifndef N_LAUNCH_MODE
#define N_LAUNCH_MODE 1
#endif

extern "C" void kernel_launch(void* const* d_in, const int* in_sizes, int n_in, void* d_out, int out_size, void* d_ws, size_t ws_size, hipStream_t stream) {
    static int ready = 0;
    if (!ready) {
        if (n_in != 21 || ws_size < WS_END || out_size != TOK * DM) { fprintf(stderr, "kernel_launch: unexpected shapes (n_in %d ws %zu out %d)\n", n_in, ws_size, out_size); ready = -1; return; }
        if (hipFuncSetAttribute((const void*)mega, hipFuncAttributeMaxDynamicSharedMemorySize, LDS_BYTES + 16) != hipSuccess) { fprintf(stderr, "kernel_launch: hipFuncSetAttribute failed\n"); ready = -1; return; }
        ready = 1;
    }
    if (ready < 0) return;
    Prm p{};
    for (int i = 0; i < 21; ++i) p.in[i] = (const float*)d_in[i];
    p.out = (float*)d_out; p.ws = (unsigned char*)d_ws;
#if N_LAUNCH_MODE == 1
    p.ph_lo = 0; p.ph_hi = NPHASE;
    void* args[] = {&p};
    if (hipMemsetAsync((unsigned char*)d_ws + OFF_BAR, 0, 16384, stream) != hipSuccess) { fprintf(stderr, "memset failed\n"); return; }
    hipError_t e = hipLaunchCooperativeKernel((const void*)mega, dim3(256), dim3(512), args, LDS_BYTES + 16, stream);
    if (e != hipSuccess) fprintf(stderr, "cooperative launch failed: %s\n", hipGetErrorString(e));
#else
    for (int ph = 0; ph < NPHASE; ++ph) {
        p.ph_lo = ph; p.ph_hi = ph + 1;
        hipLaunchKernelGGL(mega, dim3(256), dim3(512), LDS_BYTES + 16, stream, p);
    }
#endif
}
```

```cpp
#include <hip/hip_runtime.h>
#include <hip/hip_cooperative_groups.h>
#include <cstdio>
namespace cg = cooperative_groups;

#define LAS __attribute__((address_space(3)))
typedef unsigned short bf16_t;
typedef short bf16x8 __attribute__((ext_vector_type(8)));
typedef float f32x4 __attribute__((ext_vector_type(4)));
typedef float f32x16 __attribute__((ext_vector_type(16)));
typedef unsigned u32x4 __attribute__((ext_vector_type(4)));
typedef unsigned u32x2 __attribute__((ext_vector_type(2)));

constexpr int TOK = 16384, DM = 1024, SEQ = 8192;
constexpr int NP1 = 6400;
constexpr int NIT = 2048;

constexpr size_t OFF_WT1 = 0;
constexpr size_t OFF_WTG = OFF_WT1 + (size_t)NP1 * 1024 * 2;
constexpr size_t OFF_WTO0 = OFF_WTG + (size_t)1024 * 1024 * 2;
constexpr size_t OFF_WT2 = OFF_WTO0 + (size_t)1024 * 2048 * 2;
constexpr size_t OFF_WTO1 = OFF_WT2 + (size_t)8192 * 1024 * 2;
constexpr size_t OFF_H = OFF_WTO1 + (size_t)1024 * 2048 * 2;
constexpr size_t OFF_QKV = OFF_H + (size_t)TOK * 1024 * 2;
constexpr size_t OFF_UU = OFF_QKV + (size_t)TOK * 3072 * 2;
constexpr size_t OFF_WB = OFF_UU + (size_t)TOK * 1024 * 2;
constexpr size_t OFF_ATT = OFF_WB + (size_t)NIT * 8192 * 2;
constexpr size_t OFF_HALO = OFF_ATT + (size_t)NIT * 4096 * 2;
constexpr size_t OFF_BA = OFF_HALO + (size_t)256 * 3 * 3072 * 2;
constexpr size_t OFF_GL = OFF_BA + (size_t)TOK * 16 * 4;
constexpr size_t OFF_BAR = OFF_GL + (size_t)NIT * 4;
constexpr size_t WS_END = OFF_BAR + 16384;
constexpr size_t OFF_YMIX = OFF_QKV;
constexpr size_t OFF_P = OFF_QKV;
constexpr size_t OFF_Q = OFF_QKV + (size_t)TOK * 2048 * 2;
static_assert(OFF_Q + (size_t)TOK * 2048 * 2 <= OFF_WB, "Q overlaps live data");
static_assert(WS_END <= (size_t)256 * 1024 * 1024, "workspace too big");

constexpr int LDS_BYTES = 157696;

struct Prm {
    const float* in[21];
    float* out;
    unsigned char* ws;
    int ph_lo, ph_hi;
};

__device__ __forceinline__ float bf2f(bf16_t b) { return __uint_as_float(((unsigned)b) << 16); }
__device__ __forceinline__ bf16_t f2bf(float f) { unsigned u = __float_as_uint(f); u += 0x7FFFu + ((u >> 16) & 1u); return (bf16_t)(u >> 16); }
typedef __bf16 bf16v2_t __attribute__((ext_vector_type(2)));
typedef float f32x2_t __attribute__((ext_vector_type(2)));
__device__ __forceinline__ unsigned pk2(float lo, float hi) { const f32x2_t v = {lo, hi}; return __builtin_bit_cast(unsigned, __builtin_convertvector(v, bf16v2_t)); }
__device__ __forceinline__ float lo2f(unsigned u) { return __uint_as_float(u << 16); }
__device__ __forceinline__ float hi2f(unsigned u) { return __uint_as_float(u & 0xFFFF0000u); }
__device__ __forceinline__ float sigmoidf_(float x) { return 1.0f / (1.0f + __expf(-x)); }
__device__ __forceinline__ float siluf_(float x) { return x / (1.0f + __expf(-x)); }
__device__ __forceinline__ float wave_sum(float v) {
#pragma unroll
    for (int o = 32; o >= 1; o >>= 1) v += __shfl_xor(v, o);
    return v;
}
__device__ __forceinline__ u32x4 pack8(f32x4 a, f32x4 b) { u32x4 r; r.x = pk2(a[0], a[1]); r.y = pk2(a[2], a[3]); r.z = pk2(b[0], b[1]); r.w = pk2(b[2], b[3]); return r; }

namespace pg8 {
constexpr int BM = 256, BK = 64, HALF = 128, HTB = HALF * BK * 2, STAGE_BYTES = 8 * HTB, NXCD = 8, WGM = 8;
__device__ __forceinline__ int lds_byte(int r, int c) { const int st = (r >> 4) * 2 + (c >> 5), rr = r & 15, cc = c & 31, ob = rr * 64 + cc * 2; return st * 1024 + (ob ^ (((ob >> 9) & 1) << 5)); }
__device__ __forceinline__ void stage_rc(int b, int& R, int& C) { const int st = b / 1024, sb = b % 1024, swz = sb ^ (((sb >> 9) & 1) << 5); R = (st >> 1) * 16 + swz / 64; C = (st & 1) * 32 + (swz % 64) / 2; }
__device__ __forceinline__ int perm32(int rho) { const int n = rho >> 4, i = rho & 15; return 8 * (i >> 2) + 4 * n + (i & 3); }
struct Unit { int pm, pn; };
struct Gemm { const bf16_t* A; const bf16_t* Bt; int M, N, K; const bf16_t* A2; int lda, ks; };
struct StaticOrder {
    int nM, nN, nwg, G, c;
    __device__ void init(int M, int N, int G_, int c_) { nM = M / BM; nN = N / BM; nwg = nM * nN; G = G_; c = c_; }
    __device__ bool next(int i, Unit& u) const {
        const long L = (long)i * G + c; if (L >= nwg) return false;
        int wgid = (int)L; { const int q = nwg / NXCD, r = nwg % NXCD, xcd = wgid % NXCD, off = wgid / NXCD; wgid = (xcd < r ? xcd * (q + 1) : r * (q + 1) + (xcd - r) * q) + off; }
        const int nig = WGM * nN, gid = wgid / nig, fm = gid * WGM, gsz = (nM - fm) < WGM ? (nM - fm) : WGM;
        u.pm = fm + ((wgid % nig) % gsz); u.pn = (wgid % nig) / gsz; return true;
    }
};

template <class Epi>
__device__ __forceinline__ void gemm_phase(LAS unsigned char* lds, const Gemm g, const StaticOrder& S, const Epi& E) {
    const int tid = threadIdx.x, wid = __builtin_amdgcn_readfirstlane(tid >> 6), lane = tid & 63, wr = wid >> 2, wc = wid & 3, fr = lane & 15, fq = lane >> 4;
    const int K = g.K, nt = K / BK;
    unsigned voffA[2], voffB[2];
#pragma unroll
    for (int i = 0; i < 2; ++i) { int R, C; stage_rc(tid * 16 + i * 8192, R, C); const int Rb = Epi::PERM ? ((R & ~31) + perm32(R & 31)) : R;
        voffA[i] = (unsigned)(R * g.lda + C) * 2u; voffB[i] = (unsigned)(Rb * K + C) * 2u; }
    const size_t kstep = (size_t)(BK * 2);
    const size_t hstep = (size_t)HALF * K * 2;
    const size_t tstep = 2 * hstep;
    const size_t hstepA = (size_t)HALF * g.lda * 2, tstepA = 2 * hstepA;
    const int ks = g.ks; const ptrdiff_t a2off = (const char*)g.A2 - (const char*)g.A - (ptrdiff_t)ks * (ptrdiff_t)kstep;
    const unsigned ldsw = (unsigned)wid * 1024u;
    const int aoff = lds_byte(wr * 64 + fr, fq * 8), boff = lds_byte(wc * 32 + fr, fq * 8);
#define PG8_SA(b, h) (((b) * 2 + (h)) * HTB)
#define PG8_SB(b, h) ((4 + (b) * 2 + (h)) * HTB)
#define PG8_STAGE(bufoff, gbase, voff) do { _Pragma("unroll") for (int _i = 0; _i < 2; ++_i) \
        __builtin_amdgcn_global_load_lds((const unsigned*)((const char*)(gbase) + (voff)[_i]), (LAS unsigned*)(lds + (bufoff) + ldsw + _i * 8192), 16, 0, 0); } while (0)
#define PG8_LDA(dst, b, h) do { _Pragma("unroll") for (int m = 0; m < 4; ++m) _Pragma("unroll") for (int k = 0; k < 2; ++k) dst[m][k] = *(const LAS bf16x8*)(lds + PG8_SA(b, h) + aoff + m * 2048 + k * 1024); } while (0)
#define PG8_LDB(dst, b, h) do { _Pragma("unroll") for (int n = 0; n < 2; ++n) _Pragma("unroll") for (int k = 0; k < 2; ++k) dst[n][k] = *(const LAS bf16x8*)(lds + PG8_SB(b, h) + boff + n * 2048 + k * 1024); } while (0)
#define PG8_MMA(ai, bj, At, Bt) do { __builtin_amdgcn_s_setprio(1); _Pragma("unroll") for (int m = 0; m < 4; ++m) _Pragma("unroll") for (int n = 0; n < 2; ++n) _Pragma("unroll") for (int k = 0; k < 2; ++k) \
        acc[ai][bj][m][n] = __builtin_amdgcn_mfma_f32_16x16x32_bf16(Bt[n][k], At[m][k], acc[ai][bj][m][n], 0, 0, 0); __builtin_amdgcn_s_setprio(0); } while (0)
#define PG8_WAIT_V(n) asm volatile("s_waitcnt vmcnt(" #n ")" ::: "memory")
#define PG8_WAIT_L(n) asm volatile("s_waitcnt lgkmcnt(" #n ")" ::: "memory")
#define PG8_BAR __builtin_amdgcn_s_barrier()
#define PG8_SCHED __builtin_amdgcn_sched_barrier(0)
    Unit cur, nxt; int ui = 0;
    if (!S.next(0, cur)) return;
    f32x4 acc[2][2][4][2];
#pragma unroll
    for (int a = 0; a < 2; ++a)
#pragma unroll
        for (int b = 0; b < 2; ++b)
#pragma unroll
            for (int m = 0; m < 4; ++m)
#pragma unroll
                for (int n = 0; n < 2; ++n) acc[a][b][m][n] = (f32x4){0.f, 0.f, 0.f, 0.f};
    bf16x8 At[4][2], B0[2][2], B1[2][2];
    const char* cA = (const char*)g.A + (size_t)cur.pm * tstepA; const char* cB = (const char*)g.Bt + (size_t)cur.pn * tstep;
    PG8_STAGE(PG8_SB(0, 0), cB, voffB); PG8_STAGE(PG8_SA(0, 0), cA, voffA); PG8_STAGE(PG8_SB(0, 1), cB + hstep, voffB); PG8_STAGE(PG8_SA(0, 1), cA + hstepA, voffA);
    if (wr == 1) PG8_BAR;
    PG8_WAIT_V(4); PG8_BAR;
    PG8_STAGE(PG8_SB(1, 0), cB + kstep, voffB); PG8_STAGE(PG8_SA(1, 0), cA + kstep, voffA); PG8_STAGE(PG8_SB(1, 1), cB + hstep + kstep, voffB);
    PG8_WAIT_V(6); PG8_BAR;
    for (;;) {
        const bool has_next = S.next(ui + 1, nxt);
        const char* nA = has_next ? (const char*)g.A + (size_t)nxt.pm * tstepA : cA; const char* nB = has_next ? (const char*)g.Bt + (size_t)nxt.pn * tstep : cB;
        for (int t = 0; t < nt; t += 2) {
            const bool last = (t == nt - 2);
            const char* a1 = cA + (size_t)(t + 1) * kstep + ((t + 1) >= ks ? a2off : 0);
            const char* a2 = last ? nA : cA + (size_t)(t + 2) * kstep + ((t + 2) >= ks ? a2off : 0); const char* b2 = last ? nB : cB + (size_t)(t + 2) * kstep;
            const char* a3 = last ? nA + kstep : cA + (size_t)(t + 3) * kstep + ((t + 3) >= ks ? a2off : 0); const char* b3 = b2 + kstep;
            PG8_LDB(B0, 0, 0); PG8_SCHED; PG8_LDA(At, 0, 0); PG8_STAGE(PG8_SA(1, 1), a1 + hstepA, voffA);
            PG8_WAIT_L(8); PG8_BAR; PG8_WAIT_L(0); PG8_MMA(0, 0, At, B0); PG8_BAR; PG8_SCHED;
            PG8_LDB(B1, 0, 1); PG8_STAGE(PG8_SB(0, 0), b2, voffB);
            PG8_BAR; PG8_WAIT_L(0); PG8_MMA(0, 1, At, B1); PG8_BAR;
            PG8_LDA(At, 0, 1); PG8_STAGE(PG8_SA(0, 0), a2, voffA);
            PG8_BAR; PG8_WAIT_L(0); PG8_MMA(1, 0, At, B0); PG8_BAR; PG8_SCHED;
            PG8_STAGE(PG8_SB(0, 1), b2 + hstep, voffB);
            PG8_WAIT_V(6); PG8_BAR; PG8_MMA(1, 1, At, B1); PG8_BAR;
            PG8_LDB(B0, 1, 0); PG8_SCHED; PG8_LDA(At, 1, 0); PG8_STAGE(PG8_SA(0, 1), a2 + hstepA, voffA);
            PG8_WAIT_L(8); PG8_BAR; PG8_WAIT_L(0); PG8_MMA(0, 0, At, B0); PG8_BAR; PG8_SCHED;
            PG8_LDB(B1, 1, 1); PG8_STAGE(PG8_SB(1, 0), b3, voffB);
            PG8_BAR; PG8_WAIT_L(0); PG8_MMA(0, 1, At, B1); PG8_BAR;
            PG8_LDA(At, 1, 1); PG8_STAGE(PG8_SA(1, 0), a3, voffA);
            PG8_BAR; PG8_WAIT_L(0); PG8_MMA(1, 0, At, B0); PG8_BAR; PG8_SCHED;
            PG8_STAGE(PG8_SB(1, 1), b3 + hstep, voffB);
            PG8_WAIT_V(6); PG8_BAR; PG8_MMA(1, 1, At, B1); PG8_BAR;
        }
        E(acc, cur, wr, wc, fr, fq);
        if (!has_next) break;
#pragma unroll
        for (int a = 0; a < 2; ++a)
#pragma unroll
            for (int b = 0; b < 2; ++b)
#pragma unroll
                for (int m = 0; m < 4; ++m)
#pragma unroll
                    for (int n = 0; n < 2; ++n) acc[a][b][m][n] = (f32x4){0.f, 0.f, 0.f, 0.f};
        cur = nxt; cA = nA; cB = nB; ++ui;
    }
    PG8_WAIT_V(0);
    if (wr == 0) PG8_BAR;
    PG8_BAR;
#undef PG8_SA
#undef PG8_SB
#undef PG8_STAGE
#undef PG8_LDA
#undef PG8_LDB
#undef PG8_MMA
#undef PG8_WAIT_V
#undef PG8_WAIT_L
#undef PG8_BAR
#undef PG8_SCHED
}
}
using pg8::Unit;

struct Epi1 {
    static constexpr bool PERM = true;
    bf16_t* QKV; bf16_t* SZA; bf16_t* UU; bf16_t* SZB; float* BA; bf16_t* HALO;
    __device__ __forceinline__ void operator()(const f32x4 (&acc)[2][2][4][2], const Unit& u, int wr, int wc, int fr_, int fq_) const {
        int lane = (int)(threadIdx.x & 63); asm volatile("" : "+v"(lane));
        const int fr = lane & 15, fq = lane >> 4; (void)fr_; (void)fq_;
        const int row0 = u.pm * 256 + wr * 64 + fr, pn = u.pn;
#pragma unroll
        for (int ai = 0; ai < 2; ++ai)
#pragma unroll
            for (int m = 0; m < 4; ++m) {
                const size_t row = (size_t)(row0 + ai * 128 + m * 16);
#pragma unroll
                for (int bj = 0; bj < 2; ++bj) {
                    const int colt = 128 * bj + 32 * wc + 8 * fq;
                    f32x4 v0 = acc[ai][bj][m][0], v1 = acc[ai][bj][m][1];
                    if (pn < 12) {
                        const int c = pn * 256 + colt; const u32x4 pk = pack8(v0, v1);
                        *(u32x4*)(QKV + row * 3072 + c) = pk;
                        if (m == 3 && fr >= 13) *(u32x4*)(HALO + ((row >> 6) * 3 + (fr - 13)) * 3072 + c) = pk;
                    } else if (pn < 16) {
#pragma unroll
                        for (int e = 0; e < 4; ++e) { v0[e] = siluf_(v0[e]); v1[e] = siluf_(v1[e]); }
                        *(u32x4*)(SZA + row * 1024 + (pn - 12) * 256 + colt) = pack8(v0, v1);
                    } else if (pn < 20) {
                        *(u32x4*)(UU + row * 1024 + (pn - 16) * 256 + colt) = pack8(v0, v1);
                    } else if (pn < 24) {
#pragma unroll
                        for (int e = 0; e < 4; ++e) { v0[e] = siluf_(v0[e]); v1[e] = siluf_(v1[e]); }
                        *(u32x4*)(SZB + row * 1024 + (pn - 20) * 256 + colt) = pack8(v0, v1);
                    } else if (colt < 16) {
                        *(f32x4*)(BA + row * 16 + colt) = v0; *(f32x4*)(BA + row * 16 + colt + 4) = v1;
                    }
                }
            }
    }
};
struct EpiGlu {
    static constexpr bool PERM = true;
    const bf16_t* Y5; bf16_t* SZB;
    __device__ __forceinline__ void operator()(const f32x4 (&acc)[2][2][4][2], const Unit& u, int wr, int wc, int fr, int fq) const {
        const int row0 = u.pm * 256 + wr * 64 + fr;
#pragma unroll
        for (int ai = 0; ai < 2; ++ai)
#pragma unroll
            for (int m = 0; m < 4; ++m) {
                const size_t row = (size_t)(row0 + ai * 128 + m * 16);
#pragma unroll
                for (int bj = 0; bj < 2; ++bj) {
                    const int c = u.pn * 256 + 128 * bj + 32 * wc + 8 * fq;
                    const u32x4 y = *(const u32x4*)(Y5 + row * 1024 + c), z = *(const u32x4*)(SZB + row * 1024 + c);
                    const f32x4 a0 = acc[ai][bj][m][0], a1 = acc[ai][bj][m][1];
                    u32x4 o;
                    o.x = pk2(lo2f(y.x) * sigmoidf_(a0[0]) * lo2f(z.x), hi2f(y.x) * sigmoidf_(a0[1]) * hi2f(z.x));
                    o.y = pk2(lo2f(y.y) * sigmoidf_(a0[2]) * lo2f(z.y), hi2f(y.y) * sigmoidf_(a0[3]) * hi2f(z.y));
                    o.z = pk2(lo2f(y.z) * sigmoidf_(a1[0]) * lo2f(z.z), hi2f(y.z) * sigmoidf_(a1[1]) * hi2f(z.z));
                    o.w = pk2(lo2f(y.w) * sigmoidf_(a1[2]) * lo2f(z.w), hi2f(y.w) * sigmoidf_(a1[3]) * hi2f(z.w));
                    *(u32x4*)(SZB + row * 1024 + c) = o;
                }
            }
    }
};
struct EpiF32 {
    static constexpr bool PERM = false;
    float* C;
    __device__ __forceinline__ void operator()(const f32x4 (&acc)[2][2][4][2], const Unit& u, int wr, int wc, int fr, int fq) const {
        const int row0 = u.pm * 256 + wr * 64 + fr, col0 = u.pn * 256 + wc * 32 + 4 * fq;
#pragma unroll
        for (int ai = 0; ai < 2; ++ai)
#pragma unroll
            for (int m = 0; m < 4; ++m) { float* rowp = C + (size_t)(row0 + ai * 128 + m * 16) * 1024 + col0;
#pragma unroll
                for (int bj = 0; bj < 2; ++bj)
#pragma unroll
                    for (int n = 0; n < 2; ++n) *(f32x4*)(rowp + bj * 128 + n * 16) = acc[ai][bj][m][n]; }
    }
};
struct EpiB16 {
    static constexpr bool PERM = true;
    bf16_t* C;
    __device__ __forceinline__ void operator()(const f32x4 (&acc)[2][2][4][2], const Unit& u, int wr, int wc, int fr, int fq) const {
        const int row0 = u.pm * 256 + wr * 64 + fr, col0 = u.pn * 256 + wc * 32 + 8 * fq;
#pragma unroll
        for (int ai = 0; ai < 2; ++ai)
#pragma unroll
            for (int m = 0; m < 4; ++m) { bf16_t* rowp = C + (size_t)(row0 + ai * 128 + m * 16) * 1024 + col0;
#pragma unroll
                for (int bj = 0; bj < 2; ++bj) *(u32x4*)(rowp + bj * 128) = pack8(acc[ai][bj][m][0], acc[ai][bj][m][1]); }
    }
};
struct Epi2 {
    static constexpr bool PERM = false;
    bf16_t* P; bf16_t* Q;
    __device__ __forceinline__ void operator()(const f32x4 (&acc)[2][2][4][2], const Unit& u, int wr, int wc, int fr, int fq) const {
        const int row0 = u.pm * 256 + wr * 64 + fr, ch = u.pn * 64 + 16 * wc + 4 * fq;
#pragma unroll
        for (int ai = 0; ai < 2; ++ai)
#pragma unroll
            for (int m = 0; m < 4; ++m) {
                const size_t row = (size_t)(row0 + ai * 128 + m * 16);
                const f32x4 gb = acc[ai][0][m][0], gc = acc[ai][0][m][1], hv = acc[ai][1][m][0], z = acc[ai][1][m][1];
                u32x2 pp, qq;
                pp.x = pk2(gc[0] * hv[0], gc[1] * hv[1]); pp.y = pk2(gc[2] * hv[2], gc[3] * hv[3]);
                qq.x = pk2(gb[0] * siluf_(z[0]), gb[1] * siluf_(z[1])); qq.y = pk2(gb[2] * siluf_(z[2]), gb[3] * siluf_(z[3]));
                *(u32x2*)(P + row * 2048 + ch) = pp; *(u32x2*)(Q + row * 2048 + ch) = qq;
            }
    }
};

__device__ __forceinline__ int src_col(int mode, int n, int& pn_unused) {
    (void)pn_unused;
    if (mode == 0) return n;
    if (mode == 1) { if (n < 4096) return n; if (n < 6144) return n + 16; if (n < 6160) return n - 2048; return -1; }
    const int pn = n >> 8, col = n & 255, bj = col >> 7, wc = (col >> 5) & 3, nn = (col >> 4) & 1, lo = col & 15;
    return (2 * bj + nn) * 2048 + pn * 64 + 16 * wc + lo;
}
__device__ __forceinline__ void phase_convert(const Prm& p, unsigned char* lds, int t_begin, int t_end, int nblk, int bidx) {
    float* tile = (float*)lds;
    const int tid = threadIdx.x;
    for (int tix = t_begin + bidx; tix < t_end; tix += nblk) {
        int tl = tix, K, Nsrc, mode; const float* W; bf16_t* Wt;
        if (tl < 1600) { W = p.in[3]; Wt = (bf16_t*)(p.ws + OFF_WT1); K = 1024; Nsrc = 6160; mode = 1; }
        else if ((tl -= 1600) < 256) { W = p.in[16]; Wt = (bf16_t*)(p.ws + OFF_WTG); K = 1024; Nsrc = 1024; mode = 0; }
        else if ((tl -= 256) < 512) { W = p.in[17]; Wt = (bf16_t*)(p.ws + OFF_WTO0); K = 2048; Nsrc = 1024; mode = 0; }
        else if ((tl -= 512) < 2048) { W = p.in[18]; Wt = (bf16_t*)(p.ws + OFF_WT2); K = 1024; Nsrc = 8192; mode = 2; }
        else { tl -= 2048; W = p.in[20]; Wt = (bf16_t*)(p.ws + OFF_WTO1); K = 2048; Nsrc = 1024; mode = 0; }
        const int ntk = K / 64, n0 = (tl / ntk) * 64, k0 = (tl % ntk) * 64;
        { const int j = tid & 63; int dummy = 0; const int sc = src_col(mode, n0 + j, dummy);
#pragma unroll
          for (int i = 0; i < 8; ++i) { const int k = (tid >> 6) + 8 * i; tile[k * 65 + j] = sc >= 0 ? W[(size_t)(k0 + k) * Nsrc + sc] : 0.0f; } }
        __syncthreads();
        { const int r = tid >> 3, c8 = (tid & 7) * 8; u32x4 o;
          o.x = pk2(tile[(c8 + 0) * 65 + r], tile[(c8 + 1) * 65 + r]); o.y = pk2(tile[(c8 + 2) * 65 + r], tile[(c8 + 3) * 65 + r]);
          o.z = pk2(tile[(c8 + 4) * 65 + r], tile[(c8 + 5) * 65 + r]); o.w = pk2(tile[(c8 + 6) * 65 + r], tile[(c8 + 7) * 65 + r]);
          *(u32x4*)(Wt + (size_t)(n0 + r) * K + k0 + c8) = o; }
        __syncthreads();
    }
}
__device__ __forceinline__ void phase_rmsnorm_x(const float* x, const float* w, bf16_t* H) {
    const int lane = threadIdx.x & 63, nw = gridDim.x * 8;
    for (int row = blockIdx.x * 8 + (threadIdx.x >> 6); row < TOK; row += nw) {
        const f32x4* xr = (const f32x4*)(x + (size_t)row * 1024);
        f32x4 v[4]; float ss = 0.f;
#pragma unroll
        for (int i = 0; i < 4; ++i) { v[i] = xr[lane + 64 * i]; ss += v[i][0] * v[i][0] + v[i][1] * v[i][1] + v[i][2] * v[i][2] + v[i][3] * v[i][3]; }
        ss = wave_sum(ss);
        const float rstd = rsqrtf(ss * (1.0f / 1024.0f) + 1e-6f);
#pragma unroll
        for (int i = 0; i < 4; ++i) { const f32x4 w4 = ((const f32x4*)w)[lane + 64 * i]; u32x2 o;
            o.x = pk2(v[i][0] * rstd * w4[0], v[i][1] * rstd * w4[1]); o.y = pk2(v[i][2] * rstd * w4[2], v[i][3] * rstd * w4[3]);
            *(u32x2*)(H + (size_t)row * 1024 + (lane + 64 * i) * 4) = o; }
    }
}
template <bool NEXT>
__device__ __forceinline__ void phase_post(const float* base, const bf16_t* Y, const float* wpost, float* OUT, const float* wpre, bf16_t* H) {
    const int lane = threadIdx.x & 63, nw = gridDim.x * 8;
    for (int row = blockIdx.x * 8 + (threadIdx.x >> 6); row < TOK; row += nw) {
        const u32x2* yr = (const u32x2*)(Y + (size_t)row * 1024); const f32x4* br = (const f32x4*)(base + (size_t)row * 1024);
        f32x4 v[4], xb[4]; float ss = 0.f;
#pragma unroll
        for (int i = 0; i < 4; ++i) { const u32x2 y2 = yr[lane + 64 * i]; v[i] = (f32x4){lo2f(y2.x), hi2f(y2.x), lo2f(y2.y), hi2f(y2.y)}; xb[i] = br[lane + 64 * i]; ss += v[i][0] * v[i][0] + v[i][1] * v[i][1] + v[i][2] * v[i][2] + v[i][3] * v[i][3]; }
        ss = wave_sum(ss);
        const float rstd = rsqrtf(ss * (1.0f / 1024.0f) + 1e-6f);
        float s2 = 0.f;
#pragma unroll
        for (int i = 0; i < 4; ++i) { const f32x4 w4 = ((const f32x4*)wpost)[lane + 64 * i];
#pragma unroll
            for (int e = 0; e < 4; ++e) { v[i][e] = xb[i][e] + v[i][e] * rstd * w4[e]; s2 += v[i][e] * v[i][e]; }
            ((f32x4*)(OUT + (size_t)row * 1024))[lane + 64 * i] = v[i]; }
        if (NEXT) {
            s2 = wave_sum(s2);
            const float r2 = rsqrtf(s2 * (1.0f / 1024.0f) + 1e-6f);
#pragma unroll
            for (int i = 0; i < 4; ++i) { const f32x4 w4 = ((const f32x4*)wpre)[lane + 64 * i]; u32x2 o;
                o.x = pk2(v[i][0] * r2 * w4[0], v[i][1] * r2 * w4[1]); o.y = pk2(v[i][2] * r2 * w4[2], v[i][3] * r2 * w4[3]);
                *(u32x2*)(H + (size_t)row * 1024 + (lane + 64 * i) * 4) = o; }
        }
    }
}


__device__ __forceinline__ void sincos_d(double x, double& s, double& c) {
    const double k = rint(x * 0.6366197723675814);
    const double r = fma(-k, 6.123233995736766e-17, fma(-k, 1.5707963267948966, x)), r2 = r * r;
    double sp = -7.647163731819816e-13; sp = fma(sp, r2, 1.6059043836821613e-10); sp = fma(sp, r2, -2.505210838544172e-8); sp = fma(sp, r2, 2.7557319223985893e-6);
    sp = fma(sp, r2, -1.984126984126984e-4); sp = fma(sp, r2, 8.333333333333333e-3); sp = fma(sp, r2, -1.6666666666666666e-1); sp = fma(sp * r2, r, r);
    double cp = 4.779477332387385e-14; cp = fma(cp, r2, -1.1470745597729725e-11); cp = fma(cp, r2, 2.08767569878681e-9); cp = fma(cp, r2, -2.755731922398589e-7);
    cp = fma(cp, r2, 2.48015873015873e-5); cp = fma(cp, r2, -1.388888888888889e-3); cp = fma(cp, r2, 4.1666666666666664e-2); cp = fma(cp, r2, -0.5); cp = fma(cp, r2, 1.0);
    const int q = ((int)k) & 3;
    const double s0 = (q & 1) ? cp : sp, c0 = (q & 1) ? sp : cp;
    s = (q & 2) ? -s0 : s0; c = ((q + 1) & 2) ? -c0 : c0;
}
__device__ __forceinline__ double exp_d(double x) {
    const double n = rint(x * 1.4426950408889634);
    const double r = fma(-n, 2.3190468138462996e-17, fma(-n, 0.6931471805599453, x));
    double p = 1.6059043836821613e-10; p = fma(p, r, 2.08767569878681e-9); p = fma(p, r, 2.505210838544172e-8); p = fma(p, r, 2.755731922398589e-7); p = fma(p, r, 2.7557319223985893e-6);
    p = fma(p, r, 2.48015873015873e-5); p = fma(p, r, 1.984126984126984e-4); p = fma(p, r, 1.388888888888889e-3); p = fma(p, r, 8.333333333333333e-3); p = fma(p, r, 4.1666666666666664e-2);
    p = fma(p, r, 1.6666666666666666e-1); p = fma(p, r, 0.5); p = fma(p, r, 1.0); p = fma(p, r, 1.0);
    return ldexp(p, (int)n);
}
__device__ __forceinline__ float bcast_lo(float v) { auto r = __builtin_amdgcn_permlane32_swap(__float_as_uint(v), __float_as_uint(v), false, false); return __uint_as_float(r[0]); }
__device__ __forceinline__ float bcast_hi(float v) { auto r = __builtin_amdgcn_permlane32_swap(__float_as_uint(v), __float_as_uint(v), false, false); return __uint_as_float(r[1]); }

struct S5C {
    float ar[2][4], ai[2][4];
    float a512r[2], a512i[2];
    bf16x8 BB[4];
    bf16x8 CC[4];
    float dco;
};

template <bool OUT>
__device__ __forceinline__ void s5_chunk(const S5C& C, bf16_t* UU, int b, int g, int chunk, float (&st)[2][2], bf16_t* sX, int lane) {
    const int n = lane & 31, hh = lane >> 5, fr = lane & 15, fq = lane >> 4;
    const size_t tok0 = (size_t)b * SEQ + (size_t)chunk * 512;
    bf16x8 ua = *(const bf16x8*)(UU + (tok0 + n) * 1024 + 16 * g + 8 * hh);
    bf16_t uo[8];
    if (OUT) {
#pragma unroll
        for (int mt = 0; mt < 2; ++mt)
#pragma unroll
            for (int j = 0; j < 4; ++j) uo[mt * 4 + j] = UU[(tok0 + 16 * mt + 4 * fq + j) * 1024 + 16 * g + fr];
    }
    for (int blk = 0; blk < 16; ++blk) {
        const size_t t0 = tok0 + (size_t)blk * 32;
        const bf16x8 ucur = ua;
        bf16_t ucuro[8];
        if (OUT) {
#pragma unroll
            for (int i = 0; i < 8; ++i) ucuro[i] = uo[i];
        }
        if (blk < 15) {
            ua = *(const bf16x8*)(UU + (t0 + 32 + n) * 1024 + 16 * g + 8 * hh);
            if (OUT) {
#pragma unroll
                for (int mt = 0; mt < 2; ++mt)
#pragma unroll
                    for (int j = 0; j < 4; ++j) uo[mt * 4 + j] = UU[(t0 + 32 + 16 * mt + 4 * fq + j) * 1024 + 16 * g + fr];
            }
        }
        f32x16 acc[4];
#pragma unroll
        for (int tl = 0; tl < 4; ++tl) {
            f32x16 z;
#pragma unroll
            for (int i = 0; i < 16; ++i) z[i] = 0.f;
            acc[tl] = __builtin_amdgcn_mfma_f32_32x32x16_bf16(ucur, C.BB[tl], z, 0, 0, 0);
        }
#pragma unroll
        for (int tp = 0; tp < 2; ++tp) {
            f32x16& re = acc[2 * tp]; f32x16& im = acc[2 * tp + 1];
            const float a1r = C.ar[tp][0], a1i = C.ai[tp][0];
#pragma unroll
            for (int q = 0; q < 4; ++q)
#pragma unroll
                for (int r = 1; r < 4; ++r) {
                    const float pr = re[4 * q + r - 1], pi = im[4 * q + r - 1];
                    re[4 * q + r] += a1r * pr - a1i * pi; im[4 * q + r] += a1r * pi + a1i * pr;
                }
            float cr = st[tp][0], ci = st[tp][1];
            const float a4r = C.ar[tp][3], a4i = C.ai[tp][3];
#pragma unroll
            for (int q = 0; q < 4; ++q) {
                const float tr = re[4 * q + 3] + a4r * cr - a4i * ci, ti = im[4 * q + 3] + a4r * ci + a4i * cr;
                const float o0r = bcast_lo(tr), o0i = bcast_lo(ti);
                const float xr = hh ? o0r : cr, xi = hh ? o0i : ci;
                if (OUT) {
#pragma unroll
                    for (int r = 0; r < 4; ++r) { const float kr = C.ar[tp][r], ki = C.ai[tp][r];
                        re[4 * q + r] += kr * xr - ki * xi; im[4 * q + r] += kr * xi + ki * xr; }
                } else {
                    re[4 * q + 3] += a4r * xr - a4i * xi; im[4 * q + 3] += a4r * xi + a4i * xr;
                }
                cr = bcast_hi(re[4 * q + 3]); ci = bcast_hi(im[4 * q + 3]);
            }
            st[tp][0] = cr; st[tp][1] = ci;
        }
        if (OUT) {
            asm volatile("s_waitcnt lgkmcnt(0)" ::: "memory");
#pragma unroll
            for (int tp = 0; tp < 2; ++tp)
#pragma unroll
                for (int i = 0; i < 16; ++i) {
                    const int t = 8 * (i >> 2) + 4 * hh + (i & 3);
                    *(unsigned*)(sX + t * 136 + 2 * (n + 32 * tp)) = pk2(acc[2 * tp][i], acc[2 * tp + 1][i]);
                }
            asm volatile("s_waitcnt lgkmcnt(0)" ::: "memory");
            __builtin_amdgcn_wave_barrier();
#pragma unroll
            for (int mt = 0; mt < 2; ++mt) {
                f32x4 y = (f32x4){0.f, 0.f, 0.f, 0.f};
#pragma unroll
                for (int ks = 0; ks < 4; ++ks) {
                    const bf16x8 xa = *(const bf16x8*)(sX + (16 * mt + fr) * 136 + 32 * ks + 8 * fq);
                    y = __builtin_amdgcn_mfma_f32_16x16x32_bf16(xa, C.CC[ks], y, 0, 0, 0);
                }
#pragma unroll
                for (int j = 0; j < 4; ++j) {
                    float v = y[j] + C.dco * bf2f(ucuro[mt * 4 + j]);
                    const float inner = 0.7978845608028654f * (v + 0.044715f * v * v * v);
                    v = v / (1.0f + __expf(-2.0f * inner));
                    UU[(t0 + 16 * mt + 4 * fq + j) * 1024 + 16 * g + fr] = f2bf(v);
                }
            }
            asm volatile("s_waitcnt lgkmcnt(0)" ::: "memory");
            __builtin_amdgcn_wave_barrier();
        }
    }
}

__device__ __forceinline__ void phase_s5(const Prm& p, unsigned char* lds, int bg) {
    const int b = bg >> 6, g = bg & 63;
    const int tid = threadIdx.x, wv = tid >> 6, lane = tid & 63, n = lane & 31, hh = lane >> 5, fr = lane & 15, fq = lane >> 4;
    bf16_t* sX = (bf16_t*)(lds + wv * 8704);
    float* sXE = (float*)(lds + 8 * 8704);
    bf16_t* UU = (bf16_t*)(p.ws + OFF_UU);
    const float* lam_re = p.in[8]; const float* lam_im = p.in[9]; const float* b_re = p.in[10]; const float* b_im = p.in[11];
    const float* c_re = p.in[12]; const float* c_im = p.in[13];
    S5C C;
    const double dt = exp_d((double)p.in[14][g]);
    float fre[2], fim[2];
#pragma unroll
    for (int tp = 0; tp < 2; ++tp) {
        const int pp = n + 32 * tp;
        const double lr = (double)fminf(lam_re[g * 64 + pp], -1e-4f), li = (double)lam_im[g * 64 + pp];
#pragma unroll
        for (int k = 0; k < 4; ++k) { double sn, cs; sincos_d(li * dt * (k + 1), sn, cs); const double mag = exp_d(lr * dt * (k + 1)); C.ar[tp][k] = (float)(mag * cs); C.ai[tp][k] = (float)(mag * sn); }
        { double sn, cs; sincos_d(li * dt * 512.0, sn, cs); const double mag = exp_d(lr * dt * 512.0); C.a512r[tp] = (float)(mag * cs); C.a512i[tp] = (float)(mag * sn); }
        double sn, cs; sincos_d(li * dt, sn, cs);
        const double mag = exp_d(lr * dt), abr = mag * cs, abi = mag * sn;
        const double den = lr * lr + li * li, nr = abr - 1.0, ni = abi;
        fre[tp] = (float)((nr * lr + ni * li) / den); fim[tp] = (float)((ni * lr - nr * li) / den);
    }
#pragma unroll
    for (int tl = 0; tl < 4; ++tl) {
        const int tp = tl >> 1, ri = tl & 1, pp = n + 32 * tp;
#pragma unroll
        for (int j = 0; j < 8; ++j) {
            const int ch = 8 * hh + j;
            const float br = b_re[(g * 64 + pp) * 16 + ch], bi = b_im[(g * 64 + pp) * 16 + ch];
            const float v = ri == 0 ? fre[tp] * br - fim[tp] * bi : fre[tp] * bi + fim[tp] * br;
            C.BB[tl][j] = (short)f2bf(v);
        }
    }
#pragma unroll
    for (int ks = 0; ks < 4; ++ks)
#pragma unroll
        for (int j = 0; j < 8; ++j) {
            const int k = 32 * ks + 8 * fq + j, pp = k >> 1, ri = k & 1;
            const float v = ri == 0 ? c_re[(g * 16 + fr) * 64 + pp] : -c_im[(g * 16 + fr) * 64 + pp];
            C.CC[ks][j] = (short)f2bf(v);
        }
    C.dco = p.in[15][16 * g + fr];
    for (int rd = 0; rd < 2; ++rd) {
        const int chunk = wv + 8 * rd;
        float st[2][2] = {{0.f, 0.f}, {0.f, 0.f}};
        s5_chunk<false>(C, UU, b, g, chunk, st, sX, lane);
        if (hh == 0) {
#pragma unroll
            for (int tp = 0; tp < 2; ++tp) { sXE[(chunk * 64 + n + 32 * tp) * 2 + 0] = st[tp][0]; sXE[(chunk * 64 + n + 32 * tp) * 2 + 1] = st[tp][1]; }
        }
    }
    __syncthreads();
    for (int rd = 0; rd < 2; ++rd) {
        const int chunk = wv + 8 * rd;
        float st[2][2] = {{0.f, 0.f}, {0.f, 0.f}};
        for (int c2 = 0; c2 < chunk; ++c2) {
#pragma unroll
            for (int tp = 0; tp < 2; ++tp) {
                const float er = sXE[(c2 * 64 + n + 32 * tp) * 2 + 0], ei = sXE[(c2 * 64 + n + 32 * tp) * 2 + 1];
                const float nr = C.a512r[tp] * st[tp][0] - C.a512i[tp] * st[tp][1] + er, ni = C.a512r[tp] * st[tp][1] + C.a512i[tp] * st[tp][0] + ei;
                st[tp][0] = nr; st[tp][1] = ni;
            }
        }
        s5_chunk<true>(C, UU, b, g, chunk, st, sX, lane);
    }
    __syncthreads();
}

__device__ __forceinline__ void phase_gdn_prep(const Prm& p, unsigned char* lds, int it0, int nrounds) {
    const int tid0 = threadIdx.x, hb = tid0 >> 8;
    unsigned char* base = lds + hb * 76800;
    bf16_t* sQ = (bf16_t*)base;
    bf16_t* sK = (bf16_t*)(base + 17408);
    bf16_t* sV = (bf16_t*)(base + 2 * 17408);
    float* sL = (float*)(base + 3 * 17408);
    float* sBeta = (float*)(base + 4 * 17408);
    float* sGc = sBeta + 64; float* sEg = sGc + 64; float* sBE = sEg + 64;
    float* sCW = sBE + 64;
    bf16_t* QKV = (bf16_t*)(p.ws + OFF_QKV); const bf16_t* HALO = (const bf16_t*)(p.ws + OFF_HALO);
    const float* BA = (const float*)(p.ws + OFF_BA); float* GL = (float*)(p.ws + OFF_GL);
    bf16_t* WB = (bf16_t*)(p.ws + OFF_WB); bf16_t* ATT = (bf16_t*)(p.ws + OFF_ATT);
    const float* convw = p.in[4];
    for (int rd = 0; rd < nrounds; ++rd) {
        int tid = tid0; asm volatile("" : "+v"(tid));
        const int ht = tid & 255, hw = (tid >> 6) & 3, lane = tid & 63, fr = lane & 15, fq = lane >> 4;
        const int it = it0 + rd * 2 + hb;
        const int b = it >> 10, h = (it >> 7) & 7, nc = it & 127;
        const size_t tokb = (size_t)b * SEQ + (size_t)nc * 64;
#pragma unroll
        for (int i = 0; i < 6; ++i) { const int idx = ht + 256 * i, s3 = idx >> 9, tap = (idx >> 7) & 3, ch = idx & 127; sCW[idx] = convw[tap * 3072 + s3 * 1024 + h * 128 + ch]; }
        __syncthreads();
        {
            const int t = ht >> 2, cg4 = ht & 3;
#pragma unroll 1
            for (int s = 0; s < 3; ++s) {
                const int col = s * 1024 + h * 128 + cg4 * 32;
                float o[32]; float ss = 0.f;
#pragma unroll
                for (int c8 = 0; c8 < 4; ++c8) {
                    float a[8];
#pragma unroll
                    for (int e = 0; e < 8; ++e) a[e] = 0.f;
#pragma unroll
                    for (int d = 0; d < 4; ++d) {
                        const int tt = t - d;
                        u32x4 xv = (u32x4){0u, 0u, 0u, 0u};
                        if (tt >= 0) xv = *(const u32x4*)(QKV + (tokb + tt) * 3072 + col + c8 * 8);
                        else if (nc > 0) xv = *(const u32x4*)(HALO + ((size_t)(b * 128 + nc - 1) * 3 + (3 + tt)) * 3072 + col + c8 * 8);
                        const f32x4 w0 = *(const f32x4*)(sCW + s * 512 + (3 - d) * 128 + cg4 * 32 + c8 * 8), w1 = *(const f32x4*)(sCW + s * 512 + (3 - d) * 128 + cg4 * 32 + c8 * 8 + 4);
                        a[0] += w0[0] * lo2f(xv.x); a[1] += w0[1] * hi2f(xv.x); a[2] += w0[2] * lo2f(xv.y); a[3] += w0[3] * hi2f(xv.y);
                        a[4] += w1[0] * lo2f(xv.z); a[5] += w1[1] * hi2f(xv.z); a[6] += w1[2] * lo2f(xv.w); a[7] += w1[3] * hi2f(xv.w);
                    }
#pragma unroll
                    for (int e = 0; e < 8; ++e) { const float v = siluf_(a[e]); o[c8 * 8 + e] = v; ss += v * v; }
                }
                float sc = 1.0f;
                if (s < 2) { ss += __shfl_xor(ss, 1); ss += __shfl_xor(ss, 2); sc = rsqrtf(ss + 1e-6f) * (s == 0 ? 0.08838834764831845f : 1.0f); }
                bf16_t* dst = (s == 0 ? sQ : (s == 1 ? sK : sV)) + t * 136 + cg4 * 32;
#pragma unroll
                for (int c8 = 0; c8 < 4; ++c8) { u32x4 pk;
                    pk.x = pk2(o[c8 * 8 + 0] * sc, o[c8 * 8 + 1] * sc); pk.y = pk2(o[c8 * 8 + 2] * sc, o[c8 * 8 + 3] * sc);
                    pk.z = pk2(o[c8 * 8 + 4] * sc, o[c8 * 8 + 5] * sc); pk.w = pk2(o[c8 * 8 + 6] * sc, o[c8 * 8 + 7] * sc);
                    *(u32x4*)(dst + c8 * 8) = pk; }
            }
        }
        if (hw == 0) {
            const size_t tg = tokb + lane;
            const float braw = BA[tg * 16 + h], araw = BA[tg * 16 + 8 + h];
            const float beta = 1.0f / (1.0f + expf(-braw));
            const float xx = araw + p.in[6][h];
            const float sp = xx > 20.f ? xx : log1pf(expf(xx));
            float gg = -expf(p.in[5][h]) * sp;
#pragma unroll
            for (int off = 1; off < 64; off <<= 1) { const float o = __shfl_up(gg, off); if (lane >= off) gg += o; }
            sBeta[lane] = beta; sGc[lane] = gg; sEg[lane] = expf(gg); sBE[lane] = beta * expf(gg);
            if (lane == 63) GL[it] = expf(gg);
        }
        __syncthreads();
        {
            bf16x8 aK[4], aQ[4];
#pragma unroll
            for (int ks = 0; ks < 4; ++ks) { aK[ks] = *(const bf16x8*)(sK + (16 * hw + fr) * 136 + 32 * ks + 8 * fq); aQ[ks] = *(const bf16x8*)(sQ + (16 * hw + fr) * 136 + 32 * ks + 8 * fq); }
#pragma unroll
            for (int nt = 0; nt < 4; ++nt) {
                f32x4 kk = (f32x4){0.f, 0.f, 0.f, 0.f}, qk = (f32x4){0.f, 0.f, 0.f, 0.f};
#pragma unroll
                for (int ks = 0; ks < 4; ++ks) {
                    const bf16x8 bK = *(const bf16x8*)(sK + (16 * nt + fr) * 136 + 32 * ks + 8 * fq);
                    kk = __builtin_amdgcn_mfma_f32_16x16x32_bf16(aK[ks], bK, kk, 0, 0, 0);
                    qk = __builtin_amdgcn_mfma_f32_16x16x32_bf16(aQ[ks], bK, qk, 0, 0, 0);
                }
                const int mcol = 16 * nt + fr; const float gm = sGc[mcol];
#pragma unroll
                for (int j = 0; j < 4; ++j) {
                    const int c = 16 * hw + 4 * fq + j;
                    const float dec = __expf(fminf(sGc[c] - gm, 0.f));
                    sL[c * 68 + mcol] = (mcol < c) ? kk[j] * sBeta[c] * dec : 0.f;
                    ATT[(size_t)it * 4096 + c * 64 + mcol] = f2bf((mcol <= c) ? qk[j] * dec : 0.f);
                }
            }
        }
        __syncthreads();
        {
            float x[64];
            const bool isU = ht < 128; const int jc = ht & 127;
            const bf16_t* src = isU ? sV : sK;
            const float* fac = isU ? sBeta : sBE;
#pragma unroll
            for (int cb = 0; cb < 16; ++cb) {
                float a[4];
#pragma unroll
                for (int r = 0; r < 4; ++r) a[r] = bf2f(src[(4 * cb + r) * 136 + jc]) * fac[4 * cb + r];
#pragma unroll
                for (int m4 = 0; m4 < cb; ++m4)
#pragma unroll
                    for (int r = 0; r < 4; ++r) {
                        const f32x4 l = *(const f32x4*)(sL + (4 * cb + r) * 68 + 4 * m4);
                        a[r] -= l[0] * x[4 * m4] + l[1] * x[4 * m4 + 1] + l[2] * x[4 * m4 + 2] + l[3] * x[4 * m4 + 3];
                    }
                const f32x4 d1 = *(const f32x4*)(sL + (4 * cb + 1) * 68 + 4 * cb), d2 = *(const f32x4*)(sL + (4 * cb + 2) * 68 + 4 * cb), d3 = *(const f32x4*)(sL + (4 * cb + 3) * 68 + 4 * cb);
                x[4 * cb] = a[0];
                x[4 * cb + 1] = a[1] - d1[0] * x[4 * cb];
                x[4 * cb + 2] = a[2] - d2[0] * x[4 * cb] - d2[1] * x[4 * cb + 1];
                x[4 * cb + 3] = a[3] - d3[0] * x[4 * cb] - d3[1] * x[4 * cb + 1] - d3[2] * x[4 * cb + 2];
            }
            if (isU) {
                const int w8 = jc >> 4, nn = jc & 15;
#pragma unroll
                for (int rq = 0; rq < 4; ++rq)
#pragma unroll
                    for (int pc = 0; pc < 2; ++pc) {
                        const int c0 = 32 * pc + 4 * rq;
                        u32x4 o; o.x = pk2(x[c0 + 0], x[c0 + 1]); o.y = pk2(x[c0 + 2], x[c0 + 3]); o.z = pk2(x[c0 + 16], x[c0 + 17]); o.w = pk2(x[c0 + 18], x[c0 + 19]);
                        const int L = ((w8 * 2 + pc) * 64 + rq * 16 + nn) * 8;
                        *(u32x4*)(QKV + (tokb + (L >> 7)) * 3072 + 2048 + h * 128 + (L & 127)) = o;
                    }
            }
            __syncthreads();
            if (!isU) {
                bf16_t* sW2 = (bf16_t*)sL;
#pragma unroll
                for (int c = 0; c < 64; ++c) sW2[c * 136 + jc] = f2bf(-x[c]);
            }
        }
        __syncthreads();
        {
            const bf16_t* sW2 = (const bf16_t*)sL;
#pragma unroll
            for (int i = 0; i < 4; ++i) { const int ch = ht + 256 * i, r = ch >> 4, c8 = (ch & 15) * 8; *(u32x4*)(WB + (size_t)it * 8192 + r * 128 + c8) = *(const u32x4*)(sW2 + r * 136 + c8); }
        }
        {
            const int c = ht >> 2, ds = (ht & 3) * 32; const float eg = sEg[c];
#pragma unroll
            for (int c8 = 0; c8 < 4; ++c8) {
                const u32x4 v = *(const u32x4*)(sQ + c * 136 + ds + c8 * 8); u32x4 o;
                o.x = pk2(lo2f(v.x) * eg, hi2f(v.x) * eg); o.y = pk2(lo2f(v.y) * eg, hi2f(v.y) * eg); o.z = pk2(lo2f(v.z) * eg, hi2f(v.z) * eg); o.w = pk2(lo2f(v.w) * eg, hi2f(v.w) * eg);
                *(u32x4*)(QKV + (tokb + c) * 3072 + h * 128 + ds + c8 * 8) = o;
            }
            const int d = ht >> 1, cs = (ht & 1) * 32; const float gl = sGc[63];
#pragma unroll
            for (int c8 = 0; c8 < 4; ++c8) {
                float v[8];
#pragma unroll
                for (int e = 0; e < 8; ++e) { const int cc = cs + c8 * 8 + e; v[e] = bf2f(sK[cc * 136 + d]) * __expf(gl - sGc[cc]); }
                u32x4 o; o.x = pk2(v[0], v[1]); o.y = pk2(v[2], v[3]); o.z = pk2(v[4], v[5]); o.w = pk2(v[6], v[7]);
                *(u32x4*)(QKV + (tokb + (d >> 1)) * 3072 + 1024 + h * 128 + (d & 1) * 64 + cs + c8 * 8) = o;
            }
        }
        __syncthreads();
    }
}

constexpr int SC_RW = 288, SC_RK = 160;
constexpr int SC_QD = 64 * SC_RW, SC_KT = 2 * 64 * SC_RW, SC_AT = SC_KT + 128 * SC_RK, SC_U = SC_AT + 64 * SC_RK, SC_STAGE = SC_U + 8192;
static_assert(2 * SC_STAGE <= LDS_BYTES && SC_U % 16 == 0 && SC_STAGE % 16 == 0, "scan LDS layout");
struct ScanRegs { u32x4 rw[4], rq[4], rk[4], ru[2], ra[2]; };
__device__ __forceinline__ void scan_load(ScanRegs& R, const bf16_t* QKV, const bf16_t* WB, const bf16_t* ATT, int b, int h, int jh, int it, int nc, int lt) {
    const size_t tokb = (size_t)b * SEQ + (size_t)nc * 64;
#pragma unroll
    for (int i = 0; i < 4; ++i) { const int ch = lt + 256 * i, r = ch >> 4, c8 = (ch & 15) * 8;
        R.rw[i] = *(const u32x4*)(WB + (size_t)it * 8192 + r * 128 + c8);
        const bf16_t* qp = QKV + (tokb + r) * 3072 + h * 128 + c8;
        R.rq[i] = *(const u32x4*)(qp); R.rk[i] = *(const u32x4*)(qp + 1024); }
#pragma unroll
    for (int i = 0; i < 2; ++i) { const int ch = lt + 256 * i; R.ra[i] = *(const u32x4*)(ATT + (size_t)it * 4096 + ch * 8);
        const int L = jh * 4096 + ch * 8; R.ru[i] = *(const u32x4*)(QKV + (tokb + (L >> 7)) * 3072 + 2048 + h * 128 + (L & 127)); }
}
__device__ __forceinline__ void st32p(unsigned char* rowp, int g, u32x4 v) {
    const int pt = g & 3; unsigned char* p = rowp + 64 * (g >> 2) + 32 * (pt & 1) + 8 * (pt >> 1);
    *(u32x2*)p = (u32x2){v.x, v.y}; *(u32x2*)(p + 16) = (u32x2){v.z, v.w};
}
__device__ __forceinline__ void scan_store(const ScanRegs& R, unsigned char* sbp, int lt) {
#pragma unroll
    for (int i = 0; i < 4; ++i) { const int ch = lt + 256 * i, r = ch >> 4, g = ch & 15;
        st32p(sbp + r * SC_RW, g, R.rw[i]);
        st32p(sbp + SC_QD + r * SC_RW, g, R.rq[i]);
        const int d = 2 * r + (g >> 3), gk = g & 7;
        st32p(sbp + SC_KT + d * SC_RK, gk, R.rk[i]); }
#pragma unroll
    for (int i = 0; i < 2; ++i) { const int ch = lt + 256 * i, r = ch >> 3, g = ch & 7; st32p(sbp + SC_AT + r * SC_RK, g, R.ra[i]); *(u32x4*)(sbp + SC_U + ch * 16) = R.ru[i]; }
}
__device__ __forceinline__ bf16x8 pack2(const f32x4& a, const f32x4& b) {
    u32x4 r; r.x = pk2(a[0], a[1]); r.y = pk2(a[2], a[3]); r.z = pk2(b[0], b[1]); r.w = pk2(b[2], b[3]); return __builtin_bit_cast(bf16x8, r);
}
#define SCAN_BAR() do { asm volatile("s_waitcnt lgkmcnt(0)" ::: "memory"); __builtin_amdgcn_s_barrier(); asm volatile("" ::: "memory"); } while (0)
#define MF16(a, b, c) __builtin_amdgcn_mfma_f32_16x16x32_bf16(a, b, c, 0, 0, 0)
__device__ __forceinline__ void phase_gdn_scan(const Prm& p, unsigned char* lds, int blk) {
    const int tid = threadIdx.x, wv = tid >> 6, lane = tid & 63, n = lane & 15, kq = lane >> 4;
    const int bh = blk >> 1, jh = blk & 1, b = bh >> 3, h = bh & 7;
    const bf16_t* QKV = (const bf16_t*)(p.ws + OFF_QKV); const bf16_t* WB = (const bf16_t*)(p.ws + OFF_WB); const bf16_t* ATT = (const bf16_t*)(p.ws + OFF_ATT);
    const float* GL = (const float*)(p.ws + OFF_GL); bf16_t* O = (bf16_t*)(p.ws + OFF_H);
    const int itb = bh * 128;
    if (wv >= 4) {
        const int lt = tid - 256;
        ScanRegs RA, RB;
        scan_load(RA, QKV, WB, ATT, b, h, jh, itb, 0, lt);
        scan_store(RA, lds, lt);
        __builtin_amdgcn_sched_barrier(0);
        scan_load(RA, QKV, WB, ATT, b, h, jh, itb + 1, 1, lt);
        __builtin_amdgcn_sched_barrier(0);
        scan_load(RB, QKV, WB, ATT, b, h, jh, itb + 2, 2, lt);
        __builtin_amdgcn_sched_barrier(0);
        SCAN_BAR();
        for (int nc = 0; nc < 128; nc += 2) {
            __builtin_amdgcn_sched_barrier(0);
            scan_store(RA, lds + SC_STAGE, lt);
            __builtin_amdgcn_sched_barrier(0);
            { const int c3 = nc + 3 < 128 ? nc + 3 : 127; scan_load(RA, QKV, WB, ATT, b, h, jh, itb + c3, c3, lt); }
            __builtin_amdgcn_sched_barrier(0);
            SCAN_BAR();
            __builtin_amdgcn_sched_barrier(0);
            scan_store(RB, lds, lt);
            __builtin_amdgcn_sched_barrier(0);
            { const int c4 = nc + 4 < 128 ? nc + 4 : 127; scan_load(RB, QKV, WB, ATT, b, h, jh, itb + c4, c4, lt); }
            SCAN_BAR();
        }
    } else {
        const float gl0 = GL[itb + lane], gl1 = GL[itb + 64 + lane];
        f32x4 S[8];
#pragma unroll
        for (int dt = 0; dt < 8; ++dt) S[dt] = (f32x4){0.f, 0.f, 0.f, 0.f};
        const int e = 64 * jh + 16 * wv + n;
        SCAN_BAR();
        for (int nc = 0; nc < 128; ++nc) {
            const unsigned char* sbp = lds + (nc & 1) * SC_STAGE;
            const float gl = __builtin_bit_cast(float, __builtin_amdgcn_readlane(__builtin_bit_cast(int, nc < 64 ? gl0 : gl1), nc & 63));
            const unsigned char* pw = sbp + n * SC_RW + 16 * kq;
            const unsigned char* pk = sbp + SC_KT + n * SC_RK + 16 * kq;
            f32x4 V[4], Oa[4];
#pragma unroll
            for (int pc = 0; pc < 2; ++pc) {
                const u32x4 uu = *(const u32x4*)(sbp + SC_U + ((wv * 2 + pc) * 64 + lane) * 16);
                V[2 * pc] = (f32x4){lo2f(uu.x), hi2f(uu.x), lo2f(uu.y), hi2f(uu.y)}; V[2 * pc + 1] = (f32x4){lo2f(uu.z), hi2f(uu.z), lo2f(uu.w), hi2f(uu.w)};
            }
#pragma unroll
            for (int ct = 0; ct < 4; ++ct) Oa[ct] = (f32x4){0.f, 0.f, 0.f, 0.f};
            bf16x8 fa[2][8];
#define LD_WQ(dst, ks_) do { _Pragma("unroll") for (int mt = 0; mt < 4; ++mt) { dst[mt] = *(const bf16x8*)(pw + mt * 16 * SC_RW + 64 * (ks_)); dst[4 + mt] = *(const bf16x8*)(pw + SC_QD + mt * 16 * SC_RW + 64 * (ks_)); } } while (0)
            LD_WQ(fa[0], 0);
#pragma unroll
            for (int ks = 0; ks < 4; ++ks) {
                if (ks < 3) LD_WQ(fa[(ks + 1) & 1], ks + 1);
                const bf16x8 sb8 = pack2(S[2 * ks], S[2 * ks + 1]);
                __builtin_amdgcn_sched_barrier(0);
#pragma unroll
                for (int mt = 0; mt < 4; ++mt) { V[mt] = MF16(fa[ks & 1][mt], sb8, V[mt]); Oa[mt] = MF16(fa[ks & 1][4 + mt], sb8, Oa[mt]); }
                __builtin_amdgcn_sched_barrier(0);
            }
#undef LD_WQ
            bf16x8 fb[2][12];
#define LD_AK(dst, k2_) do { _Pragma("unroll") for (int mt = 0; mt < 4; ++mt) dst[mt] = *(const bf16x8*)(pk + (SC_AT - SC_KT) + mt * 16 * SC_RK + 64 * (k2_)); \
                             _Pragma("unroll") for (int dt = 0; dt < 8; ++dt) dst[4 + dt] = *(const bf16x8*)(pk + dt * 16 * SC_RK + 64 * (k2_)); } while (0)
            LD_AK(fb[0], 0);
            bf16x8 Vb[2];
            Vb[0] = pack2(V[0], V[1]); Vb[1] = pack2(V[2], V[3]);
#pragma unroll
            for (int dt = 0; dt < 8; ++dt) S[dt] *= gl;
#pragma unroll
            for (int k2 = 0; k2 < 2; ++k2) {
                if (k2 < 1) LD_AK(fb[1], 1);
                __builtin_amdgcn_sched_barrier(0);
#pragma unroll
                for (int mt = 0; mt < 4; ++mt) Oa[mt] = MF16(fb[k2][mt], Vb[k2], Oa[mt]);
#pragma unroll
                for (int dt = 0; dt < 8; ++dt) S[dt] = MF16(fb[k2][4 + dt], Vb[k2], S[dt]);
                __builtin_amdgcn_sched_barrier(0);
            }
#undef LD_AK
            bf16_t* obase = O + (size_t)(itb + nc) * 8192 + e * 64 + 4 * kq;
#pragma unroll
            for (int ct = 0; ct < 4; ++ct) { u32x2 o2; o2.x = pk2(Oa[ct][0], Oa[ct][1]); o2.y = pk2(Oa[ct][2], Oa[ct][3]); *(u32x2*)(obase + 16 * ct) = o2; }
            SCAN_BAR();
        }
    }
    __syncthreads();
}

__device__ __forceinline__ void phase_ya(const Prm& p, unsigned char* lds) {
    const bf16_t* OT = (const bf16_t*)(p.ws + OFF_H); bf16_t* SZA = (bf16_t*)p.out;
    const float* gw = p.in[7];
    bf16_t* sT = (bf16_t*)lds;
    float* sPart = (float*)(lds + 16384);
    const int tid = threadIdx.x, w = tid >> 6, c = tid & 63;
    for (int it = blockIdx.x; it < NIT; it += gridDim.x) {
        const int b = it >> 10, h = (it >> 7) & 7, nc = it & 127;
        const size_t tok = (size_t)b * SEQ + (size_t)nc * 64 + c;
#pragma unroll
        for (int i = 0; i < 2; ++i) { const int ch = tid + 512 * i; *(u32x4*)(sT + ch * 8) = *(const u32x4*)(OT + (size_t)it * 8192 + ch * 8); }
        const u32x4 z0 = *(const u32x4*)(SZA + tok * 1024 + h * 128 + 16 * w), z1 = *(const u32x4*)(SZA + tok * 1024 + h * 128 + 16 * w + 8);
        __syncthreads();
        float o[16]; float ss = 0.f;
#pragma unroll
        for (int j = 0; j < 16; ++j) { o[j] = bf2f(sT[(16 * w + j) * 64 + c]); ss += o[j] * o[j]; }
        sPart[w * 64 + c] = ss;
        __syncthreads();
        float tot = 0.f;
#pragma unroll
        for (int k = 0; k < 8; ++k) tot += sPart[k * 64 + c];
        const float rstd = rsqrtf(tot * (1.0f / 128.0f) + 1e-6f);
        const unsigned zz[8] = {z0.x, z0.y, z0.z, z0.w, z1.x, z1.y, z1.z, z1.w};
        unsigned r[8];
#pragma unroll
        for (int j = 0; j < 8; ++j)
            r[j] = pk2(o[2 * j] * rstd * gw[16 * w + 2 * j] * lo2f(zz[j]), o[2 * j + 1] * rstd * gw[16 * w + 2 * j + 1] * hi2f(zz[j]));
        *(u32x4*)(SZA + tok * 1024 + h * 128 + 16 * w) = (u32x4){r[0], r[1], r[2], r[3]};
        *(u32x4*)(SZA + tok * 1024 + h * 128 + 16 * w + 8) = (u32x4){r[4], r[5], r[6], r[7]};
        __syncthreads();
    }
}
__device__ __forceinline__ void phase_conv3(const Prm& p) {
    const bf16_t* P = (const bf16_t*)(p.ws + OFF_P); bf16_t* Q = (bf16_t*)(p.ws + OFF_Q); const float* cw = p.in[19];
    const int nth = gridDim.x * 512;
    for (int idx = blockIdx.x * 512 + threadIdx.x; idx < TOK * 256; idx += nth) {
        const int t = idx >> 8, c8 = (idx & 255) * 8, ts = t & (SEQ - 1);
        const u32x4 z4 = (u32x4){0u, 0u, 0u, 0u};
        const u32x4 p0 = *(const u32x4*)(P + (size_t)t * 2048 + c8);
        const u32x4 p1 = ts >= 1 ? *(const u32x4*)(P + (size_t)(t - 1) * 2048 + c8) : z4;
        const u32x4 p2 = ts >= 2 ? *(const u32x4*)(P + (size_t)(t - 2) * 2048 + c8) : z4;
        const u32x4 q = *(const u32x4*)(Q + (size_t)t * 2048 + c8);
        float r[8];
        const unsigned pa[4] = {p0.x, p0.y, p0.z, p0.w}, pb[4] = {p1.x, p1.y, p1.z, p1.w}, pc[4] = {p2.x, p2.y, p2.z, p2.w}, qa[4] = {q.x, q.y, q.z, q.w};
#pragma unroll
        for (int e = 0; e < 4; ++e) {
            const int c = c8 + 2 * e;
            r[2 * e] = lo2f(qa[e]) * (cw[c] * lo2f(pc[e]) + cw[2048 + c] * lo2f(pb[e]) + cw[4096 + c] * lo2f(pa[e]));
            r[2 * e + 1] = hi2f(qa[e]) * (cw[c + 1] * hi2f(pc[e]) + cw[2048 + c + 1] * hi2f(pb[e]) + cw[4096 + c + 1] * hi2f(pa[e]));
        }
        u32x4 o; o.x = pk2(r[0], r[1]); o.y = pk2(r[2], r[3]); o.z = pk2(r[4], r[5]); o.w = pk2(r[6], r[7]);
        *(u32x4*)(Q + (size_t)t * 2048 + c8) = o;
    }
}

#define XB_TMO      128
#define XB_XCNT(j)  (256  + 64 * (j))
#define XB_XSUB(j)  (1280 + 64 * (j))
#define XB_XGEN(j)  (2304 + 64 * (j))
#define XB_TOP      3328
#define XB_TOPGEN   3392
#define XCD_BAR_WORDS 3456
#define XB_SPIN_CAP (1u << 18)

__device__ __forceinline__ unsigned xb_ld(unsigned* p)              { return __hip_atomic_load(p, __ATOMIC_RELAXED, __HIP_MEMORY_SCOPE_AGENT); }
__device__ __forceinline__ unsigned xb_add(unsigned* p, unsigned v) { return __hip_atomic_fetch_add(p, v, __ATOMIC_RELAXED, __HIP_MEMORY_SCOPE_AGENT); }
__device__ __forceinline__ unsigned xb_xcc_id() { return (unsigned)__builtin_amdgcn_s_getreg((3 << 11) | 20) & 0xFu; }
#define XB_SPIN(cond, bar) do { unsigned _sp = 0; while (cond) { __builtin_amdgcn_s_sleep(1); \
    if ((++_sp & 255u) == 0u) { if (xb_ld(&(bar)[XB_TMO])) break; if (_sp > XB_SPIN_CAP) { atomicAdd(&(bar)[XB_TMO], 1u); break; } } } } while (0)

struct XcdBarrier {
    unsigned* bar; unsigned x;
    volatile LAS unsigned* st;
};

__device__ __forceinline__ XcdBarrier xcd_barrier_post(unsigned* bar, volatile LAS unsigned* st) {
    XcdBarrier b; b.bar = bar; b.x = xb_xcc_id(); b.st = st;
    if (threadIdx.x == 0) (void)xb_add(&bar[XB_XCNT(b.x)], 1u);
    return b;
}
__device__ __forceinline__ void xcd_barrier_complete(unsigned* bar, unsigned x, unsigned& nloc, unsigned& nx) {
    const unsigned G = gridDim.x * gridDim.y * gridDim.z;
    unsigned sum, cnt, mine, sp = 0u;
    for (;;) {
        sum = 0u; cnt = 0u; mine = 0u;
#pragma unroll
        for (unsigned j = 0; j < 16; ++j) { const unsigned c = xb_ld(&bar[XB_XCNT(j)]); sum += c; cnt += (c > 0u) ? 1u : 0u; mine = (j == x) ? c : mine; }
        if (sum == G) break;
        __builtin_amdgcn_s_sleep(1);
        if ((++sp & 255u) == 0u) { if (xb_ld(&bar[XB_TMO])) break; if (sp > XB_SPIN_CAP) { atomicAdd(&bar[XB_TMO], 1u); break; } }
    }
    nloc = mine > 0u ? mine : 1u; nx = cnt > 0u ? cnt : 1u;
}

__device__ __forceinline__ void xcd_barrier(const XcdBarrier& b) {
    asm volatile("s_waitcnt vmcnt(0)" ::: "memory");
    __syncthreads();
    if (threadIdx.x == 0) {
        unsigned* bar = b.bar;
        __builtin_amdgcn_s_waitcnt(0);
        unsigned nloc = b.st[0], nx = b.st[1];
        if (nloc == 0u) { xcd_barrier_complete(bar, b.x, nloc, nx); b.st[0] = nloc; b.st[1] = nx; }
        const unsigned old = xb_add(&bar[XB_XSUB(b.x)], 1u);
        const unsigned gen = old / nloc;
        if (old + 1u == (gen + 1u) * nloc) {
            __builtin_amdgcn_fence(__ATOMIC_RELEASE, "agent");
            asm volatile("s_waitcnt vmcnt(0)" ::: "memory");
            const unsigned og = xb_add(&bar[XB_TOP], 1u);
            const unsigned tg = og / nx;
            if (og + 1u == (tg + 1u) * nx) xb_add(&bar[XB_TOPGEN], 1u);
            else XB_SPIN(xb_ld(&bar[XB_TOPGEN]) == tg, bar);
            __builtin_amdgcn_fence(__ATOMIC_ACQUIRE, "agent");
            xb_add(&bar[XB_XGEN(b.x)], 1u);
            asm volatile("s_waitcnt vmcnt(0)" ::: "memory");
        } else {
            XB_SPIN(xb_ld(&bar[XB_XGEN(b.x)]) == gen, bar);
            __builtin_amdgcn_fence(__ATOMIC_ACQUIRE, "agent");
            asm volatile("s_waitcnt vmcnt(0)" ::: "memory");
        }
    }
    __syncthreads();
}

constexpr int NPHASE = 11;
#define REP_GEMM 1
#define REP_SYNC 1
#define REP_SCAN 1
#define SCAN_PROBE 1
#define REP_P0 1
#ifndef PHM
#define PHM 0x7FF
#endif
__global__ void __launch_bounds__(512, 2) mega(Prm p) {
    extern __shared__ __attribute__((aligned(16))) unsigned char shm[];
    LAS unsigned char* lds3 = (LAS unsigned char*)shm;
    unsigned char* ws = p.ws;
    volatile LAS unsigned* xst = (volatile LAS unsigned*)(lds3 + LDS_BYTES);
    if (threadIdx.x == 0) { xst[0] = 0u; xst[1] = 0u; }
    __syncthreads();
    XcdBarrier xb{};
    const bool multi = (p.ph_hi - p.ph_lo) > 1;
    if (multi) xb = xcd_barrier_post((unsigned*)(ws + OFF_BAR), xst);
    if (p.ph_lo < 0) cg::this_grid().sync();
#define PH_BEGIN(i) if (((PHM >> (i)) & 1) && p.ph_lo <= (i) && (i) < p.ph_hi) { if ((i) > p.ph_lo) { xcd_barrier(xb); if (REP_SYNC > 1) xcd_barrier(xb); } pg8::StaticOrder S; (void)S;
#define PH_END }
    PH_BEGIN(0)
        for (int rep = 0; rep < REP_P0; ++rep) {
        phase_convert(p, shm, 0, 1856, gridDim.x, blockIdx.x);
        phase_rmsnorm_x(p.in[0], p.in[1], (bf16_t*)(ws + OFF_H)); __syncthreads(); }
    PH_END
    PH_BEGIN(1)
        pg8::Gemm g{(const bf16_t*)(ws + OFF_H), (const bf16_t*)(ws + OFF_WT1), TOK, NP1, 1024, (const bf16_t*)(ws + OFF_H), 1024, 64};
        Epi1 E{(bf16_t*)(ws + OFF_QKV), (bf16_t*)p.out, (bf16_t*)(ws + OFF_UU), (bf16_t*)p.out + (size_t)TOK * 1024, (float*)(ws + OFF_BA), (bf16_t*)(ws + OFF_HALO)};
        S.init(TOK, NP1, gridDim.x, blockIdx.x); for (int rep = 0; rep < REP_GEMM; ++rep) { pg8::gemm_phase(lds3, g, S, E); __syncthreads(); }
    PH_END
    PH_BEGIN(2)
        {
            unsigned* ctr = (unsigned*)(ws + OFF_BAR) + 3600;
            volatile LAS unsigned* sIt = xst + 2;
            for (;;) {
                if (threadIdx.x == 0) sIt[0] = __hip_atomic_fetch_add(ctr, 2u, __ATOMIC_RELAXED, __HIP_MEMORY_SCOPE_AGENT);
                __syncthreads();
                const unsigned it0 = sIt[0];
                __syncthreads();
                if (it0 >= (unsigned)NIT) break;
                phase_gdn_prep(p, shm, (int)it0, 1);
            }
        }
    PH_END
    PH_BEGIN(3)
        if (blockIdx.x < 32) phase_gdn_scan(p, shm, blockIdx.x);
        else {
            const int ob = blockIdx.x - 32, nob = gridDim.x - 32;
            if (ob < 128) phase_s5(p, shm, ob);
            {
                unsigned* cnt = (unsigned*)(ws + OFF_BAR) + 3700;
                asm volatile("s_waitcnt vmcnt(0)" ::: "memory");
                __syncthreads();
                if (threadIdx.x == 0) {
                    __builtin_amdgcn_fence(__ATOMIC_RELEASE, "agent");
                    asm volatile("s_waitcnt vmcnt(0)" ::: "memory");
                    __hip_atomic_fetch_add(cnt, 1u, __ATOMIC_RELAXED, __HIP_MEMORY_SCOPE_AGENT);
                    unsigned sp = 0;
                    while (__hip_atomic_load(cnt, __ATOMIC_RELAXED, __HIP_MEMORY_SCOPE_AGENT) < (unsigned)nob) { __builtin_amdgcn_s_sleep(2); if (++sp > (1u << 22)) break; }
                    __builtin_amdgcn_fence(__ATOMIC_ACQUIRE, "agent");
                    asm volatile("s_waitcnt vmcnt(0)" ::: "memory");
                }
                __syncthreads();
            }
            pg8::Gemm g{(const bf16_t*)(ws + OFF_UU), (const bf16_t*)(ws + OFF_WTG), TOK, 1024, 1024, (const bf16_t*)(ws + OFF_UU), 1024, 64};
            EpiGlu E{(const bf16_t*)(ws + OFF_UU), (bf16_t*)p.out + (size_t)TOK * 1024};
            S.init(TOK, 1024, nob, ob); pg8::gemm_phase(lds3, g, S, E);
            __syncthreads();
            if (ob >= 32) phase_convert(p, shm, 1856, 4928, nob - 32, ob - 32);
        }
    PH_END
    PH_BEGIN(4)
        phase_ya(p, shm);
    PH_END
    PH_BEGIN(5)
        pg8::Gemm g{(const bf16_t*)p.out, (const bf16_t*)(ws + OFF_WTO0), TOK, 1024, 2048, (const bf16_t*)p.out + (size_t)TOK * 1024, 1024, 16};
        EpiB16 E{(bf16_t*)(ws + OFF_QKV)};
        S.init(TOK, 1024, gridDim.x, blockIdx.x); for (int rep = 0; rep < REP_GEMM; ++rep) { pg8::gemm_phase(lds3, g, S, E); __syncthreads(); }
    PH_END
    PH_BEGIN(6)
        phase_post<true>(p.in[0], (const bf16_t*)(ws + OFF_QKV), p.in[2], p.out, p.in[1] + 1024, (bf16_t*)(ws + OFF_H));
    PH_END
    PH_BEGIN(7)
        pg8::Gemm g{(const bf16_t*)(ws + OFF_H), (const bf16_t*)(ws + OFF_WT2), TOK, 8192, 1024, (const bf16_t*)(ws + OFF_H), 1024, 64};
        Epi2 E{(bf16_t*)(ws + OFF_P), (bf16_t*)(ws + OFF_Q)};
        S.init(TOK, 8192, gridDim.x, blockIdx.x); for (int rep = 0; rep < REP_GEMM; ++rep) { pg8::gemm_phase(lds3, g, S, E); __syncthreads(); }
    PH_END
    PH_BEGIN(8)
        phase_conv3(p);
    PH_END
    PH_BEGIN(9)
        pg8::Gemm g{(const bf16_t*)(ws + OFF_Q), (const bf16_t*)(ws + OFF_WTO1), TOK, 1024, 2048, (const bf16_t*)(ws + OFF_Q), 2048, 64};
        EpiB16 E{(bf16_t*)(ws + OFF_P)};
        S.init(TOK, 1024, gridDim.x, blockIdx.x); for (int rep = 0; rep < REP_GEMM; ++rep) { pg8::gemm_phase(lds3, g, S, E); __syncthreads(); }
    PH_END
    PH_BEGIN(10)
        phase_post<false>(p.out, (const bf16_t*)(ws + OFF_P), p.in[2] + 1024, p.out, nullptr, nullptr);
    PH_END
}

#ifndef N_LAUNCH_MODE
#define N_LAUNCH_MODE 1
#endif

extern "C" void kernel_launch(void* const* d_in, const int* in_sizes, int n_in, void* d_out, int out_size, void* d_ws, size_t ws_size, hipStream_t stream) {
    static int ready = 0;
    if (!ready) {
        if (n_in != 21 || ws_size < WS_END || out_size != TOK * DM) { fprintf(stderr, "kernel_launch: unexpected shapes (n_in %d ws %zu out %d)\n", n_in, ws_size, out_size); ready = -1; return; }
        if (hipFuncSetAttribute((const void*)mega, hipFuncAttributeMaxDynamicSharedMemorySize, LDS_BYTES + 16) != hipSuccess) { fprintf(stderr, "kernel_launch: hipFuncSetAttribute failed\n"); ready = -1; return; }
        ready = 1;
    }
    if (ready < 0) return;
    Prm p{};
    for (int i = 0; i < 21; ++i) p.in[i] = (const float*)d_in[i];
    p.out = (float*)d_out; p.ws = (unsigned char*)d_ws;
#if N_LAUNCH_MODE == 1
    p.ph_lo = 0; p.ph_hi = NPHASE;
    void* args[] = {&p};
    if (hipMemsetAsync((unsigned char*)d_ws + OFF_BAR, 0, 16384, stream) != hipSuccess) { fprintf(stderr, "memset failed\n"); return; }
    hipError_t e = hipLaunchCooperativeKernel((const void*)mega, dim3(256), dim3(512), args, LDS_BYTES + 16, stream);
    if (e != hipSuccess) fprintf(stderr, "cooperative launch failed: %s\n", hipGetErrorString(e));
#else
    for (int ph = 0; ph < NPHASE; ++ph) {
        p.ph_lo = ph; p.ph_hi = ph + 1;
        hipLaunchKernelGGL(mega, dim3(256), dim3(512), LDS_BYTES + 16, stream, p);
    }
#endif
}
```

```cpp
#include <hip/hip_runtime.h>
#include <hip/hip_cooperative_groups.h>
#include <cstdio>
namespace cg = cooperative_groups;

#define LAS __attribute__((address_space(3)))
typedef unsigned short bf16_t;
typedef short bf16x8 __attribute__((ext_vector_type(8)));
typedef float f32x4 __attribute__((ext_vector_type(4)));
typedef float f32x16 __attribute__((ext_vector_type(16)));
typedef unsigned u32x4 __attribute__((ext_vector_type(4)));
typedef unsigned u32x2 __attribute__((ext_vector_type(2)));

constexpr int TOK = 16384, DM = 1024, SEQ = 8192;
constexpr int NP1 = 6400;
constexpr int NIT = 2048;

constexpr size_t OFF_WT1 = 0;
constexpr size_t OFF_WTG = OFF_WT1 + (size_t)NP1 * 1024 * 2;
constexpr size_t OFF_WTO0 = OFF_WTG + (size_t)1024 * 1024 * 2;
constexpr size_t OFF_WT2 = OFF_WTO0 + (size_t)1024 * 2048 * 2;
constexpr size_t OFF_WTO1 = OFF_WT2 + (size_t)8192 * 1024 * 2;
constexpr size_t OFF_H = OFF_WTO1 + (size_t)1024 * 2048 * 2;
constexpr size_t OFF_QKV = OFF_H + (size_t)TOK * 1024 * 2;
constexpr size_t OFF_UU = OFF_QKV + (size_t)TOK * 3072 * 2;
constexpr size_t OFF_WB = OFF_UU + (size_t)TOK * 1024 * 2;
constexpr size_t OFF_ATT = OFF_WB + (size_t)NIT * 8192 * 2;
constexpr size_t OFF_HALO = OFF_ATT + (size_t)NIT * 4096 * 2;
constexpr size_t OFF_BA = OFF_HALO + (size_t)256 * 3 * 3072 * 2;
constexpr size_t OFF_GL = OFF_BA + (size_t)TOK * 16 * 4;
constexpr size_t OFF_BAR = OFF_GL + (size_t)NIT * 4;
constexpr size_t WS_END = OFF_BAR + 16384;
constexpr size_t OFF_YMIX = OFF_QKV;
constexpr size_t OFF_P = OFF_QKV;
constexpr size_t OFF_Q = OFF_QKV + (size_t)TOK * 2048 * 2;
static_assert(OFF_Q + (size_t)TOK * 2048 * 2 <= OFF_WB, "Q overlaps live data");
static_assert(WS_END <= (size_t)256 * 1024 * 1024, "workspace too big");

constexpr int LDS_BYTES = 157696;

struct Prm {
    const float* in[21];
    float* out;
    unsigned char* ws;
    int ph_lo, ph_hi;
};

__device__ __forceinline__ float bf2f(bf16_t b) { return __uint_as_float(((unsigned)b) << 16); }
__device__ __forceinline__ bf16_t f2bf(float f) { unsigned u = __float_as_uint(f); u += 0x7FFFu + ((u >> 16) & 1u); return (bf16_t)(u >> 16); }
typedef __bf16 bf16v2_t __attribute__((ext_vector_type(2)));
typedef float f32x2_t __attribute__((ext_vector_type(2)));
__device__ __forceinline__ unsigned pk2(float lo, float hi) { const f32x2_t v = {lo, hi}; return __builtin_bit_cast(unsigned, __builtin_convertvector(v, bf16v2_t)); }
__device__ __forceinline__ float lo2f(unsigned u) { return __uint_as_float(u << 16); }
__device__ __forceinline__ float hi2f(unsigned u) { return __uint_as_float(u & 0xFFFF0000u); }
__device__ __forceinline__ float sigmoidf_(float x) { return 1.0f / (1.0f + __expf(-x)); }
__device__ __forceinline__ float siluf_(float x) { return x / (1.0f + __expf(-x)); }
__device__ __forceinline__ float wave_sum(float v) {
#pragma unroll
    for (int o = 32; o >= 1; o >>= 1) v += __shfl_xor(v, o);
    return v;
}
__device__ __forceinline__ u32x4 pack8(f32x4 a, f32x4 b) { u32x4 r; r.x = pk2(a[0], a[1]); r.y = pk2(a[2], a[3]); r.z = pk2(b[0], b[1]); r.w = pk2(b[2], b[3]); return r; }

namespace pg8 {
constexpr int BM = 256, BK = 64, HALF = 128, HTB = HALF * BK * 2, STAGE_BYTES = 8 * HTB, NXCD = 8, WGM = 8;
__device__ __forceinline__ int lds_byte(int r, int c) { const int st = (r >> 4) * 2 + (c >> 5), rr = r & 15, cc = c & 31, ob = rr * 64 + cc * 2; return st * 1024 + (ob ^ (((ob >> 9) & 1) << 5)); }
__device__ __forceinline__ void stage_rc(int b, int& R, int& C) { const int st = b / 1024, sb = b % 1024, swz = sb ^ (((sb >> 9) & 1) << 5); R = (st >> 1) * 16 + swz / 64; C = (st & 1) * 32 + (swz % 64) / 2; }
__device__ __forceinline__ int perm32(int rho) { const int n = rho >> 4, i = rho & 15; return 8 * (i >> 2) + 4 * n + (i & 3); }
struct Unit { int pm, pn; };
struct Gemm { const bf16_t* A; const bf16_t* Bt; int M, N, K; const bf16_t* A2; int lda, ks; };
struct StaticOrder {
    int nM, nN, nwg, G, c;
    __device__ void init(int M, int N, int G_, int c_) { nM = M / BM; nN = N / BM; nwg = nM * nN; G = G_; c = c_; }
    __device__ bool next(int i, Unit& u) const {
        const long L = (long)i * G + c; if (L >= nwg) return false;
        int wgid = (int)L; { const int q = nwg / NXCD, r = nwg % NXCD, xcd = wgid % NXCD, off = wgid / NXCD; wgid = (xcd < r ? xcd * (q + 1) : r * (q + 1) + (xcd - r) * q) + off; }
        const int nig = WGM * nN, gid = wgid / nig, fm = gid * WGM, gsz = (nM - fm) < WGM ? (nM - fm) : WGM;
        u.pm = fm + ((wgid % nig) % gsz); u.pn = (wgid % nig) / gsz; return true;
    }
};

template <class Epi>
__device__ __forceinline__ void gemm_phase(LAS unsigned char* lds, const Gemm g, const StaticOrder& S, const Epi& E) {
    const int tid = threadIdx.x, wid = __builtin_amdgcn_readfirstlane(tid >> 6), lane = tid & 63, wr = wid >> 2, wc = wid & 3, fr = lane & 15, fq = lane >> 4;
    const int K = g.K, nt = K / BK;
    unsigned voffA[2], voffB[2];
#pragma unroll
    for (int i = 0; i < 2; ++i) { int R, C; stage_rc(tid * 16 + i * 8192, R, C); const int Rb = Epi::PERM ? ((R & ~31) + perm32(R & 31)) : R;
        voffA[i] = (unsigned)(R * g.lda + C) * 2u; voffB[i] = (unsigned)(Rb * K + C) * 2u; }
    const size_t kstep = (size_t)(BK * 2);
    const size_t hstep = (size_t)HALF * K * 2;
    const size_t tstep = 2 * hstep;
    const size_t hstepA = (size_t)HALF * g.lda * 2, tstepA = 2 * hstepA;
    const int ks = g.ks; const ptrdiff_t a2off = (const char*)g.A2 - (const char*)g.A - (ptrdiff_t)ks * (ptrdiff_t)kstep;
    const unsigned ldsw = (unsigned)wid * 1024u;
    const int aoff = lds_byte(wr * 64 + fr, fq * 8), boff = lds_byte(wc * 32 + fr, fq * 8);
#define PG8_SA(b, h) (((b) * 2 + (h)) * HTB)
#define PG8_SB(b, h) ((4 + (b) * 2 + (h)) * HTB)
#define PG8_STAGE(bufoff, gbase, voff) do { _Pragma("unroll") for (int _i = 0; _i < 2; ++_i) \
        __builtin_amdgcn_global_load_lds((const unsigned*)((const char*)(gbase) + (voff)[_i]), (LAS unsigned*)(lds + (bufoff) + ldsw + _i * 8192), 16, 0, 0); } while (0)
#define PG8_LDA(dst, b, h) do { _Pragma("unroll") for (int m = 0; m < 4; ++m) _Pragma("unroll") for (int k = 0; k < 2; ++k) dst[m][k] = *(const LAS bf16x8*)(lds + PG8_SA(b, h) + aoff + m * 2048 + k * 1024); } while (0)
#define PG8_LDB(dst, b, h) do { _Pragma("unroll") for (int n = 0; n < 2; ++n) _Pragma("unroll") for (int k = 0; k < 2; ++k) dst[n][k] = *(const LAS bf16x8*)(lds + PG8_SB(b, h) + boff + n * 2048 + k * 1024); } while (0)
#define PG8_MMA(ai, bj, At, Bt) do { __builtin_amdgcn_s_setprio(1); _Pragma("unroll") for (int m = 0; m < 4; ++m) _Pragma("unroll") for (int n = 0; n < 2; ++n) _Pragma("unroll") for (int k = 0; k < 2; ++k) \
        acc[ai][bj][m][n] = __builtin_amdgcn_mfma_f32_16x16x32_bf16(Bt[n][k], At[m][k], acc[ai][bj][m][n], 0, 0, 0); __builtin_amdgcn_s_setprio(0); } while (0)
#define PG8_WAIT_V(n) asm volatile("s_waitcnt vmcnt(" #n ")" ::: "memory")
#define PG8_WAIT_L(n) asm volatile("s_waitcnt lgkmcnt(" #n ")" ::: "memory")
#define PG8_BAR __builtin_amdgcn_s_barrier()
#define PG8_SCHED __builtin_amdgcn_sched_barrier(0)
    Unit cur, nxt; int ui = 0;
    if (!S.next(0, cur)) return;
    f32x4 acc[2][2][4][2];
#pragma unroll
    for (int a = 0; a < 2; ++a)
#pragma unroll
        for (int b = 0; b < 2; ++b)
#pragma unroll
            for (int m = 0; m < 4; ++m)
#pragma unroll
                for (int n = 0; n < 2; ++n) acc[a][b][m][n] = (f32x4){0.f, 0.f, 0.f, 0.f};
    bf16x8 At[4][2], B0[2][2], B1[2][2];
    const char* cA = (const char*)g.A + (size_t)cur.pm * tstepA; const char* cB = (const char*)g.Bt + (size_t)cur.pn * tstep;
    PG8_STAGE(PG8_SB(0, 0), cB, voffB); PG8_STAGE(PG8_SA(0, 0), cA, voffA); PG8_STAGE(PG8_SB(0, 1), cB + hstep, voffB); PG8_STAGE(PG8_SA(0, 1), cA + hstepA, voffA);
    if (wr == 1) PG8_BAR;
    PG8_WAIT_V(4); PG8_BAR;
    PG8_STAGE(PG8_SB(1, 0), cB + kstep, voffB); PG8_STAGE(PG8_SA(1, 0), cA + kstep, voffA); PG8_STAGE(PG8_SB(1, 1), cB + hstep + kstep, voffB);
    PG8_WAIT_V(6); PG8_BAR;
    for (;;) {
        const bool has_next = S.next(ui + 1, nxt);
        const char* nA = has_next ? (const char*)g.A + (size_t)nxt.pm * tstepA : cA; const char* nB = has_next ? (const char*)g.Bt + (size_t)nxt.pn * tstep : cB;
        for (int t = 0; t < nt; t += 2) {
            const bool last = (t == nt - 2);
            const char* a1 = cA + (size_t)(t + 1) * kstep + ((t + 1) >= ks ? a2off : 0);
            const char* a2 = last ? nA : cA + (size_t)(t + 2) * kstep + ((t + 2) >= ks ? a2off : 0); const char* b2 = last ? nB : cB + (size_t)(t + 2) * kstep;
            const char* a3 = last ? nA + kstep : cA + (size_t)(t + 3) * kstep + ((t + 3) >= ks ? a2off : 0); const char* b3 = b2 + kstep;
            PG8_LDB(B0, 0, 0); PG8_SCHED; PG8_LDA(At, 0, 0); PG8_STAGE(PG8_SA(1, 1), a1 + hstepA, voffA);
            PG8_WAIT_L(8); PG8_BAR; PG8_WAIT_L(0); PG8_MMA(0, 0, At, B0); PG8_BAR; PG8_SCHED;
            PG8_LDB(B1, 0, 1); PG8_STAGE(PG8_SB(0, 0), b2, voffB);
            PG8_BAR; PG8_WAIT_L(0); PG8_MMA(0, 1, At, B1); PG8_BAR;
            PG8_LDA(At, 0, 1); PG8_STAGE(PG8_SA(0, 0), a2, voffA);
            PG8_BAR; PG8_WAIT_L(0); PG8_MMA(1, 0, At, B0); PG8_BAR; PG8_SCHED;
            PG8_STAGE(PG8_SB(0, 1), b2 + hstep, voffB);
            PG8_WAIT_V(6); PG8_BAR; PG8_MMA(1, 1, At, B1); PG8_BAR;
            PG8_LDB(B0, 1, 0); PG8_SCHED; PG8_LDA(At, 1, 0); PG8_STAGE(PG8_SA(0, 1), a2 + hstepA, voffA);
            PG8_WAIT_L(8); PG8_BAR; PG8_WAIT_L(0); PG8_MMA(0, 0, At, B0); PG8_BAR; PG8_SCHED;
            PG8_LDB(B1, 1, 1); PG8_STAGE(PG8_SB(1, 0), b3, voffB);
            PG8_BAR; PG8_WAIT_L(0); PG8_MMA(0, 1, At, B1); PG8_BAR;
            PG8_LDA(At, 1, 1); PG8_STAGE(PG8_SA(1, 0), a3, voffA);
            PG8_BAR; PG8_WAIT_L(0); PG8_MMA(1, 0, At, B0); PG8_BAR; PG8_SCHED;
            PG8_STAGE(PG8_SB(1, 1), b3 + hstep, voffB);
            PG8_WAIT_V(6); PG8_BAR; PG8_MMA(1, 1, At, B1); PG8_BAR;
        }
        E(acc, cur, wr, wc, fr, fq);
        if (!has_next) break;
#pragma unroll
        for (int a = 0; a < 2; ++a)
#pragma unroll
            for (int b = 0; b < 2; ++b)
#pragma unroll
                for (int m = 0; m < 4; ++m)
#pragma unroll
                    for (int n = 0; n < 2; ++n) acc[a][b][m][n] = (f32x4){0.f, 0.f, 0.f, 0.f};
        cur = nxt; cA = nA; cB = nB; ++ui;
    }
    PG8_WAIT_V(0);
    if (wr == 0) PG8_BAR;
    PG8_BAR;
#undef PG8_SA
#undef PG8_SB
#undef PG8_STAGE
#undef PG8_LDA
#undef PG8_LDB
#undef PG8_MMA
#undef PG8_WAIT_V
#undef PG8_WAIT_L
#undef PG8_BAR
#undef PG8_SCHED
}
}
using pg8::Unit;

struct Epi1 {
    static constexpr bool PERM = true;
    bf16_t* QKV; bf16_t* SZA; bf16_t* UU; bf16_t* SZB; float* BA; bf16_t* HALO;
    __device__ __forceinline__ void operator()(const f32x4 (&acc)[2][2][4][2], const Unit& u, int wr, int wc, int fr_, int fq_) const {
        int lane = (int)(threadIdx.x & 63); asm volatile("" : "+v"(lane));
        const int fr = lane & 15, fq = lane >> 4; (void)fr_; (void)fq_;
        const int row0 = u.pm * 256 + wr * 64 + fr, pn = u.pn;
#pragma unroll
        for (int ai = 0; ai < 2; ++ai)
#pragma unroll
            for (int m = 0; m < 4; ++m) {
                const size_t row = (size_t)(row0 + ai * 128 + m * 16);
#pragma unroll
                for (int bj = 0; bj < 2; ++bj) {
                    const int colt = 128 * bj + 32 * wc + 8 * fq;
                    f32x4 v0 = acc[ai][bj][m][0], v1 = acc[ai][bj][m][1];
                    if (pn < 12) {
                        const int c = pn * 256 + colt; const u32x4 pk = pack8(v0, v1);
                        *(u32x4*)(QKV + row * 3072 + c) = pk;
                        if (m == 3 && fr >= 13) *(u32x4*)(HALO + ((row >> 6) * 3 + (fr - 13)) * 3072 + c) = pk;
                    } else if (pn < 16) {
#pragma unroll
                        for (int e = 0; e < 4; ++e) { v0[e] = siluf_(v0[e]); v1[e] = siluf_(v1[e]); }
                        *(u32x4*)(SZA + row * 1024 + (pn - 12) * 256 + colt) = pack8(v0, v1);
                    } else if (pn < 20) {
                        *(u32x4*)(UU + row * 1024 + (pn - 16) * 256 + colt) = pack8(v0, v1);
                    } else if (pn < 24) {
#pragma unroll
                        for (int e = 0; e < 4; ++e) { v0[e] = siluf_(v0[e]); v1[e] = siluf_(v1[e]); }
                        *(u32x4*)(SZB + row * 1024 + (pn - 20) * 256 + colt) = pack8(v0, v1);
                    } else if (colt < 16) {
                        *(f32x4*)(BA + row * 16 + colt) = v0; *(f32x4*)(BA + row * 16 + colt + 4) = v1;
                    }
                }
            }
    }
};
struct EpiGlu {
    static constexpr bool PERM = true;
    const bf16_t* Y5; bf16_t* SZB;
    __device__ __forceinline__ void operator()(const f32x4 (&acc)[2][2][4][2], const Unit& u, int wr, int wc, int fr, int fq) const {
        const int row0 = u.pm * 256 + wr * 64 + fr;
#pragma unroll
        for (int ai = 0; ai < 2; ++ai)
#pragma unroll
            for (int m = 0; m < 4; ++m) {
                const size_t row = (size_t)(row0 + ai * 128 + m * 16);
#pragma unroll
                for (int bj = 0; bj < 2; ++bj) {
                    const int c = u.pn * 256 + 128 * bj + 32 * wc + 8 * fq;
                    const u32x4 y = *(const u32x4*)(Y5 + row * 1024 + c), z = *(const u32x4*)(SZB + row * 1024 + c);
                    const f32x4 a0 = acc[ai][bj][m][0], a1 = acc[ai][bj][m][1];
                    u32x4 o;
                    o.x = pk2(lo2f(y.x) * sigmoidf_(a0[0]) * lo2f(z.x), hi2f(y.x) * sigmoidf_(a0[1]) * hi2f(z.x));
                    o.y = pk2(lo2f(y.y) * sigmoidf_(a0[2]) * lo2f(z.y), hi2f(y.y) * sigmoidf_(a0[3]) * hi2f(z.y));
                    o.z = pk2(lo2f(y.z) * sigmoidf_(a1[0]) * lo2f(z.z), hi2f(y.z) * sigmoidf_(a1[1]) * hi2f(z.z));
                    o.w = pk2(lo2f(y.w) * sigmoidf_(a1[2]) * lo2f(z.w), hi2f(y.w) * sigmoidf_(a1[3]) * hi2f(z.w));
                    *(u32x4*)(SZB + row * 1024 + c) = o;
                }
            }
    }
};
struct EpiF32 {
    static constexpr bool PERM = false;
    float* C;
    __device__ __forceinline__ void operator()(const f32x4 (&acc)[2][2][4][2], const Unit& u, int wr, int wc, int fr, int fq) const {
        const int row0 = u.pm * 256 + wr * 64 + fr, col0 = u.pn * 256 + wc * 32 + 4 * fq;
#pragma unroll
        for (int ai = 0; ai < 2; ++ai)
#pragma unroll
            for (int m = 0; m < 4; ++m) { float* rowp = C + (size_t)(row0 + ai * 128 + m * 16) * 1024 + col0;
#pragma unroll
                for (int bj = 0; bj < 2; ++bj)
#pragma unroll
                    for (int n = 0; n < 2; ++n) *(f32x4*)(rowp + bj * 128 + n * 16) = acc[ai][bj][m][n]; }
    }
};
struct EpiB16 {
    static constexpr bool PERM = true;
    bf16_t* C;
    __device__ __forceinline__ void operator()(const f32x4 (&acc)[2][2][4][2], const Unit& u, int wr, int wc, int fr, int fq) const {
        const int row0 = u.pm * 256 + wr * 64 + fr, col0 = u.pn * 256 + wc * 32 + 8 * fq;
#pragma unroll
        for (int ai = 0; ai < 2; ++ai)
#pragma unroll
            for (int m = 0; m < 4; ++m) { bf16_t* rowp = C + (size_t)(row0 + ai * 128 + m * 16) * 1024 + col0;
#pragma unroll
                for (int bj = 0; bj < 2; ++bj) *(u32x4*)(rowp + bj * 128) = pack8(acc[ai][bj][m][0], acc[ai][bj][m][1]); }
    }
};
struct Epi2 {
    static constexpr bool PERM = false;
    bf16_t* P; bf16_t* Q;
    __device__ __forceinline__ void operator()(const f32x4 (&acc)[2][2][4][2], const Unit& u, int wr, int wc, int fr, int fq) const {
        const int row0 = u.pm * 256 + wr * 64 + fr, ch = u.pn * 64 + 16 * wc + 4 * fq;
#pragma unroll
        for (int ai = 0; ai < 2; ++ai)
#pragma unroll
            for (int m = 0; m < 4; ++m) {
                const size_t row = (size_t)(row0 + ai * 128 + m * 16);
                const f32x4 gb = acc[ai][0][m][0], gc = acc[ai][0][m][1], hv = acc[ai][1][m][0], z = acc[ai][1][m][1];
                u32x2 pp, qq;
                pp.x = pk2(gc[0] * hv[0], gc[1] * hv[1]); pp.y = pk2(gc[2] * hv[2], gc[3] * hv[3]);
                qq.x = pk2(gb[0] * siluf_(z[0]), gb[1] * siluf_(z[1])); qq.y = pk2(gb[2] * siluf_(z[2]), gb[3] * siluf_(z[3]));
                *(u32x2*)(P + row * 2048 + ch) = pp; *(u32x2*)(Q + row * 2048 + ch) = qq;
            }
    }
};

__device__ __forceinline__ int src_col(int mode, int n, int& pn_unused) {
    (void)pn_unused;
    if (mode == 0) return n;
    if (mode == 1) { if (n < 4096) return n; if (n < 6144) return n + 16; if (n < 6160) return n - 2048; return -1; }
    const int pn = n >> 8, col = n & 255, bj = col >> 7, wc = (col >> 5) & 3, nn = (col >> 4) & 1, lo = col & 15;
    return (2 * bj + nn) * 2048 + pn * 64 + 16 * wc + lo;
}
__device__ __forceinline__ void phase_convert(const Prm& p, unsigned char* lds, int t_begin, int t_end, int nblk, int bidx) {
    float* tile = (float*)lds;
    const int tid = threadIdx.x;
    for (int tix = t_begin + bidx; tix < t_end; tix += nblk) {
        int tl = tix, K, Nsrc, mode; const float* W; bf16_t* Wt;
        if (tl < 1600) { W = p.in[3]; Wt = (bf16_t*)(p.ws + OFF_WT1); K = 1024; Nsrc = 6160; mode = 1; }
        else if ((tl -= 1600) < 256) { W = p.in[16]; Wt = (bf16_t*)(p.ws + OFF_WTG); K = 1024; Nsrc = 1024; mode = 0; }
        else if ((tl -= 256) < 512) { W = p.in[17]; Wt = (bf16_t*)(p.ws + OFF_WTO0); K = 2048; Nsrc = 1024; mode = 0; }
        else if ((tl -= 512) < 2048) { W = p.in[18]; Wt = (bf16_t*)(p.ws + OFF_WT2); K = 1024; Nsrc = 8192; mode = 2; }
        else { tl -= 2048; W = p.in[20]; Wt = (bf16_t*)(p.ws + OFF_WTO1); K = 2048; Nsrc = 1024; mode = 0; }
        const int ntk = K / 64, n0 = (tl / ntk) * 64, k0 = (tl % ntk) * 64;
        { const int j = tid & 63; int dummy = 0; const int sc = src_col(mode, n0 + j, dummy);
#pragma unroll
          for (int i = 0; i < 8; ++i) { const int k = (tid >> 6) + 8 * i; tile[k * 65 + j] = sc >= 0 ? W[(size_t)(k0 + k) * Nsrc + sc] : 0.0f; } }
        __syncthreads();
        { const int r = tid >> 3, c8 = (tid & 7) * 8; u32x4 o;
          o.x = pk2(tile[(c8 + 0) * 65 + r], tile[(c8 + 1) * 65 + r]); o.y = pk2(tile[(c8 + 2) * 65 + r], tile[(c8 + 3) * 65 + r]);
          o.z = pk2(tile[(c8 + 4) * 65 + r], tile[(c8 + 5) * 65 + r]); o.w = pk2(tile[(c8 + 6) * 65 + r], tile[(c8 + 7) * 65 + r]);
          *(u32x4*)(Wt + (size_t)(n0 + r) * K + k0 + c8) = o; }
        __syncthreads();
    }
}
__device__ __forceinline__ void phase_rmsnorm_x(const float* x, const float* w, bf16_t* H) {
    const int lane = threadIdx.x & 63, nw = gridDim.x * 8;
    for (int row = blockIdx.x * 8 + (threadIdx.x >> 6); row < TOK; row += nw) {
        const f32x4* xr = (const f32x4*)(x + (size_t)row * 1024);
        f32x4 v[4]; float ss = 0.f;
#pragma unroll
        for (int i = 0; i < 4; ++i) { v[i] = xr[lane + 64 * i]; ss += v[i][0] * v[i][0] + v[i][1] * v[i][1] + v[i][2] * v[i][2] + v[i][3] * v[i][3]; }
        ss = wave_sum(ss);
        const float rstd = rsqrtf(ss * (1.0f / 1024.0f) + 1e-6f);
#pragma unroll
        for (int i = 0; i < 4; ++i) { const f32x4 w4 = ((const f32x4*)w)[lane + 64 * i]; u32x2 o;
            o.x = pk2(v[i][0] * rstd * w4[0], v[i][1] * rstd * w4[1]); o.y = pk2(v[i][2] * rstd * w4[2], v[i][3] * rstd * w4[3]);
            *(u32x2*)(H + (size_t)row * 1024 + (lane + 64 * i) * 4) = o; }
    }
}
template <bool NEXT>
__device__ __forceinline__ void phase_post(const float* base, const bf16_t* Y, const float* wpost, float* OUT, const float* wpre, bf16_t* H) {
    const int lane = threadIdx.x & 63, nw = gridDim.x * 8;
    for (int row = blockIdx.x * 8 + (threadIdx.x >> 6); row < TOK; row += nw) {
        const u32x2* yr = (const u32x2*)(Y + (size_t)row * 1024); const f32x4* br = (const f32x4*)(base + (size_t)row * 1024);
        f32x4 v[4], xb[4]; float ss = 0.f;
#pragma unroll
        for (int i = 0; i < 4; ++i) { const u32x2 y2 = yr[lane + 64 * i]; v[i] = (f32x4){lo2f(y2.x), hi2f(y2.x), lo2f(y2.y), hi2f(y2.y)}; xb[i] = br[lane + 64 * i]; ss += v[i][0] * v[i][0] + v[i][1] * v[i][1] + v[i][2] * v[i][2] + v[i][3] * v[i][3]; }
        ss = wave_sum(ss);
        const float rstd = rsqrtf(ss * (1.0f / 1024.0f) + 1e-6f);
        float s2 = 0.f;
#pragma unroll
        for (int i = 0; i < 4; ++i) { const f32x4 w4 = ((const f32x4*)wpost)[lane + 64 * i];
#pragma unroll
            for (int e = 0; e < 4; ++e) { v[i][e] = xb[i][e] + v[i][e] * rstd * w4[e]; s2 += v[i][e] * v[i][e]; }
            ((f32x4*)(OUT + (size_t)row * 1024))[lane + 64 * i] = v[i]; }
        if (NEXT) {
            s2 = wave_sum(s2);
            const float r2 = rsqrtf(s2 * (1.0f / 1024.0f) + 1e-6f);
#pragma unroll
            for (int i = 0; i < 4; ++i) { const f32x4 w4 = ((const f32x4*)wpre)[lane + 64 * i]; u32x2 o;
                o.x = pk2(v[i][0] * r2 * w4[0], v[i][1] * r2 * w4[1]); o.y = pk2(v[i][2] * r2 * w4[2], v[i][3] * r2 * w4[3]);
                *(u32x2*)(H + (size_t)row * 1024 + (lane + 64 * i) * 4) = o; }
        }
    }
}


__device__ __forceinline__ void sincos_d(double x, double& s, double& c) {
    const double k = rint(x * 0.6366197723675814);
    const double r = fma(-k, 6.123233995736766e-17, fma(-k, 1.5707963267948966, x)), r2 = r * r;
    double sp = -7.647163731819816e-13; sp = fma(sp, r2, 1.6059043836821613e-10); sp = fma(sp, r2, -2.505210838544172e-8); sp = fma(sp, r2, 2.7557319223985893e-6);
    sp = fma(sp, r2, -1.984126984126984e-4); sp = fma(sp, r2, 8.333333333333333e-3); sp = fma(sp, r2, -1.6666666666666666e-1); sp = fma(sp * r2, r, r);
    double cp = 4.779477332387385e-14; cp = fma(cp, r2, -1.1470745597729725e-11); cp = fma(cp, r2, 2.08767569878681e-9); cp = fma(cp, r2, -2.755731922398589e-7);
    cp = fma(cp, r2, 2.48015873015873e-5); cp = fma(cp, r2, -1.388888888888889e-3); cp = fma(cp, r2, 4.1666666666666664e-2); cp = fma(cp, r2, -0.5); cp = fma(cp, r2, 1.0);
    const int q = ((int)k) & 3;
    const double s0 = (q & 1) ? cp : sp, c0 = (q & 1) ? sp : cp;
    s = (q & 2) ? -s0 : s0; c = ((q + 1) & 2) ? -c0 : c0;
}
__device__ __forceinline__ double exp_d(double x) {
    const double n = rint(x * 1.4426950408889634);
    const double r = fma(-n, 2.3190468138462996e-17, fma(-n, 0.6931471805599453, x));
    double p = 1.6059043836821613e-10; p = fma(p, r, 2.08767569878681e-9); p = fma(p, r, 2.505210838544172e-8); p = fma(p, r, 2.755731922398589e-7); p = fma(p, r, 2.7557319223985893e-6);
    p = fma(p, r, 2.48015873015873e-5); p = fma(p, r, 1.984126984126984e-4); p = fma(p, r, 1.388888888888889e-3); p = fma(p, r, 8.333333333333333e-3); p = fma(p, r, 4.1666666666666664e-2);
    p = fma(p, r, 1.6666666666666666e-1); p = fma(p, r, 0.5); p = fma(p, r, 1.0); p = fma(p, r, 1.0);
    return ldexp(p, (int)n);
}
__device__ __forceinline__ float bcast_lo(float v) { auto r = __builtin_amdgcn_permlane32_swap(__float_as_uint(v), __float_as_uint(v), false, false); return __uint_as_float(r[0]); }
__device__ __forceinline__ float bcast_hi(float v) { auto r = __builtin_amdgcn_permlane32_swap(__float_as_uint(v), __float_as_uint(v), false, false); return __uint_as_float(r[1]); }

struct S5C {
    float ar[2][4], ai[2][4];
    float a512r[2], a512i[2];
    bf16x8 BB[4];
    bf16x8 CC[4];
    float dco;
};

template <bool OUT>
__device__ __forceinline__ void s5_chunk(const S5C& C, bf16_t* UU, int b, int g, int chunk, float (&st)[2][2], bf16_t* sX, int lane) {
    const int n = lane & 31, hh = lane >> 5, fr = lane & 15, fq = lane >> 4;
    const size_t tok0 = (size_t)b * SEQ + (size_t)chunk * 512;
    bf16x8 ua = *(const bf16x8*)(UU + (tok0 + n) * 1024 + 16 * g + 8 * hh);
    bf16_t uo[8];
    if (OUT) {
#pragma unroll
        for (int mt = 0; mt < 2; ++mt)
#pragma unroll
            for (int j = 0; j < 4; ++j) uo[mt * 4 + j] = UU[(tok0 + 16 * mt + 4 * fq + j) * 1024 + 16 * g + fr];
    }
    for (int blk = 0; blk < 16; ++blk) {
        const size_t t0 = tok0 + (size_t)blk * 32;
        const bf16x8 ucur = ua;
        bf16_t ucuro[8];
        if (OUT) {
#pragma unroll
            for (int i = 0; i < 8; ++i) ucuro[i] = uo[i];
        }
        if (blk < 15) {
            ua = *(const bf16x8*)(UU + (t0 + 32 + n) * 1024 + 16 * g + 8 * hh);
            if (OUT) {
#pragma unroll
                for (int mt = 0; mt < 2; ++mt)
#pragma unroll
                    for (int j = 0; j < 4; ++j) uo[mt * 4 + j] = UU[(t0 + 32 + 16 * mt + 4 * fq + j) * 1024 + 16 * g + fr];
            }
        }
        f32x16 acc[4];
#pragma unroll
        for (int tl = 0; tl < 4; ++tl) {
            f32x16 z;
#pragma unroll
            for (int i = 0; i < 16; ++i) z[i] = 0.f;
            acc[tl] = __builtin_amdgcn_mfma_f32_32x32x16_bf16(ucur, C.BB[tl], z, 0, 0, 0);
        }
#pragma unroll
        for (int tp = 0; tp < 2; ++tp) {
            f32x16& re = acc[2 * tp]; f32x16& im = acc[2 * tp + 1];
            const float a1r = C.ar[tp][0], a1i = C.ai[tp][0];
#pragma unroll
            for (int q = 0; q < 4; ++q)
#pragma unroll
                for (int r = 1; r < 4; ++r) {
                    const float pr = re[4 * q + r - 1], pi = im[4 * q + r - 1];
                    re[4 * q + r] += a1r * pr - a1i * pi; im[4 * q + r] += a1r * pi + a1i * pr;
                }
            float cr = st[tp][0], ci = st[tp][1];
            const float a4r = C.ar[tp][3], a4i = C.ai[tp][3];
#pragma unroll
            for (int q = 0; q < 4; ++q) {
                const float tr = re[4 * q + 3] + a4r * cr - a4i * ci, ti = im[4 * q + 3] + a4r * ci + a4i * cr;
                const float o0r = bcast_lo(tr), o0i = bcast_lo(ti);
                const float xr = hh ? o0r : cr, xi = hh ? o0i : ci;
                if (OUT) {
#pragma unroll
                    for (int r = 0; r < 4; ++r) { const float kr = C.ar[tp][r], ki = C.ai[tp][r];
                        re[4 * q + r] += kr * xr - ki * xi; im[4 * q + r] += kr * xi + ki * xr; }
                } else {
                    re[4 * q + 3] += a4r * xr - a4i * xi; im[4 * q + 3] += a4r * xi + a4i * xr;
                }
                cr = bcast_hi(re[4 * q + 3]); ci = bcast_hi(im[4 * q + 3]);
            }
            st[tp][0] = cr; st[tp][1] = ci;
        }
        if (OUT) {
            asm volatile("s_waitcnt lgkmcnt(0)" ::: "memory");
#pragma unroll
            for (int tp = 0; tp < 2; ++tp)
#pragma unroll
                for (int i = 0; i < 16; ++i) {
                    const int t = 8 * (i >> 2) + 4 * hh + (i & 3);
                    *(unsigned*)(sX + t * 136 + 2 * (n + 32 * tp)) = pk2(acc[2 * tp][i], acc[2 * tp + 1][i]);
                }
            asm volatile("s_waitcnt lgkmcnt(0)" ::: "memory");
            __builtin_amdgcn_wave_barrier();
#pragma unroll
            for (int mt = 0; mt < 2; ++mt) {
                f32x4 y = (f32x4){0.f, 0.f, 0.f, 0.f};
#pragma unroll
                for (int ks = 0; ks < 4; ++ks) {
                    const bf16x8 xa = *(const bf16x8*)(sX + (16 * mt + fr) * 136 + 32 * ks + 8 * fq);
                    y = __builtin_amdgcn_mfma_f32_16x16x32_bf16(xa, C.CC[ks], y, 0, 0, 0);
                }
#pragma unroll
                for (int j = 0; j < 4; ++j) {
                    float v = y[j] + C.dco * bf2f(ucuro[mt * 4 + j]);
                    const float inner = 0.7978845608028654f * (v + 0.044715f * v * v * v);
                    v = v / (1.0f + __expf(-2.0f * inner));
                    UU[(t0 + 16 * mt + 4 * fq + j) * 1024 + 16 * g + fr] = f2bf(v);
                }
            }
            asm volatile("s_waitcnt lgkmcnt(0)" ::: "memory");
            __builtin_amdgcn_wave_barrier();
        }
    }
}

__device__ __forceinline__ void phase_s5(const Prm& p, unsigned char* lds, int bg) {
    const int b = bg >> 6, g = bg & 63;
    const int tid = threadIdx.x, wv = tid >> 6, lane = tid & 63, n = lane & 31, hh = lane >> 5, fr = lane & 15, fq = lane >> 4;
    bf16_t* sX = (bf16_t*)(lds + wv * 8704);
    float* sXE = (float*)(lds + 8 * 8704);
    bf16_t* UU = (bf16_t*)(p.ws + OFF_UU);
    const float* lam_re = p.in[8]; const float* lam_im = p.in[9]; const float* b_re = p.in[10]; const float* b_im = p.in[11];
    const float* c_re = p.in[12]; const float* c_im = p.in[13];
    S5C C;
    const double dt = exp_d((double)p.in[14][g]);
    float fre[2], fim[2];
#pragma unroll
    for (int tp = 0; tp < 2; ++tp) {
        const int pp = n + 32 * tp;
        const double lr = (double)fminf(lam_re[g * 64 + pp], -1e-4f), li = (double)lam_im[g * 64 + pp];
#pragma unroll
        for (int k = 0; k < 4; ++k) { double sn, cs; sincos_d(li * dt * (k + 1), sn, cs); const double mag = exp_d(lr * dt * (k + 1)); C.ar[tp][k] = (float)(mag * cs); C.ai[tp][k] = (float)(mag * sn); }
        { double sn, cs; sincos_d(li * dt * 512.0, sn, cs); const double mag = exp_d(lr * dt * 512.0); C.a512r[tp] = (float)(mag * cs); C.a512i[tp] = (float)(mag * sn); }
        double sn, cs; sincos_d(li * dt, sn, cs);
        const double mag = exp_d(lr * dt), abr = mag * cs, abi = mag * sn;
        const double den = lr * lr + li * li, nr = abr - 1.0, ni = abi;
        fre[tp] = (float)((nr * lr + ni * li) / den); fim[tp] = (float)((ni * lr - nr * li) / den);
    }
#pragma unroll
    for (int tl = 0; tl < 4; ++tl) {
        const int tp = tl >> 1, ri = tl & 1, pp = n + 32 * tp;
#pragma unroll
        for (int j = 0; j < 8; ++j) {
            const int ch = 8 * hh + j;
            const float br = b_re[(g * 64 + pp) * 16 + ch], bi = b_im[(g * 64 + pp) * 16 + ch];
            const float v = ri == 0 ? fre[tp] * br - fim[tp] * bi : fre[tp] * bi + fim[tp] * br;
            C.BB[tl][j] = (short)f2bf(v);
        }
    }
#pragma unroll
    for (int ks = 0; ks < 4; ++ks)
#pragma unroll
        for (int j = 0; j < 8; ++j) {
            const int k = 32 * ks + 8 * fq + j, pp = k >> 1, ri = k & 1;
            const float v = ri == 0 ? c_re[(g * 16 + fr) * 64 + pp] : -c_im[(g * 16 + fr) * 64 + pp];
            C.CC[ks][j] = (short)f2bf(v);
        }
    C.dco = p.in[15][16 * g + fr];
    for (int rd = 0; rd < 2; ++rd) {
        const int chunk = wv + 8 * rd;
        float st[2][2] = {{0.f, 0.f}, {0.f, 0.f}};
        s5_chunk<false>(C, UU, b, g, chunk, st, sX, lane);
        if (hh == 0) {
#pragma unroll
            for (int tp = 0; tp < 2; ++tp) { sXE[(chunk * 64 + n + 32 * tp) * 2 + 0] = st[tp][0]; sXE[(chunk * 64 + n + 32 * tp) * 2 + 1] = st[tp][1]; }
        }
    }
    __syncthreads();
    for (int rd = 0; rd < 2; ++rd) {
        const int chunk = wv + 8 * rd;
        float st[2][2] = {{0.f, 0.f}, {0.f, 0.f}};
        for (int c2 = 0; c2 < chunk; ++c2) {
#pragma unroll
            for (int tp = 0; tp < 2; ++tp) {
                const float er = sXE[(c2 * 64 + n + 32 * tp) * 2 + 0], ei = sXE[(c2 * 64 + n + 32 * tp) * 2 + 1];
                const float nr = C.a512r[tp] * st[tp][0] - C.a512i[tp] * st[tp][1] + er, ni = C.a512r[tp] * st[tp][1] + C.a512i[tp] * st[tp][0] + ei;
                st[tp][0] = nr; st[tp][1] = ni;
            }
        }
        s5_chunk<true>(C, UU, b, g, chunk, st, sX, lane);
    }
    __syncthreads();
}

__device__ __forceinline__ void phase_gdn_prep(const Prm& p, unsigned char* lds, int it0, int nrounds) {
    const int tid0 = threadIdx.x, hb = tid0 >> 8;
    unsigned char* base = lds + hb * 76800;
    bf16_t* sQ = (bf16_t*)base;
    bf16_t* sK = (bf16_t*)(base + 17408);
    bf16_t* sV = (bf16_t*)(base + 2 * 17408);
    float* sL = (float*)(base + 3 * 17408);
    float* sBeta = (float*)(base + 4 * 17408);
    float* sGc = sBeta + 64; float* sEg = sGc + 64; float* sBE = sEg + 64;
    float* sCW = sBE + 64;
    bf16_t* QKV = (bf16_t*)(p.ws + OFF_QKV); const bf16_t* HALO = (const bf16_t*)(p.ws + OFF_HALO);
    const float* BA = (const float*)(p.ws + OFF_BA); float* GL = (float*)(p.ws + OFF_GL);
    bf16_t* WB = (bf16_t*)(p.ws + OFF_WB); bf16_t* ATT = (bf16_t*)(p.ws + OFF_ATT);
    const float* convw = p.in[4];
    for (int rd = 0; rd < nrounds; ++rd) {
        int tid = tid0; asm volatile("" : "+v"(tid));
        const int ht = tid & 255, hw = (tid >> 6) & 3, lane = tid & 63, fr = lane & 15, fq = lane >> 4;
        const int it = it0 + rd * 2 + hb;
        const int b = it >> 10, h = (it >> 7) & 7, nc = it & 127;
        const size_t tokb = (size_t)b * SEQ + (size_t)nc * 64;
#pragma unroll
        for (int i = 0; i < 6; ++i) { const int idx = ht + 256 * i, s3 = idx >> 9, tap = (idx >> 7) & 3, ch = idx & 127; sCW[idx] = convw[tap * 3072 + s3 * 1024 + h * 128 + ch]; }
        __syncthreads();
        {
            const int t0 = (ht >> 4) * 4, cgp = ht & 15;
#pragma unroll 1
            for (int s = 0; s < 3; ++s) {
                const int col = s * 1024 + h * 128 + cgp * 8;
                u32x4 xr[7];
#pragma unroll
                for (int i = 0; i < 7; ++i) {
                    const int tt = t0 - 3 + i;
                    xr[i] = (u32x4){0u, 0u, 0u, 0u};
                    if (tt >= 0) xr[i] = *(const u32x4*)(QKV + (tokb + tt) * 3072 + col);
                    else if (nc > 0) xr[i] = *(const u32x4*)(HALO + ((size_t)(b * 128 + nc - 1) * 3 + (3 + tt)) * 3072 + col);
                }
                f32x4 w0[4], w1[4];
#pragma unroll
                for (int j = 0; j < 4; ++j) { w0[j] = *(const f32x4*)(sCW + s * 512 + j * 128 + cgp * 8); w1[j] = *(const f32x4*)(sCW + s * 512 + j * 128 + cgp * 8 + 4); }
                float o[4][8], ss[4];
#pragma unroll
                for (int tk = 0; tk < 4; ++tk) {
                    float a[8];
#pragma unroll
                    for (int e = 0; e < 8; ++e) a[e] = 0.f;
#pragma unroll
                    for (int j = 0; j < 4; ++j) {
                        const u32x4 xv = xr[tk + j];
                        a[0] += w0[j][0] * lo2f(xv.x); a[1] += w0[j][1] * hi2f(xv.x); a[2] += w0[j][2] * lo2f(xv.y); a[3] += w0[j][3] * hi2f(xv.y);
                        a[4] += w1[j][0] * lo2f(xv.z); a[5] += w1[j][1] * hi2f(xv.z); a[6] += w1[j][2] * lo2f(xv.w); a[7] += w1[j][3] * hi2f(xv.w);
                    }
                    float acc2 = 0.f;
#pragma unroll
                    for (int e = 0; e < 8; ++e) { const float v = siluf_(a[e]); o[tk][e] = v; acc2 += v * v; }
                    ss[tk] = acc2;
                }
                bf16_t* dst = (s == 0 ? sQ : (s == 1 ? sK : sV)) + t0 * 136 + cgp * 8;
#pragma unroll
                for (int tk = 0; tk < 4; ++tk) {
                    float sc = 1.0f;
                    if (s < 2) { float q = ss[tk]; q += __shfl_xor(q, 1); q += __shfl_xor(q, 2); q += __shfl_xor(q, 4); q += __shfl_xor(q, 8); sc = rsqrtf(q + 1e-6f) * (s == 0 ? 0.08838834764831845f : 1.0f); }
                    u32x4 pk;
                    pk.x = pk2(o[tk][0] * sc, o[tk][1] * sc); pk.y = pk2(o[tk][2] * sc, o[tk][3] * sc); pk.z = pk2(o[tk][4] * sc, o[tk][5] * sc); pk.w = pk2(o[tk][6] * sc, o[tk][7] * sc);
                    *(u32x4*)(dst + tk * 136) = pk;
                }
            }
        }
        if (hw == 0) {
            const size_t tg = tokb + lane;
            const float braw = BA[tg * 16 + h], araw = BA[tg * 16 + 8 + h];
            const float beta = 1.0f / (1.0f + expf(-braw));
            const float xx = araw + p.in[6][h];
            const float sp = xx > 20.f ? xx : log1pf(expf(xx));
            float gg = -expf(p.in[5][h]) * sp;
#pragma unroll
            for (int off = 1; off < 64; off <<= 1) { const float o = __shfl_up(gg, off); if (lane >= off) gg += o; }
            sBeta[lane] = beta; sGc[lane] = gg; sEg[lane] = expf(gg); sBE[lane] = beta * expf(gg);
            if (lane == 63) GL[it] = expf(gg);
        }
        __syncthreads();
        {
            bf16x8 aK[4], aQ[4];
#pragma unroll
            for (int ks = 0; ks < 4; ++ks) { aK[ks] = *(const bf16x8*)(sK + (16 * hw + fr) * 136 + 32 * ks + 8 * fq); aQ[ks] = *(const bf16x8*)(sQ + (16 * hw + fr) * 136 + 32 * ks + 8 * fq); }
#pragma unroll
            for (int nt = 0; nt < 4; ++nt) {
                f32x4 kk = (f32x4){0.f, 0.f, 0.f, 0.f}, qk = (f32x4){0.f, 0.f, 0.f, 0.f};
#pragma unroll
                for (int ks = 0; ks < 4; ++ks) {
                    const bf16x8 bK = *(const bf16x8*)(sK + (16 * nt + fr) * 136 + 32 * ks + 8 * fq);
                    kk = __builtin_amdgcn_mfma_f32_16x16x32_bf16(aK[ks], bK, kk, 0, 0, 0);
                    qk = __builtin_amdgcn_mfma_f32_16x16x32_bf16(aQ[ks], bK, qk, 0, 0, 0);
                }
                const int mcol = 16 * nt + fr; const float gm = sGc[mcol];
#pragma unroll
                for (int j = 0; j < 4; ++j) {
                    const int c = 16 * hw + 4 * fq + j;
                    const float dec = __expf(fminf(sGc[c] - gm, 0.f));
                    sL[c * 68 + mcol] = (mcol < c) ? kk[j] * sBeta[c] * dec : 0.f;
                    ATT[(size_t)it * 4096 + c * 64 + mcol] = f2bf((mcol <= c) ? qk[j] * dec : 0.f);
                }
            }
        }
        __syncthreads();
        {
            float x[64];
            const bool isU = ht < 128; const int jc = ht & 127;
            const bf16_t* src = isU ? sV : sK;
            const float* fac = isU ? sBeta : sBE;
#pragma unroll
            for (int cb = 0; cb < 16; ++cb) {
                float a[4];
#pragma unroll
                for (int r = 0; r < 4; ++r) a[r] = bf2f(src[(4 * cb + r) * 136 + jc]) * fac[4 * cb + r];
#pragma unroll
                for (int m4 = 0; m4 < cb; ++m4)
#pragma unroll
                    for (int r = 0; r < 4; ++r) {
                        const f32x4 l = *(const f32x4*)(sL + (4 * cb + r) * 68 + 4 * m4);
                        a[r] -= l[0] * x[4 * m4] + l[1] * x[4 * m4 + 1] + l[2] * x[4 * m4 + 2] + l[3] * x[4 * m4 + 3];
                    }
                const f32x4 d1 = *(const f32x4*)(sL + (4 * cb + 1) * 68 + 4 * cb), d2 = *(const f32x4*)(sL + (4 * cb + 2) * 68 + 4 * cb), d3 = *(const f32x4*)(sL + (4 * cb + 3) * 68 + 4 * cb);
                x[4 * cb] = a[0];
                x[4 * cb + 1] = a[1] - d1[0] * x[4 * cb];
                x[4 * cb + 2] = a[2] - d2[0] * x[4 * cb] - d2[1] * x[4 * cb + 1];
                x[4 * cb + 3] = a[3] - d3[0] * x[4 * cb] - d3[1] * x[4 * cb + 1] - d3[2] * x[4 * cb + 2];
            }
            if (isU) {
                const int w8 = jc >> 4, nn = jc & 15;
#pragma unroll
                for (int rq = 0; rq < 4; ++rq)
#pragma unroll
                    for (int pc = 0; pc < 2; ++pc) {
                        const int c0 = 32 * pc + 4 * rq;
                        u32x4 o; o.x = pk2(x[c0 + 0], x[c0 + 1]); o.y = pk2(x[c0 + 2], x[c0 + 3]); o.z = pk2(x[c0 + 16], x[c0 + 17]); o.w = pk2(x[c0 + 18], x[c0 + 19]);
                        const int L = ((w8 * 2 + pc) * 64 + rq * 16 + nn) * 8;
                        *(u32x4*)(QKV + (tokb + (L >> 7)) * 3072 + 2048 + h * 128 + (L & 127)) = o;
                    }
            }
            __syncthreads();
            if (!isU) {
                bf16_t* sW2 = (bf16_t*)sL;
#pragma unroll
                for (int c = 0; c < 64; ++c) sW2[c * 136 + jc] = f2bf(-x[c]);
            }
        }
        __syncthreads();
        {
            const bf16_t* sW2 = (const bf16_t*)sL;
#pragma unroll
            for (int i = 0; i < 4; ++i) { const int ch = ht + 256 * i, r = ch >> 4, c8 = (ch & 15) * 8; *(u32x4*)(WB + (size_t)it * 8192 + r * 128 + c8) = *(const u32x4*)(sW2 + r * 136 + c8); }
        }
        {
            const int c = ht >> 2, ds = (ht & 3) * 32; const float eg = sEg[c];
#pragma unroll
            for (int c8 = 0; c8 < 4; ++c8) {
                const u32x4 v = *(const u32x4*)(sQ + c * 136 + ds + c8 * 8); u32x4 o;
                o.x = pk2(lo2f(v.x) * eg, hi2f(v.x) * eg); o.y = pk2(lo2f(v.y) * eg, hi2f(v.y) * eg); o.z = pk2(lo2f(v.z) * eg, hi2f(v.z) * eg); o.w = pk2(lo2f(v.w) * eg, hi2f(v.w) * eg);
                *(u32x4*)(QKV + (tokb + c) * 3072 + h * 128 + ds + c8 * 8) = o;
            }
            const int d = ht >> 1, cs = (ht & 1) * 32; const float gl = sGc[63];
#pragma unroll
            for (int c8 = 0; c8 < 4; ++c8) {
                float v[8];
#pragma unroll
                for (int e = 0; e < 8; ++e) { const int cc = cs + c8 * 8 + e; v[e] = bf2f(sK[cc * 136 + d]) * __expf(gl - sGc[cc]); }
                u32x4 o; o.x = pk2(v[0], v[1]); o.y = pk2(v[2], v[3]); o.z = pk2(v[4], v[5]); o.w = pk2(v[6], v[7]);
                *(u32x4*)(QKV + (tokb + (d >> 1)) * 3072 + 1024 + h * 128 + (d & 1) * 64 + cs + c8 * 8) = o;
            }
        }
        __syncthreads();
    }
}

constexpr int SC_RW = 288, SC_RK = 160;
constexpr int SC_QD = 64 * SC_RW, SC_KT = 2 * 64 * SC_RW, SC_AT = SC_KT + 128 * SC_RK, SC_U = SC_AT + 64 * SC_RK, SC_STAGE = SC_U + 8192;
static_assert(2 * SC_STAGE <= LDS_BYTES && SC_U % 16 == 0 && SC_STAGE % 16 == 0, "scan LDS layout");
struct ScanRegs { u32x4 rw[4], rq[4], rk[4], ru[2], ra[2]; };
__device__ __forceinline__ void scan_load(ScanRegs& R, const bf16_t* QKV, const bf16_t* WB, const bf16_t* ATT, int b, int h, int jh, int it, int nc, int lt) {
    const size_t tokb = (size_t)b * SEQ + (size_t)nc * 64;
#pragma unroll
    for (int i = 0; i < 4; ++i) { const int ch = lt + 256 * i, r = ch >> 4, c8 = (ch & 15) * 8;
        R.rw[i] = *(const u32x4*)(WB + (size_t)it * 8192 + r * 128 + c8);
        const bf16_t* qp = QKV + (tokb + r) * 3072 + h * 128 + c8;
        R.rq[i] = *(const u32x4*)(qp); R.rk[i] = *(const u32x4*)(qp + 1024); }
#pragma unroll
    for (int i = 0; i < 2; ++i) { const int ch = lt + 256 * i; R.ra[i] = *(const u32x4*)(ATT + (size_t)it * 4096 + ch * 8);
        const int L = jh * 4096 + ch * 8; R.ru[i] = *(const u32x4*)(QKV + (tokb + (L >> 7)) * 3072 + 2048 + h * 128 + (L & 127)); }
}
__device__ __forceinline__ void st32p(unsigned char* rowp, int g, u32x4 v) {
    const int pt = g & 3; unsigned char* p = rowp + 64 * (g >> 2) + 32 * (pt & 1) + 8 * (pt >> 1);
    *(u32x2*)p = (u32x2){v.x, v.y}; *(u32x2*)(p + 16) = (u32x2){v.z, v.w};
}
__device__ __forceinline__ void scan_store(const ScanRegs& R, unsigned char* sbp, int lt) {
#pragma unroll
    for (int i = 0; i < 4; ++i) { const int ch = lt + 256 * i, r = ch >> 4, g = ch & 15;
        st32p(sbp + r * SC_RW, g, R.rw[i]);
        st32p(sbp + SC_QD + r * SC_RW, g, R.rq[i]);
        const int d = 2 * r + (g >> 3), gk = g & 7;
        st32p(sbp + SC_KT + d * SC_RK, gk, R.rk[i]); }
#pragma unroll
    for (int i = 0; i < 2; ++i) { const int ch = lt + 256 * i, r = ch >> 3, g = ch & 7; st32p(sbp + SC_AT + r * SC_RK, g, R.ra[i]); *(u32x4*)(sbp + SC_U + ch * 16) = R.ru[i]; }
}
__device__ __forceinline__ bf16x8 pack2(const f32x4& a, const f32x4& b) {
    u32x4 r; r.x = pk2(a[0], a[1]); r.y = pk2(a[2], a[3]); r.z = pk2(b[0], b[1]); r.w = pk2(b[2], b[3]); return __builtin_bit_cast(bf16x8, r);
}
#define SCAN_BAR() do { asm volatile("s_waitcnt lgkmcnt(0)" ::: "memory"); __builtin_amdgcn_s_barrier(); asm volatile("" ::: "memory"); } while (0)
#define MF16(a, b, c) __builtin_amdgcn_mfma_f32_16x16x32_bf16(a, b, c, 0, 0, 0)
__device__ __forceinline__ void phase_gdn_scan(const Prm& p, unsigned char* lds, int blk) {
    const int tid = threadIdx.x, wv = tid >> 6, lane = tid & 63, n = lane & 15, kq = lane >> 4;
    const int bh = blk >> 1, jh = blk & 1, b = bh >> 3, h = bh & 7;
    const bf16_t* QKV = (const bf16_t*)(p.ws + OFF_QKV); const bf16_t* WB = (const bf16_t*)(p.ws + OFF_WB); const bf16_t* ATT = (const bf16_t*)(p.ws + OFF_ATT);
    const float* GL = (const float*)(p.ws + OFF_GL); bf16_t* O = (bf16_t*)(p.ws + OFF_H);
    const int itb = bh * 128;
    if (wv >= 4) {
        const int lt = tid - 256;
        ScanRegs RA, RB;
        scan_load(RA, QKV, WB, ATT, b, h, jh, itb, 0, lt);
        scan_store(RA, lds, lt);
        __builtin_amdgcn_sched_barrier(0);
        scan_load(RA, QKV, WB, ATT, b, h, jh, itb + 1, 1, lt);
        __builtin_amdgcn_sched_barrier(0);
        scan_load(RB, QKV, WB, ATT, b, h, jh, itb + 2, 2, lt);
        __builtin_amdgcn_sched_barrier(0);
        SCAN_BAR();
        for (int nc = 0; nc < 128; nc += 2) {
            __builtin_amdgcn_sched_barrier(0);
            scan_store(RA, lds + SC_STAGE, lt);
            __builtin_amdgcn_sched_barrier(0);
            { const int c3 = nc + 3 < 128 ? nc + 3 : 127; scan_load(RA, QKV, WB, ATT, b, h, jh, itb + c3, c3, lt); }
            __builtin_amdgcn_sched_barrier(0);
            SCAN_BAR();
            __builtin_amdgcn_sched_barrier(0);
            scan_store(RB, lds, lt);
            __builtin_amdgcn_sched_barrier(0);
            { const int c4 = nc + 4 < 128 ? nc + 4 : 127; scan_load(RB, QKV, WB, ATT, b, h, jh, itb + c4, c4, lt); }
            SCAN_BAR();
        }
    } else {
        const float gl0 = GL[itb + lane], gl1 = GL[itb + 64 + lane];
        f32x4 S[8];
#pragma unroll
        for (int dt = 0; dt < 8; ++dt) S[dt] = (f32x4){0.f, 0.f, 0.f, 0.f};
        const int e = 64 * jh + 16 * wv + n;
        SCAN_BAR();
        for (int nc = 0; nc < 128; ++nc) {
            const unsigned char* sbp = lds + (nc & 1) * SC_STAGE;
            const float gl = __builtin_bit_cast(float, __builtin_amdgcn_readlane(__builtin_bit_cast(int, nc < 64 ? gl0 : gl1), nc & 63));
            const unsigned char* pw = sbp + n * SC_RW + 16 * kq;
            const unsigned char* pk = sbp + SC_KT + n * SC_RK + 16 * kq;
            f32x4 V[4], Oa[4];
#pragma unroll
            for (int pc = 0; pc < 2; ++pc) {
                const u32x4 uu = *(const u32x4*)(sbp + SC_U + ((wv * 2 + pc) * 64 + lane) * 16);
                V[2 * pc] = (f32x4){lo2f(uu.x), hi2f(uu.x), lo2f(uu.y), hi2f(uu.y)}; V[2 * pc + 1] = (f32x4){lo2f(uu.z), hi2f(uu.z), lo2f(uu.w), hi2f(uu.w)};
            }
#pragma unroll
            for (int ct = 0; ct < 4; ++ct) Oa[ct] = (f32x4){0.f, 0.f, 0.f, 0.f};
            bf16x8 fa[2][8];
#define LD_WQ(dst, ks_) do { _Pragma("unroll") for (int mt = 0; mt < 4; ++mt) { dst[mt] = *(const bf16x8*)(pw + mt * 16 * SC_RW + 64 * (ks_)); dst[4 + mt] = *(const bf16x8*)(pw + SC_QD + mt * 16 * SC_RW + 64 * (ks_)); } } while (0)
            LD_WQ(fa[0], 0);
#pragma unroll
            for (int ks = 0; ks < 4; ++ks) {
                if (ks < 3) LD_WQ(fa[(ks + 1) & 1], ks + 1);
                const bf16x8 sb8 = pack2(S[2 * ks], S[2 * ks + 1]);
                __builtin_amdgcn_sched_barrier(0);
#pragma unroll
                for (int mt = 0; mt < 4; ++mt) { V[mt] = MF16(fa[ks & 1][mt], sb8, V[mt]); Oa[mt] = MF16(fa[ks & 1][4 + mt], sb8, Oa[mt]); }
                __builtin_amdgcn_sched_barrier(0);
            }
#undef LD_WQ
            bf16x8 fb[2][12];
#define LD_AK(dst, k2_) do { _Pragma("unroll") for (int mt = 0; mt < 4; ++mt) dst[mt] = *(const bf16x8*)(pk + (SC_AT - SC_KT) + mt * 16 * SC_RK + 64 * (k2_)); \
                             _Pragma("unroll") for (int dt = 0; dt < 8; ++dt) dst[4 + dt] = *(const bf16x8*)(pk + dt * 16 * SC_RK + 64 * (k2_)); } while (0)
            LD_AK(fb[0], 0);
            bf16x8 Vb[2];
            Vb[0] = pack2(V[0], V[1]); Vb[1] = pack2(V[2], V[3]);
#pragma unroll
            for (int dt = 0; dt < 8; ++dt) S[dt] *= gl;
#pragma unroll
            for (int k2 = 0; k2 < 2; ++k2) {
                if (k2 < 1) LD_AK(fb[1], 1);
                __builtin_amdgcn_sched_barrier(0);
#pragma unroll
                for (int mt = 0; mt < 4; ++mt) Oa[mt] = MF16(fb[k2][mt], Vb[k2], Oa[mt]);
#pragma unroll
                for (int dt = 0; dt < 8; ++dt) S[dt] = MF16(fb[k2][4 + dt], Vb[k2], S[dt]);
                __builtin_amdgcn_sched_barrier(0);
            }
#undef LD_AK
            bf16_t* obase = O + (size_t)(itb + nc) * 8192 + e * 64 + 4 * kq;
#pragma unroll
            for (int ct = 0; ct < 4; ++ct) { u32x2 o2; o2.x = pk2(Oa[ct][0], Oa[ct][1]); o2.y = pk2(Oa[ct][2], Oa[ct][3]); *(u32x2*)(obase + 16 * ct) = o2; }
            SCAN_BAR();
        }
    }
    __syncthreads();
}

__device__ __forceinline__ void phase_ya(const Prm& p, unsigned char* lds) {
    const bf16_t* OT = (const bf16_t*)(p.ws + OFF_H); bf16_t* SZA = (bf16_t*)p.out;
    const float* gw = p.in[7];
    bf16_t* sT = (bf16_t*)lds;
    float* sPart = (float*)(lds + 16384);
    const int tid = threadIdx.x, w = tid >> 6, c = tid & 63;
    for (int it = blockIdx.x; it < NIT; it += gridDim.x) {
        const int b = it >> 10, h = (it >> 7) & 7, nc = it & 127;
        const size_t tok = (size_t)b * SEQ + (size_t)nc * 64 + c;
#pragma unroll
        for (int i = 0; i < 2; ++i) { const int ch = tid + 512 * i; *(u32x4*)(sT + ch * 8) = *(const u32x4*)(OT + (size_t)it * 8192 + ch * 8); }
        const u32x4 z0 = *(const u32x4*)(SZA + tok * 1024 + h * 128 + 16 * w), z1 = *(const u32x4*)(SZA + tok * 1024 + h * 128 + 16 * w + 8);
        __syncthreads();
        float o[16]; float ss = 0.f;
#pragma unroll
        for (int j = 0; j < 16; ++j) { o[j] = bf2f(sT[(16 * w + j) * 64 + c]); ss += o[j] * o[j]; }
        sPart[w * 64 + c] = ss;
        __syncthreads();
        float tot = 0.f;
#pragma unroll
        for (int k = 0; k < 8; ++k) tot += sPart[k * 64 + c];
        const float rstd = rsqrtf(tot * (1.0f / 128.0f) + 1e-6f);
        const unsigned zz[8] = {z0.x, z0.y, z0.z, z0.w, z1.x, z1.y, z1.z, z1.w};
        unsigned r[8];
#pragma unroll
        for (int j = 0; j < 8; ++j)
            r[j] = pk2(o[2 * j] * rstd * gw[16 * w + 2 * j] * lo2f(zz[j]), o[2 * j + 1] * rstd * gw[16 * w + 2 * j + 1] * hi2f(zz[j]));
        *(u32x4*)(SZA + tok * 1024 + h * 128 + 16 * w) = (u32x4){r[0], r[1], r[2], r[3]};
        *(u32x4*)(SZA + tok * 1024 + h * 128 + 16 * w + 8) = (u32x4){r[4], r[5], r[6], r[7]};
        __syncthreads();
    }
}
__device__ __forceinline__ void phase_conv3(const Prm& p) {
    const bf16_t* P = (const bf16_t*)(p.ws + OFF_P); bf16_t* Q = (bf16_t*)(p.ws + OFF_Q); const float* cw = p.in[19];
    const int nth = gridDim.x * 512;
    for (int idx = blockIdx.x * 512 + threadIdx.x; idx < TOK * 256; idx += nth) {
        const int t = idx >> 8, c8 = (idx & 255) * 8, ts = t & (SEQ - 1);
        const u32x4 z4 = (u32x4){0u, 0u, 0u, 0u};
        const u32x4 p0 = *(const u32x4*)(P + (size_t)t * 2048 + c8);
        const u32x4 p1 = ts >= 1 ? *(const u32x4*)(P + (size_t)(t - 1) * 2048 + c8) : z4;
        const u32x4 p2 = ts >= 2 ? *(const u32x4*)(P + (size_t)(t - 2) * 2048 + c8) : z4;
        const u32x4 q = *(const u32x4*)(Q + (size_t)t * 2048 + c8);
        float r[8];
        const unsigned pa[4] = {p0.x, p0.y, p0.z, p0.w}, pb[4] = {p1.x, p1.y, p1.z, p1.w}, pc[4] = {p2.x, p2.y, p2.z, p2.w}, qa[4] = {q.x, q.y, q.z, q.w};
#pragma unroll
        for (int e = 0; e < 4; ++e) {
            const int c = c8 + 2 * e;
            r[2 * e] = lo2f(qa[e]) * (cw[c] * lo2f(pc[e]) + cw[2048 + c] * lo2f(pb[e]) + cw[4096 + c] * lo2f(pa[e]));
            r[2 * e + 1] = hi2f(qa[e]) * (cw[c + 1] * hi2f(pc[e]) + cw[2048 + c + 1] * hi2f(pb[e]) + cw[4096 + c + 1] * hi2f(pa[e]));
        }
        u32x4 o; o.x = pk2(r[0], r[1]); o.y = pk2(r[2], r[3]); o.z = pk2(r[4], r[5]); o.w = pk2(r[6], r[7]);
        *(u32x4*)(Q + (size_t)t * 2048 + c8) = o;
    }
}

#define XB_TMO      128
#define XB_XCNT(j)  (256  + 64 * (j))
#define XB_XSUB(j)  (1280 + 64 * (j))
#define XB_XGEN(j)  (2304 + 64 * (j))
#define XB_TOP      3328
#define XB_TOPGEN   3392
#define XCD_BAR_WORDS 3456
#define XB_SPIN_CAP (1u << 18)

__device__ __forceinline__ unsigned xb_ld(unsigned* p)              { return __hip_atomic_load(p, __ATOMIC_RELAXED, __HIP_MEMORY_SCOPE_AGENT); }
__device__ __forceinline__ unsigned xb_add(unsigned* p, unsigned v) { return __hip_atomic_fetch_add(p, v, __ATOMIC_RELAXED, __HIP_MEMORY_SCOPE_AGENT); }
__device__ __forceinline__ unsigned xb_xcc_id() { return (unsigned)__builtin_amdgcn_s_getreg((3 << 11) | 20) & 0xFu; }
#define XB_SPIN(cond, bar) do { unsigned _sp = 0; while (cond) { __builtin_amdgcn_s_sleep(1); \
    if ((++_sp & 255u) == 0u) { if (xb_ld(&(bar)[XB_TMO])) break; if (_sp > XB_SPIN_CAP) { atomicAdd(&(bar)[XB_TMO], 1u); break; } } } } while (0)

struct XcdBarrier {
    unsigned* bar; unsigned x;
    volatile LAS unsigned* st;
};

__device__ __forceinline__ XcdBarrier xcd_barrier_post(unsigned* bar, volatile LAS unsigned* st) {
    XcdBarrier b; b.bar = bar; b.x = xb_xcc_id(); b.st = st;
    if (threadIdx.x == 0) (void)xb_add(&bar[XB_XCNT(b.x)], 1u);
    return b;
}
__device__ __forceinline__ void xcd_barrier_complete(unsigned* bar, unsigned x, unsigned& nloc, unsigned& nx) {
    const unsigned G = gridDim.x * gridDim.y * gridDim.z;
    unsigned sum, cnt, mine, sp = 0u;
    for (;;) {
        sum = 0u; cnt = 0u; mine = 0u;
#pragma unroll
        for (unsigned j = 0; j < 16; ++j) { const unsigned c = xb_ld(&bar[XB_XCNT(j)]); sum += c; cnt += (c > 0u) ? 1u : 0u; mine = (j == x) ? c : mine; }
        if (sum == G) break;
        __builtin_amdgcn_s_sleep(1);
        if ((++sp & 255u) == 0u) { if (xb_ld(&bar[XB_TMO])) break; if (sp > XB_SPIN_CAP) { atomicAdd(&bar[XB_TMO], 1u); break; } }
    }
    nloc = mine > 0u ? mine : 1u; nx = cnt > 0u ? cnt : 1u;
}

__device__ __forceinline__ void xcd_barrier(const XcdBarrier& b) {
    asm volatile("s_waitcnt vmcnt(0)" ::: "memory");
    __syncthreads();
    if (threadIdx.x == 0) {
        unsigned* bar = b.bar;
        __builtin_amdgcn_s_waitcnt(0);
        unsigned nloc = b.st[0], nx = b.st[1];
        if (nloc == 0u) { xcd_barrier_complete(bar, b.x, nloc, nx); b.st[0] = nloc; b.st[1] = nx; }
        const unsigned old = xb_add(&bar[XB_XSUB(b.x)], 1u);
        const unsigned gen = old / nloc;
        if (old + 1u == (gen + 1u) * nloc) {
            __builtin_amdgcn_fence(__ATOMIC_RELEASE, "agent");
            asm volatile("s_waitcnt vmcnt(0)" ::: "memory");
            const unsigned og = xb_add(&bar[XB_TOP], 1u);
            const unsigned tg = og / nx;
            if (og + 1u == (tg + 1u) * nx) xb_add(&bar[XB_TOPGEN], 1u);
            else XB_SPIN(xb_ld(&bar[XB_TOPGEN]) == tg, bar);
            __builtin_amdgcn_fence(__ATOMIC_ACQUIRE, "agent");
            xb_add(&bar[XB_XGEN(b.x)], 1u);
            asm volatile("s_waitcnt vmcnt(0)" ::: "memory");
        } else {
            XB_SPIN(xb_ld(&bar[XB_XGEN(b.x)]) == gen, bar);
            __builtin_amdgcn_fence(__ATOMIC_ACQUIRE, "agent");
            asm volatile("s_waitcnt vmcnt(0)" ::: "memory");
        }
    }
    __syncthreads();
}

constexpr int NPHASE = 11;
#define REP_GEMM 1
#define REP_SYNC 1
#define REP_SCAN 1
#define SCAN_PROBE 1
#define REP_P0 1
#ifndef PHM
#define PHM 0x7FF
#endif
__global__ void __launch_bounds__(512, 2) mega(Prm p) {
    extern __shared__ __attribute__((aligned(16))) unsigned char shm[];
    LAS unsigned char* lds3 = (LAS unsigned char*)shm;
    unsigned char* ws = p.ws;
    volatile LAS unsigned* xst = (volatile LAS unsigned*)(lds3 + LDS_BYTES);
    if (threadIdx.x == 0) { xst[0] = 0u; xst[1] = 0u; }
    __syncthreads();
    XcdBarrier xb{};
    const bool multi = (p.ph_hi - p.ph_lo) > 1;
    if (multi) xb = xcd_barrier_post((unsigned*)(ws + OFF_BAR), xst);
    if (p.ph_lo < 0) cg::this_grid().sync();
#define PH_BEGIN(i) if (((PHM >> (i)) & 1) && p.ph_lo <= (i) && (i) < p.ph_hi) { if ((i) > p.ph_lo) { xcd_barrier(xb); if (REP_SYNC > 1) xcd_barrier(xb); } pg8::StaticOrder S; (void)S;
#define PH_END }
    PH_BEGIN(0)
        for (int rep = 0; rep < REP_P0; ++rep) {
        phase_convert(p, shm, 0, 1856, gridDim.x, blockIdx.x);
        phase_rmsnorm_x(p.in[0], p.in[1], (bf16_t*)(ws + OFF_H)); __syncthreads(); }
    PH_END
    PH_BEGIN(1)
        pg8::Gemm g{(const bf16_t*)(ws + OFF_H), (const bf16_t*)(ws + OFF_WT1), TOK, NP1, 1024, (const bf16_t*)(ws + OFF_H), 1024, 64};
        Epi1 E{(bf16_t*)(ws + OFF_QKV), (bf16_t*)p.out, (bf16_t*)(ws + OFF_UU), (bf16_t*)p.out + (size_t)TOK * 1024, (float*)(ws + OFF_BA), (bf16_t*)(ws + OFF_HALO)};
        S.init(TOK, NP1, gridDim.x, blockIdx.x); for (int rep = 0; rep < REP_GEMM; ++rep) { pg8::gemm_phase(lds3, g, S, E); __syncthreads(); }
    PH_END
    PH_BEGIN(2)
        {
            unsigned* ctr = (unsigned*)(ws + OFF_BAR) + 3600;
            volatile LAS unsigned* sIt = xst + 2;
            for (;;) {
                if (threadIdx.x == 0) sIt[0] = __hip_atomic_fetch_add(ctr, 2u, __ATOMIC_RELAXED, __HIP_MEMORY_SCOPE_AGENT);
                __syncthreads();
                const unsigned it0 = sIt[0];
                __syncthreads();
                if (it0 >= (unsigned)NIT) break;
                phase_gdn_prep(p, shm, (int)it0, 1);
            }
        }
    PH_END
    PH_BEGIN(3)
        if (blockIdx.x < 32) phase_gdn_scan(p, shm, blockIdx.x);
        else {
            const int ob = blockIdx.x - 32, nob = gridDim.x - 32;
            if (ob < 128) phase_s5(p, shm, ob);
            {
                unsigned* cnt = (unsigned*)(ws + OFF_BAR) + 3700;
                asm volatile("s_waitcnt vmcnt(0)" ::: "memory");
                __syncthreads();
                if (threadIdx.x == 0) {
                    __builtin_amdgcn_fence(__ATOMIC_RELEASE, "agent");
                    asm volatile("s_waitcnt vmcnt(0)" ::: "memory");
                    __hip_atomic_fetch_add(cnt, 1u, __ATOMIC_RELAXED, __HIP_MEMORY_SCOPE_AGENT);
                    unsigned sp = 0;
                    while (__hip_atomic_load(cnt, __ATOMIC_RELAXED, __HIP_MEMORY_SCOPE_AGENT) < (unsigned)nob) { __builtin_amdgcn_s_sleep(2); if (++sp > (1u << 22)) break; }
                    __builtin_amdgcn_fence(__ATOMIC_ACQUIRE, "agent");
                    asm volatile("s_waitcnt vmcnt(0)" ::: "memory");
                }
                __syncthreads();
            }
            pg8::Gemm g{(const bf16_t*)(ws + OFF_UU), (const bf16_t*)(ws + OFF_WTG), TOK, 1024, 1024, (const bf16_t*)(ws + OFF_UU), 1024, 64};
            EpiGlu E{(const bf16_t*)(ws + OFF_UU), (bf16_t*)p.out + (size_t)TOK * 1024};
            S.init(TOK, 1024, nob, ob); pg8::gemm_phase(lds3, g, S, E);
            __syncthreads();
            if (ob >= 32) phase_convert(p, shm, 1856, 4928, nob - 32, ob - 32);
        }
    PH_END
    PH_BEGIN(4)
        phase_ya(p, shm);
    PH_END
    PH_BEGIN(5)
        pg8::Gemm g{(const bf16_t*)p.out, (const bf16_t*)(ws + OFF_WTO0), TOK, 1024, 2048, (const bf16_t*)p.out + (size_t)TOK * 1024, 1024, 16};
        EpiB16 E{(bf16_t*)(ws + OFF_QKV)};
        S.init(TOK, 1024, gridDim.x, blockIdx.x); for (int rep = 0; rep < REP_GEMM; ++rep) { pg8::gemm_phase(lds3, g, S, E); __syncthreads(); }
    PH_END
    PH_BEGIN(6)
        phase_post<true>(p.in[0], (const bf16_t*)(ws + OFF_QKV), p.in[2], p.out, p.in[1] + 1024, (bf16_t*)(ws + OFF_H));
    PH_END
    PH_BEGIN(7)
        pg8::Gemm g{(const bf16_t*)(ws + OFF_H), (const bf16_t*)(ws + OFF_WT2), TOK, 8192, 1024, (const bf16_t*)(ws + OFF_H), 1024, 64};
        Epi2 E{(bf16_t*)(ws + OFF_P), (bf16_t*)(ws + OFF_Q)};
        S.init(TOK, 8192, gridDim.x, blockIdx.x); for (int rep = 0; rep < REP_GEMM; ++rep) { pg8::gemm_phase(lds3, g, S, E); __syncthreads(); }
    PH_END
    PH_BEGIN(8)
        phase_conv3(p);
    PH_END
    PH_BEGIN(9)
        pg8::Gemm g{(const bf16_t*)(ws + OFF_Q), (const bf16_t*)(ws + OFF_WTO1), TOK, 1024, 2048, (const bf16_t*)(ws + OFF_Q), 2048, 64};
        EpiB16 E{(bf16_t*)(ws + OFF_P)};
        S.init(TOK, 1024, gridDim.x, blockIdx.x); for (int rep = 0; rep < REP_GEMM; ++rep) { pg8::gemm_phase(lds3, g, S, E); __syncthreads(); }
    PH_END
    PH_BEGIN(10)
        phase_post<false>(p.out, (const bf16_t*)(ws + OFF_P), p.in[2] + 1024, p.out, nullptr, nullptr);
    PH_END
}

#ifndef N_LAUNCH_MODE
#define N_LAUNCH_MODE 1
#endif

extern "C" void kernel_launch(void* const* d_in, const int* in_sizes, int n_in, void* d_out, int out_size, void* d_ws, size_t ws_size, hipStream_t stream) {
    static int ready = 0;
    if (!ready) {
        if (n_in != 21 || ws_size < WS_END || out_size != TOK * DM) { fprintf(stderr, "kernel_launch: unexpected shapes (n_in %d ws %zu out %d)\n", n_in, ws_size, out_size); ready = -1; return; }
        if (hipFuncSetAttribute((const void*)mega, hipFuncAttributeMaxDynamicSharedMemorySize, LDS_BYTES + 16) != hipSuccess) { fprintf(stderr, "kernel_launch: hipFuncSetAttribute failed\n"); ready = -1; return; }
        ready = 1;
    }
    if (ready < 0) return;
    Prm p{};
    for (int i = 0; i < 21; ++i) p.in[i] = (const float*)d_in[i];
    p.out = (float*)d_out; p.ws = (unsigned char*)d_ws;
#if N_LAUNCH_MODE == 1
    p.ph_lo = 0; p.ph_hi = NPHASE;
    void* args[] = {&p};
    if (hipMemsetAsync((unsigned char*)d_ws + OFF_BAR, 0, 16384, stream) != hipSuccess) { fprintf(stderr, "memset failed\n"); return; }
    hipError_t e = hipLaunchCooperativeKernel((const void*)mega, dim3(256), dim3(512), args, LDS_BYTES + 16, stream);
    if (e != hipSuccess) fprintf(stderr, "cooperative launch failed: %s\n", hipGetErrorString(e));
#else
    for (int ph = 0; ph < NPHASE; ++ph) {
        p.ph_lo = ph; p.ph_hi = ph + 1;
        hipLaunchKernelGGL(mega, dim3(256), dim3(512), LDS_BYTES + 16, stream, p);
    }
#endif
}
```

```cpp
#include <hip/hip_runtime.h>
#include <hip/hip_cooperative_groups.h>
#include <cstdio>
namespace cg = cooperative_groups;

#define LAS __attribute__((address_space(3)))
typedef unsigned short bf16_t;
typedef short bf16x8 __attribute__((ext_vector_type(8)));
typedef float f32x4 __attribute__((ext_vector_type(4)));
typedef float f32x16 __attribute__((ext_vector_type(16)));
typedef unsigned u32x4 __attribute__((ext_vector_type(4)));
typedef unsigned u32x2 __attribute__((ext_vector_type(2)));

constexpr int TOK = 16384, DM = 1024, SEQ = 8192;
constexpr int NP1 = 6400;
constexpr int NIT = 2048;

constexpr size_t OFF_WT1 = 0;
constexpr size_t OFF_WTG = OFF_WT1 + (size_t)NP1 * 1024 * 2;
constexpr size_t OFF_WTO0 = OFF_WTG + (size_t)1024 * 1024 * 2;
constexpr size_t OFF_WT2 = OFF_WTO0 + (size_t)1024 * 2048 * 2;
constexpr size_t OFF_WTO1 = OFF_WT2 + (size_t)8192 * 1024 * 2;
constexpr size_t OFF_H = OFF_WTO1 + (size_t)1024 * 2048 * 2;
constexpr size_t OFF_QKV = OFF_H + (size_t)TOK * 1024 * 2;
constexpr size_t OFF_UU = OFF_QKV + (size_t)TOK * 3072 * 2;
constexpr size_t OFF_WB = OFF_UU + (size_t)TOK * 1024 * 2;
constexpr size_t OFF_ATT = OFF_WB + (size_t)NIT * 8192 * 2;
constexpr size_t OFF_HALO = OFF_ATT + (size_t)NIT * 4096 * 2;
constexpr size_t OFF_BA = OFF_HALO + (size_t)256 * 3 * 3072 * 2;
constexpr size_t OFF_GL = OFF_BA + (size_t)TOK * 16 * 4;
constexpr size_t OFF_BAR = OFF_GL + (size_t)NIT * 4;
constexpr size_t WS_END = OFF_BAR + 16384;
constexpr size_t OFF_YMIX = OFF_QKV;
constexpr size_t OFF_P = OFF_QKV;
constexpr size_t OFF_Q = OFF_QKV + (size_t)TOK * 2048 * 2;
static_assert(OFF_Q + (size_t)TOK * 2048 * 2 <= OFF_WB, "Q overlaps live data");
static_assert(WS_END <= (size_t)256 * 1024 * 1024, "workspace too big");

constexpr int LDS_BYTES = 157696;

struct Prm {
    const float* in[21];
    float* out;
    unsigned char* ws;
    int ph_lo, ph_hi;
};

__device__ __forceinline__ float bf2f(bf16_t b) { return __uint_as_float(((unsigned)b) << 16); }
__device__ __forceinline__ bf16_t f2bf(float f) { unsigned u = __float_as_uint(f); u += 0x7FFFu + ((u >> 16) & 1u); return (bf16_t)(u >> 16); }
typedef __bf16 bf16v2_t __attribute__((ext_vector_type(2)));
typedef float f32x2_t __attribute__((ext_vector_type(2)));
__device__ __forceinline__ unsigned pk2(float lo, float hi) { const f32x2_t v = {lo, hi}; return __builtin_bit_cast(unsigned, __builtin_convertvector(v, bf16v2_t)); }
__device__ __forceinline__ float lo2f(unsigned u) { return __uint_as_float(u << 16); }
__device__ __forceinline__ float hi2f(unsigned u) { return __uint_as_float(u & 0xFFFF0000u); }
__device__ __forceinline__ float sigmoidf_(float x) { return 1.0f / (1.0f + __expf(-x)); }
__device__ __forceinline__ float siluf_(float x) { return x / (1.0f + __expf(-x)); }
__device__ __forceinline__ float wave_sum(float v) {
#pragma unroll
    for (int o = 32; o >= 1; o >>= 1) v += __shfl_xor(v, o);
    return v;
}
__device__ __forceinline__ u32x4 pack8(f32x4 a, f32x4 b) { u32x4 r; r.x = pk2(a[0], a[1]); r.y = pk2(a[2], a[3]); r.z = pk2(b[0], b[1]); r.w = pk2(b[2], b[3]); return r; }

namespace pg8 {
constexpr int BM = 256, BK = 64, HALF = 128, HTB = HALF * BK * 2, STAGE_BYTES = 8 * HTB, NXCD = 8, WGM = 8;
__device__ __forceinline__ int lds_byte(int r, int c) { const int st = (r >> 4) * 2 + (c >> 5), rr = r & 15, cc = c & 31, ob = rr * 64 + cc * 2; return st * 1024 + (ob ^ (((ob >> 9) & 1) << 5)); }
__device__ __forceinline__ void stage_rc(int b, int& R, int& C) { const int st = b / 1024, sb = b % 1024, swz = sb ^ (((sb >> 9) & 1) << 5); R = (st >> 1) * 16 + swz / 64; C = (st & 1) * 32 + (swz % 64) / 2; }
__device__ __forceinline__ int perm32(int rho) { const int n = rho >> 4, i = rho & 15; return 8 * (i >> 2) + 4 * n + (i & 3); }
struct Unit { int pm, pn; };
struct Gemm { const bf16_t* A; const bf16_t* Bt; int M, N, K; const bf16_t* A2; int lda, ks; };
struct StaticOrder {
    int nM, nN, nwg, G, c;
    __device__ void init(int M, int N, int G_, int c_) { nM = M / BM; nN = N / BM; nwg = nM * nN; G = G_; c = c_; }
    __device__ bool next(int i, Unit& u) const {
        const long L = (long)i * G + c; if (L >= nwg) return false;
        int wgid = (int)L; { const int q = nwg / NXCD, r = nwg % NXCD, xcd = wgid % NXCD, off = wgid / NXCD; wgid = (xcd < r ? xcd * (q + 1) : r * (q + 1) + (xcd - r) * q) + off; }
        const int nig = WGM * nN, gid = wgid / nig, fm = gid * WGM, gsz = (nM - fm) < WGM ? (nM - fm) : WGM;
        u.pm = fm + ((wgid % nig) % gsz); u.pn = (wgid % nig) / gsz; return true;
    }
};

template <class Epi>
__device__ __forceinline__ void gemm_phase(LAS unsigned char* lds, const Gemm g, const StaticOrder& S, const Epi& E) {
    const int tid = threadIdx.x, wid = __builtin_amdgcn_readfirstlane(tid >> 6), lane = tid & 63, wr = wid >> 2, wc = wid & 3, fr = lane & 15, fq = lane >> 4;
    const int K = g.K, nt = K / BK;
    unsigned voffA[2], voffB[2];
#pragma unroll
    for (int i = 0; i < 2; ++i) { int R, C; stage_rc(tid * 16 + i * 8192, R, C); const int Rb = Epi::PERM ? ((R & ~31) + perm32(R & 31)) : R;
        voffA[i] = (unsigned)(R * g.lda + C) * 2u; voffB[i] = (unsigned)(Rb * K + C) * 2u; }
    const size_t kstep = (size_t)(BK * 2);
    const size_t hstep = (size_t)HALF * K * 2;
    const size_t tstep = 2 * hstep;
    const size_t hstepA = (size_t)HALF * g.lda * 2, tstepA = 2 * hstepA;
    const int ks = g.ks; const ptrdiff_t a2off = (const char*)g.A2 - (const char*)g.A - (ptrdiff_t)ks * (ptrdiff_t)kstep;
    const unsigned ldsw = (unsigned)wid * 1024u;
    const int aoff = lds_byte(wr * 64 + fr, fq * 8), boff = lds_byte(wc * 32 + fr, fq * 8);
#define PG8_SA(b, h) (((b) * 2 + (h)) * HTB)
#define PG8_SB(b, h) ((4 + (b) * 2 + (h)) * HTB)
#define PG8_STAGE(bufoff, gbase, voff) do { _Pragma("unroll") for (int _i = 0; _i < 2; ++_i) \
        __builtin_amdgcn_global_load_lds((const unsigned*)((const char*)(gbase) + (voff)[_i]), (LAS unsigned*)(lds + (bufoff) + ldsw + _i * 8192), 16, 0, 0); } while (0)
#define PG8_LDA(dst, b, h) do { _Pragma("unroll") for (int m = 0; m < 4; ++m) _Pragma("unroll") for (int k = 0; k < 2; ++k) dst[m][k] = *(const LAS bf16x8*)(lds + PG8_SA(b, h) + aoff + m * 2048 + k * 1024); } while (0)
#define PG8_LDB(dst, b, h) do { _Pragma("unroll") for (int n = 0; n < 2; ++n) _Pragma("unroll") for (int k = 0; k < 2; ++k) dst[n][k] = *(const LAS bf16x8*)(lds + PG8_SB(b, h) + boff + n * 2048 + k * 1024); } while (0)
#define PG8_MMA(ai, bj, At, Bt) do { __builtin_amdgcn_s_setprio(1); _Pragma("unroll") for (int m = 0; m < 4; ++m) _Pragma("unroll") for (int n = 0; n < 2; ++n) _Pragma("unroll") for (int k = 0; k < 2; ++k) \
        acc[ai][bj][m][n] = __builtin_amdgcn_mfma_f32_16x16x32_bf16(Bt[n][k], At[m][k], acc[ai][bj][m][n], 0, 0, 0); __builtin_amdgcn_s_setprio(0); } while (0)
#define PG8_WAIT_V(n) asm volatile("s_waitcnt vmcnt(" #n ")" ::: "memory")
#define PG8_WAIT_L(n) asm volatile("s_waitcnt lgkmcnt(" #n ")" ::: "memory")
#define PG8_BAR __builtin_amdgcn_s_barrier()
#define PG8_SCHED __builtin_amdgcn_sched_barrier(0)
    Unit cur, nxt; int ui = 0;
    if (!S.next(0, cur)) return;
    f32x4 acc[2][2][4][2];
#pragma unroll
    for (int a = 0; a < 2; ++a)
#pragma unroll
        for (int b = 0; b < 2; ++b)
#pragma unroll
            for (int m = 0; m < 4; ++m)
#pragma unroll
                for (int n = 0; n < 2; ++n) acc[a][b][m][n] = (f32x4){0.f, 0.f, 0.f, 0.f};
    bf16x8 At[4][2], B0[2][2], B1[2][2];
    const char* cA = (const char*)g.A + (size_t)cur.pm * tstepA; const char* cB = (const char*)g.Bt + (size_t)cur.pn * tstep;
    PG8_STAGE(PG8_SB(0, 0), cB, voffB); PG8_STAGE(PG8_SA(0, 0), cA, voffA); PG8_STAGE(PG8_SB(0, 1), cB + hstep, voffB); PG8_STAGE(PG8_SA(0, 1), cA + hstepA, voffA);
    if (wr == 1) PG8_BAR;
    PG8_WAIT_V(4); PG8_BAR;
    PG8_STAGE(PG8_SB(1, 0), cB + kstep, voffB); PG8_STAGE(PG8_SA(1, 0), cA + kstep, voffA); PG8_STAGE(PG8_SB(1, 1), cB + hstep + kstep, voffB);
    PG8_WAIT_V(6); PG8_BAR;
    for (;;) {
        const bool has_next = S.next(ui + 1, nxt);
        const char* nA = has_next ? (const char*)g.A + (size_t)nxt.pm * tstepA : cA; const char* nB = has_next ? (const char*)g.Bt + (size_t)nxt.pn * tstep : cB;
        for (int t = 0; t < nt; t += 2) {
            const bool last = (t == nt - 2);
            const char* a1 = cA + (size_t)(t + 1) * kstep + ((t + 1) >= ks ? a2off : 0);
            const char* a2 = last ? nA : cA + (size_t)(t + 2) * kstep + ((t + 2) >= ks ? a2off : 0); const char* b2 = last ? nB : cB + (size_t)(t + 2) * kstep;
            const char* a3 = last ? nA + kstep : cA + (size_t)(t + 3) * kstep + ((t + 3) >= ks ? a2off : 0); const char* b3 = b2 + kstep;
            PG8_LDB(B0, 0, 0); PG8_SCHED; PG8_LDA(At, 0, 0); PG8_STAGE(PG8_SA(1, 1), a1 + hstepA, voffA);
            PG8_WAIT_L(8); PG8_BAR; PG8_WAIT_L(0); PG8_MMA(0, 0, At, B0); PG8_BAR; PG8_SCHED;
            PG8_LDB(B1, 0, 1); PG8_STAGE(PG8_SB(0, 0), b2, voffB);
            PG8_BAR; PG8_WAIT_L(0); PG8_MMA(0, 1, At, B1); PG8_BAR;
            PG8_LDA(At, 0, 1); PG8_STAGE(PG8_SA(0, 0), a2, voffA);
            PG8_BAR; PG8_WAIT_L(0); PG8_MMA(1, 0, At, B0); PG8_BAR; PG8_SCHED;
            PG8_STAGE(PG8_SB(0, 1), b2 + hstep, voffB);
            PG8_WAIT_V(6); PG8_BAR; PG8_MMA(1, 1, At, B1); PG8_BAR;
            PG8_LDB(B0, 1, 0); PG8_SCHED; PG8_LDA(At, 1, 0); PG8_STAGE(PG8_SA(0, 1), a2 + hstepA, voffA);
            PG8_WAIT_L(8); PG8_BAR; PG8_WAIT_L(0); PG8_MMA(0, 0, At, B0); PG8_BAR; PG8_SCHED;
            PG8_LDB(B1, 1, 1); PG8_STAGE(PG8_SB(1, 0), b3, voffB);
            PG8_BAR; PG8_WAIT_L(0); PG8_MMA(0, 1, At, B1); PG8_BAR;
            PG8_LDA(At, 1, 1); PG8_STAGE(PG8_SA(1, 0), a3, voffA);
            PG8_BAR; PG8_WAIT_L(0); PG8_MMA(1, 0, At, B0); PG8_BAR; PG8_SCHED;
            PG8_STAGE(PG8_SB(1, 1), b3 + hstep, voffB);
            PG8_WAIT_V(6); PG8_BAR; PG8_MMA(1, 1, At, B1); PG8_BAR;
        }
        E(acc, cur, wr, wc, fr, fq);
        if (!has_next) break;
#pragma unroll
        for (int a = 0; a < 2; ++a)
#pragma unroll
            for (int b = 0; b < 2; ++b)
#pragma unroll
                for (int m = 0; m < 4; ++m)
#pragma unroll
                    for (int n = 0; n < 2; ++n) acc[a][b][m][n] = (f32x4){0.f, 0.f, 0.f, 0.f};
        cur = nxt; cA = nA; cB = nB; ++ui;
    }
    PG8_WAIT_V(0);
    if (wr == 0) PG8_BAR;
    PG8_BAR;
#undef PG8_SA
#undef PG8_SB
#undef PG8_STAGE
#undef PG8_LDA
#undef PG8_LDB
#undef PG8_MMA
#undef PG8_WAIT_V
#undef PG8_WAIT_L
#undef PG8_BAR
#undef PG8_SCHED
}
}
using pg8::Unit;

struct Epi1 {
    static constexpr bool PERM = true;
    bf16_t* QKV; bf16_t* SZA; bf16_t* UU; bf16_t* SZB; float* BA; bf16_t* HALO;
    __device__ __forceinline__ void operator()(const f32x4 (&acc)[2][2][4][2], const Unit& u, int wr, int wc, int fr_, int fq_) const {
        int lane = (int)(threadIdx.x & 63); asm volatile("" : "+v"(lane));
        const int fr = lane & 15, fq = lane >> 4; (void)fr_; (void)fq_;
        const int row0 = u.pm * 256 + wr * 64 + fr, pn = u.pn;
#pragma unroll
        for (int ai = 0; ai < 2; ++ai)
#pragma unroll
            for (int m = 0; m < 4; ++m) {
                const size_t row = (size_t)(row0 + ai * 128 + m * 16);
#pragma unroll
                for (int bj = 0; bj < 2; ++bj) {
                    const int colt = 128 * bj + 32 * wc + 8 * fq;
                    f32x4 v0 = acc[ai][bj][m][0], v1 = acc[ai][bj][m][1];
                    if (pn < 12) {
                        const int c = pn * 256 + colt; const u32x4 pk = pack8(v0, v1);
                        *(u32x4*)(QKV + row * 3072 + c) = pk;
                        if (m == 3 && fr >= 13) *(u32x4*)(HALO + ((row >> 6) * 3 + (fr - 13)) * 3072 + c) = pk;
                    } else if (pn < 16) {
#pragma unroll
                        for (int e = 0; e < 4; ++e) { v0[e] = siluf_(v0[e]); v1[e] = siluf_(v1[e]); }
                        *(u32x4*)(SZA + row * 1024 + (pn - 12) * 256 + colt) = pack8(v0, v1);
                    } else if (pn < 20) {
                        *(u32x4*)(UU + row * 1024 + (pn - 16) * 256 + colt) = pack8(v0, v1);
                    } else if (pn < 24) {
#pragma unroll
                        for (int e = 0; e < 4; ++e) { v0[e] = siluf_(v0[e]); v1[e] = siluf_(v1[e]); }
                        *(u32x4*)(SZB + row * 1024 + (pn - 20) * 256 + colt) = pack8(v0, v1);
                    } else if (colt < 16) {
                        *(f32x4*)(BA + row * 16 + colt) = v0; *(f32x4*)(BA + row * 16 + colt + 4) = v1;
                    }
                }
            }
    }
};
struct EpiGlu {
    static constexpr bool PERM = true;
    const bf16_t* Y5; bf16_t* SZB;
    __device__ __forceinline__ void operator()(const f32x4 (&acc)[2][2][4][2], const Unit& u, int wr, int wc, int fr, int fq) const {
        const int row0 = u.pm * 256 + wr * 64 + fr;
#pragma unroll
        for (int ai = 0; ai < 2; ++ai)
#pragma unroll
            for (int m = 0; m < 4; ++m) {
                const size_t row = (size_t)(row0 + ai * 128 + m * 16);
#pragma unroll
                for (int bj = 0; bj < 2; ++bj) {
                    const int c = u.pn * 256 + 128 * bj + 32 * wc + 8 * fq;
                    const u32x4 y = *(const u32x4*)(Y5 + row * 1024 + c), z = *(const u32x4*)(SZB + row * 1024 + c);
                    const f32x4 a0 = acc[ai][bj][m][0], a1 = acc[ai][bj][m][1];
                    u32x4 o;
                    o.x = pk2(lo2f(y.x) * sigmoidf_(a0[0]) * lo2f(z.x), hi2f(y.x) * sigmoidf_(a0[1]) * hi2f(z.x));
                    o.y = pk2(lo2f(y.y) * sigmoidf_(a0[2]) * lo2f(z.y), hi2f(y.y) * sigmoidf_(a0[3]) * hi2f(z.y));
                    o.z = pk2(lo2f(y.z) * sigmoidf_(a1[0]) * lo2f(z.z), hi2f(y.z) * sigmoidf_(a1[1]) * hi2f(z.z));
                    o.w = pk2(lo2f(y.w) * sigmoidf_(a1[2]) * lo2f(z.w), hi2f(y.w) * sigmoidf_(a1[3]) * hi2f(z.w));
                    *(u32x4*)(SZB + row * 1024 + c) = o;
                }
            }
    }
};
struct EpiF32 {
    static constexpr bool PERM = false;
    float* C;
    __device__ __forceinline__ void operator()(const f32x4 (&acc)[2][2][4][2], const Unit& u, int wr, int wc, int fr, int fq) const {
        const int row0 = u.pm * 256 + wr * 64 + fr, col0 = u.pn * 256 + wc * 32 + 4 * fq;
#pragma unroll
        for (int ai = 0; ai < 2; ++ai)
#pragma unroll
            for (int m = 0; m < 4; ++m) { float* rowp = C + (size_t)(row0 + ai * 128 + m * 16) * 1024 + col0;
#pragma unroll
                for (int bj = 0; bj < 2; ++bj)
#pragma unroll
                    for (int n = 0; n < 2; ++n) *(f32x4*)(rowp + bj * 128 + n * 16) = acc[ai][bj][m][n]; }
    }
};
struct EpiB16 {
    static constexpr bool PERM = true;
    bf16_t* C;
    __device__ __forceinline__ void operator()(const f32x4 (&acc)[2][2][4][2], const Unit& u, int wr, int wc, int fr, int fq) const {
        const int row0 = u.pm * 256 + wr * 64 + fr, col0 = u.pn * 256 + wc * 32 + 8 * fq;
#pragma unroll
        for (int ai = 0; ai < 2; ++ai)
#pragma unroll
            for (int m = 0; m < 4; ++m) { bf16_t* rowp = C + (size_t)(row0 + ai * 128 + m * 16) * 1024 + col0;
#pragma unroll
                for (int bj = 0; bj < 2; ++bj) *(u32x4*)(rowp + bj * 128) = pack8(acc[ai][bj][m][0], acc[ai][bj][m][1]); }
    }
};
struct Epi2 {
    static constexpr bool PERM = false;
    bf16_t* P; bf16_t* Q;
    __device__ __forceinline__ void operator()(const f32x4 (&acc)[2][2][4][2], const Unit& u, int wr, int wc, int fr, int fq) const {
        const int row0 = u.pm * 256 + wr * 64 + fr, ch = u.pn * 64 + 16 * wc + 4 * fq;
#pragma unroll
        for (int ai = 0; ai < 2; ++ai)
#pragma unroll
            for (int m = 0; m < 4; ++m) {
                const size_t row = (size_t)(row0 + ai * 128 + m * 16);
                const f32x4 gb = acc[ai][0][m][0], gc = acc[ai][0][m][1], hv = acc[ai][1][m][0], z = acc[ai][1][m][1];
                u32x2 pp, qq;
                pp.x = pk2(gc[0] * hv[0], gc[1] * hv[1]); pp.y = pk2(gc[2] * hv[2], gc[3] * hv[3]);
                qq.x = pk2(gb[0] * siluf_(z[0]), gb[1] * siluf_(z[1])); qq.y = pk2(gb[2] * siluf_(z[2]), gb[3] * siluf_(z[3]));
                *(u32x2*)(P + row * 2048 + ch) = pp; *(u32x2*)(Q + row * 2048 + ch) = qq;
            }
    }
};

__device__ __forceinline__ int src_col(int mode, int n, int& pn_unused) {
    (void)pn_unused;
    if (mode == 0) return n;
    if (mode == 1) { if (n < 4096) return n; if (n < 6144) return n + 16; if (n < 6160) return n - 2048; return -1; }
    const int pn = n >> 8, col = n & 255, bj = col >> 7, wc = (col >> 5) & 3, nn = (col >> 4) & 1, lo = col & 15;
    return (2 * bj + nn) * 2048 + pn * 64 + 16 * wc + lo;
}
__device__ __forceinline__ void phase_convert(const Prm& p, unsigned char* lds, int t_begin, int t_end, int nblk, int bidx) {
    float* tile = (float*)lds;
    const int tid = threadIdx.x;
    for (int tix = t_begin + bidx; tix < t_end; tix += nblk) {
        int tl = tix, K, Nsrc, mode; const float* W; bf16_t* Wt;
        if (tl < 1600) { W = p.in[3]; Wt = (bf16_t*)(p.ws + OFF_WT1); K = 1024; Nsrc = 6160; mode = 1; }
        else if ((tl -= 1600) < 256) { W = p.in[16]; Wt = (bf16_t*)(p.ws + OFF_WTG); K = 1024; Nsrc = 1024; mode = 0; }
        else if ((tl -= 256) < 512) { W = p.in[17]; Wt = (bf16_t*)(p.ws + OFF_WTO0); K = 2048; Nsrc = 1024; mode = 0; }
        else if ((tl -= 512) < 2048) { W = p.in[18]; Wt = (bf16_t*)(p.ws + OFF_WT2); K = 1024; Nsrc = 8192; mode = 2; }
        else { tl -= 2048; W = p.in[20]; Wt = (bf16_t*)(p.ws + OFF_WTO1); K = 2048; Nsrc = 1024; mode = 0; }
        const int ntk = K / 64, n0 = (tl / ntk) * 64, k0 = (tl % ntk) * 64;
        { const int j = tid & 63; int dummy = 0; const int sc = src_col(mode, n0 + j, dummy);
#pragma unroll
          for (int i = 0; i < 8; ++i) { const int k = (tid >> 6) + 8 * i; tile[k * 65 + j] = sc >= 0 ? W[(size_t)(k0 + k) * Nsrc + sc] : 0.0f; } }
        __syncthreads();
        { const int r = tid >> 3, c8 = (tid & 7) * 8; u32x4 o;
          o.x = pk2(tile[(c8 + 0) * 65 + r], tile[(c8 + 1) * 65 + r]); o.y = pk2(tile[(c8 + 2) * 65 + r], tile[(c8 + 3) * 65 + r]);
          o.z = pk2(tile[(c8 + 4) * 65 + r], tile[(c8 + 5) * 65 + r]); o.w = pk2(tile[(c8 + 6) * 65 + r], tile[(c8 + 7) * 65 + r]);
          *(u32x4*)(Wt + (size_t)(n0 + r) * K + k0 + c8) = o; }
        __syncthreads();
    }
}
__device__ __forceinline__ void phase_rmsnorm_x(const float* x, const float* w, bf16_t* H) {
    const int lane = threadIdx.x & 63, nw = gridDim.x * 8;
    for (int row = blockIdx.x * 8 + (threadIdx.x >> 6); row < TOK; row += nw) {
        const f32x4* xr = (const f32x4*)(x + (size_t)row * 1024);
        f32x4 v[4]; float ss = 0.f;
#pragma unroll
        for (int i = 0; i < 4; ++i) { v[i] = xr[lane + 64 * i]; ss += v[i][0] * v[i][0] + v[i][1] * v[i][1] + v[i][2] * v[i][2] + v[i][3] * v[i][3]; }
        ss = wave_sum(ss);
        const float rstd = rsqrtf(ss * (1.0f / 1024.0f) + 1e-6f);
#pragma unroll
        for (int i = 0; i < 4; ++i) { const f32x4 w4 = ((const f32x4*)w)[lane + 64 * i]; u32x2 o;
            o.x = pk2(v[i][0] * rstd * w4[0], v[i][1] * rstd * w4[1]); o.y = pk2(v[i][2] * rstd * w4[2], v[i][3] * rstd * w4[3]);
            *(u32x2*)(H + (size_t)row * 1024 + (lane + 64 * i) * 4) = o; }
    }
}
template <bool NEXT>
__device__ __forceinline__ void phase_post(const float* base, const bf16_t* Y, const float* wpost, float* OUT, const float* wpre, bf16_t* H) {
    const int lane = threadIdx.x & 63, nw = gridDim.x * 8;
    for (int row = blockIdx.x * 8 + (threadIdx.x >> 6); row < TOK; row += nw) {
        const u32x2* yr = (const u32x2*)(Y + (size_t)row * 1024); const f32x4* br = (const f32x4*)(base + (size_t)row * 1024);
        f32x4 v[4], xb[4]; float ss = 0.f;
#pragma unroll
        for (int i = 0; i < 4; ++i) { const u32x2 y2 = yr[lane + 64 * i]; v[i] = (f32x4){lo2f(y2.x), hi2f(y2.x), lo2f(y2.y), hi2f(y2.y)}; xb[i] = br[lane + 64 * i]; ss += v[i][0] * v[i][0] + v[i][1] * v[i][1] + v[i][2] * v[i][2] + v[i][3] * v[i][3]; }
        ss = wave_sum(ss);
        const float rstd = rsqrtf(ss * (1.0f / 1024.0f) + 1e-6f);
        float s2 = 0.f;
#pragma unroll
        for (int i = 0; i < 4; ++i) { const f32x4 w4 = ((const f32x4*)wpost)[lane + 64 * i];
#pragma unroll
            for (int e = 0; e < 4; ++e) { v[i][e] = xb[i][e] + v[i][e] * rstd * w4[e]; s2 += v[i][e] * v[i][e]; }
            ((f32x4*)(OUT + (size_t)row * 1024))[lane + 64 * i] = v[i]; }
        if (NEXT) {
            s2 = wave_sum(s2);
            const float r2 = rsqrtf(s2 * (1.0f / 1024.0f) + 1e-6f);
#pragma unroll
            for (int i = 0; i < 4; ++i) { const f32x4 w4 = ((const f32x4*)wpre)[lane + 64 * i]; u32x2 o;
                o.x = pk2(v[i][0] * r2 * w4[0], v[i][1] * r2 * w4[1]); o.y = pk2(v[i][2] * r2 * w4[2], v[i][3] * r2 * w4[3]);
                *(u32x2*)(H + (size_t)row * 1024 + (lane + 64 * i) * 4) = o; }
        }
    }
}


__device__ __forceinline__ void sincos_d(double x, double& s, double& c) {
    const double k = rint(x * 0.6366197723675814);
    const double r = fma(-k, 6.123233995736766e-17, fma(-k, 1.5707963267948966, x)), r2 = r * r;
    double sp = -7.647163731819816e-13; sp = fma(sp, r2, 1.6059043836821613e-10); sp = fma(sp, r2, -2.505210838544172e-8); sp = fma(sp, r2, 2.7557319223985893e-6);
    sp = fma(sp, r2, -1.984126984126984e-4); sp = fma(sp, r2, 8.333333333333333e-3); sp = fma(sp, r2, -1.6666666666666666e-1); sp = fma(sp * r2, r, r);
    double cp = 4.779477332387385e-14; cp = fma(cp, r2, -1.1470745597729725e-11); cp = fma(cp, r2, 2.08767569878681e-9); cp = fma(cp, r2, -2.755731922398589e-7);
    cp = fma(cp, r2, 2.48015873015873e-5); cp = fma(cp, r2, -1.388888888888889e-3); cp = fma(cp, r2, 4.1666666666666664e-2); cp = fma(cp, r2, -0.5); cp = fma(cp, r2, 1.0);
    const int q = ((int)k) & 3;
    const double s0 = (q & 1) ? cp : sp, c0 = (q & 1) ? sp : cp;
    s = (q & 2) ? -s0 : s0; c = ((q + 1) & 2) ? -c0 : c0;
}
__device__ __forceinline__ double exp_d(double x) {
    const double n = rint(x * 1.4426950408889634);
    const double r = fma(-n, 2.3190468138462996e-17, fma(-n, 0.6931471805599453, x));
    double p = 1.6059043836821613e-10; p = fma(p, r, 2.08767569878681e-9); p = fma(p, r, 2.505210838544172e-8); p = fma(p, r, 2.755731922398589e-7); p = fma(p, r, 2.7557319223985893e-6);
    p = fma(p, r, 2.48015873015873e-5); p = fma(p, r, 1.984126984126984e-4); p = fma(p, r, 1.388888888888889e-3); p = fma(p, r, 8.333333333333333e-3); p = fma(p, r, 4.1666666666666664e-2);
    p = fma(p, r, 1.6666666666666666e-1); p = fma(p, r, 0.5); p = fma(p, r, 1.0); p = fma(p, r, 1.0);
    return ldexp(p, (int)n);
}
__device__ __forceinline__ float bcast_lo(float v) { auto r = __builtin_amdgcn_permlane32_swap(__float_as_uint(v), __float_as_uint(v), false, false); return __uint_as_float(r[0]); }
__device__ __forceinline__ float bcast_hi(float v) { auto r = __builtin_amdgcn_permlane32_swap(__float_as_uint(v), __float_as_uint(v), false, false); return __uint_as_float(r[1]); }

struct S5C {
    float ar[2][4], ai[2][4];
    float a512r[2], a512i[2];
    bf16x8 BB[4];
    bf16x8 CC[4];
    float dco;
};

template <bool OUT>
__device__ __forceinline__ void s5_chunk(const S5C& C, bf16_t* UU, int b, int g, int chunk, float (&st)[2][2], bf16_t* sX, int lane) {
    const int n = lane & 31, hh = lane >> 5, fr = lane & 15, fq = lane >> 4;
    const size_t tok0 = (size_t)b * SEQ + (size_t)chunk * 512;
    bf16x8 ua = *(const bf16x8*)(UU + (tok0 + n) * 1024 + 16 * g + 8 * hh);
    bf16_t uo[8];
    if (OUT) {
#pragma unroll
        for (int mt = 0; mt < 2; ++mt)
#pragma unroll
            for (int j = 0; j < 4; ++j) uo[mt * 4 + j] = UU[(tok0 + 16 * mt + 4 * fq + j) * 1024 + 16 * g + fr];
    }
    for (int blk = 0; blk < 16; ++blk) {
        const size_t t0 = tok0 + (size_t)blk * 32;
        const bf16x8 ucur = ua;
        bf16_t ucuro[8];
        if (OUT) {
#pragma unroll
            for (int i = 0; i < 8; ++i) ucuro[i] = uo[i];
        }
        if (blk < 15) {
            ua = *(const bf16x8*)(UU + (t0 + 32 + n) * 1024 + 16 * g + 8 * hh);
            if (OUT) {
#pragma unroll
                for (int mt = 0; mt < 2; ++mt)
#pragma unroll
                    for (int j = 0; j < 4; ++j) uo[mt * 4 + j] = UU[(t0 + 32 + 16 * mt + 4 * fq + j) * 1024 + 16 * g + fr];
            }
        }
        f32x16 acc[4];
#pragma unroll
        for (int tl = 0; tl < 4; ++tl) {
            f32x16 z;
#pragma unroll
            for (int i = 0; i < 16; ++i) z[i] = 0.f;
            acc[tl] = __builtin_amdgcn_mfma_f32_32x32x16_bf16(ucur, C.BB[tl], z, 0, 0, 0);
        }
#pragma unroll
        for (int tp = 0; tp < 2; ++tp) {
            f32x16& re = acc[2 * tp]; f32x16& im = acc[2 * tp + 1];
            const float a1r = C.ar[tp][0], a1i = C.ai[tp][0];
#pragma unroll
            for (int q = 0; q < 4; ++q)
#pragma unroll
                for (int r = 1; r < 4; ++r) {
                    const float pr = re[4 * q + r - 1], pi = im[4 * q + r - 1];
                    re[4 * q + r] += a1r * pr - a1i * pi; im[4 * q + r] += a1r * pi + a1i * pr;
                }
            float cr = st[tp][0], ci = st[tp][1];
            const float a4r = C.ar[tp][3], a4i = C.ai[tp][3];
#pragma unroll
            for (int q = 0; q < 4; ++q) {
                const float tr = re[4 * q + 3] + a4r * cr - a4i * ci, ti = im[4 * q + 3] + a4r * ci + a4i * cr;
                const float o0r = bcast_lo(tr), o0i = bcast_lo(ti);
                const float xr = hh ? o0r : cr, xi = hh ? o0i : ci;
                if (OUT) {
#pragma unroll
                    for (int r = 0; r < 4; ++r) { const float kr = C.ar[tp][r], ki = C.ai[tp][r];
                        re[4 * q + r] += kr * xr - ki * xi; im[4 * q + r] += kr * xi + ki * xr; }
                } else {
                    re[4 * q + 3] += a4r * xr - a4i * xi; im[4 * q + 3] += a4r * xi + a4i * xr;
                }
                cr = bcast_hi(re[4 * q + 3]); ci = bcast_hi(im[4 * q + 3]);
            }
            st[tp][0] = cr; st[tp][1] = ci;
        }
        if (OUT) {
            asm volatile("s_waitcnt lgkmcnt(0)" ::: "memory");
#pragma unroll
            for (int tp = 0; tp < 2; ++tp)
#pragma unroll
                for (int i = 0; i < 16; ++i) {
                    const int t = 8 * (i >> 2) + 4 * hh + (i & 3);
                    *(unsigned*)(sX + t * 136 + 2 * (n + 32 * tp)) = pk2(acc[2 * tp][i], acc[2 * tp + 1][i]);
                }
            asm volatile("s_waitcnt lgkmcnt(0)" ::: "memory");
            __builtin_amdgcn_wave_barrier();
#pragma unroll
            for (int mt = 0; mt < 2; ++mt) {
                f32x4 y = (f32x4){0.f, 0.f, 0.f, 0.f};
#pragma unroll
                for (int ks = 0; ks < 4; ++ks) {
                    const bf16x8 xa = *(const bf16x8*)(sX + (16 * mt + fr) * 136 + 32 * ks + 8 * fq);
                    y = __builtin_amdgcn_mfma_f32_16x16x32_bf16(xa, C.CC[ks], y, 0, 0, 0);
                }
#pragma unroll
                for (int j = 0; j < 4; ++j) {
                    float v = y[j] + C.dco * bf2f(ucuro[mt * 4 + j]);
                    const float inner = 0.7978845608028654f * (v + 0.044715f * v * v * v);
                    v = v / (1.0f + __expf(-2.0f * inner));
                    UU[(t0 + 16 * mt + 4 * fq + j) * 1024 + 16 * g + fr] = f2bf(v);
                }
            }
            asm volatile("s_waitcnt lgkmcnt(0)" ::: "memory");
            __builtin_amdgcn_wave_barrier();
        }
    }
}

__device__ __forceinline__ void phase_s5(const Prm& p, unsigned char* lds, int bg) {
    const int b = bg >> 6, g = bg & 63;
    const int tid = threadIdx.x, wv = tid >> 6, lane = tid & 63, n = lane & 31, hh = lane >> 5, fr = lane & 15, fq = lane >> 4;
    bf16_t* sX = (bf16_t*)(lds + wv * 8704);
    float* sXE = (float*)(lds + 8 * 8704);
    bf16_t* UU = (bf16_t*)(p.ws + OFF_UU);
    const float* lam_re = p.in[8]; const float* lam_im = p.in[9]; const float* b_re = p.in[10]; const float* b_im = p.in[11];
    const float* c_re = p.in[12]; const float* c_im = p.in[13];
    S5C C;
    const double dt = exp_d((double)p.in[14][g]);
    float fre[2], fim[2];
#pragma unroll
    for (int tp = 0; tp < 2; ++tp) {
        const int pp = n + 32 * tp;
        const double lr = (double)fminf(lam_re[g * 64 + pp], -1e-4f), li = (double)lam_im[g * 64 + pp];
#pragma unroll
        for (int k = 0; k < 4; ++k) { double sn, cs; sincos_d(li * dt * (k + 1), sn, cs); const double mag = exp_d(lr * dt * (k + 1)); C.ar[tp][k] = (float)(mag * cs); C.ai[tp][k] = (float)(mag * sn); }
        { double sn, cs; sincos_d(li * dt * 512.0, sn, cs); const double mag = exp_d(lr * dt * 512.0); C.a512r[tp] = (float)(mag * cs); C.a512i[tp] = (float)(mag * sn); }
        double sn, cs; sincos_d(li * dt, sn, cs);
        const double mag = exp_d(lr * dt), abr = mag * cs, abi = mag * sn;
        const double den = lr * lr + li * li, nr = abr - 1.0, ni = abi;
        fre[tp] = (float)((nr * lr + ni * li) / den); fim[tp] = (float)((ni * lr - nr * li) / den);
    }
#pragma unroll
    for (int tl = 0; tl < 4; ++tl) {
        const int tp = tl >> 1, ri = tl & 1, pp = n + 32 * tp;
#pragma unroll
        for (int j = 0; j < 8; ++j) {
            const int ch = 8 * hh + j;
            const float br = b_re[(g * 64 + pp) * 16 + ch], bi = b_im[(g * 64 + pp) * 16 + ch];
            const float v = ri == 0 ? fre[tp] * br - fim[tp] * bi : fre[tp] * bi + fim[tp] * br;
            C.BB[tl][j] = (short)f2bf(v);
        }
    }
#pragma unroll
    for (int ks = 0; ks < 4; ++ks)
#pragma unroll
        for (int j = 0; j < 8; ++j) {
            const int k = 32 * ks + 8 * fq + j, pp = k >> 1, ri = k & 1;
            const float v = ri == 0 ? c_re[(g * 16 + fr) * 64 + pp] : -c_im[(g * 16 + fr) * 64 + pp];
            C.CC[ks][j] = (short)f2bf(v);
        }
    C.dco = p.in[15][16 * g + fr];
    for (int rd = 0; rd < 2; ++rd) {
        const int chunk = wv + 8 * rd;
        float st[2][2] = {{0.f, 0.f}, {0.f, 0.f}};
        s5_chunk<false>(C, UU, b, g, chunk, st, sX, lane);
        if (hh == 0) {
#pragma unroll
            for (int tp = 0; tp < 2; ++tp) { sXE[(chunk * 64 + n + 32 * tp) * 2 + 0] = st[tp][0]; sXE[(chunk * 64 + n + 32 * tp) * 2 + 1] = st[tp][1]; }
        }
    }
    __syncthreads();
    for (int rd = 0; rd < 2; ++rd) {
        const int chunk = wv + 8 * rd;
        float st[2][2] = {{0.f, 0.f}, {0.f, 0.f}};
        for (int c2 = 0; c2 < chunk; ++c2) {
#pragma unroll
            for (int tp = 0; tp < 2; ++tp) {
                const float er = sXE[(c2 * 64 + n + 32 * tp) * 2 + 0], ei = sXE[(c2 * 64 + n + 32 * tp) * 2 + 1];
                const float nr = C.a512r[tp] * st[tp][0] - C.a512i[tp] * st[tp][1] + er, ni = C.a512r[tp] * st[tp][1] + C.a512i[tp] * st[tp][0] + ei;
                st[tp][0] = nr; st[tp][1] = ni;
            }
        }
        s5_chunk<true>(C, UU, b, g, chunk, st, sX, lane);
    }
    __syncthreads();
}

__device__ __forceinline__ void phase_gdn_prep(const Prm& p, unsigned char* lds, int it0, int nrounds) {
    const int tid0 = threadIdx.x, hb = tid0 >> 8;
    unsigned char* base = lds + hb * 76800;
    bf16_t* sQ = (bf16_t*)base;
    bf16_t* sK = (bf16_t*)(base + 17408);
    bf16_t* sV = (bf16_t*)(base + 2 * 17408);
    float* sL = (float*)(base + 3 * 17408);
    float* sBeta = (float*)(base + 4 * 17408);
    float* sGc = sBeta + 64; float* sEg = sGc + 64; float* sBE = sEg + 64;
    float* sCW = sBE + 64;
    bf16_t* QKV = (bf16_t*)(p.ws + OFF_QKV); const bf16_t* HALO = (const bf16_t*)(p.ws + OFF_HALO);
    const float* BA = (const float*)(p.ws + OFF_BA); float* GL = (float*)(p.ws + OFF_GL);
    bf16_t* WB = (bf16_t*)(p.ws + OFF_WB); bf16_t* ATT = (bf16_t*)(p.ws + OFF_ATT);
    const float* convw = p.in[4];
    for (int rd = 0; rd < nrounds; ++rd) {
        int tid = tid0; asm volatile("" : "+v"(tid));
        const int ht = tid & 255, hw = (tid >> 6) & 3, lane = tid & 63, fr = lane & 15, fq = lane >> 4;
        const int it = it0 + rd * 2 + hb;
        const int b = it >> 10, h = (it >> 7) & 7, nc = it & 127;
        const size_t tokb = (size_t)b * SEQ + (size_t)nc * 64;
#pragma unroll
        for (int i = 0; i < 6; ++i) { const int idx = ht + 256 * i, s3 = idx >> 9, tap = (idx >> 7) & 3, ch = idx & 127; sCW[idx] = convw[tap * 3072 + s3 * 1024 + h * 128 + ch]; }
        __syncthreads();
        {
            const int t0 = (ht >> 4) * 4, cgp = ht & 15;
#pragma unroll 1
            for (int s = 0; s < 3; ++s) {
                const int col = s * 1024 + h * 128 + cgp * 8;
                u32x4 xr[7];
#pragma unroll
                for (int i = 0; i < 7; ++i) {
                    const int tt = t0 - 3 + i;
                    xr[i] = (u32x4){0u, 0u, 0u, 0u};
                    if (tt >= 0) xr[i] = *(const u32x4*)(QKV + (tokb + tt) * 3072 + col);
                    else if (nc > 0) xr[i] = *(const u32x4*)(HALO + ((size_t)(b * 128 + nc - 1) * 3 + (3 + tt)) * 3072 + col);
                }
                f32x4 w0[4], w1[4];
#pragma unroll
                for (int j = 0; j < 4; ++j) { w0[j] = *(const f32x4*)(sCW + s * 512 + j * 128 + cgp * 8); w1[j] = *(const f32x4*)(sCW + s * 512 + j * 128 + cgp * 8 + 4); }
                float o[4][8], ss[4];
#pragma unroll
                for (int tk = 0; tk < 4; ++tk) {
                    float a[8];
#pragma unroll
                    for (int e = 0; e < 8; ++e) a[e] = 0.f;
#pragma unroll
                    for (int j = 0; j < 4; ++j) {
                        const u32x4 xv = xr[tk + j];
                        a[0] += w0[j][0] * lo2f(xv.x); a[1] += w0[j][1] * hi2f(xv.x); a[2] += w0[j][2] * lo2f(xv.y); a[3] += w0[j][3] * hi2f(xv.y);
                        a[4] += w1[j][0] * lo2f(xv.z); a[5] += w1[j][1] * hi2f(xv.z); a[6] += w1[j][2] * lo2f(xv.w); a[7] += w1[j][3] * hi2f(xv.w);
                    }
                    float acc2 = 0.f;
#pragma unroll
                    for (int e = 0; e < 8; ++e) { const float v = siluf_(a[e]); o[tk][e] = v; acc2 += v * v; }
                    ss[tk] = acc2;
                }
                bf16_t* dst = (s == 0 ? sQ : (s == 1 ? sK : sV)) + t0 * 136 + cgp * 8;
#pragma unroll
                for (int tk = 0; tk < 4; ++tk) {
                    float sc = 1.0f;
                    if (s < 2) { float q = ss[tk]; q += __shfl_xor(q, 1); q += __shfl_xor(q, 2); q += __shfl_xor(q, 4); q += __shfl_xor(q, 8); sc = rsqrtf(q + 1e-6f) * (s == 0 ? 0.08838834764831845f : 1.0f); }
                    u32x4 pk;
                    pk.x = pk2(o[tk][0] * sc, o[tk][1] * sc); pk.y = pk2(o[tk][2] * sc, o[tk][3] * sc); pk.z = pk2(o[tk][4] * sc, o[tk][5] * sc); pk.w = pk2(o[tk][6] * sc, o[tk][7] * sc);
                    *(u32x4*)(dst + tk * 136) = pk;
                }
            }
        }
        if (hw == 0) {
            const size_t tg = tokb + lane;
            const float braw = BA[tg * 16 + h], araw = BA[tg * 16 + 8 + h];
            const float beta = 1.0f / (1.0f + expf(-braw));
            const float xx = araw + p.in[6][h];
            const float sp = xx > 20.f ? xx : log1pf(expf(xx));
            float gg = -expf(p.in[5][h]) * sp;
#pragma unroll
            for (int off = 1; off < 64; off <<= 1) { const float o = __shfl_up(gg, off); if (lane >= off) gg += o; }
            sBeta[lane] = beta; sGc[lane] = gg; sEg[lane] = expf(gg); sBE[lane] = beta * expf(gg);
            if (lane == 63) GL[it] = expf(gg);
        }
        __syncthreads();
        {
            bf16x8 aK[4], aQ[4];
#pragma unroll
            for (int ks = 0; ks < 4; ++ks) { aK[ks] = *(const bf16x8*)(sK + (16 * hw + fr) * 136 + 32 * ks + 8 * fq); aQ[ks] = *(const bf16x8*)(sQ + (16 * hw + fr) * 136 + 32 * ks + 8 * fq); }
#pragma unroll
            for (int nt = 0; nt < 4; ++nt) {
                f32x4 kk = (f32x4){0.f, 0.f, 0.f, 0.f}, qk = (f32x4){0.f, 0.f, 0.f, 0.f};
#pragma unroll
                for (int ks = 0; ks < 4; ++ks) {
                    const bf16x8 bK = *(const bf16x8*)(sK + (16 * nt + fr) * 136 + 32 * ks + 8 * fq);
                    kk = __builtin_amdgcn_mfma_f32_16x16x32_bf16(aK[ks], bK, kk, 0, 0, 0);
                    qk = __builtin_amdgcn_mfma_f32_16x16x32_bf16(aQ[ks], bK, qk, 0, 0, 0);
                }
                const int mcol = 16 * nt + fr; const float gm = sGc[mcol];
#pragma unroll
                for (int j = 0; j < 4; ++j) {
                    const int c = 16 * hw + 4 * fq + j;
                    const float dec = __expf(fminf(sGc[c] - gm, 0.f));
                    sL[c * 68 + mcol] = (mcol < c) ? kk[j] * sBeta[c] * dec : 0.f;
                    ATT[(size_t)it * 4096 + c * 64 + mcol] = f2bf((mcol <= c) ? qk[j] * dec : 0.f);
                }
            }
        }
        __syncthreads();
        {
            float x[64];
            const bool isU = ht < 128; const int jc = ht & 127;
            const bf16_t* src = isU ? sV : sK;
            const float* fac = isU ? sBeta : sBE;
#pragma unroll
            for (int cb = 0; cb < 16; ++cb) {
                float a[4];
#pragma unroll
                for (int r = 0; r < 4; ++r) a[r] = bf2f(src[(4 * cb + r) * 136 + jc]) * fac[4 * cb + r];
#pragma unroll
                for (int m4 = 0; m4 < cb; ++m4)
#pragma unroll
                    for (int r = 0; r < 4; ++r) {
                        const f32x4 l = *(const f32x4*)(sL + (4 * cb + r) * 68 + 4 * m4);
                        a[r] -= l[0] * x[4 * m4] + l[1] * x[4 * m4 + 1] + l[2] * x[4 * m4 + 2] + l[3] * x[4 * m4 + 3];
                    }
                const f32x4 d1 = *(const f32x4*)(sL + (4 * cb + 1) * 68 + 4 * cb), d2 = *(const f32x4*)(sL + (4 * cb + 2) * 68 + 4 * cb), d3 = *(const f32x4*)(sL + (4 * cb + 3) * 68 + 4 * cb);
                x[4 * cb] = a[0];
                x[4 * cb + 1] = a[1] - d1[0] * x[4 * cb];
                x[4 * cb + 2] = a[2] - d2[0] * x[4 * cb] - d2[1] * x[4 * cb + 1];
                x[4 * cb + 3] = a[3] - d3[0] * x[4 * cb] - d3[1] * x[4 * cb + 1] - d3[2] * x[4 * cb + 2];
            }
            if (isU) {
                const int w8 = jc >> 4, nn = jc & 15;
#pragma unroll
                for (int rq = 0; rq < 4; ++rq)
#pragma unroll
                    for (int pc = 0; pc < 2; ++pc) {
                        const int c0 = 32 * pc + 4 * rq;
                        u32x4 o; o.x = pk2(x[c0 + 0], x[c0 + 1]); o.y = pk2(x[c0 + 2], x[c0 + 3]); o.z = pk2(x[c0 + 16], x[c0 + 17]); o.w = pk2(x[c0 + 18], x[c0 + 19]);
                        const int L = ((w8 * 2 + pc) * 64 + rq * 16 + nn) * 8;
                        *(u32x4*)(QKV + (tokb + (L >> 7)) * 3072 + 2048 + h * 128 + (L & 127)) = o;
                    }
            }
            __syncthreads();
            if (!isU) {
                bf16_t* sW2 = (bf16_t*)sL;
#pragma unroll
                for (int c = 0; c < 64; ++c) sW2[c * 136 + jc] = f2bf(-x[c]);
            }
        }
        __syncthreads();
        {
            const bf16_t* sW2 = (const bf16_t*)sL;
#pragma unroll
            for (int i = 0; i < 4; ++i) { const int ch = ht + 256 * i, r = ch >> 4, c8 = (ch & 15) * 8; *(u32x4*)(WB + (size_t)it * 8192 + r * 128 + c8) = *(const u32x4*)(sW2 + r * 136 + c8); }
        }
        {
            const int c = ht >> 2, ds = (ht & 3) * 32; const float eg = sEg[c];
#pragma unroll
            for (int c8 = 0; c8 < 4; ++c8) {
                const u32x4 v = *(const u32x4*)(sQ + c * 136 + ds + c8 * 8); u32x4 o;
                o.x = pk2(lo2f(v.x) * eg, hi2f(v.x) * eg); o.y = pk2(lo2f(v.y) * eg, hi2f(v.y) * eg); o.z = pk2(lo2f(v.z) * eg, hi2f(v.z) * eg); o.w = pk2(lo2f(v.w) * eg, hi2f(v.w) * eg);
                *(u32x4*)(QKV + (tokb + c) * 3072 + h * 128 + ds + c8 * 8) = o;
            }
            const int d = ht >> 1, cs = (ht & 1) * 32; const float gl = sGc[63];
#pragma unroll
            for (int c8 = 0; c8 < 4; ++c8) {
                float v[8];
#pragma unroll
                for (int e = 0; e < 8; ++e) { const int cc = cs + c8 * 8 + e; v[e] = bf2f(sK[cc * 136 + d]) * __expf(gl - sGc[cc]); }
                u32x4 o; o.x = pk2(v[0], v[1]); o.y = pk2(v[2], v[3]); o.z = pk2(v[4], v[5]); o.w = pk2(v[6], v[7]);
                *(u32x4*)(QKV + (tokb + (d >> 1)) * 3072 + 1024 + h * 128 + (d & 1) * 64 + cs + c8 * 8) = o;
            }
        }
        __syncthreads();
    }
}

constexpr int SC_RW = 288, SC_RK = 160;
constexpr int SC_QD = 64 * SC_RW, SC_KT = 2 * 64 * SC_RW, SC_AT = SC_KT + 128 * SC_RK, SC_U = SC_AT + 64 * SC_RK, SC_STAGE = SC_U + 8192;
static_assert(2 * SC_STAGE <= LDS_BYTES && SC_U % 16 == 0 && SC_STAGE % 16 == 0, "scan LDS layout");
struct ScanRegs { u32x4 rw[4], rq[4], rk[4], ru[2], ra[2]; };
__device__ __forceinline__ void scan_load(ScanRegs& R, const bf16_t* QKV, const bf16_t* WB, const bf16_t* ATT, int b, int h, int jh, int it, int nc, int lt) {
    const size_t tokb = (size_t)b * SEQ + (size_t)nc * 64;
#pragma unroll
    for (int i = 0; i < 4; ++i) { const int ch = lt + 256 * i, r = ch >> 4, c8 = (ch & 15) * 8;
        R.rw[i] = *(const u32x4*)(WB + (size_t)it * 8192 + r * 128 + c8);
        const bf16_t* qp = QKV + (tokb + r) * 3072 + h * 128 + c8;
        R.rq[i] = *(const u32x4*)(qp); R.rk[i] = *(const u32x4*)(qp + 1024); }
#pragma unroll
    for (int i = 0; i < 2; ++i) { const int ch = lt + 256 * i; R.ra[i] = *(const u32x4*)(ATT + (size_t)it * 4096 + ch * 8);
        const int L = jh * 4096 + ch * 8; R.ru[i] = *(const u32x4*)(QKV + (tokb + (L >> 7)) * 3072 + 2048 + h * 128 + (L & 127)); }
}
__device__ __forceinline__ void st32p(unsigned char* rowp, int g, u32x4 v) {
    const int pt = g & 3; unsigned char* p = rowp + 64 * (g >> 2) + 32 * (pt & 1) + 8 * (pt >> 1);
    *(u32x2*)p = (u32x2){v.x, v.y}; *(u32x2*)(p + 16) = (u32x2){v.z, v.w};
}
__device__ __forceinline__ void scan_store(const ScanRegs& R, unsigned char* sbp, int lt) {
#pragma unroll
    for (int i = 0; i < 4; ++i) { const int ch = lt + 256 * i, r = ch >> 4, g = ch & 15;
        st32p(sbp + r * SC_RW, g, R.rw[i]);
        st32p(sbp + SC_QD + r * SC_RW, g, R.rq[i]);
        const int d = 2 * r + (g >> 3), gk = g & 7;
        st32p(sbp + SC_KT + d * SC_RK, gk, R.rk[i]); }
#pragma unroll
    for (int i = 0; i < 2; ++i) { const int ch = lt + 256 * i, r = ch >> 3, g = ch & 7; st32p(sbp + SC_AT + r * SC_RK, g, R.ra[i]); *(u32x4*)(sbp + SC_U + ch * 16) = R.ru[i]; }
}
__device__ __forceinline__ bf16x8 pack2(const f32x4& a, const f32x4& b) {
    u32x4 r; r.x = pk2(a[0], a[1]); r.y = pk2(a[2], a[3]); r.z = pk2(b[0], b[1]); r.w = pk2(b[2], b[3]); return __builtin_bit_cast(bf16x8, r);
}
#define SCAN_BAR() do { asm volatile("s_waitcnt lgkmcnt(0)" ::: "memory"); __builtin_amdgcn_s_barrier(); asm volatile("" ::: "memory"); } while (0)
#define MF16(a, b, c) __builtin_amdgcn_mfma_f32_16x16x32_bf16(a, b, c, 0, 0, 0)
__device__ __forceinline__ void phase_gdn_scan(const Prm& p, unsigned char* lds, int blk) {
    const int tid = threadIdx.x, wv = tid >> 6, lane = tid & 63, n = lane & 15, kq = lane >> 4;
    const int bh = blk & 15, jh = blk >> 4, b = bh >> 3, h = bh & 7;
    const bf16_t* QKV = (const bf16_t*)(p.ws + OFF_QKV); const bf16_t* WB = (const bf16_t*)(p.ws + OFF_WB); const bf16_t* ATT = (const bf16_t*)(p.ws + OFF_ATT);
    const float* GL = (const float*)(p.ws + OFF_GL); bf16_t* O = (bf16_t*)(p.ws + OFF_H);
    const int itb = bh * 128;
    if (wv >= 4) {
        const int lt = tid - 256;
        ScanRegs RA, RB;
        scan_load(RA, QKV, WB, ATT, b, h, jh, itb, 0, lt);
        scan_store(RA, lds, lt);
        __builtin_amdgcn_sched_barrier(0);
        scan_load(RA, QKV, WB, ATT, b, h, jh, itb + 1, 1, lt);
        __builtin_amdgcn_sched_barrier(0);
        scan_load(RB, QKV, WB, ATT, b, h, jh, itb + 2, 2, lt);
        __builtin_amdgcn_sched_barrier(0);
        SCAN_BAR();
        for (int nc = 0; nc < 128; nc += 2) {
            __builtin_amdgcn_sched_barrier(0);
            scan_store(RA, lds + SC_STAGE, lt);
            __builtin_amdgcn_sched_barrier(0);
            { const int c3 = nc + 3 < 128 ? nc + 3 : 127; scan_load(RA, QKV, WB, ATT, b, h, jh, itb + c3, c3, lt); }
            __builtin_amdgcn_sched_barrier(0);
            SCAN_BAR();
            __builtin_amdgcn_sched_barrier(0);
            scan_store(RB, lds, lt);
            __builtin_amdgcn_sched_barrier(0);
            { const int c4 = nc + 4 < 128 ? nc + 4 : 127; scan_load(RB, QKV, WB, ATT, b, h, jh, itb + c4, c4, lt); }
            SCAN_BAR();
        }
    } else {
        const float gl0 = GL[itb + lane], gl1 = GL[itb + 64 + lane];
        f32x4 S[8];
#pragma unroll
        for (int dt = 0; dt < 8; ++dt) S[dt] = (f32x4){0.f, 0.f, 0.f, 0.f};
        const int e = 64 * jh + 16 * wv + n;
        SCAN_BAR();
        for (int nc = 0; nc < 128; ++nc) {
            const unsigned char* sbp = lds + (nc & 1) * SC_STAGE;
            const float gl = __builtin_bit_cast(float, __builtin_amdgcn_readlane(__builtin_bit_cast(int, nc < 64 ? gl0 : gl1), nc & 63));
            const unsigned char* pw = sbp + n * SC_RW + 16 * kq;
            const unsigned char* pk = sbp + SC_KT + n * SC_RK + 16 * kq;
            f32x4 V[4], Oa[4];
#pragma unroll
            for (int pc = 0; pc < 2; ++pc) {
                const u32x4 uu = *(const u32x4*)(sbp + SC_U + ((wv * 2 + pc) * 64 + lane) * 16);
                V[2 * pc] = (f32x4){lo2f(uu.x), hi2f(uu.x), lo2f(uu.y), hi2f(uu.y)}; V[2 * pc + 1] = (f32x4){lo2f(uu.z), hi2f(uu.z), lo2f(uu.w), hi2f(uu.w)};
            }
#pragma unroll
            for (int ct = 0; ct < 4; ++ct) Oa[ct] = (f32x4){0.f, 0.f, 0.f, 0.f};
            bf16x8 fa[2][8];
#define LD_WQ(dst, ks_) do { _Pragma("unroll") for (int mt = 0; mt < 4; ++mt) { dst[mt] = *(const bf16x8*)(pw + mt * 16 * SC_RW + 64 * (ks_)); dst[4 + mt] = *(const bf16x8*)(pw + SC_QD + mt * 16 * SC_RW + 64 * (ks_)); } } while (0)
            LD_WQ(fa[0], 0);
#pragma unroll
            for (int ks = 0; ks < 4; ++ks) {
                if (ks < 3) LD_WQ(fa[(ks + 1) & 1], ks + 1);
                const bf16x8 sb8 = pack2(S[2 * ks], S[2 * ks + 1]);
                __builtin_amdgcn_sched_barrier(0);
#pragma unroll
                for (int mt = 0; mt < 4; ++mt) { V[mt] = MF16(fa[ks & 1][mt], sb8, V[mt]); Oa[mt] = MF16(fa[ks & 1][4 + mt], sb8, Oa[mt]); }
                __builtin_amdgcn_sched_barrier(0);
            }
#undef LD_WQ
            bf16x8 fb[2][12];
#define LD_AK(dst, k2_) do { _Pragma("unroll") for (int mt = 0; mt < 4; ++mt) dst[mt] = *(const bf16x8*)(pk + (SC_AT - SC_KT) + mt * 16 * SC_RK + 64 * (k2_)); \
                             _Pragma("unroll") for (int dt = 0; dt < 8; ++dt) dst[4 + dt] = *(const bf16x8*)(pk + dt * 16 * SC_RK + 64 * (k2_)); } while (0)
            LD_AK(fb[0], 0);
            bf16x8 Vb[2];
            Vb[0] = pack2(V[0], V[1]); Vb[1] = pack2(V[2], V[3]);
#pragma unroll
            for (int dt = 0; dt < 8; ++dt) S[dt] *= gl;
#pragma unroll
            for (int k2 = 0; k2 < 2; ++k2) {
                if (k2 < 1) LD_AK(fb[1], 1);
                __builtin_amdgcn_sched_barrier(0);
#pragma unroll
                for (int mt = 0; mt < 4; ++mt) Oa[mt] = MF16(fb[k2][mt], Vb[k2], Oa[mt]);
#pragma unroll
                for (int dt = 0; dt < 8; ++dt) S[dt] = MF16(fb[k2][4 + dt], Vb[k2], S[dt]);
                __builtin_amdgcn_sched_barrier(0);
            }
#undef LD_AK
            bf16_t* obase = O + (size_t)(itb + nc) * 8192 + e * 64 + 4 * kq;
#pragma unroll
            for (int ct = 0; ct < 4; ++ct) { u32x2 o2; o2.x = pk2(Oa[ct][0], Oa[ct][1]); o2.y = pk2(Oa[ct][2], Oa[ct][3]); *(u32x2*)(obase + 16 * ct) = o2; }
            SCAN_BAR();
        }
    }
    __syncthreads();
}

__device__ __forceinline__ void phase_ya(const Prm& p, unsigned char* lds) {
    const bf16_t* OT = (const bf16_t*)(p.ws + OFF_H); bf16_t* SZA = (bf16_t*)p.out;
    const float* gw = p.in[7];
    bf16_t* sT = (bf16_t*)lds;
    float* sPart = (float*)(lds + 16384);
    const int tid = threadIdx.x, w = tid >> 6, c = tid & 63;
    for (int it = blockIdx.x; it < NIT; it += gridDim.x) {
        const int b = it >> 10, h = (it >> 7) & 7, nc = it & 127;
        const size_t tok = (size_t)b * SEQ + (size_t)nc * 64 + c;
#pragma unroll
        for (int i = 0; i < 2; ++i) { const int ch = tid + 512 * i; *(u32x4*)(sT + ch * 8) = *(const u32x4*)(OT + (size_t)it * 8192 + ch * 8); }
        const u32x4 z0 = *(const u32x4*)(SZA + tok * 1024 + h * 128 + 16 * w), z1 = *(const u32x4*)(SZA + tok * 1024 + h * 128 + 16 * w + 8);
        __syncthreads();
        float o[16]; float ss = 0.f;
#pragma unroll
        for (int j = 0; j < 16; ++j) { o[j] = bf2f(sT[(16 * w + j) * 64 + c]); ss += o[j] * o[j]; }
        sPart[w * 64 + c] = ss;
        __syncthreads();
        float tot = 0.f;
#pragma unroll
        for (int k = 0; k < 8; ++k) tot += sPart[k * 64 + c];
        const float rstd = rsqrtf(tot * (1.0f / 128.0f) + 1e-6f);
        const unsigned zz[8] = {z0.x, z0.y, z0.z, z0.w, z1.x, z1.y, z1.z, z1.w};
        unsigned r[8];
#pragma unroll
        for (int j = 0; j < 8; ++j)
            r[j] = pk2(o[2 * j] * rstd * gw[16 * w + 2 * j] * lo2f(zz[j]), o[2 * j + 1] * rstd * gw[16 * w + 2 * j + 1] * hi2f(zz[j]));
        *(u32x4*)(SZA + tok * 1024 + h * 128 + 16 * w) = (u32x4){r[0], r[1], r[2], r[3]};
        *(u32x4*)(SZA + tok * 1024 + h * 128 + 16 * w + 8) = (u32x4){r[4], r[5], r[6], r[7]};
        __syncthreads();
    }
}
__device__ __forceinline__ void phase_conv3(const Prm& p) {
    const bf16_t* P = (const bf16_t*)(p.ws + OFF_P); bf16_t* Q = (bf16_t*)(p.ws + OFF_Q); const float* cw = p.in[19];
    const int nth = gridDim.x * 512;
    for (int idx = blockIdx.x * 512 + threadIdx.x; idx < TOK * 256; idx += nth) {
        const int t = idx >> 8, c8 = (idx & 255) * 8, ts = t & (SEQ - 1);
        const u32x4 z4 = (u32x4){0u, 0u, 0u, 0u};
        const u32x4 p0 = *(const u32x4*)(P + (size_t)t * 2048 + c8);
        const u32x4 p1 = ts >= 1 ? *(const u32x4*)(P + (size_t)(t - 1) * 2048 + c8) : z4;
        const u32x4 p2 = ts >= 2 ? *(const u32x4*)(P + (size_t)(t - 2) * 2048 + c8) : z4;
        const u32x4 q = *(const u32x4*)(Q + (size_t)t * 2048 + c8);
        float r[8];
        const unsigned pa[4] = {p0.x, p0.y, p0.z, p0.w}, pb[4] = {p1.x, p1.y, p1.z, p1.w}, pc[4] = {p2.x, p2.y, p2.z, p2.w}, qa[4] = {q.x, q.y, q.z, q.w};
#pragma unroll
        for (int e = 0; e < 4; ++e) {
            const int c = c8 + 2 * e;
            r[2 * e] = lo2f(qa[e]) * (cw[c] * lo2f(pc[e]) + cw[2048 + c] * lo2f(pb[e]) + cw[4096 + c] * lo2f(pa[e]));
            r[2 * e + 1] = hi2f(qa[e]) * (cw[c + 1] * hi2f(pc[e]) + cw[2048 + c + 1] * hi2f(pb[e]) + cw[4096 + c + 1] * hi2f(pa[e]));
        }
        u32x4 o; o.x = pk2(r[0], r[1]); o.y = pk2(r[2], r[3]); o.z = pk2(r[4], r[5]); o.w = pk2(r[6], r[7]);
        *(u32x4*)(Q + (size_t)t * 2048 + c8) = o;
    }
}

#define XB_TMO      128
#define XB_XCNT(j)  (256  + 64 * (j))
#define XB_XSUB(j)  (1280 + 64 * (j))
#define XB_XGEN(j)  (2304 + 64 * (j))
#define XB_TOP      3328
#define XB_TOPGEN   3392
#define XCD_BAR_WORDS 3456
#define XB_SPIN_CAP (1u << 18)

__device__ __forceinline__ unsigned xb_ld(unsigned* p)              { return __hip_atomic_load(p, __ATOMIC_RELAXED, __HIP_MEMORY_SCOPE_AGENT); }
__device__ __forceinline__ unsigned xb_add(unsigned* p, unsigned v) { return __hip_atomic_fetch_add(p, v, __ATOMIC_RELAXED, __HIP_MEMORY_SCOPE_AGENT); }
__device__ __forceinline__ unsigned xb_xcc_id() { return (unsigned)__builtin_amdgcn_s_getreg((3 << 11) | 20) & 0xFu; }
#define XB_SPIN(cond, bar) do { unsigned _sp = 0; while (cond) { __builtin_amdgcn_s_sleep(1); \
    if ((++_sp & 255u) == 0u) { if (xb_ld(&(bar)[XB_TMO])) break; if (_sp > XB_SPIN_CAP) { atomicAdd(&(bar)[XB_TMO], 1u); break; } } } } while (0)

struct XcdBarrier {
    unsigned* bar; unsigned x;
    volatile LAS unsigned* st;
};

__device__ __forceinline__ XcdBarrier xcd_barrier_post(unsigned* bar, volatile LAS unsigned* st) {
    XcdBarrier b; b.bar = bar; b.x = xb_xcc_id(); b.st = st;
    if (threadIdx.x == 0) (void)xb_add(&bar[XB_XCNT(b.x)], 1u);
    return b;
}
__device__ __forceinline__ void xcd_barrier_complete(unsigned* bar, unsigned x, unsigned& nloc, unsigned& nx) {
    const unsigned G = gridDim.x * gridDim.y * gridDim.z;
    unsigned sum, cnt, mine, sp = 0u;
    for (;;) {
        sum = 0u; cnt = 0u; mine = 0u;
#pragma unroll
        for (unsigned j = 0; j < 16; ++j) { const unsigned c = xb_ld(&bar[XB_XCNT(j)]); sum += c; cnt += (c > 0u) ? 1u : 0u; mine = (j == x) ? c : mine; }
        if (sum == G) break;
        __builtin_amdgcn_s_sleep(1);
        if ((++sp & 255u) == 0u) { if (xb_ld(&bar[XB_TMO])) break; if (sp > XB_SPIN_CAP) { atomicAdd(&bar[XB_TMO], 1u); break; } }
    }
    nloc = mine > 0u ? mine : 1u; nx = cnt > 0u ? cnt : 1u;
}

__device__ __forceinline__ void xcd_barrier(const XcdBarrier& b) {
    asm volatile("s_waitcnt vmcnt(0)" ::: "memory");
    __syncthreads();
    if (threadIdx.x == 0) {
        unsigned* bar = b.bar;
        __builtin_amdgcn_s_waitcnt(0);
        unsigned nloc = b.st[0], nx = b.st[1];
        if (nloc == 0u) { xcd_barrier_complete(bar, b.x, nloc, nx); b.st[0] = nloc; b.st[1] = nx; }
        const unsigned old = xb_add(&bar[XB_XSUB(b.x)], 1u);
        const unsigned gen = old / nloc;
        if (old + 1u == (gen + 1u) * nloc) {
            __builtin_amdgcn_fence(__ATOMIC_RELEASE, "agent");
            asm volatile("s_waitcnt vmcnt(0)" ::: "memory");
            const unsigned og = xb_add(&bar[XB_TOP], 1u);
            const unsigned tg = og / nx;
            if (og + 1u == (tg + 1u) * nx) xb_add(&bar[XB_TOPGEN], 1u);
            else XB_SPIN(xb_ld(&bar[XB_TOPGEN]) == tg, bar);
            __builtin_amdgcn_fence(__ATOMIC_ACQUIRE, "agent");
            xb_add(&bar[XB_XGEN(b.x)], 1u);
            asm volatile("s_waitcnt vmcnt(0)" ::: "memory");
        } else {
            XB_SPIN(xb_ld(&bar[XB_XGEN(b.x)]) == gen, bar);
            __builtin_amdgcn_fence(__ATOMIC_ACQUIRE, "agent");
            asm volatile("s_waitcnt vmcnt(0)" ::: "memory");
        }
    }
    __syncthreads();
}

constexpr int NPHASE = 11;
#define REP_GEMM 1
#define REP_SYNC 1
#define REP_SCAN 1
#define SCAN_PROBE 1
#define REP_P0 1
#ifndef PHM
#define PHM 0x7FF
#endif
__global__ void __launch_bounds__(512, 2) mega(Prm p) {
    extern __shared__ __attribute__((aligned(16))) unsigned char shm[];
    LAS unsigned char* lds3 = (LAS unsigned char*)shm;
    unsigned char* ws = p.ws;
    volatile LAS unsigned* xst = (volatile LAS unsigned*)(lds3 + LDS_BYTES);
    if (threadIdx.x == 0) { xst[0] = 0u; xst[1] = 0u; }
    __syncthreads();
    XcdBarrier xb{};
    const bool multi = (p.ph_hi - p.ph_lo) > 1;
    if (multi) xb = xcd_barrier_post((unsigned*)(ws + OFF_BAR), xst);
    if (p.ph_lo < 0) cg::this_grid().sync();
#define PH_BEGIN(i) if (((PHM >> (i)) & 1) && p.ph_lo <= (i) && (i) < p.ph_hi) { if ((i) > p.ph_lo) { xcd_barrier(xb); if (REP_SYNC > 1) xcd_barrier(xb); } pg8::StaticOrder S; (void)S;
#define PH_END }
    PH_BEGIN(0)
        for (int rep = 0; rep < REP_P0; ++rep) {
        phase_convert(p, shm, 0, 1856, gridDim.x, blockIdx.x);
        phase_rmsnorm_x(p.in[0], p.in[1], (bf16_t*)(ws + OFF_H)); __syncthreads(); }
    PH_END
    PH_BEGIN(1)
        pg8::Gemm g{(const bf16_t*)(ws + OFF_H), (const bf16_t*)(ws + OFF_WT1), TOK, NP1, 1024, (const bf16_t*)(ws + OFF_H), 1024, 64};
        Epi1 E{(bf16_t*)(ws + OFF_QKV), (bf16_t*)p.out, (bf16_t*)(ws + OFF_UU), (bf16_t*)p.out + (size_t)TOK * 1024, (float*)(ws + OFF_BA), (bf16_t*)(ws + OFF_HALO)};
        S.init(TOK, NP1, gridDim.x, blockIdx.x); for (int rep = 0; rep < REP_GEMM; ++rep) { pg8::gemm_phase(lds3, g, S, E); __syncthreads(); }
    PH_END
    PH_BEGIN(2)
        {
            unsigned* ctr = (unsigned*)(ws + OFF_BAR) + 3600;
            volatile LAS unsigned* sIt = xst + 2;
            for (;;) {
                if (threadIdx.x == 0) sIt[0] = __hip_atomic_fetch_add(ctr, 2u, __ATOMIC_RELAXED, __HIP_MEMORY_SCOPE_AGENT);
                __syncthreads();
                const unsigned it0 = sIt[0];
                __syncthreads();
                if (it0 >= (unsigned)NIT) break;
                phase_gdn_prep(p, shm, (int)it0, 1);
            }
        }
    PH_END
    PH_BEGIN(3)
        if (blockIdx.x < 32) phase_gdn_scan(p, shm, blockIdx.x);
        else {
            const int ob = blockIdx.x - 32, nob = gridDim.x - 32;
            if (ob < 128) phase_s5(p, shm, ob);
            {
                unsigned* cnt = (unsigned*)(ws + OFF_BAR) + 3700;
                asm volatile("s_waitcnt vmcnt(0)" ::: "memory");
                __syncthreads();
                if (threadIdx.x == 0) {
                    __builtin_amdgcn_fence(__ATOMIC_RELEASE, "agent");
                    asm volatile("s_waitcnt vmcnt(0)" ::: "memory");
                    __hip_atomic_fetch_add(cnt, 1u, __ATOMIC_RELAXED, __HIP_MEMORY_SCOPE_AGENT);
                    unsigned sp = 0;
                    while (__hip_atomic_load(cnt, __ATOMIC_RELAXED, __HIP_MEMORY_SCOPE_AGENT) < (unsigned)nob) { __builtin_amdgcn_s_sleep(2); if (++sp > (1u << 22)) break; }
                    __builtin_amdgcn_fence(__ATOMIC_ACQUIRE, "agent");
                    asm volatile("s_waitcnt vmcnt(0)" ::: "memory");
                }
                __syncthreads();
            }
            pg8::Gemm g{(const bf16_t*)(ws + OFF_UU), (const bf16_t*)(ws + OFF_WTG), TOK, 1024, 1024, (const bf16_t*)(ws + OFF_UU), 1024, 64};
            EpiGlu E{(const bf16_t*)(ws + OFF_UU), (bf16_t*)p.out + (size_t)TOK * 1024};
            S.init(TOK, 1024, nob, ob); pg8::gemm_phase(lds3, g, S, E);
            __syncthreads();
            if (ob >= 32) phase_convert(p, shm, 1856, 4928, nob - 32, ob - 32);
        }
    PH_END
    PH_BEGIN(4)
        phase_ya(p, shm);
    PH_END
    PH_BEGIN(5)
        pg8::Gemm g{(const bf16_t*)p.out, (const bf16_t*)(ws + OFF_WTO0), TOK, 1024, 2048, (const bf16_t*)p.out + (size_t)TOK * 1024, 1024, 16};
        EpiB16 E{(bf16_t*)(ws + OFF_QKV)};
        S.init(TOK, 1024, gridDim.x, blockIdx.x); for (int rep = 0; rep < REP_GEMM; ++rep) { pg8::gemm_phase(lds3, g, S, E); __syncthreads(); }
    PH_END
    PH_BEGIN(6)
        phase_post<true>(p.in[0], (const bf16_t*)(ws + OFF_QKV), p.in[2], p.out, p.in[1] + 1024, (bf16_t*)(ws + OFF_H));
    PH_END
    PH_BEGIN(7)
        pg8::Gemm g{(const bf16_t*)(ws + OFF_H), (const bf16_t*)(ws + OFF_WT2), TOK, 8192, 1024, (const bf16_t*)(ws + OFF_H), 1024, 64};
        Epi2 E{(bf16_t*)(ws + OFF_P), (bf16_t*)(ws + OFF_Q)};
        S.init(TOK, 8192, gridDim.x, blockIdx.x); for (int rep = 0; rep < REP_GEMM; ++rep) { pg8::gemm_phase(lds3, g, S, E); __syncthreads(); }
    PH_END
    PH_BEGIN(8)
        phase_conv3(p);
    PH_END
    PH_BEGIN(9)
        pg8::Gemm g{(const bf16_t*)(ws + OFF_Q), (const bf16_t*)(ws + OFF_WTO1), TOK, 1024, 2048, (const bf16_t*)(ws + OFF_Q), 2048, 64};
        EpiB16 E{(bf16_t*)(ws + OFF_P)};
        S.init(TOK, 1024, gridDim.x, blockIdx.x); for (int rep = 0; rep < REP_GEMM; ++rep) { pg8::gemm_phase(lds3, g, S, E); __syncthreads(); }
    PH_END
    PH_BEGIN(10)
        phase_post<false>(p.out, (const bf16_t*)(ws + OFF_P), p.in[2] + 1024, p.out, nullptr, nullptr);
    PH_END
}

#ifndef N_LAUNCH_MODE
#define N_LAUNCH_MODE 1
#endif

extern "C" void kernel_launch(void* const* d_in, const int* in_sizes, int n_in, void* d_out, int out_size, void* d_ws, size_t ws_size, hipStream_t stream) {
    static int ready = 0;
    if (!ready) {
        if (n_in != 21 || ws_size < WS_END || out_size != TOK * DM) { fprintf(stderr, "kernel_launch: unexpected shapes (n_in %d ws %zu out %d)\n", n_in, ws_size, out_size); ready = -1; return; }
        if (hipFuncSetAttribute((const void*)mega, hipFuncAttributeMaxDynamicSharedMemorySize, LDS_BYTES + 16) != hipSuccess) { fprintf(stderr, "kernel_launch: hipFuncSetAttribute failed\n"); ready = -1; return; }
        ready = 1;
    }
    if (ready < 0) return;
    Prm p{};
    for (int i = 0; i < 21; ++i) p.in[i] = (const float*)d_in[i];
    p.out = (float*)d_out; p.ws = (unsigned char*)d_ws;
#if N_LAUNCH_MODE == 1
    p.ph_lo = 0; p.ph_hi = NPHASE;
    void* args[] = {&p};
    if (hipMemsetAsync((unsigned char*)d_ws + OFF_BAR, 0, 16384, stream) != hipSuccess) { fprintf(stderr, "memset failed\n"); return; }
    hipError_t e = hipLaunchCooperativeKernel((const void*)mega, dim3(256), dim3(512), args, LDS_BYTES + 16, stream);
    if (e != hipSuccess) fprintf(stderr, "cooperative launch failed: %s\n", hipGetErrorString(e));
#else
    for (int ph = 0; ph < NPHASE; ++ph) {
        p.ph_lo = ph; p.ph_hi = ph + 1;
        hipLaunchKernelGGL(mega, dim3(256), dim3(512), LDS_BYTES + 16, stream, p);
    }
#endif
}
```

```cpp
#include <hip/hip_runtime.h>
#include <hip/hip_cooperative_groups.h>
#include <cstdio>
namespace cg = cooperative_groups;

#define LAS __attribute__((address_space(3)))
typedef unsigned short bf16_t;
typedef short bf16x8 __attribute__((ext_vector_type(8)));
typedef float f32x4 __attribute__((ext_vector_type(4)));
typedef float f32x16 __attribute__((ext_vector_type(16)));
typedef unsigned u32x4 __attribute__((ext_vector_type(4)));
typedef unsigned u32x2 __attribute__((ext_vector_type(2)));

constexpr int TOK = 16384, DM = 1024, SEQ = 8192;
constexpr int NP1 = 6400;
constexpr int NIT = 2048;

constexpr size_t OFF_WT1 = 0;
constexpr size_t OFF_WTG = OFF_WT1 + (size_t)NP1 * 1024 * 2;
constexpr size_t OFF_WTO0 = OFF_WTG + (size_t)1024 * 1024 * 2;
constexpr size_t OFF_WT2 = OFF_WTO0 + (size_t)1024 * 2048 * 2;
constexpr size_t OFF_WTO1 = OFF_WT2 + (size_t)8192 * 1024 * 2;
constexpr size_t OFF_H = OFF_WTO1 + (size_t)1024 * 2048 * 2;
constexpr size_t OFF_QKV = OFF_H + (size_t)TOK * 1024 * 2;
constexpr size_t OFF_UU = OFF_QKV + (size_t)TOK * 3072 * 2;
constexpr size_t OFF_WB = OFF_UU + (size_t)TOK * 1024 * 2;
constexpr size_t OFF_ATT = OFF_WB + (size_t)NIT * 8192 * 2;
constexpr size_t OFF_HALO = OFF_ATT + (size_t)NIT * 4096 * 2;
constexpr size_t OFF_BA = OFF_HALO + (size_t)256 * 3 * 3072 * 2;
constexpr size_t OFF_GL = OFF_BA + (size_t)TOK * 16 * 4;
constexpr size_t OFF_BAR = OFF_GL + (size_t)NIT * 4;
constexpr size_t WS_END = OFF_BAR + 16384;
constexpr size_t OFF_YMIX = OFF_QKV;
constexpr size_t OFF_P = OFF_QKV;
constexpr size_t OFF_Q = OFF_QKV + (size_t)TOK * 2048 * 2;
static_assert(OFF_Q + (size_t)TOK * 2048 * 2 <= OFF_WB, "Q overlaps live data");
static_assert(WS_END <= (size_t)256 * 1024 * 1024, "workspace too big");

constexpr int LDS_BYTES = 157696;

struct Prm {
    const float* in[21];
    float* out;
    unsigned char* ws;
    int ph_lo, ph_hi;
};

__device__ __forceinline__ float bf2f(bf16_t b) { return __uint_as_float(((unsigned)b) << 16); }
__device__ __forceinline__ bf16_t f2bf(float f) { unsigned u = __float_as_uint(f); u += 0x7FFFu + ((u >> 16) & 1u); return (bf16_t)(u >> 16); }
typedef __bf16 bf16v2_t __attribute__((ext_vector_type(2)));
typedef float f32x2_t __attribute__((ext_vector_type(2)));
__device__ __forceinline__ unsigned pk2(float lo, float hi) { const f32x2_t v = {lo, hi}; return __builtin_bit_cast(unsigned, __builtin_convertvector(v, bf16v2_t)); }
__device__ __forceinline__ float lo2f(unsigned u) { return __uint_as_float(u << 16); }
__device__ __forceinline__ float hi2f(unsigned u) { return __uint_as_float(u & 0xFFFF0000u); }
__device__ __forceinline__ float sigmoidf_(float x) { return 1.0f / (1.0f + __expf(-x)); }
__device__ __forceinline__ float siluf_(float x) { return x / (1.0f + __expf(-x)); }
__device__ __forceinline__ float wave_sum(float v) {
#pragma unroll
    for (int o = 32; o >= 1; o >>= 1) v += __shfl_xor(v, o);
    return v;
}
__device__ __forceinline__ u32x4 pack8(f32x4 a, f32x4 b) { u32x4 r; r.x = pk2(a[0], a[1]); r.y = pk2(a[2], a[3]); r.z = pk2(b[0], b[1]); r.w = pk2(b[2], b[3]); return r; }

namespace pg8 {
constexpr int BM = 256, BK = 64, HALF = 128, HTB = HALF * BK * 2, STAGE_BYTES = 8 * HTB, NXCD = 8, WGM = 8;
__device__ __forceinline__ int lds_byte(int r, int c) { const int st = (r >> 4) * 2 + (c >> 5), rr = r & 15, cc = c & 31, ob = rr * 64 + cc * 2; return st * 1024 + (ob ^ (((ob >> 9) & 1) << 5)); }
__device__ __forceinline__ void stage_rc(int b, int& R, int& C) { const int st = b / 1024, sb = b % 1024, swz = sb ^ (((sb >> 9) & 1) << 5); R = (st >> 1) * 16 + swz / 64; C = (st & 1) * 32 + (swz % 64) / 2; }
__device__ __forceinline__ int perm32(int rho) { const int n = rho >> 4, i = rho & 15; return 8 * (i >> 2) + 4 * n + (i & 3); }
struct Unit { int pm, pn; };
struct Gemm { const bf16_t* A; const bf16_t* Bt; int M, N, K; const bf16_t* A2; int lda, ks; };
struct StaticOrder {
    int nM, nN, nwg, G, c;
    __device__ void init(int M, int N, int G_, int c_) { nM = M / BM; nN = N / BM; nwg = nM * nN; G = G_; c = c_; }
    __device__ bool next(int i, Unit& u) const {
        const long L = (long)i * G + c; if (L >= nwg) return false;
        int wgid = (int)L; { const int q = nwg / NXCD, r = nwg % NXCD, xcd = wgid % NXCD, off = wgid / NXCD; wgid = (xcd < r ? xcd * (q + 1) : r * (q + 1) + (xcd - r) * q) + off; }
        const int nig = WGM * nN, gid = wgid / nig, fm = gid * WGM, gsz = (nM - fm) < WGM ? (nM - fm) : WGM;
        u.pm = fm + ((wgid % nig) % gsz); u.pn = (wgid % nig) / gsz; return true;
    }
};

template <class Epi>
__device__ __forceinline__ void gemm_phase(LAS unsigned char* lds, const Gemm g, const StaticOrder& S, const Epi& E) {
    const int tid = threadIdx.x, wid = __builtin_amdgcn_readfirstlane(tid >> 6), lane = tid & 63, wr = wid >> 2, wc = wid & 3, fr = lane & 15, fq = lane >> 4;
    const int K = g.K, nt = K / BK;
    unsigned voffA[2], voffB[2];
#pragma unroll
    for (int i = 0; i < 2; ++i) { int R, C; stage_rc(tid * 16 + i * 8192, R, C); const int Rb = Epi::PERM ? ((R & ~31) + perm32(R & 31)) : R;
        voffA[i] = (unsigned)(R * g.lda + C) * 2u; voffB[i] = (unsigned)(Rb * K + C) * 2u; }
    const size_t kstep = (size_t)(BK * 2);
    const size_t hstep = (size_t)HALF * K * 2;
    const size_t tstep = 2 * hstep;
    const size_t hstepA = (size_t)HALF * g.lda * 2, tstepA = 2 * hstepA;
    const int ks = g.ks; const ptrdiff_t a2off = (const char*)g.A2 - (const char*)g.A - (ptrdiff_t)ks * (ptrdiff_t)kstep;
    const unsigned ldsw = (unsigned)wid * 1024u;
    const int aoff = lds_byte(wr * 64 + fr, fq * 8), boff = lds_byte(wc * 32 + fr, fq * 8);
#define PG8_SA(b, h) (((b) * 2 + (h)) * HTB)
#define PG8_SB(b, h) ((4 + (b) * 2 + (h)) * HTB)
#define PG8_STAGE(bufoff, gbase, voff) do { _Pragma("unroll") for (int _i = 0; _i < 2; ++_i) \
        __builtin_amdgcn_global_load_lds((const unsigned*)((const char*)(gbase) + (voff)[_i]), (LAS unsigned*)(lds + (bufoff) + ldsw + _i * 8192), 16, 0, 0); } while (0)
#define PG8_LDA(dst, b, h) do { _Pragma("unroll") for (int m = 0; m < 4; ++m) _Pragma("unroll") for (int k = 0; k < 2; ++k) dst[m][k] = *(const LAS bf16x8*)(lds + PG8_SA(b, h) + aoff + m * 2048 + k * 1024); } while (0)
#define PG8_LDB(dst, b, h) do { _Pragma("unroll") for (int n = 0; n < 2; ++n) _Pragma("unroll") for (int k = 0; k < 2; ++k) dst[n][k] = *(const LAS bf16x8*)(lds + PG8_SB(b, h) + boff + n * 2048 + k * 1024); } while (0)
#define PG8_MMA(ai, bj, At, Bt) do { __builtin_amdgcn_s_setprio(1); _Pragma("unroll") for (int m = 0; m < 4; ++m) _Pragma("unroll") for (int n = 0; n < 2; ++n) _Pragma("unroll") for (int k = 0; k < 2; ++k) \
        acc[ai][bj][m][n] = __builtin_amdgcn_mfma_f32_16x16x32_bf16(Bt[n][k], At[m][k], acc[ai][bj][m][n], 0, 0, 0); __builtin_amdgcn_s_setprio(0); } while (0)
#define PG8_WAIT_V(n) asm volatile("s_waitcnt vmcnt(" #n ")" ::: "memory")
#define PG8_WAIT_L(n) asm volatile("s_waitcnt lgkmcnt(" #n ")" ::: "memory")
#define PG8_BAR __builtin_amdgcn_s_barrier()
#define PG8_SCHED __builtin_amdgcn_sched_barrier(0)
    Unit cur, nxt; int ui = 0;
    if (!S.next(0, cur)) return;
    f32x4 acc[2][2][4][2];
#pragma unroll
    for (int a = 0; a < 2; ++a)
#pragma unroll
        for (int b = 0; b < 2; ++b)
#pragma unroll
            for (int m = 0; m < 4; ++m)
#pragma unroll
                for (int n = 0; n < 2; ++n) acc[a][b][m][n] = (f32x4){0.f, 0.f, 0.f, 0.f};
    bf16x8 At[4][2], B0[2][2], B1[2][2];
    const char* cA = (const char*)g.A + (size_t)cur.pm * tstepA; const char* cB = (const char*)g.Bt + (size_t)cur.pn * tstep;
    PG8_STAGE(PG8_SB(0, 0), cB, voffB); PG8_STAGE(PG8_SA(0, 0), cA, voffA); PG8_STAGE(PG8_SB(0, 1), cB + hstep, voffB); PG8_STAGE(PG8_SA(0, 1), cA + hstepA, voffA);
    if (wr == 1) PG8_BAR;
    PG8_WAIT_V(4); PG8_BAR;
    PG8_STAGE(PG8_SB(1, 0), cB + kstep, voffB); PG8_STAGE(PG8_SA(1, 0), cA + kstep, voffA); PG8_STAGE(PG8_SB(1, 1), cB + hstep + kstep, voffB);
    PG8_WAIT_V(6); PG8_BAR;
    for (;;) {
        const bool has_next = S.next(ui + 1, nxt);
        const char* nA = has_next ? (const char*)g.A + (size_t)nxt.pm * tstepA : cA; const char* nB = has_next ? (const char*)g.Bt + (size_t)nxt.pn * tstep : cB;
        for (int t = 0; t < nt; t += 2) {
            const bool last = (t == nt - 2);
            const char* a1 = cA + (size_t)(t + 1) * kstep + ((t + 1) >= ks ? a2off : 0);
            const char* a2 = last ? nA : cA + (size_t)(t + 2) * kstep + ((t + 2) >= ks ? a2off : 0); const char* b2 = last ? nB : cB + (size_t)(t + 2) * kstep;
            const char* a3 = last ? nA + kstep : cA + (size_t)(t + 3) * kstep + ((t + 3) >= ks ? a2off : 0); const char* b3 = b2 + kstep;
            PG8_LDB(B0, 0, 0); PG8_SCHED; PG8_LDA(At, 0, 0); PG8_STAGE(PG8_SA(1, 1), a1 + hstepA, voffA);
            PG8_WAIT_L(8); PG8_BAR; PG8_WAIT_L(0); PG8_MMA(0, 0, At, B0); PG8_BAR; PG8_SCHED;
            PG8_LDB(B1, 0, 1); PG8_STAGE(PG8_SB(0, 0), b2, voffB);
            PG8_BAR; PG8_WAIT_L(0); PG8_MMA(0, 1, At, B1); PG8_BAR;
            PG8_LDA(At, 0, 1); PG8_STAGE(PG8_SA(0, 0), a2, voffA);
            PG8_BAR; PG8_WAIT_L(0); PG8_MMA(1, 0, At, B0); PG8_BAR; PG8_SCHED;
            PG8_STAGE(PG8_SB(0, 1), b2 + hstep, voffB);
            PG8_WAIT_V(6); PG8_BAR; PG8_MMA(1, 1, At, B1); PG8_BAR;
            PG8_LDB(B0, 1, 0); PG8_SCHED; PG8_LDA(At, 1, 0); PG8_STAGE(PG8_SA(0, 1), a2 + hstepA, voffA);
            PG8_WAIT_L(8); PG8_BAR; PG8_WAIT_L(0); PG8_MMA(0, 0, At, B0); PG8_BAR; PG8_SCHED;
            PG8_LDB(B1, 1, 1); PG8_STAGE(PG8_SB(1, 0), b3, voffB);
            PG8_BAR; PG8_WAIT_L(0); PG8_MMA(0, 1, At, B1); PG8_BAR;
            PG8_LDA(At, 1, 1); PG8_STAGE(PG8_SA(1, 0), a3, voffA);
            PG8_BAR; PG8_WAIT_L(0); PG8_MMA(1, 0, At, B0); PG8_BAR; PG8_SCHED;
            PG8_STAGE(PG8_SB(1, 1), b3 + hstep, voffB);
            PG8_WAIT_V(6); PG8_BAR; PG8_MMA(1, 1, At, B1); PG8_BAR;
        }
        E(acc, cur, wr, wc, fr, fq);
        if (!has_next) break;
#pragma unroll
        for (int a = 0; a < 2; ++a)
#pragma unroll
            for (int b = 0; b < 2; ++b)
#pragma unroll
                for (int m = 0; m < 4; ++m)
#pragma unroll
                    for (int n = 0; n < 2; ++n) acc[a][b][m][n] = (f32x4){0.f, 0.f, 0.f, 0.f};
        cur = nxt; cA = nA; cB = nB; ++ui;
    }
    PG8_WAIT_V(0);
    if (wr == 0) PG8_BAR;
    PG8_BAR;
#undef PG8_SA
#undef PG8_SB
#undef PG8_STAGE
#undef PG8_LDA
#undef PG8_LDB
#undef PG8_MMA
#undef PG8_WAIT_V
#undef PG8_WAIT_L
#undef PG8_BAR
#undef PG8_SCHED
}
}
using pg8::Unit;

struct Epi1 {
    static constexpr bool PERM = true;
    bf16_t* QKV; bf16_t* SZA; bf16_t* UU; bf16_t* SZB; float* BA; bf16_t* HALO;
    __device__ __forceinline__ void operator()(const f32x4 (&acc)[2][2][4][2], const Unit& u, int wr, int wc, int fr_, int fq_) const {
        int lane = (int)(threadIdx.x & 63); asm volatile("" : "+v"(lane));
        const int fr = lane & 15, fq = lane >> 4; (void)fr_; (void)fq_;
        const int row0 = u.pm * 256 + wr * 64 + fr, pn = u.pn;
#pragma unroll
        for (int ai = 0; ai < 2; ++ai)
#pragma unroll
            for (int m = 0; m < 4; ++m) {
                const size_t row = (size_t)(row0 + ai * 128 + m * 16);
#pragma unroll
                for (int bj = 0; bj < 2; ++bj) {
                    const int colt = 128 * bj + 32 * wc + 8 * fq;
                    f32x4 v0 = acc[ai][bj][m][0], v1 = acc[ai][bj][m][1];
                    if (pn < 12) {
                        const int c = pn * 256 + colt; const u32x4 pk = pack8(v0, v1);
                        *(u32x4*)(QKV + row * 3072 + c) = pk;
                        if (m == 3 && fr >= 13) *(u32x4*)(HALO + ((row >> 6) * 3 + (fr - 13)) * 3072 + c) = pk;
                    } else if (pn < 16) {
#pragma unroll
                        for (int e = 0; e < 4; ++e) { v0[e] = siluf_(v0[e]); v1[e] = siluf_(v1[e]); }
                        *(u32x4*)(SZA + row * 1024 + (pn - 12) * 256 + colt) = pack8(v0, v1);
                    } else if (pn < 20) {
                        *(u32x4*)(UU + row * 1024 + (pn - 16) * 256 + colt) = pack8(v0, v1);
                    } else if (pn < 24) {
#pragma unroll
                        for (int e = 0; e < 4; ++e) { v0[e] = siluf_(v0[e]); v1[e] = siluf_(v1[e]); }
                        *(u32x4*)(SZB + row * 1024 + (pn - 20) * 256 + colt) = pack8(v0, v1);
                    } else if (colt < 16) {
                        *(f32x4*)(BA + row * 16 + colt) = v0; *(f32x4*)(BA + row * 16 + colt + 4) = v1;
                    }
                }
            }
    }
};
struct EpiGlu {
    static constexpr bool PERM = true;
    const bf16_t* Y5; bf16_t* SZB;
    __device__ __forceinline__ void operator()(const f32x4 (&acc)[2][2][4][2], const Unit& u, int wr, int wc, int fr, int fq) const {
        const int row0 = u.pm * 256 + wr * 64 + fr;
#pragma unroll
        for (int ai = 0; ai < 2; ++ai)
#pragma unroll
            for (int m = 0; m < 4; ++m) {
                const size_t row = (size_t)(row0 + ai * 128 + m * 16);
#pragma unroll
                for (int bj = 0; bj < 2; ++bj) {
                    const int c = u.pn * 256 + 128 * bj + 32 * wc + 8 * fq;
                    const u32x4 y = *(const u32x4*)(Y5 + row * 1024 + c), z = *(const u32x4*)(SZB + row * 1024 + c);
                    const f32x4 a0 = acc[ai][bj][m][0], a1 = acc[ai][bj][m][1];
                    u32x4 o;
                    o.x = pk2(lo2f(y.x) * sigmoidf_(a0[0]) * lo2f(z.x), hi2f(y.x) * sigmoidf_(a0[1]) * hi2f(z.x));
                    o.y = pk2(lo2f(y.y) * sigmoidf_(a0[2]) * lo2f(z.y), hi2f(y.y) * sigmoidf_(a0[3]) * hi2f(z.y));
                    o.z = pk2(lo2f(y.z) * sigmoidf_(a1[0]) * lo2f(z.z), hi2f(y.z) * sigmoidf_(a1[1]) * hi2f(z.z));
                    o.w = pk2(lo2f(y.w) * sigmoidf_(a1[2]) * lo2f(z.w), hi2f(y.w) * sigmoidf_(a1[3]) * hi2f(z.w));
                    *(u32x4*)(SZB + row * 1024 + c) = o;
                }
            }
    }
};
struct EpiF32 {
    static constexpr bool PERM = false;
    float* C;
    __device__ __forceinline__ void operator()(const f32x4 (&acc)[2][2][4][2], const Unit& u, int wr, int wc, int fr, int fq) const {
        const int row0 = u.pm * 256 + wr * 64 + fr, col0 = u.pn * 256 + wc * 32 + 4 * fq;
#pragma unroll
        for (int ai = 0; ai < 2; ++ai)
#pragma unroll
            for (int m = 0; m < 4; ++m) { float* rowp = C + (size_t)(row0 + ai * 128 + m * 16) * 1024 + col0;
#pragma unroll
                for (int bj = 0; bj < 2; ++bj)
#pragma unroll
                    for (int n = 0; n < 2; ++n) *(f32x4*)(rowp + bj * 128 + n * 16) = acc[ai][bj][m][n]; }
    }
};
struct EpiB16 {
    static constexpr bool PERM = true;
    bf16_t* C;
    __device__ __forceinline__ void operator()(const f32x4 (&acc)[2][2][4][2], const Unit& u, int wr, int wc, int fr, int fq) const {
        const int row0 = u.pm * 256 + wr * 64 + fr, col0 = u.pn * 256 + wc * 32 + 8 * fq;
#pragma unroll
        for (int ai = 0; ai < 2; ++ai)
#pragma unroll
            for (int m = 0; m < 4; ++m) { bf16_t* rowp = C + (size_t)(row0 + ai * 128 + m * 16) * 1024 + col0;
#pragma unroll
                for (int bj = 0; bj < 2; ++bj) *(u32x4*)(rowp + bj * 128) = pack8(acc[ai][bj][m][0], acc[ai][bj][m][1]); }
    }
};
struct Epi2 {
    static constexpr bool PERM = false;
    bf16_t* P; bf16_t* Q;
    __device__ __forceinline__ void operator()(const f32x4 (&acc)[2][2][4][2], const Unit& u, int wr, int wc, int fr, int fq) const {
        const int row0 = u.pm * 256 + wr * 64 + fr, ch = u.pn * 64 + 16 * wc + 4 * fq;
#pragma unroll
        for (int ai = 0; ai < 2; ++ai)
#pragma unroll
            for (int m = 0; m < 4; ++m) {
                const size_t row = (size_t)(row0 + ai * 128 + m * 16);
                const f32x4 gb = acc[ai][0][m][0], gc = acc[ai][0][m][1], hv = acc[ai][1][m][0], z = acc[ai][1][m][1];
                u32x2 pp, qq;
                pp.x = pk2(gc[0] * hv[0], gc[1] * hv[1]); pp.y = pk2(gc[2] * hv[2], gc[3] * hv[3]);
                qq.x = pk2(gb[0] * siluf_(z[0]), gb[1] * siluf_(z[1])); qq.y = pk2(gb[2] * siluf_(z[2]), gb[3] * siluf_(z[3]));
                *(u32x2*)(P + row * 2048 + ch) = pp; *(u32x2*)(Q + row * 2048 + ch) = qq;
            }
    }
};

__device__ __forceinline__ int src_col(int mode, int n, int& pn_unused) {
    (void)pn_unused;
    if (mode == 0) return n;
    if (mode == 1) { if (n < 4096) return n; if (n < 6144) return n + 16; if (n < 6160) return n - 2048; return -1; }
    const int pn = n >> 8, col = n & 255, bj = col >> 7, wc = (col >> 5) & 3, nn = (col >> 4) & 1, lo = col & 15;
    return (2 * bj + nn) * 2048 + pn * 64 + 16 * wc + lo;
}
__device__ __forceinline__ void phase_convert(const Prm& p, unsigned char* lds, int t_begin, int t_end, int nblk, int bidx) {
    float* tile = (float*)lds;
    const int tid = threadIdx.x;
    for (int tix = t_begin + bidx; tix < t_end; tix += nblk) {
        int tl = tix, K, Nsrc, mode; const float* W; bf16_t* Wt;
        if (tl < 1600) { W = p.in[3]; Wt = (bf16_t*)(p.ws + OFF_WT1); K = 1024; Nsrc = 6160; mode = 1; }
        else if ((tl -= 1600) < 256) { W = p.in[16]; Wt = (bf16_t*)(p.ws + OFF_WTG); K = 1024; Nsrc = 1024; mode = 0; }
        else if ((tl -= 256) < 512) { W = p.in[17]; Wt = (bf16_t*)(p.ws + OFF_WTO0); K = 2048; Nsrc = 1024; mode = 0; }
        else if ((tl -= 512) < 2048) { W = p.in[18]; Wt = (bf16_t*)(p.ws + OFF_WT2); K = 1024; Nsrc = 8192; mode = 2; }
        else { tl -= 2048; W = p.in[20]; Wt = (bf16_t*)(p.ws + OFF_WTO1); K = 2048; Nsrc = 1024; mode = 0; }
        const int ntk = K / 64, n0 = (tl / ntk) * 64, k0 = (tl % ntk) * 64;
        { const int j = tid & 63; int dummy = 0; const int sc = src_col(mode, n0 + j, dummy);
#pragma unroll
          for (int i = 0; i < 8; ++i) { const int k = (tid >> 6) + 8 * i; tile[k * 65 + j] = sc >= 0 ? W[(size_t)(k0 + k) * Nsrc + sc] : 0.0f; } }
        __syncthreads();
        { const int r = tid >> 3, c8 = (tid & 7) * 8; u32x4 o;
          o.x = pk2(tile[(c8 + 0) * 65 + r], tile[(c8 + 1) * 65 + r]); o.y = pk2(tile[(c8 + 2) * 65 + r], tile[(c8 + 3) * 65 + r]);
          o.z = pk2(tile[(c8 + 4) * 65 + r], tile[(c8 + 5) * 65 + r]); o.w = pk2(tile[(c8 + 6) * 65 + r], tile[(c8 + 7) * 65 + r]);
          *(u32x4*)(Wt + (size_t)(n0 + r) * K + k0 + c8) = o; }
        __syncthreads();
    }
}
__device__ __forceinline__ void phase_rmsnorm_x(const float* x, const float* w, bf16_t* H) {
    const int lane = threadIdx.x & 63, nw = gridDim.x * 8;
    for (int row = blockIdx.x * 8 + (threadIdx.x >> 6); row < TOK; row += nw) {
        const f32x4* xr = (const f32x4*)(x + (size_t)row * 1024);
        f32x4 v[4]; float ss = 0.f;
#pragma unroll
        for (int i = 0; i < 4; ++i) { v[i] = xr[lane + 64 * i]; ss += v[i][0] * v[i][0] + v[i][1] * v[i][1] + v[i][2] * v[i][2] + v[i][3] * v[i][3]; }
        ss = wave_sum(ss);
        const float rstd = rsqrtf(ss * (1.0f / 1024.0f) + 1e-6f);
#pragma unroll
        for (int i = 0; i < 4; ++i) { const f32x4 w4 = ((const f32x4*)w)[lane + 64 * i]; u32x2 o;
            o.x = pk2(v[i][0] * rstd * w4[0], v[i][1] * rstd * w4[1]); o.y = pk2(v[i][2] * rstd * w4[2], v[i][3] * rstd * w4[3]);
            *(u32x2*)(H + (size_t)row * 1024 + (lane + 64 * i) * 4) = o; }
    }
}
template <bool NEXT>
__device__ __forceinline__ void phase_post(const float* base, const bf16_t* Y, const float* wpost, float* OUT, const float* wpre, bf16_t* H) {
    const int lane = threadIdx.x & 63, nw = gridDim.x * 8;
    for (int row = blockIdx.x * 8 + (threadIdx.x >> 6); row < TOK; row += nw) {
        const u32x2* yr = (const u32x2*)(Y + (size_t)row * 1024); const f32x4* br = (const f32x4*)(base + (size_t)row * 1024);
        f32x4 v[4], xb[4]; float ss = 0.f;
#pragma unroll
        for (int i = 0; i < 4; ++i) { const u32x2 y2 = yr[lane + 64 * i]; v[i] = (f32x4){lo2f(y2.x), hi2f(y2.x), lo2f(y2.y), hi2f(y2.y)}; xb[i] = br[lane + 64 * i]; ss += v[i][0] * v[i][0] + v[i][1] * v[i][1] + v[i][2] * v[i][2] + v[i][3] * v[i][3]; }
        ss = wave_sum(ss);
        const float rstd = rsqrtf(ss * (1.0f / 1024.0f) + 1e-6f);
        float s2 = 0.f;
#pragma unroll
        for (int i = 0; i < 4; ++i) { const f32x4 w4 = ((const f32x4*)wpost)[lane + 64 * i];
#pragma unroll
            for (int e = 0; e < 4; ++e) { v[i][e] = xb[i][e] + v[i][e] * rstd * w4[e]; s2 += v[i][e] * v[i][e]; }
            ((f32x4*)(OUT + (size_t)row * 1024))[lane + 64 * i] = v[i]; }
        if (NEXT) {
            s2 = wave_sum(s2);
            const float r2 = rsqrtf(s2 * (1.0f / 1024.0f) + 1e-6f);
#pragma unroll
            for (int i = 0; i < 4; ++i) { const f32x4 w4 = ((const f32x4*)wpre)[lane + 64 * i]; u32x2 o;
                o.x = pk2(v[i][0] * r2 * w4[0], v[i][1] * r2 * w4[1]); o.y = pk2(v[i][2] * r2 * w4[2], v[i][3] * r2 * w4[3]);
                *(u32x2*)(H + (size_t)row * 1024 + (lane + 64 * i) * 4) = o; }
        }
    }
}


__device__ __forceinline__ void sincos_d(double x, double& s, double& c) {
    const double k = rint(x * 0.6366197723675814);
    const double r = fma(-k, 6.123233995736766e-17, fma(-k, 1.5707963267948966, x)), r2 = r * r;
    double sp = -7.647163731819816e-13; sp = fma(sp, r2, 1.6059043836821613e-10); sp = fma(sp, r2, -2.505210838544172e-8); sp = fma(sp, r2, 2.7557319223985893e-6);
    sp = fma(sp, r2, -1.984126984126984e-4); sp = fma(sp, r2, 8.333333333333333e-3); sp = fma(sp, r2, -1.6666666666666666e-1); sp = fma(sp * r2, r, r);
    double cp = 4.779477332387385e-14; cp = fma(cp, r2, -1.1470745597729725e-11); cp = fma(cp, r2, 2.08767569878681e-9); cp = fma(cp, r2, -2.755731922398589e-7);
    cp = fma(cp, r2, 2.48015873015873e-5); cp = fma(cp, r2, -1.388888888888889e-3); cp = fma(cp, r2, 4.1666666666666664e-2); cp = fma(cp, r2, -0.5); cp = fma(cp, r2, 1.0);
    const int q = ((int)k) & 3;
    const double s0 = (q & 1) ? cp : sp, c0 = (q & 1) ? sp : cp;
    s = (q & 2) ? -s0 : s0; c = ((q + 1) & 2) ? -c0 : c0;
}
__device__ __forceinline__ double exp_d(double x) {
    const double n = rint(x * 1.4426950408889634);
    const double r = fma(-n, 2.3190468138462996e-17, fma(-n, 0.6931471805599453, x));
    double p = 1.6059043836821613e-10; p = fma(p, r, 2.08767569878681e-9); p = fma(p, r, 2.505210838544172e-8); p = fma(p, r, 2.755731922398589e-7); p = fma(p, r, 2.7557319223985893e-6);
    p = fma(p, r, 2.48015873015873e-5); p = fma(p, r, 1.984126984126984e-4); p = fma(p, r, 1.388888888888889e-3); p = fma(p, r, 8.333333333333333e-3); p = fma(p, r, 4.1666666666666664e-2);
    p = fma(p, r, 1.6666666666666666e-1); p = fma(p, r, 0.5); p = fma(p, r, 1.0); p = fma(p, r, 1.0);
    return ldexp(p, (int)n);
}
__device__ __forceinline__ float bcast_lo(float v) { auto r = __builtin_amdgcn_permlane32_swap(__float_as_uint(v), __float_as_uint(v), false, false); return __uint_as_float(r[0]); }
__device__ __forceinline__ float bcast_hi(float v) { auto r = __builtin_amdgcn_permlane32_swap(__float_as_uint(v), __float_as_uint(v), false, false); return __uint_as_float(r[1]); }

struct S5C {
    float ar[2][4], ai[2][4];
    float a512r[2], a512i[2];
    bf16x8 BB[4];
    bf16x8 CC[4];
    float dco;
};

template <bool OUT>
__device__ __forceinline__ void s5_chunk(const S5C& C, bf16_t* UU, int b, int g, int chunk, float (&st)[2][2], bf16_t* sX, int lane) {
    const int n = lane & 31, hh = lane >> 5, fr = lane & 15, fq = lane >> 4;
    const size_t tok0 = (size_t)b * SEQ + (size_t)chunk * 512;
    bf16x8 ua = *(const bf16x8*)(UU + (tok0 + n) * 1024 + 16 * g + 8 * hh);
    bf16_t uo[8];
    if (OUT) {
#pragma unroll
        for (int mt = 0; mt < 2; ++mt)
#pragma unroll
            for (int j = 0; j < 4; ++j) uo[mt * 4 + j] = UU[(tok0 + 16 * mt + 4 * fq + j) * 1024 + 16 * g + fr];
    }
    for (int blk = 0; blk < 16; ++blk) {
        const size_t t0 = tok0 + (size_t)blk * 32;
        const bf16x8 ucur = ua;
        bf16_t ucuro[8];
        if (OUT) {
#pragma unroll
            for (int i = 0; i < 8; ++i) ucuro[i] = uo[i];
        }
        if (blk < 15) {
            ua = *(const bf16x8*)(UU + (t0 + 32 + n) * 1024 + 16 * g + 8 * hh);
            if (OUT) {
#pragma unroll
                for (int mt = 0; mt < 2; ++mt)
#pragma unroll
                    for (int j = 0; j < 4; ++j) uo[mt * 4 + j] = UU[(t0 + 32 + 16 * mt + 4 * fq + j) * 1024 + 16 * g + fr];
            }
        }
        f32x16 acc[4];
#pragma unroll
        for (int tl = 0; tl < 4; ++tl) {
            f32x16 z;
#pragma unroll
            for (int i = 0; i < 16; ++i) z[i] = 0.f;
            acc[tl] = __builtin_amdgcn_mfma_f32_32x32x16_bf16(ucur, C.BB[tl], z, 0, 0, 0);
        }
#pragma unroll
        for (int tp = 0; tp < 2; ++tp) {
            f32x16& re = acc[2 * tp]; f32x16& im = acc[2 * tp + 1];
            const float a1r = C.ar[tp][0], a1i = C.ai[tp][0];
#pragma unroll
            for (int q = 0; q < 4; ++q)
#pragma unroll
                for (int r = 1; r < 4; ++r) {
                    const float pr = re[4 * q + r - 1], pi = im[4 * q + r - 1];
                    re[4 * q + r] += a1r * pr - a1i * pi; im[4 * q + r] += a1r * pi + a1i * pr;
                }
            float cr = st[tp][0], ci = st[tp][1];
            const float a4r = C.ar[tp][3], a4i = C.ai[tp][3];
#pragma unroll
            for (int q = 0; q < 4; ++q) {
                const float tr = re[4 * q + 3] + a4r * cr - a4i * ci, ti = im[4 * q + 3] + a4r * ci + a4i * cr;
                const float o0r = bcast_lo(tr), o0i = bcast_lo(ti);
                const float xr = hh ? o0r : cr, xi = hh ? o0i : ci;
                if (OUT) {
#pragma unroll
                    for (int r = 0; r < 4; ++r) { const float kr = C.ar[tp][r], ki = C.ai[tp][r];
                        re[4 * q + r] += kr * xr - ki * xi; im[4 * q + r] += kr * xi + ki * xr; }
                } else {
                    re[4 * q + 3] += a4r * xr - a4i * xi; im[4 * q + 3] += a4r * xi + a4i * xr;
                }
                cr = bcast_hi(re[4 * q + 3]); ci = bcast_hi(im[4 * q + 3]);
            }
            st[tp][0] = cr; st[tp][1] = ci;
        }
        if (OUT) {
            asm volatile("s_waitcnt lgkmcnt(0)" ::: "memory");
#pragma unroll
            for (int tp = 0; tp < 2; ++tp)
#pragma unroll
                for (int i = 0; i < 16; ++i) {
                    const int t = 8 * (i >> 2) + 4 * hh + (i & 3);
                    *(unsigned*)(sX + t * 136 + 2 * (n + 32 * tp)) = pk2(acc[2 * tp][i], acc[2 * tp + 1][i]);
                }
            asm volatile("s_waitcnt lgkmcnt(0)" ::: "memory");
            __builtin_amdgcn_wave_barrier();
#pragma unroll
            for (int mt = 0; mt < 2; ++mt) {
                f32x4 y = (f32x4){0.f, 0.f, 0.f, 0.f};
#pragma unroll
                for (int ks = 0; ks < 4; ++ks) {
                    const bf16x8 xa = *(const bf16x8*)(sX + (16 * mt + fr) * 136 + 32 * ks + 8 * fq);
                    y = __builtin_amdgcn_mfma_f32_16x16x32_bf16(xa, C.CC[ks], y, 0, 0, 0);
                }
#pragma unroll
                for (int j = 0; j < 4; ++j) {
                    float v = y[j] + C.dco * bf2f(ucuro[mt * 4 + j]);
                    const float inner = 0.7978845608028654f * (v + 0.044715f * v * v * v);
                    v = v / (1.0f + __expf(-2.0f * inner));
                    UU[(t0 + 16 * mt + 4 * fq + j) * 1024 + 16 * g + fr] = f2bf(v);
                }
            }
            asm volatile("s_waitcnt lgkmcnt(0)" ::: "memory");
            __builtin_amdgcn_wave_barrier();
        }
    }
}

__device__ __forceinline__ void phase_s5(const Prm& p, unsigned char* lds, int bg) {
    const int b = bg >> 6, g = bg & 63;
    const int tid = threadIdx.x, wv = tid >> 6, lane = tid & 63, n = lane & 31, hh = lane >> 5, fr = lane & 15, fq = lane >> 4;
    bf16_t* sX = (bf16_t*)(lds + wv * 8704);
    float* sXE = (float*)(lds + 8 * 8704);
    bf16_t* UU = (bf16_t*)(p.ws + OFF_UU);
    const float* lam_re = p.in[8]; const float* lam_im = p.in[9]; const float* b_re = p.in[10]; const float* b_im = p.in[11];
    const float* c_re = p.in[12]; const float* c_im = p.in[13];
    S5C C;
    const double dt = exp_d((double)p.in[14][g]);
    float fre[2], fim[2];
#pragma unroll
    for (int tp = 0; tp < 2; ++tp) {
        const int pp = n + 32 * tp;
        const double lr = (double)fminf(lam_re[g * 64 + pp], -1e-4f), li = (double)lam_im[g * 64 + pp];
#pragma unroll
        for (int k = 0; k < 4; ++k) { double sn, cs; sincos_d(li * dt * (k + 1), sn, cs); const double mag = exp_d(lr * dt * (k + 1)); C.ar[tp][k] = (float)(mag * cs); C.ai[tp][k] = (float)(mag * sn); }
        { double sn, cs; sincos_d(li * dt * 512.0, sn, cs); const double mag = exp_d(lr * dt * 512.0); C.a512r[tp] = (float)(mag * cs); C.a512i[tp] = (float)(mag * sn); }
        double sn, cs; sincos_d(li * dt, sn, cs);
        const double mag = exp_d(lr * dt), abr = mag * cs, abi = mag * sn;
        const double den = lr * lr + li * li, nr = abr - 1.0, ni = abi;
        fre[tp] = (float)((nr * lr + ni * li) / den); fim[tp] = (float)((ni * lr - nr * li) / den);
    }
#pragma unroll
    for (int tl = 0; tl < 4; ++tl) {
        const int tp = tl >> 1, ri = tl & 1, pp = n + 32 * tp;
#pragma unroll
        for (int j = 0; j < 8; ++j) {
            const int ch = 8 * hh + j;
            const float br = b_re[(g * 64 + pp) * 16 + ch], bi = b_im[(g * 64 + pp) * 16 + ch];
            const float v = ri == 0 ? fre[tp] * br - fim[tp] * bi : fre[tp] * bi + fim[tp] * br;
            C.BB[tl][j] = (short)f2bf(v);
        }
    }
#pragma unroll
    for (int ks = 0; ks < 4; ++ks)
#pragma unroll
        for (int j = 0; j < 8; ++j) {
            const int k = 32 * ks + 8 * fq + j, pp = k >> 1, ri = k & 1;
            const float v = ri == 0 ? c_re[(g * 16 + fr) * 64 + pp] : -c_im[(g * 16 + fr) * 64 + pp];
            C.CC[ks][j] = (short)f2bf(v);
        }
    C.dco = p.in[15][16 * g + fr];
    for (int rd = 0; rd < 2; ++rd) {
        const int chunk = wv + 8 * rd;
        float st[2][2] = {{0.f, 0.f}, {0.f, 0.f}};
        s5_chunk<false>(C, UU, b, g, chunk, st, sX, lane);
        if (hh == 0) {
#pragma unroll
            for (int tp = 0; tp < 2; ++tp) { sXE[(chunk * 64 + n + 32 * tp) * 2 + 0] = st[tp][0]; sXE[(chunk * 64 + n + 32 * tp) * 2 + 1] = st[tp][1]; }
        }
    }
    __syncthreads();
    for (int rd = 0; rd < 2; ++rd) {
        const int chunk = wv + 8 * rd;
        float st[2][2] = {{0.f, 0.f}, {0.f, 0.f}};
        for (int c2 = 0; c2 < chunk; ++c2) {
#pragma unroll
            for (int tp = 0; tp < 2; ++tp) {
                const float er = sXE[(c2 * 64 + n + 32 * tp) * 2 + 0], ei = sXE[(c2 * 64 + n + 32 * tp) * 2 + 1];
                const float nr = C.a512r[tp] * st[tp][0] - C.a512i[tp] * st[tp][1] + er, ni = C.a512r[tp] * st[tp][1] + C.a512i[tp] * st[tp][0] + ei;
                st[tp][0] = nr; st[tp][1] = ni;
            }
        }
        s5_chunk<true>(C, UU, b, g, chunk, st, sX, lane);
    }
    __syncthreads();
}

__device__ __forceinline__ void phase_gdn_prep(const Prm& p, unsigned char* lds, int it0, int nrounds) {
    const int tid0 = threadIdx.x, hb = tid0 >> 8;
    unsigned char* base = lds + hb * 76800;
    bf16_t* sQ = (bf16_t*)base;
    bf16_t* sK = (bf16_t*)(base + 17408);
    bf16_t* sV = (bf16_t*)(base + 2 * 17408);
    float* sL = (float*)(base + 3 * 17408);
    float* sBeta = (float*)(base + 4 * 17408);
    float* sGc = sBeta + 64; float* sEg = sGc + 64; float* sBE = sEg + 64;
    float* sCW = sBE + 64;
    bf16_t* QKV = (bf16_t*)(p.ws + OFF_QKV); const bf16_t* HALO = (const bf16_t*)(p.ws + OFF_HALO);
    const float* BA = (const float*)(p.ws + OFF_BA); float* GL = (float*)(p.ws + OFF_GL);
    bf16_t* WB = (bf16_t*)(p.ws + OFF_WB); bf16_t* ATT = (bf16_t*)(p.ws + OFF_ATT);
    const float* convw = p.in[4];
    for (int rd = 0; rd < nrounds; ++rd) {
        int tid = tid0; asm volatile("" : "+v"(tid));
        const int ht = tid & 255, hw = (tid >> 6) & 3, lane = tid & 63, fr = lane & 15, fq = lane >> 4;
        const int it = it0 + rd * 2 + hb;
        const int b = it >> 10, h = (it >> 7) & 7, nc = it & 127;
        const size_t tokb = (size_t)b * SEQ + (size_t)nc * 64;
#pragma unroll
        for (int i = 0; i < 6; ++i) { const int idx = ht + 256 * i, s3 = idx >> 9, tap = (idx >> 7) & 3, ch = idx & 127; sCW[idx] = convw[tap * 3072 + s3 * 1024 + h * 128 + ch]; }
        __syncthreads();
        {
            const int t0 = (ht >> 4) * 4, cgp = ht & 15;
#pragma unroll 1
            for (int s = 0; s < 3; ++s) {
                const int col = s * 1024 + h * 128 + cgp * 8;
                u32x4 xr[7];
#pragma unroll
                for (int i = 0; i < 7; ++i) {
                    const int tt = t0 - 3 + i;
                    xr[i] = (u32x4){0u, 0u, 0u, 0u};
                    if (tt >= 0) xr[i] = *(const u32x4*)(QKV + (tokb + tt) * 3072 + col);
                    else if (nc > 0) xr[i] = *(const u32x4*)(HALO + ((size_t)(b * 128 + nc - 1) * 3 + (3 + tt)) * 3072 + col);
                }
                f32x4 w0[4], w1[4];
#pragma unroll
                for (int j = 0; j < 4; ++j) { w0[j] = *(const f32x4*)(sCW + s * 512 + j * 128 + cgp * 8); w1[j] = *(const f32x4*)(sCW + s * 512 + j * 128 + cgp * 8 + 4); }
                float o[4][8], ss[4];
#pragma unroll
                for (int tk = 0; tk < 4; ++tk) {
                    float a[8];
#pragma unroll
                    for (int e = 0; e < 8; ++e) a[e] = 0.f;
#pragma unroll
                    for (int j = 0; j < 4; ++j) {
                        const u32x4 xv = xr[tk + j];
                        a[0] += w0[j][0] * lo2f(xv.x); a[1] += w0[j][1] * hi2f(xv.x); a[2] += w0[j][2] * lo2f(xv.y); a[3] += w0[j][3] * hi2f(xv.y);
                        a[4] += w1[j][0] * lo2f(xv.z); a[5] += w1[j][1] * hi2f(xv.z); a[6] += w1[j][2] * lo2f(xv.w); a[7] += w1[j][3] * hi2f(xv.w);
                    }
                    float acc2 = 0.f;
#pragma unroll
                    for (int e = 0; e < 8; ++e) { const float v = siluf_(a[e]); o[tk][e] = v; acc2 += v * v; }
                    ss[tk] = acc2;
                }
                bf16_t* dst = (s == 0 ? sQ : (s == 1 ? sK : sV)) + t0 * 136 + cgp * 8;
#pragma unroll
                for (int tk = 0; tk < 4; ++tk) {
                    float sc = 1.0f;
                    if (s < 2) { float q = ss[tk]; q += __shfl_xor(q, 1); q += __shfl_xor(q, 2); q += __shfl_xor(q, 4); q += __shfl_xor(q, 8); sc = rsqrtf(q + 1e-6f) * (s == 0 ? 0.08838834764831845f : 1.0f); }
                    u32x4 pk;
                    pk.x = pk2(o[tk][0] * sc, o[tk][1] * sc); pk.y = pk2(o[tk][2] * sc, o[tk][3] * sc); pk.z = pk2(o[tk][4] * sc, o[tk][5] * sc); pk.w = pk2(o[tk][6] * sc, o[tk][7] * sc);
                    *(u32x4*)(dst + tk * 136) = pk;
                }
            }
        }
        if (hw == 0) {
            const size_t tg = tokb + lane;
            const float braw = BA[tg * 16 + h], araw = BA[tg * 16 + 8 + h];
            const float beta = 1.0f / (1.0f + expf(-braw));
            const float xx = araw + p.in[6][h];
            const float sp = xx > 20.f ? xx : log1pf(expf(xx));
            float gg = -expf(p.in[5][h]) * sp;
#pragma unroll
            for (int off = 1; off < 64; off <<= 1) { const float o = __shfl_up(gg, off); if (lane >= off) gg += o; }
            sBeta[lane] = beta; sGc[lane] = gg; sEg[lane] = expf(gg); sBE[lane] = beta * expf(gg);
            if (lane == 63) GL[it] = expf(gg);
        }
        __syncthreads();
        {
            bf16x8 aK[4], aQ[4];
#pragma unroll
            for (int ks = 0; ks < 4; ++ks) { aK[ks] = *(const bf16x8*)(sK + (16 * hw + fr) * 136 + 32 * ks + 8 * fq); aQ[ks] = *(const bf16x8*)(sQ + (16 * hw + fr) * 136 + 32 * ks + 8 * fq); }
#pragma unroll
            for (int nt = 0; nt < 4; ++nt) {
                f32x4 kk = (f32x4){0.f, 0.f, 0.f, 0.f}, qk = (f32x4){0.f, 0.f, 0.f, 0.f};
#pragma unroll
                for (int ks = 0; ks < 4; ++ks) {
                    const bf16x8 bK = *(const bf16x8*)(sK + (16 * nt + fr) * 136 + 32 * ks + 8 * fq);
                    kk = __builtin_amdgcn_mfma_f32_16x16x32_bf16(aK[ks], bK, kk, 0, 0, 0);
                    qk = __builtin_amdgcn_mfma_f32_16x16x32_bf16(aQ[ks], bK, qk, 0, 0, 0);
                }
                const int mcol = 16 * nt + fr; const float gm = sGc[mcol];
#pragma unroll
                for (int j = 0; j < 4; ++j) {
                    const int c = 16 * hw + 4 * fq + j;
                    const float dec = __expf(fminf(sGc[c] - gm, 0.f));
                    sL[c * 68 + mcol] = (mcol < c) ? kk[j] * sBeta[c] * dec : 0.f;
                    ATT[(size_t)it * 4096 + c * 64 + mcol] = f2bf((mcol <= c) ? qk[j] * dec : 0.f);
                }
            }
        }
        __syncthreads();
        {
            float x[64];
            const bool isU = ht < 128; const int jc = ht & 127;
            const bf16_t* src = isU ? sV : sK;
            const float* fac = isU ? sBeta : sBE;
#pragma unroll
            for (int cb = 0; cb < 16; ++cb) {
                float a[4];
#pragma unroll
                for (int r = 0; r < 4; ++r) a[r] = bf2f(src[(4 * cb + r) * 136 + jc]) * fac[4 * cb + r];
#pragma unroll
                for (int m4 = 0; m4 < cb; ++m4)
#pragma unroll
                    for (int r = 0; r < 4; ++r) {
                        const f32x4 l = *(const f32x4*)(sL + (4 * cb + r) * 68 + 4 * m4);
                        a[r] -= l[0] * x[4 * m4] + l[1] * x[4 * m4 + 1] + l[2] * x[4 * m4 + 2] + l[3] * x[4 * m4 + 3];
                    }
                const f32x4 d1 = *(const f32x4*)(sL + (4 * cb + 1) * 68 + 4 * cb), d2 = *(const f32x4*)(sL + (4 * cb + 2) * 68 + 4 * cb), d3 = *(const f32x4*)(sL + (4 * cb + 3) * 68 + 4 * cb);
                x[4 * cb] = a[0];
                x[4 * cb + 1] = a[1] - d1[0] * x[4 * cb];
                x[4 * cb + 2] = a[2] - d2[0] * x[4 * cb] - d2[1] * x[4 * cb + 1];
                x[4 * cb + 3] = a[3] - d3[0] * x[4 * cb] - d3[1] * x[4 * cb + 1] - d3[2] * x[4 * cb + 2];
            }
            if (isU) {
                const int w8 = jc >> 4, nn = jc & 15;
#pragma unroll
                for (int rq = 0; rq < 4; ++rq)
#pragma unroll
                    for (int pc = 0; pc < 2; ++pc) {
                        const int c0 = 32 * pc + 8 * rq;
                        u32x4 o; o.x = pk2(x[c0 + 0], x[c0 + 1]); o.y = pk2(x[c0 + 2], x[c0 + 3]); o.z = pk2(x[c0 + 4], x[c0 + 5]); o.w = pk2(x[c0 + 6], x[c0 + 7]);
                        const int L = ((w8 * 2 + pc) * 64 + rq * 16 + nn) * 8;
                        *(u32x4*)(QKV + (tokb + (L >> 7)) * 3072 + 2048 + h * 128 + (L & 127)) = o;
                    }
            }
            __syncthreads();
            if (!isU) {
                bf16_t* sW2 = (bf16_t*)sL;
#pragma unroll
                for (int c = 0; c < 64; ++c) sW2[c * 136 + jc] = f2bf(-x[c]);
            }
        }
        __syncthreads();
        {
            const bf16_t* sW2 = (const bf16_t*)sL;
#pragma unroll
            for (int i = 0; i < 4; ++i) { const int ch = ht + 256 * i, r = ch >> 4, c8 = (ch & 15) * 8; *(u32x4*)(WB + (size_t)it * 8192 + r * 128 + c8) = *(const u32x4*)(sW2 + r * 136 + c8); }
        }
        {
            const int c = ht >> 2, ds = (ht & 3) * 32; const float eg = sEg[c];
#pragma unroll
            for (int c8 = 0; c8 < 4; ++c8) {
                const u32x4 v = *(const u32x4*)(sQ + c * 136 + ds + c8 * 8); u32x4 o;
                o.x = pk2(lo2f(v.x) * eg, hi2f(v.x) * eg); o.y = pk2(lo2f(v.y) * eg, hi2f(v.y) * eg); o.z = pk2(lo2f(v.z) * eg, hi2f(v.z) * eg); o.w = pk2(lo2f(v.w) * eg, hi2f(v.w) * eg);
                *(u32x4*)(QKV + (tokb + c) * 3072 + h * 128 + ds + c8 * 8) = o;
            }
            const int d = ht >> 1, cs = (ht & 1) * 32; const float gl = sGc[63];
#pragma unroll
            for (int c8 = 0; c8 < 4; ++c8) {
                float v[8];
#pragma unroll
                for (int e = 0; e < 8; ++e) { const int cc = cs + c8 * 8 + e; v[e] = bf2f(sK[cc * 136 + d]) * __expf(gl - sGc[cc]); }
                u32x4 o; o.x = pk2(v[0], v[1]); o.y = pk2(v[2], v[3]); o.z = pk2(v[4], v[5]); o.w = pk2(v[6], v[7]);
                *(u32x4*)(QKV + (tokb + (d >> 1)) * 3072 + 1024 + h * 128 + (d & 1) * 64 + cs + c8 * 8) = o;
            }
        }
        __syncthreads();
    }
}

constexpr int SC_WQ = 32768, SC_KA = 24576, SC_KA0 = 3 * SC_WQ;
static_assert(SC_KA0 + 2 * SC_KA <= LDS_BYTES, "scan LDS layout");
__device__ __forceinline__ bf16x8 pack2(const f32x4& a, const f32x4& b) {
    u32x4 r; r.x = pk2(a[0], a[1]); r.y = pk2(a[2], a[3]); r.z = pk2(b[0], b[1]); r.w = pk2(b[2], b[3]); return __builtin_bit_cast(bf16x8, r);
}
#define MF16(a, b, c) __builtin_amdgcn_mfma_f32_16x16x32_bf16(a, b, c, 0, 0, 0)
#define DMA16(src, dst) __builtin_amdgcn_global_load_lds((const unsigned*)(src), (LAS unsigned*)(dst), 16, 0, 0)
__device__ __forceinline__ void phase_gdn_scan(const Prm& p, LAS unsigned char* lds, int blk) {
    const int tid = threadIdx.x, wv = __builtin_amdgcn_readfirstlane(tid >> 6), lane = tid & 63, n = lane & 15, kq = lane >> 4;
    const int bh = blk & 15, jh = blk >> 4, b = bh >> 3, h = bh & 7;
    const bf16_t* QKV = (const bf16_t*)(p.ws + OFF_QKV); const bf16_t* WB = (const bf16_t*)(p.ws + OFF_WB); const bf16_t* ATT = (const bf16_t*)(p.ws + OFF_ATT);
    const float* GL = (const float*)(p.ws + OFF_GL); bf16_t* O = (bf16_t*)(p.ws + OFF_H);
    const int itb = bh * 128;
    const bf16_t* qkv_b = QKV + (size_t)b * SEQ * 3072;
    if (wv >= 4) {
        const int lw = wv - 4;
        __builtin_amdgcn_s_setprio(3);
        unsigned oW[4], oQ[4], oK[4], oA[2];
#pragma unroll
        for (int i = 0; i < 4; ++i) {
            { const int q = lw * 4 + i, row = 4 * q + (lane >> 4), pg = lane & 15, g = pg ^ ((row & 3) | (((row >> 3) & 3) << 2)); oW[i] = (unsigned)(row * 128 + g * 8); oQ[i] = (unsigned)(row * 3072 + h * 128 + g * 8); }
            { const int q = lw * 4 + i, d = 8 * q + (lane >> 3), pg = lane & 7, g = pg ^ ((d & 3) | (((d >> 3) & 1) << 2)); oK[i] = (unsigned)((d >> 1) * 3072 + 1024 + h * 128 + (d & 1) * 64 + g * 8); }
        }
#pragma unroll
        for (int i = 0; i < 2; ++i) { const int q = lw * 2 + i, c = 8 * q + (lane >> 3), pg = lane & 7, g = pg ^ ((c & 3) | (((c >> 3) & 1) << 2)); oA[i] = (unsigned)(c * 64 + g * 8); }
#define ISSUE_WQ(ck, st) do { const bf16_t* wb_ = WB + (size_t)(itb + (ck)) * 8192; const bf16_t* qb_ = qkv_b + (size_t)(ck) * 64 * 3072; LAS unsigned char* d_ = lds + (st) * SC_WQ + lw * 4096; \
        _Pragma("unroll") for (int i = 0; i < 4; ++i) { DMA16(wb_ + oW[i], d_ + i * 1024); DMA16(qb_ + oQ[i], d_ + 16384 + i * 1024); } } while (0)
#define ISSUE_KA(ck, st) do { const bf16_t* qb_ = qkv_b + (size_t)(ck) * 64 * 3072; const bf16_t* ab_ = ATT + (size_t)(itb + (ck)) * 4096; LAS unsigned char* d_ = lds + SC_KA0 + (st) * SC_KA; \
        _Pragma("unroll") for (int i = 0; i < 4; ++i) DMA16(qb_ + oK[i], d_ + (lw * 4 + i) * 1024); \
        _Pragma("unroll") for (int i = 0; i < 2; ++i) DMA16(ab_ + oA[i], d_ + 16384 + (lw * 2 + i) * 1024); } while (0)
        ISSUE_WQ(0, 0); ISSUE_KA(0, 0); ISSUE_WQ(1, 1);
        asm volatile("s_waitcnt vmcnt(0)" ::: "memory"); __builtin_amdgcn_s_barrier(); asm volatile("" ::: "memory");
        int s3 = 2;
        for (int nc = 0; nc < 128; ++nc) {
            const int c1 = nc + 1 < 128 ? nc + 1 : 127, c2 = nc + 2 < 128 ? nc + 2 : 127;
            ISSUE_KA(c1, (nc + 1) & 1);
            ISSUE_WQ(c2, s3);
            s3 = s3 == 2 ? 0 : s3 + 1;
            asm volatile("s_waitcnt vmcnt(8)" ::: "memory");
            __builtin_amdgcn_s_barrier(); asm volatile("" ::: "memory");
        }
        asm volatile("s_waitcnt vmcnt(0)" ::: "memory");
        __builtin_amdgcn_s_setprio(0);
#undef ISSUE_WQ
#undef ISSUE_KA
    } else {
        const float gl0 = GL[itb + lane], gl1 = GL[itb + 64 + lane];
        f32x4 S[8];
#pragma unroll
        for (int dt = 0; dt < 8; ++dt) S[dt] = (f32x4){0.f, 0.f, 0.f, 0.f};
        const int e = 64 * jh + 16 * wv + n;
        unsigned uo[2];
#pragma unroll
        for (int pc = 0; pc < 2; ++pc) { const int L = (((4 * jh + wv) * 2 + pc) * 64 + lane) * 8; uo[pc] = (unsigned)((L >> 7) * 3072 + 2048 + h * 128 + (L & 127)); }
        u32x4 ua[2], ub[2];
#pragma unroll
        for (int pc = 0; pc < 2; ++pc) { ua[pc] = *(const u32x4*)(qkv_b + uo[pc]); ub[pc] = *(const u32x4*)(qkv_b + (size_t)64 * 3072 + uo[pc]); }
        const int rowb = 8 * (n >> 2) + (n & 3), swk = (n & 3) | (((n >> 2) & 1) << 2);
        unsigned offW[4], offK[2];
#pragma unroll
        for (int ks = 0; ks < 4; ++ks) offW[ks] = (unsigned)(rowb * 256 + (((4 * ks + kq) ^ n) << 4));
#pragma unroll
        for (int k2 = 0; k2 < 2; ++k2) offK[k2] = (unsigned)(rowb * 128 + (((4 * k2 + kq) ^ swk) << 4));
        asm volatile("s_waitcnt lgkmcnt(0)" ::: "memory"); __builtin_amdgcn_s_barrier(); asm volatile("" ::: "memory");
        int s3 = 0;
        for (int nc = 0; nc < 128; ++nc) {
            const LAS unsigned char* sWQ = lds + s3 * SC_WQ; const LAS unsigned char* sKA = lds + SC_KA0 + (nc & 1) * SC_KA;
            s3 = s3 == 2 ? 0 : s3 + 1;
            const float gl = __builtin_bit_cast(float, __builtin_amdgcn_readlane(__builtin_bit_cast(int, nc < 64 ? gl0 : gl1), nc & 63));
            f32x4 V[4], Oa[4];
#pragma unroll
            for (int pc = 0; pc < 2; ++pc) {
                const u32x4 uu = ua[pc];
                V[2 * pc] = (f32x4){lo2f(uu.x), hi2f(uu.x), lo2f(uu.y), hi2f(uu.y)}; V[2 * pc + 1] = (f32x4){lo2f(uu.z), hi2f(uu.z), lo2f(uu.w), hi2f(uu.w)};
                ua[pc] = ub[pc];
            }
            { const int c2 = nc + 2 < 128 ? nc + 2 : 127; const bf16_t* ubase = qkv_b + (size_t)c2 * 64 * 3072;
#pragma unroll
              for (int pc = 0; pc < 2; ++pc) ub[pc] = *(const u32x4*)(ubase + uo[pc]); }
#pragma unroll
            for (int ct = 0; ct < 4; ++ct) Oa[ct] = (f32x4){0.f, 0.f, 0.f, 0.f};
            bf16x8 fa[2][8];
#define TOFF(t, pitch) ((32 * ((t) >> 1) + 4 * ((t) & 1)) * (pitch))
#define LD_WQ(dst, ks_) do { _Pragma("unroll") for (int mt = 0; mt < 4; ++mt) { dst[mt] = *(const LAS bf16x8*)(sWQ + offW[ks_] + TOFF(mt, 256)); dst[4 + mt] = *(const LAS bf16x8*)(sWQ + 16384 + offW[ks_] + TOFF(mt, 256)); } } while (0)
            LD_WQ(fa[0], 0);
#pragma unroll
            for (int ks = 0; ks < 4; ++ks) {
                if (ks < 3) LD_WQ(fa[(ks + 1) & 1], ks + 1);
                const bf16x8 sb8 = pack2(S[2 * ks], S[2 * ks + 1]);
                __builtin_amdgcn_sched_barrier(0);
#pragma unroll
                for (int mt = 0; mt < 4; ++mt) { V[mt] = MF16(fa[ks & 1][mt], sb8, V[mt]); Oa[mt] = MF16(fa[ks & 1][4 + mt], sb8, Oa[mt]); }
                __builtin_amdgcn_sched_barrier(0);
            }
#undef LD_WQ
            bf16x8 fb[2][12];
#define LD_AK(dst, k2_) do { _Pragma("unroll") for (int mt = 0; mt < 4; ++mt) dst[mt] = *(const LAS bf16x8*)(sKA + 16384 + offK[k2_] + TOFF(mt, 128)); \
                             _Pragma("unroll") for (int dt = 0; dt < 8; ++dt) dst[4 + dt] = *(const LAS bf16x8*)(sKA + offK[k2_] + TOFF(dt, 128)); } while (0)
            LD_AK(fb[0], 0);
            bf16x8 Vb[2];
            Vb[0] = pack2(V[0], V[1]); Vb[1] = pack2(V[2], V[3]);
#pragma unroll
            for (int dt = 0; dt < 8; ++dt) S[dt] *= gl;
#pragma unroll
            for (int k2 = 0; k2 < 2; ++k2) {
                if (k2 < 1) LD_AK(fb[1], 1);
                __builtin_amdgcn_sched_barrier(0);
#pragma unroll
                for (int mt = 0; mt < 4; ++mt) Oa[mt] = MF16(fb[k2][mt], Vb[k2], Oa[mt]);
#pragma unroll
                for (int dt = 0; dt < 8; ++dt) S[dt] = MF16(fb[k2][4 + dt], Vb[k2], S[dt]);
                __builtin_amdgcn_sched_barrier(0);
            }
#undef LD_AK
#undef TOFF
            bf16_t* obase = O + (size_t)(itb + nc) * 8192 + e * 64 + 8 * kq;
#pragma unroll
            for (int pc = 0; pc < 2; ++pc) *(u32x4*)(obase + 32 * pc) = pack8(Oa[2 * pc], Oa[2 * pc + 1]);
            asm volatile("s_waitcnt lgkmcnt(0)" ::: "memory"); __builtin_amdgcn_s_barrier(); asm volatile("" ::: "memory");
        }
    }
    __syncthreads();
}

__device__ __forceinline__ void phase_ya(const Prm& p, unsigned char* lds) {
    const bf16_t* OT = (const bf16_t*)(p.ws + OFF_H); bf16_t* SZA = (bf16_t*)p.out;
    const float* gw = p.in[7];
    bf16_t* sT = (bf16_t*)lds;
    float* sPart = (float*)(lds + 16384);
    const int tid = threadIdx.x, w = tid >> 6, c = tid & 63;
    for (int it = blockIdx.x; it < NIT; it += gridDim.x) {
        const int b = it >> 10, h = (it >> 7) & 7, nc = it & 127;
        const size_t tok = (size_t)b * SEQ + (size_t)nc * 64 + c;
#pragma unroll
        for (int i = 0; i < 2; ++i) { const int ch = tid + 512 * i; *(u32x4*)(sT + ch * 8) = *(const u32x4*)(OT + (size_t)it * 8192 + ch * 8); }
        const u32x4 z0 = *(const u32x4*)(SZA + tok * 1024 + h * 128 + 16 * w), z1 = *(const u32x4*)(SZA + tok * 1024 + h * 128 + 16 * w + 8);
        __syncthreads();
        float o[16]; float ss = 0.f;
#pragma unroll
        for (int j = 0; j < 16; ++j) { o[j] = bf2f(sT[(16 * w + j) * 64 + c]); ss += o[j] * o[j]; }
        sPart[w * 64 + c] = ss;
        __syncthreads();
        float tot = 0.f;
#pragma unroll
        for (int k = 0; k < 8; ++k) tot += sPart[k * 64 + c];
        const float rstd = rsqrtf(tot * (1.0f / 128.0f) + 1e-6f);
        const unsigned zz[8] = {z0.x, z0.y, z0.z, z0.w, z1.x, z1.y, z1.z, z1.w};
        unsigned r[8];
#pragma unroll
        for (int j = 0; j < 8; ++j)
            r[j] = pk2(o[2 * j] * rstd * gw[16 * w + 2 * j] * lo2f(zz[j]), o[2 * j + 1] * rstd * gw[16 * w + 2 * j + 1] * hi2f(zz[j]));
        *(u32x4*)(SZA + tok * 1024 + h * 128 + 16 * w) = (u32x4){r[0], r[1], r[2], r[3]};
        *(u32x4*)(SZA + tok * 1024 + h * 128 + 16 * w + 8) = (u32x4){r[4], r[5], r[6], r[7]};
        __syncthreads();
    }
}
__device__ __forceinline__ void phase_conv3(const Prm& p) {
    const bf16_t* P = (const bf16_t*)(p.ws + OFF_P); bf16_t* Q = (bf16_t*)(p.ws + OFF_Q); const float* cw = p.in[19];
    const int nth = gridDim.x * 512;
    for (int idx = blockIdx.x * 512 + threadIdx.x; idx < TOK * 256; idx += nth) {
        const int t = idx >> 8, c8 = (idx & 255) * 8, ts = t & (SEQ - 1);
        const u32x4 z4 = (u32x4){0u, 0u, 0u, 0u};
        const u32x4 p0 = *(const u32x4*)(P + (size_t)t * 2048 + c8);
        const u32x4 p1 = ts >= 1 ? *(const u32x4*)(P + (size_t)(t - 1) * 2048 + c8) : z4;
        const u32x4 p2 = ts >= 2 ? *(const u32x4*)(P + (size_t)(t - 2) * 2048 + c8) : z4;
        const u32x4 q = *(const u32x4*)(Q + (size_t)t * 2048 + c8);
        float r[8];
        const unsigned pa[4] = {p0.x, p0.y, p0.z, p0.w}, pb[4] = {p1.x, p1.y, p1.z, p1.w}, pc[4] = {p2.x, p2.y, p2.z, p2.w}, qa[4] = {q.x, q.y, q.z, q.w};
#pragma unroll
        for (int e = 0; e < 4; ++e) {
            const int c = c8 + 2 * e;
            r[2 * e] = lo2f(qa[e]) * (cw[c] * lo2f(pc[e]) + cw[2048 + c] * lo2f(pb[e]) + cw[4096 + c] * lo2f(pa[e]));
            r[2 * e + 1] = hi2f(qa[e]) * (cw[c + 1] * hi2f(pc[e]) + cw[2048 + c + 1] * hi2f(pb[e]) + cw[4096 + c + 1] * hi2f(pa[e]));
        }
        u32x4 o; o.x = pk2(r[0], r[1]); o.y = pk2(r[2], r[3]); o.z = pk2(r[4], r[5]); o.w = pk2(r[6], r[7]);
        *(u32x4*)(Q + (size_t)t * 2048 + c8) = o;
    }
}

#define XB_TMO      128
#define XB_XCNT(j)  (256  + 64 * (j))
#define XB_XSUB(j)  (1280 + 64 * (j))
#define XB_XGEN(j)  (2304 + 64 * (j))
#define XB_TOP      3328
#define XB_TOPGEN   3392
#define XCD_BAR_WORDS 3456
#define XB_SPIN_CAP (1u << 18)

__device__ __forceinline__ unsigned xb_ld(unsigned* p)              { return __hip_atomic_load(p, __ATOMIC_RELAXED, __HIP_MEMORY_SCOPE_AGENT); }
__device__ __forceinline__ unsigned xb_add(unsigned* p, unsigned v) { return __hip_atomic_fetch_add(p, v, __ATOMIC_RELAXED, __HIP_MEMORY_SCOPE_AGENT); }
__device__ __forceinline__ unsigned xb_xcc_id() { return (unsigned)__builtin_amdgcn_s_getreg((3 << 11) | 20) & 0xFu; }
#define XB_SPIN(cond, bar) do { unsigned _sp = 0; while (cond) { __builtin_amdgcn_s_sleep(1); \
    if ((++_sp & 255u) == 0u) { if (xb_ld(&(bar)[XB_TMO])) break; if (_sp > XB_SPIN_CAP) { atomicAdd(&(bar)[XB_TMO], 1u); break; } } } } while (0)

struct XcdBarrier {
    unsigned* bar; unsigned x;
    volatile LAS unsigned* st;
};

__device__ __forceinline__ XcdBarrier xcd_barrier_post(unsigned* bar, volatile LAS unsigned* st) {
    XcdBarrier b; b.bar = bar; b.x = xb_xcc_id(); b.st = st;
    if (threadIdx.x == 0) (void)xb_add(&bar[XB_XCNT(b.x)], 1u);
    return b;
}
__device__ __forceinline__ void xcd_barrier_complete(unsigned* bar, unsigned x, unsigned& nloc, unsigned& nx) {
    const unsigned G = gridDim.x * gridDim.y * gridDim.z;
    unsigned sum, cnt, mine, sp = 0u;
    for (;;) {
        sum = 0u; cnt = 0u; mine = 0u;
#pragma unroll
        for (unsigned j = 0; j < 16; ++j) { const unsigned c = xb_ld(&bar[XB_XCNT(j)]); sum += c; cnt += (c > 0u) ? 1u : 0u; mine = (j == x) ? c : mine; }
        if (sum == G) break;
        __builtin_amdgcn_s_sleep(1);
        if ((++sp & 255u) == 0u) { if (xb_ld(&bar[XB_TMO])) break; if (sp > XB_SPIN_CAP) { atomicAdd(&bar[XB_TMO], 1u); break; } }
    }
    nloc = mine > 0u ? mine : 1u; nx = cnt > 0u ? cnt : 1u;
}

__device__ __forceinline__ void xcd_barrier(const XcdBarrier& b) {
    asm volatile("s_waitcnt vmcnt(0)" ::: "memory");
    __syncthreads();
    if (threadIdx.x == 0) {
        unsigned* bar = b.bar;
        __builtin_amdgcn_s_waitcnt(0);
        unsigned nloc = b.st[0], nx = b.st[1];
        if (nloc == 0u) { xcd_barrier_complete(bar, b.x, nloc, nx); b.st[0] = nloc; b.st[1] = nx; }
        const unsigned old = xb_add(&bar[XB_XSUB(b.x)], 1u);
        const unsigned gen = old / nloc;
        if (old + 1u == (gen + 1u) * nloc) {
            __builtin_amdgcn_fence(__ATOMIC_RELEASE, "agent");
            asm volatile("s_waitcnt vmcnt(0)" ::: "memory");
            const unsigned og = xb_add(&bar[XB_TOP], 1u);
            const unsigned tg = og / nx;
            if (og + 1u == (tg + 1u) * nx) xb_add(&bar[XB_TOPGEN], 1u);
            else XB_SPIN(xb_ld(&bar[XB_TOPGEN]) == tg, bar);
            __builtin_amdgcn_fence(__ATOMIC_ACQUIRE, "agent");
            xb_add(&bar[XB_XGEN(b.x)], 1u);
            asm volatile("s_waitcnt vmcnt(0)" ::: "memory");
        } else {
            XB_SPIN(xb_ld(&bar[XB_XGEN(b.x)]) == gen, bar);
            __builtin_amdgcn_fence(__ATOMIC_ACQUIRE, "agent");
            asm volatile("s_waitcnt vmcnt(0)" ::: "memory");
        }
    }
    __syncthreads();
}

constexpr int NPHASE = 11;
#define REP_GEMM 1
#define REP_SYNC 1
#define REP_SCAN 1
#define SCAN_PROBE 1
#define REP_P0 1
#ifndef PHM
#define PHM 0x7FF
#endif
__global__ void __launch_bounds__(512, 2) mega(Prm p) {
    extern __shared__ __attribute__((aligned(16))) unsigned char shm[];
    LAS unsigned char* lds3 = (LAS unsigned char*)shm;
    unsigned char* ws = p.ws;
    volatile LAS unsigned* xst = (volatile LAS unsigned*)(lds3 + LDS_BYTES);
    if (threadIdx.x == 0) { xst[0] = 0u; xst[1] = 0u; }
    __syncthreads();
    XcdBarrier xb{};
    const bool multi = (p.ph_hi - p.ph_lo) > 1;
    if (multi) xb = xcd_barrier_post((unsigned*)(ws + OFF_BAR), xst);
    if (p.ph_lo < 0) cg::this_grid().sync();
#define PH_BEGIN(i) if (((PHM >> (i)) & 1) && p.ph_lo <= (i) && (i) < p.ph_hi) { if ((i) > p.ph_lo) { xcd_barrier(xb); if (REP_SYNC > 1) xcd_barrier(xb); } pg8::StaticOrder S; (void)S;
#define PH_END }
    PH_BEGIN(0)
        for (int rep = 0; rep < REP_P0; ++rep) {
        phase_convert(p, shm, 0, 1856, gridDim.x, blockIdx.x);
        phase_rmsnorm_x(p.in[0], p.in[1], (bf16_t*)(ws + OFF_H)); __syncthreads(); }
    PH_END
    PH_BEGIN(1)
        pg8::Gemm g{(const bf16_t*)(ws + OFF_H), (const bf16_t*)(ws + OFF_WT1), TOK, NP1, 1024, (const bf16_t*)(ws + OFF_H), 1024, 64};
        Epi1 E{(bf16_t*)(ws + OFF_QKV), (bf16_t*)p.out, (bf16_t*)(ws + OFF_UU), (bf16_t*)p.out + (size_t)TOK * 1024, (float*)(ws + OFF_BA), (bf16_t*)(ws + OFF_HALO)};
        S.init(TOK, NP1, gridDim.x, blockIdx.x); for (int rep = 0; rep < REP_GEMM; ++rep) { pg8::gemm_phase(lds3, g, S, E); __syncthreads(); }
    PH_END
    PH_BEGIN(2)
        {
            unsigned* ctr = (unsigned*)(ws + OFF_BAR) + 3600;
            volatile LAS unsigned* sIt = xst + 2;
            for (;;) {
                if (threadIdx.x == 0) sIt[0] = __hip_atomic_fetch_add(ctr, 2u, __ATOMIC_RELAXED, __HIP_MEMORY_SCOPE_AGENT);
                __syncthreads();
                const unsigned it0 = sIt[0];
                __syncthreads();
                if (it0 >= (unsigned)NIT) break;
                phase_gdn_prep(p, shm, (int)it0, 1);
            }
        }
    PH_END
    PH_BEGIN(3)
        if (blockIdx.x < 32) phase_gdn_scan(p, lds3, blockIdx.x);
        else {
            const int ob = blockIdx.x - 32, nob = gridDim.x - 32;
            if (ob < 128) phase_s5(p, shm, ob);
            {
                unsigned* cnt = (unsigned*)(ws + OFF_BAR) + 3700;
                asm volatile("s_waitcnt vmcnt(0)" ::: "memory");
                __syncthreads();
                if (threadIdx.x == 0) {
                    __builtin_amdgcn_fence(__ATOMIC_RELEASE, "agent");
                    asm volatile("s_waitcnt vmcnt(0)" ::: "memory");
                    __hip_atomic_fetch_add(cnt, 1u, __ATOMIC_RELAXED, __HIP_MEMORY_SCOPE_AGENT);
                    unsigned sp = 0;
                    while (__hip_atomic_load(cnt, __ATOMIC_RELAXED, __HIP_MEMORY_SCOPE_AGENT) < (unsigned)nob) { __builtin_amdgcn_s_sleep(2); if (++sp > (1u << 22)) break; }
                    __builtin_amdgcn_fence(__ATOMIC_ACQUIRE, "agent");
                    asm volatile("s_waitcnt vmcnt(0)" ::: "memory");
                }
                __syncthreads();
            }
            pg8::Gemm g{(const bf16_t*)(ws + OFF_UU), (const bf16_t*)(ws + OFF_WTG), TOK, 1024, 1024, (const bf16_t*)(ws + OFF_UU), 1024, 64};
            EpiGlu E{(const bf16_t*)(ws + OFF_UU), (bf16_t*)p.out + (size_t)TOK * 1024};
            S.init(TOK, 1024, nob, ob); pg8::gemm_phase(lds3, g, S, E);
            __syncthreads();
            if (ob >= 32) phase_convert(p, shm, 1856, 4928, nob - 32, ob - 32);
        }
    PH_END
    PH_BEGIN(4)
        phase_ya(p, shm);
    PH_END
    PH_BEGIN(5)
        pg8::Gemm g{(const bf16_t*)p.out, (const bf16_t*)(ws + OFF_WTO0), TOK, 1024, 2048, (const bf16_t*)p.out + (size_t)TOK * 1024, 1024, 16};
        EpiB16 E{(bf16_t*)(ws + OFF_QKV)};
        S.init(TOK, 1024, gridDim.x, blockIdx.x); for (int rep = 0; rep < REP_GEMM; ++rep) { pg8::gemm_phase(lds3, g, S, E); __syncthreads(); }
    PH_END
    PH_BEGIN(6)
        phase_post<true>(p.in[0], (const bf16_t*)(ws + OFF_QKV), p.in[2], p.out, p.in[1] + 1024, (bf16_t*)(ws + OFF_H));
    PH_END
    PH_BEGIN(7)
        pg8::Gemm g{(const bf16_t*)(ws + OFF_H), (const bf16_t*)(ws + OFF_WT2), TOK, 8192, 1024, (const bf16_t*)(ws + OFF_H), 1024, 64};
        Epi2 E{(bf16_t*)(ws + OFF_P), (bf16_t*)(ws + OFF_Q)};
        S.init(TOK, 8192, gridDim.x, blockIdx.x); for (int rep = 0; rep < REP_GEMM; ++rep) { pg8::gemm_phase(lds3, g, S, E); __syncthreads(); }
    PH_END
    PH_BEGIN(8)
        phase_conv3(p);
    PH_END
    PH_BEGIN(9)
        pg8::Gemm g{(const bf16_t*)(ws + OFF_Q), (const bf16_t*)(ws + OFF_WTO1), TOK, 1024, 2048, (const bf16_t*)(ws + OFF_Q), 2048, 64};
        EpiB16 E{(bf16_t*)(ws + OFF_P)};
        S.init(TOK, 1024, gridDim.x, blockIdx.x); for (int rep = 0; rep < REP_GEMM; ++rep) { pg8::gemm_phase(lds3, g, S, E); __syncthreads(); }
    PH_END
    PH_BEGIN(10)
        phase_post<false>(p.out, (const bf16_t*)(ws + OFF_P), p.in[2] + 1024, p.out, nullptr, nullptr);
    PH_END
}

#ifndef N_LAUNCH_MODE
#define N_LAUNCH_MODE 1
#endif

extern "C" void kernel_launch(void* const* d_in, const int* in_sizes, int n_in, void* d_out, int out_size, void* d_ws, size_t ws_size, hipStream_t stream) {
    static int ready = 0;
    if (!ready) {
        if (n_in != 21 || ws_size < WS_END || out_size != TOK * DM) { fprintf(stderr, "kernel_launch: unexpected shapes (n_in %d ws %zu out %d)\n", n_in, ws_size, out_size); ready = -1; return; }
        if (hipFuncSetAttribute((const void*)mega, hipFuncAttributeMaxDynamicSharedMemorySize, LDS_BYTES + 16) != hipSuccess) { fprintf(stderr, "kernel_launch: hipFuncSetAttribute failed\n"); ready = -1; return; }
        ready = 1;
    }
    if (ready < 0) return;
    Prm p{};
    for (int i = 0; i < 21; ++i) p.in[i] = (const float*)d_in[i];
    p.out = (float*)d_out; p.ws = (unsigned char*)d_ws;
#if N_LAUNCH_MODE == 1
    p.ph_lo = 0; p.ph_hi = NPHASE;
    void* args[] = {&p};
    if (hipMemsetAsync((unsigned char*)d_ws + OFF_BAR, 0, 16384, stream) != hipSuccess) { fprintf(stderr, "memset failed\n"); return; }
    hipError_t e = hipLaunchCooperativeKernel((const void*)mega, dim3(256), dim3(512), args, LDS_BYTES + 16, stream);
    if (e != hipSuccess) fprintf(stderr, "cooperative launch failed: %s\n", hipGetErrorString(e));
#else
    for (int ph = 0; ph < NPHASE; ++ph) {
        p.ph_lo = ph; p.ph_hi = ph + 1;
        hipLaunchKernelGGL(mega, dim3(256), dim3(512), LDS_BYTES + 16, stream, p);
    }
#endif
}
```

```cpp
#include <hip/hip_runtime.h>
#include <hip/hip_cooperative_groups.h>
#include <cstdio>
namespace cg = cooperative_groups;

#define LAS __attribute__((address_space(3)))
typedef unsigned short bf16_t;
typedef short bf16x8 __attribute__((ext_vector_type(8)));
typedef float f32x4 __attribute__((ext_vector_type(4)));
typedef float f32x16 __attribute__((ext_vector_type(16)));
typedef unsigned u32x4 __attribute__((ext_vector_type(4)));
typedef unsigned u32x2 __attribute__((ext_vector_type(2)));

constexpr int TOK = 16384, DM = 1024, SEQ = 8192;
constexpr int NP1 = 6400;
constexpr int NIT = 2048;

constexpr size_t OFF_WT1 = 0;
constexpr size_t OFF_WTG = OFF_WT1 + (size_t)NP1 * 1024 * 2;
constexpr size_t OFF_WTO0 = OFF_WTG + (size_t)1024 * 1024 * 2;
constexpr size_t OFF_WT2 = OFF_WTO0 + (size_t)1024 * 2048 * 2;
constexpr size_t OFF_WTO1 = OFF_WT2 + (size_t)8192 * 1024 * 2;
constexpr size_t OFF_H = OFF_WTO1 + (size_t)1024 * 2048 * 2;
constexpr size_t OFF_QKV = OFF_H + (size_t)TOK * 1024 * 2;
constexpr size_t OFF_UU = OFF_QKV + (size_t)TOK * 3072 * 2;
constexpr size_t OFF_WB = OFF_UU + (size_t)TOK * 1024 * 2;
constexpr size_t OFF_ATT = OFF_WB + (size_t)NIT * 8192 * 2;
constexpr size_t OFF_HALO = OFF_ATT + (size_t)NIT * 4096 * 2;
constexpr size_t OFF_BA = OFF_HALO + (size_t)256 * 3 * 3072 * 2;
constexpr size_t OFF_GL = OFF_BA + (size_t)TOK * 16 * 4;
constexpr size_t OFF_BAR = OFF_GL + (size_t)NIT * 4;
constexpr size_t WS_END = OFF_BAR + 16384;
constexpr size_t OFF_YMIX = OFF_QKV;
constexpr size_t OFF_P = OFF_QKV;
constexpr size_t OFF_Q = OFF_QKV + (size_t)TOK * 2048 * 2;
static_assert(OFF_Q + (size_t)TOK * 2048 * 2 <= OFF_WB, "Q overlaps live data");
static_assert(WS_END <= (size_t)256 * 1024 * 1024, "workspace too big");

constexpr int LDS_BYTES = 157696;

struct Prm {
    const float* in[21];
    float* out;
    unsigned char* ws;
    int ph_lo, ph_hi;
};

__device__ __forceinline__ float bf2f(bf16_t b) { return __uint_as_float(((unsigned)b) << 16); }
__device__ __forceinline__ bf16_t f2bf(float f) { unsigned u = __float_as_uint(f); u += 0x7FFFu + ((u >> 16) & 1u); return (bf16_t)(u >> 16); }
typedef __bf16 bf16v2_t __attribute__((ext_vector_type(2)));
typedef float f32x2_t __attribute__((ext_vector_type(2)));
__device__ __forceinline__ unsigned pk2(float lo, float hi) { const f32x2_t v = {lo, hi}; return __builtin_bit_cast(unsigned, __builtin_convertvector(v, bf16v2_t)); }
__device__ __forceinline__ float lo2f(unsigned u) { return __uint_as_float(u << 16); }
__device__ __forceinline__ float hi2f(unsigned u) { return __uint_as_float(u & 0xFFFF0000u); }
__device__ __forceinline__ float sigmoidf_(float x) { return 1.0f / (1.0f + __expf(-x)); }
__device__ __forceinline__ float siluf_(float x) { return x / (1.0f + __expf(-x)); }
__device__ __forceinline__ float wave_sum(float v) {
#pragma unroll
    for (int o = 32; o >= 1; o >>= 1) v += __shfl_xor(v, o);
    return v;
}
__device__ __forceinline__ u32x4 pack8(f32x4 a, f32x4 b) { u32x4 r; r.x = pk2(a[0], a[1]); r.y = pk2(a[2], a[3]); r.z = pk2(b[0], b[1]); r.w = pk2(b[2], b[3]); return r; }

namespace pg8 {
constexpr int BM = 256, BK = 64, HALF = 128, HTB = HALF * BK * 2, STAGE_BYTES = 8 * HTB, NXCD = 8, WGM = 8;
__device__ __forceinline__ int lds_byte(int r, int c) { const int st = (r >> 4) * 2 + (c >> 5), rr = r & 15, cc = c & 31, ob = rr * 64 + cc * 2; return st * 1024 + (ob ^ (((ob >> 9) & 1) << 5)); }
__device__ __forceinline__ void stage_rc(int b, int& R, int& C) { const int st = b / 1024, sb = b % 1024, swz = sb ^ (((sb >> 9) & 1) << 5); R = (st >> 1) * 16 + swz / 64; C = (st & 1) * 32 + (swz % 64) / 2; }
__device__ __forceinline__ int perm32(int rho) { const int n = rho >> 4, i = rho & 15; return 8 * (i >> 2) + 4 * n + (i & 3); }
struct Unit { int pm, pn; };
struct Gemm { const bf16_t* A; const bf16_t* Bt; int M, N, K; const bf16_t* A2; int lda, ks; };
struct StaticOrder {
    int nM, nN, nwg, G, c;
    __device__ void init(int M, int N, int G_, int c_) { nM = M / BM; nN = N / BM; nwg = nM * nN; G = G_; c = c_; }
    __device__ bool next(int i, Unit& u) const {
        const long L = (long)i * G + c; if (L >= nwg) return false;
        int wgid = (int)L; { const int q = nwg / NXCD, r = nwg % NXCD, xcd = wgid % NXCD, off = wgid / NXCD; wgid = (xcd < r ? xcd * (q + 1) : r * (q + 1) + (xcd - r) * q) + off; }
        const int nig = WGM * nN, gid = wgid / nig, fm = gid * WGM, gsz = (nM - fm) < WGM ? (nM - fm) : WGM;
        u.pm = fm + ((wgid % nig) % gsz); u.pn = (wgid % nig) / gsz; return true;
    }
};

template <class Epi>
__device__ __forceinline__ void gemm_phase(LAS unsigned char* lds, const Gemm g, const StaticOrder& S, const Epi& E) {
    const int tid = threadIdx.x, wid = __builtin_amdgcn_readfirstlane(tid >> 6), lane = tid & 63, wr = wid >> 2, wc = wid & 3, fr = lane & 15, fq = lane >> 4;
    const int K = g.K, nt = K / BK;
    unsigned voffA[2], voffB[2];
#pragma unroll
    for (int i = 0; i < 2; ++i) { int R, C; stage_rc(tid * 16 + i * 8192, R, C); const int Rb = Epi::PERM ? ((R & ~31) + perm32(R & 31)) : R;
        voffA[i] = (unsigned)(R * g.lda + C) * 2u; voffB[i] = (unsigned)(Rb * K + C) * 2u; }
    const size_t kstep = (size_t)(BK * 2);
    const size_t hstep = (size_t)HALF * K * 2;
    const size_t tstep = 2 * hstep;
    const size_t hstepA = (size_t)HALF * g.lda * 2, tstepA = 2 * hstepA;
    const int ks = g.ks; const ptrdiff_t a2off = (const char*)g.A2 - (const char*)g.A - (ptrdiff_t)ks * (ptrdiff_t)kstep;
    const unsigned ldsw = (unsigned)wid * 1024u;
    const int aoff = lds_byte(wr * 64 + fr, fq * 8), boff = lds_byte(wc * 32 + fr, fq * 8);
#define PG8_SA(b, h) (((b) * 2 + (h)) * HTB)
#define PG8_SB(b, h) ((4 + (b) * 2 + (h)) * HTB)
#define PG8_STAGE(bufoff, gbase, voff) do { _Pragma("unroll") for (int _i = 0; _i < 2; ++_i) \
        __builtin_amdgcn_global_load_lds((const unsigned*)((const char*)(gbase) + (voff)[_i]), (LAS unsigned*)(lds + (bufoff) + ldsw + _i * 8192), 16, 0, 0); } while (0)
#define PG8_LDA(dst, b, h) do { _Pragma("unroll") for (int m = 0; m < 4; ++m) _Pragma("unroll") for (int k = 0; k < 2; ++k) dst[m][k] = *(const LAS bf16x8*)(lds + PG8_SA(b, h) + aoff + m * 2048 + k * 1024); } while (0)
#define PG8_LDB(dst, b, h) do { _Pragma("unroll") for (int n = 0; n < 2; ++n) _Pragma("unroll") for (int k = 0; k < 2; ++k) dst[n][k] = *(const LAS bf16x8*)(lds + PG8_SB(b, h) + boff + n * 2048 + k * 1024); } while (0)
#define PG8_MMA(ai, bj, At, Bt) do { __builtin_amdgcn_s_setprio(1); _Pragma("unroll") for (int m = 0; m < 4; ++m) _Pragma("unroll") for (int n = 0; n < 2; ++n) _Pragma("unroll") for (int k = 0; k < 2; ++k) \
        acc[ai][bj][m][n] = __builtin_amdgcn_mfma_f32_16x16x32_bf16(Bt[n][k], At[m][k], acc[ai][bj][m][n], 0, 0, 0); __builtin_amdgcn_s_setprio(0); } while (0)
#define PG8_WAIT_V(n) asm volatile("s_waitcnt vmcnt(" #n ")" ::: "memory")
#define PG8_WAIT_L(n) asm volatile("s_waitcnt lgkmcnt(" #n ")" ::: "memory")
#define PG8_BAR __builtin_amdgcn_s_barrier()
#define PG8_SCHED __builtin_amdgcn_sched_barrier(0)
    Unit cur, nxt; int ui = 0;
    if (!S.next(0, cur)) return;
    f32x4 acc[2][2][4][2];
#pragma unroll
    for (int a = 0; a < 2; ++a)
#pragma unroll
        for (int b = 0; b < 2; ++b)
#pragma unroll
            for (int m = 0; m < 4; ++m)
#pragma unroll
                for (int n = 0; n < 2; ++n) acc[a][b][m][n] = (f32x4){0.f, 0.f, 0.f, 0.f};
    bf16x8 At[4][2], B0[2][2], B1[2][2];
    const char* cA = (const char*)g.A + (size_t)cur.pm * tstepA; const char* cB = (const char*)g.Bt + (size_t)cur.pn * tstep;
    PG8_STAGE(PG8_SB(0, 0), cB, voffB); PG8_STAGE(PG8_SA(0, 0), cA, voffA); PG8_STAGE(PG8_SB(0, 1), cB + hstep, voffB); PG8_STAGE(PG8_SA(0, 1), cA + hstepA, voffA);
    if (wr == 1) PG8_BAR;
    PG8_WAIT_V(4); PG8_BAR;
    PG8_STAGE(PG8_SB(1, 0), cB + kstep, voffB); PG8_STAGE(PG8_SA(1, 0), cA + kstep, voffA); PG8_STAGE(PG8_SB(1, 1), cB + hstep + kstep, voffB);
    PG8_WAIT_V(6); PG8_BAR;
    for (;;) {
        const bool has_next = S.next(ui + 1, nxt);
        const char* nA = has_next ? (const char*)g.A + (size_t)nxt.pm * tstepA : cA; const char* nB = has_next ? (const char*)g.Bt + (size_t)nxt.pn * tstep : cB;
        for (int t = 0; t < nt; t += 2) {
            const bool last = (t == nt - 2);
            const char* a1 = cA + (size_t)(t + 1) * kstep + ((t + 1) >= ks ? a2off : 0);
            const char* a2 = last ? nA : cA + (size_t)(t + 2) * kstep + ((t + 2) >= ks ? a2off : 0); const char* b2 = last ? nB : cB + (size_t)(t + 2) * kstep;
            const char* a3 = last ? nA + kstep : cA + (size_t)(t + 3) * kstep + ((t + 3) >= ks ? a2off : 0); const char* b3 = b2 + kstep;
            PG8_LDB(B0, 0, 0); PG8_SCHED; PG8_LDA(At, 0, 0); PG8_STAGE(PG8_SA(1, 1), a1 + hstepA, voffA);
            PG8_WAIT_L(8); PG8_BAR; PG8_WAIT_L(0); PG8_MMA(0, 0, At, B0); PG8_BAR; PG8_SCHED;
            PG8_LDB(B1, 0, 1); PG8_STAGE(PG8_SB(0, 0), b2, voffB);
            PG8_BAR; PG8_WAIT_L(0); PG8_MMA(0, 1, At, B1); PG8_BAR;
            PG8_LDA(At, 0, 1); PG8_STAGE(PG8_SA(0, 0), a2, voffA);
            PG8_BAR; PG8_WAIT_L(0); PG8_MMA(1, 0, At, B0); PG8_BAR; PG8_SCHED;
            PG8_STAGE(PG8_SB(0, 1), b2 + hstep, voffB);
            PG8_WAIT_V(6); PG8_BAR; PG8_MMA(1, 1, At, B1); PG8_BAR;
            PG8_LDB(B0, 1, 0); PG8_SCHED; PG8_LDA(At, 1, 0); PG8_STAGE(PG8_SA(0, 1), a2 + hstepA, voffA);
            PG8_WAIT_L(8); PG8_BAR; PG8_WAIT_L(0); PG8_MMA(0, 0, At, B0); PG8_BAR; PG8_SCHED;
            PG8_LDB(B1, 1, 1); PG8_STAGE(PG8_SB(1, 0), b3, voffB);
            PG8_BAR; PG8_WAIT_L(0); PG8_MMA(0, 1, At, B1); PG8_BAR;
            PG8_LDA(At, 1, 1); PG8_STAGE(PG8_SA(1, 0), a3, voffA);
            PG8_BAR; PG8_WAIT_L(0); PG8_MMA(1, 0, At, B0); PG8_BAR; PG8_SCHED;
            PG8_STAGE(PG8_SB(1, 1), b3 + hstep, voffB);
            PG8_WAIT_V(6); PG8_BAR; PG8_MMA(1, 1, At, B1); PG8_BAR;
        }
        E(acc, cur, wr, wc, fr, fq);
        if (!has_next) break;
#pragma unroll
        for (int a = 0; a < 2; ++a)
#pragma unroll
            for (int b = 0; b < 2; ++b)
#pragma unroll
                for (int m = 0; m < 4; ++m)
#pragma unroll
                    for (int n = 0; n < 2; ++n) acc[a][b][m][n] = (f32x4){0.f, 0.f, 0.f, 0.f};
        cur = nxt; cA = nA; cB = nB; ++ui;
    }
    PG8_WAIT_V(0);
    if (wr == 0) PG8_BAR;
    PG8_BAR;
#undef PG8_SA
#undef PG8_SB
#undef PG8_STAGE
#undef PG8_LDA
#undef PG8_LDB
#undef PG8_MMA
#undef PG8_WAIT_V
#undef PG8_WAIT_L
#undef PG8_BAR
#undef PG8_SCHED
}
}
using pg8::Unit;

struct Epi1 {
    static constexpr bool PERM = true;
    bf16_t* QKV; bf16_t* SZA; bf16_t* UU; bf16_t* SZB; float* BA; bf16_t* HALO;
    __device__ __forceinline__ void operator()(const f32x4 (&acc)[2][2][4][2], const Unit& u, int wr, int wc, int fr_, int fq_) const {
        int lane = (int)(threadIdx.x & 63); asm volatile("" : "+v"(lane));
        const int fr = lane & 15, fq = lane >> 4; (void)fr_; (void)fq_;
        const int row0 = u.pm * 256 + wr * 64 + fr, pn = u.pn;
#pragma unroll
        for (int ai = 0; ai < 2; ++ai)
#pragma unroll
            for (int m = 0; m < 4; ++m) {
                const size_t row = (size_t)(row0 + ai * 128 + m * 16);
#pragma unroll
                for (int bj = 0; bj < 2; ++bj) {
                    const int colt = 128 * bj + 32 * wc + 8 * fq;
                    f32x4 v0 = acc[ai][bj][m][0], v1 = acc[ai][bj][m][1];
                    if (pn < 12) {
                        const int c = pn * 256 + colt; const u32x4 pk = pack8(v0, v1);
                        *(u32x4*)(QKV + row * 3072 + c) = pk;
                        if (m == 3 && fr >= 13) *(u32x4*)(HALO + ((row >> 6) * 3 + (fr - 13)) * 3072 + c) = pk;
                    } else if (pn < 16) {
#pragma unroll
                        for (int e = 0; e < 4; ++e) { v0[e] = siluf_(v0[e]); v1[e] = siluf_(v1[e]); }
                        *(u32x4*)(SZA + row * 1024 + (pn - 12) * 256 + colt) = pack8(v0, v1);
                    } else if (pn < 20) {
                        *(u32x4*)(UU + row * 1024 + (pn - 16) * 256 + colt) = pack8(v0, v1);
                    } else if (pn < 24) {
#pragma unroll
                        for (int e = 0; e < 4; ++e) { v0[e] = siluf_(v0[e]); v1[e] = siluf_(v1[e]); }
                        *(u32x4*)(SZB + row * 1024 + (pn - 20) * 256 + colt) = pack8(v0, v1);
                    } else if (colt < 16) {
                        *(f32x4*)(BA + row * 16 + colt) = v0; *(f32x4*)(BA + row * 16 + colt + 4) = v1;
                    }
                }
            }
    }
};
struct EpiGlu {
    static constexpr bool PERM = true;
    const bf16_t* Y5; bf16_t* SZB;
    __device__ __forceinline__ void operator()(const f32x4 (&acc)[2][2][4][2], const Unit& u, int wr, int wc, int fr, int fq) const {
        const int row0 = u.pm * 256 + wr * 64 + fr;
#pragma unroll
        for (int ai = 0; ai < 2; ++ai)
#pragma unroll
            for (int m = 0; m < 4; ++m) {
                const size_t row = (size_t)(row0 + ai * 128 + m * 16);
#pragma unroll
                for (int bj = 0; bj < 2; ++bj) {
                    const int c = u.pn * 256 + 128 * bj + 32 * wc + 8 * fq;
                    const u32x4 y = *(const u32x4*)(Y5 + row * 1024 + c), z = *(const u32x4*)(SZB + row * 1024 + c);
                    const f32x4 a0 = acc[ai][bj][m][0], a1 = acc[ai][bj][m][1];
                    u32x4 o;
                    o.x = pk2(lo2f(y.x) * sigmoidf_(a0[0]) * lo2f(z.x), hi2f(y.x) * sigmoidf_(a0[1]) * hi2f(z.x));
                    o.y = pk2(lo2f(y.y) * sigmoidf_(a0[2]) * lo2f(z.y), hi2f(y.y) * sigmoidf_(a0[3]) * hi2f(z.y));
                    o.z = pk2(lo2f(y.z) * sigmoidf_(a1[0]) * lo2f(z.z), hi2f(y.z) * sigmoidf_(a1[1]) * hi2f(z.z));
                    o.w = pk2(lo2f(y.w) * sigmoidf_(a1[2]) * lo2f(z.w), hi2f(y.w) * sigmoidf_(a1[3]) * hi2f(z.w));
                    *(u32x4*)(SZB + row * 1024 + c) = o;
                }
            }
    }
};
struct EpiF32 {
    static constexpr bool PERM = false;
    float* C;
    __device__ __forceinline__ void operator()(const f32x4 (&acc)[2][2][4][2], const Unit& u, int wr, int wc, int fr, int fq) const {
        const int row0 = u.pm * 256 + wr * 64 + fr, col0 = u.pn * 256 + wc * 32 + 4 * fq;
#pragma unroll
        for (int ai = 0; ai < 2; ++ai)
#pragma unroll
            for (int m = 0; m < 4; ++m) { float* rowp = C + (size_t)(row0 + ai * 128 + m * 16) * 1024 + col0;
#pragma unroll
                for (int bj = 0; bj < 2; ++bj)
#pragma unroll
                    for (int n = 0; n < 2; ++n) *(f32x4*)(rowp + bj * 128 + n * 16) = acc[ai][bj][m][n]; }
    }
};
struct EpiB16 {
    static constexpr bool PERM = true;
    bf16_t* C;
    __device__ __forceinline__ void operator()(const f32x4 (&acc)[2][2][4][2], const Unit& u, int wr, int wc, int fr, int fq) const {
        const int row0 = u.pm * 256 + wr * 64 + fr, col0 = u.pn * 256 + wc * 32 + 8 * fq;
#pragma unroll
        for (int ai = 0; ai < 2; ++ai)
#pragma unroll
            for (int m = 0; m < 4; ++m) { bf16_t* rowp = C + (size_t)(row0 + ai * 128 + m * 16) * 1024 + col0;
#pragma unroll
                for (int bj = 0; bj < 2; ++bj) *(u32x4*)(rowp + bj * 128) = pack8(acc[ai][bj][m][0], acc[ai][bj][m][1]); }
    }
};
struct Epi2 {
    static constexpr bool PERM = false;
    bf16_t* P; bf16_t* Q;
    __device__ __forceinline__ void operator()(const f32x4 (&acc)[2][2][4][2], const Unit& u, int wr, int wc, int fr, int fq) const {
        const int row0 = u.pm * 256 + wr * 64 + fr, ch = u.pn * 64 + 16 * wc + 4 * fq;
#pragma unroll
        for (int ai = 0; ai < 2; ++ai)
#pragma unroll
            for (int m = 0; m < 4; ++m) {
                const size_t row = (size_t)(row0 + ai * 128 + m * 16);
                const f32x4 gb = acc[ai][0][m][0], gc = acc[ai][0][m][1], hv = acc[ai][1][m][0], z = acc[ai][1][m][1];
                u32x2 pp, qq;
                pp.x = pk2(gc[0] * hv[0], gc[1] * hv[1]); pp.y = pk2(gc[2] * hv[2], gc[3] * hv[3]);
                qq.x = pk2(gb[0] * siluf_(z[0]), gb[1] * siluf_(z[1])); qq.y = pk2(gb[2] * siluf_(z[2]), gb[3] * siluf_(z[3]));
                *(u32x2*)(P + row * 2048 + ch) = pp; *(u32x2*)(Q + row * 2048 + ch) = qq;
            }
    }
};

__device__ __forceinline__ int src_col(int mode, int n, int& pn_unused) {
    (void)pn_unused;
    if (mode == 0) return n;
    if (mode == 1) { if (n < 4096) return n; if (n < 6144) return n + 16; if (n < 6160) return n - 2048; return -1; }
    const int pn = n >> 8, col = n & 255, bj = col >> 7, wc = (col >> 5) & 3, nn = (col >> 4) & 1, lo = col & 15;
    return (2 * bj + nn) * 2048 + pn * 64 + 16 * wc + lo;
}
__device__ __forceinline__ void phase_convert(const Prm& p, unsigned char* lds, int t_begin, int t_end, int nblk, int bidx) {
    float* tile = (float*)lds;
    const int tid = threadIdx.x;
    for (int tix = t_begin + bidx; tix < t_end; tix += nblk) {
        int tl = tix, K, Nsrc, mode; const float* W; bf16_t* Wt;
        if (tl < 1600) { W = p.in[3]; Wt = (bf16_t*)(p.ws + OFF_WT1); K = 1024; Nsrc = 6160; mode = 1; }
        else if ((tl -= 1600) < 256) { W = p.in[16]; Wt = (bf16_t*)(p.ws + OFF_WTG); K = 1024; Nsrc = 1024; mode = 0; }
        else if ((tl -= 256) < 512) { W = p.in[17]; Wt = (bf16_t*)(p.ws + OFF_WTO0); K = 2048; Nsrc = 1024; mode = 0; }
        else if ((tl -= 512) < 2048) { W = p.in[18]; Wt = (bf16_t*)(p.ws + OFF_WT2); K = 1024; Nsrc = 8192; mode = 2; }
        else { tl -= 2048; W = p.in[20]; Wt = (bf16_t*)(p.ws + OFF_WTO1); K = 2048; Nsrc = 1024; mode = 0; }
        const int ntk = K / 64, n0 = (tl / ntk) * 64, k0 = (tl % ntk) * 64;
        { const int j = tid & 63; int dummy = 0; const int sc = src_col(mode, n0 + j, dummy);
#pragma unroll
          for (int i = 0; i < 8; ++i) { const int k = (tid >> 6) + 8 * i; tile[k * 65 + j] = sc >= 0 ? W[(size_t)(k0 + k) * Nsrc + sc] : 0.0f; } }
        __syncthreads();
        { const int r = tid >> 3, c8 = (tid & 7) * 8; u32x4 o;
          o.x = pk2(tile[(c8 + 0) * 65 + r], tile[(c8 + 1) * 65 + r]); o.y = pk2(tile[(c8 + 2) * 65 + r], tile[(c8 + 3) * 65 + r]);
          o.z = pk2(tile[(c8 + 4) * 65 + r], tile[(c8 + 5) * 65 + r]); o.w = pk2(tile[(c8 + 6) * 65 + r], tile[(c8 + 7) * 65 + r]);
          *(u32x4*)(Wt + (size_t)(n0 + r) * K + k0 + c8) = o; }
        __syncthreads();
    }
}
__device__ __forceinline__ void phase_rmsnorm_x(const float* x, const float* w, bf16_t* H) {
    const int lane = threadIdx.x & 63, nw = gridDim.x * 8;
    for (int row = blockIdx.x * 8 + (threadIdx.x >> 6); row < TOK; row += nw) {
        const f32x4* xr = (const f32x4*)(x + (size_t)row * 1024);
        f32x4 v[4]; float ss = 0.f;
#pragma unroll
        for (int i = 0; i < 4; ++i) { v[i] = xr[lane + 64 * i]; ss += v[i][0] * v[i][0] + v[i][1] * v[i][1] + v[i][2] * v[i][2] + v[i][3] * v[i][3]; }
        ss = wave_sum(ss);
        const float rstd = rsqrtf(ss * (1.0f / 1024.0f) + 1e-6f);
#pragma unroll
        for (int i = 0; i < 4; ++i) { const f32x4 w4 = ((const f32x4*)w)[lane + 64 * i]; u32x2 o;
            o.x = pk2(v[i][0] * rstd * w4[0], v[i][1] * rstd * w4[1]); o.y = pk2(v[i][2] * rstd * w4[2], v[i][3] * rstd * w4[3]);
            *(u32x2*)(H + (size_t)row * 1024 + (lane + 64 * i) * 4) = o; }
    }
}
template <bool NEXT>
__device__ __forceinline__ void phase_post(const float* base, const bf16_t* Y, const float* wpost, float* OUT, const float* wpre, bf16_t* H) {
    const int lane = threadIdx.x & 63, nw = gridDim.x * 8;
    for (int row = blockIdx.x * 8 + (threadIdx.x >> 6); row < TOK; row += nw) {
        const u32x2* yr = (const u32x2*)(Y + (size_t)row * 1024); const f32x4* br = (const f32x4*)(base + (size_t)row * 1024);
        f32x4 v[4], xb[4]; float ss = 0.f;
#pragma unroll
        for (int i = 0; i < 4; ++i) { const u32x2 y2 = yr[lane + 64 * i]; v[i] = (f32x4){lo2f(y2.x), hi2f(y2.x), lo2f(y2.y), hi2f(y2.y)}; xb[i] = br[lane + 64 * i]; ss += v[i][0] * v[i][0] + v[i][1] * v[i][1] + v[i][2] * v[i][2] + v[i][3] * v[i][3]; }
        ss = wave_sum(ss);
        const float rstd = rsqrtf(ss * (1.0f / 1024.0f) + 1e-6f);
        float s2 = 0.f;
#pragma unroll
        for (int i = 0; i < 4; ++i) { const f32x4 w4 = ((const f32x4*)wpost)[lane + 64 * i];
#pragma unroll
            for (int e = 0; e < 4; ++e) { v[i][e] = xb[i][e] + v[i][e] * rstd * w4[e]; s2 += v[i][e] * v[i][e]; }
            ((f32x4*)(OUT + (size_t)row * 1024))[lane + 64 * i] = v[i]; }
        if (NEXT) {
            s2 = wave_sum(s2);
            const float r2 = rsqrtf(s2 * (1.0f / 1024.0f) + 1e-6f);
#pragma unroll
            for (int i = 0; i < 4; ++i) { const f32x4 w4 = ((const f32x4*)wpre)[lane + 64 * i]; u32x2 o;
                o.x = pk2(v[i][0] * r2 * w4[0], v[i][1] * r2 * w4[1]); o.y = pk2(v[i][2] * r2 * w4[2], v[i][3] * r2 * w4[3]);
                *(u32x2*)(H + (size_t)row * 1024 + (lane + 64 * i) * 4) = o; }
        }
    }
}


__device__ __forceinline__ void sincos_d(double x, double& s, double& c) {
    const double k = rint(x * 0.6366197723675814);
    const double r = fma(-k, 6.123233995736766e-17, fma(-k, 1.5707963267948966, x)), r2 = r * r;
    double sp = -7.647163731819816e-13; sp = fma(sp, r2, 1.6059043836821613e-10); sp = fma(sp, r2, -2.505210838544172e-8); sp = fma(sp, r2, 2.7557319223985893e-6);
    sp = fma(sp, r2, -1.984126984126984e-4); sp = fma(sp, r2, 8.333333333333333e-3); sp = fma(sp, r2, -1.6666666666666666e-1); sp = fma(sp * r2, r, r);
    double cp = 4.779477332387385e-14; cp = fma(cp, r2, -1.1470745597729725e-11); cp = fma(cp, r2, 2.08767569878681e-9); cp = fma(cp, r2, -2.755731922398589e-7);
    cp = fma(cp, r2, 2.48015873015873e-5); cp = fma(cp, r2, -1.388888888888889e-3); cp = fma(cp, r2, 4.1666666666666664e-2); cp = fma(cp, r2, -0.5); cp = fma(cp, r2, 1.0);
    const int q = ((int)k) & 3;
    const double s0 = (q & 1) ? cp : sp, c0 = (q & 1) ? sp : cp;
    s = (q & 2) ? -s0 : s0; c = ((q + 1) & 2) ? -c0 : c0;
}
__device__ __forceinline__ double exp_d(double x) {
    const double n = rint(x * 1.4426950408889634);
    const double r = fma(-n, 2.3190468138462996e-17, fma(-n, 0.6931471805599453, x));
    double p = 1.6059043836821613e-10; p = fma(p, r, 2.08767569878681e-9); p = fma(p, r, 2.505210838544172e-8); p = fma(p, r, 2.755731922398589e-7); p = fma(p, r, 2.7557319223985893e-6);
    p = fma(p, r, 2.48015873015873e-5); p = fma(p, r, 1.984126984126984e-4); p = fma(p, r, 1.388888888888889e-3); p = fma(p, r, 8.333333333333333e-3); p = fma(p, r, 4.1666666666666664e-2);
    p = fma(p, r, 1.6666666666666666e-1); p = fma(p, r, 0.5); p = fma(p, r, 1.0); p = fma(p, r, 1.0);
    return ldexp(p, (int)n);
}
__device__ __forceinline__ float bcast_lo(float v) { auto r = __builtin_amdgcn_permlane32_swap(__float_as_uint(v), __float_as_uint(v), false, false); return __uint_as_float(r[0]); }
__device__ __forceinline__ float bcast_hi(float v) { auto r = __builtin_amdgcn_permlane32_swap(__float_as_uint(v), __float_as_uint(v), false, false); return __uint_as_float(r[1]); }

struct S5C {
    float ar[2][4], ai[2][4];
    float a512r[2], a512i[2];
    bf16x8 BB[4];
    bf16x8 CC[4];
    float dco;
};

template <bool OUT>
__device__ __forceinline__ void s5_chunk(const S5C& C, bf16_t* UU, int b, int g, int chunk, float (&st)[2][2], bf16_t* sX, int lane) {
    const int n = lane & 31, hh = lane >> 5, fr = lane & 15, fq = lane >> 4;
    const size_t tok0 = (size_t)b * SEQ + (size_t)chunk * 512;
    bf16x8 ua = *(const bf16x8*)(UU + (tok0 + n) * 1024 + 16 * g + 8 * hh);
    bf16_t uo[8];
    if (OUT) {
#pragma unroll
        for (int mt = 0; mt < 2; ++mt)
#pragma unroll
            for (int j = 0; j < 4; ++j) uo[mt * 4 + j] = UU[(tok0 + 16 * mt + 4 * fq + j) * 1024 + 16 * g + fr];
    }
    for (int blk = 0; blk < 16; ++blk) {
        const size_t t0 = tok0 + (size_t)blk * 32;
        const bf16x8 ucur = ua;
        bf16_t ucuro[8];
        if (OUT) {
#pragma unroll
            for (int i = 0; i < 8; ++i) ucuro[i] = uo[i];
        }
        if (blk < 15) {
            ua = *(const bf16x8*)(UU + (t0 + 32 + n) * 1024 + 16 * g + 8 * hh);
            if (OUT) {
#pragma unroll
                for (int mt = 0; mt < 2; ++mt)
#pragma unroll
                    for (int j = 0; j < 4; ++j) uo[mt * 4 + j] = UU[(t0 + 32 + 16 * mt + 4 * fq + j) * 1024 + 16 * g + fr];
            }
        }
        f32x16 acc[4];
#pragma unroll
        for (int tl = 0; tl < 4; ++tl) {
            f32x16 z;
#pragma unroll
            for (int i = 0; i < 16; ++i) z[i] = 0.f;
            acc[tl] = __builtin_amdgcn_mfma_f32_32x32x16_bf16(ucur, C.BB[tl], z, 0, 0, 0);
        }
#pragma unroll
        for (int tp = 0; tp < 2; ++tp) {
            f32x16& re = acc[2 * tp]; f32x16& im = acc[2 * tp + 1];
            const float a1r = C.ar[tp][0], a1i = C.ai[tp][0];
#pragma unroll
            for (int q = 0; q < 4; ++q)
#pragma unroll
                for (int r = 1; r < 4; ++r) {
                    const float pr = re[4 * q + r - 1], pi = im[4 * q + r - 1];
                    re[4 * q + r] += a1r * pr - a1i * pi; im[4 * q + r] += a1r * pi + a1i * pr;
                }
            float cr = st[tp][0], ci = st[tp][1];
            const float a4r = C.ar[tp][3], a4i = C.ai[tp][3];
#pragma unroll
            for (int q = 0; q < 4; ++q) {
                const float tr = re[4 * q + 3] + a4r * cr - a4i * ci, ti = im[4 * q + 3] + a4r * ci + a4i * cr;
                const float o0r = bcast_lo(tr), o0i = bcast_lo(ti);
                const float xr = hh ? o0r : cr, xi = hh ? o0i : ci;
                if (OUT) {
#pragma unroll
                    for (int r = 0; r < 4; ++r) { const float kr = C.ar[tp][r], ki = C.ai[tp][r];
                        re[4 * q + r] += kr * xr - ki * xi; im[4 * q + r] += kr * xi + ki * xr; }
                } else {
                    re[4 * q + 3] += a4r * xr - a4i * xi; im[4 * q + 3] += a4r * xi + a4i * xr;
                }
                cr = bcast_hi(re[4 * q + 3]); ci = bcast_hi(im[4 * q + 3]);
            }
            st[tp][0] = cr; st[tp][1] = ci;
        }
        if (OUT) {
            asm volatile("s_waitcnt lgkmcnt(0)" ::: "memory");
#pragma unroll
            for (int tp = 0; tp < 2; ++tp)
#pragma unroll
                for (int i = 0; i < 16; ++i) {
                    const int t = 8 * (i >> 2) + 4 * hh + (i & 3);
                    *(unsigned*)(sX + t * 136 + 2 * (n + 32 * tp)) = pk2(acc[2 * tp][i], acc[2 * tp + 1][i]);
                }
            asm volatile("s_waitcnt lgkmcnt(0)" ::: "memory");
            __builtin_amdgcn_wave_barrier();
#pragma unroll
            for (int mt = 0; mt < 2; ++mt) {
                f32x4 y = (f32x4){0.f, 0.f, 0.f, 0.f};
#pragma unroll
                for (int ks = 0; ks < 4; ++ks) {
                    const bf16x8 xa = *(const bf16x8*)(sX + (16 * mt + fr) * 136 + 32 * ks + 8 * fq);
                    y = __builtin_amdgcn_mfma_f32_16x16x32_bf16(xa, C.CC[ks], y, 0, 0, 0);
                }
#pragma unroll
                for (int j = 0; j < 4; ++j) {
                    float v = y[j] + C.dco * bf2f(ucuro[mt * 4 + j]);
                    const float inner = 0.7978845608028654f * (v + 0.044715f * v * v * v);
                    v = v / (1.0f + __expf(-2.0f * inner));
                    UU[(t0 + 16 * mt + 4 * fq + j) * 1024 + 16 * g + fr] = f2bf(v);
                }
            }
            asm volatile("s_waitcnt lgkmcnt(0)" ::: "memory");
            __builtin_amdgcn_wave_barrier();
        }
    }
}

__device__ __forceinline__ void phase_s5(const Prm& p, unsigned char* lds, int bg) {
    const int b = bg >> 6, g = bg & 63;
    const int tid = threadIdx.x, wv = tid >> 6, lane = tid & 63, n = lane & 31, hh = lane >> 5, fr = lane & 15, fq = lane >> 4;
    bf16_t* sX = (bf16_t*)(lds + wv * 8704);
    float* sXE = (float*)(lds + 8 * 8704);
    bf16_t* UU = (bf16_t*)(p.ws + OFF_UU);
    const float* lam_re = p.in[8]; const float* lam_im = p.in[9]; const float* b_re = p.in[10]; const float* b_im = p.in[11];
    const float* c_re = p.in[12]; const float* c_im = p.in[13];
    S5C C;
    const double dt = exp_d((double)p.in[14][g]);
    float fre[2], fim[2];
#pragma unroll
    for (int tp = 0; tp < 2; ++tp) {
        const int pp = n + 32 * tp;
        const double lr = (double)fminf(lam_re[g * 64 + pp], -1e-4f), li = (double)lam_im[g * 64 + pp];
#pragma unroll
        for (int k = 0; k < 4; ++k) { double sn, cs; sincos_d(li * dt * (k + 1), sn, cs); const double mag = exp_d(lr * dt * (k + 1)); C.ar[tp][k] = (float)(mag * cs); C.ai[tp][k] = (float)(mag * sn); }
        { double sn, cs; sincos_d(li * dt * 512.0, sn, cs); const double mag = exp_d(lr * dt * 512.0); C.a512r[tp] = (float)(mag * cs); C.a512i[tp] = (float)(mag * sn); }
        double sn, cs; sincos_d(li * dt, sn, cs);
        const double mag = exp_d(lr * dt), abr = mag * cs, abi = mag * sn;
        const double den = lr * lr + li * li, nr = abr - 1.0, ni = abi;
        fre[tp] = (float)((nr * lr + ni * li) / den); fim[tp] = (float)((ni * lr - nr * li) / den);
    }
#pragma unroll
    for (int tl = 0; tl < 4; ++tl) {
        const int tp = tl >> 1, ri = tl & 1, pp = n + 32 * tp;
#pragma unroll
        for (int j = 0; j < 8; ++j) {
            const int ch = 8 * hh + j;
            const float br = b_re[(g * 64 + pp) * 16 + ch], bi = b_im[(g * 64 + pp) * 16 + ch];
            const float v = ri == 0 ? fre[tp] * br - fim[tp] * bi : fre[tp] * bi + fim[tp] * br;
            C.BB[tl][j] = (short)f2bf(v);
        }
    }
#pragma unroll
    for (int ks = 0; ks < 4; ++ks)
#pragma unroll
        for (int j = 0; j < 8; ++j) {
            const int k = 32 * ks + 8 * fq + j, pp = k >> 1, ri = k & 1;
            const float v = ri == 0 ? c_re[(g * 16 + fr) * 64 + pp] : -c_im[(g * 16 + fr) * 64 + pp];
            C.CC[ks][j] = (short)f2bf(v);
        }
    C.dco = p.in[15][16 * g + fr];
    for (int rd = 0; rd < 2; ++rd) {
        const int chunk = wv + 8 * rd;
        float st[2][2] = {{0.f, 0.f}, {0.f, 0.f}};
        s5_chunk<false>(C, UU, b, g, chunk, st, sX, lane);
        if (hh == 0) {
#pragma unroll
            for (int tp = 0; tp < 2; ++tp) { sXE[(chunk * 64 + n + 32 * tp) * 2 + 0] = st[tp][0]; sXE[(chunk * 64 + n + 32 * tp) * 2 + 1] = st[tp][1]; }
        }
    }
    __syncthreads();
    for (int rd = 0; rd < 2; ++rd) {
        const int chunk = wv + 8 * rd;
        float st[2][2] = {{0.f, 0.f}, {0.f, 0.f}};
        for (int c2 = 0; c2 < chunk; ++c2) {
#pragma unroll
            for (int tp = 0; tp < 2; ++tp) {
                const float er = sXE[(c2 * 64 + n + 32 * tp) * 2 + 0], ei = sXE[(c2 * 64 + n + 32 * tp) * 2 + 1];
                const float nr = C.a512r[tp] * st[tp][0] - C.a512i[tp] * st[tp][1] + er, ni = C.a512r[tp] * st[tp][1] + C.a512i[tp] * st[tp][0] + ei;
                st[tp][0] = nr; st[tp][1] = ni;
            }
        }
        s5_chunk<true>(C, UU, b, g, chunk, st, sX, lane);
    }
    __syncthreads();
}

__device__ __forceinline__ void phase_gdn_prep(const Prm& p, unsigned char* lds, int it0, int nrounds) {
    const int tid0 = threadIdx.x, hb = tid0 >> 8;
    unsigned char* base = lds + hb * 76800;
    bf16_t* sQ = (bf16_t*)base;
    bf16_t* sK = (bf16_t*)(base + 17408);
    bf16_t* sV = (bf16_t*)(base + 2 * 17408);
    float* sL = (float*)(base + 3 * 17408);
    float* sBeta = (float*)(base + 4 * 17408);
    float* sGc = sBeta + 64; float* sEg = sGc + 64; float* sBE = sEg + 64;
    float* sCW = sBE + 64;
    bf16_t* QKV = (bf16_t*)(p.ws + OFF_QKV); const bf16_t* HALO = (const bf16_t*)(p.ws + OFF_HALO);
    const float* BA = (const float*)(p.ws + OFF_BA); float* GL = (float*)(p.ws + OFF_GL);
    bf16_t* WB = (bf16_t*)(p.ws + OFF_WB); bf16_t* ATT = (bf16_t*)(p.ws + OFF_ATT);
    const float* convw = p.in[4];
    for (int rd = 0; rd < nrounds; ++rd) {
        int tid = tid0; asm volatile("" : "+v"(tid));
        const int ht = tid & 255, hw = (tid >> 6) & 3, lane = tid & 63, fr = lane & 15, fq = lane >> 4;
        const int it = it0 + rd * 2 + hb;
        const int b = it >> 10, h = (it >> 7) & 7, nc = it & 127;
        const size_t tokb = (size_t)b * SEQ + (size_t)nc * 64;
#pragma unroll
        for (int i = 0; i < 6; ++i) { const int idx = ht + 256 * i, s3 = idx >> 9, tap = (idx >> 7) & 3, ch = idx & 127; sCW[idx] = convw[tap * 3072 + s3 * 1024 + h * 128 + ch]; }
        __syncthreads();
        {
            const int t0 = (ht >> 4) * 4, cgp = ht & 15;
#pragma unroll 1
            for (int s = 0; s < 3; ++s) {
                const int col = s * 1024 + h * 128 + cgp * 8;
                u32x4 xr[7];
#pragma unroll
                for (int i = 0; i < 7; ++i) {
                    const int tt = t0 - 3 + i;
                    xr[i] = (u32x4){0u, 0u, 0u, 0u};
                    if (tt >= 0) xr[i] = *(const u32x4*)(QKV + (tokb + tt) * 3072 + col);
                    else if (nc > 0) xr[i] = *(const u32x4*)(HALO + ((size_t)(b * 128 + nc - 1) * 3 + (3 + tt)) * 3072 + col);
                }
                f32x4 w0[4], w1[4];
#pragma unroll
                for (int j = 0; j < 4; ++j) { w0[j] = *(const f32x4*)(sCW + s * 512 + j * 128 + cgp * 8); w1[j] = *(const f32x4*)(sCW + s * 512 + j * 128 + cgp * 8 + 4); }
                float o[4][8], ss[4];
#pragma unroll
                for (int tk = 0; tk < 4; ++tk) {
                    float a[8];
#pragma unroll
                    for (int e = 0; e < 8; ++e) a[e] = 0.f;
#pragma unroll
                    for (int j = 0; j < 4; ++j) {
                        const u32x4 xv = xr[tk + j];
                        a[0] += w0[j][0] * lo2f(xv.x); a[1] += w0[j][1] * hi2f(xv.x); a[2] += w0[j][2] * lo2f(xv.y); a[3] += w0[j][3] * hi2f(xv.y);
                        a[4] += w1[j][0] * lo2f(xv.z); a[5] += w1[j][1] * hi2f(xv.z); a[6] += w1[j][2] * lo2f(xv.w); a[7] += w1[j][3] * hi2f(xv.w);
                    }
                    float acc2 = 0.f;
#pragma unroll
                    for (int e = 0; e < 8; ++e) { const float v = siluf_(a[e]); o[tk][e] = v; acc2 += v * v; }
                    ss[tk] = acc2;
                }
                bf16_t* dst = (s == 0 ? sQ : (s == 1 ? sK : sV)) + t0 * 136 + cgp * 8;
#pragma unroll
                for (int tk = 0; tk < 4; ++tk) {
                    float sc = 1.0f;
                    if (s < 2) { float q = ss[tk]; q += __shfl_xor(q, 1); q += __shfl_xor(q, 2); q += __shfl_xor(q, 4); q += __shfl_xor(q, 8); sc = rsqrtf(q + 1e-6f) * (s == 0 ? 0.08838834764831845f : 1.0f); }
                    u32x4 pk;
                    pk.x = pk2(o[tk][0] * sc, o[tk][1] * sc); pk.y = pk2(o[tk][2] * sc, o[tk][3] * sc); pk.z = pk2(o[tk][4] * sc, o[tk][5] * sc); pk.w = pk2(o[tk][6] * sc, o[tk][7] * sc);
                    *(u32x4*)(dst + tk * 136) = pk;
                }
            }
        }
        if (hw == 0) {
            const size_t tg = tokb + lane;
            const float braw = BA[tg * 16 + h], araw = BA[tg * 16 + 8 + h];
            const float beta = 1.0f / (1.0f + expf(-braw));
            const float xx = araw + p.in[6][h];
            const float sp = xx > 20.f ? xx : log1pf(expf(xx));
            float gg = -expf(p.in[5][h]) * sp;
#pragma unroll
            for (int off = 1; off < 64; off <<= 1) { const float o = __shfl_up(gg, off); if (lane >= off) gg += o; }
            sBeta[lane] = beta; sGc[lane] = gg; sEg[lane] = expf(gg); sBE[lane] = beta * expf(gg);
            if (lane == 63) GL[it] = expf(gg);
        }
        __syncthreads();
        {
            bf16x8 aK[4], aQ[4];
#pragma unroll
            for (int ks = 0; ks < 4; ++ks) { aK[ks] = *(const bf16x8*)(sK + (16 * hw + fr) * 136 + 32 * ks + 8 * fq); aQ[ks] = *(const bf16x8*)(sQ + (16 * hw + fr) * 136 + 32 * ks + 8 * fq); }
#pragma unroll
            for (int nt = 0; nt < 4; ++nt) {
                f32x4 kk = (f32x4){0.f, 0.f, 0.f, 0.f}, qk = (f32x4){0.f, 0.f, 0.f, 0.f};
#pragma unroll
                for (int ks = 0; ks < 4; ++ks) {
                    const bf16x8 bK = *(const bf16x8*)(sK + (16 * nt + fr) * 136 + 32 * ks + 8 * fq);
                    kk = __builtin_amdgcn_mfma_f32_16x16x32_bf16(aK[ks], bK, kk, 0, 0, 0);
                    qk = __builtin_amdgcn_mfma_f32_16x16x32_bf16(aQ[ks], bK, qk, 0, 0, 0);
                }
                const int mcol = 16 * nt + fr; const float gm = sGc[mcol];
#pragma unroll
                for (int j = 0; j < 4; ++j) {
                    const int c = 16 * hw + 4 * fq + j;
                    const float dec = __expf(fminf(sGc[c] - gm, 0.f));
                    sL[c * 68 + mcol] = (mcol < c) ? kk[j] * sBeta[c] * dec : 0.f;
                    ATT[(size_t)it * 4096 + c * 64 + mcol] = f2bf((mcol <= c) ? qk[j] * dec : 0.f);
                }
            }
        }
        __syncthreads();
        {
            float x[64];
            const bool isU = ht < 128; const int jc = ht & 127;
            const bf16_t* src = isU ? sV : sK;
            const float* fac = isU ? sBeta : sBE;
#pragma unroll
            for (int cb = 0; cb < 16; ++cb) {
                float a[4];
#pragma unroll
                for (int r = 0; r < 4; ++r) a[r] = bf2f(src[(4 * cb + r) * 136 + jc]) * fac[4 * cb + r];
#pragma unroll
                for (int m4 = 0; m4 < cb; ++m4)
#pragma unroll
                    for (int r = 0; r < 4; ++r) {
                        const f32x4 l = *(const f32x4*)(sL + (4 * cb + r) * 68 + 4 * m4);
                        a[r] -= l[0] * x[4 * m4] + l[1] * x[4 * m4 + 1] + l[2] * x[4 * m4 + 2] + l[3] * x[4 * m4 + 3];
                    }
                const f32x4 d1 = *(const f32x4*)(sL + (4 * cb + 1) * 68 + 4 * cb), d2 = *(const f32x4*)(sL + (4 * cb + 2) * 68 + 4 * cb), d3 = *(const f32x4*)(sL + (4 * cb + 3) * 68 + 4 * cb);
                x[4 * cb] = a[0];
                x[4 * cb + 1] = a[1] - d1[0] * x[4 * cb];
                x[4 * cb + 2] = a[2] - d2[0] * x[4 * cb] - d2[1] * x[4 * cb + 1];
                x[4 * cb + 3] = a[3] - d3[0] * x[4 * cb] - d3[1] * x[4 * cb + 1] - d3[2] * x[4 * cb + 2];
            }
            if (isU) {
                const int w8 = jc >> 4, nn = jc & 15;
#pragma unroll
                for (int rq = 0; rq < 4; ++rq)
#pragma unroll
                    for (int pc = 0; pc < 2; ++pc) {
                        const int c0 = 32 * pc + 8 * rq;
                        u32x4 o; o.x = pk2(x[c0 + 0], x[c0 + 1]); o.y = pk2(x[c0 + 2], x[c0 + 3]); o.z = pk2(x[c0 + 4], x[c0 + 5]); o.w = pk2(x[c0 + 6], x[c0 + 7]);
                        const int L = ((w8 * 2 + pc) * 64 + rq * 16 + nn) * 8;
                        *(u32x4*)(QKV + (tokb + (L >> 7)) * 3072 + 2048 + h * 128 + (L & 127)) = o;
                    }
            }
            __syncthreads();
            if (!isU) {
                bf16_t* sW2 = (bf16_t*)sL;
#pragma unroll
                for (int c = 0; c < 64; ++c) sW2[c * 136 + jc] = f2bf(-x[c]);
            }
        }
        __syncthreads();
        {
            const bf16_t* sW2 = (const bf16_t*)sL;
#pragma unroll
            for (int i = 0; i < 4; ++i) { const int ch = ht + 256 * i, r = ch >> 4, c8 = (ch & 15) * 8; *(u32x4*)(WB + (size_t)it * 8192 + r * 128 + c8) = *(const u32x4*)(sW2 + r * 136 + c8); }
        }
        {
            const int c = ht >> 2, ds = (ht & 3) * 32; const float eg = sEg[c];
#pragma unroll
            for (int c8 = 0; c8 < 4; ++c8) {
                const u32x4 v = *(const u32x4*)(sQ + c * 136 + ds + c8 * 8); u32x4 o;
                o.x = pk2(lo2f(v.x) * eg, hi2f(v.x) * eg); o.y = pk2(lo2f(v.y) * eg, hi2f(v.y) * eg); o.z = pk2(lo2f(v.z) * eg, hi2f(v.z) * eg); o.w = pk2(lo2f(v.w) * eg, hi2f(v.w) * eg);
                *(u32x4*)(QKV + (tokb + c) * 3072 + h * 128 + ds + c8 * 8) = o;
            }
            const int d = ht >> 1, cs = (ht & 1) * 32; const float gl = sGc[63];
#pragma unroll
            for (int c8 = 0; c8 < 4; ++c8) {
                float v[8];
#pragma unroll
                for (int e = 0; e < 8; ++e) { const int cc = cs + c8 * 8 + e; v[e] = bf2f(sK[cc * 136 + d]) * __expf(gl - sGc[cc]); }
                u32x4 o; o.x = pk2(v[0], v[1]); o.y = pk2(v[2], v[3]); o.z = pk2(v[4], v[5]); o.w = pk2(v[6], v[7]);
                *(u32x4*)(QKV + (tokb + (d >> 1)) * 3072 + 1024 + h * 128 + (d & 1) * 64 + cs + c8 * 8) = o;
            }
        }
        __syncthreads();
    }
}

constexpr int SC_WQ = 32768, SC_KA = 24576, SC_KA0 = 3 * SC_WQ;
static_assert(SC_KA0 + 2 * SC_KA <= LDS_BYTES, "scan LDS layout");
__device__ __forceinline__ bf16x8 pack2(const f32x4& a, const f32x4& b) {
    u32x4 r; r.x = pk2(a[0], a[1]); r.y = pk2(a[2], a[3]); r.z = pk2(b[0], b[1]); r.w = pk2(b[2], b[3]); return __builtin_bit_cast(bf16x8, r);
}
#define MF16(a, b, c) __builtin_amdgcn_mfma_f32_16x16x32_bf16(a, b, c, 0, 0, 0)
#define DMA16(src, dst) __builtin_amdgcn_global_load_lds((const unsigned*)(src), (LAS unsigned*)(dst), 16, 0, 0)
__device__ __forceinline__ void phase_gdn_scan(const Prm& p, LAS unsigned char* lds, int blk) {
    const int tid = threadIdx.x, wv = __builtin_amdgcn_readfirstlane(tid >> 6), lane = tid & 63, n = lane & 15, kq = lane >> 4;
    const int bh = blk & 15, jh = blk >> 4, b = bh >> 3, h = bh & 7;
    const bf16_t* QKV = (const bf16_t*)(p.ws + OFF_QKV); const bf16_t* WB = (const bf16_t*)(p.ws + OFF_WB); const bf16_t* ATT = (const bf16_t*)(p.ws + OFF_ATT);
    const float* GL = (const float*)(p.ws + OFF_GL); bf16_t* O = (bf16_t*)(p.ws + OFF_H);
    const int itb = bh * 128;
    const bf16_t* qkv_b = QKV + (size_t)b * SEQ * 3072;
    if (wv >= 4) {
        const int lw = wv - 4;
        __builtin_amdgcn_s_setprio(3);
        unsigned oW[4], oQ[4], oK[4], oA[2];
#pragma unroll
        for (int i = 0; i < 4; ++i) {
            { const int q = lw * 4 + i, row = 4 * q + (lane >> 4), pg = lane & 15, g = pg ^ ((row & 3) | (((row >> 3) & 3) << 2)); oW[i] = (unsigned)(row * 128 + g * 8); oQ[i] = (unsigned)(row * 3072 + h * 128 + g * 8); }
            { const int q = lw * 4 + i, d = 8 * q + (lane >> 3), pg = lane & 7, g = pg ^ ((d & 3) | (((d >> 3) & 1) << 2)); oK[i] = (unsigned)((d >> 1) * 3072 + 1024 + h * 128 + (d & 1) * 64 + g * 8); }
        }
#pragma unroll
        for (int i = 0; i < 2; ++i) { const int q = lw * 2 + i, c = 8 * q + (lane >> 3), pg = lane & 7, g = pg ^ ((c & 3) | (((c >> 3) & 1) << 2)); oA[i] = (unsigned)(c * 64 + g * 8); }
#define ISSUE_WQ(ck, st) do { const bf16_t* wb_ = WB + (size_t)(itb + (ck)) * 8192; const bf16_t* qb_ = qkv_b + (size_t)(ck) * 64 * 3072; LAS unsigned char* d_ = lds + (st) * SC_WQ + lw * 4096; \
        _Pragma("unroll") for (int i = 0; i < 4; ++i) { DMA16(wb_ + oW[i], d_ + i * 1024); DMA16(qb_ + oQ[i], d_ + 16384 + i * 1024); } } while (0)
#define ISSUE_KA(ck, st) do { const bf16_t* qb_ = qkv_b + (size_t)(ck) * 64 * 3072; const bf16_t* ab_ = ATT + (size_t)(itb + (ck)) * 4096; LAS unsigned char* d_ = lds + SC_KA0 + (st) * SC_KA; \
        _Pragma("unroll") for (int i = 0; i < 4; ++i) DMA16(qb_ + oK[i], d_ + (lw * 4 + i) * 1024); \
        _Pragma("unroll") for (int i = 0; i < 2; ++i) DMA16(ab_ + oA[i], d_ + 16384 + (lw * 2 + i) * 1024); } while (0)
        ISSUE_WQ(0, 0); ISSUE_KA(0, 0); ISSUE_WQ(1, 1);
        asm volatile("s_waitcnt vmcnt(0)" ::: "memory"); __builtin_amdgcn_s_barrier(); asm volatile("" ::: "memory");
        int s3 = 2;
        for (int nc = 0; nc < 128; ++nc) {
            const int c1 = nc + 1 < 128 ? nc + 1 : 127, c2 = nc + 2 < 128 ? nc + 2 : 127;
            ISSUE_KA(c1, (nc + 1) & 1);
            ISSUE_WQ(c2, s3);
            s3 = s3 == 2 ? 0 : s3 + 1;
            asm volatile("s_waitcnt vmcnt(8)" ::: "memory");
            __builtin_amdgcn_s_barrier(); asm volatile("" ::: "memory");
        }
        asm volatile("s_waitcnt vmcnt(0)" ::: "memory");
        __builtin_amdgcn_s_setprio(0);
#undef ISSUE_WQ
#undef ISSUE_KA
    } else if (wv >= 2) {
        for (int nc = 0; nc < 129; ++nc) { __builtin_amdgcn_s_barrier(); asm volatile("" ::: "memory"); }
    } else {
        const float gl0 = GL[itb + lane], gl1 = GL[itb + 64 + lane];
        f32x4 S[8];
#pragma unroll
        for (int dt = 0; dt < 8; ++dt) S[dt] = (f32x4){0.f, 0.f, 0.f, 0.f};
        const int e = 32 * jh + 16 * wv + n;
        unsigned uo[2];
#pragma unroll
        for (int pc = 0; pc < 2; ++pc) { const int L = (((2 * jh + wv) * 2 + pc) * 64 + lane) * 8; uo[pc] = (unsigned)((L >> 7) * 3072 + 2048 + h * 128 + (L & 127)); }
        u32x4 ua[2], ub[2];
#pragma unroll
        for (int pc = 0; pc < 2; ++pc) { ua[pc] = *(const u32x4*)(qkv_b + uo[pc]); ub[pc] = *(const u32x4*)(qkv_b + (size_t)64 * 3072 + uo[pc]); }
        const int rowb = 8 * (n >> 2) + (n & 3), swk = (n & 3) | (((n >> 2) & 1) << 2);
        unsigned offW[4], offK[2];
#pragma unroll
        for (int ks = 0; ks < 4; ++ks) offW[ks] = (unsigned)(rowb * 256 + (((4 * ks + kq) ^ n) << 4));
#pragma unroll
        for (int k2 = 0; k2 < 2; ++k2) offK[k2] = (unsigned)(rowb * 128 + (((4 * k2 + kq) ^ swk) << 4));
        asm volatile("s_waitcnt lgkmcnt(0)" ::: "memory"); __builtin_amdgcn_s_barrier(); asm volatile("" ::: "memory");
        int s3 = 0;
        for (int nc = 0; nc < 128; ++nc) {
            const LAS unsigned char* sWQ = lds + s3 * SC_WQ; const LAS unsigned char* sKA = lds + SC_KA0 + (nc & 1) * SC_KA;
            s3 = s3 == 2 ? 0 : s3 + 1;
            const float gl = __builtin_bit_cast(float, __builtin_amdgcn_readlane(__builtin_bit_cast(int, nc < 64 ? gl0 : gl1), nc & 63));
            f32x4 V[4], Oa[4];
#pragma unroll
            for (int pc = 0; pc < 2; ++pc) {
                const u32x4 uu = ua[pc];
                V[2 * pc] = (f32x4){lo2f(uu.x), hi2f(uu.x), lo2f(uu.y), hi2f(uu.y)}; V[2 * pc + 1] = (f32x4){lo2f(uu.z), hi2f(uu.z), lo2f(uu.w), hi2f(uu.w)};
                ua[pc] = ub[pc];
            }
            { const int c2 = nc + 2 < 128 ? nc + 2 : 127; const bf16_t* ubase = qkv_b + (size_t)c2 * 64 * 3072;
#pragma unroll
              for (int pc = 0; pc < 2; ++pc) ub[pc] = *(const u32x4*)(ubase + uo[pc]); }
#pragma unroll
            for (int ct = 0; ct < 4; ++ct) Oa[ct] = (f32x4){0.f, 0.f, 0.f, 0.f};
            bf16x8 fa[2][8];
#define TOFF(t, pitch) ((32 * ((t) >> 1) + 4 * ((t) & 1)) * (pitch))
#define LD_WQ(dst, ks_) do { _Pragma("unroll") for (int mt = 0; mt < 4; ++mt) { dst[mt] = *(const LAS bf16x8*)(sWQ + offW[ks_] + TOFF(mt, 256)); dst[4 + mt] = *(const LAS bf16x8*)(sWQ + 16384 + offW[ks_] + TOFF(mt, 256)); } } while (0)
            LD_WQ(fa[0], 0);
#pragma unroll
            for (int ks = 0; ks < 4; ++ks) {
                if (ks < 3) LD_WQ(fa[(ks + 1) & 1], ks + 1);
                const bf16x8 sb8 = pack2(S[2 * ks], S[2 * ks + 1]);
                __builtin_amdgcn_sched_barrier(0);
#pragma unroll
                for (int mt = 0; mt < 4; ++mt) { V[mt] = MF16(fa[ks & 1][mt], sb8, V[mt]); Oa[mt] = MF16(fa[ks & 1][4 + mt], sb8, Oa[mt]); }
                __builtin_amdgcn_sched_barrier(0);
            }
#undef LD_WQ
            bf16x8 fb[2][12];
#define LD_AK(dst, k2_) do { _Pragma("unroll") for (int mt = 0; mt < 4; ++mt) dst[mt] = *(const LAS bf16x8*)(sKA + 16384 + offK[k2_] + TOFF(mt, 128)); \
                             _Pragma("unroll") for (int dt = 0; dt < 8; ++dt) dst[4 + dt] = *(const LAS bf16x8*)(sKA + offK[k2_] + TOFF(dt, 128)); } while (0)
            LD_AK(fb[0], 0);
            bf16x8 Vb[2];
            Vb[0] = pack2(V[0], V[1]); Vb[1] = pack2(V[2], V[3]);
#pragma unroll
            for (int dt = 0; dt < 8; ++dt) S[dt] *= gl;
#pragma unroll
            for (int k2 = 0; k2 < 2; ++k2) {
                if (k2 < 1) LD_AK(fb[1], 1);
                __builtin_amdgcn_sched_barrier(0);
#pragma unroll
                for (int mt = 0; mt < 4; ++mt) Oa[mt] = MF16(fb[k2][mt], Vb[k2], Oa[mt]);
#pragma unroll
                for (int dt = 0; dt < 8; ++dt) S[dt] = MF16(fb[k2][4 + dt], Vb[k2], S[dt]);
                __builtin_amdgcn_sched_barrier(0);
            }
#undef LD_AK
#undef TOFF
            bf16_t* obase = O + (size_t)(itb + nc) * 8192 + e * 64 + 8 * kq;
#pragma unroll
            for (int pc = 0; pc < 2; ++pc) *(u32x4*)(obase + 32 * pc) = pack8(Oa[2 * pc], Oa[2 * pc + 1]);
            asm volatile("s_waitcnt lgkmcnt(0)" ::: "memory"); __builtin_amdgcn_s_barrier(); asm volatile("" ::: "memory");
        }
    }
    __syncthreads();
}

__device__ __forceinline__ void phase_ya(const Prm& p, unsigned char* lds) {
    const bf16_t* OT = (const bf16_t*)(p.ws + OFF_H); bf16_t* SZA = (bf16_t*)p.out;
    const float* gw = p.in[7];
    bf16_t* sT = (bf16_t*)lds;
    float* sPart = (float*)(lds + 16384);
    const int tid = threadIdx.x, w = tid >> 6, c = tid & 63;
    for (int it = blockIdx.x; it < NIT; it += gridDim.x) {
        const int b = it >> 10, h = (it >> 7) & 7, nc = it & 127;
        const size_t tok = (size_t)b * SEQ + (size_t)nc * 64 + c;
#pragma unroll
        for (int i = 0; i < 2; ++i) { const int ch = tid + 512 * i; *(u32x4*)(sT + ch * 8) = *(const u32x4*)(OT + (size_t)it * 8192 + ch * 8); }
        const u32x4 z0 = *(const u32x4*)(SZA + tok * 1024 + h * 128 + 16 * w), z1 = *(const u32x4*)(SZA + tok * 1024 + h * 128 + 16 * w + 8);
        __syncthreads();
        float o[16]; float ss = 0.f;
#pragma unroll
        for (int j = 0; j < 16; ++j) { o[j] = bf2f(sT[(16 * w + j) * 64 + c]); ss += o[j] * o[j]; }
        sPart[w * 64 + c] = ss;
        __syncthreads();
        float tot = 0.f;
#pragma unroll
        for (int k = 0; k < 8; ++k) tot += sPart[k * 64 + c];
        const float rstd = rsqrtf(tot * (1.0f / 128.0f) + 1e-6f);
        const unsigned zz[8] = {z0.x, z0.y, z0.z, z0.w, z1.x, z1.y, z1.z, z1.w};
        unsigned r[8];
#pragma unroll
        for (int j = 0; j < 8; ++j)
            r[j] = pk2(o[2 * j] * rstd * gw[16 * w + 2 * j] * lo2f(zz[j]), o[2 * j + 1] * rstd * gw[16 * w + 2 * j + 1] * hi2f(zz[j]));
        *(u32x4*)(SZA + tok * 1024 + h * 128 + 16 * w) = (u32x4){r[0], r[1], r[2], r[3]};
        *(u32x4*)(SZA + tok * 1024 + h * 128 + 16 * w + 8) = (u32x4){r[4], r[5], r[6], r[7]};
        __syncthreads();
    }
}
__device__ __forceinline__ void phase_conv3(const Prm& p) {
    const bf16_t* P = (const bf16_t*)(p.ws + OFF_P); bf16_t* Q = (bf16_t*)(p.ws + OFF_Q); const float* cw = p.in[19];
    const int nth = gridDim.x * 512;
    for (int idx = blockIdx.x * 512 + threadIdx.x; idx < (TOK / 4) * 256; idx += nth) {
        const int t0 = (idx >> 8) * 4, c8 = (idx & 255) * 8;
        const bool first = (t0 & (SEQ - 1)) == 0;
        u32x4 pr[6], qr[4];
#pragma unroll
        for (int i = 0; i < 6; ++i) pr[i] = (i < 2 && first) ? (u32x4){0u, 0u, 0u, 0u} : *(const u32x4*)(P + (size_t)(t0 - 2 + i) * 2048 + c8);
#pragma unroll
        for (int i = 0; i < 4; ++i) qr[i] = *(const u32x4*)(Q + (size_t)(t0 + i) * 2048 + c8);
        float w0[8], w1[8], w2[8];
#pragma unroll
        for (int e = 0; e < 8; ++e) { w0[e] = cw[c8 + e]; w1[e] = cw[2048 + c8 + e]; w2[e] = cw[4096 + c8 + e]; }
#pragma unroll
        for (int i = 0; i < 4; ++i) {
            const unsigned pa[4] = {pr[i + 2].x, pr[i + 2].y, pr[i + 2].z, pr[i + 2].w}, pb[4] = {pr[i + 1].x, pr[i + 1].y, pr[i + 1].z, pr[i + 1].w}, pc[4] = {pr[i].x, pr[i].y, pr[i].z, pr[i].w};
            const unsigned qa[4] = {qr[i].x, qr[i].y, qr[i].z, qr[i].w};
            unsigned o[4];
#pragma unroll
            for (int e = 0; e < 4; ++e)
                o[e] = pk2(lo2f(qa[e]) * (w0[2 * e] * lo2f(pc[e]) + w1[2 * e] * lo2f(pb[e]) + w2[2 * e] * lo2f(pa[e])),
                           hi2f(qa[e]) * (w0[2 * e + 1] * hi2f(pc[e]) + w1[2 * e + 1] * hi2f(pb[e]) + w2[2 * e + 1] * hi2f(pa[e])));
            *(u32x4*)(Q + (size_t)(t0 + i) * 2048 + c8) = (u32x4){o[0], o[1], o[2], o[3]};
        }
    }
}

#define XB_TMO      128
#define XB_XCNT(j)  (256  + 64 * (j))
#define XB_XSUB(j)  (1280 + 64 * (j))
#define XB_XGEN(j)  (2304 + 64 * (j))
#define XB_TOP      3328
#define XB_TOPGEN   3392
#define XCD_BAR_WORDS 3456
#define XB_SPIN_CAP (1u << 18)

__device__ __forceinline__ unsigned xb_ld(unsigned* p)              { return __hip_atomic_load(p, __ATOMIC_RELAXED, __HIP_MEMORY_SCOPE_AGENT); }
__device__ __forceinline__ unsigned xb_add(unsigned* p, unsigned v) { return __hip_atomic_fetch_add(p, v, __ATOMIC_RELAXED, __HIP_MEMORY_SCOPE_AGENT); }
__device__ __forceinline__ unsigned xb_xcc_id() { return (unsigned)__builtin_amdgcn_s_getreg((3 << 11) | 20) & 0xFu; }
#define XB_SPIN(cond, bar) do { unsigned _sp = 0; while (cond) { __builtin_amdgcn_s_sleep(1); \
    if ((++_sp & 255u) == 0u) { if (xb_ld(&(bar)[XB_TMO])) break; if (_sp > XB_SPIN_CAP) { atomicAdd(&(bar)[XB_TMO], 1u); break; } } } } while (0)

struct XcdBarrier {
    unsigned* bar; unsigned x;
    volatile LAS unsigned* st;
};

__device__ __forceinline__ XcdBarrier xcd_barrier_post(unsigned* bar, volatile LAS unsigned* st) {
    XcdBarrier b; b.bar = bar; b.x = xb_xcc_id(); b.st = st;
    if (threadIdx.x == 0) (void)xb_add(&bar[XB_XCNT(b.x)], 1u);
    return b;
}
__device__ __forceinline__ void xcd_barrier_complete(unsigned* bar, unsigned x, unsigned& nloc, unsigned& nx) {
    const unsigned G = gridDim.x * gridDim.y * gridDim.z;
    unsigned sum, cnt, mine, sp = 0u;
    for (;;) {
        sum = 0u; cnt = 0u; mine = 0u;
#pragma unroll
        for (unsigned j = 0; j < 16; ++j) { const unsigned c = xb_ld(&bar[XB_XCNT(j)]); sum += c; cnt += (c > 0u) ? 1u : 0u; mine = (j == x) ? c : mine; }
        if (sum == G) break;
        __builtin_amdgcn_s_sleep(1);
        if ((++sp & 255u) == 0u) { if (xb_ld(&bar[XB_TMO])) break; if (sp > XB_SPIN_CAP) { atomicAdd(&bar[XB_TMO], 1u); break; } }
    }
    nloc = mine > 0u ? mine : 1u; nx = cnt > 0u ? cnt : 1u;
}

__device__ __forceinline__ void xcd_barrier(const XcdBarrier& b) {
    asm volatile("s_waitcnt vmcnt(0)" ::: "memory");
    __syncthreads();
    if (threadIdx.x == 0) {
        unsigned* bar = b.bar;
        __builtin_amdgcn_s_waitcnt(0);
        unsigned nloc = b.st[0], nx = b.st[1];
        if (nloc == 0u) { xcd_barrier_complete(bar, b.x, nloc, nx); b.st[0] = nloc; b.st[1] = nx; }
        const unsigned old = xb_add(&bar[XB_XSUB(b.x)], 1u);
        const unsigned gen = old / nloc;
        if (old + 1u == (gen + 1u) * nloc) {
            __builtin_amdgcn_fence(__ATOMIC_RELEASE, "agent");
            asm volatile("s_waitcnt vmcnt(0)" ::: "memory");
            const unsigned og = xb_add(&bar[XB_TOP], 1u);
            const unsigned tg = og / nx;
            if (og + 1u == (tg + 1u) * nx) xb_add(&bar[XB_TOPGEN], 1u);
            else XB_SPIN(xb_ld(&bar[XB_TOPGEN]) == tg, bar);
            __builtin_amdgcn_fence(__ATOMIC_ACQUIRE, "agent");
            xb_add(&bar[XB_XGEN(b.x)], 1u);
            asm volatile("s_waitcnt vmcnt(0)" ::: "memory");
        } else {
            XB_SPIN(xb_ld(&bar[XB_XGEN(b.x)]) == gen, bar);
            __builtin_amdgcn_fence(__ATOMIC_ACQUIRE, "agent");
            asm volatile("s_waitcnt vmcnt(0)" ::: "memory");
        }
    }
    __syncthreads();
}

constexpr int NPHASE = 11;
#define REP_GEMM 1
#define REP_SYNC 1
#define REP_SCAN 1
#define SCAN_PROBE 1
#define REP_P0 1
#ifndef PHM
#define PHM 0x7FF
#endif
__global__ void __launch_bounds__(512, 2) mega(Prm p) {
    extern __shared__ __attribute__((aligned(16))) unsigned char shm[];
    LAS unsigned char* lds3 = (LAS unsigned char*)shm;
    unsigned char* ws = p.ws;
    volatile LAS unsigned* xst = (volatile LAS unsigned*)(lds3 + LDS_BYTES);
    if (threadIdx.x == 0) { xst[0] = 0u; xst[1] = 0u; }
    __syncthreads();
    XcdBarrier xb{};
    const bool multi = (p.ph_hi - p.ph_lo) > 1;
    if (multi) xb = xcd_barrier_post((unsigned*)(ws + OFF_BAR), xst);
    if (p.ph_lo < 0) cg::this_grid().sync();
#define PH_BEGIN(i) if (((PHM >> (i)) & 1) && p.ph_lo <= (i) && (i) < p.ph_hi) { if ((i) > p.ph_lo) { xcd_barrier(xb); if (REP_SYNC > 1) xcd_barrier(xb); } pg8::StaticOrder S; (void)S;
#define PH_END }
    PH_BEGIN(0)
        for (int rep = 0; rep < REP_P0; ++rep) {
        phase_convert(p, shm, 0, 1856, gridDim.x, blockIdx.x);
        phase_rmsnorm_x(p.in[0], p.in[1], (bf16_t*)(ws + OFF_H)); __syncthreads(); }
    PH_END
    PH_BEGIN(1)
        pg8::Gemm g{(const bf16_t*)(ws + OFF_H), (const bf16_t*)(ws + OFF_WT1), TOK, NP1, 1024, (const bf16_t*)(ws + OFF_H), 1024, 64};
        Epi1 E{(bf16_t*)(ws + OFF_QKV), (bf16_t*)p.out, (bf16_t*)(ws + OFF_UU), (bf16_t*)p.out + (size_t)TOK * 1024, (float*)(ws + OFF_BA), (bf16_t*)(ws + OFF_HALO)};
        S.init(TOK, NP1, gridDim.x, blockIdx.x); for (int rep = 0; rep < REP_GEMM; ++rep) { pg8::gemm_phase(lds3, g, S, E); __syncthreads(); }
    PH_END
    PH_BEGIN(2)
        {
            unsigned* ctr = (unsigned*)(ws + OFF_BAR) + 3600;
            volatile LAS unsigned* sIt = xst + 2;
            for (;;) {
                if (threadIdx.x == 0) sIt[0] = __hip_atomic_fetch_add(ctr, 2u, __ATOMIC_RELAXED, __HIP_MEMORY_SCOPE_AGENT);
                __syncthreads();
                const unsigned it0 = sIt[0];
                __syncthreads();
                if (it0 >= (unsigned)NIT) break;
                phase_gdn_prep(p, shm, (int)it0, 1);
            }
        }
    PH_END
    PH_BEGIN(3)
        if (blockIdx.x < 64) phase_gdn_scan(p, lds3, blockIdx.x);
        else {
            const int ob = blockIdx.x - 64, nob = gridDim.x - 64;
            if (ob < 128) phase_s5(p, shm, ob);
            {
                unsigned* cnt = (unsigned*)(ws + OFF_BAR) + 3700;
                asm volatile("s_waitcnt vmcnt(0)" ::: "memory");
                __syncthreads();
                if (threadIdx.x == 0) {
                    __builtin_amdgcn_fence(__ATOMIC_RELEASE, "agent");
                    asm volatile("s_waitcnt vmcnt(0)" ::: "memory");
                    __hip_atomic_fetch_add(cnt, 1u, __ATOMIC_RELAXED, __HIP_MEMORY_SCOPE_AGENT);
                    unsigned sp = 0;
                    while (__hip_atomic_load(cnt, __ATOMIC_RELAXED, __HIP_MEMORY_SCOPE_AGENT) < (unsigned)nob) { __builtin_amdgcn_s_sleep(2); if (++sp > (1u << 22)) break; }
                    __builtin_amdgcn_fence(__ATOMIC_ACQUIRE, "agent");
                    asm volatile("s_waitcnt vmcnt(0)" ::: "memory");
                }
                __syncthreads();
            }
            pg8::Gemm g{(const bf16_t*)(ws + OFF_UU), (const bf16_t*)(ws + OFF_WTG), TOK, 1024, 1024, (const bf16_t*)(ws + OFF_UU), 1024, 64};
            EpiGlu E{(const bf16_t*)(ws + OFF_UU), (bf16_t*)p.out + (size_t)TOK * 1024};
            S.init(TOK, 1024, nob, ob); pg8::gemm_phase(lds3, g, S, E);
            __syncthreads();
            if (ob >= 64) phase_convert(p, shm, 1856, 4928, nob - 64, ob - 64);
        }
    PH_END
    PH_BEGIN(4)
        phase_ya(p, shm);
    PH_END
    PH_BEGIN(5)
        pg8::Gemm g{(const bf16_t*)p.out, (const bf16_t*)(ws + OFF_WTO0), TOK, 1024, 2048, (const bf16_t*)p.out + (size_t)TOK * 1024, 1024, 16};
        EpiB16 E{(bf16_t*)(ws + OFF_QKV)};
        S.init(TOK, 1024, gridDim.x, blockIdx.x); for (int rep = 0; rep < REP_GEMM; ++rep) { pg8::gemm_phase(lds3, g, S, E); __syncthreads(); }
    PH_END
    PH_BEGIN(6)
        phase_post<true>(p.in[0], (const bf16_t*)(ws + OFF_QKV), p.in[2], p.out, p.in[1] + 1024, (bf16_t*)(ws + OFF_H));
    PH_END
    PH_BEGIN(7)
        pg8::Gemm g{(const bf16_t*)(ws + OFF_H), (const bf16_t*)(ws + OFF_WT2), TOK, 8192, 1024, (const bf16_t*)(ws + OFF_H), 1024, 64};
        Epi2 E{(bf16_t*)(ws + OFF_P), (bf16_t*)(ws + OFF_Q)};
        S.init(TOK, 8192, gridDim.x, blockIdx.x); for (int rep = 0; rep < REP_GEMM; ++rep) { pg8::gemm_phase(lds3, g, S, E); __syncthreads(); }
    PH_END
    PH_BEGIN(8)
        phase_conv3(p);
    PH_END
    PH_BEGIN(9)
        pg8::Gemm g{(const bf16_t*)(ws + OFF_Q), (const bf16_t*)(ws + OFF_WTO1), TOK, 1024, 2048, (const bf16_t*)(ws + OFF_Q), 2048, 64};
        EpiB16 E{(bf16_t*)(ws + OFF_P)};
        S.init(TOK, 1024, gridDim.x, blockIdx.x); for (int rep = 0; rep < REP_GEMM; ++rep) { pg8::gemm_phase(lds3, g, S, E); __syncthreads(); }
    PH_END
    PH_BEGIN(10)
        phase_post<false>(p.out, (const bf16_t*)(ws + OFF_P), p.in[2] + 1024, p.out, nullptr, nullptr);
    PH_END
}

#ifndef N_LAUNCH_MODE
#define N_LAUNCH_MODE 1
#endif

extern "C" void kernel_launch(void* const* d_in, const int* in_sizes, int n_in, void* d_out, int out_size, void* d_ws, size_t ws_size, hipStream_t stream) {
    static int ready = 0;
    if (!ready) {
        if (n_in != 21 || ws_size < WS_END || out_size != TOK * DM) { fprintf(stderr, "kernel_launch: unexpected shapes (n_in %d ws %zu out %d)\n", n_in, ws_size, out_size); ready = -1; return; }
        if (hipFuncSetAttribute((const void*)mega, hipFuncAttributeMaxDynamicSharedMemorySize, LDS_BYTES + 16) != hipSuccess) { fprintf(stderr, "kernel_launch: hipFuncSetAttribute failed\n"); ready = -1; return; }
        ready = 1;
    }
    if (ready < 0) return;
    Prm p{};
    for (int i = 0; i < 21; ++i) p.in[i] = (const float*)d_in[i];
    p.out = (float*)d_out; p.ws = (unsigned char*)d_ws;
#if N_LAUNCH_MODE == 1
    p.ph_lo = 0; p.ph_hi = NPHASE;
    void* args[] = {&p};
    if (hipMemsetAsync((unsigned char*)d_ws + OFF_BAR, 0, 16384, stream) != hipSuccess) { fprintf(stderr, "memset failed\n"); return; }
    hipError_t e = hipLaunchCooperativeKernel((const void*)mega, dim3(256), dim3(512), args, LDS_BYTES + 16, stream);
    if (e != hipSuccess) fprintf(stderr, "cooperative launch failed: %s\n", hipGetErrorString(e));
#else
    for (int ph = 0; ph < NPHASE; ++ph) {
        p.ph_lo = ph; p.ph_hi = ph + 1;
        hipLaunchKernelGGL(mega, dim3(256), dim3(512), LDS_BYTES + 16, stream, p);
    }
#endif
}
```

```cpp
#include <hip/hip_runtime.h>
#include <hip/hip_cooperative_groups.h>
#include <cstdio>
namespace cg = cooperative_groups;

#define LAS __attribute__((address_space(3)))
typedef unsigned short bf16_t;
typedef short bf16x8 __attribute__((ext_vector_type(8)));
typedef float f32x4 __attribute__((ext_vector_type(4)));
typedef float f32x16 __attribute__((ext_vector_type(16)));
typedef unsigned u32x4 __attribute__((ext_vector_type(4)));
typedef unsigned u32x2 __attribute__((ext_vector_type(2)));

constexpr int TOK = 16384, DM = 1024, SEQ = 8192;
constexpr int NP1 = 6400;
constexpr int NIT = 2048;

constexpr size_t OFF_WT1 = 0;
constexpr size_t OFF_WTG = OFF_WT1 + (size_t)NP1 * 1024 * 2;
constexpr size_t OFF_WTO0 = OFF_WTG + (size_t)1024 * 1024 * 2;
constexpr size_t OFF_WT2 = OFF_WTO0 + (size_t)1024 * 2048 * 2;
constexpr size_t OFF_WTO1 = OFF_WT2 + (size_t)8192 * 1024 * 2;
constexpr size_t OFF_H = OFF_WTO1 + (size_t)1024 * 2048 * 2;
constexpr size_t OFF_QKV = OFF_H + (size_t)TOK * 1024 * 2;
constexpr size_t OFF_UU = OFF_QKV + (size_t)TOK * 3072 * 2;
constexpr size_t OFF_WB = OFF_UU + (size_t)TOK * 1024 * 2;
constexpr size_t OFF_ATT = OFF_WB + (size_t)NIT * 8192 * 2;
constexpr size_t OFF_HALO = OFF_ATT + (size_t)NIT * 4096 * 2;
constexpr size_t OFF_BA = OFF_HALO + (size_t)256 * 3 * 3072 * 2;
constexpr size_t OFF_GL = OFF_BA + (size_t)TOK * 16 * 4;
constexpr size_t OFF_BAR = OFF_GL + (size_t)NIT * 4;
constexpr size_t WS_END = OFF_BAR + 16384;
constexpr size_t OFF_YMIX = OFF_QKV;
constexpr size_t OFF_P = OFF_QKV;
constexpr size_t OFF_Q = OFF_QKV + (size_t)TOK * 2048 * 2;
static_assert(OFF_Q + (size_t)TOK * 2048 * 2 <= OFF_WB, "Q overlaps live data");
static_assert(WS_END <= (size_t)256 * 1024 * 1024, "workspace too big");

constexpr int LDS_BYTES = 157696;

struct Prm {
    const float* in[21];
    float* out;
    unsigned char* ws;
    int ph_lo, ph_hi;
};

__device__ __forceinline__ float bf2f(bf16_t b) { return __uint_as_float(((unsigned)b) << 16); }
__device__ __forceinline__ bf16_t f2bf(float f) { unsigned u = __float_as_uint(f); u += 0x7FFFu + ((u >> 16) & 1u); return (bf16_t)(u >> 16); }
typedef __bf16 bf16v2_t __attribute__((ext_vector_type(2)));
typedef float f32x2_t __attribute__((ext_vector_type(2)));
__device__ __forceinline__ unsigned pk2(float lo, float hi) { const f32x2_t v = {lo, hi}; return __builtin_bit_cast(unsigned, __builtin_convertvector(v, bf16v2_t)); }
__device__ __forceinline__ float lo2f(unsigned u) { return __uint_as_float(u << 16); }
__device__ __forceinline__ float hi2f(unsigned u) { return __uint_as_float(u & 0xFFFF0000u); }
__device__ __forceinline__ float sigmoidf_(float x) { return 1.0f / (1.0f + __expf(-x)); }
__device__ __forceinline__ float siluf_(float x) { return x / (1.0f + __expf(-x)); }
__device__ __forceinline__ float wave_sum(float v) {
#pragma unroll
    for (int o = 32; o >= 1; o >>= 1) v += __shfl_xor(v, o);
    return v;
}
__device__ __forceinline__ u32x4 pack8(f32x4 a, f32x4 b) { u32x4 r; r.x = pk2(a[0], a[1]); r.y = pk2(a[2], a[3]); r.z = pk2(b[0], b[1]); r.w = pk2(b[2], b[3]); return r; }

namespace pg8 {
constexpr int BM = 256, BK = 64, HALF = 128, HTB = HALF * BK * 2, STAGE_BYTES = 8 * HTB, NXCD = 8, WGM = 8;
__device__ __forceinline__ int lds_byte(int r, int c) { const int st = (r >> 4) * 2 + (c >> 5), rr = r & 15, cc = c & 31, ob = rr * 64 + cc * 2; return st * 1024 + (ob ^ (((ob >> 9) & 1) << 5)); }
__device__ __forceinline__ void stage_rc(int b, int& R, int& C) { const int st = b / 1024, sb = b % 1024, swz = sb ^ (((sb >> 9) & 1) << 5); R = (st >> 1) * 16 + swz / 64; C = (st & 1) * 32 + (swz % 64) / 2; }
__device__ __forceinline__ int perm32(int rho) { const int n = rho >> 4, i = rho & 15; return 8 * (i >> 2) + 4 * n + (i & 3); }
struct Unit { int pm, pn; };
struct Gemm { const bf16_t* A; const bf16_t* Bt; int M, N, K; const bf16_t* A2; int lda, ks; };
struct StaticOrder {
    int nM, nN, nwg, G, c;
    __device__ void init(int M, int N, int G_, int c_) { nM = M / BM; nN = N / BM; nwg = nM * nN; G = G_; c = c_; }
    __device__ bool next(int i, Unit& u) const {
        const long L = (long)i * G + c; if (L >= nwg) return false;
        int wgid = (int)L; { const int q = nwg / NXCD, r = nwg % NXCD, xcd = wgid % NXCD, off = wgid / NXCD; wgid = (xcd < r ? xcd * (q + 1) : r * (q + 1) + (xcd - r) * q) + off; }
        const int nig = WGM * nN, gid = wgid / nig, fm = gid * WGM, gsz = (nM - fm) < WGM ? (nM - fm) : WGM;
        u.pm = fm + ((wgid % nig) % gsz); u.pn = (wgid % nig) / gsz; return true;
    }
};

template <class Epi>
__device__ __forceinline__ void gemm_phase(LAS unsigned char* lds, const Gemm g, const StaticOrder& S, const Epi& E) {
    const int tid = threadIdx.x, wid = __builtin_amdgcn_readfirstlane(tid >> 6), lane = tid & 63, wr = wid >> 2, wc = wid & 3, fr = lane & 15, fq = lane >> 4;
    const int K = g.K, nt = K / BK;
    unsigned voffA[2], voffB[2];
#pragma unroll
    for (int i = 0; i < 2; ++i) { int R, C; stage_rc(tid * 16 + i * 8192, R, C); const int Rb = Epi::PERM ? ((R & ~31) + perm32(R & 31)) : R;
        voffA[i] = (unsigned)(R * g.lda + C) * 2u; voffB[i] = (unsigned)(Rb * K + C) * 2u; }
    const size_t kstep = (size_t)(BK * 2);
    const size_t hstep = (size_t)HALF * K * 2;
    const size_t tstep = 2 * hstep;
    const size_t hstepA = (size_t)HALF * g.lda * 2, tstepA = 2 * hstepA;
    const int ks = g.ks; const ptrdiff_t a2off = (const char*)g.A2 - (const char*)g.A - (ptrdiff_t)ks * (ptrdiff_t)kstep;
    const unsigned ldsw = (unsigned)wid * 1024u;
    const int aoff = lds_byte(wr * 64 + fr, fq * 8), boff = lds_byte(wc * 32 + fr, fq * 8);
#define PG8_SA(b, h) (((b) * 2 + (h)) * HTB)
#define PG8_SB(b, h) ((4 + (b) * 2 + (h)) * HTB)
#define PG8_STAGE(bufoff, gbase, voff) do { _Pragma("unroll") for (int _i = 0; _i < 2; ++_i) \
        __builtin_amdgcn_global_load_lds((const unsigned*)((const char*)(gbase) + (voff)[_i]), (LAS unsigned*)(lds + (bufoff) + ldsw + _i * 8192), 16, 0, 0); } while (0)
#define PG8_LDA(dst, b, h) do { _Pragma("unroll") for (int m = 0; m < 4; ++m) _Pragma("unroll") for (int k = 0; k < 2; ++k) dst[m][k] = *(const LAS bf16x8*)(lds + PG8_SA(b, h) + aoff + m * 2048 + k * 1024); } while (0)
#define PG8_LDB(dst, b, h) do { _Pragma("unroll") for (int n = 0; n < 2; ++n) _Pragma("unroll") for (int k = 0; k < 2; ++k) dst[n][k] = *(const LAS bf16x8*)(lds + PG8_SB(b, h) + boff + n * 2048 + k * 1024); } while (0)
#define PG8_MMA(ai, bj, At, Bt) do { __builtin_amdgcn_s_setprio(1); _Pragma("unroll") for (int m = 0; m < 4; ++m) _Pragma("unroll") for (int n = 0; n < 2; ++n) _Pragma("unroll") for (int k = 0; k < 2; ++k) \
        acc[ai][bj][m][n] = __builtin_amdgcn_mfma_f32_16x16x32_bf16(Bt[n][k], At[m][k], acc[ai][bj][m][n], 0, 0, 0); __builtin_amdgcn_s_setprio(0); } while (0)
#define PG8_WAIT_V(n) asm volatile("s_waitcnt vmcnt(" #n ")" ::: "memory")
#define PG8_WAIT_L(n) asm volatile("s_waitcnt lgkmcnt(" #n ")" ::: "memory")
#define PG8_BAR __builtin_amdgcn_s_barrier()
#define PG8_SCHED __builtin_amdgcn_sched_barrier(0)
    Unit cur, nxt; int ui = 0;
    if (!S.next(0, cur)) return;
    f32x4 acc[2][2][4][2];
#pragma unroll
    for (int a = 0; a < 2; ++a)
#pragma unroll
        for (int b = 0; b < 2; ++b)
#pragma unroll
            for (int m = 0; m < 4; ++m)
#pragma unroll
                for (int n = 0; n < 2; ++n) acc[a][b][m][n] = (f32x4){0.f, 0.f, 0.f, 0.f};
    bf16x8 At[4][2], B0[2][2], B1[2][2];
    const char* cA = (const char*)g.A + (size_t)cur.pm * tstepA; const char* cB = (const char*)g.Bt + (size_t)cur.pn * tstep;
    PG8_STAGE(PG8_SB(0, 0), cB, voffB); PG8_STAGE(PG8_SA(0, 0), cA, voffA); PG8_STAGE(PG8_SB(0, 1), cB + hstep, voffB); PG8_STAGE(PG8_SA(0, 1), cA + hstepA, voffA);
    if (wr == 1) PG8_BAR;
    PG8_WAIT_V(4); PG8_BAR;
    PG8_STAGE(PG8_SB(1, 0), cB + kstep, voffB); PG8_STAGE(PG8_SA(1, 0), cA + kstep, voffA); PG8_STAGE(PG8_SB(1, 1), cB + hstep + kstep, voffB);
    PG8_WAIT_V(6); PG8_BAR;
    for (;;) {
        const bool has_next = S.next(ui + 1, nxt);
        const char* nA = has_next ? (const char*)g.A + (size_t)nxt.pm * tstepA : cA; const char* nB = has_next ? (const char*)g.Bt + (size_t)nxt.pn * tstep : cB;
        for (int t = 0; t < nt; t += 2) {
            const bool last = (t == nt - 2);
            const char* a1 = cA + (size_t)(t + 1) * kstep + ((t + 1) >= ks ? a2off : 0);
            const char* a2 = last ? nA : cA + (size_t)(t + 2) * kstep + ((t + 2) >= ks ? a2off : 0); const char* b2 = last ? nB : cB + (size_t)(t + 2) * kstep;
            const char* a3 = last ? nA + kstep : cA + (size_t)(t + 3) * kstep + ((t + 3) >= ks ? a2off : 0); const char* b3 = b2 + kstep;
            PG8_LDB(B0, 0, 0); PG8_SCHED; PG8_LDA(At, 0, 0); PG8_STAGE(PG8_SA(1, 1), a1 + hstepA, voffA);
            PG8_WAIT_L(8); PG8_BAR; PG8_WAIT_L(0); PG8_MMA(0, 0, At, B0); PG8_BAR; PG8_SCHED;
            PG8_LDB(B1, 0, 1); PG8_STAGE(PG8_SB(0, 0), b2, voffB);
            PG8_BAR; PG8_WAIT_L(0); PG8_MMA(0, 1, At, B1); PG8_BAR;
            PG8_LDA(At, 0, 1); PG8_STAGE(PG8_SA(0, 0), a2, voffA);
            PG8_BAR; PG8_WAIT_L(0); PG8_MMA(1, 0, At, B0); PG8_BAR; PG8_SCHED;
            PG8_STAGE(PG8_SB(0, 1), b2 + hstep, voffB);
            PG8_WAIT_V(6); PG8_BAR; PG8_MMA(1, 1, At, B1); PG8_BAR;
            PG8_LDB(B0, 1, 0); PG8_SCHED; PG8_LDA(At, 1, 0); PG8_STAGE(PG8_SA(0, 1), a2 + hstepA, voffA);
            PG8_WAIT_L(8); PG8_BAR; PG8_WAIT_L(0); PG8_MMA(0, 0, At, B0); PG8_BAR; PG8_SCHED;
            PG8_LDB(B1, 1, 1); PG8_STAGE(PG8_SB(1, 0), b3, voffB);
            PG8_BAR; PG8_WAIT_L(0); PG8_MMA(0, 1, At, B1); PG8_BAR;
            PG8_LDA(At, 1, 1); PG8_STAGE(PG8_SA(1, 0), a3, voffA);
            PG8_BAR; PG8_WAIT_L(0); PG8_MMA(1, 0, At, B0); PG8_BAR; PG8_SCHED;
            PG8_STAGE(PG8_SB(1, 1), b3 + hstep, voffB);
            PG8_WAIT_V(6); PG8_BAR; PG8_MMA(1, 1, At, B1); PG8_BAR;
        }
        E(acc, cur, wr, wc, fr, fq);
        if (!has_next) break;
#pragma unroll
        for (int a = 0; a < 2; ++a)
#pragma unroll
            for (int b = 0; b < 2; ++b)
#pragma unroll
                for (int m = 0; m < 4; ++m)
#pragma unroll
                    for (int n = 0; n < 2; ++n) acc[a][b][m][n] = (f32x4){0.f, 0.f, 0.f, 0.f};
        cur = nxt; cA = nA; cB = nB; ++ui;
    }
    PG8_WAIT_V(0);
    if (wr == 0) PG8_BAR;
    PG8_BAR;
#undef PG8_SA
#undef PG8_SB
#undef PG8_STAGE
#undef PG8_LDA
#undef PG8_LDB
#undef PG8_MMA
#undef PG8_WAIT_V
#undef PG8_WAIT_L
#undef PG8_BAR
#undef PG8_SCHED
}
}
using pg8::Unit;

struct Epi1 {
    static constexpr bool PERM = true;
    bf16_t* QKV; bf16_t* SZA; bf16_t* UU; bf16_t* SZB; float* BA; bf16_t* HALO;
    __device__ __forceinline__ void operator()(const f32x4 (&acc)[2][2][4][2], const Unit& u, int wr, int wc, int fr_, int fq_) const {
        int lane = (int)(threadIdx.x & 63); asm volatile("" : "+v"(lane));
        const int fr = lane & 15, fq = lane >> 4; (void)fr_; (void)fq_;
        const int row0 = u.pm * 256 + wr * 64 + fr, pn = u.pn;
#pragma unroll
        for (int ai = 0; ai < 2; ++ai)
#pragma unroll
            for (int m = 0; m < 4; ++m) {
                const size_t row = (size_t)(row0 + ai * 128 + m * 16);
#pragma unroll
                for (int bj = 0; bj < 2; ++bj) {
                    const int colt = 128 * bj + 32 * wc + 8 * fq;
                    f32x4 v0 = acc[ai][bj][m][0], v1 = acc[ai][bj][m][1];
                    if (pn < 12) {
                        const int c = pn * 256 + colt; const u32x4 pk = pack8(v0, v1);
                        *(u32x4*)(QKV + row * 3072 + c) = pk;
                        if (m == 3 && fr >= 13) *(u32x4*)(HALO + ((row >> 6) * 3 + (fr - 13)) * 3072 + c) = pk;
                    } else if (pn < 16) {
#pragma unroll
                        for (int e = 0; e < 4; ++e) { v0[e] = siluf_(v0[e]); v1[e] = siluf_(v1[e]); }
                        *(u32x4*)(SZA + row * 1024 + (pn - 12) * 256 + colt) = pack8(v0, v1);
                    } else if (pn < 20) {
                        *(u32x4*)(UU + row * 1024 + (pn - 16) * 256 + colt) = pack8(v0, v1);
                    } else if (pn < 24) {
#pragma unroll
                        for (int e = 0; e < 4; ++e) { v0[e] = siluf_(v0[e]); v1[e] = siluf_(v1[e]); }
                        *(u32x4*)(SZB + row * 1024 + (pn - 20) * 256 + colt) = pack8(v0, v1);
                    } else if (colt < 16) {
                        *(f32x4*)(BA + row * 16 + colt) = v0; *(f32x4*)(BA + row * 16 + colt + 4) = v1;
                    }
                }
            }
    }
};
struct EpiGlu {
    static constexpr bool PERM = true;
    const bf16_t* Y5; bf16_t* SZB;
    __device__ __forceinline__ void operator()(const f32x4 (&acc)[2][2][4][2], const Unit& u, int wr, int wc, int fr, int fq) const {
        const int row0 = u.pm * 256 + wr * 64 + fr;
#pragma unroll
        for (int ai = 0; ai < 2; ++ai)
#pragma unroll
            for (int m = 0; m < 4; ++m) {
                const size_t row = (size_t)(row0 + ai * 128 + m * 16);
#pragma unroll
                for (int bj = 0; bj < 2; ++bj) {
                    const int c = u.pn * 256 + 128 * bj + 32 * wc + 8 * fq;
                    const u32x4 y = *(const u32x4*)(Y5 + row * 1024 + c), z = *(const u32x4*)(SZB + row * 1024 + c);
                    const f32x4 a0 = acc[ai][bj][m][0], a1 = acc[ai][bj][m][1];
                    u32x4 o;
                    o.x = pk2(lo2f(y.x) * sigmoidf_(a0[0]) * lo2f(z.x), hi2f(y.x) * sigmoidf_(a0[1]) * hi2f(z.x));
                    o.y = pk2(lo2f(y.y) * sigmoidf_(a0[2]) * lo2f(z.y), hi2f(y.y) * sigmoidf_(a0[3]) * hi2f(z.y));
                    o.z = pk2(lo2f(y.z) * sigmoidf_(a1[0]) * lo2f(z.z), hi2f(y.z) * sigmoidf_(a1[1]) * hi2f(z.z));
                    o.w = pk2(lo2f(y.w) * sigmoidf_(a1[2]) * lo2f(z.w), hi2f(y.w) * sigmoidf_(a1[3]) * hi2f(z.w));
                    *(u32x4*)(SZB + row * 1024 + c) = o;
                }
            }
    }
};
struct EpiF32 {
    static constexpr bool PERM = false;
    float* C;
    __device__ __forceinline__ void operator()(const f32x4 (&acc)[2][2][4][2], const Unit& u, int wr, int wc, int fr, int fq) const {
        const int row0 = u.pm * 256 + wr * 64 + fr, col0 = u.pn * 256 + wc * 32 + 4 * fq;
#pragma unroll
        for (int ai = 0; ai < 2; ++ai)
#pragma unroll
            for (int m = 0; m < 4; ++m) { float* rowp = C + (size_t)(row0 + ai * 128 + m * 16) * 1024 + col0;
#pragma unroll
                for (int bj = 0; bj < 2; ++bj)
#pragma unroll
                    for (int n = 0; n < 2; ++n) *(f32x4*)(rowp + bj * 128 + n * 16) = acc[ai][bj][m][n]; }
    }
};
struct EpiB16 {
    static constexpr bool PERM = true;
    bf16_t* C;
    __device__ __forceinline__ void operator()(const f32x4 (&acc)[2][2][4][2], const Unit& u, int wr, int wc, int fr, int fq) const {
        const int row0 = u.pm * 256 + wr * 64 + fr, col0 = u.pn * 256 + wc * 32 + 8 * fq;
#pragma unroll
        for (int ai = 0; ai < 2; ++ai)
#pragma unroll
            for (int m = 0; m < 4; ++m) { bf16_t* rowp = C + (size_t)(row0 + ai * 128 + m * 16) * 1024 + col0;
#pragma unroll
                for (int bj = 0; bj < 2; ++bj) *(u32x4*)(rowp + bj * 128) = pack8(acc[ai][bj][m][0], acc[ai][bj][m][1]); }
    }
};
struct Epi2 {
    static constexpr bool PERM = false;
    bf16_t* P; bf16_t* Q;
    __device__ __forceinline__ void operator()(const f32x4 (&acc)[2][2][4][2], const Unit& u, int wr, int wc, int fr, int fq) const {
        const int row0 = u.pm * 256 + wr * 64 + fr, ch = u.pn * 64 + 16 * wc + 4 * fq;
#pragma unroll
        for (int ai = 0; ai < 2; ++ai)
#pragma unroll
            for (int m = 0; m < 4; ++m) {
                const size_t row = (size_t)(row0 + ai * 128 + m * 16);
                const f32x4 gb = acc[ai][0][m][0], gc = acc[ai][0][m][1], hv = acc[ai][1][m][0], z = acc[ai][1][m][1];
                u32x2 pp, qq;
                pp.x = pk2(gc[0] * hv[0], gc[1] * hv[1]); pp.y = pk2(gc[2] * hv[2], gc[3] * hv[3]);
                qq.x = pk2(gb[0] * siluf_(z[0]), gb[1] * siluf_(z[1])); qq.y = pk2(gb[2] * siluf_(z[2]), gb[3] * siluf_(z[3]));
                *(u32x2*)(P + row * 2048 + ch) = pp; *(u32x2*)(Q + row * 2048 + ch) = qq;
            }
    }
};

__device__ __forceinline__ int src_col(int mode, int n, int& pn_unused) {
    (void)pn_unused;
    if (mode == 0) return n;
    if (mode == 1) { if (n < 4096) return n; if (n < 6144) return n + 16; if (n < 6160) return n - 2048; return -1; }
    const int pn = n >> 8, col = n & 255, bj = col >> 7, wc = (col >> 5) & 3, nn = (col >> 4) & 1, lo = col & 15;
    return (2 * bj + nn) * 2048 + pn * 64 + 16 * wc + lo;
}
__device__ __forceinline__ void phase_convert(const Prm& p, unsigned char* lds, int t_begin, int t_end, int nblk, int bidx) {
    float* tile = (float*)lds;
    const int tid = threadIdx.x;
    for (int tix = t_begin + bidx; tix < t_end; tix += nblk) {
        int tl = tix, K, Nsrc, mode; const float* W; bf16_t* Wt;
        if (tl < 1600) { W = p.in[3]; Wt = (bf16_t*)(p.ws + OFF_WT1); K = 1024; Nsrc = 6160; mode = 1; }
        else if ((tl -= 1600) < 256) { W = p.in[16]; Wt = (bf16_t*)(p.ws + OFF_WTG); K = 1024; Nsrc = 1024; mode = 0; }
        else if ((tl -= 256) < 512) { W = p.in[17]; Wt = (bf16_t*)(p.ws + OFF_WTO0); K = 2048; Nsrc = 1024; mode = 0; }
        else if ((tl -= 512) < 2048) { W = p.in[18]; Wt = (bf16_t*)(p.ws + OFF_WT2); K = 1024; Nsrc = 8192; mode = 2; }
        else { tl -= 2048; W = p.in[20]; Wt = (bf16_t*)(p.ws + OFF_WTO1); K = 2048; Nsrc = 1024; mode = 0; }
        const int ntk = K / 64, n0 = (tl / ntk) * 64, k0 = (tl % ntk) * 64;
        { const int j = tid & 63; int dummy = 0; const int sc = src_col(mode, n0 + j, dummy);
#pragma unroll
          for (int i = 0; i < 8; ++i) { const int k = (tid >> 6) + 8 * i; tile[k * 65 + j] = sc >= 0 ? W[(size_t)(k0 + k) * Nsrc + sc] : 0.0f; } }
        __syncthreads();
        { const int r = tid >> 3, c8 = (tid & 7) * 8; u32x4 o;
          o.x = pk2(tile[(c8 + 0) * 65 + r], tile[(c8 + 1) * 65 + r]); o.y = pk2(tile[(c8 + 2) * 65 + r], tile[(c8 + 3) * 65 + r]);
          o.z = pk2(tile[(c8 + 4) * 65 + r], tile[(c8 + 5) * 65 + r]); o.w = pk2(tile[(c8 + 6) * 65 + r], tile[(c8 + 7) * 65 + r]);
          *(u32x4*)(Wt + (size_t)(n0 + r) * K + k0 + c8) = o; }
        __syncthreads();
    }
}
__device__ __forceinline__ void phase_rmsnorm_x(const float* x, const float* w, bf16_t* H) {
    const int lane = threadIdx.x & 63, nw = gridDim.x * 8;
    for (int row = blockIdx.x * 8 + (threadIdx.x >> 6); row < TOK; row += nw) {
        const f32x4* xr = (const f32x4*)(x + (size_t)row * 1024);
        f32x4 v[4]; float ss = 0.f;
#pragma unroll
        for (int i = 0; i < 4; ++i) { v[i] = xr[lane + 64 * i]; ss += v[i][0] * v[i][0] + v[i][1] * v[i][1] + v[i][2] * v[i][2] + v[i][3] * v[i][3]; }
        ss = wave_sum(ss);
        const float rstd = rsqrtf(ss * (1.0f / 1024.0f) + 1e-6f);
#pragma unroll
        for (int i = 0; i < 4; ++i) { const f32x4 w4 = ((const f32x4*)w)[lane + 64 * i]; u32x2 o;
            o.x = pk2(v[i][0] * rstd * w4[0], v[i][1] * rstd * w4[1]); o.y = pk2(v[i][2] * rstd * w4[2], v[i][3] * rstd * w4[3]);
            *(u32x2*)(H + (size_t)row * 1024 + (lane + 64 * i) * 4) = o; }
    }
}
template <bool NEXT>
__device__ __forceinline__ void phase_post(const float* base, const bf16_t* Y, const float* wpost, float* OUT, const float* wpre, bf16_t* H) {
    const int lane = threadIdx.x & 63, nw = gridDim.x * 8;
    for (int row = blockIdx.x * 8 + (threadIdx.x >> 6); row < TOK; row += nw) {
        const u32x2* yr = (const u32x2*)(Y + (size_t)row * 1024); const f32x4* br = (const f32x4*)(base + (size_t)row * 1024);
        f32x4 v[4], xb[4]; float ss = 0.f;
#pragma unroll
        for (int i = 0; i < 4; ++i) { const u32x2 y2 = yr[lane + 64 * i]; v[i] = (f32x4){lo2f(y2.x), hi2f(y2.x), lo2f(y2.y), hi2f(y2.y)}; xb[i] = br[lane + 64 * i]; ss += v[i][0] * v[i][0] + v[i][1] * v[i][1] + v[i][2] * v[i][2] + v[i][3] * v[i][3]; }
        ss = wave_sum(ss);
        const float rstd = rsqrtf(ss * (1.0f / 1024.0f) + 1e-6f);
        float s2 = 0.f;
#pragma unroll
        for (int i = 0; i < 4; ++i) { const f32x4 w4 = ((const f32x4*)wpost)[lane + 64 * i];
#pragma unroll
            for (int e = 0; e < 4; ++e) { v[i][e] = xb[i][e] + v[i][e] * rstd * w4[e]; s2 += v[i][e] * v[i][e]; }
            ((f32x4*)(OUT + (size_t)row * 1024))[lane + 64 * i] = v[i]; }
        if (NEXT) {
            s2 = wave_sum(s2);
            const float r2 = rsqrtf(s2 * (1.0f / 1024.0f) + 1e-6f);
#pragma unroll
            for (int i = 0; i < 4; ++i) { const f32x4 w4 = ((const f32x4*)wpre)[lane + 64 * i]; u32x2 o;
                o.x = pk2(v[i][0] * r2 * w4[0], v[i][1] * r2 * w4[1]); o.y = pk2(v[i][2] * r2 * w4[2], v[i][3] * r2 * w4[3]);
                *(u32x2*)(H + (size_t)row * 1024 + (lane + 64 * i) * 4) = o; }
        }
    }
}


__device__ __forceinline__ void sincos_d(double x, double& s, double& c) {
    const double k = rint(x * 0.6366197723675814);
    const double r = fma(-k, 6.123233995736766e-17, fma(-k, 1.5707963267948966, x)), r2 = r * r;
    double sp = -7.647163731819816e-13; sp = fma(sp, r2, 1.6059043836821613e-10); sp = fma(sp, r2, -2.505210838544172e-8); sp = fma(sp, r2, 2.7557319223985893e-6);
    sp = fma(sp, r2, -1.984126984126984e-4); sp = fma(sp, r2, 8.333333333333333e-3); sp = fma(sp, r2, -1.6666666666666666e-1); sp = fma(sp * r2, r, r);
    double cp = 4.779477332387385e-14; cp = fma(cp, r2, -1.1470745597729725e-11); cp = fma(cp, r2, 2.08767569878681e-9); cp = fma(cp, r2, -2.755731922398589e-7);
    cp = fma(cp, r2, 2.48015873015873e-5); cp = fma(cp, r2, -1.388888888888889e-3); cp = fma(cp, r2, 4.1666666666666664e-2); cp = fma(cp, r2, -0.5); cp = fma(cp, r2, 1.0);
    const int q = ((int)k) & 3;
    const double s0 = (q & 1) ? cp : sp, c0 = (q & 1) ? sp : cp;
    s = (q & 2) ? -s0 : s0; c = ((q + 1) & 2) ? -c0 : c0;
}
__device__ __forceinline__ double exp_d(double x) {
    const double n = rint(x * 1.4426950408889634);
    const double r = fma(-n, 2.3190468138462996e-17, fma(-n, 0.6931471805599453, x));
    double p = 1.6059043836821613e-10; p = fma(p, r, 2.08767569878681e-9); p = fma(p, r, 2.505210838544172e-8); p = fma(p, r, 2.755731922398589e-7); p = fma(p, r, 2.7557319223985893e-6);
    p = fma(p, r, 2.48015873015873e-5); p = fma(p, r, 1.984126984126984e-4); p = fma(p, r, 1.388888888888889e-3); p = fma(p, r, 8.333333333333333e-3); p = fma(p, r, 4.1666666666666664e-2);
    p = fma(p, r, 1.6666666666666666e-1); p = fma(p, r, 0.5); p = fma(p, r, 1.0); p = fma(p, r, 1.0);
    return ldexp(p, (int)n);
}
__device__ __forceinline__ float bcast_lo(float v) { auto r = __builtin_amdgcn_permlane32_swap(__float_as_uint(v), __float_as_uint(v), false, false); return __uint_as_float(r[0]); }
__device__ __forceinline__ float bcast_hi(float v) { auto r = __builtin_amdgcn_permlane32_swap(__float_as_uint(v), __float_as_uint(v), false, false); return __uint_as_float(r[1]); }

struct S5C {
    float ar[2][4], ai[2][4];
    float a512r[2], a512i[2];
    bf16x8 BB[4];
    bf16x8 CC[4];
    float dco;
};

template <bool OUT>
__device__ __forceinline__ void s5_chunk(const S5C& C, bf16_t* UU, int b, int g, int chunk, float (&st)[2][2], bf16_t* sX, int lane) {
    const int n = lane & 31, hh = lane >> 5, fr = lane & 15, fq = lane >> 4;
    const size_t tok0 = (size_t)b * SEQ + (size_t)chunk * 512;
    bf16x8 ua = *(const bf16x8*)(UU + (tok0 + n) * 1024 + 16 * g + 8 * hh);
    bf16_t uo[8];
    if (OUT) {
#pragma unroll
        for (int mt = 0; mt < 2; ++mt)
#pragma unroll
            for (int j = 0; j < 4; ++j) uo[mt * 4 + j] = UU[(tok0 + 16 * mt + 4 * fq + j) * 1024 + 16 * g + fr];
    }
    for (int blk = 0; blk < 16; ++blk) {
        const size_t t0 = tok0 + (size_t)blk * 32;
        const bf16x8 ucur = ua;
        bf16_t ucuro[8];
        if (OUT) {
#pragma unroll
            for (int i = 0; i < 8; ++i) ucuro[i] = uo[i];
        }
        if (blk < 15) {
            ua = *(const bf16x8*)(UU + (t0 + 32 + n) * 1024 + 16 * g + 8 * hh);
            if (OUT) {
#pragma unroll
                for (int mt = 0; mt < 2; ++mt)
#pragma unroll
                    for (int j = 0; j < 4; ++j) uo[mt * 4 + j] = UU[(t0 + 32 + 16 * mt + 4 * fq + j) * 1024 + 16 * g + fr];
            }
        }
        f32x16 acc[4];
#pragma unroll
        for (int tl = 0; tl < 4; ++tl) {
            f32x16 z;
#pragma unroll
            for (int i = 0; i < 16; ++i) z[i] = 0.f;
            acc[tl] = __builtin_amdgcn_mfma_f32_32x32x16_bf16(ucur, C.BB[tl], z, 0, 0, 0);
        }
#pragma unroll
        for (int tp = 0; tp < 2; ++tp) {
            f32x16& re = acc[2 * tp]; f32x16& im = acc[2 * tp + 1];
            const float a1r = C.ar[tp][0], a1i = C.ai[tp][0];
#pragma unroll
            for (int q = 0; q < 4; ++q)
#pragma unroll
                for (int r = 1; r < 4; ++r) {
                    const float pr = re[4 * q + r - 1], pi = im[4 * q + r - 1];
                    re[4 * q + r] += a1r * pr - a1i * pi; im[4 * q + r] += a1r * pi + a1i * pr;
                }
            float cr = st[tp][0], ci = st[tp][1];
            const float a4r = C.ar[tp][3], a4i = C.ai[tp][3];
#pragma unroll
            for (int q = 0; q < 4; ++q) {
                const float tr = re[4 * q + 3] + a4r * cr - a4i * ci, ti = im[4 * q + 3] + a4r * ci + a4i * cr;
                const float o0r = bcast_lo(tr), o0i = bcast_lo(ti);
                const float xr = hh ? o0r : cr, xi = hh ? o0i : ci;
                if (OUT) {
#pragma unroll
                    for (int r = 0; r < 4; ++r) { const float kr = C.ar[tp][r], ki = C.ai[tp][r];
                        re[4 * q + r] += kr * xr - ki * xi; im[4 * q + r] += kr * xi + ki * xr; }
                } else {
                    re[4 * q + 3] += a4r * xr - a4i * xi; im[4 * q + 3] += a4r * xi + a4i * xr;
                }
                cr = bcast_hi(re[4 * q + 3]); ci = bcast_hi(im[4 * q + 3]);
            }
            st[tp][0] = cr; st[tp][1] = ci;
        }
        if (OUT) {
            asm volatile("s_waitcnt lgkmcnt(0)" ::: "memory");
#pragma unroll
            for (int tp = 0; tp < 2; ++tp)
#pragma unroll
                for (int i = 0; i < 16; ++i) {
                    const int t = 8 * (i >> 2) + 4 * hh + (i & 3);
                    *(unsigned*)(sX + t * 136 + 2 * (n + 32 * tp)) = pk2(acc[2 * tp][i], acc[2 * tp + 1][i]);
                }
            asm volatile("s_waitcnt lgkmcnt(0)" ::: "memory");
            __builtin_amdgcn_wave_barrier();
#pragma unroll
            for (int mt = 0; mt < 2; ++mt) {
                f32x4 y = (f32x4){0.f, 0.f, 0.f, 0.f};
#pragma unroll
                for (int ks = 0; ks < 4; ++ks) {
                    const bf16x8 xa = *(const bf16x8*)(sX + (16 * mt + fr) * 136 + 32 * ks + 8 * fq);
                    y = __builtin_amdgcn_mfma_f32_16x16x32_bf16(xa, C.CC[ks], y, 0, 0, 0);
                }
#pragma unroll
                for (int j = 0; j < 4; ++j) {
                    float v = y[j] + C.dco * bf2f(ucuro[mt * 4 + j]);
                    const float inner = 0.7978845608028654f * (v + 0.044715f * v * v * v);
                    v = v / (1.0f + __expf(-2.0f * inner));
                    UU[(t0 + 16 * mt + 4 * fq + j) * 1024 + 16 * g + fr] = f2bf(v);
                }
            }
            asm volatile("s_waitcnt lgkmcnt(0)" ::: "memory");
            __builtin_amdgcn_wave_barrier();
        }
    }
}

__device__ __forceinline__ void phase_s5(const Prm& p, unsigned char* lds, int bg) {
    const int b = bg >> 6, g = bg & 63;
    const int tid = threadIdx.x, wv = tid >> 6, lane = tid & 63, n = lane & 31, hh = lane >> 5, fr = lane & 15, fq = lane >> 4;
    bf16_t* sX = (bf16_t*)(lds + wv * 8704);
    float* sXE = (float*)(lds + 8 * 8704);
    bf16_t* UU = (bf16_t*)(p.ws + OFF_UU);
    const float* lam_re = p.in[8]; const float* lam_im = p.in[9]; const float* b_re = p.in[10]; const float* b_im = p.in[11];
    const float* c_re = p.in[12]; const float* c_im = p.in[13];
    S5C C;
    const double dt = exp_d((double)p.in[14][g]);
    float fre[2], fim[2];
#pragma unroll
    for (int tp = 0; tp < 2; ++tp) {
        const int pp = n + 32 * tp;
        const double lr = (double)fminf(lam_re[g * 64 + pp], -1e-4f), li = (double)lam_im[g * 64 + pp];
#pragma unroll
        for (int k = 0; k < 4; ++k) { double sn, cs; sincos_d(li * dt * (k + 1), sn, cs); const double mag = exp_d(lr * dt * (k + 1)); C.ar[tp][k] = (float)(mag * cs); C.ai[tp][k] = (float)(mag * sn); }
        { double sn, cs; sincos_d(li * dt * 512.0, sn, cs); const double mag = exp_d(lr * dt * 512.0); C.a512r[tp] = (float)(mag * cs); C.a512i[tp] = (float)(mag * sn); }
        double sn, cs; sincos_d(li * dt, sn, cs);
        const double mag = exp_d(lr * dt), abr = mag * cs, abi = mag * sn;
        const double den = lr * lr + li * li, nr = abr - 1.0, ni = abi;
        fre[tp] = (float)((nr * lr + ni * li) / den); fim[tp] = (float)((ni * lr - nr * li) / den);
    }
#pragma unroll
    for (int tl = 0; tl < 4; ++tl) {
        const int tp = tl >> 1, ri = tl & 1, pp = n + 32 * tp;
#pragma unroll
        for (int j = 0; j < 8; ++j) {
            const int ch = 8 * hh + j;
            const float br = b_re[(g * 64 + pp) * 16 + ch], bi = b_im[(g * 64 + pp) * 16 + ch];
            const float v = ri == 0 ? fre[tp] * br - fim[tp] * bi : fre[tp] * bi + fim[tp] * br;
            C.BB[tl][j] = (short)f2bf(v);
        }
    }
#pragma unroll
    for (int ks = 0; ks < 4; ++ks)
#pragma unroll
        for (int j = 0; j < 8; ++j) {
            const int k = 32 * ks + 8 * fq + j, pp = k >> 1, ri = k & 1;
            const float v = ri == 0 ? c_re[(g * 16 + fr) * 64 + pp] : -c_im[(g * 16 + fr) * 64 + pp];
            C.CC[ks][j] = (short)f2bf(v);
        }
    C.dco = p.in[15][16 * g + fr];
    for (int rd = 0; rd < 2; ++rd) {
        const int chunk = wv + 8 * rd;
        float st[2][2] = {{0.f, 0.f}, {0.f, 0.f}};
        s5_chunk<false>(C, UU, b, g, chunk, st, sX, lane);
        if (hh == 0) {
#pragma unroll
            for (int tp = 0; tp < 2; ++tp) { sXE[(chunk * 64 + n + 32 * tp) * 2 + 0] = st[tp][0]; sXE[(chunk * 64 + n + 32 * tp) * 2 + 1] = st[tp][1]; }
        }
    }
    __syncthreads();
    for (int rd = 0; rd < 2; ++rd) {
        const int chunk = wv + 8 * rd;
        float st[2][2] = {{0.f, 0.f}, {0.f, 0.f}};
        for (int c2 = 0; c2 < chunk; ++c2) {
#pragma unroll
            for (int tp = 0; tp < 2; ++tp) {
                const float er = sXE[(c2 * 64 + n + 32 * tp) * 2 + 0], ei = sXE[(c2 * 64 + n + 32 * tp) * 2 + 1];
                const float nr = C.a512r[tp] * st[tp][0] - C.a512i[tp] * st[tp][1] + er, ni = C.a512r[tp] * st[tp][1] + C.a512i[tp] * st[tp][0] + ei;
                st[tp][0] = nr; st[tp][1] = ni;
            }
        }
        s5_chunk<true>(C, UU, b, g, chunk, st, sX, lane);
    }
    __syncthreads();
}

__device__ __forceinline__ void phase_gdn_prep(const Prm& p, unsigned char* lds, int it0, int nrounds) {
    const int tid0 = threadIdx.x, hb = tid0 >> 8;
    unsigned char* base = lds + hb * 76800;
    bf16_t* sQ = (bf16_t*)base;
    bf16_t* sK = (bf16_t*)(base + 17408);
    bf16_t* sV = (bf16_t*)(base + 2 * 17408);
    float* sL = (float*)(base + 3 * 17408);
    float* sBeta = (float*)(base + 4 * 17408);
    float* sGc = sBeta + 64; float* sEg = sGc + 64; float* sBE = sEg + 64;
    float* sCW = sBE + 64;
    bf16_t* QKV = (bf16_t*)(p.ws + OFF_QKV); const bf16_t* HALO = (const bf16_t*)(p.ws + OFF_HALO);
    const float* BA = (const float*)(p.ws + OFF_BA); float* GL = (float*)(p.ws + OFF_GL);
    bf16_t* WB = (bf16_t*)(p.ws + OFF_WB); bf16_t* ATT = (bf16_t*)(p.ws + OFF_ATT);
    const float* convw = p.in[4];
    for (int rd = 0; rd < nrounds; ++rd) {
        int tid = tid0; asm volatile("" : "+v"(tid));
        const int ht = tid & 255, hw = (tid >> 6) & 3, lane = tid & 63, fr = lane & 15, fq = lane >> 4;
        const int it = it0 + rd * 2 + hb;
        const int b = it >> 10, h = (it >> 7) & 7, nc = it & 127;
        const size_t tokb = (size_t)b * SEQ + (size_t)nc * 64;
#pragma unroll
        for (int i = 0; i < 6; ++i) { const int idx = ht + 256 * i, s3 = idx >> 9, tap = (idx >> 7) & 3, ch = idx & 127; sCW[idx] = convw[tap * 3072 + s3 * 1024 + h * 128 + ch]; }
        __syncthreads();
        {
            const int t0 = (ht >> 4) * 4, cgp = ht & 15;
#pragma unroll 1
            for (int s = 0; s < 3; ++s) {
                const int col = s * 1024 + h * 128 + cgp * 8;
                u32x4 xr[7];
#pragma unroll
                for (int i = 0; i < 7; ++i) {
                    const int tt = t0 - 3 + i;
                    xr[i] = (u32x4){0u, 0u, 0u, 0u};
                    if (tt >= 0) xr[i] = *(const u32x4*)(QKV + (tokb + tt) * 3072 + col);
                    else if (nc > 0) xr[i] = *(const u32x4*)(HALO + ((size_t)(b * 128 + nc - 1) * 3 + (3 + tt)) * 3072 + col);
                }
                f32x4 w0[4], w1[4];
#pragma unroll
                for (int j = 0; j < 4; ++j) { w0[j] = *(const f32x4*)(sCW + s * 512 + j * 128 + cgp * 8); w1[j] = *(const f32x4*)(sCW + s * 512 + j * 128 + cgp * 8 + 4); }
                float o[4][8], ss[4];
#pragma unroll
                for (int tk = 0; tk < 4; ++tk) {
                    float a[8];
#pragma unroll
                    for (int e = 0; e < 8; ++e) a[e] = 0.f;
#pragma unroll
                    for (int j = 0; j < 4; ++j) {
                        const u32x4 xv = xr[tk + j];
                        a[0] += w0[j][0] * lo2f(xv.x); a[1] += w0[j][1] * hi2f(xv.x); a[2] += w0[j][2] * lo2f(xv.y); a[3] += w0[j][3] * hi2f(xv.y);
                        a[4] += w1[j][0] * lo2f(xv.z); a[5] += w1[j][1] * hi2f(xv.z); a[6] += w1[j][2] * lo2f(xv.w); a[7] += w1[j][3] * hi2f(xv.w);
                    }
                    float acc2 = 0.f;
#pragma unroll
                    for (int e = 0; e < 8; ++e) { const float v = siluf_(a[e]); o[tk][e] = v; acc2 += v * v; }
                    ss[tk] = acc2;
                }
                bf16_t* dst = (s == 0 ? sQ : (s == 1 ? sK : sV)) + t0 * 136 + cgp * 8;
#pragma unroll
                for (int tk = 0; tk < 4; ++tk) {
                    float sc = 1.0f;
                    if (s < 2) { float q = ss[tk]; q += __shfl_xor(q, 1); q += __shfl_xor(q, 2); q += __shfl_xor(q, 4); q += __shfl_xor(q, 8); sc = rsqrtf(q + 1e-6f) * (s == 0 ? 0.08838834764831845f : 1.0f); }
                    u32x4 pk;
                    pk.x = pk2(o[tk][0] * sc, o[tk][1] * sc); pk.y = pk2(o[tk][2] * sc, o[tk][3] * sc); pk.z = pk2(o[tk][4] * sc, o[tk][5] * sc); pk.w = pk2(o[tk][6] * sc, o[tk][7] * sc);
                    *(u32x4*)(dst + tk * 136) = pk;
                }
            }
        }
        if (hw == 0) {
            const size_t tg = tokb + lane;
            const float braw = BA[tg * 16 + h], araw = BA[tg * 16 + 8 + h];
            const float beta = 1.0f / (1.0f + expf(-braw));
            const float xx = araw + p.in[6][h];
            const float sp = xx > 20.f ? xx : log1pf(expf(xx));
            float gg = -expf(p.in[5][h]) * sp;
#pragma unroll
            for (int off = 1; off < 64; off <<= 1) { const float o = __shfl_up(gg, off); if (lane >= off) gg += o; }
            sBeta[lane] = beta; sGc[lane] = gg; sEg[lane] = expf(gg); sBE[lane] = beta * expf(gg);
            if (lane == 63) GL[it] = expf(gg);
        }
        __syncthreads();
        {
            bf16x8 aK[4], aQ[4];
#pragma unroll
            for (int ks = 0; ks < 4; ++ks) { aK[ks] = *(const bf16x8*)(sK + (16 * hw + fr) * 136 + 32 * ks + 8 * fq); aQ[ks] = *(const bf16x8*)(sQ + (16 * hw + fr) * 136 + 32 * ks + 8 * fq); }
#pragma unroll
            for (int nt = 0; nt < 4; ++nt) {
                f32x4 kk = (f32x4){0.f, 0.f, 0.f, 0.f}, qk = (f32x4){0.f, 0.f, 0.f, 0.f};
#pragma unroll
                for (int ks = 0; ks < 4; ++ks) {
                    const bf16x8 bK = *(const bf16x8*)(sK + (16 * nt + fr) * 136 + 32 * ks + 8 * fq);
                    kk = __builtin_amdgcn_mfma_f32_16x16x32_bf16(aK[ks], bK, kk, 0, 0, 0);
                    qk = __builtin_amdgcn_mfma_f32_16x16x32_bf16(aQ[ks], bK, qk, 0, 0, 0);
                }
                const int mcol = 16 * nt + fr; const float gm = sGc[mcol];
#pragma unroll
                for (int j = 0; j < 4; ++j) {
                    const int c = 16 * hw + 4 * fq + j;
                    const float dec = __expf(fminf(sGc[c] - gm, 0.f));
                    sL[c * 68 + mcol] = (mcol < c) ? kk[j] * sBeta[c] * dec : 0.f;
                    ATT[(size_t)it * 4096 + c * 64 + mcol] = f2bf((mcol <= c) ? qk[j] * dec : 0.f);
                }
            }
        }
        __syncthreads();
        {
            f32x2_t xv[32];
#define X_(i) (xv[(i) >> 1][(i) & 1])
            const bool isU = ht < 128; const int jc = ht & 127;
            const bf16_t* src = isU ? sV : sK;
            const float* fac = isU ? sBeta : sBE;
#pragma unroll
            for (int cb = 0; cb < 16; ++cb) {
                f32x2_t a2[4];
#pragma unroll
                for (int r = 0; r < 4; ++r) { a2[r].x = bf2f(src[(4 * cb + r) * 136 + jc]) * fac[4 * cb + r]; a2[r].y = 0.f; }
                const f32x4 d1 = *(const f32x4*)(sL + (4 * cb + 1) * 68 + 4 * cb), d2 = *(const f32x4*)(sL + (4 * cb + 2) * 68 + 4 * cb), d3 = *(const f32x4*)(sL + (4 * cb + 3) * 68 + 4 * cb);
                const int nb = (cb + 1) / 2;
                f32x4 lb[2][4][2];
#define SOLVE_LOAD(mb_, buf_) do { _Pragma("unroll") for (int q = 0; q < 2; ++q) _Pragma("unroll") for (int r = 0; r < 4; ++r) \
                    if (2 * (mb_) + q < cb) lb[buf_][r][q] = *(const f32x4*)(sL + (4 * cb + r) * 68 + 4 * (2 * (mb_) + q)); } while (0)
                if (nb > 0) SOLVE_LOAD(0, 0);
#pragma unroll
                for (int mb = 0; mb < nb; ++mb) {
                    if (mb + 1 < nb) SOLVE_LOAD(mb + 1, (mb + 1) & 1);
                    __builtin_amdgcn_sched_barrier(0);
#pragma unroll
                    for (int q = 0; q < 2; ++q)
#pragma unroll
                        for (int r = 0; r < 4; ++r)
                            if (2 * mb + q < cb) { const f32x4 l = lb[mb & 1][r][q]; const int m2 = 2 * (2 * mb + q);
                                a2[r] -= (f32x2_t){l[0], l[1]} * xv[m2]; a2[r] -= (f32x2_t){l[2], l[3]} * xv[m2 + 1]; }
                    __builtin_amdgcn_sched_barrier(0);
                }
#undef SOLVE_LOAD
                const float a0 = a2[0].x + a2[0].y, a1 = a2[1].x + a2[1].y, a2s = a2[2].x + a2[2].y, a3 = a2[3].x + a2[3].y;
                const float y0 = a0, y1 = a1 - d1[0] * y0, y2 = a2s - d2[0] * y0 - d2[1] * y1, y3 = a3 - d3[0] * y0 - d3[1] * y1 - d3[2] * y2;
                xv[2 * cb] = (f32x2_t){y0, y1}; xv[2 * cb + 1] = (f32x2_t){y2, y3};
            }
            if (isU) {
                const int w8 = jc >> 4, nn = jc & 15;
#pragma unroll
                for (int rq = 0; rq < 4; ++rq)
#pragma unroll
                    for (int pc = 0; pc < 2; ++pc) {
                        const int c0 = 32 * pc + 8 * rq;
                        u32x4 o; o.x = pk2(X_(c0 + 0), X_(c0 + 1)); o.y = pk2(X_(c0 + 2), X_(c0 + 3)); o.z = pk2(X_(c0 + 4), X_(c0 + 5)); o.w = pk2(X_(c0 + 6), X_(c0 + 7));
                        const int L = ((w8 * 2 + pc) * 64 + rq * 16 + nn) * 8;
                        *(u32x4*)(QKV + (tokb + (L >> 7)) * 3072 + 2048 + h * 128 + (L & 127)) = o;
                    }
            }
            __syncthreads();
            if (!isU) {
                bf16_t* sW2 = (bf16_t*)sL;
#pragma unroll
                for (int c = 0; c < 64; ++c) sW2[c * 136 + jc] = f2bf(-X_(c));
            }
        }
        __syncthreads();
        {
            const bf16_t* sW2 = (const bf16_t*)sL;
#pragma unroll
            for (int i = 0; i < 4; ++i) { const int ch = ht + 256 * i, r = ch >> 4, c8 = (ch & 15) * 8; *(u32x4*)(WB + (size_t)it * 8192 + r * 128 + c8) = *(const u32x4*)(sW2 + r * 136 + c8); }
        }
#undef X_
        {
            const int c = ht >> 2, ds = (ht & 3) * 32; const float eg = sEg[c];
#pragma unroll
            for (int c8 = 0; c8 < 4; ++c8) {
                const u32x4 v = *(const u32x4*)(sQ + c * 136 + ds + c8 * 8); u32x4 o;
                o.x = pk2(lo2f(v.x) * eg, hi2f(v.x) * eg); o.y = pk2(lo2f(v.y) * eg, hi2f(v.y) * eg); o.z = pk2(lo2f(v.z) * eg, hi2f(v.z) * eg); o.w = pk2(lo2f(v.w) * eg, hi2f(v.w) * eg);
                *(u32x4*)(QKV + (tokb + c) * 3072 + h * 128 + ds + c8 * 8) = o;
            }
            const int d = ht >> 1, cs = (ht & 1) * 32; const float gl = sGc[63];
#pragma unroll
            for (int c8 = 0; c8 < 4; ++c8) {
                float v[8];
#pragma unroll
                for (int e = 0; e < 8; ++e) { const int cc = cs + c8 * 8 + e; v[e] = bf2f(sK[cc * 136 + d]) * __expf(gl - sGc[cc]); }
                u32x4 o; o.x = pk2(v[0], v[1]); o.y = pk2(v[2], v[3]); o.z = pk2(v[4], v[5]); o.w = pk2(v[6], v[7]);
                *(u32x4*)(QKV + (tokb + (d >> 1)) * 3072 + 1024 + h * 128 + (d & 1) * 64 + cs + c8 * 8) = o;
            }
        }
        __syncthreads();
    }
}

constexpr int SC_WQ = 32768, SC_KA = 24576, SC_KA0 = 3 * SC_WQ;
static_assert(SC_KA0 + 2 * SC_KA <= LDS_BYTES, "scan LDS layout");
__device__ __forceinline__ bf16x8 pack2(const f32x4& a, const f32x4& b) {
    u32x4 r; r.x = pk2(a[0], a[1]); r.y = pk2(a[2], a[3]); r.z = pk2(b[0], b[1]); r.w = pk2(b[2], b[3]); return __builtin_bit_cast(bf16x8, r);
}
#define MF16(a, b, c) __builtin_amdgcn_mfma_f32_16x16x32_bf16(a, b, c, 0, 0, 0)
#define DMA16(src, dst) __builtin_amdgcn_global_load_lds((const unsigned*)(src), (LAS unsigned*)(dst), 16, 0, 0)
__device__ __forceinline__ void phase_gdn_scan(const Prm& p, LAS unsigned char* lds, int blk) {
    const int tid = threadIdx.x, wv = __builtin_amdgcn_readfirstlane(tid >> 6), lane = tid & 63, n = lane & 15, kq = lane >> 4;
    const int bh = blk & 15, jh = blk >> 4, b = bh >> 3, h = bh & 7;
    const bf16_t* QKV = (const bf16_t*)(p.ws + OFF_QKV); const bf16_t* WB = (const bf16_t*)(p.ws + OFF_WB); const bf16_t* ATT = (const bf16_t*)(p.ws + OFF_ATT);
    const float* GL = (const float*)(p.ws + OFF_GL); bf16_t* O = (bf16_t*)(p.ws + OFF_H);
    const int itb = bh * 128;
    const bf16_t* qkv_b = QKV + (size_t)b * SEQ * 3072;
    if (wv >= 4) {
        const int lw = wv - 4;
        __builtin_amdgcn_s_setprio(3);
        unsigned oW[4], oQ[4], oK[4], oA[2];
#pragma unroll
        for (int i = 0; i < 4; ++i) {
            { const int q = lw * 4 + i, row = 4 * q + (lane >> 4), pg = lane & 15, g = pg ^ ((row & 3) | (((row >> 3) & 3) << 2)); oW[i] = (unsigned)(row * 128 + g * 8); oQ[i] = (unsigned)(row * 3072 + h * 128 + g * 8); }
            { const int q = lw * 4 + i, d = 8 * q + (lane >> 3), pg = lane & 7, g = pg ^ ((d & 3) | (((d >> 3) & 1) << 2)); oK[i] = (unsigned)((d >> 1) * 3072 + 1024 + h * 128 + (d & 1) * 64 + g * 8); }
        }
#pragma unroll
        for (int i = 0; i < 2; ++i) { const int q = lw * 2 + i, c = 8 * q + (lane >> 3), pg = lane & 7, g = pg ^ ((c & 3) | (((c >> 3) & 1) << 2)); oA[i] = (unsigned)(c * 64 + g * 8); }
#define ISSUE_WQ(ck, st) do { const bf16_t* wb_ = WB + (size_t)(itb + (ck)) * 8192; const bf16_t* qb_ = qkv_b + (size_t)(ck) * 64 * 3072; LAS unsigned char* d_ = lds + (st) * SC_WQ + lw * 4096; \
        _Pragma("unroll") for (int i = 0; i < 4; ++i) { DMA16(wb_ + oW[i], d_ + i * 1024); DMA16(qb_ + oQ[i], d_ + 16384 + i * 1024); } } while (0)
#define ISSUE_KA(ck, st) do { const bf16_t* qb_ = qkv_b + (size_t)(ck) * 64 * 3072; const bf16_t* ab_ = ATT + (size_t)(itb + (ck)) * 4096; LAS unsigned char* d_ = lds + SC_KA0 + (st) * SC_KA; \
        _Pragma("unroll") for (int i = 0; i < 4; ++i) DMA16(qb_ + oK[i], d_ + (lw * 4 + i) * 1024); \
        _Pragma("unroll") for (int i = 0; i < 2; ++i) DMA16(ab_ + oA[i], d_ + 16384 + (lw * 2 + i) * 1024); } while (0)
        ISSUE_WQ(0, 0); ISSUE_KA(0, 0); ISSUE_WQ(1, 1);
        asm volatile("s_waitcnt vmcnt(0)" ::: "memory"); __builtin_amdgcn_s_barrier(); asm volatile("" ::: "memory");
        int s3 = 2;
        for (int nc = 0; nc < 128; ++nc) {
            const int c1 = nc + 1 < 128 ? nc + 1 : 127, c2 = nc + 2 < 128 ? nc + 2 : 127;
            ISSUE_KA(c1, (nc + 1) & 1);
            ISSUE_WQ(c2, s3);
            s3 = s3 == 2 ? 0 : s3 + 1;
            asm volatile("s_waitcnt vmcnt(8)" ::: "memory");
            __builtin_amdgcn_s_barrier(); asm volatile("" ::: "memory");
        }
        asm volatile("s_waitcnt vmcnt(0)" ::: "memory");
        __builtin_amdgcn_s_setprio(0);
#undef ISSUE_WQ
#undef ISSUE_KA
    } else if (wv >= 2) {
        for (int nc = 0; nc < 129; ++nc) { __builtin_amdgcn_s_barrier(); asm volatile("" ::: "memory"); }
    } else {
        const float gl0 = GL[itb + lane], gl1 = GL[itb + 64 + lane];
        f32x4 S[8];
#pragma unroll
        for (int dt = 0; dt < 8; ++dt) S[dt] = (f32x4){0.f, 0.f, 0.f, 0.f};
        const int e = 32 * jh + 16 * wv + n;
        unsigned uo[2];
#pragma unroll
        for (int pc = 0; pc < 2; ++pc) { const int L = (((2 * jh + wv) * 2 + pc) * 64 + lane) * 8; uo[pc] = (unsigned)((L >> 7) * 3072 + 2048 + h * 128 + (L & 127)); }
        u32x4 ua[2], ub[2];
#pragma unroll
        for (int pc = 0; pc < 2; ++pc) { ua[pc] = *(const u32x4*)(qkv_b + uo[pc]); ub[pc] = *(const u32x4*)(qkv_b + (size_t)64 * 3072 + uo[pc]); }
        const int rowb = 8 * (n >> 2) + (n & 3), swk = (n & 3) | (((n >> 2) & 1) << 2);
        unsigned offW[4], offK[2];
#pragma unroll
        for (int ks = 0; ks < 4; ++ks) offW[ks] = (unsigned)(rowb * 256 + (((4 * ks + kq) ^ n) << 4));
#pragma unroll
        for (int k2 = 0; k2 < 2; ++k2) offK[k2] = (unsigned)(rowb * 128 + (((4 * k2 + kq) ^ swk) << 4));
        asm volatile("s_waitcnt lgkmcnt(0)" ::: "memory"); __builtin_amdgcn_s_barrier(); asm volatile("" ::: "memory");
        int s3 = 0;
        for (int nc = 0; nc < 128; ++nc) {
            const LAS unsigned char* sWQ = lds + s3 * SC_WQ; const LAS unsigned char* sKA = lds + SC_KA0 + (nc & 1) * SC_KA;
            s3 = s3 == 2 ? 0 : s3 + 1;
            const float gl = __builtin_bit_cast(float, __builtin_amdgcn_readlane(__builtin_bit_cast(int, nc < 64 ? gl0 : gl1), nc & 63));
            f32x4 V[4], Oa[4];
#pragma unroll
            for (int pc = 0; pc < 2; ++pc) {
                const u32x4 uu = ua[pc];
                V[2 * pc] = (f32x4){lo2f(uu.x), hi2f(uu.x), lo2f(uu.y), hi2f(uu.y)}; V[2 * pc + 1] = (f32x4){lo2f(uu.z), hi2f(uu.z), lo2f(uu.w), hi2f(uu.w)};
                ua[pc] = ub[pc];
            }
            { const int c2 = nc + 2 < 128 ? nc + 2 : 127; const bf16_t* ubase = qkv_b + (size_t)c2 * 64 * 3072;
#pragma unroll
              for (int pc = 0; pc < 2; ++pc) ub[pc] = *(const u32x4*)(ubase + uo[pc]); }
#pragma unroll
            for (int ct = 0; ct < 4; ++ct) Oa[ct] = (f32x4){0.f, 0.f, 0.f, 0.f};
            bf16x8 fa[2][8];
#define TOFF(t, pitch) ((32 * ((t) >> 1) + 4 * ((t) & 1)) * (pitch))
#define LD_WQ(dst, ks_) do { _Pragma("unroll") for (int mt = 0; mt < 4; ++mt) { dst[mt] = *(const LAS bf16x8*)(sWQ + offW[ks_] + TOFF(mt, 256)); dst[4 + mt] = *(const LAS bf16x8*)(sWQ + 16384 + offW[ks_] + TOFF(mt, 256)); } } while (0)
            LD_WQ(fa[0], 0);
#pragma unroll
            for (int ks = 0; ks < 4; ++ks) {
                if (ks < 3) LD_WQ(fa[(ks + 1) & 1], ks + 1);
                const bf16x8 sb8 = pack2(S[2 * ks], S[2 * ks + 1]);
                __builtin_amdgcn_sched_barrier(0);
#pragma unroll
                for (int mt = 0; mt < 4; ++mt) { V[mt] = MF16(fa[ks & 1][mt], sb8, V[mt]); Oa[mt] = MF16(fa[ks & 1][4 + mt], sb8, Oa[mt]); }
                __builtin_amdgcn_sched_barrier(0);
            }
#undef LD_WQ
            bf16x8 fb[2][12];
#define LD_AK(dst, k2_) do { _Pragma("unroll") for (int mt = 0; mt < 4; ++mt) dst[mt] = *(const LAS bf16x8*)(sKA + 16384 + offK[k2_] + TOFF(mt, 128)); \
                             _Pragma("unroll") for (int dt = 0; dt < 8; ++dt) dst[4 + dt] = *(const LAS bf16x8*)(sKA + offK[k2_] + TOFF(dt, 128)); } while (0)
            LD_AK(fb[0], 0);
            bf16x8 Vb[2];
            Vb[0] = pack2(V[0], V[1]); Vb[1] = pack2(V[2], V[3]);
#pragma unroll
            for (int dt = 0; dt < 8; ++dt) S[dt] *= gl;
#pragma unroll
            for (int k2 = 0; k2 < 2; ++k2) {
                if (k2 < 1) LD_AK(fb[1], 1);
                __builtin_amdgcn_sched_barrier(0);
#pragma unroll
                for (int mt = 0; mt < 4; ++mt) Oa[mt] = MF16(fb[k2][mt], Vb[k2], Oa[mt]);
#pragma unroll
                for (int dt = 0; dt < 8; ++dt) S[dt] = MF16(fb[k2][4 + dt], Vb[k2], S[dt]);
                __builtin_amdgcn_sched_barrier(0);
            }
#undef LD_AK
#undef TOFF
            bf16_t* obase = O + (size_t)(itb + nc) * 8192 + e * 64 + 8 * kq;
#pragma unroll
            for (int pc = 0; pc < 2; ++pc) *(u32x4*)(obase + 32 * pc) = pack8(Oa[2 * pc], Oa[2 * pc + 1]);
            asm volatile("s_waitcnt lgkmcnt(0)" ::: "memory"); __builtin_amdgcn_s_barrier(); asm volatile("" ::: "memory");
        }
    }
    __syncthreads();
}

__device__ __forceinline__ void phase_ya(const Prm& p, unsigned char* lds) {
    const bf16_t* OT = (const bf16_t*)(p.ws + OFF_H); bf16_t* SZA = (bf16_t*)p.out;
    const float* gw = p.in[7];
    bf16_t* sT = (bf16_t*)lds;
    float* sPart = (float*)(lds + 16384);
    const int tid = threadIdx.x, w = tid >> 6, c = tid & 63;
    for (int it = blockIdx.x; it < NIT; it += gridDim.x) {
        const int b = it >> 10, h = (it >> 7) & 7, nc = it & 127;
        const size_t tok = (size_t)b * SEQ + (size_t)nc * 64 + c;
#pragma unroll
        for (int i = 0; i < 2; ++i) { const int ch = tid + 512 * i; *(u32x4*)(sT + ch * 8) = *(const u32x4*)(OT + (size_t)it * 8192 + ch * 8); }
        const u32x4 z0 = *(const u32x4*)(SZA + tok * 1024 + h * 128 + 16 * w), z1 = *(const u32x4*)(SZA + tok * 1024 + h * 128 + 16 * w + 8);
        __syncthreads();
        float o[16]; float ss = 0.f;
#pragma unroll
        for (int j = 0; j < 16; ++j) { o[j] = bf2f(sT[(16 * w + j) * 64 + c]); ss += o[j] * o[j]; }
        sPart[w * 64 + c] = ss;
        __syncthreads();
        float tot = 0.f;
#pragma unroll
        for (int k = 0; k < 8; ++k) tot += sPart[k * 64 + c];
        const float rstd = rsqrtf(tot * (1.0f / 128.0f) + 1e-6f);
        const unsigned zz[8] = {z0.x, z0.y, z0.z, z0.w, z1.x, z1.y, z1.z, z1.w};
        unsigned r[8];
#pragma unroll
        for (int j = 0; j < 8; ++j)
            r[j] = pk2(o[2 * j] * rstd * gw[16 * w + 2 * j] * lo2f(zz[j]), o[2 * j + 1] * rstd * gw[16 * w + 2 * j + 1] * hi2f(zz[j]));
        *(u32x4*)(SZA + tok * 1024 + h * 128 + 16 * w) = (u32x4){r[0], r[1], r[2], r[3]};
        *(u32x4*)(SZA + tok * 1024 + h * 128 + 16 * w + 8) = (u32x4){r[4], r[5], r[6], r[7]};
        __syncthreads();
    }
}
__device__ __forceinline__ void phase_conv3(const Prm& p) {
    const bf16_t* P = (const bf16_t*)(p.ws + OFF_P); bf16_t* Q = (bf16_t*)(p.ws + OFF_Q); const float* cw = p.in[19];
    const int nth = gridDim.x * 512;
    for (int idx = blockIdx.x * 512 + threadIdx.x; idx < (TOK / 4) * 256; idx += nth) {
        const int t0 = (idx >> 8) * 4, c8 = (idx & 255) * 8;
        const bool first = (t0 & (SEQ - 1)) == 0;
        u32x4 pr[6], qr[4];
#pragma unroll
        for (int i = 0; i < 6; ++i) pr[i] = (i < 2 && first) ? (u32x4){0u, 0u, 0u, 0u} : *(const u32x4*)(P + (size_t)(t0 - 2 + i) * 2048 + c8);
#pragma unroll
        for (int i = 0; i < 4; ++i) qr[i] = *(const u32x4*)(Q + (size_t)(t0 + i) * 2048 + c8);
        float w0[8], w1[8], w2[8];
#pragma unroll
        for (int e = 0; e < 8; ++e) { w0[e] = cw[c8 + e]; w1[e] = cw[2048 + c8 + e]; w2[e] = cw[4096 + c8 + e]; }
#pragma unroll
        for (int i = 0; i < 4; ++i) {
            const unsigned pa[4] = {pr[i + 2].x, pr[i + 2].y, pr[i + 2].z, pr[i + 2].w}, pb[4] = {pr[i + 1].x, pr[i + 1].y, pr[i + 1].z, pr[i + 1].w}, pc[4] = {pr[i].x, pr[i].y, pr[i].z, pr[i].w};
            const unsigned qa[4] = {qr[i].x, qr[i].y, qr[i].z, qr[i].w};
            unsigned o[4];
#pragma unroll
            for (int e = 0; e < 4; ++e)
                o[e] = pk2(lo2f(qa[e]) * (w0[2 * e] * lo2f(pc[e]) + w1[2 * e] * lo2f(pb[e]) + w2[2 * e] * lo2f(pa[e])),
                           hi2f(qa[e]) * (w0[2 * e + 1] * hi2f(pc[e]) + w1[2 * e + 1] * hi2f(pb[e]) + w2[2 * e + 1] * hi2f(pa[e])));
            *(u32x4*)(Q + (size_t)(t0 + i) * 2048 + c8) = (u32x4){o[0], o[1], o[2], o[3]};
        }
    }
}

#define XB_TMO      128
#define XB_XCNT(j)  (256  + 64 * (j))
#define XB_XSUB(j)  (1280 + 64 * (j))
#define XB_XGEN(j)  (2304 + 64 * (j))
#define XB_TOP      3328
#define XB_TOPGEN   3392
#define XCD_BAR_WORDS 3456
#define XB_SPIN_CAP (1u << 18)

__device__ __forceinline__ unsigned xb_ld(unsigned* p)              { return __hip_atomic_load(p, __ATOMIC_RELAXED, __HIP_MEMORY_SCOPE_AGENT); }
__device__ __forceinline__ unsigned xb_add(unsigned* p, unsigned v) { return __hip_atomic_fetch_add(p, v, __ATOMIC_RELAXED, __HIP_MEMORY_SCOPE_AGENT); }
__device__ __forceinline__ unsigned xb_xcc_id() { return (unsigned)__builtin_amdgcn_s_getreg((3 << 11) | 20) & 0xFu; }
#define XB_SPIN(cond, bar) do { unsigned _sp = 0; while (cond) { __builtin_amdgcn_s_sleep(1); \
    if ((++_sp & 255u) == 0u) { if (xb_ld(&(bar)[XB_TMO])) break; if (_sp > XB_SPIN_CAP) { atomicAdd(&(bar)[XB_TMO], 1u); break; } } } } while (0)

struct XcdBarrier {
    unsigned* bar; unsigned x;
    volatile LAS unsigned* st;
};

__device__ __forceinline__ XcdBarrier xcd_barrier_post(unsigned* bar, volatile LAS unsigned* st) {
    XcdBarrier b; b.bar = bar; b.x = xb_xcc_id(); b.st = st;
    if (threadIdx.x == 0) (void)xb_add(&bar[XB_XCNT(b.x)], 1u);
    return b;
}
__device__ __forceinline__ void xcd_barrier_complete(unsigned* bar, unsigned x, unsigned& nloc, unsigned& nx) {
    const unsigned G = gridDim.x * gridDim.y * gridDim.z;
    unsigned sum, cnt, mine, sp = 0u;
    for (;;) {
        sum = 0u; cnt = 0u; mine = 0u;
#pragma unroll
        for (unsigned j = 0; j < 16; ++j) { const unsigned c = xb_ld(&bar[XB_XCNT(j)]); sum += c; cnt += (c > 0u) ? 1u : 0u; mine = (j == x) ? c : mine; }
        if (sum == G) break;
        __builtin_amdgcn_s_sleep(1);
        if ((++sp & 255u) == 0u) { if (xb_ld(&bar[XB_TMO])) break; if (sp > XB_SPIN_CAP) { atomicAdd(&bar[XB_TMO], 1u); break; } }
    }
    nloc = mine > 0u ? mine : 1u; nx = cnt > 0u ? cnt : 1u;
}

__device__ __forceinline__ void xcd_barrier(const XcdBarrier& b) {
    asm volatile("s_waitcnt vmcnt(0)" ::: "memory");
    __syncthreads();
    if (threadIdx.x == 0) {
        unsigned* bar = b.bar;
        __builtin_amdgcn_s_waitcnt(0);
        unsigned nloc = b.st[0], nx = b.st[1];
        if (nloc == 0u) { xcd_barrier_complete(bar, b.x, nloc, nx); b.st[0] = nloc; b.st[1] = nx; }
        const unsigned old = xb_add(&bar[XB_XSUB(b.x)], 1u);
        const unsigned gen = old / nloc;
        if (old + 1u == (gen + 1u) * nloc) {
            __builtin_amdgcn_fence(__ATOMIC_RELEASE, "agent");
            asm volatile("s_waitcnt vmcnt(0)" ::: "memory");
            const unsigned og = xb_add(&bar[XB_TOP], 1u);
            const unsigned tg = og / nx;
            if (og + 1u == (tg + 1u) * nx) xb_add(&bar[XB_TOPGEN], 1u);
            else XB_SPIN(xb_ld(&bar[XB_TOPGEN]) == tg, bar);
            __builtin_amdgcn_fence(__ATOMIC_ACQUIRE, "agent");
            xb_add(&bar[XB_XGEN(b.x)], 1u);
            asm volatile("s_waitcnt vmcnt(0)" ::: "memory");
        } else {
            XB_SPIN(xb_ld(&bar[XB_XGEN(b.x)]) == gen, bar);
            __builtin_amdgcn_fence(__ATOMIC_ACQUIRE, "agent");
            asm volatile("s_waitcnt vmcnt(0)" ::: "memory");
        }
    }
    __syncthreads();
}

constexpr int NPHASE = 11;
#define REP_GEMM 1
#define REP_SYNC 1
#define REP_SCAN 1
#define SCAN_PROBE 1
#define REP_P0 1
#ifndef PHM
#define PHM 0x7FF
#endif
__global__ void __launch_bounds__(512, 2) mega(Prm p) {
    extern __shared__ __attribute__((aligned(16))) unsigned char shm[];
    LAS unsigned char* lds3 = (LAS unsigned char*)shm;
    unsigned char* ws = p.ws;
    volatile LAS unsigned* xst = (volatile LAS unsigned*)(lds3 + LDS_BYTES);
    if (threadIdx.x == 0) { xst[0] = 0u; xst[1] = 0u; }
    __syncthreads();
    XcdBarrier xb{};
    const bool multi = (p.ph_hi - p.ph_lo) > 1;
    if (multi) xb = xcd_barrier_post((unsigned*)(ws + OFF_BAR), xst);
    if (p.ph_lo < 0) cg::this_grid().sync();
#define PH_BEGIN(i) if (((PHM >> (i)) & 1) && p.ph_lo <= (i) && (i) < p.ph_hi) { if ((i) > p.ph_lo) { xcd_barrier(xb); if (REP_SYNC > 1) xcd_barrier(xb); } pg8::StaticOrder S; (void)S;
#define PH_END }
    PH_BEGIN(0)
        for (int rep = 0; rep < REP_P0; ++rep) {
        phase_convert(p, shm, 0, 1856, gridDim.x, blockIdx.x);
        phase_rmsnorm_x(p.in[0], p.in[1], (bf16_t*)(ws + OFF_H)); __syncthreads(); }
    PH_END
    PH_BEGIN(1)
        pg8::Gemm g{(const bf16_t*)(ws + OFF_H), (const bf16_t*)(ws + OFF_WT1), TOK, NP1, 1024, (const bf16_t*)(ws + OFF_H), 1024, 64};
        Epi1 E{(bf16_t*)(ws + OFF_QKV), (bf16_t*)p.out, (bf16_t*)(ws + OFF_UU), (bf16_t*)p.out + (size_t)TOK * 1024, (float*)(ws + OFF_BA), (bf16_t*)(ws + OFF_HALO)};
        S.init(TOK, NP1, gridDim.x, blockIdx.x); for (int rep = 0; rep < REP_GEMM; ++rep) { pg8::gemm_phase(lds3, g, S, E); __syncthreads(); }
    PH_END
    PH_BEGIN(2)
        {
            unsigned* ctr = (unsigned*)(ws + OFF_BAR) + 3600;
            volatile LAS unsigned* sIt = xst + 2;
            for (;;) {
                if (threadIdx.x == 0) sIt[0] = __hip_atomic_fetch_add(ctr, 2u, __ATOMIC_RELAXED, __HIP_MEMORY_SCOPE_AGENT);
                __syncthreads();
                const unsigned it0 = sIt[0];
                __syncthreads();
                if (it0 >= (unsigned)NIT) break;
                phase_gdn_prep(p, shm, (int)it0, 1);
            }
        }
    PH_END
    PH_BEGIN(3)
        if (blockIdx.x < 64) phase_gdn_scan(p, lds3, blockIdx.x);
        else {
            const int ob = blockIdx.x - 64, nob = gridDim.x - 64;
            if (ob < 128) phase_s5(p, shm, ob);
            {
                unsigned* cnt = (unsigned*)(ws + OFF_BAR) + 3700;
                asm volatile("s_waitcnt vmcnt(0)" ::: "memory");
                __syncthreads();
                if (threadIdx.x == 0) {
                    __builtin_amdgcn_fence(__ATOMIC_RELEASE, "agent");
                    asm volatile("s_waitcnt vmcnt(0)" ::: "memory");
                    __hip_atomic_fetch_add(cnt, 1u, __ATOMIC_RELAXED, __HIP_MEMORY_SCOPE_AGENT);
                    unsigned sp = 0;
                    while (__hip_atomic_load(cnt, __ATOMIC_RELAXED, __HIP_MEMORY_SCOPE_AGENT) < (unsigned)nob) { __builtin_amdgcn_s_sleep(2); if (++sp > (1u << 22)) break; }
                    __builtin_amdgcn_fence(__ATOMIC_ACQUIRE, "agent");
                    asm volatile("s_waitcnt vmcnt(0)" ::: "memory");
                }
                __syncthreads();
            }
            pg8::Gemm g{(const bf16_t*)(ws + OFF_UU), (const bf16_t*)(ws + OFF_WTG), TOK, 1024, 1024, (const bf16_t*)(ws + OFF_UU), 1024, 64};
            EpiGlu E{(const bf16_t*)(ws + OFF_UU), (bf16_t*)p.out + (size_t)TOK * 1024};
            S.init(TOK, 1024, nob, ob); pg8::gemm_phase(lds3, g, S, E);
            __syncthreads();
            if (ob >= 64) phase_convert(p, shm, 1856, 4928, nob - 64, ob - 64);
        }
    PH_END
    PH_BEGIN(4)
        phase_ya(p, shm);
    PH_END
    PH_BEGIN(5)
        pg8::Gemm g{(const bf16_t*)p.out, (const bf16_t*)(ws + OFF_WTO0), TOK, 1024, 2048, (const bf16_t*)p.out + (size_t)TOK * 1024, 1024, 16};
        EpiB16 E{(bf16_t*)(ws + OFF_QKV)};
        S.init(TOK, 1024, gridDim.x, blockIdx.x); for (int rep = 0; rep < REP_GEMM; ++rep) { pg8::gemm_phase(lds3, g, S, E); __syncthreads(); }
    PH_END
    PH_BEGIN(6)
        phase_post<true>(p.in[0], (const bf16_t*)(ws + OFF_QKV), p.in[2], p.out, p.in[1] + 1024, (bf16_t*)(ws + OFF_H));
    PH_END
    PH_BEGIN(7)
        pg8::Gemm g{(const bf16_t*)(ws + OFF_H), (const bf16_t*)(ws + OFF_WT2), TOK, 8192, 1024, (const bf16_t*)(ws + OFF_H), 1024, 64};
        Epi2 E{(bf16_t*)(ws + OFF_P), (bf16_t*)(ws + OFF_Q)};
        S.init(TOK, 8192, gridDim.x, blockIdx.x); for (int rep = 0; rep < REP_GEMM; ++rep) { pg8::gemm_phase(lds3, g, S, E); __syncthreads(); }
    PH_END
    PH_BEGIN(8)
        phase_conv3(p);
    PH_END
    PH_BEGIN(9)
        pg8::Gemm g{(const bf16_t*)(ws + OFF_Q), (const bf16_t*)(ws + OFF_WTO1), TOK, 1024, 2048, (const bf16_t*)(ws + OFF_Q), 2048, 64};
        EpiB16 E{(bf16_t*)(ws + OFF_P)};
        S.init(TOK, 1024, gridDim.x, blockIdx.x); for (int rep = 0; rep < REP_GEMM; ++rep) { pg8::gemm_phase(lds3, g, S, E); __syncthreads(); }
    PH_END
    PH_BEGIN(10)
        phase_post<false>(p.out, (const bf16_t*)(ws + OFF_P), p.in[2] + 1024, p.out, nullptr, nullptr);
    PH_END
}

#ifndef N_LAUNCH_MODE
#define N_LAUNCH_MODE 1
#endif

extern "C" void kernel_launch(void* const* d_in, const int* in_sizes, int n_in, void* d_out, int out_size, void* d_ws, size_t ws_size, hipStream_t stream) {
    static int ready = 0;
    if (!ready) {
        if (n_in != 21 || ws_size < WS_END || out_size != TOK * DM) { fprintf(stderr, "kernel_launch: unexpected shapes (n_in %d ws %zu out %d)\n", n_in, ws_size, out_size); ready = -1; return; }
        if (hipFuncSetAttribute((const void*)mega, hipFuncAttributeMaxDynamicSharedMemorySize, LDS_BYTES + 16) != hipSuccess) { fprintf(stderr, "kernel_launch: hipFuncSetAttribute failed\n"); ready = -1; return; }
        ready = 1;
    }
    if (ready < 0) return;
    Prm p{};
    for (int i = 0; i < 21; ++i) p.in[i] = (const float*)d_in[i];
    p.out = (float*)d_out; p.ws = (unsigned char*)d_ws;
#if N_LAUNCH_MODE == 1
    p.ph_lo = 0; p.ph_hi = NPHASE;
    void* args[] = {&p};
    if (hipMemsetAsync((unsigned char*)d_ws + OFF_BAR, 0, 16384, stream) != hipSuccess) { fprintf(stderr, "memset failed\n"); return; }
    hipError_t e = hipLaunchCooperativeKernel((const void*)mega, dim3(256), dim3(512), args, LDS_BYTES + 16, stream);
    if (e != hipSuccess) fprintf(stderr, "cooperative launch failed: %s\n", hipGetErrorString(e));
#else
    for (int ph = 0; ph < NPHASE; ++ph) {
        p.ph_lo = ph; p.ph_hi = ph + 1;
        hipLaunchKernelGGL(mega, dim3(256), dim3(512), LDS_BYTES + 16, stream, p);
    }
#endif
}
```

```cpp
#include <hip/hip_runtime.h>
#include <hip/hip_cooperative_groups.h>
#include <cstdio>
namespace cg = cooperative_groups;

#define LAS __attribute__((address_space(3)))
typedef unsigned short bf16_t;
typedef short bf16x8 __attribute__((ext_vector_type(8)));
typedef float f32x4 __attribute__((ext_vector_type(4)));
typedef float f32x16 __attribute__((ext_vector_type(16)));
typedef unsigned u32x4 __attribute__((ext_vector_type(4)));
typedef unsigned u32x2 __attribute__((ext_vector_type(2)));

constexpr int TOK = 16384, DM = 1024, SEQ = 8192;
constexpr int NP1 = 6400;
constexpr int NIT = 2048;

constexpr size_t OFF_WT1 = 0;
constexpr size_t OFF_WTG = OFF_WT1 + (size_t)NP1 * 1024 * 2;
constexpr size_t OFF_WTO0 = OFF_WTG + (size_t)1024 * 1024 * 2;
constexpr size_t OFF_WT2 = OFF_WTO0 + (size_t)1024 * 2048 * 2;
constexpr size_t OFF_WTO1 = OFF_WT2 + (size_t)8192 * 1024 * 2;
constexpr size_t OFF_H = OFF_WTO1 + (size_t)1024 * 2048 * 2;
constexpr size_t OFF_QKV = OFF_H + (size_t)TOK * 1024 * 2;
constexpr size_t OFF_UU = OFF_QKV + (size_t)TOK * 3072 * 2;
constexpr size_t OFF_WB = OFF_UU + (size_t)TOK * 1024 * 2;
constexpr size_t OFF_ATT = OFF_WB + (size_t)NIT * 8192 * 2;
constexpr size_t OFF_HALO = OFF_ATT + (size_t)NIT * 4096 * 2;
constexpr size_t OFF_BA = OFF_HALO + (size_t)256 * 3 * 3072 * 2;
constexpr size_t OFF_GL = OFF_BA + (size_t)TOK * 16 * 4;
constexpr size_t OFF_BAR = OFF_GL + (size_t)NIT * 4;
constexpr size_t WS_END = OFF_BAR + 16384;
constexpr size_t OFF_YMIX = OFF_QKV;
constexpr size_t OFF_P = OFF_QKV;
constexpr size_t OFF_Q = OFF_QKV + (size_t)TOK * 2048 * 2;
static_assert(OFF_Q + (size_t)TOK * 2048 * 2 <= OFF_WB, "Q overlaps live data");
static_assert(WS_END <= (size_t)256 * 1024 * 1024, "workspace too big");

constexpr int LDS_BYTES = 157696;

struct Prm {
    const float* in[21];
    float* out;
    unsigned char* ws;
    int ph_lo, ph_hi;
};

__device__ __forceinline__ float bf2f(bf16_t b) { return __uint_as_float(((unsigned)b) << 16); }
__device__ __forceinline__ bf16_t f2bf(float f) { unsigned u = __float_as_uint(f); u += 0x7FFFu + ((u >> 16) & 1u); return (bf16_t)(u >> 16); }
typedef __bf16 bf16v2_t __attribute__((ext_vector_type(2)));
typedef float f32x2_t __attribute__((ext_vector_type(2)));
__device__ __forceinline__ unsigned pk2(float lo, float hi) { const f32x2_t v = {lo, hi}; return __builtin_bit_cast(unsigned, __builtin_convertvector(v, bf16v2_t)); }
__device__ __forceinline__ float lo2f(unsigned u) { return __uint_as_float(u << 16); }
__device__ __forceinline__ float hi2f(unsigned u) { return __uint_as_float(u & 0xFFFF0000u); }
__device__ __forceinline__ float sigmoidf_(float x) { return 1.0f / (1.0f + __expf(-x)); }
__device__ __forceinline__ float siluf_(float x) { return x / (1.0f + __expf(-x)); }
__device__ __forceinline__ float wave_sum(float v) {
#pragma unroll
    for (int o = 32; o >= 1; o >>= 1) v += __shfl_xor(v, o);
    return v;
}
__device__ __forceinline__ u32x4 pack8(f32x4 a, f32x4 b) { u32x4 r; r.x = pk2(a[0], a[1]); r.y = pk2(a[2], a[3]); r.z = pk2(b[0], b[1]); r.w = pk2(b[2], b[3]); return r; }

namespace pg8 {
constexpr int BM = 256, BK = 64, HALF = 128, HTB = HALF * BK * 2, STAGE_BYTES = 8 * HTB, NXCD = 8, WGM = 8;
__device__ __forceinline__ int lds_byte(int r, int c) { const int st = (r >> 4) * 2 + (c >> 5), rr = r & 15, cc = c & 31, ob = rr * 64 + cc * 2; return st * 1024 + (ob ^ (((ob >> 9) & 1) << 5)); }
__device__ __forceinline__ void stage_rc(int b, int& R, int& C) { const int st = b / 1024, sb = b % 1024, swz = sb ^ (((sb >> 9) & 1) << 5); R = (st >> 1) * 16 + swz / 64; C = (st & 1) * 32 + (swz % 64) / 2; }
__device__ __forceinline__ int perm32(int rho) { const int n = rho >> 4, i = rho & 15; return 8 * (i >> 2) + 4 * n + (i & 3); }
struct Unit { int pm, pn; };
struct Gemm { const bf16_t* A; const bf16_t* Bt; int M, N, K; const bf16_t* A2; int lda, ks; };
struct StaticOrder {
    int nM, nN, nwg, G, c;
    int lmode, lbase, lcount, lhalf;
    __device__ void init(int M, int N, int G_, int c_) { nM = M / BM; nN = N / BM; nwg = nM * nN; G = G_; c = c_; lmode = 0; lbase = 0; lcount = 0; lhalf = 0; }
    __device__ void init_list(int base, int count, int half) { nM = 64; nN = 4; nwg = 256; G = 1; c = 0; lmode = 1; lbase = base; lcount = count; lhalf = half; }
    __device__ bool next(int i, Unit& u) const {
        if (lmode) { if (i >= lcount) return false; const int j = lbase + i, bb = j >> 6, r = j & 63; u.pm = 32 * bb + 16 * lhalf + (r >> 2); u.pn = r & 3; return true; }
        const long L = (long)i * G + c; if (L >= nwg) return false;
        int wgid = (int)L; { const int q = nwg / NXCD, r = nwg % NXCD, xcd = wgid % NXCD, off = wgid / NXCD; wgid = (xcd < r ? xcd * (q + 1) : r * (q + 1) + (xcd - r) * q) + off; }
        const int nig = WGM * nN, gid = wgid / nig, fm = gid * WGM, gsz = (nM - fm) < WGM ? (nM - fm) : WGM;
        u.pm = fm + ((wgid % nig) % gsz); u.pn = (wgid % nig) / gsz; return true;
    }
};

template <class Epi>
__device__ __forceinline__ void gemm_phase(LAS unsigned char* lds, const Gemm g, const StaticOrder& S, const Epi& E) {
    const int tid = threadIdx.x, wid = __builtin_amdgcn_readfirstlane(tid >> 6), lane = tid & 63, wr = wid >> 2, wc = wid & 3, fr = lane & 15, fq = lane >> 4;
    const int K = g.K, nt = K / BK;
    unsigned voffA[2], voffB[2];
#pragma unroll
    for (int i = 0; i < 2; ++i) { int R, C; stage_rc(tid * 16 + i * 8192, R, C); const int Rb = Epi::PERM ? ((R & ~31) + perm32(R & 31)) : R;
        voffA[i] = (unsigned)(R * g.lda + C) * 2u; voffB[i] = (unsigned)(Rb * K + C) * 2u; }
    const size_t kstep = (size_t)(BK * 2);
    const size_t hstep = (size_t)HALF * K * 2;
    const size_t tstep = 2 * hstep;
    const size_t hstepA = (size_t)HALF * g.lda * 2, tstepA = 2 * hstepA;
    const int ks = g.ks; const ptrdiff_t a2off = (const char*)g.A2 - (const char*)g.A - (ptrdiff_t)ks * (ptrdiff_t)kstep;
    const unsigned ldsw = (unsigned)wid * 1024u;
    const int aoff = lds_byte(wr * 64 + fr, fq * 8), boff = lds_byte(wc * 32 + fr, fq * 8);
#define PG8_SA(b, h) (((b) * 2 + (h)) * HTB)
#define PG8_SB(b, h) ((4 + (b) * 2 + (h)) * HTB)
#define PG8_STAGE(bufoff, gbase, voff) do { _Pragma("unroll") for (int _i = 0; _i < 2; ++_i) \
        __builtin_amdgcn_global_load_lds((const unsigned*)((const char*)(gbase) + (voff)[_i]), (LAS unsigned*)(lds + (bufoff) + ldsw + _i * 8192), 16, 0, 0); } while (0)
#define PG8_LDA(dst, b, h) do { _Pragma("unroll") for (int m = 0; m < 4; ++m) _Pragma("unroll") for (int k = 0; k < 2; ++k) dst[m][k] = *(const LAS bf16x8*)(lds + PG8_SA(b, h) + aoff + m * 2048 + k * 1024); } while (0)
#define PG8_LDB(dst, b, h) do { _Pragma("unroll") for (int n = 0; n < 2; ++n) _Pragma("unroll") for (int k = 0; k < 2; ++k) dst[n][k] = *(const LAS bf16x8*)(lds + PG8_SB(b, h) + boff + n * 2048 + k * 1024); } while (0)
#define PG8_MMA(ai, bj, At, Bt) do { __builtin_amdgcn_s_setprio(1); _Pragma("unroll") for (int m = 0; m < 4; ++m) _Pragma("unroll") for (int n = 0; n < 2; ++n) _Pragma("unroll") for (int k = 0; k < 2; ++k) \
        acc[ai][bj][m][n] = __builtin_amdgcn_mfma_f32_16x16x32_bf16(Bt[n][k], At[m][k], acc[ai][bj][m][n], 0, 0, 0); __builtin_amdgcn_s_setprio(0); } while (0)
#define PG8_WAIT_V(n) asm volatile("s_waitcnt vmcnt(" #n ")" ::: "memory")
#define PG8_WAIT_L(n) asm volatile("s_waitcnt lgkmcnt(" #n ")" ::: "memory")
#define PG8_BAR __builtin_amdgcn_s_barrier()
#define PG8_SCHED __builtin_amdgcn_sched_barrier(0)
    Unit cur, nxt; int ui = 0;
    if (!S.next(0, cur)) return;
    f32x4 acc[2][2][4][2];
#pragma unroll
    for (int a = 0; a < 2; ++a)
#pragma unroll
        for (int b = 0; b < 2; ++b)
#pragma unroll
            for (int m = 0; m < 4; ++m)
#pragma unroll
                for (int n = 0; n < 2; ++n) acc[a][b][m][n] = (f32x4){0.f, 0.f, 0.f, 0.f};
    bf16x8 At[4][2], B0[2][2], B1[2][2];
    const char* cA = (const char*)g.A + (size_t)cur.pm * tstepA; const char* cB = (const char*)g.Bt + (size_t)cur.pn * tstep;
    PG8_STAGE(PG8_SB(0, 0), cB, voffB); PG8_STAGE(PG8_SA(0, 0), cA, voffA); PG8_STAGE(PG8_SB(0, 1), cB + hstep, voffB); PG8_STAGE(PG8_SA(0, 1), cA + hstepA, voffA);
    if (wr == 1) PG8_BAR;
    PG8_WAIT_V(4); PG8_BAR;
    PG8_STAGE(PG8_SB(1, 0), cB + kstep, voffB); PG8_STAGE(PG8_SA(1, 0), cA + kstep, voffA); PG8_STAGE(PG8_SB(1, 1), cB + hstep + kstep, voffB);
    PG8_WAIT_V(6); PG8_BAR;
    for (;;) {
        const bool has_next = S.next(ui + 1, nxt);
        const char* nA = has_next ? (const char*)g.A + (size_t)nxt.pm * tstepA : cA; const char* nB = has_next ? (const char*)g.Bt + (size_t)nxt.pn * tstep : cB;
        for (int t = 0; t < nt; t += 2) {
            const bool last = (t == nt - 2);
            const char* a1 = cA + (size_t)(t + 1) * kstep + ((t + 1) >= ks ? a2off : 0);
            const char* a2 = last ? nA : cA + (size_t)(t + 2) * kstep + ((t + 2) >= ks ? a2off : 0); const char* b2 = last ? nB : cB + (size_t)(t + 2) * kstep;
            const char* a3 = last ? nA + kstep : cA + (size_t)(t + 3) * kstep + ((t + 3) >= ks ? a2off : 0); const char* b3 = b2 + kstep;
            PG8_LDB(B0, 0, 0); PG8_SCHED; PG8_LDA(At, 0, 0); PG8_STAGE(PG8_SA(1, 1), a1 + hstepA, voffA);
            PG8_WAIT_L(8); PG8_BAR; PG8_WAIT_L(0); PG8_MMA(0, 0, At, B0); PG8_BAR; PG8_SCHED;
            PG8_LDB(B1, 0, 1); PG8_STAGE(PG8_SB(0, 0), b2, voffB);
            PG8_BAR; PG8_WAIT_L(0); PG8_MMA(0, 1, At, B1); PG8_BAR;
            PG8_LDA(At, 0, 1); PG8_STAGE(PG8_SA(0, 0), a2, voffA);
            PG8_BAR; PG8_WAIT_L(0); PG8_MMA(1, 0, At, B0); PG8_BAR; PG8_SCHED;
            PG8_STAGE(PG8_SB(0, 1), b2 + hstep, voffB);
            PG8_WAIT_V(6); PG8_BAR; PG8_MMA(1, 1, At, B1); PG8_BAR;
            PG8_LDB(B0, 1, 0); PG8_SCHED; PG8_LDA(At, 1, 0); PG8_STAGE(PG8_SA(0, 1), a2 + hstepA, voffA);
            PG8_WAIT_L(8); PG8_BAR; PG8_WAIT_L(0); PG8_MMA(0, 0, At, B0); PG8_BAR; PG8_SCHED;
            PG8_LDB(B1, 1, 1); PG8_STAGE(PG8_SB(1, 0), b3, voffB);
            PG8_BAR; PG8_WAIT_L(0); PG8_MMA(0, 1, At, B1); PG8_BAR;
            PG8_LDA(At, 1, 1); PG8_STAGE(PG8_SA(1, 0), a3, voffA);
            PG8_BAR; PG8_WAIT_L(0); PG8_MMA(1, 0, At, B0); PG8_BAR; PG8_SCHED;
            PG8_STAGE(PG8_SB(1, 1), b3 + hstep, voffB);
            PG8_WAIT_V(6); PG8_BAR; PG8_MMA(1, 1, At, B1); PG8_BAR;
        }
        E(acc, cur, wr, wc, fr, fq);
        if (!has_next) break;
#pragma unroll
        for (int a = 0; a < 2; ++a)
#pragma unroll
            for (int b = 0; b < 2; ++b)
#pragma unroll
                for (int m = 0; m < 4; ++m)
#pragma unroll
                    for (int n = 0; n < 2; ++n) acc[a][b][m][n] = (f32x4){0.f, 0.f, 0.f, 0.f};
        cur = nxt; cA = nA; cB = nB; ++ui;
    }
    PG8_WAIT_V(0);
    if (wr == 0) PG8_BAR;
    PG8_BAR;
#undef PG8_SA
#undef PG8_SB
#undef PG8_STAGE
#undef PG8_LDA
#undef PG8_LDB
#undef PG8_MMA
#undef PG8_WAIT_V
#undef PG8_WAIT_L
#undef PG8_BAR
#undef PG8_SCHED
}
}
using pg8::Unit;

struct Epi1 {
    static constexpr bool PERM = true;
    bf16_t* QKV; bf16_t* SZA; bf16_t* UU; bf16_t* SZB; float* BA; bf16_t* HALO;
    __device__ __forceinline__ void operator()(const f32x4 (&acc)[2][2][4][2], const Unit& u, int wr, int wc, int fr_, int fq_) const {
        int lane = (int)(threadIdx.x & 63); asm volatile("" : "+v"(lane));
        const int fr = lane & 15, fq = lane >> 4; (void)fr_; (void)fq_;
        const int row0 = u.pm * 256 + wr * 64 + fr, pn = u.pn;
#pragma unroll
        for (int ai = 0; ai < 2; ++ai)
#pragma unroll
            for (int m = 0; m < 4; ++m) {
                const size_t row = (size_t)(row0 + ai * 128 + m * 16);
#pragma unroll
                for (int bj = 0; bj < 2; ++bj) {
                    const int colt = 128 * bj + 32 * wc + 8 * fq;
                    f32x4 v0 = acc[ai][bj][m][0], v1 = acc[ai][bj][m][1];
                    if (pn < 12) {
                        const int c = pn * 256 + colt; const u32x4 pk = pack8(v0, v1);
                        *(u32x4*)(QKV + row * 3072 + c) = pk;
                        if (m == 3 && fr >= 13) *(u32x4*)(HALO + ((row >> 6) * 3 + (fr - 13)) * 3072 + c) = pk;
                    } else if (pn < 16) {
#pragma unroll
                        for (int e = 0; e < 4; ++e) { v0[e] = siluf_(v0[e]); v1[e] = siluf_(v1[e]); }
                        *(u32x4*)(SZA + row * 1024 + (pn - 12) * 256 + colt) = pack8(v0, v1);
                    } else if (pn < 20) {
                        *(u32x4*)(UU + row * 1024 + (pn - 16) * 256 + colt) = pack8(v0, v1);
                    } else if (pn < 24) {
#pragma unroll
                        for (int e = 0; e < 4; ++e) { v0[e] = siluf_(v0[e]); v1[e] = siluf_(v1[e]); }
                        *(u32x4*)(SZB + row * 1024 + (pn - 20) * 256 + colt) = pack8(v0, v1);
                    } else if (colt < 16) {
                        *(f32x4*)(BA + row * 16 + colt) = v0; *(f32x4*)(BA + row * 16 + colt + 4) = v1;
                    }
                }
            }
    }
};
struct EpiGlu {
    static constexpr bool PERM = true;
    const bf16_t* Y5; bf16_t* SZB;
    __device__ __forceinline__ void operator()(const f32x4 (&acc)[2][2][4][2], const Unit& u, int wr, int wc, int fr, int fq) const {
        const int row0 = u.pm * 256 + wr * 64 + fr;
#pragma unroll
        for (int ai = 0; ai < 2; ++ai)
#pragma unroll
            for (int m = 0; m < 4; ++m) {
                const size_t row = (size_t)(row0 + ai * 128 + m * 16);
#pragma unroll
                for (int bj = 0; bj < 2; ++bj) {
                    const int c = u.pn * 256 + 128 * bj + 32 * wc + 8 * fq;
                    const u32x4 y = *(const u32x4*)(Y5 + row * 1024 + c), z = *(const u32x4*)(SZB + row * 1024 + c);
                    const f32x4 a0 = acc[ai][bj][m][0], a1 = acc[ai][bj][m][1];
                    u32x4 o;
                    o.x = pk2(lo2f(y.x) * sigmoidf_(a0[0]) * lo2f(z.x), hi2f(y.x) * sigmoidf_(a0[1]) * hi2f(z.x));
                    o.y = pk2(lo2f(y.y) * sigmoidf_(a0[2]) * lo2f(z.y), hi2f(y.y) * sigmoidf_(a0[3]) * hi2f(z.y));
                    o.z = pk2(lo2f(y.z) * sigmoidf_(a1[0]) * lo2f(z.z), hi2f(y.z) * sigmoidf_(a1[1]) * hi2f(z.z));
                    o.w = pk2(lo2f(y.w) * sigmoidf_(a1[2]) * lo2f(z.w), hi2f(y.w) * sigmoidf_(a1[3]) * hi2f(z.w));
                    *(u32x4*)(SZB + row * 1024 + c) = o;
                }
            }
    }
};
struct EpiF32 {
    static constexpr bool PERM = false;
    float* C;
    __device__ __forceinline__ void operator()(const f32x4 (&acc)[2][2][4][2], const Unit& u, int wr, int wc, int fr, int fq) const {
        const int row0 = u.pm * 256 + wr * 64 + fr, col0 = u.pn * 256 + wc * 32 + 4 * fq;
#pragma unroll
        for (int ai = 0; ai < 2; ++ai)
#pragma unroll
            for (int m = 0; m < 4; ++m) { float* rowp = C + (size_t)(row0 + ai * 128 + m * 16) * 1024 + col0;
#pragma unroll
                for (int bj = 0; bj < 2; ++bj)
#pragma unroll
                    for (int n = 0; n < 2; ++n) *(f32x4*)(rowp + bj * 128 + n * 16) = acc[ai][bj][m][n]; }
    }
};
struct EpiB16 {
    static constexpr bool PERM = true;
    bf16_t* C;
    __device__ __forceinline__ void operator()(const f32x4 (&acc)[2][2][4][2], const Unit& u, int wr, int wc, int fr, int fq) const {
        const int row0 = u.pm * 256 + wr * 64 + fr, col0 = u.pn * 256 + wc * 32 + 8 * fq;
#pragma unroll
        for (int ai = 0; ai < 2; ++ai)
#pragma unroll
            for (int m = 0; m < 4; ++m) { bf16_t* rowp = C + (size_t)(row0 + ai * 128 + m * 16) * 1024 + col0;
#pragma unroll
                for (int bj = 0; bj < 2; ++bj) *(u32x4*)(rowp + bj * 128) = pack8(acc[ai][bj][m][0], acc[ai][bj][m][1]); }
    }
};
struct Epi2 {
    static constexpr bool PERM = false;
    bf16_t* P; bf16_t* Q;
    __device__ __forceinline__ void operator()(const f32x4 (&acc)[2][2][4][2], const Unit& u, int wr, int wc, int fr, int fq) const {
        const int row0 = u.pm * 256 + wr * 64 + fr, ch = u.pn * 64 + 16 * wc + 4 * fq;
#pragma unroll
        for (int ai = 0; ai < 2; ++ai)
#pragma unroll
            for (int m = 0; m < 4; ++m) {
                const size_t row = (size_t)(row0 + ai * 128 + m * 16);
                const f32x4 gb = acc[ai][0][m][0], gc = acc[ai][0][m][1], hv = acc[ai][1][m][0], z = acc[ai][1][m][1];
                u32x2 pp, qq;
                pp.x = pk2(gc[0] * hv[0], gc[1] * hv[1]); pp.y = pk2(gc[2] * hv[2], gc[3] * hv[3]);
                qq.x = pk2(gb[0] * siluf_(z[0]), gb[1] * siluf_(z[1])); qq.y = pk2(gb[2] * siluf_(z[2]), gb[3] * siluf_(z[3]));
                *(u32x2*)(P + row * 2048 + ch) = pp; *(u32x2*)(Q + row * 2048 + ch) = qq;
            }
    }
};

__device__ __forceinline__ int src_col(int mode, int n, int& pn_unused) {
    (void)pn_unused;
    if (mode == 0) return n;
    if (mode == 1) { if (n < 4096) return n; if (n < 6144) return n + 16; if (n < 6160) return n - 2048; return -1; }
    const int pn = n >> 8, col = n & 255, bj = col >> 7, wc = (col >> 5) & 3, nn = (col >> 4) & 1, lo = col & 15;
    return (2 * bj + nn) * 2048 + pn * 64 + 16 * wc + lo;
}
__device__ __forceinline__ void phase_convert(const Prm& p, unsigned char* lds, int t_begin, int t_end, int nblk, int bidx) {
    float* tile = (float*)lds;
    const int tid = threadIdx.x;
    for (int tix = t_begin + bidx; tix < t_end; tix += nblk) {
        int tl = tix, K, Nsrc, mode; const float* W; bf16_t* Wt;
        if (tl < 1600) { W = p.in[3]; Wt = (bf16_t*)(p.ws + OFF_WT1); K = 1024; Nsrc = 6160; mode = 1; }
        else if ((tl -= 1600) < 256) { W = p.in[16]; Wt = (bf16_t*)(p.ws + OFF_WTG); K = 1024; Nsrc = 1024; mode = 0; }
        else if ((tl -= 256) < 512) { W = p.in[17]; Wt = (bf16_t*)(p.ws + OFF_WTO0); K = 2048; Nsrc = 1024; mode = 0; }
        else if ((tl -= 512) < 2048) { W = p.in[18]; Wt = (bf16_t*)(p.ws + OFF_WT2); K = 1024; Nsrc = 8192; mode = 2; }
        else { tl -= 2048; W = p.in[20]; Wt = (bf16_t*)(p.ws + OFF_WTO1); K = 2048; Nsrc = 1024; mode = 0; }
        const int ntk = K / 64, n0 = (tl / ntk) * 64, k0 = (tl % ntk) * 64;
        { const int j = tid & 63; int dummy = 0; const int sc = src_col(mode, n0 + j, dummy);
#pragma unroll
          for (int i = 0; i < 8; ++i) { const int k = (tid >> 6) + 8 * i; tile[k * 65 + j] = sc >= 0 ? W[(size_t)(k0 + k) * Nsrc + sc] : 0.0f; } }
        __syncthreads();
        { const int r = tid >> 3, c8 = (tid & 7) * 8; u32x4 o;
          o.x = pk2(tile[(c8 + 0) * 65 + r], tile[(c8 + 1) * 65 + r]); o.y = pk2(tile[(c8 + 2) * 65 + r], tile[(c8 + 3) * 65 + r]);
          o.z = pk2(tile[(c8 + 4) * 65 + r], tile[(c8 + 5) * 65 + r]); o.w = pk2(tile[(c8 + 6) * 65 + r], tile[(c8 + 7) * 65 + r]);
          *(u32x4*)(Wt + (size_t)(n0 + r) * K + k0 + c8) = o; }
        __syncthreads();
    }
}
__device__ __forceinline__ void phase_rmsnorm_x(const float* x, const float* w, bf16_t* H) {
    const int lane = threadIdx.x & 63, nw = gridDim.x * 8;
    for (int row = blockIdx.x * 8 + (threadIdx.x >> 6); row < TOK; row += nw) {
        const f32x4* xr = (const f32x4*)(x + (size_t)row * 1024);
        f32x4 v[4]; float ss = 0.f;
#pragma unroll
        for (int i = 0; i < 4; ++i) { v[i] = xr[lane + 64 * i]; ss += v[i][0] * v[i][0] + v[i][1] * v[i][1] + v[i][2] * v[i][2] + v[i][3] * v[i][3]; }
        ss = wave_sum(ss);
        const float rstd = rsqrtf(ss * (1.0f / 1024.0f) + 1e-6f);
#pragma unroll
        for (int i = 0; i < 4; ++i) { const f32x4 w4 = ((const f32x4*)w)[lane + 64 * i]; u32x2 o;
            o.x = pk2(v[i][0] * rstd * w4[0], v[i][1] * rstd * w4[1]); o.y = pk2(v[i][2] * rstd * w4[2], v[i][3] * rstd * w4[3]);
            *(u32x2*)(H + (size_t)row * 1024 + (lane + 64 * i) * 4) = o; }
    }
}
template <bool NEXT>
__device__ __forceinline__ void phase_post(const float* base, const bf16_t* Y, const float* wpost, float* OUT, const float* wpre, bf16_t* H) {
    const int lane = threadIdx.x & 63, nw = gridDim.x * 8;
    for (int row = blockIdx.x * 8 + (threadIdx.x >> 6); row < TOK; row += nw) {
        const u32x2* yr = (const u32x2*)(Y + (size_t)row * 1024); const f32x4* br = (const f32x4*)(base + (size_t)row * 1024);
        f32x4 v[4], xb[4]; float ss = 0.f;
#pragma unroll
        for (int i = 0; i < 4; ++i) { const u32x2 y2 = yr[lane + 64 * i]; v[i] = (f32x4){lo2f(y2.x), hi2f(y2.x), lo2f(y2.y), hi2f(y2.y)}; xb[i] = br[lane + 64 * i]; ss += v[i][0] * v[i][0] + v[i][1] * v[i][1] + v[i][2] * v[i][2] + v[i][3] * v[i][3]; }
        ss = wave_sum(ss);
        const float rstd = rsqrtf(ss * (1.0f / 1024.0f) + 1e-6f);
        float s2 = 0.f;
#pragma unroll
        for (int i = 0; i < 4; ++i) { const f32x4 w4 = ((const f32x4*)wpost)[lane + 64 * i];
#pragma unroll
            for (int e = 0; e < 4; ++e) { v[i][e] = xb[i][e] + v[i][e] * rstd * w4[e]; s2 += v[i][e] * v[i][e]; }
            ((f32x4*)(OUT + (size_t)row * 1024))[lane + 64 * i] = v[i]; }
        if (NEXT) {
            s2 = wave_sum(s2);
            const float r2 = rsqrtf(s2 * (1.0f / 1024.0f) + 1e-6f);
#pragma unroll
            for (int i = 0; i < 4; ++i) { const f32x4 w4 = ((const f32x4*)wpre)[lane + 64 * i]; u32x2 o;
                o.x = pk2(v[i][0] * r2 * w4[0], v[i][1] * r2 * w4[1]); o.y = pk2(v[i][2] * r2 * w4[2], v[i][3] * r2 * w4[3]);
                *(u32x2*)(H + (size_t)row * 1024 + (lane + 64 * i) * 4) = o; }
        }
    }
}


__device__ __forceinline__ void sincos_d(double x, double& s, double& c) {
    const double k = rint(x * 0.6366197723675814);
    const double r = fma(-k, 6.123233995736766e-17, fma(-k, 1.5707963267948966, x)), r2 = r * r;
    double sp = -7.647163731819816e-13; sp = fma(sp, r2, 1.6059043836821613e-10); sp = fma(sp, r2, -2.505210838544172e-8); sp = fma(sp, r2, 2.7557319223985893e-6);
    sp = fma(sp, r2, -1.984126984126984e-4); sp = fma(sp, r2, 8.333333333333333e-3); sp = fma(sp, r2, -1.6666666666666666e-1); sp = fma(sp * r2, r, r);
    double cp = 4.779477332387385e-14; cp = fma(cp, r2, -1.1470745597729725e-11); cp = fma(cp, r2, 2.08767569878681e-9); cp = fma(cp, r2, -2.755731922398589e-7);
    cp = fma(cp, r2, 2.48015873015873e-5); cp = fma(cp, r2, -1.388888888888889e-3); cp = fma(cp, r2, 4.1666666666666664e-2); cp = fma(cp, r2, -0.5); cp = fma(cp, r2, 1.0);
    const int q = ((int)k) & 3;
    const double s0 = (q & 1) ? cp : sp, c0 = (q & 1) ? sp : cp;
    s = (q & 2) ? -s0 : s0; c = ((q + 1) & 2) ? -c0 : c0;
}
__device__ __forceinline__ double exp_d(double x) {
    const double n = rint(x * 1.4426950408889634);
    const double r = fma(-n, 2.3190468138462996e-17, fma(-n, 0.6931471805599453, x));
    double p = 1.6059043836821613e-10; p = fma(p, r, 2.08767569878681e-9); p = fma(p, r, 2.505210838544172e-8); p = fma(p, r, 2.755731922398589e-7); p = fma(p, r, 2.7557319223985893e-6);
    p = fma(p, r, 2.48015873015873e-5); p = fma(p, r, 1.984126984126984e-4); p = fma(p, r, 1.388888888888889e-3); p = fma(p, r, 8.333333333333333e-3); p = fma(p, r, 4.1666666666666664e-2);
    p = fma(p, r, 1.6666666666666666e-1); p = fma(p, r, 0.5); p = fma(p, r, 1.0); p = fma(p, r, 1.0);
    return ldexp(p, (int)n);
}
__device__ __forceinline__ float bcast_lo(float v) { auto r = __builtin_amdgcn_permlane32_swap(__float_as_uint(v), __float_as_uint(v), false, false); return __uint_as_float(r[0]); }
__device__ __forceinline__ float bcast_hi(float v) { auto r = __builtin_amdgcn_permlane32_swap(__float_as_uint(v), __float_as_uint(v), false, false); return __uint_as_float(r[1]); }

struct S5C {
    float ar[2][4], ai[2][4];
    float a512r[2], a512i[2];
    bf16x8 BB[4];
    bf16x8 CC[4];
    float dco;
};

template <bool OUT>
__device__ __forceinline__ void s5_chunk(const S5C& C, bf16_t* UU, int b, int g, int chunk, float (&st)[2][2], bf16_t* sX, int lane) {
    const int n = lane & 31, hh = lane >> 5, fr = lane & 15, fq = lane >> 4;
    const size_t tok0 = (size_t)b * SEQ + (size_t)chunk * 512;
    bf16x8 ua = *(const bf16x8*)(UU + (tok0 + n) * 1024 + 16 * g + 8 * hh);
    bf16_t uo[8];
    if (OUT) {
#pragma unroll
        for (int mt = 0; mt < 2; ++mt)
#pragma unroll
            for (int j = 0; j < 4; ++j) uo[mt * 4 + j] = UU[(tok0 + 16 * mt + 4 * fq + j) * 1024 + 16 * g + fr];
    }
    for (int blk = 0; blk < 16; ++blk) {
        const size_t t0 = tok0 + (size_t)blk * 32;
        const bf16x8 ucur = ua;
        bf16_t ucuro[8];
        if (OUT) {
#pragma unroll
            for (int i = 0; i < 8; ++i) ucuro[i] = uo[i];
        }
        if (blk < 15) {
            ua = *(const bf16x8*)(UU + (t0 + 32 + n) * 1024 + 16 * g + 8 * hh);
            if (OUT) {
#pragma unroll
                for (int mt = 0; mt < 2; ++mt)
#pragma unroll
                    for (int j = 0; j < 4; ++j) uo[mt * 4 + j] = UU[(t0 + 32 + 16 * mt + 4 * fq + j) * 1024 + 16 * g + fr];
            }
        }
        f32x16 acc[4];
#pragma unroll
        for (int tl = 0; tl < 4; ++tl) {
            f32x16 z;
#pragma unroll
            for (int i = 0; i < 16; ++i) z[i] = 0.f;
            acc[tl] = __builtin_amdgcn_mfma_f32_32x32x16_bf16(ucur, C.BB[tl], z, 0, 0, 0);
        }
#pragma unroll
        for (int tp = 0; tp < 2; ++tp) {
            f32x16& re = acc[2 * tp]; f32x16& im = acc[2 * tp + 1];
            const float a1r = C.ar[tp][0], a1i = C.ai[tp][0];
#pragma unroll
            for (int q = 0; q < 4; ++q)
#pragma unroll
                for (int r = 1; r < 4; ++r) {
                    const float pr = re[4 * q + r - 1], pi = im[4 * q + r - 1];
                    re[4 * q + r] += a1r * pr - a1i * pi; im[4 * q + r] += a1r * pi + a1i * pr;
                }
            float cr = st[tp][0], ci = st[tp][1];
            const float a4r = C.ar[tp][3], a4i = C.ai[tp][3];
#pragma unroll
            for (int q = 0; q < 4; ++q) {
                const float tr = re[4 * q + 3] + a4r * cr - a4i * ci, ti = im[4 * q + 3] + a4r * ci + a4i * cr;
                const float o0r = bcast_lo(tr), o0i = bcast_lo(ti);
                const float xr = hh ? o0r : cr, xi = hh ? o0i : ci;
                if (OUT) {
#pragma unroll
                    for (int r = 0; r < 4; ++r) { const float kr = C.ar[tp][r], ki = C.ai[tp][r];
                        re[4 * q + r] += kr * xr - ki * xi; im[4 * q + r] += kr * xi + ki * xr; }
                } else {
                    re[4 * q + 3] += a4r * xr - a4i * xi; im[4 * q + 3] += a4r * xi + a4i * xr;
                }
                cr = bcast_hi(re[4 * q + 3]); ci = bcast_hi(im[4 * q + 3]);
            }
            st[tp][0] = cr; st[tp][1] = ci;
        }
        if (OUT) {
            asm volatile("s_waitcnt lgkmcnt(0)" ::: "memory");
#pragma unroll
            for (int tp = 0; tp < 2; ++tp)
#pragma unroll
                for (int i = 0; i < 16; ++i) {
                    const int t = 8 * (i >> 2) + 4 * hh + (i & 3);
                    *(unsigned*)(sX + t * 136 + 2 * (n + 32 * tp)) = pk2(acc[2 * tp][i], acc[2 * tp + 1][i]);
                }
            asm volatile("s_waitcnt lgkmcnt(0)" ::: "memory");
            __builtin_amdgcn_wave_barrier();
#pragma unroll
            for (int mt = 0; mt < 2; ++mt) {
                f32x4 y = (f32x4){0.f, 0.f, 0.f, 0.f};
#pragma unroll
                for (int ks = 0; ks < 4; ++ks) {
                    const bf16x8 xa = *(const bf16x8*)(sX + (16 * mt + fr) * 136 + 32 * ks + 8 * fq);
                    y = __builtin_amdgcn_mfma_f32_16x16x32_bf16(xa, C.CC[ks], y, 0, 0, 0);
                }
#pragma unroll
                for (int j = 0; j < 4; ++j) {
                    float v = y[j] + C.dco * bf2f(ucuro[mt * 4 + j]);
                    const float inner = 0.7978845608028654f * (v + 0.044715f * v * v * v);
                    v = v / (1.0f + __expf(-2.0f * inner));
                    UU[(t0 + 16 * mt + 4 * fq + j) * 1024 + 16 * g + fr] = f2bf(v);
                }
            }
            asm volatile("s_waitcnt lgkmcnt(0)" ::: "memory");
            __builtin_amdgcn_wave_barrier();
        }
    }
}

__device__ __forceinline__ void phase_s5(const Prm& p, unsigned char* lds, int bg) {
    const int b = bg >> 6, g = bg & 63;
    const int tid = threadIdx.x, wv = tid >> 6, lane = tid & 63, n = lane & 31, hh = lane >> 5, fr = lane & 15, fq = lane >> 4;
    bf16_t* sX = (bf16_t*)(lds + wv * 8704);
    float* sXE = (float*)(lds + 8 * 8704);
    bf16_t* UU = (bf16_t*)(p.ws + OFF_UU);
    const float* lam_re = p.in[8]; const float* lam_im = p.in[9]; const float* b_re = p.in[10]; const float* b_im = p.in[11];
    const float* c_re = p.in[12]; const float* c_im = p.in[13];
    S5C C;
    const double dt = exp_d((double)p.in[14][g]);
    float fre[2], fim[2];
#pragma unroll
    for (int tp = 0; tp < 2; ++tp) {
        const int pp = n + 32 * tp;
        const double lr = (double)fminf(lam_re[g * 64 + pp], -1e-4f), li = (double)lam_im[g * 64 + pp];
#pragma unroll
        for (int k = 0; k < 4; ++k) { double sn, cs; sincos_d(li * dt * (k + 1), sn, cs); const double mag = exp_d(lr * dt * (k + 1)); C.ar[tp][k] = (float)(mag * cs); C.ai[tp][k] = (float)(mag * sn); }
        { double sn, cs; sincos_d(li * dt * 512.0, sn, cs); const double mag = exp_d(lr * dt * 512.0); C.a512r[tp] = (float)(mag * cs); C.a512i[tp] = (float)(mag * sn); }
        double sn, cs; sincos_d(li * dt, sn, cs);
        const double mag = exp_d(lr * dt), abr = mag * cs, abi = mag * sn;
        const double den = lr * lr + li * li, nr = abr - 1.0, ni = abi;
        fre[tp] = (float)((nr * lr + ni * li) / den); fim[tp] = (float)((ni * lr - nr * li) / den);
    }
#pragma unroll
    for (int tl = 0; tl < 4; ++tl) {
        const int tp = tl >> 1, ri = tl & 1, pp = n + 32 * tp;
#pragma unroll
        for (int j = 0; j < 8; ++j) {
            const int ch = 8 * hh + j;
            const float br = b_re[(g * 64 + pp) * 16 + ch], bi = b_im[(g * 64 + pp) * 16 + ch];
            const float v = ri == 0 ? fre[tp] * br - fim[tp] * bi : fre[tp] * bi + fim[tp] * br;
            C.BB[tl][j] = (short)f2bf(v);
        }
    }
#pragma unroll
    for (int ks = 0; ks < 4; ++ks)
#pragma unroll
        for (int j = 0; j < 8; ++j) {
            const int k = 32 * ks + 8 * fq + j, pp = k >> 1, ri = k & 1;
            const float v = ri == 0 ? c_re[(g * 16 + fr) * 64 + pp] : -c_im[(g * 16 + fr) * 64 + pp];
            C.CC[ks][j] = (short)f2bf(v);
        }
    C.dco = p.in[15][16 * g + fr];
    for (int rd = 0; rd < 2; ++rd) {
        const int chunk = wv + 8 * rd;
        float st[2][2] = {{0.f, 0.f}, {0.f, 0.f}};
        s5_chunk<false>(C, UU, b, g, chunk, st, sX, lane);
        if (hh == 0) {
#pragma unroll
            for (int tp = 0; tp < 2; ++tp) { sXE[(chunk * 64 + n + 32 * tp) * 2 + 0] = st[tp][0]; sXE[(chunk * 64 + n + 32 * tp) * 2 + 1] = st[tp][1]; }
        }
    }
    __syncthreads();
    for (int rd = 0; rd < 2; ++rd) {
        const int chunk = wv + 8 * rd;
        float st[2][2] = {{0.f, 0.f}, {0.f, 0.f}};
        for (int c2 = 0; c2 < chunk; ++c2) {
#pragma unroll
            for (int tp = 0; tp < 2; ++tp) {
                const float er = sXE[(c2 * 64 + n + 32 * tp) * 2 + 0], ei = sXE[(c2 * 64 + n + 32 * tp) * 2 + 1];
                const float nr = C.a512r[tp] * st[tp][0] - C.a512i[tp] * st[tp][1] + er, ni = C.a512r[tp] * st[tp][1] + C.a512i[tp] * st[tp][0] + ei;
                st[tp][0] = nr; st[tp][1] = ni;
            }
        }
        s5_chunk<true>(C, UU, b, g, chunk, st, sX, lane);
        if (rd == 0) {
            asm volatile("s_waitcnt vmcnt(0)" ::: "memory");
            __syncthreads();
            if (threadIdx.x == 0) { __builtin_amdgcn_fence(__ATOMIC_RELEASE, "agent"); asm volatile("s_waitcnt vmcnt(0)" ::: "memory");
                __hip_atomic_fetch_add((unsigned*)(p.ws + OFF_BAR) + 3900, 1u, __ATOMIC_RELAXED, __HIP_MEMORY_SCOPE_AGENT); }
        }
    }
    __syncthreads();
}

__device__ __forceinline__ void phase_gdn_prep(const Prm& p, unsigned char* lds, int it0, int nrounds) {
    const int tid0 = threadIdx.x, hb = tid0 >> 8;
    unsigned char* base = lds + hb * 76800;
    bf16_t* sQ = (bf16_t*)base;
    bf16_t* sK = (bf16_t*)(base + 17408);
    bf16_t* sV = (bf16_t*)(base + 2 * 17408);
    float* sL = (float*)(base + 3 * 17408);
    float* sBeta = (float*)(base + 4 * 17408);
    float* sGc = sBeta + 64; float* sEg = sGc + 64; float* sBE = sEg + 64;
    float* sCW = sBE + 64;
    bf16_t* QKV = (bf16_t*)(p.ws + OFF_QKV); const bf16_t* HALO = (const bf16_t*)(p.ws + OFF_HALO);
    const float* BA = (const float*)(p.ws + OFF_BA); float* GL = (float*)(p.ws + OFF_GL);
    bf16_t* WB = (bf16_t*)(p.ws + OFF_WB); bf16_t* ATT = (bf16_t*)(p.ws + OFF_ATT);
    const float* convw = p.in[4];
    for (int rd = 0; rd < nrounds; ++rd) {
        int tid = tid0; asm volatile("" : "+v"(tid));
        const int ht = tid & 255, hw = (tid >> 6) & 3, lane = tid & 63, fr = lane & 15, fq = lane >> 4;
        const int it = it0 + rd * 2 + hb;
        const int b = it >> 10, h = (it >> 7) & 7, nc = it & 127;
        const size_t tokb = (size_t)b * SEQ + (size_t)nc * 64;
#pragma unroll
        for (int i = 0; i < 6; ++i) { const int idx = ht + 256 * i, s3 = idx >> 9, tap = (idx >> 7) & 3, ch = idx & 127; sCW[idx] = convw[tap * 3072 + s3 * 1024 + h * 128 + ch]; }
        __syncthreads();
        {
            const int t0 = (ht >> 4) * 4, cgp = ht & 15;
#pragma unroll 1
            for (int s = 0; s < 3; ++s) {
                const int col = s * 1024 + h * 128 + cgp * 8;
                u32x4 xr[7];
#pragma unroll
                for (int i = 0; i < 7; ++i) {
                    const int tt = t0 - 3 + i;
                    xr[i] = (u32x4){0u, 0u, 0u, 0u};
                    if (tt >= 0) xr[i] = *(const u32x4*)(QKV + (tokb + tt) * 3072 + col);
                    else if (nc > 0) xr[i] = *(const u32x4*)(HALO + ((size_t)(b * 128 + nc - 1) * 3 + (3 + tt)) * 3072 + col);
                }
                f32x4 w0[4], w1[4];
#pragma unroll
                for (int j = 0; j < 4; ++j) { w0[j] = *(const f32x4*)(sCW + s * 512 + j * 128 + cgp * 8); w1[j] = *(const f32x4*)(sCW + s * 512 + j * 128 + cgp * 8 + 4); }
                float o[4][8], ss[4];
#pragma unroll
                for (int tk = 0; tk < 4; ++tk) {
                    float a[8];
#pragma unroll
                    for (int e = 0; e < 8; ++e) a[e] = 0.f;
#pragma unroll
                    for (int j = 0; j < 4; ++j) {
                        const u32x4 xv = xr[tk + j];
                        a[0] += w0[j][0] * lo2f(xv.x); a[1] += w0[j][1] * hi2f(xv.x); a[2] += w0[j][2] * lo2f(xv.y); a[3] += w0[j][3] * hi2f(xv.y);
                        a[4] += w1[j][0] * lo2f(xv.z); a[5] += w1[j][1] * hi2f(xv.z); a[6] += w1[j][2] * lo2f(xv.w); a[7] += w1[j][3] * hi2f(xv.w);
                    }
                    float acc2 = 0.f;
#pragma unroll
                    for (int e = 0; e < 8; ++e) { const float v = siluf_(a[e]); o[tk][e] = v; acc2 += v * v; }
                    ss[tk] = acc2;
                }
                bf16_t* dst = (s == 0 ? sQ : (s == 1 ? sK : sV)) + t0 * 136 + cgp * 8;
#pragma unroll
                for (int tk = 0; tk < 4; ++tk) {
                    float sc = 1.0f;
                    if (s < 2) { float q = ss[tk]; q += __shfl_xor(q, 1); q += __shfl_xor(q, 2); q += __shfl_xor(q, 4); q += __shfl_xor(q, 8); sc = rsqrtf(q + 1e-6f) * (s == 0 ? 0.08838834764831845f : 1.0f); }
                    u32x4 pk;
                    pk.x = pk2(o[tk][0] * sc, o[tk][1] * sc); pk.y = pk2(o[tk][2] * sc, o[tk][3] * sc); pk.z = pk2(o[tk][4] * sc, o[tk][5] * sc); pk.w = pk2(o[tk][6] * sc, o[tk][7] * sc);
                    *(u32x4*)(dst + tk * 136) = pk;
                }
            }
        }
        if (hw == 0) {
            const size_t tg = tokb + lane;
            const float braw = BA[tg * 16 + h], araw = BA[tg * 16 + 8 + h];
            const float beta = 1.0f / (1.0f + expf(-braw));
            const float xx = araw + p.in[6][h];
            const float sp = xx > 20.f ? xx : log1pf(expf(xx));
            float gg = -expf(p.in[5][h]) * sp;
#pragma unroll
            for (int off = 1; off < 64; off <<= 1) { const float o = __shfl_up(gg, off); if (lane >= off) gg += o; }
            sBeta[lane] = beta; sGc[lane] = gg; sEg[lane] = expf(gg); sBE[lane] = beta * expf(gg);
            if (lane == 63) GL[it] = expf(gg);
        }
        __syncthreads();
        {
            bf16x8 aK[4], aQ[4];
#pragma unroll
            for (int ks = 0; ks < 4; ++ks) { aK[ks] = *(const bf16x8*)(sK + (16 * hw + fr) * 136 + 32 * ks + 8 * fq); aQ[ks] = *(const bf16x8*)(sQ + (16 * hw + fr) * 136 + 32 * ks + 8 * fq); }
#pragma unroll
            for (int nt = 0; nt < 4; ++nt) {
                f32x4 kk = (f32x4){0.f, 0.f, 0.f, 0.f}, qk = (f32x4){0.f, 0.f, 0.f, 0.f};
#pragma unroll
                for (int ks = 0; ks < 4; ++ks) {
                    const bf16x8 bK = *(const bf16x8*)(sK + (16 * nt + fr) * 136 + 32 * ks + 8 * fq);
                    kk = __builtin_amdgcn_mfma_f32_16x16x32_bf16(aK[ks], bK, kk, 0, 0, 0);
                    qk = __builtin_amdgcn_mfma_f32_16x16x32_bf16(aQ[ks], bK, qk, 0, 0, 0);
                }
                const int mcol = 16 * nt + fr; const float gm = sGc[mcol];
#pragma unroll
                for (int j = 0; j < 4; ++j) {
                    const int c = 16 * hw + 4 * fq + j;
                    const float dec = __expf(fminf(sGc[c] - gm, 0.f));
                    sL[c * 68 + mcol] = (mcol < c) ? kk[j] * sBeta[c] * dec : 0.f;
                    ATT[(size_t)it * 4096 + c * 64 + mcol] = f2bf((mcol <= c) ? qk[j] * dec : 0.f);
                }
            }
        }
        __syncthreads();
        {
            f32x2_t xv[32];
#define X_(i) (xv[(i) >> 1][(i) & 1])
            const bool isU = ht < 128; const int jc = ht & 127;
            const bf16_t* src = isU ? sV : sK;
            const float* fac = isU ? sBeta : sBE;
#pragma unroll
            for (int cb = 0; cb < 16; ++cb) {
                f32x2_t a2[4];
#pragma unroll
                for (int r = 0; r < 4; ++r) { a2[r].x = bf2f(src[(4 * cb + r) * 136 + jc]) * fac[4 * cb + r]; a2[r].y = 0.f; }
                const f32x4 d1 = *(const f32x4*)(sL + (4 * cb + 1) * 68 + 4 * cb), d2 = *(const f32x4*)(sL + (4 * cb + 2) * 68 + 4 * cb), d3 = *(const f32x4*)(sL + (4 * cb + 3) * 68 + 4 * cb);
                const int nb = (cb + 1) / 2;
                f32x4 lb[2][4][2];
#define SOLVE_LOAD(mb_, buf_) do { _Pragma("unroll") for (int q = 0; q < 2; ++q) _Pragma("unroll") for (int r = 0; r < 4; ++r) \
                    if (2 * (mb_) + q < cb) lb[buf_][r][q] = *(const f32x4*)(sL + (4 * cb + r) * 68 + 4 * (2 * (mb_) + q)); } while (0)
                if (nb > 0) SOLVE_LOAD(0, 0);
#pragma unroll
                for (int mb = 0; mb < nb; ++mb) {
                    if (mb + 1 < nb) SOLVE_LOAD(mb + 1, (mb + 1) & 1);
                    __builtin_amdgcn_sched_barrier(0);
#pragma unroll
                    for (int q = 0; q < 2; ++q)
#pragma unroll
                        for (int r = 0; r < 4; ++r)
                            if (2 * mb + q < cb) { const f32x4 l = lb[mb & 1][r][q]; const int m2 = 2 * (2 * mb + q);
                                a2[r] -= (f32x2_t){l[0], l[1]} * xv[m2]; a2[r] -= (f32x2_t){l[2], l[3]} * xv[m2 + 1]; }
                    __builtin_amdgcn_sched_barrier(0);
                }
#undef SOLVE_LOAD
                const float a0 = a2[0].x + a2[0].y, a1 = a2[1].x + a2[1].y, a2s = a2[2].x + a2[2].y, a3 = a2[3].x + a2[3].y;
                const float y0 = a0, y1 = a1 - d1[0] * y0, y2 = a2s - d2[0] * y0 - d2[1] * y1, y3 = a3 - d3[0] * y0 - d3[1] * y1 - d3[2] * y2;
                xv[2 * cb] = (f32x2_t){y0, y1}; xv[2 * cb + 1] = (f32x2_t){y2, y3};
            }
            if (isU) {
                const int w8 = jc >> 4, nn = jc & 15;
#pragma unroll
                for (int rq = 0; rq < 4; ++rq)
#pragma unroll
                    for (int pc = 0; pc < 2; ++pc) {
                        const int c0 = 32 * pc + 8 * rq;
                        u32x4 o; o.x = pk2(X_(c0 + 0), X_(c0 + 1)); o.y = pk2(X_(c0 + 2), X_(c0 + 3)); o.z = pk2(X_(c0 + 4), X_(c0 + 5)); o.w = pk2(X_(c0 + 6), X_(c0 + 7));
                        const int L = ((w8 * 2 + pc) * 64 + rq * 16 + nn) * 8;
                        *(u32x4*)(QKV + (tokb + (L >> 7)) * 3072 + 2048 + h * 128 + (L & 127)) = o;
                    }
            }
            __syncthreads();
            if (!isU) {
                bf16_t* sW2 = (bf16_t*)sL;
#pragma unroll
                for (int c = 0; c < 64; ++c) sW2[c * 136 + jc] = f2bf(-X_(c));
            }
        }
        __syncthreads();
        {
            const bf16_t* sW2 = (const bf16_t*)sL;
#pragma unroll
            for (int i = 0; i < 4; ++i) { const int ch = ht + 256 * i, r = ch >> 4, c8 = (ch & 15) * 8; *(u32x4*)(WB + (size_t)it * 8192 + r * 128 + c8) = *(const u32x4*)(sW2 + r * 136 + c8); }
        }
#undef X_
        {
            const int c = ht >> 2, ds = (ht & 3) * 32; const float eg = sEg[c];
#pragma unroll
            for (int c8 = 0; c8 < 4; ++c8) {
                const u32x4 v = *(const u32x4*)(sQ + c * 136 + ds + c8 * 8); u32x4 o;
                o.x = pk2(lo2f(v.x) * eg, hi2f(v.x) * eg); o.y = pk2(lo2f(v.y) * eg, hi2f(v.y) * eg); o.z = pk2(lo2f(v.z) * eg, hi2f(v.z) * eg); o.w = pk2(lo2f(v.w) * eg, hi2f(v.w) * eg);
                *(u32x4*)(QKV + (tokb + c) * 3072 + h * 128 + ds + c8 * 8) = o;
            }
            const int d = ht >> 1, cs = (ht & 1) * 32; const float gl = sGc[63];
#pragma unroll
            for (int c8 = 0; c8 < 4; ++c8) {
                float v[8];
#pragma unroll
                for (int e = 0; e < 8; ++e) { const int cc = cs + c8 * 8 + e; v[e] = bf2f(sK[cc * 136 + d]) * __expf(gl - sGc[cc]); }
                u32x4 o; o.x = pk2(v[0], v[1]); o.y = pk2(v[2], v[3]); o.z = pk2(v[4], v[5]); o.w = pk2(v[6], v[7]);
                *(u32x4*)(QKV + (tokb + (d >> 1)) * 3072 + 1024 + h * 128 + (d & 1) * 64 + cs + c8 * 8) = o;
            }
        }
        __syncthreads();
    }
}

constexpr int SC_WQ = 32768, SC_KA = 24576, SC_KA0 = 3 * SC_WQ;
static_assert(SC_KA0 + 2 * SC_KA <= LDS_BYTES, "scan LDS layout");
__device__ __forceinline__ bf16x8 pack2(const f32x4& a, const f32x4& b) {
    u32x4 r; r.x = pk2(a[0], a[1]); r.y = pk2(a[2], a[3]); r.z = pk2(b[0], b[1]); r.w = pk2(b[2], b[3]); return __builtin_bit_cast(bf16x8, r);
}
#define MF16(a, b, c) __builtin_amdgcn_mfma_f32_16x16x32_bf16(a, b, c, 0, 0, 0)
#define DMA16(src, dst) __builtin_amdgcn_global_load_lds((const unsigned*)(src), (LAS unsigned*)(dst), 16, 0, 0)
__device__ __forceinline__ void phase_gdn_scan(const Prm& p, LAS unsigned char* lds, int blk) {
    const int tid = threadIdx.x, wv = __builtin_amdgcn_readfirstlane(tid >> 6), lane = tid & 63, n = lane & 15, kq = lane >> 4;
    const int bh = blk & 15, jh = blk >> 4, b = bh >> 3, h = bh & 7;
    const bf16_t* QKV = (const bf16_t*)(p.ws + OFF_QKV); const bf16_t* WB = (const bf16_t*)(p.ws + OFF_WB); const bf16_t* ATT = (const bf16_t*)(p.ws + OFF_ATT);
    const float* GL = (const float*)(p.ws + OFF_GL); bf16_t* O = (bf16_t*)(p.ws + OFF_H);
    const int itb = bh * 128;
    const bf16_t* qkv_b = QKV + (size_t)b * SEQ * 3072;
    if (wv >= 4) {
        const int lw = wv - 4;
        __builtin_amdgcn_s_setprio(3);
        unsigned oW[4], oQ[4], oK[4], oA[2];
#pragma unroll
        for (int i = 0; i < 4; ++i) {
            { const int q = lw * 4 + i, row = 4 * q + (lane >> 4), pg = lane & 15, g = pg ^ ((row & 3) | (((row >> 3) & 3) << 2)); oW[i] = (unsigned)(row * 128 + g * 8); oQ[i] = (unsigned)(row * 3072 + h * 128 + g * 8); }
            { const int q = lw * 4 + i, d = 8 * q + (lane >> 3), pg = lane & 7, g = pg ^ ((d & 3) | (((d >> 3) & 1) << 2)); oK[i] = (unsigned)((d >> 1) * 3072 + 1024 + h * 128 + (d & 1) * 64 + g * 8); }
        }
#pragma unroll
        for (int i = 0; i < 2; ++i) { const int q = lw * 2 + i, c = 8 * q + (lane >> 3), pg = lane & 7, g = pg ^ ((c & 3) | (((c >> 3) & 1) << 2)); oA[i] = (unsigned)(c * 64 + g * 8); }
#define ISSUE_WQ(ck, st) do { const bf16_t* wb_ = WB + (size_t)(itb + (ck)) * 8192; const bf16_t* qb_ = qkv_b + (size_t)(ck) * 64 * 3072; LAS unsigned char* d_ = lds + (st) * SC_WQ + lw * 4096; \
        _Pragma("unroll") for (int i = 0; i < 4; ++i) { DMA16(wb_ + oW[i], d_ + i * 1024); DMA16(qb_ + oQ[i], d_ + 16384 + i * 1024); } } while (0)
#define ISSUE_KA(ck, st) do { const bf16_t* qb_ = qkv_b + (size_t)(ck) * 64 * 3072; const bf16_t* ab_ = ATT + (size_t)(itb + (ck)) * 4096; LAS unsigned char* d_ = lds + SC_KA0 + (st) * SC_KA; \
        _Pragma("unroll") for (int i = 0; i < 4; ++i) DMA16(qb_ + oK[i], d_ + (lw * 4 + i) * 1024); \
        _Pragma("unroll") for (int i = 0; i < 2; ++i) DMA16(ab_ + oA[i], d_ + 16384 + (lw * 2 + i) * 1024); } while (0)
        ISSUE_WQ(0, 0); ISSUE_KA(0, 0); ISSUE_WQ(1, 1);
        asm volatile("s_waitcnt vmcnt(0)" ::: "memory"); __builtin_amdgcn_s_barrier(); asm volatile("" ::: "memory");
        int s3 = 2;
        for (int nc = 0; nc < 128; ++nc) {
            const int c1 = nc + 1 < 128 ? nc + 1 : 127, c2 = nc + 2 < 128 ? nc + 2 : 127;
            ISSUE_KA(c1, (nc + 1) & 1);
            ISSUE_WQ(c2, s3);
            s3 = s3 == 2 ? 0 : s3 + 1;
            asm volatile("s_waitcnt vmcnt(8)" ::: "memory");
            __builtin_amdgcn_s_barrier(); asm volatile("" ::: "memory");
        }
        asm volatile("s_waitcnt vmcnt(0)" ::: "memory");
        __builtin_amdgcn_s_setprio(0);
#undef ISSUE_WQ
#undef ISSUE_KA
    } else if (wv >= 2) {
        for (int nc = 0; nc < 129; ++nc) { __builtin_amdgcn_s_barrier(); asm volatile("" ::: "memory"); }
    } else {
        const float gl0 = GL[itb + lane], gl1 = GL[itb + 64 + lane];
        f32x4 S[8];
#pragma unroll
        for (int dt = 0; dt < 8; ++dt) S[dt] = (f32x4){0.f, 0.f, 0.f, 0.f};
        const int e = 32 * jh + 16 * wv + n;
        unsigned uo[2];
#pragma unroll
        for (int pc = 0; pc < 2; ++pc) { const int L = (((2 * jh + wv) * 2 + pc) * 64 + lane) * 8; uo[pc] = (unsigned)((L >> 7) * 3072 + 2048 + h * 128 + (L & 127)); }
        u32x4 ua[2], ub[2];
#pragma unroll
        for (int pc = 0; pc < 2; ++pc) { ua[pc] = *(const u32x4*)(qkv_b + uo[pc]); ub[pc] = *(const u32x4*)(qkv_b + (size_t)64 * 3072 + uo[pc]); }
        const int rowb = 8 * (n >> 2) + (n & 3), swk = (n & 3) | (((n >> 2) & 1) << 2);
        unsigned offW[4], offK[2];
#pragma unroll
        for (int ks = 0; ks < 4; ++ks) offW[ks] = (unsigned)(rowb * 256 + (((4 * ks + kq) ^ n) << 4));
#pragma unroll
        for (int k2 = 0; k2 < 2; ++k2) offK[k2] = (unsigned)(rowb * 128 + (((4 * k2 + kq) ^ swk) << 4));
        asm volatile("s_waitcnt lgkmcnt(0)" ::: "memory"); __builtin_amdgcn_s_barrier(); asm volatile("" ::: "memory");
        int s3 = 0;
        for (int nc = 0; nc < 128; ++nc) {
            const LAS unsigned char* sWQ = lds + s3 * SC_WQ; const LAS unsigned char* sKA = lds + SC_KA0 + (nc & 1) * SC_KA;
            s3 = s3 == 2 ? 0 : s3 + 1;
            const float gl = __builtin_bit_cast(float, __builtin_amdgcn_readlane(__builtin_bit_cast(int, nc < 64 ? gl0 : gl1), nc & 63));
            f32x4 V[4], Oa[4];
#pragma unroll
            for (int pc = 0; pc < 2; ++pc) {
                const u32x4 uu = ua[pc];
                V[2 * pc] = (f32x4){lo2f(uu.x), hi2f(uu.x), lo2f(uu.y), hi2f(uu.y)}; V[2 * pc + 1] = (f32x4){lo2f(uu.z), hi2f(uu.z), lo2f(uu.w), hi2f(uu.w)};
                ua[pc] = ub[pc];
            }
            { const int c2 = nc + 2 < 128 ? nc + 2 : 127; const bf16_t* ubase = qkv_b + (size_t)c2 * 64 * 3072;
#pragma unroll
              for (int pc = 0; pc < 2; ++pc) ub[pc] = *(const u32x4*)(ubase + uo[pc]); }
#pragma unroll
            for (int ct = 0; ct < 4; ++ct) Oa[ct] = (f32x4){0.f, 0.f, 0.f, 0.f};
            bf16x8 fa[2][8];
#define TOFF(t, pitch) ((32 * ((t) >> 1) + 4 * ((t) & 1)) * (pitch))
#define LD_WQ(dst, ks_) do { _Pragma("unroll") for (int mt = 0; mt < 4; ++mt) { dst[mt] = *(const LAS bf16x8*)(sWQ + offW[ks_] + TOFF(mt, 256)); dst[4 + mt] = *(const LAS bf16x8*)(sWQ + 16384 + offW[ks_] + TOFF(mt, 256)); } } while (0)
            LD_WQ(fa[0], 0);
#pragma unroll
            for (int ks = 0; ks < 4; ++ks) {
                if (ks < 3) LD_WQ(fa[(ks + 1) & 1], ks + 1);
                const bf16x8 sb8 = pack2(S[2 * ks], S[2 * ks + 1]);
                __builtin_amdgcn_sched_barrier(0);
#pragma unroll
                for (int mt = 0; mt < 4; ++mt) { V[mt] = MF16(fa[ks & 1][mt], sb8, V[mt]); Oa[mt] = MF16(fa[ks & 1][4 + mt], sb8, Oa[mt]); }
                __builtin_amdgcn_sched_barrier(0);
            }
#undef LD_WQ
            bf16x8 fb[2][12];
#define LD_AK(dst, k2_) do { _Pragma("unroll") for (int mt = 0; mt < 4; ++mt) dst[mt] = *(const LAS bf16x8*)(sKA + 16384 + offK[k2_] + TOFF(mt, 128)); \
                             _Pragma("unroll") for (int dt = 0; dt < 8; ++dt) dst[4 + dt] = *(const LAS bf16x8*)(sKA + offK[k2_] + TOFF(dt, 128)); } while (0)
            LD_AK(fb[0], 0);
            bf16x8 Vb[2];
            Vb[0] = pack2(V[0], V[1]); Vb[1] = pack2(V[2], V[3]);
#pragma unroll
            for (int dt = 0; dt < 8; ++dt) S[dt] *= gl;
#pragma unroll
            for (int k2 = 0; k2 < 2; ++k2) {
                if (k2 < 1) LD_AK(fb[1], 1);
                __builtin_amdgcn_sched_barrier(0);
#pragma unroll
                for (int mt = 0; mt < 4; ++mt) Oa[mt] = MF16(fb[k2][mt], Vb[k2], Oa[mt]);
#pragma unroll
                for (int dt = 0; dt < 8; ++dt) S[dt] = MF16(fb[k2][4 + dt], Vb[k2], S[dt]);
                __builtin_amdgcn_sched_barrier(0);
            }
#undef LD_AK
#undef TOFF
            bf16_t* obase = O + (size_t)(itb + nc) * 8192 + e * 64 + 8 * kq;
#pragma unroll
            for (int pc = 0; pc < 2; ++pc) *(u32x4*)(obase + 32 * pc) = pack8(Oa[2 * pc], Oa[2 * pc + 1]);
            asm volatile("s_waitcnt lgkmcnt(0)" ::: "memory"); __builtin_amdgcn_s_barrier(); asm volatile("" ::: "memory");
        }
    }
    __syncthreads();
}

__device__ __forceinline__ void phase_ya(const Prm& p, unsigned char* lds) {
    const bf16_t* OT = (const bf16_t*)(p.ws + OFF_H); bf16_t* SZA = (bf16_t*)p.out;
    const float* gw = p.in[7];
    bf16_t* sT = (bf16_t*)lds;
    float* sPart = (float*)(lds + 16384);
    const int tid = threadIdx.x, w = tid >> 6, c = tid & 63;
    for (int it = blockIdx.x; it < NIT; it += gridDim.x) {
        const int b = it >> 10, h = (it >> 7) & 7, nc = it & 127;
        const size_t tok = (size_t)b * SEQ + (size_t)nc * 64 + c;
#pragma unroll
        for (int i = 0; i < 2; ++i) { const int ch = tid + 512 * i; *(u32x4*)(sT + ch * 8) = *(const u32x4*)(OT + (size_t)it * 8192 + ch * 8); }
        const u32x4 z0 = *(const u32x4*)(SZA + tok * 1024 + h * 128 + 16 * w), z1 = *(const u32x4*)(SZA + tok * 1024 + h * 128 + 16 * w + 8);
        __syncthreads();
        float o[16]; float ss = 0.f;
#pragma unroll
        for (int j = 0; j < 16; ++j) { o[j] = bf2f(sT[(16 * w + j) * 64 + c]); ss += o[j] * o[j]; }
        sPart[w * 64 + c] = ss;
        __syncthreads();
        float tot = 0.f;
#pragma unroll
        for (int k = 0; k < 8; ++k) tot += sPart[k * 64 + c];
        const float rstd = rsqrtf(tot * (1.0f / 128.0f) + 1e-6f);
        const unsigned zz[8] = {z0.x, z0.y, z0.z, z0.w, z1.x, z1.y, z1.z, z1.w};
        unsigned r[8];
#pragma unroll
        for (int j = 0; j < 8; ++j)
            r[j] = pk2(o[2 * j] * rstd * gw[16 * w + 2 * j] * lo2f(zz[j]), o[2 * j + 1] * rstd * gw[16 * w + 2 * j + 1] * hi2f(zz[j]));
        *(u32x4*)(SZA + tok * 1024 + h * 128 + 16 * w) = (u32x4){r[0], r[1], r[2], r[3]};
        *(u32x4*)(SZA + tok * 1024 + h * 128 + 16 * w + 8) = (u32x4){r[4], r[5], r[6], r[7]};
        __syncthreads();
    }
}
__device__ __forceinline__ void phase_conv3(const Prm& p) {
    const bf16_t* P = (const bf16_t*)(p.ws + OFF_P); bf16_t* Q = (bf16_t*)(p.ws + OFF_Q); const float* cw = p.in[19];
    const int nth = gridDim.x * 512;
    for (int idx = blockIdx.x * 512 + threadIdx.x; idx < (TOK / 4) * 256; idx += nth) {
        const int t0 = (idx >> 8) * 4, c8 = (idx & 255) * 8;
        const bool first = (t0 & (SEQ - 1)) == 0;
        u32x4 pr[6], qr[4];
#pragma unroll
        for (int i = 0; i < 6; ++i) pr[i] = (i < 2 && first) ? (u32x4){0u, 0u, 0u, 0u} : *(const u32x4*)(P + (size_t)(t0 - 2 + i) * 2048 + c8);
#pragma unroll
        for (int i = 0; i < 4; ++i) qr[i] = *(const u32x4*)(Q + (size_t)(t0 + i) * 2048 + c8);
        float w0[8], w1[8], w2[8];
#pragma unroll
        for (int e = 0; e < 8; ++e) { w0[e] = cw[c8 + e]; w1[e] = cw[2048 + c8 + e]; w2[e] = cw[4096 + c8 + e]; }
#pragma unroll
        for (int i = 0; i < 4; ++i) {
            const unsigned pa[4] = {pr[i + 2].x, pr[i + 2].y, pr[i + 2].z, pr[i + 2].w}, pb[4] = {pr[i + 1].x, pr[i + 1].y, pr[i + 1].z, pr[i + 1].w}, pc[4] = {pr[i].x, pr[i].y, pr[i].z, pr[i].w};
            const unsigned qa[4] = {qr[i].x, qr[i].y, qr[i].z, qr[i].w};
            unsigned o[4];
#pragma unroll
            for (int e = 0; e < 4; ++e)
                o[e] = pk2(lo2f(qa[e]) * (w0[2 * e] * lo2f(pc[e]) + w1[2 * e] * lo2f(pb[e]) + w2[2 * e] * lo2f(pa[e])),
                           hi2f(qa[e]) * (w0[2 * e + 1] * hi2f(pc[e]) + w1[2 * e + 1] * hi2f(pb[e]) + w2[2 * e + 1] * hi2f(pa[e])));
            *(u32x4*)(Q + (size_t)(t0 + i) * 2048 + c8) = (u32x4){o[0], o[1], o[2], o[3]};
        }
    }
}

#define XB_TMO      128
#define XB_XCNT(j)  (256  + 64 * (j))
#define XB_XSUB(j)  (1280 + 64 * (j))
#define XB_XGEN(j)  (2304 + 64 * (j))
#define XB_TOP      3328
#define XB_TOPGEN   3392
#define XCD_BAR_WORDS 3456
#define XB_SPIN_CAP (1u << 18)

__device__ __forceinline__ unsigned xb_ld(unsigned* p)              { return __hip_atomic_load(p, __ATOMIC_RELAXED, __HIP_MEMORY_SCOPE_AGENT); }
__device__ __forceinline__ unsigned xb_add(unsigned* p, unsigned v) { return __hip_atomic_fetch_add(p, v, __ATOMIC_RELAXED, __HIP_MEMORY_SCOPE_AGENT); }
__device__ __forceinline__ unsigned xb_xcc_id() { return (unsigned)__builtin_amdgcn_s_getreg((3 << 11) | 20) & 0xFu; }
#define XB_SPIN(cond, bar) do { unsigned _sp = 0; while (cond) { __builtin_amdgcn_s_sleep(1); \
    if ((++_sp & 255u) == 0u) { if (xb_ld(&(bar)[XB_TMO])) break; if (_sp > XB_SPIN_CAP) { atomicAdd(&(bar)[XB_TMO], 1u); break; } } } } while (0)

struct XcdBarrier {
    unsigned* bar; unsigned x;
    volatile LAS unsigned* st;
};

__device__ __forceinline__ XcdBarrier xcd_barrier_post(unsigned* bar, volatile LAS unsigned* st) {
    XcdBarrier b; b.bar = bar; b.x = xb_xcc_id(); b.st = st;
    if (threadIdx.x == 0) (void)xb_add(&bar[XB_XCNT(b.x)], 1u);
    return b;
}
__device__ __forceinline__ void xcd_barrier_complete(unsigned* bar, unsigned x, unsigned& nloc, unsigned& nx) {
    const unsigned G = gridDim.x * gridDim.y * gridDim.z;
    unsigned sum, cnt, mine, sp = 0u;
    for (;;) {
        sum = 0u; cnt = 0u; mine = 0u;
#pragma unroll
        for (unsigned j = 0; j < 16; ++j) { const unsigned c = xb_ld(&bar[XB_XCNT(j)]); sum += c; cnt += (c > 0u) ? 1u : 0u; mine = (j == x) ? c : mine; }
        if (sum == G) break;
        __builtin_amdgcn_s_sleep(1);
        if ((++sp & 255u) == 0u) { if (xb_ld(&bar[XB_TMO])) break; if (sp > XB_SPIN_CAP) { atomicAdd(&bar[XB_TMO], 1u); break; } }
    }
    nloc = mine > 0u ? mine : 1u; nx = cnt > 0u ? cnt : 1u;
}

__device__ __forceinline__ void xcd_barrier(const XcdBarrier& b) {
    asm volatile("s_waitcnt vmcnt(0)" ::: "memory");
    __syncthreads();
    if (threadIdx.x == 0) {
        unsigned* bar = b.bar;
        __builtin_amdgcn_s_waitcnt(0);
        unsigned nloc = b.st[0], nx = b.st[1];
        if (nloc == 0u) { xcd_barrier_complete(bar, b.x, nloc, nx); b.st[0] = nloc; b.st[1] = nx; }
        const unsigned old = xb_add(&bar[XB_XSUB(b.x)], 1u);
        const unsigned gen = old / nloc;
        if (old + 1u == (gen + 1u) * nloc) {
            __builtin_amdgcn_fence(__ATOMIC_RELEASE, "agent");
            asm volatile("s_waitcnt vmcnt(0)" ::: "memory");
            const unsigned og = xb_add(&bar[XB_TOP], 1u);
            const unsigned tg = og / nx;
            if (og + 1u == (tg + 1u) * nx) xb_add(&bar[XB_TOPGEN], 1u);
            else XB_SPIN(xb_ld(&bar[XB_TOPGEN]) == tg, bar);
            __builtin_amdgcn_fence(__ATOMIC_ACQUIRE, "agent");
            xb_add(&bar[XB_XGEN(b.x)], 1u);
            asm volatile("s_waitcnt vmcnt(0)" ::: "memory");
        } else {
            XB_SPIN(xb_ld(&bar[XB_XGEN(b.x)]) == gen, bar);
            __builtin_amdgcn_fence(__ATOMIC_ACQUIRE, "agent");
            asm volatile("s_waitcnt vmcnt(0)" ::: "memory");
        }
    }
    __syncthreads();
}

constexpr int NPHASE = 11;
#define REP_GEMM 1
#define REP_SYNC 1
#define REP_SCAN 1
#define SCAN_PROBE 1
#define REP_P0 1
#ifndef PHM
#define PHM 0x7FF
#endif
__global__ void __launch_bounds__(512, 2) mega(Prm p) {
    extern __shared__ __attribute__((aligned(16))) unsigned char shm[];
    LAS unsigned char* lds3 = (LAS unsigned char*)shm;
    unsigned char* ws = p.ws;
    volatile LAS unsigned* xst = (volatile LAS unsigned*)(lds3 + LDS_BYTES);
    if (threadIdx.x == 0) { xst[0] = 0u; xst[1] = 0u; }
    __syncthreads();
    XcdBarrier xb{};
    const bool multi = (p.ph_hi - p.ph_lo) > 1;
    if (multi) xb = xcd_barrier_post((unsigned*)(ws + OFF_BAR), xst);
    if (p.ph_lo < 0) cg::this_grid().sync();
#define PH_BEGIN(i) if (((PHM >> (i)) & 1) && p.ph_lo <= (i) && (i) < p.ph_hi) { if ((i) > p.ph_lo) { xcd_barrier(xb); if (REP_SYNC > 1) xcd_barrier(xb); } pg8::StaticOrder S; (void)S;
#define PH_END }
    PH_BEGIN(0)
        for (int rep = 0; rep < REP_P0; ++rep) {
        phase_convert(p, shm, 0, 1856, gridDim.x, blockIdx.x);
        phase_rmsnorm_x(p.in[0], p.in[1], (bf16_t*)(ws + OFF_H)); __syncthreads(); }
    PH_END
    PH_BEGIN(1)
        pg8::Gemm g{(const bf16_t*)(ws + OFF_H), (const bf16_t*)(ws + OFF_WT1), TOK, NP1, 1024, (const bf16_t*)(ws + OFF_H), 1024, 64};
        Epi1 E{(bf16_t*)(ws + OFF_QKV), (bf16_t*)p.out, (bf16_t*)(ws + OFF_UU), (bf16_t*)p.out + (size_t)TOK * 1024, (float*)(ws + OFF_BA), (bf16_t*)(ws + OFF_HALO)};
        S.init(TOK, NP1, gridDim.x, blockIdx.x); for (int rep = 0; rep < REP_GEMM; ++rep) { pg8::gemm_phase(lds3, g, S, E); __syncthreads(); }
    PH_END
    PH_BEGIN(2)
        {
            unsigned* ctr = (unsigned*)(ws + OFF_BAR) + 3600;
            volatile LAS unsigned* sIt = xst + 2;
            for (;;) {
                if (threadIdx.x == 0) sIt[0] = __hip_atomic_fetch_add(ctr, 2u, __ATOMIC_RELAXED, __HIP_MEMORY_SCOPE_AGENT);
                __syncthreads();
                const unsigned it0 = sIt[0];
                __syncthreads();
                if (it0 >= (unsigned)NIT) break;
                phase_gdn_prep(p, shm, (int)it0, 1);
            }
        }
    PH_END
    PH_BEGIN(3)
        if (blockIdx.x < 64) phase_gdn_scan(p, lds3, blockIdx.x);
        else {
            const int ob = blockIdx.x - 64;
            pg8::Gemm g{(const bf16_t*)(ws + OFF_UU), (const bf16_t*)(ws + OFF_WTG), TOK, 1024, 1024, (const bf16_t*)(ws + OFF_UU), 1024, 64};
            EpiGlu E{(const bf16_t*)(ws + OFF_UU), (bf16_t*)p.out + (size_t)TOK * 1024};
            unsigned* cw = (unsigned*)(ws + OFF_BAR);
            if (ob < 128) {
                phase_s5(p, shm, ob);
                asm volatile("s_waitcnt vmcnt(0)" ::: "memory");
                __syncthreads();
                if (threadIdx.x == 0) {
                    __builtin_amdgcn_fence(__ATOMIC_RELEASE, "agent");
                    asm volatile("s_waitcnt vmcnt(0)" ::: "memory");
                    __hip_atomic_fetch_add(cw + 3700, 1u, __ATOMIC_RELAXED, __HIP_MEMORY_SCOPE_AGENT);
                    unsigned sp = 0;
                    while (__hip_atomic_load(cw + 3700, __ATOMIC_RELAXED, __HIP_MEMORY_SCOPE_AGENT) < 128u) { __builtin_amdgcn_s_sleep(2); if (++sp > (1u << 22)) break; }
                    __builtin_amdgcn_fence(__ATOMIC_ACQUIRE, "agent");
                    asm volatile("s_waitcnt vmcnt(0)" ::: "memory");
                }
                __syncthreads();
                S.init_list(ob, 1, 1); pg8::gemm_phase(lds3, g, S, E);
            } else {
                const int e = ob - 128;
                phase_convert(p, shm, 1856, 1856 + 2304, 64, e);
                __syncthreads();
                if (threadIdx.x == 0) {
                    unsigned sp = 0;
                    while (__hip_atomic_load(cw + 3900, __ATOMIC_RELAXED, __HIP_MEMORY_SCOPE_AGENT) < 128u) { __builtin_amdgcn_s_sleep(2); if (++sp > (1u << 22)) break; }
                    __builtin_amdgcn_fence(__ATOMIC_ACQUIRE, "agent");
                    asm volatile("s_waitcnt vmcnt(0)" ::: "memory");
                }
                __syncthreads();
                S.init_list(2 * e, 2, 0); pg8::gemm_phase(lds3, g, S, E);
                __syncthreads();
                phase_convert(p, shm, 1856 + 2304, 4928, 64, e);
            }
        }
    PH_END
    PH_BEGIN(4)
        phase_ya(p, shm);
    PH_END
    PH_BEGIN(5)
        pg8::Gemm g{(const bf16_t*)p.out, (const bf16_t*)(ws + OFF_WTO0), TOK, 1024, 2048, (const bf16_t*)p.out + (size_t)TOK * 1024, 1024, 16};
        EpiB16 E{(bf16_t*)(ws + OFF_QKV)};
        S.init(TOK, 1024, gridDim.x, blockIdx.x); for (int rep = 0; rep < REP_GEMM; ++rep) { pg8::gemm_phase(lds3, g, S, E); __syncthreads(); }
    PH_END
    PH_BEGIN(6)
        phase_post<true>(p.in[0], (const bf16_t*)(ws + OFF_QKV), p.in[2], p.out, p.in[1] + 1024, (bf16_t*)(ws + OFF_H));
    PH_END
    PH_BEGIN(7)
        pg8::Gemm g{(const bf16_t*)(ws + OFF_H), (const bf16_t*)(ws + OFF_WT2), TOK, 8192, 1024, (const bf16_t*)(ws + OFF_H), 1024, 64};
        Epi2 E{(bf16_t*)(ws + OFF_P), (bf16_t*)(ws + OFF_Q)};
        S.init(TOK, 8192, gridDim.x, blockIdx.x); for (int rep = 0; rep < REP_GEMM; ++rep) { pg8::gemm_phase(lds3, g, S, E); __syncthreads(); }
    PH_END
    PH_BEGIN(8)
        phase_conv3(p);
    PH_END
    PH_BEGIN(9)
        pg8::Gemm g{(const bf16_t*)(ws + OFF_Q), (const bf16_t*)(ws + OFF_WTO1), TOK, 1024, 2048, (const bf16_t*)(ws + OFF_Q), 2048, 64};
        EpiB16 E{(bf16_t*)(ws + OFF_P)};
        S.init(TOK, 1024, gridDim.x, blockIdx.x); for (int rep = 0; rep < REP_GEMM; ++rep) { pg8::gemm_phase(lds3, g, S, E); __syncthreads(); }
    PH_END
    PH_BEGIN(10)
        phase_post<false>(p.out, (const bf16_t*)(ws + OFF_P), p.in[2] + 1024, p.out, nullptr, nullptr);
    PH_END
}

#ifndef N_LAUNCH_MODE
#define N_LAUNCH_MODE 1
#endif

extern "C" void kernel_launch(void* const* d_in, const int* in_sizes, int n_in, void* d_out, int out_size, void* d_ws, size_t ws_size, hipStream_t stream) {
    static int ready = 0;
    if (!ready) {
        if (n_in != 21 || ws_size < WS_END || out_size != TOK * DM) { fprintf(stderr, "kernel_launch: unexpected shapes (n_in %d ws %zu out %d)\n", n_in, ws_size, out_size); ready = -1; return; }
        if (hipFuncSetAttribute((const void*)mega, hipFuncAttributeMaxDynamicSharedMemorySize, LDS_BYTES + 16) != hipSuccess) { fprintf(stderr, "kernel_launch: hipFuncSetAttribute failed\n"); ready = -1; return; }
        ready = 1;
    }
    if (ready < 0) return;
    Prm p{};
    for (int i = 0; i < 21; ++i) p.in[i] = (const float*)d_in[i];
    p.out = (float*)d_out; p.ws = (unsigned char*)d_ws;
#if N_LAUNCH_MODE == 1
    p.ph_lo = 0; p.ph_hi = NPHASE;
    void* args[] = {&p};
    if (hipMemsetAsync((unsigned char*)d_ws + OFF_BAR, 0, 16384, stream) != hipSuccess) { fprintf(stderr, "memset failed\n"); return; }
    hipError_t e = hipLaunchCooperativeKernel((const void*)mega, dim3(256), dim3(512), args, LDS_BYTES + 16, stream);
    if (e != hipSuccess) fprintf(stderr, "cooperative launch failed: %s\n", hipGetErrorString(e));
#else
    for (int ph = 0; ph < NPHASE; ++ph) {
        p.ph_lo = ph; p.ph_hi = ph + 1;
        hipLaunchKernelGGL(mega, dim3(256), dim3(512), LDS_BYTES + 16, stream, p);
    }
#endif
}
```

```cpp
#include <hip/hip_runtime.h>
#include <hip/hip_cooperative_groups.h>
#include <cstdio>
namespace cg = cooperative_groups;

#define LAS __attribute__((address_space(3)))
typedef unsigned short bf16_t;
typedef short bf16x8 __attribute__((ext_vector_type(8)));
typedef float f32x4 __attribute__((ext_vector_type(4)));
typedef float f32x16 __attribute__((ext_vector_type(16)));
typedef unsigned u32x4 __attribute__((ext_vector_type(4)));
typedef unsigned u32x2 __attribute__((ext_vector_type(2)));

constexpr int TOK = 16384, DM = 1024, SEQ = 8192;
constexpr int NP1 = 6400;
constexpr int NIT = 2048;

constexpr size_t OFF_WT1 = 0;
constexpr size_t OFF_WTG = OFF_WT1 + (size_t)NP1 * 1024 * 2;
constexpr size_t OFF_WTO0 = OFF_WTG + (size_t)1024 * 1024 * 2;
constexpr size_t OFF_WT2 = OFF_WTO0 + (size_t)1024 * 2048 * 2;
constexpr size_t OFF_WTO1 = OFF_WT2 + (size_t)8192 * 1024 * 2;
constexpr size_t OFF_H = OFF_WTO1 + (size_t)1024 * 2048 * 2;
constexpr size_t OFF_QKV = OFF_H + (size_t)TOK * 1024 * 2;
constexpr size_t OFF_UU = OFF_QKV + (size_t)TOK * 3072 * 2;
constexpr size_t OFF_WB = OFF_UU + (size_t)TOK * 1024 * 2;
constexpr size_t OFF_ATT = OFF_WB + (size_t)NIT * 8192 * 2;
constexpr size_t OFF_HALO = OFF_ATT + (size_t)NIT * 4096 * 2;
constexpr size_t OFF_BA = OFF_HALO + (size_t)256 * 3 * 3072 * 2;
constexpr size_t OFF_GL = OFF_BA + (size_t)TOK * 16 * 4;
constexpr size_t OFF_BAR = OFF_GL + (size_t)NIT * 4;
constexpr size_t WS_END = OFF_BAR + 16384;
constexpr size_t OFF_YMIX = OFF_QKV;
constexpr size_t OFF_P = OFF_QKV;
constexpr size_t OFF_Q = OFF_QKV + (size_t)TOK * 2048 * 2;
static_assert(OFF_Q + (size_t)TOK * 2048 * 2 <= OFF_WB, "Q overlaps live data");
static_assert(WS_END <= (size_t)256 * 1024 * 1024, "workspace too big");

constexpr int LDS_BYTES = 157696;

struct Prm {
    const float* in[21];
    float* out;
    unsigned char* ws;
    int ph_lo, ph_hi;
};

__device__ __forceinline__ float bf2f(bf16_t b) { return __uint_as_float(((unsigned)b) << 16); }
__device__ __forceinline__ bf16_t f2bf(float f) { unsigned u = __float_as_uint(f); u += 0x7FFFu + ((u >> 16) & 1u); return (bf16_t)(u >> 16); }
typedef __bf16 bf16v2_t __attribute__((ext_vector_type(2)));
typedef float f32x2_t __attribute__((ext_vector_type(2)));
__device__ __forceinline__ unsigned pk2(float lo, float hi) { const f32x2_t v = {lo, hi}; return __builtin_bit_cast(unsigned, __builtin_convertvector(v, bf16v2_t)); }
__device__ __forceinline__ float lo2f(unsigned u) { return __uint_as_float(u << 16); }
__device__ __forceinline__ float hi2f(unsigned u) { return __uint_as_float(u & 0xFFFF0000u); }
__device__ __forceinline__ float sigmoidf_(float x) { return 1.0f / (1.0f + __expf(-x)); }
__device__ __forceinline__ float siluf_(float x) { return x / (1.0f + __expf(-x)); }
__device__ __forceinline__ float wave_sum(float v) {
#pragma unroll
    for (int o = 32; o >= 1; o >>= 1) v += __shfl_xor(v, o);
    return v;
}
__device__ __forceinline__ u32x4 pack8(f32x4 a, f32x4 b) { u32x4 r; r.x = pk2(a[0], a[1]); r.y = pk2(a[2], a[3]); r.z = pk2(b[0], b[1]); r.w = pk2(b[2], b[3]); return r; }

namespace pg8 {
constexpr int BM = 256, BK = 64, HALF = 128, HTB = HALF * BK * 2, STAGE_BYTES = 8 * HTB, NXCD = 8, WGM = 8;
__device__ __forceinline__ int lds_byte(int r, int c) { const int st = (r >> 4) * 2 + (c >> 5), rr = r & 15, cc = c & 31, ob = rr * 64 + cc * 2; return st * 1024 + (ob ^ (((ob >> 9) & 1) << 5)); }
__device__ __forceinline__ void stage_rc(int b, int& R, int& C) { const int st = b / 1024, sb = b % 1024, swz = sb ^ (((sb >> 9) & 1) << 5); R = (st >> 1) * 16 + swz / 64; C = (st & 1) * 32 + (swz % 64) / 2; }
__device__ __forceinline__ int perm32(int rho) { const int n = rho >> 4, i = rho & 15; return 8 * (i >> 2) + 4 * n + (i & 3); }
struct Unit { int pm, pn; };
struct Gemm { const bf16_t* A; const bf16_t* Bt; int M, N, K; const bf16_t* A2; int lda, ks; };
struct StaticOrder {
    int nM, nN, nwg, G, c;
    int lmode, lbase, lcount, lhalf;
    __device__ void init(int M, int N, int G_, int c_) { nM = M / BM; nN = N / BM; nwg = nM * nN; G = G_; c = c_; lmode = 0; lbase = 0; lcount = 0; lhalf = 0; }
    __device__ void init_list(int base, int count, int half) { nM = 64; nN = 4; nwg = 256; G = 1; c = 0; lmode = 1; lbase = base; lcount = count; lhalf = half; }
    __device__ bool next(int i, Unit& u) const {
        if (lmode) { if (i >= lcount) return false; const int j = lbase + i, bb = j >> 6, r = j & 63; u.pm = 32 * bb + 16 * lhalf + (r >> 2); u.pn = r & 3; return true; }
        const long L = (long)i * G + c; if (L >= nwg) return false;
        int wgid = (int)L; { const int q = nwg / NXCD, r = nwg % NXCD, xcd = wgid % NXCD, off = wgid / NXCD; wgid = (xcd < r ? xcd * (q + 1) : r * (q + 1) + (xcd - r) * q) + off; }
        const int nig = WGM * nN, gid = wgid / nig, fm = gid * WGM, gsz = (nM - fm) < WGM ? (nM - fm) : WGM;
        u.pm = fm + ((wgid % nig) % gsz); u.pn = (wgid % nig) / gsz; return true;
    }
};

template <class Epi>
__device__ __forceinline__ void gemm_phase(LAS unsigned char* lds, const Gemm g, const StaticOrder& S, const Epi& E) {
    const int tid = threadIdx.x, wid = __builtin_amdgcn_readfirstlane(tid >> 6), lane = tid & 63, wr = wid >> 2, wc = wid & 3, fr = lane & 15, fq = lane >> 4;
    const int K = g.K, nt = K / BK;
    unsigned voffA[2], voffB[2];
#pragma unroll
    for (int i = 0; i < 2; ++i) { int R, C; stage_rc(tid * 16 + i * 8192, R, C); const int Rb = Epi::PERM ? ((R & ~31) + perm32(R & 31)) : R;
        voffA[i] = (unsigned)(R * g.lda + C) * 2u; voffB[i] = (unsigned)(Rb * K + C) * 2u; }
    const size_t kstep = (size_t)(BK * 2);
    const size_t hstep = (size_t)HALF * K * 2;
    const size_t tstep = 2 * hstep;
    const size_t hstepA = (size_t)HALF * g.lda * 2, tstepA = 2 * hstepA;
    const int ks = g.ks; const ptrdiff_t a2off = (const char*)g.A2 - (const char*)g.A - (ptrdiff_t)ks * (ptrdiff_t)kstep;
    const unsigned ldsw = (unsigned)wid * 1024u;
    const int aoff = lds_byte(wr * 64 + fr, fq * 8), boff = lds_byte(wc * 32 + fr, fq * 8);
#define PG8_SA(b, h) (((b) * 2 + (h)) * HTB)
#define PG8_SB(b, h) ((4 + (b) * 2 + (h)) * HTB)
#define PG8_STAGE(bufoff, gbase, voff) do { _Pragma("unroll") for (int _i = 0; _i < 2; ++_i) \
        __builtin_amdgcn_global_load_lds((const unsigned*)((const char*)(gbase) + (voff)[_i]), (LAS unsigned*)(lds + (bufoff) + ldsw + _i * 8192), 16, 0, 0); } while (0)
#define PG8_LDA(dst, b, h) do { _Pragma("unroll") for (int m = 0; m < 4; ++m) _Pragma("unroll") for (int k = 0; k < 2; ++k) dst[m][k] = *(const LAS bf16x8*)(lds + PG8_SA(b, h) + aoff + m * 2048 + k * 1024); } while (0)
#define PG8_LDB(dst, b, h) do { _Pragma("unroll") for (int n = 0; n < 2; ++n) _Pragma("unroll") for (int k = 0; k < 2; ++k) dst[n][k] = *(const LAS bf16x8*)(lds + PG8_SB(b, h) + boff + n * 2048 + k * 1024); } while (0)
#define PG8_MMA(ai, bj, At, Bt) do { __builtin_amdgcn_s_setprio(1); _Pragma("unroll") for (int m = 0; m < 4; ++m) _Pragma("unroll") for (int n = 0; n < 2; ++n) _Pragma("unroll") for (int k = 0; k < 2; ++k) \
        acc[ai][bj][m][n] = __builtin_amdgcn_mfma_f32_16x16x32_bf16(Bt[n][k], At[m][k], acc[ai][bj][m][n], 0, 0, 0); __builtin_amdgcn_s_setprio(0); } while (0)
#define PG8_WAIT_V(n) asm volatile("s_waitcnt vmcnt(" #n ")" ::: "memory")
#define PG8_WAIT_L(n) asm volatile("s_waitcnt lgkmcnt(" #n ")" ::: "memory")
#define PG8_BAR __builtin_amdgcn_s_barrier()
#define PG8_SCHED __builtin_amdgcn_sched_barrier(0)
    Unit cur, nxt; int ui = 0;
    if (!S.next(0, cur)) return;
    f32x4 acc[2][2][4][2];
#pragma unroll
    for (int a = 0; a < 2; ++a)
#pragma unroll
        for (int b = 0; b < 2; ++b)
#pragma unroll
            for (int m = 0; m < 4; ++m)
#pragma unroll
                for (int n = 0; n < 2; ++n) acc[a][b][m][n] = (f32x4){0.f, 0.f, 0.f, 0.f};
    bf16x8 At[4][2], B0[2][2], B1[2][2];
    const char* cA = (const char*)g.A + (size_t)cur.pm * tstepA; const char* cB = (const char*)g.Bt + (size_t)cur.pn * tstep;
    PG8_STAGE(PG8_SB(0, 0), cB, voffB); PG8_STAGE(PG8_SA(0, 0), cA, voffA); PG8_STAGE(PG8_SB(0, 1), cB + hstep, voffB); PG8_STAGE(PG8_SA(0, 1), cA + hstepA, voffA);
    if (wr == 1) PG8_BAR;
    PG8_WAIT_V(4); PG8_BAR;
    PG8_STAGE(PG8_SB(1, 0), cB + kstep, voffB); PG8_STAGE(PG8_SA(1, 0), cA + kstep, voffA); PG8_STAGE(PG8_SB(1, 1), cB + hstep + kstep, voffB);
    PG8_WAIT_V(6); PG8_BAR;
    for (;;) {
        const bool has_next = S.next(ui + 1, nxt);
        const char* nA = has_next ? (const char*)g.A + (size_t)nxt.pm * tstepA : cA; const char* nB = has_next ? (const char*)g.Bt + (size_t)nxt.pn * tstep : cB;
        for (int t = 0; t < nt; t += 2) {
            const bool last = (t == nt - 2);
            const char* a1 = cA + (size_t)(t + 1) * kstep + ((t + 1) >= ks ? a2off : 0);
            const char* a2 = last ? nA : cA + (size_t)(t + 2) * kstep + ((t + 2) >= ks ? a2off : 0); const char* b2 = last ? nB : cB + (size_t)(t + 2) * kstep;
            const char* a3 = last ? nA + kstep : cA + (size_t)(t + 3) * kstep + ((t + 3) >= ks ? a2off : 0); const char* b3 = b2 + kstep;
            PG8_LDB(B0, 0, 0); PG8_SCHED; PG8_LDA(At, 0, 0); PG8_STAGE(PG8_SA(1, 1), a1 + hstepA, voffA);
            PG8_WAIT_L(8); PG8_BAR; PG8_WAIT_L(0); PG8_MMA(0, 0, At, B0); PG8_BAR; PG8_SCHED;
            PG8_LDB(B1, 0, 1); PG8_STAGE(PG8_SB(0, 0), b2, voffB);
            PG8_BAR; PG8_WAIT_L(0); PG8_MMA(0, 1, At, B1); PG8_BAR;
            PG8_LDA(At, 0, 1); PG8_STAGE(PG8_SA(0, 0), a2, voffA);
            PG8_BAR; PG8_WAIT_L(0); PG8_MMA(1, 0, At, B0); PG8_BAR; PG8_SCHED;
            PG8_STAGE(PG8_SB(0, 1), b2 + hstep, voffB);
            PG8_WAIT_V(6); PG8_BAR; PG8_MMA(1, 1, At, B1); PG8_BAR;
            PG8_LDB(B0, 1, 0); PG8_SCHED; PG8_LDA(At, 1, 0); PG8_STAGE(PG8_SA(0, 1), a2 + hstepA, voffA);
            PG8_WAIT_L(8); PG8_BAR; PG8_WAIT_L(0); PG8_MMA(0, 0, At, B0); PG8_BAR; PG8_SCHED;
            PG8_LDB(B1, 1, 1); PG8_STAGE(PG8_SB(1, 0), b3, voffB);
            PG8_BAR; PG8_WAIT_L(0); PG8_MMA(0, 1, At, B1); PG8_BAR;
            PG8_LDA(At, 1, 1); PG8_STAGE(PG8_SA(1, 0), a3, voffA);
            PG8_BAR; PG8_WAIT_L(0); PG8_MMA(1, 0, At, B0); PG8_BAR; PG8_SCHED;
            PG8_STAGE(PG8_SB(1, 1), b3 + hstep, voffB);
            PG8_WAIT_V(6); PG8_BAR; PG8_MMA(1, 1, At, B1); PG8_BAR;
        }
        E(acc, cur, wr, wc, fr, fq);
        if (!has_next) break;
#pragma unroll
        for (int a = 0; a < 2; ++a)
#pragma unroll
            for (int b = 0; b < 2; ++b)
#pragma unroll
                for (int m = 0; m < 4; ++m)
#pragma unroll
                    for (int n = 0; n < 2; ++n) acc[a][b][m][n] = (f32x4){0.f, 0.f, 0.f, 0.f};
        cur = nxt; cA = nA; cB = nB; ++ui;
    }
    PG8_WAIT_V(0);
    if (wr == 0) PG8_BAR;
    PG8_BAR;
#undef PG8_SA
#undef PG8_SB
#undef PG8_STAGE
#undef PG8_LDA
#undef PG8_LDB
#undef PG8_MMA
#undef PG8_WAIT_V
#undef PG8_WAIT_L
#undef PG8_BAR
#undef PG8_SCHED
}
}
using pg8::Unit;

struct Epi1 {
    static constexpr bool PERM = true;
    bf16_t* QKV; bf16_t* SZA; bf16_t* UU; bf16_t* SZB; float* BA; bf16_t* HALO;
    __device__ __forceinline__ void operator()(const f32x4 (&acc)[2][2][4][2], const Unit& u, int wr, int wc, int fr_, int fq_) const {
        int lane = (int)(threadIdx.x & 63); asm volatile("" : "+v"(lane));
        const int fr = lane & 15, fq = lane >> 4; (void)fr_; (void)fq_;
        const int row0 = u.pm * 256 + wr * 64 + fr, pn = u.pn;
#pragma unroll
        for (int ai = 0; ai < 2; ++ai)
#pragma unroll
            for (int m = 0; m < 4; ++m) {
                const size_t row = (size_t)(row0 + ai * 128 + m * 16);
#pragma unroll
                for (int bj = 0; bj < 2; ++bj) {
                    const int colt = 128 * bj + 32 * wc + 8 * fq;
                    f32x4 v0 = acc[ai][bj][m][0], v1 = acc[ai][bj][m][1];
                    if (pn < 12) {
                        const int c = pn * 256 + colt; const u32x4 pk = pack8(v0, v1);
                        *(u32x4*)(QKV + row * 3072 + c) = pk;
                        if (m == 3 && fr >= 13) *(u32x4*)(HALO + ((row >> 6) * 3 + (fr - 13)) * 3072 + c) = pk;
                    } else if (pn < 16) {
#pragma unroll
                        for (int e = 0; e < 4; ++e) { v0[e] = siluf_(v0[e]); v1[e] = siluf_(v1[e]); }
                        *(u32x4*)(SZA + row * 1024 + (pn - 12) * 256 + colt) = pack8(v0, v1);
                    } else if (pn < 20) {
                        *(u32x4*)(UU + row * 1024 + (pn - 16) * 256 + colt) = pack8(v0, v1);
                    } else if (pn < 24) {
#pragma unroll
                        for (int e = 0; e < 4; ++e) { v0[e] = siluf_(v0[e]); v1[e] = siluf_(v1[e]); }
                        *(u32x4*)(SZB + row * 1024 + (pn - 20) * 256 + colt) = pack8(v0, v1);
                    } else if (colt < 16) {
                        *(f32x4*)(BA + row * 16 + colt) = v0; *(f32x4*)(BA + row * 16 + colt + 4) = v1;
                    }
                }
            }
    }
};
struct EpiGlu {
    static constexpr bool PERM = true;
    const bf16_t* Y5; bf16_t* SZB;
    __device__ __forceinline__ void operator()(const f32x4 (&acc)[2][2][4][2], const Unit& u, int wr, int wc, int fr, int fq) const {
        const int row0 = u.pm * 256 + wr * 64 + fr;
#pragma unroll
        for (int ai = 0; ai < 2; ++ai)
#pragma unroll
            for (int m = 0; m < 4; ++m) {
                const size_t row = (size_t)(row0 + ai * 128 + m * 16);
#pragma unroll
                for (int bj = 0; bj < 2; ++bj) {
                    const int c = u.pn * 256 + 128 * bj + 32 * wc + 8 * fq;
                    const u32x4 y = *(const u32x4*)(Y5 + row * 1024 + c), z = *(const u32x4*)(SZB + row * 1024 + c);
                    const f32x4 a0 = acc[ai][bj][m][0], a1 = acc[ai][bj][m][1];
                    u32x4 o;
                    o.x = pk2(lo2f(y.x) * sigmoidf_(a0[0]) * lo2f(z.x), hi2f(y.x) * sigmoidf_(a0[1]) * hi2f(z.x));
                    o.y = pk2(lo2f(y.y) * sigmoidf_(a0[2]) * lo2f(z.y), hi2f(y.y) * sigmoidf_(a0[3]) * hi2f(z.y));
                    o.z = pk2(lo2f(y.z) * sigmoidf_(a1[0]) * lo2f(z.z), hi2f(y.z) * sigmoidf_(a1[1]) * hi2f(z.z));
                    o.w = pk2(lo2f(y.w) * sigmoidf_(a1[2]) * lo2f(z.w), hi2f(y.w) * sigmoidf_(a1[3]) * hi2f(z.w));
                    *(u32x4*)(SZB + row * 1024 + c) = o;
                }
            }
    }
};
struct EpiF32 {
    static constexpr bool PERM = false;
    float* C;
    __device__ __forceinline__ void operator()(const f32x4 (&acc)[2][2][4][2], const Unit& u, int wr, int wc, int fr, int fq) const {
        const int row0 = u.pm * 256 + wr * 64 + fr, col0 = u.pn * 256 + wc * 32 + 4 * fq;
#pragma unroll
        for (int ai = 0; ai < 2; ++ai)
#pragma unroll
            for (int m = 0; m < 4; ++m) { float* rowp = C + (size_t)(row0 + ai * 128 + m * 16) * 1024 + col0;
#pragma unroll
                for (int bj = 0; bj < 2; ++bj)
#pragma unroll
                    for (int n = 0; n < 2; ++n) *(f32x4*)(rowp + bj * 128 + n * 16) = acc[ai][bj][m][n]; }
    }
};
struct EpiB16 {
    static constexpr bool PERM = true;
    bf16_t* C;
    __device__ __forceinline__ void operator()(const f32x4 (&acc)[2][2][4][2], const Unit& u, int wr, int wc, int fr, int fq) const {
        const int row0 = u.pm * 256 + wr * 64 + fr, col0 = u.pn * 256 + wc * 32 + 8 * fq;
#pragma unroll
        for (int ai = 0; ai < 2; ++ai)
#pragma unroll
            for (int m = 0; m < 4; ++m) { bf16_t* rowp = C + (size_t)(row0 + ai * 128 + m * 16) * 1024 + col0;
#pragma unroll
                for (int bj = 0; bj < 2; ++bj) *(u32x4*)(rowp + bj * 128) = pack8(acc[ai][bj][m][0], acc[ai][bj][m][1]); }
    }
};
struct Epi2 {
    static constexpr bool PERM = false;
    bf16_t* P; bf16_t* Q;
    __device__ __forceinline__ void operator()(const f32x4 (&acc)[2][2][4][2], const Unit& u, int wr, int wc, int fr, int fq) const {
        const int row0 = u.pm * 256 + wr * 64 + fr, ch = u.pn * 64 + 16 * wc + 4 * fq;
#pragma unroll
        for (int ai = 0; ai < 2; ++ai)
#pragma unroll
            for (int m = 0; m < 4; ++m) {
                const size_t row = (size_t)(row0 + ai * 128 + m * 16);
                const f32x4 gb = acc[ai][0][m][0], gc = acc[ai][0][m][1], hv = acc[ai][1][m][0], z = acc[ai][1][m][1];
                u32x2 pp, qq;
                pp.x = pk2(gc[0] * hv[0], gc[1] * hv[1]); pp.y = pk2(gc[2] * hv[2], gc[3] * hv[3]);
                qq.x = pk2(gb[0] * siluf_(z[0]), gb[1] * siluf_(z[1])); qq.y = pk2(gb[2] * siluf_(z[2]), gb[3] * siluf_(z[3]));
                *(u32x2*)(P + row * 2048 + ch) = pp; *(u32x2*)(Q + row * 2048 + ch) = qq;
            }
    }
};

__device__ __forceinline__ int src_col(int mode, int n, int& pn_unused) {
    (void)pn_unused;
    if (mode == 0) return n;
    if (mode == 1) { if (n < 4096) return n; if (n < 6144) return n + 16; if (n < 6160) return n - 2048; return -1; }
    const int pn = n >> 8, col = n & 255, bj = col >> 7, wc = (col >> 5) & 3, nn = (col >> 4) & 1, lo = col & 15;
    return (2 * bj + nn) * 2048 + pn * 64 + 16 * wc + lo;
}
__device__ __forceinline__ void phase_convert(const Prm& p, unsigned char* lds, int t_begin, int t_end, int nblk, int bidx) {
    float* tile = (float*)lds;
    const int tid = threadIdx.x;
    for (int tix = t_begin + bidx; tix < t_end; tix += nblk) {
        int tl = tix, K, Nsrc, mode; const float* W; bf16_t* Wt;
        if (tl < 1600) { W = p.in[3]; Wt = (bf16_t*)(p.ws + OFF_WT1); K = 1024; Nsrc = 6160; mode = 1; }
        else if ((tl -= 1600) < 256) { W = p.in[16]; Wt = (bf16_t*)(p.ws + OFF_WTG); K = 1024; Nsrc = 1024; mode = 0; }
        else if ((tl -= 256) < 512) { W = p.in[17]; Wt = (bf16_t*)(p.ws + OFF_WTO0); K = 2048; Nsrc = 1024; mode = 0; }
        else if ((tl -= 512) < 2048) { W = p.in[18]; Wt = (bf16_t*)(p.ws + OFF_WT2); K = 1024; Nsrc = 8192; mode = 2; }
        else { tl -= 2048; W = p.in[20]; Wt = (bf16_t*)(p.ws + OFF_WTO1); K = 2048; Nsrc = 1024; mode = 0; }
        const int ntk = K / 64, n0 = (tl / ntk) * 64, k0 = (tl % ntk) * 64;
        { const int j = tid & 63; int dummy = 0; const int sc = src_col(mode, n0 + j, dummy);
#pragma unroll
          for (int i = 0; i < 8; ++i) { const int k = (tid >> 6) + 8 * i; tile[k * 65 + j] = sc >= 0 ? W[(size_t)(k0 + k) * Nsrc + sc] : 0.0f; } }
        __syncthreads();
        { const int r = tid >> 3, c8 = (tid & 7) * 8; u32x4 o;
          o.x = pk2(tile[(c8 + 0) * 65 + r], tile[(c8 + 1) * 65 + r]); o.y = pk2(tile[(c8 + 2) * 65 + r], tile[(c8 + 3) * 65 + r]);
          o.z = pk2(tile[(c8 + 4) * 65 + r], tile[(c8 + 5) * 65 + r]); o.w = pk2(tile[(c8 + 6) * 65 + r], tile[(c8 + 7) * 65 + r]);
          *(u32x4*)(Wt + (size_t)(n0 + r) * K + k0 + c8) = o; }
        __syncthreads();
    }
}
__device__ __forceinline__ void phase_rmsnorm_x(const float* x, const float* w, bf16_t* H) {
    const int lane = threadIdx.x & 63, nw = gridDim.x * 8;
    for (int row = blockIdx.x * 8 + (threadIdx.x >> 6); row < TOK; row += nw) {
        const f32x4* xr = (const f32x4*)(x + (size_t)row * 1024);
        f32x4 v[4]; float ss = 0.f;
#pragma unroll
        for (int i = 0; i < 4; ++i) { v[i] = xr[lane + 64 * i]; ss += v[i][0] * v[i][0] + v[i][1] * v[i][1] + v[i][2] * v[i][2] + v[i][3] * v[i][3]; }
        ss = wave_sum(ss);
        const float rstd = rsqrtf(ss * (1.0f / 1024.0f) + 1e-6f);
#pragma unroll
        for (int i = 0; i < 4; ++i) { const f32x4 w4 = ((const f32x4*)w)[lane + 64 * i]; u32x2 o;
            o.x = pk2(v[i][0] * rstd * w4[0], v[i][1] * rstd * w4[1]); o.y = pk2(v[i][2] * rstd * w4[2], v[i][3] * rstd * w4[3]);
            *(u32x2*)(H + (size_t)row * 1024 + (lane + 64 * i) * 4) = o; }
    }
}
template <bool NEXT>
__device__ __forceinline__ void phase_post(const float* base, const bf16_t* Y, const float* wpost, float* OUT, const float* wpre, bf16_t* H) {
    const int lane = threadIdx.x & 63, nw = gridDim.x * 8;
    for (int row = blockIdx.x * 8 + (threadIdx.x >> 6); row < TOK; row += nw) {
        const u32x2* yr = (const u32x2*)(Y + (size_t)row * 1024); const f32x4* br = (const f32x4*)(base + (size_t)row * 1024);
        f32x4 v[4], xb[4]; float ss = 0.f;
#pragma unroll
        for (int i = 0; i < 4; ++i) { const u32x2 y2 = yr[lane + 64 * i]; v[i] = (f32x4){lo2f(y2.x), hi2f(y2.x), lo2f(y2.y), hi2f(y2.y)}; xb[i] = br[lane + 64 * i]; ss += v[i][0] * v[i][0] + v[i][1] * v[i][1] + v[i][2] * v[i][2] + v[i][3] * v[i][3]; }
        ss = wave_sum(ss);
        const float rstd = rsqrtf(ss * (1.0f / 1024.0f) + 1e-6f);
        float s2 = 0.f;
#pragma unroll
        for (int i = 0; i < 4; ++i) { const f32x4 w4 = ((const f32x4*)wpost)[lane + 64 * i];
#pragma unroll
            for (int e = 0; e < 4; ++e) { v[i][e] = xb[i][e] + v[i][e] * rstd * w4[e]; s2 += v[i][e] * v[i][e]; }
            ((f32x4*)(OUT + (size_t)row * 1024))[lane + 64 * i] = v[i]; }
        if (NEXT) {
            s2 = wave_sum(s2);
            const float r2 = rsqrtf(s2 * (1.0f / 1024.0f) + 1e-6f);
#pragma unroll
            for (int i = 0; i < 4; ++i) { const f32x4 w4 = ((const f32x4*)wpre)[lane + 64 * i]; u32x2 o;
                o.x = pk2(v[i][0] * r2 * w4[0], v[i][1] * r2 * w4[1]); o.y = pk2(v[i][2] * r2 * w4[2], v[i][3] * r2 * w4[3]);
                *(u32x2*)(H + (size_t)row * 1024 + (lane + 64 * i) * 4) = o; }
        }
    }
}


__device__ __forceinline__ void sincos_d(double x, double& s, double& c) {
    const double k = rint(x * 0.6366197723675814);
    const double r = fma(-k, 6.123233995736766e-17, fma(-k, 1.5707963267948966, x)), r2 = r * r;
    double sp = -7.647163731819816e-13; sp = fma(sp, r2, 1.6059043836821613e-10); sp = fma(sp, r2, -2.505210838544172e-8); sp = fma(sp, r2, 2.7557319223985893e-6);
    sp = fma(sp, r2, -1.984126984126984e-4); sp = fma(sp, r2, 8.333333333333333e-3); sp = fma(sp, r2, -1.6666666666666666e-1); sp = fma(sp * r2, r, r);
    double cp = 4.779477332387385e-14; cp = fma(cp, r2, -1.1470745597729725e-11); cp = fma(cp, r2, 2.08767569878681e-9); cp = fma(cp, r2, -2.755731922398589e-7);
    cp = fma(cp, r2, 2.48015873015873e-5); cp = fma(cp, r2, -1.388888888888889e-3); cp = fma(cp, r2, 4.1666666666666664e-2); cp = fma(cp, r2, -0.5); cp = fma(cp, r2, 1.0);
    const int q = ((int)k) & 3;
    const double s0 = (q & 1) ? cp : sp, c0 = (q & 1) ? sp : cp;
    s = (q & 2) ? -s0 : s0; c = ((q + 1) & 2) ? -c0 : c0;
}
__device__ __forceinline__ double exp_d(double x) {
    const double n = rint(x * 1.4426950408889634);
    const double r = fma(-n, 2.3190468138462996e-17, fma(-n, 0.6931471805599453, x));
    double p = 1.6059043836821613e-10; p = fma(p, r, 2.08767569878681e-9); p = fma(p, r, 2.505210838544172e-8); p = fma(p, r, 2.755731922398589e-7); p = fma(p, r, 2.7557319223985893e-6);
    p = fma(p, r, 2.48015873015873e-5); p = fma(p, r, 1.984126984126984e-4); p = fma(p, r, 1.388888888888889e-3); p = fma(p, r, 8.333333333333333e-3); p = fma(p, r, 4.1666666666666664e-2);
    p = fma(p, r, 1.6666666666666666e-1); p = fma(p, r, 0.5); p = fma(p, r, 1.0); p = fma(p, r, 1.0);
    return ldexp(p, (int)n);
}
__device__ __forceinline__ float bcast_lo(float v) { auto r = __builtin_amdgcn_permlane32_swap(__float_as_uint(v), __float_as_uint(v), false, false); return __uint_as_float(r[0]); }
__device__ __forceinline__ float bcast_hi(float v) { auto r = __builtin_amdgcn_permlane32_swap(__float_as_uint(v), __float_as_uint(v), false, false); return __uint_as_float(r[1]); }

struct S5C {
    float ar[2][4], ai[2][4];
    float a512r[2], a512i[2];
    bf16x8 BB[4];
    bf16x8 CC[4];
    float dco;
};

template <bool OUT>
__device__ __forceinline__ void s5_chunk(const S5C& C, bf16_t* UU, int b, int g, int chunk, float (&st)[2][2], bf16_t* sX, int lane) {
    const int n = lane & 31, hh = lane >> 5, fr = lane & 15, fq = lane >> 4;
    const size_t tok0 = (size_t)b * SEQ + (size_t)chunk * 512;
    bf16x8 ua = *(const bf16x8*)(UU + (tok0 + n) * 1024 + 16 * g + 8 * hh);
    bf16_t uo[8];
    if (OUT) {
#pragma unroll
        for (int mt = 0; mt < 2; ++mt)
#pragma unroll
            for (int j = 0; j < 4; ++j) uo[mt * 4 + j] = UU[(tok0 + 16 * mt + 4 * fq + j) * 1024 + 16 * g + fr];
    }
    for (int blk = 0; blk < 16; ++blk) {
        const size_t t0 = tok0 + (size_t)blk * 32;
        const bf16x8 ucur = ua;
        bf16_t ucuro[8];
        if (OUT) {
#pragma unroll
            for (int i = 0; i < 8; ++i) ucuro[i] = uo[i];
        }
        if (blk < 15) {
            ua = *(const bf16x8*)(UU + (t0 + 32 + n) * 1024 + 16 * g + 8 * hh);
            if (OUT) {
#pragma unroll
                for (int mt = 0; mt < 2; ++mt)
#pragma unroll
                    for (int j = 0; j < 4; ++j) uo[mt * 4 + j] = UU[(t0 + 32 + 16 * mt + 4 * fq + j) * 1024 + 16 * g + fr];
            }
        }
        f32x16 acc[4];
#pragma unroll
        for (int tl = 0; tl < 4; ++tl) {
            f32x16 z;
#pragma unroll
            for (int i = 0; i < 16; ++i) z[i] = 0.f;
            acc[tl] = __builtin_amdgcn_mfma_f32_32x32x16_bf16(ucur, C.BB[tl], z, 0, 0, 0);
        }
#pragma unroll
        for (int tp = 0; tp < 2; ++tp) {
            f32x16& re = acc[2 * tp]; f32x16& im = acc[2 * tp + 1];
            const float a1r = C.ar[tp][0], a1i = C.ai[tp][0];
#pragma unroll
            for (int q = 0; q < 4; ++q)
#pragma unroll
                for (int r = 1; r < 4; ++r) {
                    const float pr = re[4 * q + r - 1], pi = im[4 * q + r - 1];
                    re[4 * q + r] += a1r * pr - a1i * pi; im[4 * q + r] += a1r * pi + a1i * pr;
                }
            float cr = st[tp][0], ci = st[tp][1];
            const float a4r = C.ar[tp][3], a4i = C.ai[tp][3];
#pragma unroll
            for (int q = 0; q < 4; ++q) {
                const float tr = re[4 * q + 3] + a4r * cr - a4i * ci, ti = im[4 * q + 3] + a4r * ci + a4i * cr;
                const float o0r = bcast_lo(tr), o0i = bcast_lo(ti);
                const float xr = hh ? o0r : cr, xi = hh ? o0i : ci;
                if (OUT) {
#pragma unroll
                    for (int r = 0; r < 4; ++r) { const float kr = C.ar[tp][r], ki = C.ai[tp][r];
                        re[4 * q + r] += kr * xr - ki * xi; im[4 * q + r] += kr * xi + ki * xr; }
                } else {
                    re[4 * q + 3] += a4r * xr - a4i * xi; im[4 * q + 3] += a4r * xi + a4i * xr;
                }
                cr = bcast_hi(re[4 * q + 3]); ci = bcast_hi(im[4 * q + 3]);
            }
            st[tp][0] = cr; st[tp][1] = ci;
        }
        if (OUT) {
            asm volatile("s_waitcnt lgkmcnt(0)" ::: "memory");
#pragma unroll
            for (int tp = 0; tp < 2; ++tp)
#pragma unroll
                for (int i = 0; i < 16; ++i) {
                    const int t = 8 * (i >> 2) + 4 * hh + (i & 3);
                    *(unsigned*)(sX + t * 136 + 2 * (n + 32 * tp)) = pk2(acc[2 * tp][i], acc[2 * tp + 1][i]);
                }
            asm volatile("s_waitcnt lgkmcnt(0)" ::: "memory");
            __builtin_amdgcn_wave_barrier();
#pragma unroll
            for (int mt = 0; mt < 2; ++mt) {
                f32x4 y = (f32x4){0.f, 0.f, 0.f, 0.f};
#pragma unroll
                for (int ks = 0; ks < 4; ++ks) {
                    const bf16x8 xa = *(const bf16x8*)(sX + (16 * mt + fr) * 136 + 32 * ks + 8 * fq);
                    y = __builtin_amdgcn_mfma_f32_16x16x32_bf16(xa, C.CC[ks], y, 0, 0, 0);
                }
#pragma unroll
                for (int j = 0; j < 4; ++j) {
                    float v = y[j] + C.dco * bf2f(ucuro[mt * 4 + j]);
                    const float inner = 0.7978845608028654f * (v + 0.044715f * v * v * v);
                    v = v / (1.0f + __expf(-2.0f * inner));
                    UU[(t0 + 16 * mt + 4 * fq + j) * 1024 + 16 * g + fr] = f2bf(v);
                }
            }
            asm volatile("s_waitcnt lgkmcnt(0)" ::: "memory");
            __builtin_amdgcn_wave_barrier();
        }
    }
}

__device__ __forceinline__ void phase_s5(const Prm& p, unsigned char* lds, int bg) {
    const int b = bg >> 6, g = bg & 63;
    const int tid = threadIdx.x, wv = tid >> 6, lane = tid & 63, n = lane & 31, hh = lane >> 5, fr = lane & 15, fq = lane >> 4;
    bf16_t* sX = (bf16_t*)(lds + wv * 8704);
    float* sXE = (float*)(lds + 8 * 8704);
    bf16_t* UU = (bf16_t*)(p.ws + OFF_UU);
    const float* lam_re = p.in[8]; const float* lam_im = p.in[9]; const float* b_re = p.in[10]; const float* b_im = p.in[11];
    const float* c_re = p.in[12]; const float* c_im = p.in[13];
    S5C C;
    const double dt = exp_d((double)p.in[14][g]);
    float fre[2], fim[2];
#pragma unroll
    for (int tp = 0; tp < 2; ++tp) {
        const int pp = n + 32 * tp;
        const double lr = (double)fminf(lam_re[g * 64 + pp], -1e-4f), li = (double)lam_im[g * 64 + pp];
#pragma unroll
        for (int k = 0; k < 4; ++k) { double sn, cs; sincos_d(li * dt * (k + 1), sn, cs); const double mag = exp_d(lr * dt * (k + 1)); C.ar[tp][k] = (float)(mag * cs); C.ai[tp][k] = (float)(mag * sn); }
        { double sn, cs; sincos_d(li * dt * 512.0, sn, cs); const double mag = exp_d(lr * dt * 512.0); C.a512r[tp] = (float)(mag * cs); C.a512i[tp] = (float)(mag * sn); }
        double sn, cs; sincos_d(li * dt, sn, cs);
        const double mag = exp_d(lr * dt), abr = mag * cs, abi = mag * sn;
        const double den = lr * lr + li * li, nr = abr - 1.0, ni = abi;
        fre[tp] = (float)((nr * lr + ni * li) / den); fim[tp] = (float)((ni * lr - nr * li) / den);
    }
#pragma unroll
    for (int tl = 0; tl < 4; ++tl) {
        const int tp = tl >> 1, ri = tl & 1, pp = n + 32 * tp;
#pragma unroll
        for (int j = 0; j < 8; ++j) {
            const int ch = 8 * hh + j;
            const float br = b_re[(g * 64 + pp) * 16 + ch], bi = b_im[(g * 64 + pp) * 16 + ch];
            const float v = ri == 0 ? fre[tp] * br - fim[tp] * bi : fre[tp] * bi + fim[tp] * br;
            C.BB[tl][j] = (short)f2bf(v);
        }
    }
#pragma unroll
    for (int ks = 0; ks < 4; ++ks)
#pragma unroll
        for (int j = 0; j < 8; ++j) {
            const int k = 32 * ks + 8 * fq + j, pp = k >> 1, ri = k & 1;
            const float v = ri == 0 ? c_re[(g * 16 + fr) * 64 + pp] : -c_im[(g * 16 + fr) * 64 + pp];
            C.CC[ks][j] = (short)f2bf(v);
        }
    C.dco = p.in[15][16 * g + fr];
    for (int rd = 0; rd < 2; ++rd) {
        const int chunk = wv + 8 * rd;
        float st[2][2] = {{0.f, 0.f}, {0.f, 0.f}};
        s5_chunk<false>(C, UU, b, g, chunk, st, sX, lane);
        if (hh == 0) {
#pragma unroll
            for (int tp = 0; tp < 2; ++tp) { sXE[(chunk * 64 + n + 32 * tp) * 2 + 0] = st[tp][0]; sXE[(chunk * 64 + n + 32 * tp) * 2 + 1] = st[tp][1]; }
        }
    }
    __syncthreads();
    for (int rd = 0; rd < 2; ++rd) {
        const int chunk = wv + 8 * rd;
        float st[2][2] = {{0.f, 0.f}, {0.f, 0.f}};
        for (int c2 = 0; c2 < chunk; ++c2) {
#pragma unroll
            for (int tp = 0; tp < 2; ++tp) {
                const float er = sXE[(c2 * 64 + n + 32 * tp) * 2 + 0], ei = sXE[(c2 * 64 + n + 32 * tp) * 2 + 1];
                const float nr = C.a512r[tp] * st[tp][0] - C.a512i[tp] * st[tp][1] + er, ni = C.a512r[tp] * st[tp][1] + C.a512i[tp] * st[tp][0] + ei;
                st[tp][0] = nr; st[tp][1] = ni;
            }
        }
        s5_chunk<true>(C, UU, b, g, chunk, st, sX, lane);
        if (rd == 0) {
            asm volatile("s_waitcnt vmcnt(0)" ::: "memory");
            __syncthreads();
            if (threadIdx.x == 0) { __builtin_amdgcn_fence(__ATOMIC_RELEASE, "agent"); asm volatile("s_waitcnt vmcnt(0)" ::: "memory");
                __hip_atomic_fetch_add((unsigned*)(p.ws + OFF_BAR) + 3900, 1u, __ATOMIC_RELAXED, __HIP_MEMORY_SCOPE_AGENT); }
        }
    }
    __syncthreads();
}

__device__ __forceinline__ void phase_gdn_prep(const Prm& p, unsigned char* lds, int it0, int nrounds) {
    const int tid0 = threadIdx.x, hb = tid0 >> 8;
    unsigned char* base = lds + hb * 76800;
    bf16_t* sQ = (bf16_t*)base;
    bf16_t* sK = (bf16_t*)(base + 17408);
    bf16_t* sV = (bf16_t*)(base + 2 * 17408);
    float* sL = (float*)(base + 3 * 17408);
    float* sBeta = (float*)(base + 4 * 17408);
    float* sGc = sBeta + 64; float* sEg = sGc + 64; float* sBE = sEg + 64;
    float* sCW = sBE + 64;
    bf16_t* QKV = (bf16_t*)(p.ws + OFF_QKV); const bf16_t* HALO = (const bf16_t*)(p.ws + OFF_HALO);
    const float* BA = (const float*)(p.ws + OFF_BA); float* GL = (float*)(p.ws + OFF_GL);
    bf16_t* WB = (bf16_t*)(p.ws + OFF_WB); bf16_t* ATT = (bf16_t*)(p.ws + OFF_ATT);
    const float* convw = p.in[4];
    for (int rd = 0; rd < nrounds; ++rd) {
        int tid = tid0; asm volatile("" : "+v"(tid));
        const int ht = tid & 255, hw = (tid >> 6) & 3, lane = tid & 63, fr = lane & 15, fq = lane >> 4;
        const int it = it0 + rd * 2 + hb;
        const int b = it >> 10, h = (it >> 7) & 7, nc = it & 127;
        const size_t tokb = (size_t)b * SEQ + (size_t)nc * 64;
#pragma unroll
        for (int i = 0; i < 6; ++i) { const int idx = ht + 256 * i, s3 = idx >> 9, tap = (idx >> 7) & 3, ch = idx & 127; sCW[idx] = convw[tap * 3072 + s3 * 1024 + h * 128 + ch]; }
        __syncthreads();
        {
            const int t0 = (ht >> 4) * 4, cgp = ht & 15;
            u32x4 xall[3][7];
#pragma unroll
            for (int s = 0; s < 3; ++s) {
                const int col = s * 1024 + h * 128 + cgp * 8;
#pragma unroll
                for (int i = 0; i < 7; ++i) {
                    const int tt = t0 - 3 + i;
                    xall[s][i] = (u32x4){0u, 0u, 0u, 0u};
                    if (tt >= 0) xall[s][i] = *(const u32x4*)(QKV + (tokb + tt) * 3072 + col);
                    else if (nc > 0) xall[s][i] = *(const u32x4*)(HALO + ((size_t)(b * 128 + nc - 1) * 3 + (3 + tt)) * 3072 + col);
                }
            }
#pragma unroll
            for (int s = 0; s < 3; ++s) {
                u32x4 xr[7];
#pragma unroll
                for (int i = 0; i < 7; ++i) xr[i] = xall[s][i];
                f32x4 w0[4], w1[4];
#pragma unroll
                for (int j = 0; j < 4; ++j) { w0[j] = *(const f32x4*)(sCW + s * 512 + j * 128 + cgp * 8); w1[j] = *(const f32x4*)(sCW + s * 512 + j * 128 + cgp * 8 + 4); }
                float o[4][8], ss[4];
#pragma unroll
                for (int tk = 0; tk < 4; ++tk) {
                    float a[8];
#pragma unroll
                    for (int e = 0; e < 8; ++e) a[e] = 0.f;
#pragma unroll
                    for (int j = 0; j < 4; ++j) {
                        const u32x4 xv = xr[tk + j];
                        a[0] += w0[j][0] * lo2f(xv.x); a[1] += w0[j][1] * hi2f(xv.x); a[2] += w0[j][2] * lo2f(xv.y); a[3] += w0[j][3] * hi2f(xv.y);
                        a[4] += w1[j][0] * lo2f(xv.z); a[5] += w1[j][1] * hi2f(xv.z); a[6] += w1[j][2] * lo2f(xv.w); a[7] += w1[j][3] * hi2f(xv.w);
                    }
                    float acc2 = 0.f;
#pragma unroll
                    for (int e = 0; e < 8; ++e) { const float v = siluf_(a[e]); o[tk][e] = v; acc2 += v * v; }
                    ss[tk] = acc2;
                }
                bf16_t* dst = (s == 0 ? sQ : (s == 1 ? sK : sV)) + t0 * 136 + cgp * 8;
#pragma unroll
                for (int tk = 0; tk < 4; ++tk) {
                    float sc = 1.0f;
                    if (s < 2) { float q = ss[tk]; q += __shfl_xor(q, 1); q += __shfl_xor(q, 2); q += __shfl_xor(q, 4); q += __shfl_xor(q, 8); sc = rsqrtf(q + 1e-6f) * (s == 0 ? 0.08838834764831845f : 1.0f); }
                    u32x4 pk;
                    pk.x = pk2(o[tk][0] * sc, o[tk][1] * sc); pk.y = pk2(o[tk][2] * sc, o[tk][3] * sc); pk.z = pk2(o[tk][4] * sc, o[tk][5] * sc); pk.w = pk2(o[tk][6] * sc, o[tk][7] * sc);
                    *(u32x4*)(dst + tk * 136) = pk;
                }
            }
        }
        if (hw == 0) {
            const size_t tg = tokb + lane;
            const float braw = BA[tg * 16 + h], araw = BA[tg * 16 + 8 + h];
            const float beta = 1.0f / (1.0f + expf(-braw));
            const float xx = araw + p.in[6][h];
            const float sp = xx > 20.f ? xx : log1pf(expf(xx));
            float gg = -expf(p.in[5][h]) * sp;
#pragma unroll
            for (int off = 1; off < 64; off <<= 1) { const float o = __shfl_up(gg, off); if (lane >= off) gg += o; }
            sBeta[lane] = beta; sGc[lane] = gg; sEg[lane] = expf(gg); sBE[lane] = beta * expf(gg);
            if (lane == 63) GL[it] = expf(gg);
        }
        __syncthreads();
        {
            bf16x8 aK[4], aQ[4];
#pragma unroll
            for (int ks = 0; ks < 4; ++ks) { aK[ks] = *(const bf16x8*)(sK + (16 * hw + fr) * 136 + 32 * ks + 8 * fq); aQ[ks] = *(const bf16x8*)(sQ + (16 * hw + fr) * 136 + 32 * ks + 8 * fq); }
#pragma unroll
            for (int nt = 0; nt < 4; ++nt) {
                f32x4 kk = (f32x4){0.f, 0.f, 0.f, 0.f}, qk = (f32x4){0.f, 0.f, 0.f, 0.f};
#pragma unroll
                for (int ks = 0; ks < 4; ++ks) {
                    const bf16x8 bK = *(const bf16x8*)(sK + (16 * nt + fr) * 136 + 32 * ks + 8 * fq);
                    kk = __builtin_amdgcn_mfma_f32_16x16x32_bf16(aK[ks], bK, kk, 0, 0, 0);
                    qk = __builtin_amdgcn_mfma_f32_16x16x32_bf16(aQ[ks], bK, qk, 0, 0, 0);
                }
                const int mcol = 16 * nt + fr; const float gm = sGc[mcol];
#pragma unroll
                for (int j = 0; j < 4; ++j) {
                    const int c = 16 * hw + 4 * fq + j;
                    const float dec = __expf(fminf(sGc[c] - gm, 0.f));
                    sL[c * 68 + mcol] = (mcol < c) ? kk[j] * sBeta[c] * dec : 0.f;
                    ATT[(size_t)it * 4096 + c * 64 + mcol] = f2bf((mcol <= c) ? qk[j] * dec : 0.f);
                }
            }
        }
        __syncthreads();
        {
            f32x2_t xv[32];
#define X_(i) (xv[(i) >> 1][(i) & 1])
            const bool isU = ht < 128; const int jc = ht & 127;
            const bf16_t* src = isU ? sV : sK;
            const float* fac = isU ? sBeta : sBE;
#pragma unroll
            for (int cb = 0; cb < 16; ++cb) {
                f32x2_t a2[4];
#pragma unroll
                for (int r = 0; r < 4; ++r) { a2[r].x = bf2f(src[(4 * cb + r) * 136 + jc]) * fac[4 * cb + r]; a2[r].y = 0.f; }
                const f32x4 d1 = *(const f32x4*)(sL + (4 * cb + 1) * 68 + 4 * cb), d2 = *(const f32x4*)(sL + (4 * cb + 2) * 68 + 4 * cb), d3 = *(const f32x4*)(sL + (4 * cb + 3) * 68 + 4 * cb);
                const int nb = (cb + 1) / 2;
                f32x4 lb[2][4][2];
#define SOLVE_LOAD(mb_, buf_) do { _Pragma("unroll") for (int q = 0; q < 2; ++q) _Pragma("unroll") for (int r = 0; r < 4; ++r) \
                    if (2 * (mb_) + q < cb) lb[buf_][r][q] = *(const f32x4*)(sL + (4 * cb + r) * 68 + 4 * (2 * (mb_) + q)); } while (0)
                if (nb > 0) SOLVE_LOAD(0, 0);
#pragma unroll
                for (int mb = 0; mb < nb; ++mb) {
                    if (mb + 1 < nb) SOLVE_LOAD(mb + 1, (mb + 1) & 1);
                    __builtin_amdgcn_sched_barrier(0);
#pragma unroll
                    for (int q = 0; q < 2; ++q)
#pragma unroll
                        for (int r = 0; r < 4; ++r)
                            if (2 * mb + q < cb) { const f32x4 l = lb[mb & 1][r][q]; const int m2 = 2 * (2 * mb + q);
                                a2[r] -= (f32x2_t){l[0], l[1]} * xv[m2]; a2[r] -= (f32x2_t){l[2], l[3]} * xv[m2 + 1]; }
                    __builtin_amdgcn_sched_barrier(0);
                }
#undef SOLVE_LOAD
                const float a0 = a2[0].x + a2[0].y, a1 = a2[1].x + a2[1].y, a2s = a2[2].x + a2[2].y, a3 = a2[3].x + a2[3].y;
                const float y0 = a0, y1 = a1 - d1[0] * y0, y2 = a2s - d2[0] * y0 - d2[1] * y1, y3 = a3 - d3[0] * y0 - d3[1] * y1 - d3[2] * y2;
                xv[2 * cb] = (f32x2_t){y0, y1}; xv[2 * cb + 1] = (f32x2_t){y2, y3};
            }
            if (isU) {
                const int w8 = jc >> 4, nn = jc & 15;
#pragma unroll
                for (int rq = 0; rq < 4; ++rq)
#pragma unroll
                    for (int pc = 0; pc < 2; ++pc) {
                        const int c0 = 32 * pc + 8 * rq;
                        u32x4 o; o.x = pk2(X_(c0 + 0), X_(c0 + 1)); o.y = pk2(X_(c0 + 2), X_(c0 + 3)); o.z = pk2(X_(c0 + 4), X_(c0 + 5)); o.w = pk2(X_(c0 + 6), X_(c0 + 7));
                        const int L = ((w8 * 2 + pc) * 64 + rq * 16 + nn) * 8;
                        *(u32x4*)(QKV + (tokb + (L >> 7)) * 3072 + 2048 + h * 128 + (L & 127)) = o;
                    }
            }
            __syncthreads();
            if (!isU) {
                bf16_t* sW2 = (bf16_t*)sL;
#pragma unroll
                for (int c = 0; c < 64; ++c) sW2[c * 136 + jc] = f2bf(-X_(c));
            }
        }
        __syncthreads();
        {
            const bf16_t* sW2 = (const bf16_t*)sL;
#pragma unroll
            for (int i = 0; i < 4; ++i) { const int ch = ht + 256 * i, r = ch >> 4, c8 = (ch & 15) * 8; *(u32x4*)(WB + (size_t)it * 8192 + r * 128 + c8) = *(const u32x4*)(sW2 + r * 136 + c8); }
        }
#undef X_
        {
            const int c = ht >> 2, ds = (ht & 3) * 32; const float eg = sEg[c];
#pragma unroll
            for (int c8 = 0; c8 < 4; ++c8) {
                const u32x4 v = *(const u32x4*)(sQ + c * 136 + ds + c8 * 8); u32x4 o;
                o.x = pk2(lo2f(v.x) * eg, hi2f(v.x) * eg); o.y = pk2(lo2f(v.y) * eg, hi2f(v.y) * eg); o.z = pk2(lo2f(v.z) * eg, hi2f(v.z) * eg); o.w = pk2(lo2f(v.w) * eg, hi2f(v.w) * eg);
                *(u32x4*)(QKV + (tokb + c) * 3072 + h * 128 + ds + c8 * 8) = o;
            }
            const int d = ht >> 1, cs = (ht & 1) * 32; const float gl = sGc[63];
#pragma unroll
            for (int c8 = 0; c8 < 4; ++c8) {
                float v[8];
#pragma unroll
                for (int e = 0; e < 8; ++e) { const int cc = cs + c8 * 8 + e; v[e] = bf2f(sK[cc * 136 + d]) * __expf(gl - sGc[cc]); }
                u32x4 o; o.x = pk2(v[0], v[1]); o.y = pk2(v[2], v[3]); o.z = pk2(v[4], v[5]); o.w = pk2(v[6], v[7]);
                *(u32x4*)(QKV + (tokb + (d >> 1)) * 3072 + 1024 + h * 128 + (d & 1) * 64 + cs + c8 * 8) = o;
            }
        }
        __syncthreads();
    }
}

constexpr int SC_WQ = 32768, SC_KA = 24576, SC_KA0 = 3 * SC_WQ;
static_assert(SC_KA0 + 2 * SC_KA <= LDS_BYTES, "scan LDS layout");
__device__ __forceinline__ bf16x8 pack2(const f32x4& a, const f32x4& b) {
    u32x4 r; r.x = pk2(a[0], a[1]); r.y = pk2(a[2], a[3]); r.z = pk2(b[0], b[1]); r.w = pk2(b[2], b[3]); return __builtin_bit_cast(bf16x8, r);
}
#define MF16(a, b, c) __builtin_amdgcn_mfma_f32_16x16x32_bf16(a, b, c, 0, 0, 0)
#define DMA16(src, dst) __builtin_amdgcn_global_load_lds((const unsigned*)(src), (LAS unsigned*)(dst), 16, 0, 0)
__device__ __forceinline__ void phase_gdn_scan(const Prm& p, LAS unsigned char* lds, int blk) {
    const int tid = threadIdx.x, wv = __builtin_amdgcn_readfirstlane(tid >> 6), lane = tid & 63, n = lane & 15, kq = lane >> 4;
    const int bh = blk & 15, jh = blk >> 4, b = bh >> 3, h = bh & 7;
    const bf16_t* QKV = (const bf16_t*)(p.ws + OFF_QKV); const bf16_t* WB = (const bf16_t*)(p.ws + OFF_WB); const bf16_t* ATT = (const bf16_t*)(p.ws + OFF_ATT);
    const float* GL = (const float*)(p.ws + OFF_GL); bf16_t* O = (bf16_t*)(p.ws + OFF_H);
    const int itb = bh * 128;
    const bf16_t* qkv_b = QKV + (size_t)b * SEQ * 3072;
    if (wv >= 4) {
        const int lw = wv - 4;
        __builtin_amdgcn_s_setprio(3);
        unsigned oW[4], oQ[4], oK[4], oA[2];
#pragma unroll
        for (int i = 0; i < 4; ++i) {
            { const int q = lw * 4 + i, row = 4 * q + (lane >> 4), pg = lane & 15, g = pg ^ ((row & 3) | (((row >> 3) & 3) << 2)); oW[i] = (unsigned)(row * 128 + g * 8); oQ[i] = (unsigned)(row * 3072 + h * 128 + g * 8); }
            { const int q = lw * 4 + i, d = 8 * q + (lane >> 3), pg = lane & 7, g = pg ^ ((d & 3) | (((d >> 3) & 1) << 2)); oK[i] = (unsigned)((d >> 1) * 3072 + 1024 + h * 128 + (d & 1) * 64 + g * 8); }
        }
#pragma unroll
        for (int i = 0; i < 2; ++i) { const int q = lw * 2 + i, c = 8 * q + (lane >> 3), pg = lane & 7, g = pg ^ ((c & 3) | (((c >> 3) & 1) << 2)); oA[i] = (unsigned)(c * 64 + g * 8); }
#define ISSUE_WQ(ck, st) do { const bf16_t* wb_ = WB + (size_t)(itb + (ck)) * 8192; const bf16_t* qb_ = qkv_b + (size_t)(ck) * 64 * 3072; LAS unsigned char* d_ = lds + (st) * SC_WQ + lw * 4096; \
        _Pragma("unroll") for (int i = 0; i < 4; ++i) { DMA16(wb_ + oW[i], d_ + i * 1024); DMA16(qb_ + oQ[i], d_ + 16384 + i * 1024); } } while (0)
#define ISSUE_KA(ck, st) do { const bf16_t* qb_ = qkv_b + (size_t)(ck) * 64 * 3072; const bf16_t* ab_ = ATT + (size_t)(itb + (ck)) * 4096; LAS unsigned char* d_ = lds + SC_KA0 + (st) * SC_KA; \
        _Pragma("unroll") for (int i = 0; i < 4; ++i) DMA16(qb_ + oK[i], d_ + (lw * 4 + i) * 1024); \
        _Pragma("unroll") for (int i = 0; i < 2; ++i) DMA16(ab_ + oA[i], d_ + 16384 + (lw * 2 + i) * 1024); } while (0)
        ISSUE_WQ(0, 0); ISSUE_KA(0, 0); ISSUE_WQ(1, 1);
        asm volatile("s_waitcnt vmcnt(0)" ::: "memory"); __builtin_amdgcn_s_barrier(); asm volatile("" ::: "memory");
        int s3 = 2;
        for (int nc = 0; nc < 128; ++nc) {
            const int c1 = nc + 1 < 128 ? nc + 1 : 127, c2 = nc + 2 < 128 ? nc + 2 : 127;
            ISSUE_WQ(c2, s3);
            ISSUE_KA(c1, (nc + 1) & 1);
            s3 = s3 == 2 ? 0 : s3 + 1;
            asm volatile("s_waitcnt vmcnt(14)" ::: "memory");
            __builtin_amdgcn_s_barrier(); asm volatile("" ::: "memory");
            __builtin_amdgcn_s_barrier(); asm volatile("" ::: "memory");
        }
        asm volatile("s_waitcnt vmcnt(0)" ::: "memory");
        __builtin_amdgcn_s_setprio(0);
#undef ISSUE_WQ
#undef ISSUE_KA
    } else if (wv >= 2) {
        for (int nc = 0; nc < 257; ++nc) { __builtin_amdgcn_s_barrier(); asm volatile("" ::: "memory"); }
    } else {
        const float gl0 = GL[itb + lane], gl1 = GL[itb + 64 + lane];
        f32x4 S[8];
#pragma unroll
        for (int dt = 0; dt < 8; ++dt) S[dt] = (f32x4){0.f, 0.f, 0.f, 0.f};
        const int e = 32 * jh + 16 * wv + n;
        unsigned uo[2];
#pragma unroll
        for (int pc = 0; pc < 2; ++pc) { const int L = (((2 * jh + wv) * 2 + pc) * 64 + lane) * 8; uo[pc] = (unsigned)((L >> 7) * 3072 + 2048 + h * 128 + (L & 127)); }
        u32x4 ua[2], ub[2];
#pragma unroll
        for (int pc = 0; pc < 2; ++pc) { ua[pc] = *(const u32x4*)(qkv_b + uo[pc]); ub[pc] = *(const u32x4*)(qkv_b + (size_t)64 * 3072 + uo[pc]); }
        const int rowb = 8 * (n >> 2) + (n & 3), swk = (n & 3) | (((n >> 2) & 1) << 2);
        unsigned offW[4], offK[2];
#pragma unroll
        for (int ks = 0; ks < 4; ++ks) offW[ks] = (unsigned)(rowb * 256 + (((4 * ks + kq) ^ n) << 4));
#pragma unroll
        for (int k2 = 0; k2 < 2; ++k2) offK[k2] = (unsigned)(rowb * 128 + (((4 * k2 + kq) ^ swk) << 4));
        asm volatile("s_waitcnt lgkmcnt(0)" ::: "memory"); __builtin_amdgcn_s_barrier(); asm volatile("" ::: "memory");
        int s3 = 0;
        for (int nc = 0; nc < 128; ++nc) {
            const LAS unsigned char* sWQ = lds + s3 * SC_WQ; const LAS unsigned char* sKA = lds + SC_KA0 + (nc & 1) * SC_KA;
            s3 = s3 == 2 ? 0 : s3 + 1;
            const float gl = __builtin_bit_cast(float, __builtin_amdgcn_readlane(__builtin_bit_cast(int, nc < 64 ? gl0 : gl1), nc & 63));
            f32x4 V[4], Oa[4];
#pragma unroll
            for (int pc = 0; pc < 2; ++pc) {
                const u32x4 uu = ua[pc];
                V[2 * pc] = (f32x4){lo2f(uu.x), hi2f(uu.x), lo2f(uu.y), hi2f(uu.y)}; V[2 * pc + 1] = (f32x4){lo2f(uu.z), hi2f(uu.z), lo2f(uu.w), hi2f(uu.w)};
                ua[pc] = ub[pc];
            }
            { const int c2 = nc + 2 < 128 ? nc + 2 : 127; const bf16_t* ubase = qkv_b + (size_t)c2 * 64 * 3072;
#pragma unroll
              for (int pc = 0; pc < 2; ++pc) ub[pc] = *(const u32x4*)(ubase + uo[pc]); }
#pragma unroll
            for (int ct = 0; ct < 4; ++ct) Oa[ct] = (f32x4){0.f, 0.f, 0.f, 0.f};
            bf16x8 fa[2][8];
#define TOFF(t, pitch) ((32 * ((t) >> 1) + 4 * ((t) & 1)) * (pitch))
#define LD_WQ(dst, ks_) do { _Pragma("unroll") for (int mt = 0; mt < 4; ++mt) { dst[mt] = *(const LAS bf16x8*)(sWQ + offW[ks_] + TOFF(mt, 256)); dst[4 + mt] = *(const LAS bf16x8*)(sWQ + 16384 + offW[ks_] + TOFF(mt, 256)); } } while (0)
            LD_WQ(fa[0], 0);
#pragma unroll
            for (int ks = 0; ks < 4; ++ks) {
                if (ks < 3) LD_WQ(fa[(ks + 1) & 1], ks + 1);
                const bf16x8 sb8 = pack2(S[2 * ks], S[2 * ks + 1]);
                __builtin_amdgcn_sched_barrier(0);
#pragma unroll
                for (int mt = 0; mt < 4; ++mt) { V[mt] = MF16(fa[ks & 1][mt], sb8, V[mt]); Oa[mt] = MF16(fa[ks & 1][4 + mt], sb8, Oa[mt]); }
                __builtin_amdgcn_sched_barrier(0);
            }
#undef LD_WQ
            asm volatile("s_waitcnt lgkmcnt(0)" ::: "memory"); __builtin_amdgcn_s_barrier(); asm volatile("" ::: "memory");
            bf16x8 fb[2][12];
#define LD_AK(dst, k2_) do { _Pragma("unroll") for (int mt = 0; mt < 4; ++mt) dst[mt] = *(const LAS bf16x8*)(sKA + 16384 + offK[k2_] + TOFF(mt, 128)); \
                             _Pragma("unroll") for (int dt = 0; dt < 8; ++dt) dst[4 + dt] = *(const LAS bf16x8*)(sKA + offK[k2_] + TOFF(dt, 128)); } while (0)
            LD_AK(fb[0], 0);
            bf16x8 Vb[2];
            Vb[0] = pack2(V[0], V[1]); Vb[1] = pack2(V[2], V[3]);
#pragma unroll
            for (int dt = 0; dt < 8; ++dt) S[dt] *= gl;
#pragma unroll
            for (int k2 = 0; k2 < 2; ++k2) {
                if (k2 < 1) LD_AK(fb[1], 1);
                __builtin_amdgcn_sched_barrier(0);
#pragma unroll
                for (int mt = 0; mt < 4; ++mt) Oa[mt] = MF16(fb[k2][mt], Vb[k2], Oa[mt]);
#pragma unroll
                for (int dt = 0; dt < 8; ++dt) S[dt] = MF16(fb[k2][4 + dt], Vb[k2], S[dt]);
                __builtin_amdgcn_sched_barrier(0);
            }
#undef LD_AK
#undef TOFF
            bf16_t* obase = O + (size_t)(itb + nc) * 8192 + e * 64 + 8 * kq;
#pragma unroll
            for (int pc = 0; pc < 2; ++pc) *(u32x4*)(obase + 32 * pc) = pack8(Oa[2 * pc], Oa[2 * pc + 1]);
            asm volatile("s_waitcnt lgkmcnt(0)" ::: "memory"); __builtin_amdgcn_s_barrier(); asm volatile("" ::: "memory");
        }
    }
    __syncthreads();
}

__device__ __forceinline__ void phase_ya(const Prm& p, unsigned char* lds) {
    const bf16_t* OT = (const bf16_t*)(p.ws + OFF_H); bf16_t* SZA = (bf16_t*)p.out;
    const float* gw = p.in[7];
    bf16_t* sT = (bf16_t*)lds;
    float* sPart = (float*)(lds + 16384);
    const int tid = threadIdx.x, w = tid >> 6, c = tid & 63;
    for (int it = blockIdx.x; it < NIT; it += gridDim.x) {
        const int b = it >> 10, h = (it >> 7) & 7, nc = it & 127;
        const size_t tok = (size_t)b * SEQ + (size_t)nc * 64 + c;
#pragma unroll
        for (int i = 0; i < 2; ++i) { const int ch = tid + 512 * i; *(u32x4*)(sT + ch * 8) = *(const u32x4*)(OT + (size_t)it * 8192 + ch * 8); }
        const u32x4 z0 = *(const u32x4*)(SZA + tok * 1024 + h * 128 + 16 * w), z1 = *(const u32x4*)(SZA + tok * 1024 + h * 128 + 16 * w + 8);
        __syncthreads();
        float o[16]; float ss = 0.f;
#pragma unroll
        for (int j = 0; j < 16; ++j) { o[j] = bf2f(sT[(16 * w + j) * 64 + c]); ss += o[j] * o[j]; }
        sPart[w * 64 + c] = ss;
        __syncthreads();
        float tot = 0.f;
#pragma unroll
        for (int k = 0; k < 8; ++k) tot += sPart[k * 64 + c];
        const float rstd = rsqrtf(tot * (1.0f / 128.0f) + 1e-6f);
        const unsigned zz[8] = {z0.x, z0.y, z0.z, z0.w, z1.x, z1.y, z1.z, z1.w};
        unsigned r[8];
#pragma unroll
        for (int j = 0; j < 8; ++j)
            r[j] = pk2(o[2 * j] * rstd * gw[16 * w + 2 * j] * lo2f(zz[j]), o[2 * j + 1] * rstd * gw[16 * w + 2 * j + 1] * hi2f(zz[j]));
        *(u32x4*)(SZA + tok * 1024 + h * 128 + 16 * w) = (u32x4){r[0], r[1], r[2], r[3]};
        *(u32x4*)(SZA + tok * 1024 + h * 128 + 16 * w + 8) = (u32x4){r[4], r[5], r[6], r[7]};
        __syncthreads();
    }
}
__device__ __forceinline__ void phase_conv3(const Prm& p) {
    const bf16_t* P = (const bf16_t*)(p.ws + OFF_P); bf16_t* Q = (bf16_t*)(p.ws + OFF_Q); const float* cw = p.in[19];
    const int nth = gridDim.x * 512;
    for (int idx = blockIdx.x * 512 + threadIdx.x; idx < (TOK / 4) * 256; idx += nth) {
        const int t0 = (idx >> 8) * 4, c8 = (idx & 255) * 8;
        const bool first = (t0 & (SEQ - 1)) == 0;
        u32x4 pr[6], qr[4];
#pragma unroll
        for (int i = 0; i < 6; ++i) pr[i] = (i < 2 && first) ? (u32x4){0u, 0u, 0u, 0u} : *(const u32x4*)(P + (size_t)(t0 - 2 + i) * 2048 + c8);
#pragma unroll
        for (int i = 0; i < 4; ++i) qr[i] = *(const u32x4*)(Q + (size_t)(t0 + i) * 2048 + c8);
        float w0[8], w1[8], w2[8];
#pragma unroll
        for (int e = 0; e < 8; ++e) { w0[e] = cw[c8 + e]; w1[e] = cw[2048 + c8 + e]; w2[e] = cw[4096 + c8 + e]; }
#pragma unroll
        for (int i = 0; i < 4; ++i) {
            const unsigned pa[4] = {pr[i + 2].x, pr[i + 2].y, pr[i + 2].z, pr[i + 2].w}, pb[4] = {pr[i + 1].x, pr[i + 1].y, pr[i + 1].z, pr[i + 1].w}, pc[4] = {pr[i].x, pr[i].y, pr[i].z, pr[i].w};
            const unsigned qa[4] = {qr[i].x, qr[i].y, qr[i].z, qr[i].w};
            unsigned o[4];
#pragma unroll
            for (int e = 0; e < 4; ++e)
                o[e] = pk2(lo2f(qa[e]) * (w0[2 * e] * lo2f(pc[e]) + w1[2 * e] * lo2f(pb[e]) + w2[2 * e] * lo2f(pa[e])),
                           hi2f(qa[e]) * (w0[2 * e + 1] * hi2f(pc[e]) + w1[2 * e + 1] * hi2f(pb[e]) + w2[2 * e + 1] * hi2f(pa[e])));
            *(u32x4*)(Q + (size_t)(t0 + i) * 2048 + c8) = (u32x4){o[0], o[1], o[2], o[3]};
        }
    }
}

#define XB_TMO      128
#define XB_XCNT(j)  (256  + 64 * (j))
#define XB_XSUB(j)  (1280 + 64 * (j))
#define XB_XGEN(j)  (2304 + 64 * (j))
#define XB_TOP      3328
#define XB_TOPGEN   3392
#define XCD_BAR_WORDS 3456
#define XB_SPIN_CAP (1u << 18)

__device__ __forceinline__ unsigned xb_ld(unsigned* p)              { return __hip_atomic_load(p, __ATOMIC_RELAXED, __HIP_MEMORY_SCOPE_AGENT); }
__device__ __forceinline__ unsigned xb_add(unsigned* p, unsigned v) { return __hip_atomic_fetch_add(p, v, __ATOMIC_RELAXED, __HIP_MEMORY_SCOPE_AGENT); }
__device__ __forceinline__ unsigned xb_xcc_id() { return (unsigned)__builtin_amdgcn_s_getreg((3 << 11) | 20) & 0xFu; }
#define XB_SPIN(cond, bar) do { unsigned _sp = 0; while (cond) { __builtin_amdgcn_s_sleep(1); \
    if ((++_sp & 255u) == 0u) { if (xb_ld(&(bar)[XB_TMO])) break; if (_sp > XB_SPIN_CAP) { atomicAdd(&(bar)[XB_TMO], 1u); break; } } } } while (0)

struct XcdBarrier {
    unsigned* bar; unsigned x;
    volatile LAS unsigned* st;
};

__device__ __forceinline__ XcdBarrier xcd_barrier_post(unsigned* bar, volatile LAS unsigned* st) {
    XcdBarrier b; b.bar = bar; b.x = xb_xcc_id(); b.st = st;
    if (threadIdx.x == 0) (void)xb_add(&bar[XB_XCNT(b.x)], 1u);
    return b;
}
__device__ __forceinline__ void xcd_barrier_complete(unsigned* bar, unsigned x, unsigned& nloc, unsigned& nx) {
    const unsigned G = gridDim.x * gridDim.y * gridDim.z;
    unsigned sum, cnt, mine, sp = 0u;
    for (;;) {
        sum = 0u; cnt = 0u; mine = 0u;
#pragma unroll
        for (unsigned j = 0; j < 16; ++j) { const unsigned c = xb_ld(&bar[XB_XCNT(j)]); sum += c; cnt += (c > 0u) ? 1u : 0u; mine = (j == x) ? c : mine; }
        if (sum == G) break;
        __builtin_amdgcn_s_sleep(1);
        if ((++sp & 255u) == 0u) { if (xb_ld(&bar[XB_TMO])) break; if (sp > XB_SPIN_CAP) { atomicAdd(&bar[XB_TMO], 1u); break; } }
    }
    nloc = mine > 0u ? mine : 1u; nx = cnt > 0u ? cnt : 1u;
}

__device__ __forceinline__ void xcd_barrier(const XcdBarrier& b) {
    asm volatile("s_waitcnt vmcnt(0)" ::: "memory");
    __syncthreads();
    if (threadIdx.x == 0) {
        unsigned* bar = b.bar;
        __builtin_amdgcn_s_waitcnt(0);
        unsigned nloc = b.st[0], nx = b.st[1];
        if (nloc == 0u) { xcd_barrier_complete(bar, b.x, nloc, nx); b.st[0] = nloc; b.st[1] = nx; }
        const unsigned old = xb_add(&bar[XB_XSUB(b.x)], 1u);
        const unsigned gen = old / nloc;
        if (old + 1u == (gen + 1u) * nloc) {
            __builtin_amdgcn_fence(__ATOMIC_RELEASE, "agent");
            asm volatile("s_waitcnt vmcnt(0)" ::: "memory");
            const unsigned og = xb_add(&bar[XB_TOP], 1u);
            const unsigned tg = og / nx;
            if (og + 1u == (tg + 1u) * nx) xb_add(&bar[XB_TOPGEN], 1u);
            else XB_SPIN(xb_ld(&bar[XB_TOPGEN]) == tg, bar);
            __builtin_amdgcn_fence(__ATOMIC_ACQUIRE, "agent");
            xb_add(&bar[XB_XGEN(b.x)], 1u);
            asm volatile("s_waitcnt vmcnt(0)" ::: "memory");
        } else {
            XB_SPIN(xb_ld(&bar[XB_XGEN(b.x)]) == gen, bar);
            __builtin_amdgcn_fence(__ATOMIC_ACQUIRE, "agent");
            asm volatile("s_waitcnt vmcnt(0)" ::: "memory");
        }
    }
    __syncthreads();
}

constexpr int NPHASE = 11;
#define REP_GEMM 1
#define REP_SYNC 1
#define REP_SCAN 1
#define SCAN_PROBE 1
#define REP_P0 1
#ifndef PHM
#define PHM 0x7FF
#endif
__global__ void __launch_bounds__(512, 2) mega(Prm p) {
    extern __shared__ __attribute__((aligned(16))) unsigned char shm[];
    LAS unsigned char* lds3 = (LAS unsigned char*)shm;
    unsigned char* ws = p.ws;
    volatile LAS unsigned* xst = (volatile LAS unsigned*)(lds3 + LDS_BYTES);
    if (threadIdx.x == 0) { xst[0] = 0u; xst[1] = 0u; }
    __syncthreads();
    XcdBarrier xb{};
    const bool multi = (p.ph_hi - p.ph_lo) > 1;
    if (multi) xb = xcd_barrier_post((unsigned*)(ws + OFF_BAR), xst);
    if (p.ph_lo < 0) cg::this_grid().sync();
#define PH_BEGIN(i) if (((PHM >> (i)) & 1) && p.ph_lo <= (i) && (i) < p.ph_hi) { if ((i) > p.ph_lo) { xcd_barrier(xb); if (REP_SYNC > 1) xcd_barrier(xb); } pg8::StaticOrder S; (void)S;
#define PH_END }
    PH_BEGIN(0)
        for (int rep = 0; rep < REP_P0; ++rep) {
        phase_convert(p, shm, 0, 1856, gridDim.x, blockIdx.x);
        phase_rmsnorm_x(p.in[0], p.in[1], (bf16_t*)(ws + OFF_H)); __syncthreads(); }
    PH_END
    PH_BEGIN(1)
        pg8::Gemm g{(const bf16_t*)(ws + OFF_H), (const bf16_t*)(ws + OFF_WT1), TOK, NP1, 1024, (const bf16_t*)(ws + OFF_H), 1024, 64};
        Epi1 E{(bf16_t*)(ws + OFF_QKV), (bf16_t*)p.out, (bf16_t*)(ws + OFF_UU), (bf16_t*)p.out + (size_t)TOK * 1024, (float*)(ws + OFF_BA), (bf16_t*)(ws + OFF_HALO)};
        S.init(TOK, NP1, gridDim.x, blockIdx.x); for (int rep = 0; rep < REP_GEMM; ++rep) { pg8::gemm_phase(lds3, g, S, E); __syncthreads(); }
    PH_END
    PH_BEGIN(2)
        {
            unsigned* ctr = (unsigned*)(ws + OFF_BAR) + 3600;
            volatile LAS unsigned* sIt = xst + 2;
            for (;;) {
                if (threadIdx.x == 0) sIt[0] = __hip_atomic_fetch_add(ctr, 2u, __ATOMIC_RELAXED, __HIP_MEMORY_SCOPE_AGENT);
                __syncthreads();
                const unsigned it0 = sIt[0];
                __syncthreads();
                if (it0 >= (unsigned)NIT) break;
                phase_gdn_prep(p, shm, (int)it0, 1);
            }
        }
    PH_END
    PH_BEGIN(3)
        if (blockIdx.x < 64) phase_gdn_scan(p, lds3, blockIdx.x);
        else {
            const int ob = blockIdx.x - 64;
            pg8::Gemm g{(const bf16_t*)(ws + OFF_UU), (const bf16_t*)(ws + OFF_WTG), TOK, 1024, 1024, (const bf16_t*)(ws + OFF_UU), 1024, 64};
            EpiGlu E{(const bf16_t*)(ws + OFF_UU), (bf16_t*)p.out + (size_t)TOK * 1024};
            unsigned* cw = (unsigned*)(ws + OFF_BAR);
            if (ob < 128) {
                phase_s5(p, shm, ob);
                asm volatile("s_waitcnt vmcnt(0)" ::: "memory");
                __syncthreads();
                if (threadIdx.x == 0) {
                    __builtin_amdgcn_fence(__ATOMIC_RELEASE, "agent");
                    asm volatile("s_waitcnt vmcnt(0)" ::: "memory");
                    __hip_atomic_fetch_add(cw + 3700, 1u, __ATOMIC_RELAXED, __HIP_MEMORY_SCOPE_AGENT);
                    unsigned sp = 0;
                    while (__hip_atomic_load(cw + 3700, __ATOMIC_RELAXED, __HIP_MEMORY_SCOPE_AGENT) < 128u) { __builtin_amdgcn_s_sleep(2); if (++sp > (1u << 22)) break; }
                    __builtin_amdgcn_fence(__ATOMIC_ACQUIRE, "agent");
                    asm volatile("s_waitcnt vmcnt(0)" ::: "memory");
                }
                __syncthreads();
                S.init_list(ob, 1, 1); pg8::gemm_phase(lds3, g, S, E);
            } else {
                const int e = ob - 128;
                phase_convert(p, shm, 1856, 1856 + 2304, 64, e);
                __syncthreads();
                if (threadIdx.x == 0) {
                    unsigned sp = 0;
                    while (__hip_atomic_load(cw + 3900, __ATOMIC_RELAXED, __HIP_MEMORY_SCOPE_AGENT) < 128u) { __builtin_amdgcn_s_sleep(2); if (++sp > (1u << 22)) break; }
                    __builtin_amdgcn_fence(__ATOMIC_ACQUIRE, "agent");
                    asm volatile("s_waitcnt vmcnt(0)" ::: "memory");
                }
                __syncthreads();
                S.init_list(2 * e, 2, 0); pg8::gemm_phase(lds3, g, S, E);
                __syncthreads();
                phase_convert(p, shm, 1856 + 2304, 4928, 64, e);
            }
        }
    PH_END
    PH_BEGIN(4)
        phase_ya(p, shm);
    PH_END
    PH_BEGIN(5)
        pg8::Gemm g{(const bf16_t*)p.out, (const bf16_t*)(ws + OFF_WTO0), TOK, 1024, 2048, (const bf16_t*)p.out + (size_t)TOK * 1024, 1024, 16};
        EpiB16 E{(bf16_t*)(ws + OFF_QKV)};
        S.init(TOK, 1024, gridDim.x, blockIdx.x); for (int rep = 0; rep < REP_GEMM; ++rep) { pg8::gemm_phase(lds3, g, S, E); __syncthreads(); }
    PH_END
    PH_BEGIN(6)
        phase_post<true>(p.in[0], (const bf16_t*)(ws + OFF_QKV), p.in[2], p.out, p.in[1] + 1024, (bf16_t*)(ws + OFF_H));
    PH_END
    PH_BEGIN(7)
        pg8::Gemm g{(const bf16_t*)(ws + OFF_H), (const bf16_t*)(ws + OFF_WT2), TOK, 8192, 1024, (const bf16_t*)(ws + OFF_H), 1024, 64};
        Epi2 E{(bf16_t*)(ws + OFF_P), (bf16_t*)(ws + OFF_Q)};
        S.init(TOK, 8192, gridDim.x, blockIdx.x); for (int rep = 0; rep < REP_GEMM; ++rep) { pg8::gemm_phase(lds3, g, S, E); __syncthreads(); }
    PH_END
    PH_BEGIN(8)
        phase_conv3(p);
    PH_END
    PH_BEGIN(9)
        pg8::Gemm g{(const bf16_t*)(ws + OFF_Q), (const bf16_t*)(ws + OFF_WTO1), TOK, 1024, 2048, (const bf16_t*)(ws + OFF_Q), 2048, 64};
        EpiB16 E{(bf16_t*)(ws + OFF_P)};
        S.init(TOK, 1024, gridDim.x, blockIdx.x); for (int rep = 0; rep < REP_GEMM; ++rep) { pg8::gemm_phase(lds3, g, S, E); __syncthreads(); }
    PH_END
    PH_BEGIN(10)
        phase_post<false>(p.out, (const bf16_t*)(ws + OFF_P), p.in[2] + 1024, p.out, nullptr, nullptr);
    PH_END
}

#ifndef N_LAUNCH_MODE
#define N_LAUNCH_MODE 1
#endif

extern "C" void kernel_launch(void* const* d_in, const int* in_sizes, int n_in, void* d_out, int out_size, void* d_ws, size_t ws_size, hipStream_t stream) {
    static int ready = 0;
    if (!ready) {
        if (n_in != 21 || ws_size < WS_END || out_size != TOK * DM) { fprintf(stderr, "kernel_launch: unexpected shapes (n_in %d ws %zu out %d)\n", n_in, ws_size, out_size); ready = -1; return; }
        if (hipFuncSetAttribute((const void*)mega, hipFuncAttributeMaxDynamicSharedMemorySize, LDS_BYTES + 16) != hipSuccess) { fprintf(stderr, "kernel_launch: hipFuncSetAttribute failed\n"); ready = -1; return; }
        ready = 1;
    }
    if (ready < 0) return;
    Prm p{};
    for (int i = 0; i < 21; ++i) p.in[i] = (const float*)d_in[i];
    p.out = (float*)d_out; p.ws = (unsigned char*)d_ws;
#if N_LAUNCH_MODE == 1
    p.ph_lo = 0; p.ph_hi = NPHASE;
    void* args[] = {&p};
    if (hipMemsetAsync((unsigned char*)d_ws + OFF_BAR, 0, 16384, stream) != hipSuccess) { fprintf(stderr, "memset failed\n"); return; }
    hipError_t e = hipLaunchCooperativeKernel((const void*)mega, dim3(256), dim3(512), args, LDS_BYTES + 16, stream);
    if (e != hipSuccess) fprintf(stderr, "cooperative launch failed: %s\n", hipGetErrorString(e));
#else
    for (int ph = 0; ph < NPHASE; ++ph) {
        p.ph_lo = ph; p.ph_hi = ph + 1;
        hipLaunchKernelGGL(mega, dim3(256), dim3(512), LDS_BYTES + 16, stream, p);
    }
#endif
}
```

```cpp
#include <hip/hip_runtime.h>
#include <hip/hip_cooperative_groups.h>
#include <cstdio>
namespace cg = cooperative_groups;

#define LAS __attribute__((address_space(3)))
typedef unsigned short bf16_t;
typedef short bf16x8 __attribute__((ext_vector_type(8)));
typedef float f32x4 __attribute__((ext_vector_type(4)));
typedef float f32x16 __attribute__((ext_vector_type(16)));
typedef unsigned u32x4 __attribute__((ext_vector_type(4)));
typedef unsigned u32x2 __attribute__((ext_vector_type(2)));

constexpr int TOK = 16384, DM = 1024, SEQ = 8192;
constexpr int NP1 = 6400;
constexpr int NIT = 2048;

constexpr size_t OFF_WT1 = 0;
constexpr size_t OFF_WTG = OFF_WT1 + (size_t)NP1 * 1024 * 2;
constexpr size_t OFF_WTO0 = OFF_WTG + (size_t)1024 * 1024 * 2;
constexpr size_t OFF_WT2 = OFF_WTO0 + (size_t)1024 * 2048 * 2;
constexpr size_t OFF_WTO1 = OFF_WT2 + (size_t)8192 * 1024 * 2;
constexpr size_t OFF_H = OFF_WTO1 + (size_t)1024 * 2048 * 2;
constexpr size_t OFF_QKV = OFF_H + (size_t)TOK * 1024 * 2;
constexpr size_t OFF_UU = OFF_QKV + (size_t)TOK * 3072 * 2;
constexpr size_t OFF_WB = OFF_UU + (size_t)TOK * 1024 * 2;
constexpr size_t OFF_ATT = OFF_WB + (size_t)NIT * 8192 * 2;
constexpr size_t OFF_HALO = OFF_ATT + (size_t)NIT * 4096 * 2;
constexpr size_t OFF_BA = OFF_HALO + (size_t)256 * 3 * 3072 * 2;
constexpr size_t OFF_GL = OFF_BA + (size_t)TOK * 16 * 4;
constexpr size_t OFF_BAR = OFF_GL + (size_t)NIT * 4;
constexpr size_t WS_END = OFF_BAR + 16384;
constexpr size_t OFF_YMIX = OFF_QKV;
constexpr size_t OFF_P = OFF_QKV;
constexpr size_t OFF_Q = OFF_QKV + (size_t)TOK * 2048 * 2;
static_assert(OFF_Q + (size_t)TOK * 2048 * 2 <= OFF_WB, "Q overlaps live data");
static_assert(WS_END <= (size_t)256 * 1024 * 1024, "workspace too big");

constexpr int LDS_BYTES = 157696;

struct Prm {
    const float* in[21];
    float* out;
    unsigned char* ws;
    int ph_lo, ph_hi;
};

__device__ __forceinline__ float bf2f(bf16_t b) { return __uint_as_float(((unsigned)b) << 16); }
__device__ __forceinline__ bf16_t f2bf(float f) { unsigned u = __float_as_uint(f); u += 0x7FFFu + ((u >> 16) & 1u); return (bf16_t)(u >> 16); }
typedef __bf16 bf16v2_t __attribute__((ext_vector_type(2)));
typedef float f32x2_t __attribute__((ext_vector_type(2)));
__device__ __forceinline__ unsigned pk2(float lo, float hi) { const f32x2_t v = {lo, hi}; return __builtin_bit_cast(unsigned, __builtin_convertvector(v, bf16v2_t)); }
__device__ __forceinline__ float lo2f(unsigned u) { return __uint_as_float(u << 16); }
__device__ __forceinline__ float hi2f(unsigned u) { return __uint_as_float(u & 0xFFFF0000u); }
__device__ __forceinline__ float sigmoidf_(float x) { return 1.0f / (1.0f + __expf(-x)); }
__device__ __forceinline__ float siluf_(float x) { return x / (1.0f + __expf(-x)); }
__device__ __forceinline__ float wave_sum(float v) {
#pragma unroll
    for (int o = 32; o >= 1; o >>= 1) v += __shfl_xor(v, o);
    return v;
}
__device__ __forceinline__ u32x4 pack8(f32x4 a, f32x4 b) { u32x4 r; r.x = pk2(a[0], a[1]); r.y = pk2(a[2], a[3]); r.z = pk2(b[0], b[1]); r.w = pk2(b[2], b[3]); return r; }

namespace pg8 {
constexpr int BM = 256, BK = 64, HALF = 128, HTB = HALF * BK * 2, STAGE_BYTES = 8 * HTB, NXCD = 8, WGM = 8;
__device__ __forceinline__ int lds_byte(int r, int c) { const int st = (r >> 4) * 2 + (c >> 5), rr = r & 15, cc = c & 31, ob = rr * 64 + cc * 2; return st * 1024 + (ob ^ (((ob >> 9) & 1) << 5)); }
__device__ __forceinline__ void stage_rc(int b, int& R, int& C) { const int st = b / 1024, sb = b % 1024, swz = sb ^ (((sb >> 9) & 1) << 5); R = (st >> 1) * 16 + swz / 64; C = (st & 1) * 32 + (swz % 64) / 2; }
__device__ __forceinline__ int perm32(int rho) { const int n = rho >> 4, i = rho & 15; return 8 * (i >> 2) + 4 * n + (i & 3); }
struct Unit { int pm, pn; };
struct Gemm { const bf16_t* A; const bf16_t* Bt; int M, N, K; const bf16_t* A2; int lda, ks; };
struct StaticOrder {
    int nM, nN, nwg, G, c;
    int lmode, lbase, lcount, lhalf;
    __device__ void init(int M, int N, int G_, int c_) { nM = M / BM; nN = N / BM; nwg = nM * nN; G = G_; c = c_; lmode = 0; lbase = 0; lcount = 0; lhalf = 0; }
    __device__ void init_list(int base, int count, int half) { nM = 64; nN = 4; nwg = 256; G = 1; c = 0; lmode = 1; lbase = base; lcount = count; lhalf = half; }
    __device__ bool next(int i, Unit& u) const {
        if (lmode) { if (i >= lcount) return false; const int j = lbase + i, bb = j >> 6, r = j & 63; u.pm = 32 * bb + 16 * lhalf + (r >> 2); u.pn = r & 3; return true; }
        const long L = (long)i * G + c; if (L >= nwg) return false;
        int wgid = (int)L; { const int q = nwg / NXCD, r = nwg % NXCD, xcd = wgid % NXCD, off = wgid / NXCD; wgid = (xcd < r ? xcd * (q + 1) : r * (q + 1) + (xcd - r) * q) + off; }
        const int nig = WGM * nN, gid = wgid / nig, fm = gid * WGM, gsz = (nM - fm) < WGM ? (nM - fm) : WGM;
        u.pm = fm + ((wgid % nig) % gsz); u.pn = (wgid % nig) / gsz; return true;
    }
};

template <class Epi>
__device__ __forceinline__ void gemm_phase(LAS unsigned char* lds, const Gemm g, const StaticOrder& S, const Epi& E) {
    const int tid = threadIdx.x, wid = __builtin_amdgcn_readfirstlane(tid >> 6), lane = tid & 63, wr = wid >> 2, wc = wid & 3, fr = lane & 15, fq = lane >> 4;
    const int K = g.K, nt = K / BK;
    unsigned voffA[2], voffB[2];
#pragma unroll
    for (int i = 0; i < 2; ++i) { int R, C; stage_rc(tid * 16 + i * 8192, R, C); const int Rb = Epi::PERM ? ((R & ~31) + perm32(R & 31)) : R;
        voffA[i] = (unsigned)(R * g.lda + C) * 2u; voffB[i] = (unsigned)(Rb * K + C) * 2u; }
    const size_t kstep = (size_t)(BK * 2);
    const size_t hstep = (size_t)HALF * K * 2;
    const size_t tstep = 2 * hstep;
    const size_t hstepA = (size_t)HALF * g.lda * 2, tstepA = 2 * hstepA;
    const int ks = g.ks; const ptrdiff_t a2off = (const char*)g.A2 - (const char*)g.A - (ptrdiff_t)ks * (ptrdiff_t)kstep;
    const unsigned ldsw = (unsigned)wid * 1024u;
    const int aoff = lds_byte(wr * 64 + fr, fq * 8), boff = lds_byte(wc * 32 + fr, fq * 8);
#define PG8_SA(b, h) (((b) * 2 + (h)) * HTB)
#define PG8_SB(b, h) ((4 + (b) * 2 + (h)) * HTB)
#define PG8_STAGE(bufoff, gbase, voff) do { _Pragma("unroll") for (int _i = 0; _i < 2; ++_i) \
        __builtin_amdgcn_global_load_lds((const unsigned*)((const char*)(gbase) + (voff)[_i]), (LAS unsigned*)(lds + (bufoff) + ldsw + _i * 8192), 16, 0, 0); } while (0)
#define PG8_LDA(dst, b, h) do { _Pragma("unroll") for (int m = 0; m < 4; ++m) _Pragma("unroll") for (int k = 0; k < 2; ++k) dst[m][k] = *(const LAS bf16x8*)(lds + PG8_SA(b, h) + aoff + m * 2048 + k * 1024); } while (0)
#define PG8_LDB(dst, b, h) do { _Pragma("unroll") for (int n = 0; n < 2; ++n) _Pragma("unroll") for (int k = 0; k < 2; ++k) dst[n][k] = *(const LAS bf16x8*)(lds + PG8_SB(b, h) + boff + n * 2048 + k * 1024); } while (0)
#define PG8_MMA(ai, bj, At, Bt) do { __builtin_amdgcn_s_setprio(1); _Pragma("unroll") for (int m = 0; m < 4; ++m) _Pragma("unroll") for (int n = 0; n < 2; ++n) _Pragma("unroll") for (int k = 0; k < 2; ++k) \
        acc[ai][bj][m][n] = __builtin_amdgcn_mfma_f32_16x16x32_bf16(Bt[n][k], At[m][k], acc[ai][bj][m][n], 0, 0, 0); __builtin_amdgcn_s_setprio(0); } while (0)
#define PG8_WAIT_V(n) asm volatile("s_waitcnt vmcnt(" #n ")" ::: "memory")
#define PG8_WAIT_L(n) asm volatile("s_waitcnt lgkmcnt(" #n ")" ::: "memory")
#define PG8_BAR __builtin_amdgcn_s_barrier()
#define PG8_SCHED __builtin_amdgcn_sched_barrier(0)
    Unit cur, nxt; int ui = 0;
    if (!S.next(0, cur)) return;
    f32x4 acc[2][2][4][2];
#pragma unroll
    for (int a = 0; a < 2; ++a)
#pragma unroll
        for (int b = 0; b < 2; ++b)
#pragma unroll
            for (int m = 0; m < 4; ++m)
#pragma unroll
                for (int n = 0; n < 2; ++n) acc[a][b][m][n] = (f32x4){0.f, 0.f, 0.f, 0.f};
    bf16x8 At[4][2], B0[2][2], B1[2][2];
    const char* cA = (const char*)g.A + (size_t)cur.pm * tstepA; const char* cB = (const char*)g.Bt + (size_t)cur.pn * tstep;
    PG8_STAGE(PG8_SB(0, 0), cB, voffB); PG8_STAGE(PG8_SA(0, 0), cA, voffA); PG8_STAGE(PG8_SB(0, 1), cB + hstep, voffB); PG8_STAGE(PG8_SA(0, 1), cA + hstepA, voffA);
    if (wr == 1) PG8_BAR;
    PG8_WAIT_V(4); PG8_BAR;
    PG8_STAGE(PG8_SB(1, 0), cB + kstep, voffB); PG8_STAGE(PG8_SA(1, 0), cA + kstep, voffA); PG8_STAGE(PG8_SB(1, 1), cB + hstep + kstep, voffB);
    PG8_WAIT_V(6); PG8_BAR;
    for (;;) {
        const bool has_next = S.next(ui + 1, nxt);
        const char* nA = has_next ? (const char*)g.A + (size_t)nxt.pm * tstepA : cA; const char* nB = has_next ? (const char*)g.Bt + (size_t)nxt.pn * tstep : cB;
        for (int t = 0; t < nt; t += 2) {
            const bool last = (t == nt - 2);
            const char* a1 = cA + (size_t)(t + 1) * kstep + ((t + 1) >= ks ? a2off : 0);
            const char* a2 = last ? nA : cA + (size_t)(t + 2) * kstep + ((t + 2) >= ks ? a2off : 0); const char* b2 = last ? nB : cB + (size_t)(t + 2) * kstep;
            const char* a3 = last ? nA + kstep : cA + (size_t)(t + 3) * kstep + ((t + 3) >= ks ? a2off : 0); const char* b3 = b2 + kstep;
            PG8_LDB(B0, 0, 0); PG8_SCHED; PG8_LDA(At, 0, 0); PG8_STAGE(PG8_SA(1, 1), a1 + hstepA, voffA);
            PG8_WAIT_L(8); PG8_BAR; PG8_WAIT_L(0); PG8_MMA(0, 0, At, B0); PG8_BAR; PG8_SCHED;
            PG8_LDB(B1, 0, 1); PG8_STAGE(PG8_SB(0, 0), b2, voffB);
            PG8_BAR; PG8_WAIT_L(0); PG8_MMA(0, 1, At, B1); PG8_BAR;
            PG8_LDA(At, 0, 1); PG8_STAGE(PG8_SA(0, 0), a2, voffA);
            PG8_BAR; PG8_WAIT_L(0); PG8_MMA(1, 0, At, B0); PG8_BAR; PG8_SCHED;
            PG8_STAGE(PG8_SB(0, 1), b2 + hstep, voffB);
            PG8_WAIT_V(6); PG8_BAR; PG8_MMA(1, 1, At, B1); PG8_BAR;
            PG8_LDB(B0, 1, 0); PG8_SCHED; PG8_LDA(At, 1, 0); PG8_STAGE(PG8_SA(0, 1), a2 + hstepA, voffA);
            PG8_WAIT_L(8); PG8_BAR; PG8_WAIT_L(0); PG8_MMA(0, 0, At, B0); PG8_BAR; PG8_SCHED;
            PG8_LDB(B1, 1, 1); PG8_STAGE(PG8_SB(1, 0), b3, voffB);
            PG8_BAR; PG8_WAIT_L(0); PG8_MMA(0, 1, At, B1); PG8_BAR;
            PG8_LDA(At, 1, 1); PG8_STAGE(PG8_SA(1, 0), a3, voffA);
            PG8_BAR; PG8_WAIT_L(0); PG8_MMA(1, 0, At, B0); PG8_BAR; PG8_SCHED;
            PG8_STAGE(PG8_SB(1, 1), b3 + hstep, voffB);
            PG8_WAIT_V(6); PG8_BAR; PG8_MMA(1, 1, At, B1); PG8_BAR;
        }
        E(acc, cur, wr, wc, fr, fq);
        if (!has_next) break;
#pragma unroll
        for (int a = 0; a < 2; ++a)
#pragma unroll
            for (int b = 0; b < 2; ++b)
#pragma unroll
                for (int m = 0; m < 4; ++m)
#pragma unroll
                    for (int n = 0; n < 2; ++n) acc[a][b][m][n] = (f32x4){0.f, 0.f, 0.f, 0.f};
        cur = nxt; cA = nA; cB = nB; ++ui;
    }
    PG8_WAIT_V(0);
    if (wr == 0) PG8_BAR;
    PG8_BAR;
#undef PG8_SA
#undef PG8_SB
#undef PG8_STAGE
#undef PG8_LDA
#undef PG8_LDB
#undef PG8_MMA
#undef PG8_WAIT_V
#undef PG8_WAIT_L
#undef PG8_BAR
#undef PG8_SCHED
}
}
using pg8::Unit;

struct Epi1 {
    static constexpr bool PERM = true;
    bf16_t* QKV; bf16_t* SZA; bf16_t* UU; bf16_t* SZB; float* BA; bf16_t* HALO;
    __device__ __forceinline__ void operator()(const f32x4 (&acc)[2][2][4][2], const Unit& u, int wr, int wc, int fr_, int fq_) const {
        int lane = (int)(threadIdx.x & 63); asm volatile("" : "+v"(lane));
        const int fr = lane & 15, fq = lane >> 4; (void)fr_; (void)fq_;
        const int row0 = u.pm * 256 + wr * 64 + fr, pn = u.pn;
#pragma unroll
        for (int ai = 0; ai < 2; ++ai)
#pragma unroll
            for (int m = 0; m < 4; ++m) {
                const size_t row = (size_t)(row0 + ai * 128 + m * 16);
#pragma unroll
                for (int bj = 0; bj < 2; ++bj) {
                    const int colt = 128 * bj + 32 * wc + 8 * fq;
                    f32x4 v0 = acc[ai][bj][m][0], v1 = acc[ai][bj][m][1];
                    if (pn < 12) {
                        const int c = pn * 256 + colt; const u32x4 pk = pack8(v0, v1);
                        *(u32x4*)(QKV + row * 3072 + c) = pk;
                        if (m == 3 && fr >= 13) *(u32x4*)(HALO + ((row >> 6) * 3 + (fr - 13)) * 3072 + c) = pk;
                    } else if (pn < 16) {
#pragma unroll
                        for (int e = 0; e < 4; ++e) { v0[e] = siluf_(v0[e]); v1[e] = siluf_(v1[e]); }
                        *(u32x4*)(SZA + row * 1024 + (pn - 12) * 256 + colt) = pack8(v0, v1);
                    } else if (pn < 20) {
                        *(u32x4*)(UU + row * 1024 + (pn - 16) * 256 + colt) = pack8(v0, v1);
                    } else if (pn < 24) {
#pragma unroll
                        for (int e = 0; e < 4; ++e) { v0[e] = siluf_(v0[e]); v1[e] = siluf_(v1[e]); }
                        *(u32x4*)(SZB + row * 1024 + (pn - 20) * 256 + colt) = pack8(v0, v1);
                    } else if (colt < 16) {
                        *(f32x4*)(BA + row * 16 + colt) = v0; *(f32x4*)(BA + row * 16 + colt + 4) = v1;
                    }
                }
            }
    }
};
struct EpiGlu {
    static constexpr bool PERM = true;
    const bf16_t* Y5; bf16_t* SZB;
    __device__ __forceinline__ void operator()(const f32x4 (&acc)[2][2][4][2], const Unit& u, int wr, int wc, int fr, int fq) const {
        const int row0 = u.pm * 256 + wr * 64 + fr;
#pragma unroll
        for (int ai = 0; ai < 2; ++ai)
#pragma unroll
            for (int m = 0; m < 4; ++m) {
                const size_t row = (size_t)(row0 + ai * 128 + m * 16);
#pragma unroll
                for (int bj = 0; bj < 2; ++bj) {
                    const int c = u.pn * 256 + 128 * bj + 32 * wc + 8 * fq;
                    const u32x4 y = *(const u32x4*)(Y5 + row * 1024 + c), z = *(const u32x4*)(SZB + row * 1024 + c);
                    const f32x4 a0 = acc[ai][bj][m][0], a1 = acc[ai][bj][m][1];
                    u32x4 o;
                    o.x = pk2(lo2f(y.x) * sigmoidf_(a0[0]) * lo2f(z.x), hi2f(y.x) * sigmoidf_(a0[1]) * hi2f(z.x));
                    o.y = pk2(lo2f(y.y) * sigmoidf_(a0[2]) * lo2f(z.y), hi2f(y.y) * sigmoidf_(a0[3]) * hi2f(z.y));
                    o.z = pk2(lo2f(y.z) * sigmoidf_(a1[0]) * lo2f(z.z), hi2f(y.z) * sigmoidf_(a1[1]) * hi2f(z.z));
                    o.w = pk2(lo2f(y.w) * sigmoidf_(a1[2]) * lo2f(z.w), hi2f(y.w) * sigmoidf_(a1[3]) * hi2f(z.w));
                    *(u32x4*)(SZB + row * 1024 + c) = o;
                }
            }
    }
};
struct EpiF32 {
    static constexpr bool PERM = false;
    float* C;
    __device__ __forceinline__ void operator()(const f32x4 (&acc)[2][2][4][2], const Unit& u, int wr, int wc, int fr, int fq) const {
        const int row0 = u.pm * 256 + wr * 64 + fr, col0 = u.pn * 256 + wc * 32 + 4 * fq;
#pragma unroll
        for (int ai = 0; ai < 2; ++ai)
#pragma unroll
            for (int m = 0; m < 4; ++m) { float* rowp = C + (size_t)(row0 + ai * 128 + m * 16) * 1024 + col0;
#pragma unroll
                for (int bj = 0; bj < 2; ++bj)
#pragma unroll
                    for (int n = 0; n < 2; ++n) *(f32x4*)(rowp + bj * 128 + n * 16) = acc[ai][bj][m][n]; }
    }
};
struct EpiB16 {
    static constexpr bool PERM = true;
    bf16_t* C;
    __device__ __forceinline__ void operator()(const f32x4 (&acc)[2][2][4][2], const Unit& u, int wr, int wc, int fr, int fq) const {
        const int row0 = u.pm * 256 + wr * 64 + fr, col0 = u.pn * 256 + wc * 32 + 8 * fq;
#pragma unroll
        for (int ai = 0; ai < 2; ++ai)
#pragma unroll
            for (int m = 0; m < 4; ++m) { bf16_t* rowp = C + (size_t)(row0 + ai * 128 + m * 16) * 1024 + col0;
#pragma unroll
                for (int bj = 0; bj < 2; ++bj) *(u32x4*)(rowp + bj * 128) = pack8(acc[ai][bj][m][0], acc[ai][bj][m][1]); }
    }
};
struct Epi2 {
    static constexpr bool PERM = false;
    bf16_t* P; bf16_t* Q;
    __device__ __forceinline__ void operator()(const f32x4 (&acc)[2][2][4][2], const Unit& u, int wr, int wc, int fr, int fq) const {
        const int row0 = u.pm * 256 + wr * 64 + fr, ch = u.pn * 64 + 16 * wc + 4 * fq;
#pragma unroll
        for (int ai = 0; ai < 2; ++ai)
#pragma unroll
            for (int m = 0; m < 4; ++m) {
                const size_t row = (size_t)(row0 + ai * 128 + m * 16);
                const f32x4 gb = acc[ai][0][m][0], gc = acc[ai][0][m][1], hv = acc[ai][1][m][0], z = acc[ai][1][m][1];
                u32x2 pp, qq;
                pp.x = pk2(gc[0] * hv[0], gc[1] * hv[1]); pp.y = pk2(gc[2] * hv[2], gc[3] * hv[3]);
                qq.x = pk2(gb[0] * siluf_(z[0]), gb[1] * siluf_(z[1])); qq.y = pk2(gb[2] * siluf_(z[2]), gb[3] * siluf_(z[3]));
                *(u32x2*)(P + row * 2048 + ch) = pp; *(u32x2*)(Q + row * 2048 + ch) = qq;
            }
    }
};

__device__ __forceinline__ int src_col(int mode, int n, int& pn_unused) {
    (void)pn_unused;
    if (mode == 0) return n;
    if (mode == 1) { if (n < 4096) return n; if (n < 6144) return n + 16; if (n < 6160) return n - 2048; return -1; }
    const int pn = n >> 8, col = n & 255, bj = col >> 7, wc = (col >> 5) & 3, nn = (col >> 4) & 1, lo = col & 15;
    return (2 * bj + nn) * 2048 + pn * 64 + 16 * wc + lo;
}
__device__ __forceinline__ void phase_convert(const Prm& p, unsigned char* lds, int t_begin, int t_end, int nblk, int bidx) {
    float* tile = (float*)lds;
    const int tid = threadIdx.x;
    for (int tix = t_begin + bidx; tix < t_end; tix += nblk) {
        int tl = tix, K, Nsrc, mode; const float* W; bf16_t* Wt;
        if (tl < 1600) { W = p.in[3]; Wt = (bf16_t*)(p.ws + OFF_WT1); K = 1024; Nsrc = 6160; mode = 1; }
        else if ((tl -= 1600) < 256) { W = p.in[16]; Wt = (bf16_t*)(p.ws + OFF_WTG); K = 1024; Nsrc = 1024; mode = 0; }
        else if ((tl -= 256) < 512) { W = p.in[17]; Wt = (bf16_t*)(p.ws + OFF_WTO0); K = 2048; Nsrc = 1024; mode = 0; }
        else if ((tl -= 512) < 2048) { W = p.in[18]; Wt = (bf16_t*)(p.ws + OFF_WT2); K = 1024; Nsrc = 8192; mode = 2; }
        else { tl -= 2048; W = p.in[20]; Wt = (bf16_t*)(p.ws + OFF_WTO1); K = 2048; Nsrc = 1024; mode = 0; }
        const int ntk = K / 64, n0 = (tl / ntk) * 64, k0 = (tl % ntk) * 64;
        { const int j = tid & 63; int dummy = 0; const int sc = src_col(mode, n0 + j, dummy);
#pragma unroll
          for (int i = 0; i < 8; ++i) { const int k = (tid >> 6) + 8 * i; tile[k * 65 + j] = sc >= 0 ? W[(size_t)(k0 + k) * Nsrc + sc] : 0.0f; } }
        __syncthreads();
        { const int r = tid >> 3, c8 = (tid & 7) * 8; u32x4 o;
          o.x = pk2(tile[(c8 + 0) * 65 + r], tile[(c8 + 1) * 65 + r]); o.y = pk2(tile[(c8 + 2) * 65 + r], tile[(c8 + 3) * 65 + r]);
          o.z = pk2(tile[(c8 + 4) * 65 + r], tile[(c8 + 5) * 65 + r]); o.w = pk2(tile[(c8 + 6) * 65 + r], tile[(c8 + 7) * 65 + r]);
          *(u32x4*)(Wt + (size_t)(n0 + r) * K + k0 + c8) = o; }
        __syncthreads();
    }
}
__device__ __forceinline__ void phase_rmsnorm_x(const float* x, const float* w, bf16_t* H) {
    const int lane = threadIdx.x & 63, nw = gridDim.x * 8;
    for (int row = blockIdx.x * 8 + (threadIdx.x >> 6); row < TOK; row += nw) {
        const f32x4* xr = (const f32x4*)(x + (size_t)row * 1024);
        f32x4 v[4]; float ss = 0.f;
#pragma unroll
        for (int i = 0; i < 4; ++i) { v[i] = xr[lane + 64 * i]; ss += v[i][0] * v[i][0] + v[i][1] * v[i][1] + v[i][2] * v[i][2] + v[i][3] * v[i][3]; }
        ss = wave_sum(ss);
        const float rstd = rsqrtf(ss * (1.0f / 1024.0f) + 1e-6f);
#pragma unroll
        for (int i = 0; i < 4; ++i) { const f32x4 w4 = ((const f32x4*)w)[lane + 64 * i]; u32x2 o;
            o.x = pk2(v[i][0] * rstd * w4[0], v[i][1] * rstd * w4[1]); o.y = pk2(v[i][2] * rstd * w4[2], v[i][3] * rstd * w4[3]);
            *(u32x2*)(H + (size_t)row * 1024 + (lane + 64 * i) * 4) = o; }
    }
}
template <bool NEXT>
__device__ __forceinline__ void phase_post(const float* base, const bf16_t* Y, const float* wpost, float* OUT, const float* wpre, bf16_t* H) {
    const int lane = threadIdx.x & 63, nw = gridDim.x * 8;
    for (int row = blockIdx.x * 8 + (threadIdx.x >> 6); row < TOK; row += nw) {
        const u32x2* yr = (const u32x2*)(Y + (size_t)row * 1024); const f32x4* br = (const f32x4*)(base + (size_t)row * 1024);
        f32x4 v[4], xb[4]; float ss = 0.f;
#pragma unroll
        for (int i = 0; i < 4; ++i) { const u32x2 y2 = yr[lane + 64 * i]; v[i] = (f32x4){lo2f(y2.x), hi2f(y2.x), lo2f(y2.y), hi2f(y2.y)}; xb[i] = br[lane + 64 * i]; ss += v[i][0] * v[i][0] + v[i][1] * v[i][1] + v[i][2] * v[i][2] + v[i][3] * v[i][3]; }
        ss = wave_sum(ss);
        const float rstd = rsqrtf(ss * (1.0f / 1024.0f) + 1e-6f);
        float s2 = 0.f;
#pragma unroll
        for (int i = 0; i < 4; ++i) { const f32x4 w4 = ((const f32x4*)wpost)[lane + 64 * i];
#pragma unroll
            for (int e = 0; e < 4; ++e) { v[i][e] = xb[i][e] + v[i][e] * rstd * w4[e]; s2 += v[i][e] * v[i][e]; }
            ((f32x4*)(OUT + (size_t)row * 1024))[lane + 64 * i] = v[i]; }
        if (NEXT) {
            s2 = wave_sum(s2);
            const float r2 = rsqrtf(s2 * (1.0f / 1024.0f) + 1e-6f);
#pragma unroll
            for (int i = 0; i < 4; ++i) { const f32x4 w4 = ((const f32x4*)wpre)[lane + 64 * i]; u32x2 o;
                o.x = pk2(v[i][0] * r2 * w4[0], v[i][1] * r2 * w4[1]); o.y = pk2(v[i][2] * r2 * w4[2], v[i][3] * r2 * w4[3]);
                *(u32x2*)(H + (size_t)row * 1024 + (lane + 64 * i) * 4) = o; }
        }
    }
}


__device__ __forceinline__ void phase_ba(const Prm& p, unsigned char* lds) {
    const int tid = threadIdx.x, wv = tid >> 6, lane = tid & 63, n = lane & 15, kq = lane >> 4, mt = wv & 3, kh = wv >> 2;
    const bf16_t* H = (const bf16_t*)(p.ws + OFF_H); const bf16_t* Wb = (const bf16_t*)(p.ws + OFF_WT1) + (size_t)6144 * 1024; float* BA = (float*)(p.ws + OFF_BA);
    const size_t row0 = (size_t)blockIdx.x * 64 + 16 * mt;
    const bf16_t* ap = H + (row0 + n) * 1024 + 512 * kh + 8 * kq; const bf16_t* bp = Wb + (size_t)n * 1024 + 512 * kh + 8 * kq;
    bf16x8 a[16], b[16];
#pragma unroll
    for (int i = 0; i < 16; ++i) { a[i] = *(const bf16x8*)(ap + i * 32); b[i] = *(const bf16x8*)(bp + i * 32); }
    f32x4 acc = (f32x4){0.f, 0.f, 0.f, 0.f};
#pragma unroll
    for (int i = 0; i < 16; ++i) acc = __builtin_amdgcn_mfma_f32_16x16x32_bf16(a[i], b[i], acc, 0, 0, 0);
    float* part = (float*)lds;
#pragma unroll
    for (int j = 0; j < 4; ++j) part[(kh * 64 + 16 * mt + 4 * kq + j) * 16 + n] = acc[j];
    __syncthreads();
    for (int i = tid; i < 1024; i += 512) BA[(size_t)blockIdx.x * 1024 + i] = part[i] + part[1024 + i];
    __syncthreads();
}
__device__ __forceinline__ void sincos_d(double x, double& s, double& c) {
    const double k = rint(x * 0.6366197723675814);
    const double r = fma(-k, 6.123233995736766e-17, fma(-k, 1.5707963267948966, x)), r2 = r * r;
    double sp = -7.647163731819816e-13; sp = fma(sp, r2, 1.6059043836821613e-10); sp = fma(sp, r2, -2.505210838544172e-8); sp = fma(sp, r2, 2.7557319223985893e-6);
    sp = fma(sp, r2, -1.984126984126984e-4); sp = fma(sp, r2, 8.333333333333333e-3); sp = fma(sp, r2, -1.6666666666666666e-1); sp = fma(sp * r2, r, r);
    double cp = 4.779477332387385e-14; cp = fma(cp, r2, -1.1470745597729725e-11); cp = fma(cp, r2, 2.08767569878681e-9); cp = fma(cp, r2, -2.755731922398589e-7);
    cp = fma(cp, r2, 2.48015873015873e-5); cp = fma(cp, r2, -1.388888888888889e-3); cp = fma(cp, r2, 4.1666666666666664e-2); cp = fma(cp, r2, -0.5); cp = fma(cp, r2, 1.0);
    const int q = ((int)k) & 3;
    const double s0 = (q & 1) ? cp : sp, c0 = (q & 1) ? sp : cp;
    s = (q & 2) ? -s0 : s0; c = ((q + 1) & 2) ? -c0 : c0;
}
__device__ __forceinline__ double exp_d(double x) {
    const double n = rint(x * 1.4426950408889634);
    const double r = fma(-n, 2.3190468138462996e-17, fma(-n, 0.6931471805599453, x));
    double p = 1.6059043836821613e-10; p = fma(p, r, 2.08767569878681e-9); p = fma(p, r, 2.505210838544172e-8); p = fma(p, r, 2.755731922398589e-7); p = fma(p, r, 2.7557319223985893e-6);
    p = fma(p, r, 2.48015873015873e-5); p = fma(p, r, 1.984126984126984e-4); p = fma(p, r, 1.388888888888889e-3); p = fma(p, r, 8.333333333333333e-3); p = fma(p, r, 4.1666666666666664e-2);
    p = fma(p, r, 1.6666666666666666e-1); p = fma(p, r, 0.5); p = fma(p, r, 1.0); p = fma(p, r, 1.0);
    return ldexp(p, (int)n);
}
__device__ __forceinline__ float bcast_lo(float v) { auto r = __builtin_amdgcn_permlane32_swap(__float_as_uint(v), __float_as_uint(v), false, false); return __uint_as_float(r[0]); }
__device__ __forceinline__ float bcast_hi(float v) { auto r = __builtin_amdgcn_permlane32_swap(__float_as_uint(v), __float_as_uint(v), false, false); return __uint_as_float(r[1]); }

struct S5C {
    float ar[2][4], ai[2][4];
    float a512r[2], a512i[2];
    bf16x8 BB[4];
    bf16x8 CC[4];
    float dco;
};

template <bool OUT>
__device__ __forceinline__ void s5_chunk(const S5C& C, bf16_t* UU, int b, int g, int chunk, float (&st)[2][2], bf16_t* sX, int lane) {
    const int n = lane & 31, hh = lane >> 5, fr = lane & 15, fq = lane >> 4;
    const size_t tok0 = (size_t)b * SEQ + (size_t)chunk * 512;
    bf16x8 ua = *(const bf16x8*)(UU + (tok0 + n) * 1024 + 16 * g + 8 * hh);
    bf16_t uo[8];
    if (OUT) {
#pragma unroll
        for (int mt = 0; mt < 2; ++mt)
#pragma unroll
            for (int j = 0; j < 4; ++j) uo[mt * 4 + j] = UU[(tok0 + 16 * mt + 4 * fq + j) * 1024 + 16 * g + fr];
    }
    for (int blk = 0; blk < 16; ++blk) {
        const size_t t0 = tok0 + (size_t)blk * 32;
        const bf16x8 ucur = ua;
        bf16_t ucuro[8];
        if (OUT) {
#pragma unroll
            for (int i = 0; i < 8; ++i) ucuro[i] = uo[i];
        }
        if (blk < 15) {
            ua = *(const bf16x8*)(UU + (t0 + 32 + n) * 1024 + 16 * g + 8 * hh);
            if (OUT) {
#pragma unroll
                for (int mt = 0; mt < 2; ++mt)
#pragma unroll
                    for (int j = 0; j < 4; ++j) uo[mt * 4 + j] = UU[(t0 + 32 + 16 * mt + 4 * fq + j) * 1024 + 16 * g + fr];
            }
        }
        f32x16 acc[4];
#pragma unroll
        for (int tl = 0; tl < 4; ++tl) {
            f32x16 z;
#pragma unroll
            for (int i = 0; i < 16; ++i) z[i] = 0.f;
            acc[tl] = __builtin_amdgcn_mfma_f32_32x32x16_bf16(ucur, C.BB[tl], z, 0, 0, 0);
        }
#pragma unroll
        for (int tp = 0; tp < 2; ++tp) {
            f32x16& re = acc[2 * tp]; f32x16& im = acc[2 * tp + 1];
            const float a1r = C.ar[tp][0], a1i = C.ai[tp][0];
#pragma unroll
            for (int q = 0; q < 4; ++q)
#pragma unroll
                for (int r = 1; r < 4; ++r) {
                    const float pr = re[4 * q + r - 1], pi = im[4 * q + r - 1];
                    re[4 * q + r] += a1r * pr - a1i * pi; im[4 * q + r] += a1r * pi + a1i * pr;
                }
            float cr = st[tp][0], ci = st[tp][1];
            const float a4r = C.ar[tp][3], a4i = C.ai[tp][3];
#pragma unroll
            for (int q = 0; q < 4; ++q) {
                const float tr = re[4 * q + 3] + a4r * cr - a4i * ci, ti = im[4 * q + 3] + a4r * ci + a4i * cr;
                const float o0r = bcast_lo(tr), o0i = bcast_lo(ti);
                const float xr = hh ? o0r : cr, xi = hh ? o0i : ci;
                if (OUT) {
#pragma unroll
                    for (int r = 0; r < 4; ++r) { const float kr = C.ar[tp][r], ki = C.ai[tp][r];
                        re[4 * q + r] += kr * xr - ki * xi; im[4 * q + r] += kr * xi + ki * xr; }
                } else {
                    re[4 * q + 3] += a4r * xr - a4i * xi; im[4 * q + 3] += a4r * xi + a4i * xr;
                }
                cr = bcast_hi(re[4 * q + 3]); ci = bcast_hi(im[4 * q + 3]);
            }
            st[tp][0] = cr; st[tp][1] = ci;
        }
        if (OUT) {
            asm volatile("s_waitcnt lgkmcnt(0)" ::: "memory");
#pragma unroll
            for (int tp = 0; tp < 2; ++tp)
#pragma unroll
                for (int i = 0; i < 16; ++i) {
                    const int t = 8 * (i >> 2) + 4 * hh + (i & 3);
                    *(unsigned*)(sX + t * 136 + 2 * (n + 32 * tp)) = pk2(acc[2 * tp][i], acc[2 * tp + 1][i]);
                }
            asm volatile("s_waitcnt lgkmcnt(0)" ::: "memory");
            __builtin_amdgcn_wave_barrier();
#pragma unroll
            for (int mt = 0; mt < 2; ++mt) {
                f32x4 y = (f32x4){0.f, 0.f, 0.f, 0.f};
#pragma unroll
                for (int ks = 0; ks < 4; ++ks) {
                    const bf16x8 xa = *(const bf16x8*)(sX + (16 * mt + fr) * 136 + 32 * ks + 8 * fq);
                    y = __builtin_amdgcn_mfma_f32_16x16x32_bf16(xa, C.CC[ks], y, 0, 0, 0);
                }
#pragma unroll
                for (int j = 0; j < 4; ++j) {
                    float v = y[j] + C.dco * bf2f(ucuro[mt * 4 + j]);
                    const float inner = 0.7978845608028654f * (v + 0.044715f * v * v * v);
                    v = v / (1.0f + __expf(-2.0f * inner));
                    UU[(t0 + 16 * mt + 4 * fq + j) * 1024 + 16 * g + fr] = f2bf(v);
                }
            }
            asm volatile("s_waitcnt lgkmcnt(0)" ::: "memory");
            __builtin_amdgcn_wave_barrier();
        }
    }
}

__device__ __forceinline__ void phase_s5(const Prm& p, unsigned char* lds, int bg) {
    const int b = bg >> 6, g = bg & 63;
    const int tid = threadIdx.x, wv = tid >> 6, lane = tid & 63, n = lane & 31, hh = lane >> 5, fr = lane & 15, fq = lane >> 4;
    bf16_t* sX = (bf16_t*)(lds + wv * 8704);
    float* sXE = (float*)(lds + 8 * 8704);
    bf16_t* UU = (bf16_t*)(p.ws + OFF_UU);
    const float* lam_re = p.in[8]; const float* lam_im = p.in[9]; const float* b_re = p.in[10]; const float* b_im = p.in[11];
    const float* c_re = p.in[12]; const float* c_im = p.in[13];
    S5C C;
    const double dt = exp_d((double)p.in[14][g]);
    float fre[2], fim[2];
#pragma unroll
    for (int tp = 0; tp < 2; ++tp) {
        const int pp = n + 32 * tp;
        const double lr = (double)fminf(lam_re[g * 64 + pp], -1e-4f), li = (double)lam_im[g * 64 + pp];
#pragma unroll
        for (int k = 0; k < 4; ++k) { double sn, cs; sincos_d(li * dt * (k + 1), sn, cs); const double mag = exp_d(lr * dt * (k + 1)); C.ar[tp][k] = (float)(mag * cs); C.ai[tp][k] = (float)(mag * sn); }
        { double sn, cs; sincos_d(li * dt * 512.0, sn, cs); const double mag = exp_d(lr * dt * 512.0); C.a512r[tp] = (float)(mag * cs); C.a512i[tp] = (float)(mag * sn); }
        double sn, cs; sincos_d(li * dt, sn, cs);
        const double mag = exp_d(lr * dt), abr = mag * cs, abi = mag * sn;
        const double den = lr * lr + li * li, nr = abr - 1.0, ni = abi;
        fre[tp] = (float)((nr * lr + ni * li) / den); fim[tp] = (float)((ni * lr - nr * li) / den);
    }
#pragma unroll
    for (int tl = 0; tl < 4; ++tl) {
        const int tp = tl >> 1, ri = tl & 1, pp = n + 32 * tp;
#pragma unroll
        for (int j = 0; j < 8; ++j) {
            const int ch = 8 * hh + j;
            const float br = b_re[(g * 64 + pp) * 16 + ch], bi = b_im[(g * 64 + pp) * 16 + ch];
            const float v = ri == 0 ? fre[tp] * br - fim[tp] * bi : fre[tp] * bi + fim[tp] * br;
            C.BB[tl][j] = (short)f2bf(v);
        }
    }
#pragma unroll
    for (int ks = 0; ks < 4; ++ks)
#pragma unroll
        for (int j = 0; j < 8; ++j) {
            const int k = 32 * ks + 8 * fq + j, pp = k >> 1, ri = k & 1;
            const float v = ri == 0 ? c_re[(g * 16 + fr) * 64 + pp] : -c_im[(g * 16 + fr) * 64 + pp];
            C.CC[ks][j] = (short)f2bf(v);
        }
    C.dco = p.in[15][16 * g + fr];
    for (int rd = 0; rd < 2; ++rd) {
        const int chunk = wv + 8 * rd;
        float st[2][2] = {{0.f, 0.f}, {0.f, 0.f}};
        s5_chunk<false>(C, UU, b, g, chunk, st, sX, lane);
        if (hh == 0) {
#pragma unroll
            for (int tp = 0; tp < 2; ++tp) { sXE[(chunk * 64 + n + 32 * tp) * 2 + 0] = st[tp][0]; sXE[(chunk * 64 + n + 32 * tp) * 2 + 1] = st[tp][1]; }
        }
    }
    __syncthreads();
    for (int rd = 0; rd < 2; ++rd) {
        const int chunk = wv + 8 * rd;
        float st[2][2] = {{0.f, 0.f}, {0.f, 0.f}};
        for (int c2 = 0; c2 < chunk; ++c2) {
#pragma unroll
            for (int tp = 0; tp < 2; ++tp) {
                const float er = sXE[(c2 * 64 + n + 32 * tp) * 2 + 0], ei = sXE[(c2 * 64 + n + 32 * tp) * 2 + 1];
                const float nr = C.a512r[tp] * st[tp][0] - C.a512i[tp] * st[tp][1] + er, ni = C.a512r[tp] * st[tp][1] + C.a512i[tp] * st[tp][0] + ei;
                st[tp][0] = nr; st[tp][1] = ni;
            }
        }
        s5_chunk<true>(C, UU, b, g, chunk, st, sX, lane);
        if (rd == 0) {
            asm volatile("s_waitcnt vmcnt(0)" ::: "memory");
            __syncthreads();
            if (threadIdx.x == 0) { __builtin_amdgcn_fence(__ATOMIC_RELEASE, "agent"); asm volatile("s_waitcnt vmcnt(0)" ::: "memory");
                __hip_atomic_fetch_add((unsigned*)(p.ws + OFF_BAR) + 3900, 1u, __ATOMIC_RELAXED, __HIP_MEMORY_SCOPE_AGENT); }
        }
    }
    __syncthreads();
}

__device__ __forceinline__ void phase_gdn_prep(const Prm& p, unsigned char* lds, int it0, int nrounds) {
    const int tid0 = threadIdx.x, hb = tid0 >> 8;
    unsigned char* base = lds + hb * 76800;
    bf16_t* sQ = (bf16_t*)base;
    bf16_t* sK = (bf16_t*)(base + 17408);
    bf16_t* sV = (bf16_t*)(base + 2 * 17408);
    float* sL = (float*)(base + 3 * 17408);
    float* sBeta = (float*)(base + 4 * 17408);
    float* sGc = sBeta + 64; float* sEg = sGc + 64; float* sBE = sEg + 64;
    float* sCW = sBE + 64;
    bf16_t* QKV = (bf16_t*)(p.ws + OFF_QKV); const bf16_t* HALO = (const bf16_t*)(p.ws + OFF_HALO);
    const float* BA = (const float*)(p.ws + OFF_BA); float* GL = (float*)(p.ws + OFF_GL);
    bf16_t* WB = (bf16_t*)(p.ws + OFF_WB); bf16_t* ATT = (bf16_t*)(p.ws + OFF_ATT);
    const float* convw = p.in[4];
    for (int rd = 0; rd < nrounds; ++rd) {
        int tid = tid0; asm volatile("" : "+v"(tid));
        const int ht = tid & 255, hw = (tid >> 6) & 3, lane = tid & 63, fr = lane & 15, fq = lane >> 4;
        const int it = it0 + rd * 2 + hb;
        const int b = it >> 10, h = (it >> 7) & 7, nc = it & 127;
        const size_t tokb = (size_t)b * SEQ + (size_t)nc * 64;
#pragma unroll
        for (int i = 0; i < 6; ++i) { const int idx = ht + 256 * i, s3 = idx >> 9, tap = (idx >> 7) & 3, ch = idx & 127; sCW[idx] = convw[tap * 3072 + s3 * 1024 + h * 128 + ch]; }
        __syncthreads();
        {
            const int t0 = (ht >> 4) * 4, cgp = ht & 15;
            u32x4 xall[3][7];
#pragma unroll
            for (int s = 0; s < 3; ++s) {
                const int col = s * 1024 + h * 128 + cgp * 8;
#pragma unroll
                for (int i = 0; i < 7; ++i) {
                    const int tt = t0 - 3 + i;
                    xall[s][i] = (u32x4){0u, 0u, 0u, 0u};
                    if (tt >= 0) xall[s][i] = *(const u32x4*)(QKV + (tokb + tt) * 3072 + col);
                    else if (nc > 0) xall[s][i] = *(const u32x4*)(HALO + ((size_t)(b * 128 + nc - 1) * 3 + (3 + tt)) * 3072 + col);
                }
            }
#pragma unroll
            for (int s = 0; s < 3; ++s) {
                u32x4 xr[7];
#pragma unroll
                for (int i = 0; i < 7; ++i) xr[i] = xall[s][i];
                f32x4 w0[4], w1[4];
#pragma unroll
                for (int j = 0; j < 4; ++j) { w0[j] = *(const f32x4*)(sCW + s * 512 + j * 128 + cgp * 8); w1[j] = *(const f32x4*)(sCW + s * 512 + j * 128 + cgp * 8 + 4); }
                float o[4][8], ss[4];
#pragma unroll
                for (int tk = 0; tk < 4; ++tk) {
                    float a[8];
#pragma unroll
                    for (int e = 0; e < 8; ++e) a[e] = 0.f;
#pragma unroll
                    for (int j = 0; j < 4; ++j) {
                        const u32x4 xv = xr[tk + j];
                        a[0] += w0[j][0] * lo2f(xv.x); a[1] += w0[j][1] * hi2f(xv.x); a[2] += w0[j][2] * lo2f(xv.y); a[3] += w0[j][3] * hi2f(xv.y);
                        a[4] += w1[j][0] * lo2f(xv.z); a[5] += w1[j][1] * hi2f(xv.z); a[6] += w1[j][2] * lo2f(xv.w); a[7] += w1[j][3] * hi2f(xv.w);
                    }
                    float acc2 = 0.f;
#pragma unroll
                    for (int e = 0; e < 8; ++e) { const float v = siluf_(a[e]); o[tk][e] = v; acc2 += v * v; }
                    ss[tk] = acc2;
                }
                bf16_t* dst = (s == 0 ? sQ : (s == 1 ? sK : sV)) + t0 * 136 + cgp * 8;
#pragma unroll
                for (int tk = 0; tk < 4; ++tk) {
                    float sc = 1.0f;
                    if (s < 2) { float q = ss[tk]; q += __shfl_xor(q, 1); q += __shfl_xor(q, 2); q += __shfl_xor(q, 4); q += __shfl_xor(q, 8); sc = rsqrtf(q + 1e-6f) * (s == 0 ? 0.08838834764831845f : 1.0f); }
                    u32x4 pk;
                    pk.x = pk2(o[tk][0] * sc, o[tk][1] * sc); pk.y = pk2(o[tk][2] * sc, o[tk][3] * sc); pk.z = pk2(o[tk][4] * sc, o[tk][5] * sc); pk.w = pk2(o[tk][6] * sc, o[tk][7] * sc);
                    *(u32x4*)(dst + tk * 136) = pk;
                }
            }
        }
        if (hw == 0) {
            const size_t tg = tokb + lane;
            const float braw = BA[tg * 16 + h], araw = BA[tg * 16 + 8 + h];
            const float beta = 1.0f / (1.0f + expf(-braw));
            const float xx = araw + p.in[6][h];
            const float sp = xx > 20.f ? xx : log1pf(expf(xx));
            float gg = -expf(p.in[5][h]) * sp;
#pragma unroll
            for (int off = 1; off < 64; off <<= 1) { const float o = __shfl_up(gg, off); if (lane >= off) gg += o; }
            sBeta[lane] = beta; sGc[lane] = gg; sEg[lane] = expf(gg); sBE[lane] = beta * expf(gg);
            if (lane == 63) GL[it] = expf(gg);
        }
        __syncthreads();
        {
            bf16x8 aK[4], aQ[4];
#pragma unroll
            for (int ks = 0; ks < 4; ++ks) { aK[ks] = *(const bf16x8*)(sK + (16 * hw + fr) * 136 + 32 * ks + 8 * fq); aQ[ks] = *(const bf16x8*)(sQ + (16 * hw + fr) * 136 + 32 * ks + 8 * fq); }
#pragma unroll
            for (int nt = 0; nt < 4; ++nt) {
                f32x4 kk = (f32x4){0.f, 0.f, 0.f, 0.f}, qk = (f32x4){0.f, 0.f, 0.f, 0.f};
#pragma unroll
                for (int ks = 0; ks < 4; ++ks) {
                    const bf16x8 bK = *(const bf16x8*)(sK + (16 * nt + fr) * 136 + 32 * ks + 8 * fq);
                    kk = __builtin_amdgcn_mfma_f32_16x16x32_bf16(aK[ks], bK, kk, 0, 0, 0);
                    qk = __builtin_amdgcn_mfma_f32_16x16x32_bf16(aQ[ks], bK, qk, 0, 0, 0);
                }
                const int mcol = 16 * nt + fr; const float gm = sGc[mcol];
#pragma unroll
                for (int j = 0; j < 4; ++j) {
                    const int c = 16 * hw + 4 * fq + j;
                    const float dec = __expf(fminf(sGc[c] - gm, 0.f));
                    sL[c * 68 + mcol] = (mcol < c) ? kk[j] * sBeta[c] * dec : 0.f;
                    ATT[(size_t)it * 4096 + c * 64 + mcol] = f2bf((mcol <= c) ? qk[j] * dec : 0.f);
                }
            }
        }
        __syncthreads();
        {
            f32x2_t xv[32];
#define X_(i) (xv[(i) >> 1][(i) & 1])
            const bool isU = ht < 128; const int jc = ht & 127;
            const bf16_t* src = isU ? sV : sK;
            const float* fac = isU ? sBeta : sBE;
#pragma unroll
            for (int cb = 0; cb < 16; ++cb) {
                f32x2_t a2[4];
#pragma unroll
                for (int r = 0; r < 4; ++r) { a2[r].x = bf2f(src[(4 * cb + r) * 136 + jc]) * fac[4 * cb + r]; a2[r].y = 0.f; }
                const f32x4 d1 = *(const f32x4*)(sL + (4 * cb + 1) * 68 + 4 * cb), d2 = *(const f32x4*)(sL + (4 * cb + 2) * 68 + 4 * cb), d3 = *(const f32x4*)(sL + (4 * cb + 3) * 68 + 4 * cb);
                const int nb = (cb + 1) / 2;
                f32x4 lb[2][4][2];
#define SOLVE_LOAD(mb_, buf_) do { _Pragma("unroll") for (int q = 0; q < 2; ++q) _Pragma("unroll") for (int r = 0; r < 4; ++r) \
                    if (2 * (mb_) + q < cb) lb[buf_][r][q] = *(const f32x4*)(sL + (4 * cb + r) * 68 + 4 * (2 * (mb_) + q)); } while (0)
                if (nb > 0) SOLVE_LOAD(0, 0);
#pragma unroll
                for (int mb = 0; mb < nb; ++mb) {
                    if (mb + 1 < nb) SOLVE_LOAD(mb + 1, (mb + 1) & 1);
                    __builtin_amdgcn_sched_barrier(0);
#pragma unroll
                    for (int q = 0; q < 2; ++q)
#pragma unroll
                        for (int r = 0; r < 4; ++r)
                            if (2 * mb + q < cb) { const f32x4 l = lb[mb & 1][r][q]; const int m2 = 2 * (2 * mb + q);
                                a2[r] -= (f32x2_t){l[0], l[1]} * xv[m2]; a2[r] -= (f32x2_t){l[2], l[3]} * xv[m2 + 1]; }
                    __builtin_amdgcn_sched_barrier(0);
                }
#undef SOLVE_LOAD
                const float a0 = a2[0].x + a2[0].y, a1 = a2[1].x + a2[1].y, a2s = a2[2].x + a2[2].y, a3 = a2[3].x + a2[3].y;
                const float y0 = a0, y1 = a1 - d1[0] * y0, y2 = a2s - d2[0] * y0 - d2[1] * y1, y3 = a3 - d3[0] * y0 - d3[1] * y1 - d3[2] * y2;
                xv[2 * cb] = (f32x2_t){y0, y1}; xv[2 * cb + 1] = (f32x2_t){y2, y3};
            }
            if (isU) {
                const int w8 = jc >> 4, nn = jc & 15;
#pragma unroll
                for (int rq = 0; rq < 4; ++rq)
#pragma unroll
                    for (int pc = 0; pc < 2; ++pc) {
                        const int c0 = 32 * pc + 8 * rq;
                        u32x4 o; o.x = pk2(X_(c0 + 0), X_(c0 + 1)); o.y = pk2(X_(c0 + 2), X_(c0 + 3)); o.z = pk2(X_(c0 + 4), X_(c0 + 5)); o.w = pk2(X_(c0 + 6), X_(c0 + 7));
                        const int L = ((w8 * 2 + pc) * 64 + rq * 16 + nn) * 8;
                        *(u32x4*)(QKV + (tokb + (L >> 7)) * 3072 + 2048 + h * 128 + (L & 127)) = o;
                    }
            }
            __syncthreads();
            if (!isU) {
                bf16_t* sW2 = (bf16_t*)sL;
#pragma unroll
                for (int c = 0; c < 64; ++c) sW2[c * 136 + jc] = f2bf(-X_(c));
            }
        }
        __syncthreads();
        {
            const bf16_t* sW2 = (const bf16_t*)sL;
#pragma unroll
            for (int i = 0; i < 4; ++i) { const int ch = ht + 256 * i, r = ch >> 4, c8 = (ch & 15) * 8; *(u32x4*)(WB + (size_t)it * 8192 + r * 128 + c8) = *(const u32x4*)(sW2 + r * 136 + c8); }
        }
#undef X_
        {
            const int c = ht >> 2, ds = (ht & 3) * 32; const float eg = sEg[c];
#pragma unroll
            for (int c8 = 0; c8 < 4; ++c8) {
                const u32x4 v = *(const u32x4*)(sQ + c * 136 + ds + c8 * 8); u32x4 o;
                o.x = pk2(lo2f(v.x) * eg, hi2f(v.x) * eg); o.y = pk2(lo2f(v.y) * eg, hi2f(v.y) * eg); o.z = pk2(lo2f(v.z) * eg, hi2f(v.z) * eg); o.w = pk2(lo2f(v.w) * eg, hi2f(v.w) * eg);
                *(u32x4*)(QKV + (tokb + c) * 3072 + h * 128 + ds + c8 * 8) = o;
            }
            const int d = ht >> 1, cs = (ht & 1) * 32; const float gl = sGc[63];
#pragma unroll
            for (int c8 = 0; c8 < 4; ++c8) {
                float v[8];
#pragma unroll
                for (int e = 0; e < 8; ++e) { const int cc = cs + c8 * 8 + e; v[e] = bf2f(sK[cc * 136 + d]) * __expf(gl - sGc[cc]); }
                u32x4 o; o.x = pk2(v[0], v[1]); o.y = pk2(v[2], v[3]); o.z = pk2(v[4], v[5]); o.w = pk2(v[6], v[7]);
                *(u32x4*)(QKV + (tokb + (d >> 1)) * 3072 + 1024 + h * 128 + (d & 1) * 64 + cs + c8 * 8) = o;
            }
        }
        __syncthreads();
    }
}

constexpr int SC_WQ = 32768, SC_KA = 24576, SC_KA0 = 3 * SC_WQ;
static_assert(SC_KA0 + 2 * SC_KA <= LDS_BYTES, "scan LDS layout");
__device__ __forceinline__ bf16x8 pack2(const f32x4& a, const f32x4& b) {
    u32x4 r; r.x = pk2(a[0], a[1]); r.y = pk2(a[2], a[3]); r.z = pk2(b[0], b[1]); r.w = pk2(b[2], b[3]); return __builtin_bit_cast(bf16x8, r);
}
#define MF16(a, b, c) __builtin_amdgcn_mfma_f32_16x16x32_bf16(a, b, c, 0, 0, 0)
#define DMA16(src, dst) __builtin_amdgcn_global_load_lds((const unsigned*)(src), (LAS unsigned*)(dst), 16, 0, 0)
__device__ __forceinline__ void phase_gdn_scan(const Prm& p, LAS unsigned char* lds, int blk) {
    const int tid = threadIdx.x, wv = __builtin_amdgcn_readfirstlane(tid >> 6), lane = tid & 63, n = lane & 15, kq = lane >> 4;
    const int bh = blk & 15, jh = blk >> 4, b = bh >> 3, h = bh & 7;
    const bf16_t* QKV = (const bf16_t*)(p.ws + OFF_QKV); const bf16_t* WB = (const bf16_t*)(p.ws + OFF_WB); const bf16_t* ATT = (const bf16_t*)(p.ws + OFF_ATT);
    const float* GL = (const float*)(p.ws + OFF_GL); bf16_t* O = (bf16_t*)(p.ws + OFF_H);
    const int itb = bh * 128;
    const bf16_t* qkv_b = QKV + (size_t)b * SEQ * 3072;
    if (wv >= 4) {
        const int lw = wv - 4;
        __builtin_amdgcn_s_setprio(3);
        unsigned oW[4], oQ[4], oK[4], oA[2];
#pragma unroll
        for (int i = 0; i < 4; ++i) {
            { const int q = lw * 4 + i, row = 4 * q + (lane >> 4), pg = lane & 15, g = pg ^ ((row & 3) | (((row >> 3) & 3) << 2)); oW[i] = (unsigned)(row * 128 + g * 8); oQ[i] = (unsigned)(row * 3072 + h * 128 + g * 8); }
            { const int q = lw * 4 + i, d = 8 * q + (lane >> 3), pg = lane & 7, g = pg ^ ((d & 3) | (((d >> 3) & 1) << 2)); oK[i] = (unsigned)((d >> 1) * 3072 + 1024 + h * 128 + (d & 1) * 64 + g * 8); }
        }
#pragma unroll
        for (int i = 0; i < 2; ++i) { const int q = lw * 2 + i, c = 8 * q + (lane >> 3), pg = lane & 7, g = pg ^ ((c & 3) | (((c >> 3) & 1) << 2)); oA[i] = (unsigned)(c * 64 + g * 8); }
#define ISSUE_WQ(ck, st) do { const bf16_t* wb_ = WB + (size_t)(itb + (ck)) * 8192; const bf16_t* qb_ = qkv_b + (size_t)(ck) * 64 * 3072; LAS unsigned char* d_ = lds + (st) * SC_WQ + lw * 4096; \
        _Pragma("unroll") for (int i = 0; i < 4; ++i) { DMA16(wb_ + oW[i], d_ + i * 1024); DMA16(qb_ + oQ[i], d_ + 16384 + i * 1024); } } while (0)
#define ISSUE_KA(ck, st) do { const bf16_t* qb_ = qkv_b + (size_t)(ck) * 64 * 3072; const bf16_t* ab_ = ATT + (size_t)(itb + (ck)) * 4096; LAS unsigned char* d_ = lds + SC_KA0 + (st) * SC_KA; \
        _Pragma("unroll") for (int i = 0; i < 4; ++i) DMA16(qb_ + oK[i], d_ + (lw * 4 + i) * 1024); \
        _Pragma("unroll") for (int i = 0; i < 2; ++i) DMA16(ab_ + oA[i], d_ + 16384 + (lw * 2 + i) * 1024); } while (0)
        ISSUE_WQ(0, 0); ISSUE_KA(0, 0); ISSUE_WQ(1, 1);
        asm volatile("s_waitcnt vmcnt(0)" ::: "memory"); __builtin_amdgcn_s_barrier(); asm volatile("" ::: "memory");
        int s3 = 2;
        for (int nc = 0; nc < 128; ++nc) {
            const int c1 = nc + 1 < 128 ? nc + 1 : 127, c2 = nc + 2 < 128 ? nc + 2 : 127;
            ISSUE_WQ(c2, s3);
            ISSUE_KA(c1, (nc + 1) & 1);
            s3 = s3 == 2 ? 0 : s3 + 1;
            asm volatile("s_waitcnt vmcnt(14)" ::: "memory");
            __builtin_amdgcn_s_barrier(); asm volatile("" ::: "memory");
            __builtin_amdgcn_s_barrier(); asm volatile("" ::: "memory");
        }
        asm volatile("s_waitcnt vmcnt(0)" ::: "memory");
        __builtin_amdgcn_s_setprio(0);
#undef ISSUE_WQ
#undef ISSUE_KA
    } else if (wv >= 2) {
        for (int nc = 0; nc < 257; ++nc) { __builtin_amdgcn_s_barrier(); asm volatile("" ::: "memory"); }
    } else {
        const float gl0 = GL[itb + lane], gl1 = GL[itb + 64 + lane];
        f32x4 S[8];
#pragma unroll
        for (int dt = 0; dt < 8; ++dt) S[dt] = (f32x4){0.f, 0.f, 0.f, 0.f};
        const int e = 32 * jh + 16 * wv + n;
        unsigned uo[2];
#pragma unroll
        for (int pc = 0; pc < 2; ++pc) { const int L = (((2 * jh + wv) * 2 + pc) * 64 + lane) * 8; uo[pc] = (unsigned)((L >> 7) * 3072 + 2048 + h * 128 + (L & 127)); }
        u32x4 ua[2], ub[2];
#pragma unroll
        for (int pc = 0; pc < 2; ++pc) { ua[pc] = *(const u32x4*)(qkv_b + uo[pc]); ub[pc] = *(const u32x4*)(qkv_b + (size_t)64 * 3072 + uo[pc]); }
        const int rowb = 8 * (n >> 2) + (n & 3), swk = (n & 3) | (((n >> 2) & 1) << 2);
        unsigned offW[4], offK[2];
#pragma unroll
        for (int ks = 0; ks < 4; ++ks) offW[ks] = (unsigned)(rowb * 256 + (((4 * ks + kq) ^ n) << 4));
#pragma unroll
        for (int k2 = 0; k2 < 2; ++k2) offK[k2] = (unsigned)(rowb * 128 + (((4 * k2 + kq) ^ swk) << 4));
        asm volatile("s_waitcnt lgkmcnt(0)" ::: "memory"); __builtin_amdgcn_s_barrier(); asm volatile("" ::: "memory");
        int s3 = 0;
        for (int nc = 0; nc < 128; ++nc) {
            const LAS unsigned char* sWQ = lds + s3 * SC_WQ; const LAS unsigned char* sKA = lds + SC_KA0 + (nc & 1) * SC_KA;
            s3 = s3 == 2 ? 0 : s3 + 1;
            const float gl = __builtin_bit_cast(float, __builtin_amdgcn_readlane(__builtin_bit_cast(int, nc < 64 ? gl0 : gl1), nc & 63));
            f32x4 V[4], Oa[4];
#pragma unroll
            for (int pc = 0; pc < 2; ++pc) {
                const u32x4 uu = ua[pc];
                V[2 * pc] = (f32x4){lo2f(uu.x), hi2f(uu.x), lo2f(uu.y), hi2f(uu.y)}; V[2 * pc + 1] = (f32x4){lo2f(uu.z), hi2f(uu.z), lo2f(uu.w), hi2f(uu.w)};
                ua[pc] = ub[pc];
            }
            { const int c2 = nc + 2 < 128 ? nc + 2 : 127; const bf16_t* ubase = qkv_b + (size_t)c2 * 64 * 3072;
#pragma unroll
              for (int pc = 0; pc < 2; ++pc) ub[pc] = *(const u32x4*)(ubase + uo[pc]); }
#pragma unroll
            for (int ct = 0; ct < 4; ++ct) Oa[ct] = (f32x4){0.f, 0.f, 0.f, 0.f};
            bf16x8 fa[2][8];
#define TOFF(t, pitch) ((32 * ((t) >> 1) + 4 * ((t) & 1)) * (pitch))
#define LD_WQ(dst, ks_) do { _Pragma("unroll") for (int mt = 0; mt < 4; ++mt) { dst[mt] = *(const LAS bf16x8*)(sWQ + offW[ks_] + TOFF(mt, 256)); dst[4 + mt] = *(const LAS bf16x8*)(sWQ + 16384 + offW[ks_] + TOFF(mt, 256)); } } while (0)
            LD_WQ(fa[0], 0);
#pragma unroll
            for (int ks = 0; ks < 4; ++ks) {
                if (ks < 3) LD_WQ(fa[(ks + 1) & 1], ks + 1);
                const bf16x8 sb8 = pack2(S[2 * ks], S[2 * ks + 1]);
                __builtin_amdgcn_sched_barrier(0);
#pragma unroll
                for (int mt = 0; mt < 4; ++mt) { V[mt] = MF16(fa[ks & 1][mt], sb8, V[mt]); Oa[mt] = MF16(fa[ks & 1][4 + mt], sb8, Oa[mt]); }
                __builtin_amdgcn_sched_barrier(0);
            }
#undef LD_WQ
            asm volatile("s_waitcnt lgkmcnt(0)" ::: "memory"); __builtin_amdgcn_s_barrier(); asm volatile("" ::: "memory");
            bf16x8 fb[2][12];
#define LD_AK(dst, k2_) do { _Pragma("unroll") for (int mt = 0; mt < 4; ++mt) dst[mt] = *(const LAS bf16x8*)(sKA + 16384 + offK[k2_] + TOFF(mt, 128)); \
                             _Pragma("unroll") for (int dt = 0; dt < 8; ++dt) dst[4 + dt] = *(const LAS bf16x8*)(sKA + offK[k2_] + TOFF(dt, 128)); } while (0)
            LD_AK(fb[0], 0);
            bf16x8 Vb[2];
            Vb[0] = pack2(V[0], V[1]); Vb[1] = pack2(V[2], V[3]);
#pragma unroll
            for (int dt = 0; dt < 8; ++dt) S[dt] *= gl;
#pragma unroll
            for (int k2 = 0; k2 < 2; ++k2) {
                if (k2 < 1) LD_AK(fb[1], 1);
                __builtin_amdgcn_sched_barrier(0);
#pragma unroll
                for (int mt = 0; mt < 4; ++mt) Oa[mt] = MF16(fb[k2][mt], Vb[k2], Oa[mt]);
#pragma unroll
                for (int dt = 0; dt < 8; ++dt) S[dt] = MF16(fb[k2][4 + dt], Vb[k2], S[dt]);
                __builtin_amdgcn_sched_barrier(0);
            }
#undef LD_AK
#undef TOFF
            bf16_t* obase = O + (size_t)(itb + nc) * 8192 + e * 64 + 8 * kq;
#pragma unroll
            for (int pc = 0; pc < 2; ++pc) *(u32x4*)(obase + 32 * pc) = pack8(Oa[2 * pc], Oa[2 * pc + 1]);
            asm volatile("s_waitcnt lgkmcnt(0)" ::: "memory"); __builtin_amdgcn_s_barrier(); asm volatile("" ::: "memory");
        }
    }
    __syncthreads();
}

__device__ __forceinline__ void phase_ya(const Prm& p, unsigned char* lds) {
    const bf16_t* OT = (const bf16_t*)(p.ws + OFF_H); bf16_t* SZA = (bf16_t*)p.out;
    const float* gw = p.in[7];
    bf16_t* sT = (bf16_t*)lds;
    float* sPart = (float*)(lds + 16384);
    const int tid = threadIdx.x, w = tid >> 6, c = tid & 63;
    for (int it = blockIdx.x; it < NIT; it += gridDim.x) {
        const int b = it >> 10, h = (it >> 7) & 7, nc = it & 127;
        const size_t tok = (size_t)b * SEQ + (size_t)nc * 64 + c;
#pragma unroll
        for (int i = 0; i < 2; ++i) { const int ch = tid + 512 * i; *(u32x4*)(sT + ch * 8) = *(const u32x4*)(OT + (size_t)it * 8192 + ch * 8); }
        const u32x4 z0 = *(const u32x4*)(SZA + tok * 1024 + h * 128 + 16 * w), z1 = *(const u32x4*)(SZA + tok * 1024 + h * 128 + 16 * w + 8);
        __syncthreads();
        float o[16]; float ss = 0.f;
#pragma unroll
        for (int j = 0; j < 16; ++j) { o[j] = bf2f(sT[(16 * w + j) * 64 + c]); ss += o[j] * o[j]; }
        sPart[w * 64 + c] = ss;
        __syncthreads();
        float tot = 0.f;
#pragma unroll
        for (int k = 0; k < 8; ++k) tot += sPart[k * 64 + c];
        const float rstd = rsqrtf(tot * (1.0f / 128.0f) + 1e-6f);
        const unsigned zz[8] = {z0.x, z0.y, z0.z, z0.w, z1.x, z1.y, z1.z, z1.w};
        unsigned r[8];
#pragma unroll
        for (int j = 0; j < 8; ++j)
            r[j] = pk2(o[2 * j] * rstd * gw[16 * w + 2 * j] * lo2f(zz[j]), o[2 * j + 1] * rstd * gw[16 * w + 2 * j + 1] * hi2f(zz[j]));
        *(u32x4*)(SZA + tok * 1024 + h * 128 + 16 * w) = (u32x4){r[0], r[1], r[2], r[3]};
        *(u32x4*)(SZA + tok * 1024 + h * 128 + 16 * w + 8) = (u32x4){r[4], r[5], r[6], r[7]};
        __syncthreads();
    }
}
__device__ __forceinline__ void phase_conv3(const Prm& p) {
    const bf16_t* P = (const bf16_t*)(p.ws + OFF_P); bf16_t* Q = (bf16_t*)(p.ws + OFF_Q); const float* cw = p.in[19];
    const int nth = gridDim.x * 512;
    for (int idx = blockIdx.x * 512 + threadIdx.x; idx < (TOK / 4) * 256; idx += nth) {
        const int t0 = (idx >> 8) * 4, c8 = (idx & 255) * 8;
        const bool first = (t0 & (SEQ - 1)) == 0;
        u32x4 pr[6], qr[4];
#pragma unroll
        for (int i = 0; i < 6; ++i) pr[i] = (i < 2 && first) ? (u32x4){0u, 0u, 0u, 0u} : *(const u32x4*)(P + (size_t)(t0 - 2 + i) * 2048 + c8);
#pragma unroll
        for (int i = 0; i < 4; ++i) qr[i] = *(const u32x4*)(Q + (size_t)(t0 + i) * 2048 + c8);
        float w0[8], w1[8], w2[8];
#pragma unroll
        for (int e = 0; e < 8; ++e) { w0[e] = cw[c8 + e]; w1[e] = cw[2048 + c8 + e]; w2[e] = cw[4096 + c8 + e]; }
#pragma unroll
        for (int i = 0; i < 4; ++i) {
            const unsigned pa[4] = {pr[i + 2].x, pr[i + 2].y, pr[i + 2].z, pr[i + 2].w}, pb[4] = {pr[i + 1].x, pr[i + 1].y, pr[i + 1].z, pr[i + 1].w}, pc[4] = {pr[i].x, pr[i].y, pr[i].z, pr[i].w};
            const unsigned qa[4] = {qr[i].x, qr[i].y, qr[i].z, qr[i].w};
            unsigned o[4];
#pragma unroll
            for (int e = 0; e < 4; ++e)
                o[e] = pk2(lo2f(qa[e]) * (w0[2 * e] * lo2f(pc[e]) + w1[2 * e] * lo2f(pb[e]) + w2[2 * e] * lo2f(pa[e])),
                           hi2f(qa[e]) * (w0[2 * e + 1] * hi2f(pc[e]) + w1[2 * e + 1] * hi2f(pb[e]) + w2[2 * e + 1] * hi2f(pa[e])));
            *(u32x4*)(Q + (size_t)(t0 + i) * 2048 + c8) = (u32x4){o[0], o[1], o[2], o[3]};
        }
    }
}

#define XB_TMO      128
#define XB_XCNT(j)  (256  + 64 * (j))
#define XB_XSUB(j)  (1280 + 64 * (j))
#define XB_XGEN(j)  (2304 + 64 * (j))
#define XB_TOP      3328
#define XB_TOPGEN   3392
#define XCD_BAR_WORDS 3456
#define XB_SPIN_CAP (1u << 18)

__device__ __forceinline__ unsigned xb_ld(unsigned* p)              { return __hip_atomic_load(p, __ATOMIC_RELAXED, __HIP_MEMORY_SCOPE_AGENT); }
__device__ __forceinline__ unsigned xb_add(unsigned* p, unsigned v) { return __hip_atomic_fetch_add(p, v, __ATOMIC_RELAXED, __HIP_MEMORY_SCOPE_AGENT); }
__device__ __forceinline__ unsigned xb_xcc_id() { return (unsigned)__builtin_amdgcn_s_getreg((3 << 11) | 20) & 0xFu; }
#define XB_SPIN(cond, bar) do { unsigned _sp = 0; while (cond) { __builtin_amdgcn_s_sleep(1); \
    if ((++_sp & 255u) == 0u) { if (xb_ld(&(bar)[XB_TMO])) break; if (_sp > XB_SPIN_CAP) { atomicAdd(&(bar)[XB_TMO], 1u); break; } } } } while (0)

struct XcdBarrier {
    unsigned* bar; unsigned x;
    volatile LAS unsigned* st;
};

__device__ __forceinline__ XcdBarrier xcd_barrier_post(unsigned* bar, volatile LAS unsigned* st) {
    XcdBarrier b; b.bar = bar; b.x = xb_xcc_id(); b.st = st;
    if (threadIdx.x == 0) (void)xb_add(&bar[XB_XCNT(b.x)], 1u);
    return b;
}
__device__ __forceinline__ void xcd_barrier_complete(unsigned* bar, unsigned x, unsigned& nloc, unsigned& nx) {
    const unsigned G = gridDim.x * gridDim.y * gridDim.z;
    unsigned sum, cnt, mine, sp = 0u;
    for (;;) {
        sum = 0u; cnt = 0u; mine = 0u;
#pragma unroll
        for (unsigned j = 0; j < 16; ++j) { const unsigned c = xb_ld(&bar[XB_XCNT(j)]); sum += c; cnt += (c > 0u) ? 1u : 0u; mine = (j == x) ? c : mine; }
        if (sum == G) break;
        __builtin_amdgcn_s_sleep(1);
        if ((++sp & 255u) == 0u) { if (xb_ld(&bar[XB_TMO])) break; if (sp > XB_SPIN_CAP) { atomicAdd(&bar[XB_TMO], 1u); break; } }
    }
    nloc = mine > 0u ? mine : 1u; nx = cnt > 0u ? cnt : 1u;
}

__device__ __forceinline__ void xcd_barrier(const XcdBarrier& b) {
    asm volatile("s_waitcnt vmcnt(0)" ::: "memory");
    __syncthreads();
    if (threadIdx.x == 0) {
        unsigned* bar = b.bar;
        __builtin_amdgcn_s_waitcnt(0);
        unsigned nloc = b.st[0], nx = b.st[1];
        if (nloc == 0u) { xcd_barrier_complete(bar, b.x, nloc, nx); b.st[0] = nloc; b.st[1] = nx; }
        const unsigned old = xb_add(&bar[XB_XSUB(b.x)], 1u);
        const unsigned gen = old / nloc;
        if (old + 1u == (gen + 1u) * nloc) {
            __builtin_amdgcn_fence(__ATOMIC_RELEASE, "agent");
            asm volatile("s_waitcnt vmcnt(0)" ::: "memory");
            const unsigned og = xb_add(&bar[XB_TOP], 1u);
            const unsigned tg = og / nx;
            if (og + 1u == (tg + 1u) * nx) xb_add(&bar[XB_TOPGEN], 1u);
            else XB_SPIN(xb_ld(&bar[XB_TOPGEN]) == tg, bar);
            __builtin_amdgcn_fence(__ATOMIC_ACQUIRE, "agent");
            xb_add(&bar[XB_XGEN(b.x)], 1u);
            asm volatile("s_waitcnt vmcnt(0)" ::: "memory");
        } else {
            XB_SPIN(xb_ld(&bar[XB_XGEN(b.x)]) == gen, bar);
            __builtin_amdgcn_fence(__ATOMIC_ACQUIRE, "agent");
            asm volatile("s_waitcnt vmcnt(0)" ::: "memory");
        }
    }
    __syncthreads();
}

constexpr int NPHASE = 11;
#define REP_GEMM 1
#define REP_SYNC 1
#define REP_SCAN 1
#define SCAN_PROBE 1
#define REP_P0 1
#ifndef PHM
#define PHM 0x7FF
#endif
__global__ void __launch_bounds__(512, 2) mega(Prm p) {
    extern __shared__ __attribute__((aligned(16))) unsigned char shm[];
    LAS unsigned char* lds3 = (LAS unsigned char*)shm;
    unsigned char* ws = p.ws;
    volatile LAS unsigned* xst = (volatile LAS unsigned*)(lds3 + LDS_BYTES);
    if (threadIdx.x == 0) { xst[0] = 0u; xst[1] = 0u; }
    __syncthreads();
    XcdBarrier xb{};
    const bool multi = (p.ph_hi - p.ph_lo) > 1;
    if (multi) xb = xcd_barrier_post((unsigned*)(ws + OFF_BAR), xst);
    if (p.ph_lo < 0) cg::this_grid().sync();
#define PH_BEGIN(i) if (((PHM >> (i)) & 1) && p.ph_lo <= (i) && (i) < p.ph_hi) { if ((i) > p.ph_lo) { xcd_barrier(xb); if (REP_SYNC > 1) xcd_barrier(xb); } pg8::StaticOrder S; (void)S;
#define PH_END }
    PH_BEGIN(0)
        for (int rep = 0; rep < REP_P0; ++rep) {
        phase_convert(p, shm, 0, 1856, gridDim.x, blockIdx.x);
        phase_rmsnorm_x(p.in[0], p.in[1], (bf16_t*)(ws + OFF_H)); __syncthreads(); }
    PH_END
    PH_BEGIN(1)
        phase_ba(p, shm);
        pg8::Gemm g{(const bf16_t*)(ws + OFF_H), (const bf16_t*)(ws + OFF_WT1), TOK, 6144, 1024, (const bf16_t*)(ws + OFF_H), 1024, 64};
        Epi1 E{(bf16_t*)(ws + OFF_QKV), (bf16_t*)p.out, (bf16_t*)(ws + OFF_UU), (bf16_t*)p.out + (size_t)TOK * 1024, (float*)(ws + OFF_BA), (bf16_t*)(ws + OFF_HALO)};
        S.init(TOK, 6144, gridDim.x, blockIdx.x); for (int rep = 0; rep < REP_GEMM; ++rep) { pg8::gemm_phase(lds3, g, S, E); __syncthreads(); }
    PH_END
    PH_BEGIN(2)
        {
            unsigned* ctr = (unsigned*)(ws + OFF_BAR) + 3600;
            volatile LAS unsigned* sIt = xst + 2;
            for (;;) {
                if (threadIdx.x == 0) sIt[0] = __hip_atomic_fetch_add(ctr, 2u, __ATOMIC_RELAXED, __HIP_MEMORY_SCOPE_AGENT);
                __syncthreads();
                const unsigned it0 = sIt[0];
                __syncthreads();
                if (it0 >= (unsigned)NIT) break;
                phase_gdn_prep(p, shm, (int)it0, 1);
            }
        }
    PH_END
    PH_BEGIN(3)
        if (blockIdx.x < 64) phase_gdn_scan(p, lds3, blockIdx.x);
        else {
            const int ob = blockIdx.x - 64;
            pg8::Gemm g{(const bf16_t*)(ws + OFF_UU), (const bf16_t*)(ws + OFF_WTG), TOK, 1024, 1024, (const bf16_t*)(ws + OFF_UU), 1024, 64};
            EpiGlu E{(const bf16_t*)(ws + OFF_UU), (bf16_t*)p.out + (size_t)TOK * 1024};
            unsigned* cw = (unsigned*)(ws + OFF_BAR);
            if (ob < 128) {
                phase_s5(p, shm, ob);
                asm volatile("s_waitcnt vmcnt(0)" ::: "memory");
                __syncthreads();
                if (threadIdx.x == 0) {
                    __builtin_amdgcn_fence(__ATOMIC_RELEASE, "agent");
                    asm volatile("s_waitcnt vmcnt(0)" ::: "memory");
                    __hip_atomic_fetch_add(cw + 3700, 1u, __ATOMIC_RELAXED, __HIP_MEMORY_SCOPE_AGENT);
                    unsigned sp = 0;
                    while (__hip_atomic_load(cw + 3700, __ATOMIC_RELAXED, __HIP_MEMORY_SCOPE_AGENT) < 128u) { __builtin_amdgcn_s_sleep(2); if (++sp > (1u << 22)) break; }
                    __builtin_amdgcn_fence(__ATOMIC_ACQUIRE, "agent");
                    asm volatile("s_waitcnt vmcnt(0)" ::: "memory");
                }
                __syncthreads();
                S.init_list(ob, 1, 1); pg8::gemm_phase(lds3, g, S, E);
            } else {
                const int e = ob - 128;
                phase_convert(p, shm, 1856, 1856 + 2304, 64, e);
                __syncthreads();
                if (threadIdx.x == 0) {
                    unsigned sp = 0;
                    while (__hip_atomic_load(cw + 3900, __ATOMIC_RELAXED, __HIP_MEMORY_SCOPE_AGENT) < 128u) { __builtin_amdgcn_s_sleep(2); if (++sp > (1u << 22)) break; }
                    __builtin_amdgcn_fence(__ATOMIC_ACQUIRE, "agent");
                    asm volatile("s_waitcnt vmcnt(0)" ::: "memory");
                }
                __syncthreads();
                S.init_list(2 * e, 2, 0); pg8::gemm_phase(lds3, g, S, E);
                __syncthreads();
                phase_convert(p, shm, 1856 + 2304, 4928, 64, e);
            }
        }
    PH_END
    PH_BEGIN(4)
        phase_ya(p, shm);
    PH_END
    PH_BEGIN(5)
        pg8::Gemm g{(const bf16_t*)p.out, (const bf16_t*)(ws + OFF_WTO0), TOK, 1024, 2048, (const bf16_t*)p.out + (size_t)TOK * 1024, 1024, 16};
        EpiB16 E{(bf16_t*)(ws + OFF_QKV)};
        S.init(TOK, 1024, gridDim.x, blockIdx.x); for (int rep = 0; rep < REP_GEMM; ++rep) { pg8::gemm_phase(lds3, g, S, E); __syncthreads(); }
    PH_END
    PH_BEGIN(6)
        phase_post<true>(p.in[0], (const bf16_t*)(ws + OFF_QKV), p.in[2], p.out, p.in[1] + 1024, (bf16_t*)(ws + OFF_H));
    PH_END
    PH_BEGIN(7)
        pg8::Gemm g{(const bf16_t*)(ws + OFF_H), (const bf16_t*)(ws + OFF_WT2), TOK, 8192, 1024, (const bf16_t*)(ws + OFF_H), 1024, 64};
        Epi2 E{(bf16_t*)(ws + OFF_P), (bf16_t*)(ws + OFF_Q)};
        S.init(TOK, 8192, gridDim.x, blockIdx.x); for (int rep = 0; rep < REP_GEMM; ++rep) { pg8::gemm_phase(lds3, g, S, E); __syncthreads(); }
    PH_END
    PH_BEGIN(8)
        phase_conv3(p);
    PH_END
    PH_BEGIN(9)
        pg8::Gemm g{(const bf16_t*)(ws + OFF_Q), (const bf16_t*)(ws + OFF_WTO1), TOK, 1024, 2048, (const bf16_t*)(ws + OFF_Q), 2048, 64};
        EpiB16 E{(bf16_t*)(ws + OFF_P)};
        S.init(TOK, 1024, gridDim.x, blockIdx.x); for (int rep = 0; rep < REP_GEMM; ++rep) { pg8::gemm_phase(lds3, g, S, E); __syncthreads(); }
    PH_END
    PH_BEGIN(10)
        phase_post<false>(p.out, (const bf16_t*)(ws + OFF_P), p.in[2] + 1024, p.out, nullptr, nullptr);
    PH_END
}

#ifndef N_LAUNCH_MODE
#define N_LAUNCH_MODE 1
#endif

extern "C" void kernel_launch(void* const* d_in, const int* in_sizes, int n_in, void* d_out, int out_size, void* d_ws, size_t ws_size, hipStream_t stream) {
    static int ready = 0;
    if (!ready) {
        if (n_in != 21 || ws_size < WS_END || out_size != TOK * DM) { fprintf(stderr, "kernel_launch: unexpected shapes (n_in %d ws %zu out %d)\n", n_in, ws_size, out_size); ready = -1; return; }
        if (hipFuncSetAttribute((const void*)mega, hipFuncAttributeMaxDynamicSharedMemorySize, LDS_BYTES + 16) != hipSuccess) { fprintf(stderr, "kernel_launch: hipFuncSetAttribute failed\n"); ready = -1; return; }
        ready = 1;
    }
    if (ready < 0) return;
    Prm p{};
    for (int i = 0; i < 21; ++i) p.in[i] = (const float*)d_in[i];
    p.out = (float*)d_out; p.ws = (unsigned char*)d_ws;
#if N_LAUNCH_MODE == 1
    p.ph_lo = 0; p.ph_hi = NPHASE;
    void* args[] = {&p};
    if (hipMemsetAsync((unsigned char*)d_ws + OFF_BAR, 0, 16384, stream) != hipSuccess) { fprintf(stderr, "memset failed\n"); return; }
    hipError_t e = hipLaunchCooperativeKernel((const void*)mega, dim3(256), dim3(512), args, LDS_BYTES + 16, stream);
    if (e != hipSuccess) fprintf(stderr, "cooperative launch failed: %s\n", hipGetErrorString(e));
#else
    for (int ph = 0; ph < NPHASE; ++ph) {
        p.ph_lo = ph; p.ph_hi = ph + 1;
        hipLaunchKernelGGL(mega, dim3(256), dim3(512), LDS_BYTES + 16, stream, p);
    }
#endif
}
```

```cpp
#include <hip/hip_runtime.h>
#include <hip/hip_cooperative_groups.h>
#include <cstdio>
namespace cg = cooperative_groups;

#define LAS __attribute__((address_space(3)))
typedef unsigned short bf16_t;
typedef short bf16x8 __attribute__((ext_vector_type(8)));
typedef float f32x4 __attribute__((ext_vector_type(4)));
typedef float f32x16 __attribute__((ext_vector_type(16)));
typedef unsigned u32x4 __attribute__((ext_vector_type(4)));
typedef unsigned u32x2 __attribute__((ext_vector_type(2)));

constexpr int TOK = 16384, DM = 1024, SEQ = 8192;
constexpr int NP1 = 6400;
constexpr int NIT = 2048;

constexpr size_t OFF_WT1 = 0;
constexpr size_t OFF_WTG = OFF_WT1 + (size_t)NP1 * 1024 * 2;
constexpr size_t OFF_WTO0 = OFF_WTG + (size_t)1024 * 1024 * 2;
constexpr size_t OFF_WT2 = OFF_WTO0 + (size_t)1024 * 2048 * 2;
constexpr size_t OFF_WTO1 = OFF_WT2 + (size_t)8192 * 1024 * 2;
constexpr size_t OFF_H = OFF_WTO1 + (size_t)1024 * 2048 * 2;
constexpr size_t OFF_QKV = OFF_H + (size_t)TOK * 1024 * 2;
constexpr size_t OFF_UU = OFF_QKV + (size_t)TOK * 3072 * 2;
constexpr size_t OFF_WB = OFF_UU + (size_t)TOK * 1024 * 2;
constexpr size_t OFF_ATT = OFF_WB + (size_t)NIT * 8192 * 2;
constexpr size_t OFF_HALO = OFF_ATT + (size_t)NIT * 4096 * 2;
constexpr size_t OFF_BA = OFF_HALO + (size_t)256 * 3 * 3072 * 2;
constexpr size_t OFF_GL = OFF_BA + (size_t)TOK * 16 * 4;
constexpr size_t OFF_BAR = OFF_GL + (size_t)NIT * 4;
constexpr size_t WS_END = OFF_BAR + 16384;
constexpr size_t OFF_YMIX = OFF_QKV;
constexpr size_t OFF_P = OFF_QKV;
constexpr size_t OFF_Q = OFF_QKV + (size_t)TOK * 2048 * 2;
static_assert(OFF_Q + (size_t)TOK * 2048 * 2 <= OFF_WB, "Q overlaps live data");
static_assert(WS_END <= (size_t)256 * 1024 * 1024, "workspace too big");

constexpr int LDS_BYTES = 157696;

struct Prm {
    const float* in[21];
    float* out;
    unsigned char* ws;
    int ph_lo, ph_hi;
};

__device__ __forceinline__ float bf2f(bf16_t b) { return __uint_as_float(((unsigned)b) << 16); }
__device__ __forceinline__ bf16_t f2bf(float f) { unsigned u = __float_as_uint(f); u += 0x7FFFu + ((u >> 16) & 1u); return (bf16_t)(u >> 16); }
typedef __bf16 bf16v2_t __attribute__((ext_vector_type(2)));
typedef float f32x2_t __attribute__((ext_vector_type(2)));
__device__ __forceinline__ unsigned pk2(float lo, float hi) { const f32x2_t v = {lo, hi}; return __builtin_bit_cast(unsigned, __builtin_convertvector(v, bf16v2_t)); }
__device__ __forceinline__ float lo2f(unsigned u) { return __uint_as_float(u << 16); }
__device__ __forceinline__ float hi2f(unsigned u) { return __uint_as_float(u & 0xFFFF0000u); }
__device__ __forceinline__ float sigmoidf_(float x) { return 1.0f / (1.0f + __expf(-x)); }
__device__ __forceinline__ float siluf_(float x) { return x / (1.0f + __expf(-x)); }
__device__ __forceinline__ float wave_sum(float v) {
#pragma unroll
    for (int o = 32; o >= 1; o >>= 1) v += __shfl_xor(v, o);
    return v;
}
__device__ __forceinline__ u32x4 pack8(f32x4 a, f32x4 b) { u32x4 r; r.x = pk2(a[0], a[1]); r.y = pk2(a[2], a[3]); r.z = pk2(b[0], b[1]); r.w = pk2(b[2], b[3]); return r; }

namespace pg8 {
constexpr int BM = 256, BK = 64, HALF = 128, HTB = HALF * BK * 2, STAGE_BYTES = 8 * HTB, NXCD = 8, WGM = 8;
__device__ __forceinline__ int lds_byte(int r, int c) { const int st = (r >> 4) * 2 + (c >> 5), rr = r & 15, cc = c & 31, ob = rr * 64 + cc * 2; return st * 1024 + (ob ^ (((ob >> 9) & 1) << 5)); }
__device__ __forceinline__ void stage_rc(int b, int& R, int& C) { const int st = b / 1024, sb = b % 1024, swz = sb ^ (((sb >> 9) & 1) << 5); R = (st >> 1) * 16 + swz / 64; C = (st & 1) * 32 + (swz % 64) / 2; }
__device__ __forceinline__ int perm32(int rho) { const int n = rho >> 4, i = rho & 15; return 8 * (i >> 2) + 4 * n + (i & 3); }
struct Unit { int pm, pn; };
struct Gemm { const bf16_t* A; const bf16_t* Bt; int M, N, K; const bf16_t* A2; int lda, ks; };
struct StaticOrder {
    int nM, nN, nwg, G, c;
    int lmode, lbase, lcount, lhalf;
    __device__ void init(int M, int N, int G_, int c_) { nM = M / BM; nN = N / BM; nwg = nM * nN; G = G_; c = c_; lmode = 0; lbase = 0; lcount = 0; lhalf = 0; }
    __device__ void init_list(int base, int count, int half) { nM = 64; nN = 4; nwg = 256; G = 1; c = 0; lmode = 1; lbase = base; lcount = count; lhalf = half; }
    __device__ bool next(int i, Unit& u) const {
        if (lmode) { if (i >= lcount) return false; const int j = lbase + i, bb = j >> 6, r = j & 63; u.pm = 32 * bb + 16 * lhalf + (r >> 2); u.pn = r & 3; return true; }
        const long L = (long)i * G + c; if (L >= nwg) return false;
        int wgid = (int)L; { const int q = nwg / NXCD, r = nwg % NXCD, xcd = wgid % NXCD, off = wgid / NXCD; wgid = (xcd < r ? xcd * (q + 1) : r * (q + 1) + (xcd - r) * q) + off; }
        const int nig = WGM * nN, gid = wgid / nig, fm = gid * WGM, gsz = (nM - fm) < WGM ? (nM - fm) : WGM;
        u.pm = fm + ((wgid % nig) % gsz); u.pn = (wgid % nig) / gsz; return true;
    }
};

template <class Epi>
__device__ __forceinline__ void gemm_phase(LAS unsigned char* lds, const Gemm g, const StaticOrder& S, const Epi& E) {
    const int tid = threadIdx.x, wid = __builtin_amdgcn_readfirstlane(tid >> 6), lane = tid & 63, wr = wid >> 2, wc = wid & 3, fr = lane & 15, fq = lane >> 4;
    const int K = g.K, nt = K / BK;
    unsigned voffA[2], voffB[2];
#pragma unroll
    for (int i = 0; i < 2; ++i) { int R, C; stage_rc(tid * 16 + i * 8192, R, C); const int Rb = Epi::PERM ? ((R & ~31) + perm32(R & 31)) : R;
        voffA[i] = (unsigned)(R * g.lda + C) * 2u; voffB[i] = (unsigned)(Rb * K + C) * 2u; }
    const size_t kstep = (size_t)(BK * 2);
    const size_t hstep = (size_t)HALF * K * 2;
    const size_t tstep = 2 * hstep;
    const size_t hstepA = (size_t)HALF * g.lda * 2, tstepA = 2 * hstepA;
    const int ks = g.ks; const ptrdiff_t a2off = (const char*)g.A2 - (const char*)g.A - (ptrdiff_t)ks * (ptrdiff_t)kstep;
    const unsigned ldsw = (unsigned)wid * 1024u;
    const int aoff = lds_byte(wr * 64 + fr, fq * 8), boff = lds_byte(wc * 32 + fr, fq * 8);
#define PG8_SA(b, h) (((b) * 2 + (h)) * HTB)
#define PG8_SB(b, h) ((4 + (b) * 2 + (h)) * HTB)
#define PG8_STAGE(bufoff, gbase, voff) do { _Pragma("unroll") for (int _i = 0; _i < 2; ++_i) \
        __builtin_amdgcn_global_load_lds((const unsigned*)((const char*)(gbase) + (voff)[_i]), (LAS unsigned*)(lds + (bufoff) + ldsw + _i * 8192), 16, 0, 0); } while (0)
#define PG8_LDA(dst, b, h) do { _Pragma("unroll") for (int m = 0; m < 4; ++m) _Pragma("unroll") for (int k = 0; k < 2; ++k) dst[m][k] = *(const LAS bf16x8*)(lds + PG8_SA(b, h) + aoff + m * 2048 + k * 1024); } while (0)
#define PG8_LDB(dst, b, h) do { _Pragma("unroll") for (int n = 0; n < 2; ++n) _Pragma("unroll") for (int k = 0; k < 2; ++k) dst[n][k] = *(const LAS bf16x8*)(lds + PG8_SB(b, h) + boff + n * 2048 + k * 1024); } while (0)
#define PG8_MMA(ai, bj, At, Bt) do { __builtin_amdgcn_s_setprio(1); _Pragma("unroll") for (int m = 0; m < 4; ++m) _Pragma("unroll") for (int n = 0; n < 2; ++n) _Pragma("unroll") for (int k = 0; k < 2; ++k) \
        acc[ai][bj][m][n] = __builtin_amdgcn_mfma_f32_16x16x32_bf16(Bt[n][k], At[m][k], acc[ai][bj][m][n], 0, 0, 0); __builtin_amdgcn_s_setprio(0); } while (0)
#define PG8_WAIT_V(n) asm volatile("s_waitcnt vmcnt(" #n ")" ::: "memory")
#define PG8_WAIT_L(n) asm volatile("s_waitcnt lgkmcnt(" #n ")" ::: "memory")
#define PG8_BAR __builtin_amdgcn_s_barrier()
#define PG8_SCHED __builtin_amdgcn_sched_barrier(0)
    Unit cur, nxt; int ui = 0;
    if (!S.next(0, cur)) return;
    f32x4 acc[2][2][4][2];
#pragma unroll
    for (int a = 0; a < 2; ++a)
#pragma unroll
        for (int b = 0; b < 2; ++b)
#pragma unroll
            for (int m = 0; m < 4; ++m)
#pragma unroll
                for (int n = 0; n < 2; ++n) acc[a][b][m][n] = (f32x4){0.f, 0.f, 0.f, 0.f};
    bf16x8 At[4][2], B0[2][2], B1[2][2];
    const char* cA = (const char*)g.A + (size_t)cur.pm * tstepA; const char* cB = (const char*)g.Bt + (size_t)cur.pn * tstep;
    PG8_STAGE(PG8_SB(0, 0), cB, voffB); PG8_STAGE(PG8_SA(0, 0), cA, voffA); PG8_STAGE(PG8_SB(0, 1), cB + hstep, voffB); PG8_STAGE(PG8_SA(0, 1), cA + hstepA, voffA);
    if (wr == 1) PG8_BAR;
    PG8_WAIT_V(4); PG8_BAR;
    PG8_STAGE(PG8_SB(1, 0), cB + kstep, voffB); PG8_STAGE(PG8_SA(1, 0), cA + kstep, voffA); PG8_STAGE(PG8_SB(1, 1), cB + hstep + kstep, voffB);
    PG8_WAIT_V(6); PG8_BAR;
    for (;;) {
        const bool has_next = S.next(ui + 1, nxt);
        const char* nA = has_next ? (const char*)g.A + (size_t)nxt.pm * tstepA : cA; const char* nB = has_next ? (const char*)g.Bt + (size_t)nxt.pn * tstep : cB;
        for (int t = 0; t < nt; t += 2) {
            const bool last = (t == nt - 2);
            const char* a1 = cA + (size_t)(t + 1) * kstep + ((t + 1) >= ks ? a2off : 0);
            const char* a2 = last ? nA : cA + (size_t)(t + 2) * kstep + ((t + 2) >= ks ? a2off : 0); const char* b2 = last ? nB : cB + (size_t)(t + 2) * kstep;
            const char* a3 = last ? nA + kstep : cA + (size_t)(t + 3) * kstep + ((t + 3) >= ks ? a2off : 0); const char* b3 = b2 + kstep;
            PG8_LDB(B0, 0, 0); PG8_SCHED; PG8_LDA(At, 0, 0); PG8_STAGE(PG8_SA(1, 1), a1 + hstepA, voffA);
            PG8_WAIT_L(8); PG8_BAR; PG8_WAIT_L(0); PG8_MMA(0, 0, At, B0); PG8_BAR; PG8_SCHED;
            PG8_LDB(B1, 0, 1); PG8_STAGE(PG8_SB(0, 0), b2, voffB);
            PG8_BAR; PG8_WAIT_L(0); PG8_MMA(0, 1, At, B1); PG8_BAR;
            PG8_LDA(At, 0, 1); PG8_STAGE(PG8_SA(0, 0), a2, voffA);
            PG8_BAR; PG8_WAIT_L(0); PG8_MMA(1, 0, At, B0); PG8_BAR; PG8_SCHED;
            PG8_STAGE(PG8_SB(0, 1), b2 + hstep, voffB);
            PG8_WAIT_V(6); PG8_BAR; PG8_MMA(1, 1, At, B1); PG8_BAR;
            PG8_LDB(B0, 1, 0); PG8_SCHED; PG8_LDA(At, 1, 0); PG8_STAGE(PG8_SA(0, 1), a2 + hstepA, voffA);
            PG8_WAIT_L(8); PG8_BAR; PG8_WAIT_L(0); PG8_MMA(0, 0, At, B0); PG8_BAR; PG8_SCHED;
            PG8_LDB(B1, 1, 1); PG8_STAGE(PG8_SB(1, 0), b3, voffB);
            PG8_BAR; PG8_WAIT_L(0); PG8_MMA(0, 1, At, B1); PG8_BAR;
            PG8_LDA(At, 1, 1); PG8_STAGE(PG8_SA(1, 0), a3, voffA);
            PG8_BAR; PG8_WAIT_L(0); PG8_MMA(1, 0, At, B0); PG8_BAR; PG8_SCHED;
            PG8_STAGE(PG8_SB(1, 1), b3 + hstep, voffB);
            PG8_WAIT_V(6); PG8_BAR; PG8_MMA(1, 1, At, B1); PG8_BAR;
        }
        E(acc, cur, wr, wc, fr, fq);
        if (!has_next) break;
#pragma unroll
        for (int a = 0; a < 2; ++a)
#pragma unroll
            for (int b = 0; b < 2; ++b)
#pragma unroll
                for (int m = 0; m < 4; ++m)
#pragma unroll
                    for (int n = 0; n < 2; ++n) acc[a][b][m][n] = (f32x4){0.f, 0.f, 0.f, 0.f};
        cur = nxt; cA = nA; cB = nB; ++ui;
    }
    PG8_WAIT_V(0);
    if (wr == 0) PG8_BAR;
    PG8_BAR;
#undef PG8_SA
#undef PG8_SB
#undef PG8_STAGE
#undef PG8_LDA
#undef PG8_LDB
#undef PG8_MMA
#undef PG8_WAIT_V
#undef PG8_WAIT_L
#undef PG8_BAR
#undef PG8_SCHED
}
}
using pg8::Unit;

struct Epi1 {
    static constexpr bool PERM = true;
    bf16_t* QKV; bf16_t* SZA; bf16_t* UU; bf16_t* SZB; float* BA; bf16_t* HALO;
    __device__ __forceinline__ void operator()(const f32x4 (&acc)[2][2][4][2], const Unit& u, int wr, int wc, int fr_, int fq_) const {
        int lane = (int)(threadIdx.x & 63); asm volatile("" : "+v"(lane));
        const int fr = lane & 15, fq = lane >> 4; (void)fr_; (void)fq_;
        const int row0 = u.pm * 256 + wr * 64 + fr, pn = u.pn;
#pragma unroll
        for (int ai = 0; ai < 2; ++ai)
#pragma unroll
            for (int m = 0; m < 4; ++m) {
                const size_t row = (size_t)(row0 + ai * 128 + m * 16);
#pragma unroll
                for (int bj = 0; bj < 2; ++bj) {
                    const int colt = 128 * bj + 32 * wc + 8 * fq;
                    f32x4 v0 = acc[ai][bj][m][0], v1 = acc[ai][bj][m][1];
                    if (pn < 12) {
                        const int c = pn * 256 + colt; const u32x4 pk = pack8(v0, v1);
                        *(u32x4*)(QKV + row * 3072 + c) = pk;
                        if (m == 3 && fr >= 13) *(u32x4*)(HALO + ((row >> 6) * 3 + (fr - 13)) * 3072 + c) = pk;
                    } else if (pn < 16) {
#pragma unroll
                        for (int e = 0; e < 4; ++e) { v0[e] = siluf_(v0[e]); v1[e] = siluf_(v1[e]); }
                        *(u32x4*)(SZA + row * 1024 + (pn - 12) * 256 + colt) = pack8(v0, v1);
                    } else if (pn < 20) {
                        *(u32x4*)(UU + row * 1024 + (pn - 16) * 256 + colt) = pack8(v0, v1);
                    } else if (pn < 24) {
#pragma unroll
                        for (int e = 0; e < 4; ++e) { v0[e] = siluf_(v0[e]); v1[e] = siluf_(v1[e]); }
                        *(u32x4*)(SZB + row * 1024 + (pn - 20) * 256 + colt) = pack8(v0, v1);
                    } else if (colt < 16) {
                        *(f32x4*)(BA + row * 16 + colt) = v0; *(f32x4*)(BA + row * 16 + colt + 4) = v1;
                    }
                }
            }
    }
};
struct EpiGlu {
    static constexpr bool PERM = true;
    const bf16_t* Y5; bf16_t* SZB;
    __device__ __forceinline__ void operator()(const f32x4 (&acc)[2][2][4][2], const Unit& u, int wr, int wc, int fr, int fq) const {
        const int row0 = u.pm * 256 + wr * 64 + fr;
#pragma unroll
        for (int ai = 0; ai < 2; ++ai)
#pragma unroll
            for (int m = 0; m < 4; ++m) {
                const size_t row = (size_t)(row0 + ai * 128 + m * 16);
#pragma unroll
                for (int bj = 0; bj < 2; ++bj) {
                    const int c = u.pn * 256 + 128 * bj + 32 * wc + 8 * fq;
                    const u32x4 y = *(const u32x4*)(Y5 + row * 1024 + c), z = *(const u32x4*)(SZB + row * 1024 + c);
                    const f32x4 a0 = acc[ai][bj][m][0], a1 = acc[ai][bj][m][1];
                    u32x4 o;
                    o.x = pk2(lo2f(y.x) * sigmoidf_(a0[0]) * lo2f(z.x), hi2f(y.x) * sigmoidf_(a0[1]) * hi2f(z.x));
                    o.y = pk2(lo2f(y.y) * sigmoidf_(a0[2]) * lo2f(z.y), hi2f(y.y) * sigmoidf_(a0[3]) * hi2f(z.y));
                    o.z = pk2(lo2f(y.z) * sigmoidf_(a1[0]) * lo2f(z.z), hi2f(y.z) * sigmoidf_(a1[1]) * hi2f(z.z));
                    o.w = pk2(lo2f(y.w) * sigmoidf_(a1[2]) * lo2f(z.w), hi2f(y.w) * sigmoidf_(a1[3]) * hi2f(z.w));
                    *(u32x4*)(SZB + row * 1024 + c) = o;
                }
            }
    }
};
struct EpiF32 {
    static constexpr bool PERM = false;
    float* C;
    __device__ __forceinline__ void operator()(const f32x4 (&acc)[2][2][4][2], const Unit& u, int wr, int wc, int fr, int fq) const {
        const int row0 = u.pm * 256 + wr * 64 + fr, col0 = u.pn * 256 + wc * 32 + 4 * fq;
#pragma unroll
        for (int ai = 0; ai < 2; ++ai)
#pragma unroll
            for (int m = 0; m < 4; ++m) { float* rowp = C + (size_t)(row0 + ai * 128 + m * 16) * 1024 + col0;
#pragma unroll
                for (int bj = 0; bj < 2; ++bj)
#pragma unroll
                    for (int n = 0; n < 2; ++n) *(f32x4*)(rowp + bj * 128 + n * 16) = acc[ai][bj][m][n]; }
    }
};
struct EpiB16 {
    static constexpr bool PERM = true;
    bf16_t* C;
    __device__ __forceinline__ void operator()(const f32x4 (&acc)[2][2][4][2], const Unit& u, int wr, int wc, int fr, int fq) const {
        const int row0 = u.pm * 256 + wr * 64 + fr, col0 = u.pn * 256 + wc * 32 + 8 * fq;
#pragma unroll
        for (int ai = 0; ai < 2; ++ai)
#pragma unroll
            for (int m = 0; m < 4; ++m) { bf16_t* rowp = C + (size_t)(row0 + ai * 128 + m * 16) * 1024 + col0;
#pragma unroll
                for (int bj = 0; bj < 2; ++bj) *(u32x4*)(rowp + bj * 128) = pack8(acc[ai][bj][m][0], acc[ai][bj][m][1]); }
    }
};
struct Epi2 {
    static constexpr bool PERM = false;
    bf16_t* P; bf16_t* Q;
    __device__ __forceinline__ void operator()(const f32x4 (&acc)[2][2][4][2], const Unit& u, int wr, int wc, int fr, int fq) const {
        const int row0 = u.pm * 256 + wr * 64 + fr, ch = u.pn * 64 + 16 * wc + 4 * fq;
#pragma unroll
        for (int ai = 0; ai < 2; ++ai)
#pragma unroll
            for (int m = 0; m < 4; ++m) {
                const size_t row = (size_t)(row0 + ai * 128 + m * 16);
                const f32x4 gb = acc[ai][0][m][0], gc = acc[ai][0][m][1], hv = acc[ai][1][m][0], z = acc[ai][1][m][1];
                u32x2 pp, qq;
                pp.x = pk2(gc[0] * hv[0], gc[1] * hv[1]); pp.y = pk2(gc[2] * hv[2], gc[3] * hv[3]);
                qq.x = pk2(gb[0] * siluf_(z[0]), gb[1] * siluf_(z[1])); qq.y = pk2(gb[2] * siluf_(z[2]), gb[3] * siluf_(z[3]));
                *(u32x2*)(P + row * 2048 + ch) = pp; *(u32x2*)(Q + row * 2048 + ch) = qq;
            }
    }
};

__device__ __forceinline__ int src_col(int mode, int n, int& pn_unused) {
    (void)pn_unused;
    if (mode == 0) return n;
    if (mode == 1) { if (n < 4096) return n; if (n < 6144) return n + 16; if (n < 6160) return n - 2048; return -1; }
    const int pn = n >> 8, col = n & 255, bj = col >> 7, wc = (col >> 5) & 3, nn = (col >> 4) & 1, lo = col & 15;
    return (2 * bj + nn) * 2048 + pn * 64 + 16 * wc + lo;
}
__device__ __forceinline__ void phase_convert(const Prm& p, unsigned char* lds, int t_begin, int t_end, int nblk, int bidx) {
    float* tile = (float*)lds;
    const int tid = threadIdx.x;
    for (int tix = t_begin + bidx; tix < t_end; tix += nblk) {
        int tl = tix, K, Nsrc, mode; const float* W; bf16_t* Wt;
        if (tl < 1600) { W = p.in[3]; Wt = (bf16_t*)(p.ws + OFF_WT1); K = 1024; Nsrc = 6160; mode = 1; }
        else if ((tl -= 1600) < 256) { W = p.in[16]; Wt = (bf16_t*)(p.ws + OFF_WTG); K = 1024; Nsrc = 1024; mode = 0; }
        else if ((tl -= 256) < 512) { W = p.in[17]; Wt = (bf16_t*)(p.ws + OFF_WTO0); K = 2048; Nsrc = 1024; mode = 0; }
        else if ((tl -= 512) < 2048) { W = p.in[18]; Wt = (bf16_t*)(p.ws + OFF_WT2); K = 1024; Nsrc = 8192; mode = 2; }
        else { tl -= 2048; W = p.in[20]; Wt = (bf16_t*)(p.ws + OFF_WTO1); K = 2048; Nsrc = 1024; mode = 0; }
        const int ntk = K / 64, n0 = (tl / ntk) * 64, k0 = (tl % ntk) * 64;
        { const int j = tid & 63; int dummy = 0; const int sc = src_col(mode, n0 + j, dummy);
#pragma unroll
          for (int i = 0; i < 8; ++i) { const int k = (tid >> 6) + 8 * i; tile[k * 65 + j] = sc >= 0 ? W[(size_t)(k0 + k) * Nsrc + sc] : 0.0f; } }
        __syncthreads();
        { const int r = tid >> 3, c8 = (tid & 7) * 8; u32x4 o;
          o.x = pk2(tile[(c8 + 0) * 65 + r], tile[(c8 + 1) * 65 + r]); o.y = pk2(tile[(c8 + 2) * 65 + r], tile[(c8 + 3) * 65 + r]);
          o.z = pk2(tile[(c8 + 4) * 65 + r], tile[(c8 + 5) * 65 + r]); o.w = pk2(tile[(c8 + 6) * 65 + r], tile[(c8 + 7) * 65 + r]);
          *(u32x4*)(Wt + (size_t)(n0 + r) * K + k0 + c8) = o; }
        __syncthreads();
    }
}
__device__ __forceinline__ void phase_rmsnorm_x(const float* x, const float* w, bf16_t* H) {
    const int lane = threadIdx.x & 63, nw = gridDim.x * 8;
    for (int row = blockIdx.x * 8 + (threadIdx.x >> 6); row < TOK; row += nw) {
        const f32x4* xr = (const f32x4*)(x + (size_t)row * 1024);
        f32x4 v[4]; float ss = 0.f;
#pragma unroll
        for (int i = 0; i < 4; ++i) { v[i] = xr[lane + 64 * i]; ss += v[i][0] * v[i][0] + v[i][1] * v[i][1] + v[i][2] * v[i][2] + v[i][3] * v[i][3]; }
        ss = wave_sum(ss);
        const float rstd = rsqrtf(ss * (1.0f / 1024.0f) + 1e-6f);
#pragma unroll
        for (int i = 0; i < 4; ++i) { const f32x4 w4 = ((const f32x4*)w)[lane + 64 * i]; u32x2 o;
            o.x = pk2(v[i][0] * rstd * w4[0], v[i][1] * rstd * w4[1]); o.y = pk2(v[i][2] * rstd * w4[2], v[i][3] * rstd * w4[3]);
            *(u32x2*)(H + (size_t)row * 1024 + (lane + 64 * i) * 4) = o; }
    }
}
template <bool NEXT>
__device__ __forceinline__ void phase_post(const float* base, const bf16_t* Y, const float* wpost, float* OUT, const float* wpre, bf16_t* H) {
    const int lane = threadIdx.x & 63, nw = gridDim.x * 8;
    for (int row = blockIdx.x * 8 + (threadIdx.x >> 6); row < TOK; row += nw) {
        const u32x2* yr = (const u32x2*)(Y + (size_t)row * 1024); const f32x4* br = (const f32x4*)(base + (size_t)row * 1024);
        f32x4 v[4], xb[4]; float ss = 0.f;
#pragma unroll
        for (int i = 0; i < 4; ++i) { const u32x2 y2 = yr[lane + 64 * i]; v[i] = (f32x4){lo2f(y2.x), hi2f(y2.x), lo2f(y2.y), hi2f(y2.y)}; xb[i] = br[lane + 64 * i]; ss += v[i][0] * v[i][0] + v[i][1] * v[i][1] + v[i][2] * v[i][2] + v[i][3] * v[i][3]; }
        ss = wave_sum(ss);
        const float rstd = rsqrtf(ss * (1.0f / 1024.0f) + 1e-6f);
        float s2 = 0.f;
#pragma unroll
        for (int i = 0; i < 4; ++i) { const f32x4 w4 = ((const f32x4*)wpost)[lane + 64 * i];
#pragma unroll
            for (int e = 0; e < 4; ++e) { v[i][e] = xb[i][e] + v[i][e] * rstd * w4[e]; s2 += v[i][e] * v[i][e]; }
            ((f32x4*)(OUT + (size_t)row * 1024))[lane + 64 * i] = v[i]; }
        if (NEXT) {
            s2 = wave_sum(s2);
            const float r2 = rsqrtf(s2 * (1.0f / 1024.0f) + 1e-6f);
#pragma unroll
            for (int i = 0; i < 4; ++i) { const f32x4 w4 = ((const f32x4*)wpre)[lane + 64 * i]; u32x2 o;
                o.x = pk2(v[i][0] * r2 * w4[0], v[i][1] * r2 * w4[1]); o.y = pk2(v[i][2] * r2 * w4[2], v[i][3] * r2 * w4[3]);
                *(u32x2*)(H + (size_t)row * 1024 + (lane + 64 * i) * 4) = o; }
        }
    }
}


__device__ __forceinline__ void phase_ba(const Prm& p, unsigned char* lds) {
    const int tid = threadIdx.x, wv = tid >> 6, lane = tid & 63, n = lane & 15, kq = lane >> 4, mt = wv & 3, kh = wv >> 2;
    const bf16_t* H = (const bf16_t*)(p.ws + OFF_H); const bf16_t* Wb = (const bf16_t*)(p.ws + OFF_WT1) + (size_t)6144 * 1024; float* BA = (float*)(p.ws + OFF_BA);
    const size_t row0 = (size_t)blockIdx.x * 64 + 16 * mt;
    const bf16_t* ap = H + (row0 + n) * 1024 + 512 * kh + 8 * kq; const bf16_t* bp = Wb + (size_t)n * 1024 + 512 * kh + 8 * kq;
    bf16x8 a[16], b[16];
#pragma unroll
    for (int i = 0; i < 16; ++i) { a[i] = *(const bf16x8*)(ap + i * 32); b[i] = *(const bf16x8*)(bp + i * 32); }
    f32x4 acc = (f32x4){0.f, 0.f, 0.f, 0.f};
#pragma unroll
    for (int i = 0; i < 16; ++i) acc = __builtin_amdgcn_mfma_f32_16x16x32_bf16(a[i], b[i], acc, 0, 0, 0);
    float* part = (float*)lds;
#pragma unroll
    for (int j = 0; j < 4; ++j) part[(kh * 64 + 16 * mt + 4 * kq + j) * 16 + n] = acc[j];
    __syncthreads();
    for (int i = tid; i < 1024; i += 512) BA[(size_t)blockIdx.x * 1024 + i] = part[i] + part[1024 + i];
    __syncthreads();
}
__device__ __forceinline__ void sincos_d(double x, double& s, double& c) {
    const double k = rint(x * 0.6366197723675814);
    const double r = fma(-k, 6.123233995736766e-17, fma(-k, 1.5707963267948966, x)), r2 = r * r;
    double sp = -7.647163731819816e-13; sp = fma(sp, r2, 1.6059043836821613e-10); sp = fma(sp, r2, -2.505210838544172e-8); sp = fma(sp, r2, 2.7557319223985893e-6);
    sp = fma(sp, r2, -1.984126984126984e-4); sp = fma(sp, r2, 8.333333333333333e-3); sp = fma(sp, r2, -1.6666666666666666e-1); sp = fma(sp * r2, r, r);
    double cp = 4.779477332387385e-14; cp = fma(cp, r2, -1.1470745597729725e-11); cp = fma(cp, r2, 2.08767569878681e-9); cp = fma(cp, r2, -2.755731922398589e-7);
    cp = fma(cp, r2, 2.48015873015873e-5); cp = fma(cp, r2, -1.388888888888889e-3); cp = fma(cp, r2, 4.1666666666666664e-2); cp = fma(cp, r2, -0.5); cp = fma(cp, r2, 1.0);
    const int q = ((int)k) & 3;
    const double s0 = (q & 1) ? cp : sp, c0 = (q & 1) ? sp : cp;
    s = (q & 2) ? -s0 : s0; c = ((q + 1) & 2) ? -c0 : c0;
}
__device__ __forceinline__ double exp_d(double x) {
    const double n = rint(x * 1.4426950408889634);
    const double r = fma(-n, 2.3190468138462996e-17, fma(-n, 0.6931471805599453, x));
    double p = 1.6059043836821613e-10; p = fma(p, r, 2.08767569878681e-9); p = fma(p, r, 2.505210838544172e-8); p = fma(p, r, 2.755731922398589e-7); p = fma(p, r, 2.7557319223985893e-6);
    p = fma(p, r, 2.48015873015873e-5); p = fma(p, r, 1.984126984126984e-4); p = fma(p, r, 1.388888888888889e-3); p = fma(p, r, 8.333333333333333e-3); p = fma(p, r, 4.1666666666666664e-2);
    p = fma(p, r, 1.6666666666666666e-1); p = fma(p, r, 0.5); p = fma(p, r, 1.0); p = fma(p, r, 1.0);
    return ldexp(p, (int)n);
}
__device__ __forceinline__ float bcast_lo(float v) { auto r = __builtin_amdgcn_permlane32_swap(__float_as_uint(v), __float_as_uint(v), false, false); return __uint_as_float(r[0]); }
__device__ __forceinline__ float bcast_hi(float v) { auto r = __builtin_amdgcn_permlane32_swap(__float_as_uint(v), __float_as_uint(v), false, false); return __uint_as_float(r[1]); }

struct S5C {
    float ar[2][4], ai[2][4];
    float a512r[2], a512i[2];
    bf16x8 BB[4];
    bf16x8 CC[4];
    float dco;
};

template <bool OUT>
__device__ __forceinline__ void s5_chunk(const S5C& C, bf16_t* UU, int b, int g, int chunk, float (&st)[2][2], bf16_t* sX, int lane) {
    const int n = lane & 31, hh = lane >> 5, fr = lane & 15, fq = lane >> 4;
    const size_t tok0 = (size_t)b * SEQ + (size_t)chunk * 512;
    bf16x8 ua = *(const bf16x8*)(UU + (tok0 + n) * 1024 + 16 * g + 8 * hh);
    bf16_t uo[8];
    if (OUT) {
#pragma unroll
        for (int mt = 0; mt < 2; ++mt)
#pragma unroll
            for (int j = 0; j < 4; ++j) uo[mt * 4 + j] = UU[(tok0 + 16 * mt + 4 * fq + j) * 1024 + 16 * g + fr];
    }
    for (int blk = 0; blk < 16; ++blk) {
        const size_t t0 = tok0 + (size_t)blk * 32;
        const bf16x8 ucur = ua;
        bf16_t ucuro[8];
        if (OUT) {
#pragma unroll
            for (int i = 0; i < 8; ++i) ucuro[i] = uo[i];
        }
        if (blk < 15) {
            ua = *(const bf16x8*)(UU + (t0 + 32 + n) * 1024 + 16 * g + 8 * hh);
            if (OUT) {
#pragma unroll
                for (int mt = 0; mt < 2; ++mt)
#pragma unroll
                    for (int j = 0; j < 4; ++j) uo[mt * 4 + j] = UU[(t0 + 32 + 16 * mt + 4 * fq + j) * 1024 + 16 * g + fr];
            }
        }
        f32x16 acc[4];
#pragma unroll
        for (int tl = 0; tl < 4; ++tl) {
            f32x16 z;
#pragma unroll
            for (int i = 0; i < 16; ++i) z[i] = 0.f;
            acc[tl] = __builtin_amdgcn_mfma_f32_32x32x16_bf16(ucur, C.BB[tl], z, 0, 0, 0);
        }
#pragma unroll
        for (int tp = 0; tp < 2; ++tp) {
            f32x16& re = acc[2 * tp]; f32x16& im = acc[2 * tp + 1];
            const float a1r = C.ar[tp][0], a1i = C.ai[tp][0];
#pragma unroll
            for (int q = 0; q < 4; ++q)
#pragma unroll
                for (int r = 1; r < 4; ++r) {
                    const float pr = re[4 * q + r - 1], pi = im[4 * q + r - 1];
                    re[4 * q + r] = __builtin_fmaf(-a1i, pi, __builtin_fmaf(a1r, pr, re[4 * q + r])); im[4 * q + r] = __builtin_fmaf(a1i, pr, __builtin_fmaf(a1r, pi, im[4 * q + r]));
                }
            float cr = st[tp][0], ci = st[tp][1];
            const float a4r = C.ar[tp][3], a4i = C.ai[tp][3];
#pragma unroll
            for (int q = 0; q < 4; ++q) {
                const float tr = __builtin_fmaf(-a4i, ci, __builtin_fmaf(a4r, cr, re[4 * q + 3])), ti = __builtin_fmaf(a4i, cr, __builtin_fmaf(a4r, ci, im[4 * q + 3]));
                const float o0r = bcast_lo(tr), o0i = bcast_lo(ti);
                const float xr = hh ? o0r : cr, xi = hh ? o0i : ci;
                if (OUT) {
#pragma unroll
                    for (int r = 0; r < 4; ++r) { const float kr = C.ar[tp][r], ki = C.ai[tp][r];
                        re[4 * q + r] = __builtin_fmaf(-ki, xi, __builtin_fmaf(kr, xr, re[4 * q + r])); im[4 * q + r] = __builtin_fmaf(ki, xr, __builtin_fmaf(kr, xi, im[4 * q + r])); }
                } else {
                    re[4 * q + 3] = __builtin_fmaf(-a4i, xi, __builtin_fmaf(a4r, xr, re[4 * q + 3])); im[4 * q + 3] = __builtin_fmaf(a4i, xr, __builtin_fmaf(a4r, xi, im[4 * q + 3]));
                }
                cr = bcast_hi(re[4 * q + 3]); ci = bcast_hi(im[4 * q + 3]);
            }
            st[tp][0] = cr; st[tp][1] = ci;
        }
        if (OUT) {
            asm volatile("s_waitcnt lgkmcnt(0)" ::: "memory");
#pragma unroll
            for (int tp = 0; tp < 2; ++tp)
#pragma unroll
                for (int i = 0; i < 16; ++i) {
                    const int t = 8 * (i >> 2) + 4 * hh + (i & 3);
                    *(unsigned*)(sX + t * 136 + 2 * (n + 32 * tp)) = pk2(acc[2 * tp][i], acc[2 * tp + 1][i]);
                }
            asm volatile("s_waitcnt lgkmcnt(0)" ::: "memory");
            __builtin_amdgcn_wave_barrier();
#pragma unroll
            for (int mt = 0; mt < 2; ++mt) {
                f32x4 y = (f32x4){0.f, 0.f, 0.f, 0.f};
#pragma unroll
                for (int ks = 0; ks < 4; ++ks) {
                    const bf16x8 xa = *(const bf16x8*)(sX + (16 * mt + fr) * 136 + 32 * ks + 8 * fq);
                    y = __builtin_amdgcn_mfma_f32_16x16x32_bf16(xa, C.CC[ks], y, 0, 0, 0);
                }
#pragma unroll
                for (int j = 0; j < 4; ++j) {
                    float v = y[j] + C.dco * bf2f(ucuro[mt * 4 + j]);
                    const float inner = 0.7978845608028654f * (v + 0.044715f * v * v * v);
                    v = v / (1.0f + __expf(-2.0f * inner));
                    UU[(t0 + 16 * mt + 4 * fq + j) * 1024 + 16 * g + fr] = f2bf(v);
                }
            }
            asm volatile("s_waitcnt lgkmcnt(0)" ::: "memory");
            __builtin_amdgcn_wave_barrier();
        }
    }
}

__device__ __forceinline__ void phase_s5(const Prm& p, unsigned char* lds, int bg) {
    const int b = bg >> 6, g = bg & 63;
    const int tid = threadIdx.x, wv = tid >> 6, lane = tid & 63, n = lane & 31, hh = lane >> 5, fr = lane & 15, fq = lane >> 4;
    bf16_t* sX = (bf16_t*)(lds + wv * 8704);
    float* sXE = (float*)(lds + 8 * 8704);
    bf16_t* UU = (bf16_t*)(p.ws + OFF_UU);
    const float* lam_re = p.in[8]; const float* lam_im = p.in[9]; const float* b_re = p.in[10]; const float* b_im = p.in[11];
    const float* c_re = p.in[12]; const float* c_im = p.in[13];
    S5C C;
    const double dt = exp_d((double)p.in[14][g]);
    float fre[2], fim[2];
#pragma unroll
    for (int tp = 0; tp < 2; ++tp) {
        const int pp = n + 32 * tp;
        const double lr = (double)fminf(lam_re[g * 64 + pp], -1e-4f), li = (double)lam_im[g * 64 + pp];
#pragma unroll
        for (int k = 0; k < 4; ++k) { double sn, cs; sincos_d(li * dt * (k + 1), sn, cs); const double mag = exp_d(lr * dt * (k + 1)); C.ar[tp][k] = (float)(mag * cs); C.ai[tp][k] = (float)(mag * sn); }
        { double sn, cs; sincos_d(li * dt * 512.0, sn, cs); const double mag = exp_d(lr * dt * 512.0); C.a512r[tp] = (float)(mag * cs); C.a512i[tp] = (float)(mag * sn); }
        double sn, cs; sincos_d(li * dt, sn, cs);
        const double mag = exp_d(lr * dt), abr = mag * cs, abi = mag * sn;
        const double den = lr * lr + li * li, nr = abr - 1.0, ni = abi;
        fre[tp] = (float)((nr * lr + ni * li) / den); fim[tp] = (float)((ni * lr - nr * li) / den);
    }
#pragma unroll
    for (int tl = 0; tl < 4; ++tl) {
        const int tp = tl >> 1, ri = tl & 1, pp = n + 32 * tp;
#pragma unroll
        for (int j = 0; j < 8; ++j) {
            const int ch = 8 * hh + j;
            const float br = b_re[(g * 64 + pp) * 16 + ch], bi = b_im[(g * 64 + pp) * 16 + ch];
            const float v = ri == 0 ? fre[tp] * br - fim[tp] * bi : fre[tp] * bi + fim[tp] * br;
            C.BB[tl][j] = (short)f2bf(v);
        }
    }
#pragma unroll
    for (int ks = 0; ks < 4; ++ks)
#pragma unroll
        for (int j = 0; j < 8; ++j) {
            const int k = 32 * ks + 8 * fq + j, pp = k >> 1, ri = k & 1;
            const float v = ri == 0 ? c_re[(g * 16 + fr) * 64 + pp] : -c_im[(g * 16 + fr) * 64 + pp];
            C.CC[ks][j] = (short)f2bf(v);
        }
    C.dco = p.in[15][16 * g + fr];
    for (int rd = 0; rd < 2; ++rd) {
        const int chunk = wv + 8 * rd;
        float st[2][2] = {{0.f, 0.f}, {0.f, 0.f}};
        s5_chunk<false>(C, UU, b, g, chunk, st, sX, lane);
        if (hh == 0) {
#pragma unroll
            for (int tp = 0; tp < 2; ++tp) { sXE[(chunk * 64 + n + 32 * tp) * 2 + 0] = st[tp][0]; sXE[(chunk * 64 + n + 32 * tp) * 2 + 1] = st[tp][1]; }
        }
    }
    __syncthreads();
    for (int rd = 0; rd < 2; ++rd) {
        const int chunk = wv + 8 * rd;
        float st[2][2] = {{0.f, 0.f}, {0.f, 0.f}};
        for (int c2 = 0; c2 < chunk; ++c2) {
#pragma unroll
            for (int tp = 0; tp < 2; ++tp) {
                const float er = sXE[(c2 * 64 + n + 32 * tp) * 2 + 0], ei = sXE[(c2 * 64 + n + 32 * tp) * 2 + 1];
                const float nr = C.a512r[tp] * st[tp][0] - C.a512i[tp] * st[tp][1] + er, ni = C.a512r[tp] * st[tp][1] + C.a512i[tp] * st[tp][0] + ei;
                st[tp][0] = nr; st[tp][1] = ni;
            }
        }
        s5_chunk<true>(C, UU, b, g, chunk, st, sX, lane);
        if (rd == 0) {
            asm volatile("s_waitcnt vmcnt(0)" ::: "memory");
            __syncthreads();
            if (threadIdx.x == 0) { __builtin_amdgcn_fence(__ATOMIC_RELEASE, "agent"); asm volatile("s_waitcnt vmcnt(0)" ::: "memory");
                __hip_atomic_fetch_add((unsigned*)(p.ws + OFF_BAR) + 3900, 1u, __ATOMIC_RELAXED, __HIP_MEMORY_SCOPE_AGENT); }
        }
    }
    __syncthreads();
}

__device__ __forceinline__ void phase_gdn_prep(const Prm& p, unsigned char* lds, int it0, int nrounds) {
    const int tid0 = threadIdx.x, hb = tid0 >> 8;
    unsigned char* base = lds + hb * 76800;
    bf16_t* sQ = (bf16_t*)base;
    bf16_t* sK = (bf16_t*)(base + 17408);
    bf16_t* sV = (bf16_t*)(base + 2 * 17408);
    float* sL = (float*)(base + 3 * 17408);
    float* sBeta = (float*)(base + 4 * 17408);
    float* sGc = sBeta + 64; float* sEg = sGc + 64; float* sBE = sEg + 64;
    float* sCW = sBE + 64;
    bf16_t* QKV = (bf16_t*)(p.ws + OFF_QKV); const bf16_t* HALO = (const bf16_t*)(p.ws + OFF_HALO);
    const float* BA = (const float*)(p.ws + OFF_BA); float* GL = (float*)(p.ws + OFF_GL);
    bf16_t* WB = (bf16_t*)(p.ws + OFF_WB); bf16_t* ATT = (bf16_t*)(p.ws + OFF_ATT);
    const float* convw = p.in[4];
    for (int rd = 0; rd < nrounds; ++rd) {
        int tid = tid0; asm volatile("" : "+v"(tid));
        const int ht = tid & 255, hw = (tid >> 6) & 3, lane = tid & 63, fr = lane & 15, fq = lane >> 4;
        const int it = it0 + rd * 2 + hb;
        const int b = it >> 10, h = (it >> 7) & 7, nc = it & 127;
        const size_t tokb = (size_t)b * SEQ + (size_t)nc * 64;
#pragma unroll
        for (int i = 0; i < 6; ++i) { const int idx = ht + 256 * i, s3 = idx >> 9, tap = (idx >> 7) & 3, ch = idx & 127; sCW[idx] = convw[tap * 3072 + s3 * 1024 + h * 128 + ch]; }
        __syncthreads();
        {
            const int t0 = (ht >> 4) * 4, cgp = ht & 15;
            u32x4 xall[3][7];
#pragma unroll
            for (int s = 0; s < 3; ++s) {
                const int col = s * 1024 + h * 128 + cgp * 8;
#pragma unroll
                for (int i = 0; i < 7; ++i) {
                    const int tt = t0 - 3 + i;
                    xall[s][i] = (u32x4){0u, 0u, 0u, 0u};
                    if (tt >= 0) xall[s][i] = *(const u32x4*)(QKV + (tokb + tt) * 3072 + col);
                    else if (nc > 0) xall[s][i] = *(const u32x4*)(HALO + ((size_t)(b * 128 + nc - 1) * 3 + (3 + tt)) * 3072 + col);
                }
            }
#pragma unroll
            for (int s = 0; s < 3; ++s) {
                u32x4 xr[7];
#pragma unroll
                for (int i = 0; i < 7; ++i) xr[i] = xall[s][i];
                f32x4 w0[4], w1[4];
#pragma unroll
                for (int j = 0; j < 4; ++j) { w0[j] = *(const f32x4*)(sCW + s * 512 + j * 128 + cgp * 8); w1[j] = *(const f32x4*)(sCW + s * 512 + j * 128 + cgp * 8 + 4); }
                float o[4][8], ss[4];
#pragma unroll
                for (int tk = 0; tk < 4; ++tk) {
                    float a[8];
#pragma unroll
                    for (int e = 0; e < 8; ++e) a[e] = 0.f;
#pragma unroll
                    for (int j = 0; j < 4; ++j) {
                        const u32x4 xv = xr[tk + j];
                        a[0] += w0[j][0] * lo2f(xv.x); a[1] += w0[j][1] * hi2f(xv.x); a[2] += w0[j][2] * lo2f(xv.y); a[3] += w0[j][3] * hi2f(xv.y);
                        a[4] += w1[j][0] * lo2f(xv.z); a[5] += w1[j][1] * hi2f(xv.z); a[6] += w1[j][2] * lo2f(xv.w); a[7] += w1[j][3] * hi2f(xv.w);
                    }
                    float acc2 = 0.f;
#pragma unroll
                    for (int e = 0; e < 8; ++e) { const float v = siluf_(a[e]); o[tk][e] = v; acc2 += v * v; }
                    ss[tk] = acc2;
                }
                bf16_t* dst = (s == 0 ? sQ : (s == 1 ? sK : sV)) + t0 * 136 + cgp * 8;
#pragma unroll
                for (int tk = 0; tk < 4; ++tk) {
                    float sc = 1.0f;
                    if (s < 2) { float q = ss[tk]; q += __shfl_xor(q, 1); q += __shfl_xor(q, 2); q += __shfl_xor(q, 4); q += __shfl_xor(q, 8); sc = rsqrtf(q + 1e-6f) * (s == 0 ? 0.08838834764831845f : 1.0f); }
                    u32x4 pk;
                    pk.x = pk2(o[tk][0] * sc, o[tk][1] * sc); pk.y = pk2(o[tk][2] * sc, o[tk][3] * sc); pk.z = pk2(o[tk][4] * sc, o[tk][5] * sc); pk.w = pk2(o[tk][6] * sc, o[tk][7] * sc);
                    *(u32x4*)(dst + tk * 136) = pk;
                }
            }
        }
        if (hw == 0) {
            const size_t tg = tokb + lane;
            const float braw = BA[tg * 16 + h], araw = BA[tg * 16 + 8 + h];
            const float beta = 1.0f / (1.0f + expf(-braw));
            const float xx = araw + p.in[6][h];
            const float sp = xx > 20.f ? xx : log1pf(expf(xx));
            float gg = -expf(p.in[5][h]) * sp;
#pragma unroll
            for (int off = 1; off < 64; off <<= 1) { const float o = __shfl_up(gg, off); if (lane >= off) gg += o; }
            sBeta[lane] = beta; sGc[lane] = gg; sEg[lane] = expf(gg); sBE[lane] = beta * expf(gg);
            if (lane == 63) GL[it] = expf(gg);
        }
        __syncthreads();
        {
            bf16x8 aK[4], aQ[4];
#pragma unroll
            for (int ks = 0; ks < 4; ++ks) { aK[ks] = *(const bf16x8*)(sK + (16 * hw + fr) * 136 + 32 * ks + 8 * fq); aQ[ks] = *(const bf16x8*)(sQ + (16 * hw + fr) * 136 + 32 * ks + 8 * fq); }
#pragma unroll
            for (int nt = 0; nt < 4; ++nt) {
                f32x4 kk = (f32x4){0.f, 0.f, 0.f, 0.f}, qk = (f32x4){0.f, 0.f, 0.f, 0.f};
#pragma unroll
                for (int ks = 0; ks < 4; ++ks) {
                    const bf16x8 bK = *(const bf16x8*)(sK + (16 * nt + fr) * 136 + 32 * ks + 8 * fq);
                    kk = __builtin_amdgcn_mfma_f32_16x16x32_bf16(aK[ks], bK, kk, 0, 0, 0);
                    qk = __builtin_amdgcn_mfma_f32_16x16x32_bf16(aQ[ks], bK, qk, 0, 0, 0);
                }
                const int mcol = 16 * nt + fr; const float gm = sGc[mcol];
#pragma unroll
                for (int j = 0; j < 4; ++j) {
                    const int c = 16 * hw + 4 * fq + j;
                    const float dec = __expf(fminf(sGc[c] - gm, 0.f));
                    sL[c * 68 + mcol] = (mcol < c) ? kk[j] * sBeta[c] * dec : 0.f;
                    ATT[(size_t)it * 4096 + c * 64 + mcol] = f2bf((mcol <= c) ? qk[j] * dec : 0.f);
                }
            }
        }
        __syncthreads();
        {
            f32x2_t xv[32];
#define X_(i) (xv[(i) >> 1][(i) & 1])
            const bool isU = ht < 128; const int jc = ht & 127;
            const bf16_t* src = isU ? sV : sK;
            const float* fac = isU ? sBeta : sBE;
#pragma unroll
            for (int cb = 0; cb < 16; ++cb) {
                f32x2_t a2[4];
#pragma unroll
                for (int r = 0; r < 4; ++r) { a2[r].x = bf2f(src[(4 * cb + r) * 136 + jc]) * fac[4 * cb + r]; a2[r].y = 0.f; }
                const f32x4 d1 = *(const f32x4*)(sL + (4 * cb + 1) * 68 + 4 * cb), d2 = *(const f32x4*)(sL + (4 * cb + 2) * 68 + 4 * cb), d3 = *(const f32x4*)(sL + (4 * cb + 3) * 68 + 4 * cb);
                const int nb = (cb + 1) / 2;
                f32x4 lb[2][4][2];
#define SOLVE_LOAD(mb_, buf_) do { _Pragma("unroll") for (int q = 0; q < 2; ++q) _Pragma("unroll") for (int r = 0; r < 4; ++r) \
                    if (2 * (mb_) + q < cb) lb[buf_][r][q] = *(const f32x4*)(sL + (4 * cb + r) * 68 + 4 * (2 * (mb_) + q)); } while (0)
                if (nb > 0) SOLVE_LOAD(0, 0);
#pragma unroll
                for (int mb = 0; mb < nb; ++mb) {
                    if (mb + 1 < nb) SOLVE_LOAD(mb + 1, (mb + 1) & 1);
                    __builtin_amdgcn_sched_barrier(0);
#pragma unroll
                    for (int q = 0; q < 2; ++q)
#pragma unroll
                        for (int r = 0; r < 4; ++r)
                            if (2 * mb + q < cb) { const f32x4 l = lb[mb & 1][r][q]; const int m2 = 2 * (2 * mb + q);
                                a2[r] -= (f32x2_t){l[0], l[1]} * xv[m2]; a2[r] -= (f32x2_t){l[2], l[3]} * xv[m2 + 1]; }
                    __builtin_amdgcn_sched_barrier(0);
                }
#undef SOLVE_LOAD
                const float a0 = a2[0].x + a2[0].y, a1 = a2[1].x + a2[1].y, a2s = a2[2].x + a2[2].y, a3 = a2[3].x + a2[3].y;
                const float y0 = a0, y1 = a1 - d1[0] * y0, y2 = a2s - d2[0] * y0 - d2[1] * y1, y3 = a3 - d3[0] * y0 - d3[1] * y1 - d3[2] * y2;
                xv[2 * cb] = (f32x2_t){y0, y1}; xv[2 * cb + 1] = (f32x2_t){y2, y3};
            }
            if (isU) {
                const int w8 = jc >> 4, nn = jc & 15;
#pragma unroll
                for (int rq = 0; rq < 4; ++rq)
#pragma unroll
                    for (int pc = 0; pc < 2; ++pc) {
                        const int c0 = 32 * pc + 8 * rq;
                        u32x4 o; o.x = pk2(X_(c0 + 0), X_(c0 + 1)); o.y = pk2(X_(c0 + 2), X_(c0 + 3)); o.z = pk2(X_(c0 + 4), X_(c0 + 5)); o.w = pk2(X_(c0 + 6), X_(c0 + 7));
                        const int L = ((w8 * 2 + pc) * 64 + rq * 16 + nn) * 8;
                        *(u32x4*)(QKV + (tokb + (L >> 7)) * 3072 + 2048 + h * 128 + (L & 127)) = o;
                    }
            }
            __syncthreads();
            if (!isU) {
                bf16_t* sW2 = (bf16_t*)sL;
#pragma unroll
                for (int c = 0; c < 64; ++c) sW2[c * 136 + jc] = f2bf(-X_(c));
            }
        }
        __syncthreads();
        {
            const bf16_t* sW2 = (const bf16_t*)sL;
#pragma unroll
            for (int i = 0; i < 4; ++i) { const int ch = ht + 256 * i, r = ch >> 4, c8 = (ch & 15) * 8; *(u32x4*)(WB + (size_t)it * 8192 + r * 128 + c8) = *(const u32x4*)(sW2 + r * 136 + c8); }
        }
#undef X_
        {
            const int c = ht >> 2, ds = (ht & 3) * 32; const float eg = sEg[c];
#pragma unroll
            for (int c8 = 0; c8 < 4; ++c8) {
                const u32x4 v = *(const u32x4*)(sQ + c * 136 + ds + c8 * 8); u32x4 o;
                o.x = pk2(lo2f(v.x) * eg, hi2f(v.x) * eg); o.y = pk2(lo2f(v.y) * eg, hi2f(v.y) * eg); o.z = pk2(lo2f(v.z) * eg, hi2f(v.z) * eg); o.w = pk2(lo2f(v.w) * eg, hi2f(v.w) * eg);
                *(u32x4*)(QKV + (tokb + c) * 3072 + h * 128 + ds + c8 * 8) = o;
            }
            const int d = ht >> 1, cs = (ht & 1) * 32; const float gl = sGc[63];
#pragma unroll
            for (int c8 = 0; c8 < 4; ++c8) {
                float v[8];
#pragma unroll
                for (int e = 0; e < 8; ++e) { const int cc = cs + c8 * 8 + e; v[e] = bf2f(sK[cc * 136 + d]) * __expf(gl - sGc[cc]); }
                u32x4 o; o.x = pk2(v[0], v[1]); o.y = pk2(v[2], v[3]); o.z = pk2(v[4], v[5]); o.w = pk2(v[6], v[7]);
                *(u32x4*)(QKV + (tokb + (d >> 1)) * 3072 + 1024 + h * 128 + (d & 1) * 64 + cs + c8 * 8) = o;
            }
        }
        __syncthreads();
    }
}

constexpr int SC_WQ = 32768, SC_KA = 24576, SC_KA0 = 3 * SC_WQ;
static_assert(SC_KA0 + 2 * SC_KA <= LDS_BYTES, "scan LDS layout");
__device__ __forceinline__ bf16x8 pack2(const f32x4& a, const f32x4& b) {
    u32x4 r; r.x = pk2(a[0], a[1]); r.y = pk2(a[2], a[3]); r.z = pk2(b[0], b[1]); r.w = pk2(b[2], b[3]); return __builtin_bit_cast(bf16x8, r);
}
#define MF16(a, b, c) __builtin_amdgcn_mfma_f32_16x16x32_bf16(a, b, c, 0, 0, 0)
#define DMA16(src, dst) __builtin_amdgcn_global_load_lds((const unsigned*)(src), (LAS unsigned*)(dst), 16, 0, 0)
__device__ __forceinline__ void phase_gdn_scan(const Prm& p, LAS unsigned char* lds, int blk) {
    const int tid = threadIdx.x, wv = __builtin_amdgcn_readfirstlane(tid >> 6), lane = tid & 63, n = lane & 15, kq = lane >> 4;
    const int bh = blk & 15, jh = blk >> 4, b = bh >> 3, h = bh & 7;
    const bf16_t* QKV = (const bf16_t*)(p.ws + OFF_QKV); const bf16_t* WB = (const bf16_t*)(p.ws + OFF_WB); const bf16_t* ATT = (const bf16_t*)(p.ws + OFF_ATT);
    const float* GL = (const float*)(p.ws + OFF_GL); bf16_t* O = (bf16_t*)(p.ws + OFF_H);
    const int itb = bh * 128;
    const bf16_t* qkv_b = QKV + (size_t)b * SEQ * 3072;
    if (wv >= 4) {
        const int lw = wv - 4;
        __builtin_amdgcn_s_setprio(3);
        unsigned oW[4], oQ[4], oK[4], oA[2];
#pragma unroll
        for (int i = 0; i < 4; ++i) {
            { const int q = lw * 4 + i, row = 4 * q + (lane >> 4), pg = lane & 15, g = pg ^ ((row & 3) | (((row >> 3) & 3) << 2)); oW[i] = (unsigned)(row * 128 + g * 8); oQ[i] = (unsigned)(row * 3072 + h * 128 + g * 8); }
            { const int q = lw * 4 + i, d = 8 * q + (lane >> 3), pg = lane & 7, g = pg ^ ((d & 3) | (((d >> 3) & 1) << 2)); oK[i] = (unsigned)((d >> 1) * 3072 + 1024 + h * 128 + (d & 1) * 64 + g * 8); }
        }
#pragma unroll
        for (int i = 0; i < 2; ++i) { const int q = lw * 2 + i, c = 8 * q + (lane >> 3), pg = lane & 7, g = pg ^ ((c & 3) | (((c >> 3) & 1) << 2)); oA[i] = (unsigned)(c * 64 + g * 8); }
#define ISSUE_WQ(ck, st) do { const bf16_t* wb_ = WB + (size_t)(itb + (ck)) * 8192; const bf16_t* qb_ = qkv_b + (size_t)(ck) * 64 * 3072; LAS unsigned char* d_ = lds + (st) * SC_WQ + lw * 4096; \
        _Pragma("unroll") for (int i = 0; i < 4; ++i) { DMA16(wb_ + oW[i], d_ + i * 1024); DMA16(qb_ + oQ[i], d_ + 16384 + i * 1024); } } while (0)
#define ISSUE_KA(ck, st) do { const bf16_t* qb_ = qkv_b + (size_t)(ck) * 64 * 3072; const bf16_t* ab_ = ATT + (size_t)(itb + (ck)) * 4096; LAS unsigned char* d_ = lds + SC_KA0 + (st) * SC_KA; \
        _Pragma("unroll") for (int i = 0; i < 4; ++i) DMA16(qb_ + oK[i], d_ + (lw * 4 + i) * 1024); \
        _Pragma("unroll") for (int i = 0; i < 2; ++i) DMA16(ab_ + oA[i], d_ + 16384 + (lw * 2 + i) * 1024); } while (0)
        ISSUE_WQ(0, 0); ISSUE_KA(0, 0); ISSUE_WQ(1, 1);
        asm volatile("s_waitcnt vmcnt(0)" ::: "memory"); __builtin_amdgcn_s_barrier(); asm volatile("" ::: "memory");
        int s3 = 2;
        for (int nc = 0; nc < 128; ++nc) {
            const int c1 = nc + 1 < 128 ? nc + 1 : 127, c2 = nc + 2 < 128 ? nc + 2 : 127;
            ISSUE_WQ(c2, s3);
            ISSUE_KA(c1, (nc + 1) & 1);
            s3 = s3 == 2 ? 0 : s3 + 1;
            asm volatile("s_waitcnt vmcnt(14)" ::: "memory");
            __builtin_amdgcn_s_barrier(); asm volatile("" ::: "memory");
            __builtin_amdgcn_s_barrier(); asm volatile("" ::: "memory");
        }
        asm volatile("s_waitcnt vmcnt(0)" ::: "memory");
        __builtin_amdgcn_s_setprio(0);
#undef ISSUE_WQ
#undef ISSUE_KA
    } else if (wv >= 2) {
        for (int nc = 0; nc < 257; ++nc) { __builtin_amdgcn_s_barrier(); asm volatile("" ::: "memory"); }
    } else {
        const float gl0 = GL[itb + lane], gl1 = GL[itb + 64 + lane];
        f32x4 S[8];
#pragma unroll
        for (int dt = 0; dt < 8; ++dt) S[dt] = (f32x4){0.f, 0.f, 0.f, 0.f};
        const int e = 32 * jh + 16 * wv + n;
        unsigned uo[2];
#pragma unroll
        for (int pc = 0; pc < 2; ++pc) { const int L = (((2 * jh + wv) * 2 + pc) * 64 + lane) * 8; uo[pc] = (unsigned)((L >> 7) * 3072 + 2048 + h * 128 + (L & 127)); }
        u32x4 ua[2], ub[2];
#pragma unroll
        for (int pc = 0; pc < 2; ++pc) { ua[pc] = *(const u32x4*)(qkv_b + uo[pc]); ub[pc] = *(const u32x4*)(qkv_b + (size_t)64 * 3072 + uo[pc]); }
        const int rowb = 8 * (n >> 2) + (n & 3), swk = (n & 3) | (((n >> 2) & 1) << 2);
        unsigned offW[4], offK[2];
#pragma unroll
        for (int ks = 0; ks < 4; ++ks) offW[ks] = (unsigned)(rowb * 256 + (((4 * ks + kq) ^ n) << 4));
#pragma unroll
        for (int k2 = 0; k2 < 2; ++k2) offK[k2] = (unsigned)(rowb * 128 + (((4 * k2 + kq) ^ swk) << 4));
        asm volatile("s_waitcnt lgkmcnt(0)" ::: "memory"); __builtin_amdgcn_s_barrier(); asm volatile("" ::: "memory");
        int s3 = 0;
        for (int nc = 0; nc < 128; ++nc) {
            const LAS unsigned char* sWQ = lds + s3 * SC_WQ; const LAS unsigned char* sKA = lds + SC_KA0 + (nc & 1) * SC_KA;
            s3 = s3 == 2 ? 0 : s3 + 1;
            const float gl = __builtin_bit_cast(float, __builtin_amdgcn_readlane(__builtin_bit_cast(int, nc < 64 ? gl0 : gl1), nc & 63));
            f32x4 V[4], Oa[4];
#pragma unroll
            for (int pc = 0; pc < 2; ++pc) {
                const u32x4 uu = ua[pc];
                V[2 * pc] = (f32x4){lo2f(uu.x), hi2f(uu.x), lo2f(uu.y), hi2f(uu.y)}; V[2 * pc + 1] = (f32x4){lo2f(uu.z), hi2f(uu.z), lo2f(uu.w), hi2f(uu.w)};
                ua[pc] = ub[pc];
            }
            { const int c2 = nc + 2 < 128 ? nc + 2 : 127; const bf16_t* ubase = qkv_b + (size_t)c2 * 64 * 3072;
#pragma unroll
              for (int pc = 0; pc < 2; ++pc) ub[pc] = *(const u32x4*)(ubase + uo[pc]); }
#pragma unroll
            for (int ct = 0; ct < 4; ++ct) Oa[ct] = (f32x4){0.f, 0.f, 0.f, 0.f};
            bf16x8 fa[2][8];
#define TOFF(t, pitch) ((32 * ((t) >> 1) + 4 * ((t) & 1)) * (pitch))
#define LD_WQ(dst, ks_) do { _Pragma("unroll") for (int mt = 0; mt < 4; ++mt) { dst[mt] = *(const LAS bf16x8*)(sWQ + offW[ks_] + TOFF(mt, 256)); dst[4 + mt] = *(const LAS bf16x8*)(sWQ + 16384 + offW[ks_] + TOFF(mt, 256)); } } while (0)
            LD_WQ(fa[0], 0);
#pragma unroll
            for (int ks = 0; ks < 4; ++ks) {
                if (ks < 3) LD_WQ(fa[(ks + 1) & 1], ks + 1);
                const bf16x8 sb8 = pack2(S[2 * ks], S[2 * ks + 1]);
                __builtin_amdgcn_sched_barrier(0);
#pragma unroll
                for (int mt = 0; mt < 4; ++mt) { V[mt] = MF16(fa[ks & 1][mt], sb8, V[mt]); Oa[mt] = MF16(fa[ks & 1][4 + mt], sb8, Oa[mt]); }
                __builtin_amdgcn_sched_barrier(0);
            }
#undef LD_WQ
            asm volatile("s_waitcnt lgkmcnt(0)" ::: "memory"); __builtin_amdgcn_s_barrier(); asm volatile("" ::: "memory");
            bf16x8 fb[2][12];
#define LD_AK(dst, k2_) do { _Pragma("unroll") for (int mt = 0; mt < 4; ++mt) dst[mt] = *(const LAS bf16x8*)(sKA + 16384 + offK[k2_] + TOFF(mt, 128)); \
                             _Pragma("unroll") for (int dt = 0; dt < 8; ++dt) dst[4 + dt] = *(const LAS bf16x8*)(sKA + offK[k2_] + TOFF(dt, 128)); } while (0)
            LD_AK(fb[0], 0);
            bf16x8 Vb[2];
            Vb[0] = pack2(V[0], V[1]); Vb[1] = pack2(V[2], V[3]);
#pragma unroll
            for (int dt = 0; dt < 8; ++dt) S[dt] *= gl;
#pragma unroll
            for (int k2 = 0; k2 < 2; ++k2) {
                if (k2 < 1) LD_AK(fb[1], 1);
                __builtin_amdgcn_sched_barrier(0);
#pragma unroll
                for (int mt = 0; mt < 4; ++mt) Oa[mt] = MF16(fb[k2][mt], Vb[k2], Oa[mt]);
#pragma unroll
                for (int dt = 0; dt < 8; ++dt) S[dt] = MF16(fb[k2][4 + dt], Vb[k2], S[dt]);
                __builtin_amdgcn_sched_barrier(0);
            }
#undef LD_AK
#undef TOFF
            bf16_t* obase = O + (size_t)(itb + nc) * 8192 + e * 64 + 8 * kq;
#pragma unroll
            for (int pc = 0; pc < 2; ++pc) *(u32x4*)(obase + 32 * pc) = pack8(Oa[2 * pc], Oa[2 * pc + 1]);
            asm volatile("s_waitcnt lgkmcnt(0)" ::: "memory"); __builtin_amdgcn_s_barrier(); asm volatile("" ::: "memory");
        }
    }
    __syncthreads();
}

__device__ __forceinline__ void phase_ya(const Prm& p, unsigned char* lds) {
    const bf16_t* OT = (const bf16_t*)(p.ws + OFF_H); bf16_t* SZA = (bf16_t*)p.out;
    const float* gw = p.in[7];
    bf16_t* sT = (bf16_t*)lds;
    float* sPart = (float*)(lds + 16384);
    const int tid = threadIdx.x, w = tid >> 6, c = tid & 63;
    for (int it = blockIdx.x; it < NIT; it += gridDim.x) {
        const int b = it >> 10, h = (it >> 7) & 7, nc = it & 127;
        const size_t tok = (size_t)b * SEQ + (size_t)nc * 64 + c;
#pragma unroll
        for (int i = 0; i < 2; ++i) { const int ch = tid + 512 * i; *(u32x4*)(sT + ch * 8) = *(const u32x4*)(OT + (size_t)it * 8192 + ch * 8); }
        const u32x4 z0 = *(const u32x4*)(SZA + tok * 1024 + h * 128 + 16 * w), z1 = *(const u32x4*)(SZA + tok * 1024 + h * 128 + 16 * w + 8);
        __syncthreads();
        float o[16]; float ss = 0.f;
#pragma unroll
        for (int j = 0; j < 16; ++j) { o[j] = bf2f(sT[(16 * w + j) * 64 + c]); ss += o[j] * o[j]; }
        sPart[w * 64 + c] = ss;
        __syncthreads();
        float tot = 0.f;
#pragma unroll
        for (int k = 0; k < 8; ++k) tot += sPart[k * 64 + c];
        const float rstd = rsqrtf(tot * (1.0f / 128.0f) + 1e-6f);
        const unsigned zz[8] = {z0.x, z0.y, z0.z, z0.w, z1.x, z1.y, z1.z, z1.w};
        unsigned r[8];
#pragma unroll
        for (int j = 0; j < 8; ++j)
            r[j] = pk2(o[2 * j] * rstd * gw[16 * w + 2 * j] * lo2f(zz[j]), o[2 * j + 1] * rstd * gw[16 * w + 2 * j + 1] * hi2f(zz[j]));
        *(u32x4*)(SZA + tok * 1024 + h * 128 + 16 * w) = (u32x4){r[0], r[1], r[2], r[3]};
        *(u32x4*)(SZA + tok * 1024 + h * 128 + 16 * w + 8) = (u32x4){r[4], r[5], r[6], r[7]};
        __syncthreads();
    }
}
__device__ __forceinline__ void phase_conv3(const Prm& p) {
    const bf16_t* P = (const bf16_t*)(p.ws + OFF_P); bf16_t* Q = (bf16_t*)(p.ws + OFF_Q); const float* cw = p.in[19];
    const int nth = gridDim.x * 512;
    for (int idx = blockIdx.x * 512 + threadIdx.x; idx < (TOK / 4) * 256; idx += nth) {
        const int t0 = (idx >> 8) * 4, c8 = (idx & 255) * 8;
        const bool first = (t0 & (SEQ - 1)) == 0;
        u32x4 pr[6], qr[4];
#pragma unroll
        for (int i = 0; i < 6; ++i) pr[i] = (i < 2 && first) ? (u32x4){0u, 0u, 0u, 0u} : *(const u32x4*)(P + (size_t)(t0 - 2 + i) * 2048 + c8);
#pragma unroll
        for (int i = 0; i < 4; ++i) qr[i] = *(const u32x4*)(Q + (size_t)(t0 + i) * 2048 + c8);
        float w0[8], w1[8], w2[8];
#pragma unroll
        for (int e = 0; e < 8; ++e) { w0[e] = cw[c8 + e]; w1[e] = cw[2048 + c8 + e]; w2[e] = cw[4096 + c8 + e]; }
#pragma unroll
        for (int i = 0; i < 4; ++i) {
            const unsigned pa[4] = {pr[i + 2].x, pr[i + 2].y, pr[i + 2].z, pr[i + 2].w}, pb[4] = {pr[i + 1].x, pr[i + 1].y, pr[i + 1].z, pr[i + 1].w}, pc[4] = {pr[i].x, pr[i].y, pr[i].z, pr[i].w};
            const unsigned qa[4] = {qr[i].x, qr[i].y, qr[i].z, qr[i].w};
            unsigned o[4];
#pragma unroll
            for (int e = 0; e < 4; ++e)
                o[e] = pk2(lo2f(qa[e]) * (w0[2 * e] * lo2f(pc[e]) + w1[2 * e] * lo2f(pb[e]) + w2[2 * e] * lo2f(pa[e])),
                           hi2f(qa[e]) * (w0[2 * e + 1] * hi2f(pc[e]) + w1[2 * e + 1] * hi2f(pb[e]) + w2[2 * e + 1] * hi2f(pa[e])));
            *(u32x4*)(Q + (size_t)(t0 + i) * 2048 + c8) = (u32x4){o[0], o[1], o[2], o[3]};
        }
    }
}

#define XB_TMO      128
#define XB_XCNT(j)  (256  + 64 * (j))
#define XB_XSUB(j)  (1280 + 64 * (j))
#define XB_XGEN(j)  (2304 + 64 * (j))
#define XB_TOP      3328
#define XB_TOPGEN   3392
#define XCD_BAR_WORDS 3456
#define XB_SPIN_CAP (1u << 18)

__device__ __forceinline__ unsigned xb_ld(unsigned* p)              { return __hip_atomic_load(p, __ATOMIC_RELAXED, __HIP_MEMORY_SCOPE_AGENT); }
__device__ __forceinline__ unsigned xb_add(unsigned* p, unsigned v) { return __hip_atomic_fetch_add(p, v, __ATOMIC_RELAXED, __HIP_MEMORY_SCOPE_AGENT); }
__device__ __forceinline__ unsigned xb_xcc_id() { return (unsigned)__builtin_amdgcn_s_getreg((3 << 11) | 20) & 0xFu; }
#define XB_SPIN(cond, bar) do { unsigned _sp = 0; while (cond) { __builtin_amdgcn_s_sleep(1); \
    if ((++_sp & 255u) == 0u) { if (xb_ld(&(bar)[XB_TMO])) break; if (_sp > XB_SPIN_CAP) { atomicAdd(&(bar)[XB_TMO], 1u); break; } } } } while (0)

struct XcdBarrier {
    unsigned* bar; unsigned x;
    volatile LAS unsigned* st;
};

__device__ __forceinline__ XcdBarrier xcd_barrier_post(unsigned* bar, volatile LAS unsigned* st) {
    XcdBarrier b; b.bar = bar; b.x = xb_xcc_id(); b.st = st;
    if (threadIdx.x == 0) (void)xb_add(&bar[XB_XCNT(b.x)], 1u);
    return b;
}
__device__ __forceinline__ void xcd_barrier_complete(unsigned* bar, unsigned x, unsigned& nloc, unsigned& nx) {
    const unsigned G = gridDim.x * gridDim.y * gridDim.z;
    unsigned sum, cnt, mine, sp = 0u;
    for (;;) {
        sum = 0u; cnt = 0u; mine = 0u;
#pragma unroll
        for (unsigned j = 0; j < 16; ++j) { const unsigned c = xb_ld(&bar[XB_XCNT(j)]); sum += c; cnt += (c > 0u) ? 1u : 0u; mine = (j == x) ? c : mine; }
        if (sum == G) break;
        __builtin_amdgcn_s_sleep(1);
        if ((++sp & 255u) == 0u) { if (xb_ld(&bar[XB_TMO])) break; if (sp > XB_SPIN_CAP) { atomicAdd(&bar[XB_TMO], 1u); break; } }
    }
    nloc = mine > 0u ? mine : 1u; nx = cnt > 0u ? cnt : 1u;
}

__device__ __forceinline__ void xcd_barrier(const XcdBarrier& b) {
    asm volatile("s_waitcnt vmcnt(0)" ::: "memory");
    __syncthreads();
    if (threadIdx.x == 0) {
        unsigned* bar = b.bar;
        __builtin_amdgcn_s_waitcnt(0);
        unsigned nloc = b.st[0], nx = b.st[1];
        if (nloc == 0u) { xcd_barrier_complete(bar, b.x, nloc, nx); b.st[0] = nloc; b.st[1] = nx; }
        const unsigned old = xb_add(&bar[XB_XSUB(b.x)], 1u);
        const unsigned gen = old / nloc;
        if (old + 1u == (gen + 1u) * nloc) {
            __builtin_amdgcn_fence(__ATOMIC_RELEASE, "agent");
            asm volatile("s_waitcnt vmcnt(0)" ::: "memory");
            const unsigned og = xb_add(&bar[XB_TOP], 1u);
            const unsigned tg = og / nx;
            if (og + 1u == (tg + 1u) * nx) xb_add(&bar[XB_TOPGEN], 1u);
            else XB_SPIN(xb_ld(&bar[XB_TOPGEN]) == tg, bar);
            __builtin_amdgcn_fence(__ATOMIC_ACQUIRE, "agent");
            xb_add(&bar[XB_XGEN(b.x)], 1u);
            asm volatile("s_waitcnt vmcnt(0)" ::: "memory");
        } else {
            XB_SPIN(xb_ld(&bar[XB_XGEN(b.x)]) == gen, bar);
            __builtin_amdgcn_fence(__ATOMIC_ACQUIRE, "agent");
            asm volatile("s_waitcnt vmcnt(0)" ::: "memory");
        }
    }
    __syncthreads();
}

constexpr int NPHASE = 11;
#define REP_GEMM 1
#define REP_SYNC 1
#define REP_SCAN 1
#define SCAN_PROBE 1
#define REP_P0 1
#ifndef PHM
#define PHM 0x7FF
#endif
__global__ void __launch_bounds__(512, 2) mega(Prm p) {
    extern __shared__ __attribute__((aligned(16))) unsigned char shm[];
    LAS unsigned char* lds3 = (LAS unsigned char*)shm;
    unsigned char* ws = p.ws;
    volatile LAS unsigned* xst = (volatile LAS unsigned*)(lds3 + LDS_BYTES);
    if (threadIdx.x == 0) { xst[0] = 0u; xst[1] = 0u; }
    __syncthreads();
    XcdBarrier xb{};
    const bool multi = (p.ph_hi - p.ph_lo) > 1;
    if (multi) xb = xcd_barrier_post((unsigned*)(ws + OFF_BAR), xst);
    if (p.ph_lo < 0) cg::this_grid().sync();
#define PH_BEGIN(i) if (((PHM >> (i)) & 1) && p.ph_lo <= (i) && (i) < p.ph_hi) { if ((i) > p.ph_lo) { xcd_barrier(xb); if (REP_SYNC > 1) xcd_barrier(xb); } pg8::StaticOrder S; (void)S;
#define PH_END }
    PH_BEGIN(0)
        for (int rep = 0; rep < REP_P0; ++rep) {
        phase_convert(p, shm, 0, 1856, gridDim.x, blockIdx.x);
        phase_rmsnorm_x(p.in[0], p.in[1], (bf16_t*)(ws + OFF_H)); __syncthreads(); }
    PH_END
    PH_BEGIN(1)
        phase_ba(p, shm);
        pg8::Gemm g{(const bf16_t*)(ws + OFF_H), (const bf16_t*)(ws + OFF_WT1), TOK, 6144, 1024, (const bf16_t*)(ws + OFF_H), 1024, 64};
        Epi1 E{(bf16_t*)(ws + OFF_QKV), (bf16_t*)p.out, (bf16_t*)(ws + OFF_UU), (bf16_t*)p.out + (size_t)TOK * 1024, (float*)(ws + OFF_BA), (bf16_t*)(ws + OFF_HALO)};
        S.init(TOK, 6144, gridDim.x, blockIdx.x); for (int rep = 0; rep < REP_GEMM; ++rep) { pg8::gemm_phase(lds3, g, S, E); __syncthreads(); }
    PH_END
    PH_BEGIN(2)
        {
            unsigned* ctr = (unsigned*)(ws + OFF_BAR) + 3600;
            volatile LAS unsigned* sIt = xst + 2;
            for (;;) {
                if (threadIdx.x == 0) sIt[0] = __hip_atomic_fetch_add(ctr, 2u, __ATOMIC_RELAXED, __HIP_MEMORY_SCOPE_AGENT);
                __syncthreads();
                const unsigned it0 = sIt[0];
                __syncthreads();
                if (it0 >= (unsigned)NIT) break;
                phase_gdn_prep(p, shm, (int)it0, 1);
            }
        }
    PH_END
    PH_BEGIN(3)
        if (blockIdx.x < 64) phase_gdn_scan(p, lds3, blockIdx.x);
        else {
            const int ob = blockIdx.x - 64;
            pg8::Gemm g{(const bf16_t*)(ws + OFF_UU), (const bf16_t*)(ws + OFF_WTG), TOK, 1024, 1024, (const bf16_t*)(ws + OFF_UU), 1024, 64};
            EpiGlu E{(const bf16_t*)(ws + OFF_UU), (bf16_t*)p.out + (size_t)TOK * 1024};
            unsigned* cw = (unsigned*)(ws + OFF_BAR);
            if (ob < 128) {
                phase_s5(p, shm, ob);
                asm volatile("s_waitcnt vmcnt(0)" ::: "memory");
                __syncthreads();
                if (threadIdx.x == 0) {
                    __builtin_amdgcn_fence(__ATOMIC_RELEASE, "agent");
                    asm volatile("s_waitcnt vmcnt(0)" ::: "memory");
                    __hip_atomic_fetch_add(cw + 3700, 1u, __ATOMIC_RELAXED, __HIP_MEMORY_SCOPE_AGENT);
                    unsigned sp = 0;
                    while (__hip_atomic_load(cw + 3700, __ATOMIC_RELAXED, __HIP_MEMORY_SCOPE_AGENT) < 128u) { __builtin_amdgcn_s_sleep(2); if (++sp > (1u << 22)) break; }
                    __builtin_amdgcn_fence(__ATOMIC_ACQUIRE, "agent");
                    asm volatile("s_waitcnt vmcnt(0)" ::: "memory");
                }
                __syncthreads();
                S.init_list(ob, 1, 1); pg8::gemm_phase(lds3, g, S, E);
            } else {
                const int e = ob - 128;
                phase_convert(p, shm, 1856, 1856 + 2304, 64, e);
                __syncthreads();
                if (threadIdx.x == 0) {
                    unsigned sp = 0;
                    while (__hip_atomic_load(cw + 3900, __ATOMIC_RELAXED, __HIP_MEMORY_SCOPE_AGENT) < 128u) { __builtin_amdgcn_s_sleep(2); if (++sp > (1u << 22)) break; }
                    __builtin_amdgcn_fence(__ATOMIC_ACQUIRE, "agent");
                    asm volatile("s_waitcnt vmcnt(0)" ::: "memory");
                }
                __syncthreads();
                S.init_list(2 * e, 2, 0); pg8::gemm_phase(lds3, g, S, E);
                __syncthreads();
                phase_convert(p, shm, 1856 + 2304, 4928, 64, e);
            }
        }
    PH_END
    PH_BEGIN(4)
        phase_ya(p, shm);
    PH_END
    PH_BEGIN(5)
        pg8::Gemm g{(const bf16_t*)p.out, (const bf16_t*)(ws + OFF_WTO0), TOK, 1024, 2048, (const bf16_t*)p.out + (size_t)TOK * 1024, 1024, 16};
        EpiB16 E{(bf16_t*)(ws + OFF_QKV)};
        S.init(TOK, 1024, gridDim.x, blockIdx.x); for (int rep = 0; rep < REP_GEMM; ++rep) { pg8::gemm_phase(lds3, g, S, E); __syncthreads(); }
    PH_END
    PH_BEGIN(6)
        phase_post<true>(p.in[0], (const bf16_t*)(ws + OFF_QKV), p.in[2], p.out, p.in[1] + 1024, (bf16_t*)(ws + OFF_H));
    PH_END
    PH_BEGIN(7)
        pg8::Gemm g{(const bf16_t*)(ws + OFF_H), (const bf16_t*)(ws + OFF_WT2), TOK, 8192, 1024, (const bf16_t*)(ws + OFF_H), 1024, 64};
        Epi2 E{(bf16_t*)(ws + OFF_P), (bf16_t*)(ws + OFF_Q)};
        S.init(TOK, 8192, gridDim.x, blockIdx.x); for (int rep = 0; rep < REP_GEMM; ++rep) { pg8::gemm_phase(lds3, g, S, E); __syncthreads(); }
    PH_END
    PH_BEGIN(8)
        phase_conv3(p);
    PH_END
    PH_BEGIN(9)
        pg8::Gemm g{(const bf16_t*)(ws + OFF_Q), (const bf16_t*)(ws + OFF_WTO1), TOK, 1024, 2048, (const bf16_t*)(ws + OFF_Q), 2048, 64};
        EpiB16 E{(bf16_t*)(ws + OFF_P)};
        S.init(TOK, 1024, gridDim.x, blockIdx.x); for (int rep = 0; rep < REP_GEMM; ++rep) { pg8::gemm_phase(lds3, g, S, E); __syncthreads(); }
    PH_END
    PH_BEGIN(10)
        phase_post<false>(p.out, (const bf16_t*)(ws + OFF_P), p.in[2] + 1024, p.out, nullptr, nullptr);
    PH_END
}

#ifndef N_LAUNCH_MODE
#define N_LAUNCH_MODE 1
#endif

extern "C" void kernel_launch(void* const* d_in, const int* in_sizes, int n_in, void* d_out, int out_size, void* d_ws, size_t ws_size, hipStream_t stream) {
    static int ready = 0;
    if (!ready) {
        if (n_in != 21 || ws_size < WS_END || out_size != TOK * DM) { fprintf(stderr, "kernel_launch: unexpected shapes (n_in %d ws %zu out %d)\n", n_in, ws_size, out_size); ready = -1; return; }
        if (hipFuncSetAttribute((const void*)mega, hipFuncAttributeMaxDynamicSharedMemorySize, LDS_BYTES + 16) != hipSuccess) { fprintf(stderr, "kernel_launch: hipFuncSetAttribute failed\n"); ready = -1; return; }
        ready = 1;
    }
    if (ready < 0) return;
    Prm p{};
    for (int i = 0; i < 21; ++i) p.in[i] = (const float*)d_in[i];
    p.out = (float*)d_out; p.ws = (unsigned char*)d_ws;
#if N_LAUNCH_MODE == 1
    p.ph_lo = 0; p.ph_hi = NPHASE;
    void* args[] = {&p};
    if (hipMemsetAsync((unsigned char*)d_ws + OFF_BAR, 0, 16384, stream) != hipSuccess) { fprintf(stderr, "memset failed\n"); return; }
    hipError_t e = hipLaunchCooperativeKernel((const void*)mega, dim3(256), dim3(512), args, LDS_BYTES + 16, stream);
    if (e != hipSuccess) fprintf(stderr, "cooperative launch failed: %s\n", hipGetErrorString(e));
#else
    for (int ph = 0; ph < NPHASE; ++ph) {
        p.ph_lo = ph; p.ph_hi = ph + 1;
        hipLaunchKernelGGL(mega, dim3(256), dim3(512), LDS_BYTES + 16, stream, p);
    }
#endif
}
```

```cpp
#include <hip/hip_runtime.h>
#include <hip/hip_cooperative_groups.h>
#include <cstdio>
namespace cg = cooperative_groups;

#define LAS __attribute__((address_space(3)))
typedef unsigned short bf16_t;
typedef short bf16x8 __attribute__((ext_vector_type(8)));
typedef float f32x4 __attribute__((ext_vector_type(4)));
typedef float f32x16 __attribute__((ext_vector_type(16)));
typedef unsigned u32x4 __attribute__((ext_vector_type(4)));
typedef unsigned u32x2 __attribute__((ext_vector_type(2)));

constexpr int TOK = 16384, DM = 1024, SEQ = 8192;
constexpr int NP1 = 6400;
constexpr int NIT = 2048;

constexpr size_t OFF_WT1 = 0;
constexpr size_t OFF_WTG = OFF_WT1 + (size_t)NP1 * 1024 * 2;
constexpr size_t OFF_WTO0 = OFF_WTG + (size_t)1024 * 1024 * 2;
constexpr size_t OFF_WT2 = OFF_WTO0 + (size_t)1024 * 2048 * 2;
constexpr size_t OFF_WTO1 = OFF_WT2 + (size_t)8192 * 1024 * 2;
constexpr size_t OFF_H = OFF_WTO1 + (size_t)1024 * 2048 * 2;
constexpr size_t OFF_QKV = OFF_H + (size_t)TOK * 1024 * 2;
constexpr size_t OFF_UU = OFF_QKV + (size_t)TOK * 3072 * 2;
constexpr size_t OFF_WB = OFF_UU + (size_t)TOK * 1024 * 2;
constexpr size_t OFF_ATT = OFF_WB + (size_t)NIT * 8192 * 2;
constexpr size_t OFF_HALO = OFF_ATT + (size_t)NIT * 4096 * 2;
constexpr size_t OFF_BA = OFF_HALO + (size_t)256 * 3 * 3072 * 2;
constexpr size_t OFF_GL = OFF_BA + (size_t)TOK * 16 * 4;
constexpr size_t OFF_BAR = OFF_GL + (size_t)NIT * 4;
constexpr size_t WS_END = OFF_BAR + 16384;
constexpr size_t OFF_YMIX = OFF_QKV;
constexpr size_t OFF_P = OFF_QKV;
constexpr size_t OFF_Q = OFF_QKV + (size_t)TOK * 2048 * 2;
static_assert(OFF_Q + (size_t)TOK * 2048 * 2 <= OFF_WB, "Q overlaps live data");
static_assert(WS_END <= (size_t)256 * 1024 * 1024, "workspace too big");

constexpr int LDS_BYTES = 157696;

struct Prm {
    const float* in[21];
    float* out;
    unsigned char* ws;
    int ph_lo, ph_hi;
};

__device__ __forceinline__ float bf2f(bf16_t b) { return __uint_as_float(((unsigned)b) << 16); }
__device__ __forceinline__ bf16_t f2bf(float f) { unsigned u = __float_as_uint(f); u += 0x7FFFu + ((u >> 16) & 1u); return (bf16_t)(u >> 16); }
typedef __bf16 bf16v2_t __attribute__((ext_vector_type(2)));
typedef float f32x2_t __attribute__((ext_vector_type(2)));
__device__ __forceinline__ unsigned pk2(float lo, float hi) { const f32x2_t v = {lo, hi}; return __builtin_bit_cast(unsigned, __builtin_convertvector(v, bf16v2_t)); }
__device__ __forceinline__ float lo2f(unsigned u) { return __uint_as_float(u << 16); }
__device__ __forceinline__ float hi2f(unsigned u) { return __uint_as_float(u & 0xFFFF0000u); }
__device__ __forceinline__ float sigmoidf_(float x) { return 1.0f / (1.0f + __expf(-x)); }
__device__ __forceinline__ float siluf_(float x) { return x / (1.0f + __expf(-x)); }
__device__ __forceinline__ float wave_sum(float v) {
#pragma unroll
    for (int o = 32; o >= 1; o >>= 1) v += __shfl_xor(v, o);
    return v;
}
__device__ __forceinline__ u32x4 pack8(f32x4 a, f32x4 b) { u32x4 r; r.x = pk2(a[0], a[1]); r.y = pk2(a[2], a[3]); r.z = pk2(b[0], b[1]); r.w = pk2(b[2], b[3]); return r; }

namespace pg8 {
constexpr int BM = 256, BK = 64, HALF = 128, HTB = HALF * BK * 2, STAGE_BYTES = 8 * HTB, NXCD = 8, WGM = 8;
__device__ __forceinline__ int lds_byte(int r, int c) { const int st = (r >> 4) * 2 + (c >> 5), rr = r & 15, cc = c & 31, ob = rr * 64 + cc * 2; return st * 1024 + (ob ^ (((ob >> 9) & 1) << 5)); }
__device__ __forceinline__ void stage_rc(int b, int& R, int& C) { const int st = b / 1024, sb = b % 1024, swz = sb ^ (((sb >> 9) & 1) << 5); R = (st >> 1) * 16 + swz / 64; C = (st & 1) * 32 + (swz % 64) / 2; }
__device__ __forceinline__ int perm32(int rho) { const int n = rho >> 4, i = rho & 15; return 8 * (i >> 2) + 4 * n + (i & 3); }
struct Unit { int pm, pn; };
struct Gemm { const bf16_t* A; const bf16_t* Bt; int M, N, K; const bf16_t* A2; int lda, ks; };
struct StaticOrder {
    int nM, nN, nwg, G, c;
    int lmode, lbase, lcount, lhalf;
    __device__ void init(int M, int N, int G_, int c_) { nM = M / BM; nN = N / BM; nwg = nM * nN; G = G_; c = c_; lmode = 0; lbase = 0; lcount = 0; lhalf = 0; }
    __device__ void init_list(int base, int count, int half) { nM = 64; nN = 4; nwg = 256; G = 1; c = 0; lmode = 1; lbase = base; lcount = count; lhalf = half; }
    __device__ bool next(int i, Unit& u) const {
        if (lmode) { if (i >= lcount) return false; const int j = lbase + i, bb = j >> 6, r = j & 63; u.pm = 32 * bb + 16 * lhalf + (r >> 2); u.pn = r & 3; return true; }
        const long L = (long)i * G + c; if (L >= nwg) return false;
        int wgid = (int)L; { const int q = nwg / NXCD, r = nwg % NXCD, xcd = wgid % NXCD, off = wgid / NXCD; wgid = (xcd < r ? xcd * (q + 1) : r * (q + 1) + (xcd - r) * q) + off; }
        const int nig = WGM * nN, gid = wgid / nig, fm = gid * WGM, gsz = (nM - fm) < WGM ? (nM - fm) : WGM;
        u.pm = fm + ((wgid % nig) % gsz); u.pn = (wgid % nig) / gsz; return true;
    }
};

template <class Epi>
__device__ __forceinline__ void gemm_phase(LAS unsigned char* lds, const Gemm g, const StaticOrder& S, const Epi& E) {
    const int tid = threadIdx.x, wid = __builtin_amdgcn_readfirstlane(tid >> 6), lane = tid & 63, wr = wid >> 2, wc = wid & 3, fr = lane & 15, fq = lane >> 4;
    const int K = g.K, nt = K / BK;
    unsigned voffA[2], voffB[2];
#pragma unroll
    for (int i = 0; i < 2; ++i) { int R, C; stage_rc(tid * 16 + i * 8192, R, C); const int Rb = Epi::PERM ? ((R & ~31) + perm32(R & 31)) : R;
        voffA[i] = (unsigned)(R * g.lda + C) * 2u; voffB[i] = (unsigned)(Rb * K + C) * 2u; }
    const size_t kstep = (size_t)(BK * 2);
    const size_t hstep = (size_t)HALF * K * 2;
    const size_t tstep = 2 * hstep;
    const size_t hstepA = (size_t)HALF * g.lda * 2, tstepA = 2 * hstepA;
    const int ks = g.ks; const ptrdiff_t a2off = (const char*)g.A2 - (const char*)g.A - (ptrdiff_t)ks * (ptrdiff_t)kstep;
    const unsigned ldsw = (unsigned)wid * 1024u;
    const int aoff = lds_byte(wr * 64 + fr, fq * 8), boff = lds_byte(wc * 32 + fr, fq * 8);
#define PG8_SA(b, h) (((b) * 2 + (h)) * HTB)
#define PG8_SB(b, h) ((4 + (b) * 2 + (h)) * HTB)
#define PG8_STAGE(bufoff, gbase, voff) do { _Pragma("unroll") for (int _i = 0; _i < 2; ++_i) \
        __builtin_amdgcn_global_load_lds((const unsigned*)((const char*)(gbase) + (voff)[_i]), (LAS unsigned*)(lds + (bufoff) + ldsw + _i * 8192), 16, 0, 0); } while (0)
#define PG8_LDA(dst, b, h) do { _Pragma("unroll") for (int m = 0; m < 4; ++m) _Pragma("unroll") for (int k = 0; k < 2; ++k) dst[m][k] = *(const LAS bf16x8*)(lds + PG8_SA(b, h) + aoff + m * 2048 + k * 1024); } while (0)
#define PG8_LDB(dst, b, h) do { _Pragma("unroll") for (int n = 0; n < 2; ++n) _Pragma("unroll") for (int k = 0; k < 2; ++k) dst[n][k] = *(const LAS bf16x8*)(lds + PG8_SB(b, h) + boff + n * 2048 + k * 1024); } while (0)
#define PG8_MMA(ai, bj, At, Bt) do { __builtin_amdgcn_s_setprio(1); _Pragma("unroll") for (int m = 0; m < 4; ++m) _Pragma("unroll") for (int n = 0; n < 2; ++n) _Pragma("unroll") for (int k = 0; k < 2; ++k) \
        acc[ai][bj][m][n] = __builtin_amdgcn_mfma_f32_16x16x32_bf16(Bt[n][k], At[m][k], acc[ai][bj][m][n], 0, 0, 0); __builtin_amdgcn_s_setprio(0); } while (0)
#define PG8_WAIT_V(n) asm volatile("s_waitcnt vmcnt(" #n ")" ::: "memory")
#define PG8_WAIT_L(n) asm volatile("s_waitcnt lgkmcnt(" #n ")" ::: "memory")
#define PG8_BAR __builtin_amdgcn_s_barrier()
#define PG8_SCHED __builtin_amdgcn_sched_barrier(0)
    Unit cur, nxt; int ui = 0;
    if (!S.next(0, cur)) return;
    f32x4 acc[2][2][4][2];
#pragma unroll
    for (int a = 0; a < 2; ++a)
#pragma unroll
        for (int b = 0; b < 2; ++b)
#pragma unroll
            for (int m = 0; m < 4; ++m)
#pragma unroll
                for (int n = 0; n < 2; ++n) acc[a][b][m][n] = (f32x4){0.f, 0.f, 0.f, 0.f};
    bf16x8 At[4][2], B0[2][2], B1[2][2];
    const char* cA = (const char*)g.A + (size_t)cur.pm * tstepA; const char* cB = (const char*)g.Bt + (size_t)cur.pn * tstep;
    PG8_STAGE(PG8_SB(0, 0), cB, voffB); PG8_STAGE(PG8_SA(0, 0), cA, voffA); PG8_STAGE(PG8_SB(0, 1), cB + hstep, voffB); PG8_STAGE(PG8_SA(0, 1), cA + hstepA, voffA);
    if (wr == 1) PG8_BAR;
    PG8_WAIT_V(4); PG8_BAR;
    PG8_STAGE(PG8_SB(1, 0), cB + kstep, voffB); PG8_STAGE(PG8_SA(1, 0), cA + kstep, voffA); PG8_STAGE(PG8_SB(1, 1), cB + hstep + kstep, voffB);
    PG8_WAIT_V(6); PG8_BAR;
    for (;;) {
        const bool has_next = S.next(ui + 1, nxt);
        const char* nA = has_next ? (const char*)g.A + (size_t)nxt.pm * tstepA : cA; const char* nB = has_next ? (const char*)g.Bt + (size_t)nxt.pn * tstep : cB;
        for (int t = 0; t < nt; t += 2) {
            const bool last = (t == nt - 2);
            const char* a1 = cA + (size_t)(t + 1) * kstep + ((t + 1) >= ks ? a2off : 0);
            const char* a2 = last ? nA : cA + (size_t)(t + 2) * kstep + ((t + 2) >= ks ? a2off : 0); const char* b2 = last ? nB : cB + (size_t)(t + 2) * kstep;
            const char* a3 = last ? nA + kstep : cA + (size_t)(t + 3) * kstep + ((t + 3) >= ks ? a2off : 0); const char* b3 = b2 + kstep;
            PG8_LDB(B0, 0, 0); PG8_SCHED; PG8_LDA(At, 0, 0); PG8_STAGE(PG8_SA(1, 1), a1 + hstepA, voffA);
            PG8_WAIT_L(8); PG8_BAR; PG8_WAIT_L(0); PG8_MMA(0, 0, At, B0); PG8_BAR; PG8_SCHED;
            PG8_LDB(B1, 0, 1); PG8_STAGE(PG8_SB(0, 0), b2, voffB);
            PG8_BAR; PG8_WAIT_L(0); PG8_MMA(0, 1, At, B1); PG8_BAR;
            PG8_LDA(At, 0, 1); PG8_STAGE(PG8_SA(0, 0), a2, voffA);
            PG8_BAR; PG8_WAIT_L(0); PG8_MMA(1, 0, At, B0); PG8_BAR; PG8_SCHED;
            PG8_STAGE(PG8_SB(0, 1), b2 + hstep, voffB);
            PG8_WAIT_V(6); PG8_BAR; PG8_MMA(1, 1, At, B1); PG8_BAR;
            PG8_LDB(B0, 1, 0); PG8_SCHED; PG8_LDA(At, 1, 0); PG8_STAGE(PG8_SA(0, 1), a2 + hstepA, voffA);
            PG8_WAIT_L(8); PG8_BAR; PG8_WAIT_L(0); PG8_MMA(0, 0, At, B0); PG8_BAR; PG8_SCHED;
            PG8_LDB(B1, 1, 1); PG8_STAGE(PG8_SB(1, 0), b3, voffB);
            PG8_BAR; PG8_WAIT_L(0); PG8_MMA(0, 1, At, B1); PG8_BAR;
            PG8_LDA(At, 1, 1); PG8_STAGE(PG8_SA(1, 0), a3, voffA);
            PG8_BAR; PG8_WAIT_L(0); PG8_MMA(1, 0, At, B0); PG8_BAR; PG8_SCHED;
            PG8_STAGE(PG8_SB(1, 1), b3 + hstep, voffB);
            PG8_WAIT_V(6); PG8_BAR; PG8_MMA(1, 1, At, B1); PG8_BAR;
        }
        E(acc, cur, wr, wc, fr, fq);
        if (!has_next) break;
#pragma unroll
        for (int a = 0; a < 2; ++a)
#pragma unroll
            for (int b = 0; b < 2; ++b)
#pragma unroll
                for (int m = 0; m < 4; ++m)
#pragma unroll
                    for (int n = 0; n < 2; ++n) acc[a][b][m][n] = (f32x4){0.f, 0.f, 0.f, 0.f};
        cur = nxt; cA = nA; cB = nB; ++ui;
    }
    PG8_WAIT_V(0);
    if (wr == 0) PG8_BAR;
    PG8_BAR;
#undef PG8_SA
#undef PG8_SB
#undef PG8_STAGE
#undef PG8_LDA
#undef PG8_LDB
#undef PG8_MMA
#undef PG8_WAIT_V
#undef PG8_WAIT_L
#undef PG8_BAR
#undef PG8_SCHED
}
}
using pg8::Unit;

struct Epi1 {
    static constexpr bool PERM = true;
    bf16_t* QKV; bf16_t* SZA; bf16_t* UU; bf16_t* SZB; float* BA; bf16_t* HALO;
    __device__ __forceinline__ void operator()(const f32x4 (&acc)[2][2][4][2], const Unit& u, int wr, int wc, int fr_, int fq_) const {
        int lane = (int)(threadIdx.x & 63); asm volatile("" : "+v"(lane));
        const int fr = lane & 15, fq = lane >> 4; (void)fr_; (void)fq_;
        const int row0 = u.pm * 256 + wr * 64 + fr, pn = u.pn;
#pragma unroll
        for (int ai = 0; ai < 2; ++ai)
#pragma unroll
            for (int m = 0; m < 4; ++m) {
                const size_t row = (size_t)(row0 + ai * 128 + m * 16);
#pragma unroll
                for (int bj = 0; bj < 2; ++bj) {
                    const int colt = 128 * bj + 32 * wc + 8 * fq;
                    f32x4 v0 = acc[ai][bj][m][0], v1 = acc[ai][bj][m][1];
                    if (pn < 12) {
                        const int c = pn * 256 + colt; const u32x4 pk = pack8(v0, v1);
                        *(u32x4*)(QKV + row * 3072 + c) = pk;
                        if (m == 3 && fr >= 13) *(u32x4*)(HALO + ((row >> 6) * 3 + (fr - 13)) * 3072 + c) = pk;
                    } else if (pn < 16) {
#pragma unroll
                        for (int e = 0; e < 4; ++e) { v0[e] = siluf_(v0[e]); v1[e] = siluf_(v1[e]); }
                        *(u32x4*)(SZA + row * 1024 + (pn - 12) * 256 + colt) = pack8(v0, v1);
                    } else if (pn < 20) {
                        *(u32x4*)(UU + row * 1024 + (pn - 16) * 256 + colt) = pack8(v0, v1);
                    } else if (pn < 24) {
#pragma unroll
                        for (int e = 0; e < 4; ++e) { v0[e] = siluf_(v0[e]); v1[e] = siluf_(v1[e]); }
                        *(u32x4*)(SZB + row * 1024 + (pn - 20) * 256 + colt) = pack8(v0, v1);
                    } else if (colt < 16) {
                        *(f32x4*)(BA + row * 16 + colt) = v0; *(f32x4*)(BA + row * 16 + colt + 4) = v1;
                    }
                }
            }
    }
};
struct EpiGlu {
    static constexpr bool PERM = true;
    const bf16_t* Y5; bf16_t* SZB;
    __device__ __forceinline__ void operator()(const f32x4 (&acc)[2][2][4][2], const Unit& u, int wr, int wc, int fr, int fq) const {
        const int row0 = u.pm * 256 + wr * 64 + fr;
#pragma unroll
        for (int ai = 0; ai < 2; ++ai)
#pragma unroll
            for (int m = 0; m < 4; ++m) {
                const size_t row = (size_t)(row0 + ai * 128 + m * 16);
#pragma unroll
                for (int bj = 0; bj < 2; ++bj) {
                    const int c = u.pn * 256 + 128 * bj + 32 * wc + 8 * fq;
                    const u32x4 y = *(const u32x4*)(Y5 + row * 1024 + c), z = *(const u32x4*)(SZB + row * 1024 + c);
                    const f32x4 a0 = acc[ai][bj][m][0], a1 = acc[ai][bj][m][1];
                    u32x4 o;
                    o.x = pk2(lo2f(y.x) * sigmoidf_(a0[0]) * lo2f(z.x), hi2f(y.x) * sigmoidf_(a0[1]) * hi2f(z.x));
                    o.y = pk2(lo2f(y.y) * sigmoidf_(a0[2]) * lo2f(z.y), hi2f(y.y) * sigmoidf_(a0[3]) * hi2f(z.y));
                    o.z = pk2(lo2f(y.z) * sigmoidf_(a1[0]) * lo2f(z.z), hi2f(y.z) * sigmoidf_(a1[1]) * hi2f(z.z));
                    o.w = pk2(lo2f(y.w) * sigmoidf_(a1[2]) * lo2f(z.w), hi2f(y.w) * sigmoidf_(a1[3]) * hi2f(z.w));
                    *(u32x4*)(SZB + row * 1024 + c) = o;
                }
            }
    }
};
struct EpiF32 {
    static constexpr bool PERM = false;
    float* C;
    __device__ __forceinline__ void operator()(const f32x4 (&acc)[2][2][4][2], const Unit& u, int wr, int wc, int fr, int fq) const {
        const int row0 = u.pm * 256 + wr * 64 + fr, col0 = u.pn * 256 + wc * 32 + 4 * fq;
#pragma unroll
        for (int ai = 0; ai < 2; ++ai)
#pragma unroll
            for (int m = 0; m < 4; ++m) { float* rowp = C + (size_t)(row0 + ai * 128 + m * 16) * 1024 + col0;
#pragma unroll
                for (int bj = 0; bj < 2; ++bj)
#pragma unroll
                    for (int n = 0; n < 2; ++n) *(f32x4*)(rowp + bj * 128 + n * 16) = acc[ai][bj][m][n]; }
    }
};
struct EpiB16 {
    static constexpr bool PERM = true;
    bf16_t* C;
    __device__ __forceinline__ void operator()(const f32x4 (&acc)[2][2][4][2], const Unit& u, int wr, int wc, int fr, int fq) const {
        const int row0 = u.pm * 256 + wr * 64 + fr, col0 = u.pn * 256 + wc * 32 + 8 * fq;
#pragma unroll
        for (int ai = 0; ai < 2; ++ai)
#pragma unroll
            for (int m = 0; m < 4; ++m) { bf16_t* rowp = C + (size_t)(row0 + ai * 128 + m * 16) * 1024 + col0;
#pragma unroll
                for (int bj = 0; bj < 2; ++bj) *(u32x4*)(rowp + bj * 128) = pack8(acc[ai][bj][m][0], acc[ai][bj][m][1]); }
    }
};
struct Epi2 {
    static constexpr bool PERM = false;
    bf16_t* P; bf16_t* Q;
    __device__ __forceinline__ void operator()(const f32x4 (&acc)[2][2][4][2], const Unit& u, int wr, int wc, int fr, int fq) const {
        const int row0 = u.pm * 256 + wr * 64 + fr, ch = u.pn * 64 + 16 * wc + 4 * fq;
#pragma unroll
        for (int ai = 0; ai < 2; ++ai)
#pragma unroll
            for (int m = 0; m < 4; ++m) {
                const size_t row = (size_t)(row0 + ai * 128 + m * 16);
                const f32x4 gb = acc[ai][0][m][0], gc = acc[ai][0][m][1], hv = acc[ai][1][m][0], z = acc[ai][1][m][1];
                u32x2 pp, qq;
                pp.x = pk2(gc[0] * hv[0], gc[1] * hv[1]); pp.y = pk2(gc[2] * hv[2], gc[3] * hv[3]);
                qq.x = pk2(gb[0] * siluf_(z[0]), gb[1] * siluf_(z[1])); qq.y = pk2(gb[2] * siluf_(z[2]), gb[3] * siluf_(z[3]));
                *(u32x2*)(P + row * 2048 + ch) = pp; *(u32x2*)(Q + row * 2048 + ch) = qq;
            }
    }
};

__device__ __forceinline__ int src_col(int mode, int n, int& pn_unused) {
    (void)pn_unused;
    if (mode == 0) return n;
    if (mode == 1) { if (n < 4096) return n; if (n < 6144) return n + 16; if (n < 6160) return n - 2048; return -1; }
    const int pn = n >> 8, col = n & 255, bj = col >> 7, wc = (col >> 5) & 3, nn = (col >> 4) & 1, lo = col & 15;
    return (2 * bj + nn) * 2048 + pn * 64 + 16 * wc + lo;
}
struct CvtTile { const float* W; bf16_t* Wt; int K, Nsrc, mode, n0, k0; };
__device__ __forceinline__ CvtTile cvt_decode(const Prm& p, int tix) {
    CvtTile t; int tl = tix;
    if (tl < 1600) { t.W = p.in[3]; t.Wt = (bf16_t*)(p.ws + OFF_WT1); t.K = 1024; t.Nsrc = 6160; t.mode = 1; }
    else if ((tl -= 1600) < 256) { t.W = p.in[16]; t.Wt = (bf16_t*)(p.ws + OFF_WTG); t.K = 1024; t.Nsrc = 1024; t.mode = 0; }
    else if ((tl -= 256) < 512) { t.W = p.in[17]; t.Wt = (bf16_t*)(p.ws + OFF_WTO0); t.K = 2048; t.Nsrc = 1024; t.mode = 0; }
    else if ((tl -= 512) < 2048) { t.W = p.in[18]; t.Wt = (bf16_t*)(p.ws + OFF_WT2); t.K = 1024; t.Nsrc = 8192; t.mode = 2; }
    else { tl -= 2048; t.W = p.in[20]; t.Wt = (bf16_t*)(p.ws + OFF_WTO1); t.K = 2048; t.Nsrc = 1024; t.mode = 0; }
    const int ntk = t.K / 64; t.n0 = (tl / ntk) * 64; t.k0 = (tl % ntk) * 64; return t;
}
__device__ __forceinline__ void phase_convert(const Prm& p, unsigned char* lds, int t_begin, int t_end, int nblk, int bidx) {
    float* tiles = (float*)lds;
    const int tid = threadIdx.x, j = tid & 63, kr = tid >> 6, r = tid >> 3, c8 = (tid & 7) * 8;
    for (int base = t_begin + bidx * 4; base < t_end; base += nblk * 4) {
        float v[4][8];
#pragma unroll
        for (int q = 0; q < 4; ++q) {
            const int tix = base + q < t_end ? base + q : t_end - 1;
            const CvtTile t = cvt_decode(p, tix);
            int dummy = 0; const int sc = src_col(t.mode, t.n0 + j, dummy);
#pragma unroll
            for (int i = 0; i < 8; ++i) v[q][i] = sc >= 0 ? t.W[(size_t)(t.k0 + kr + 8 * i) * t.Nsrc + sc] : 0.0f;
        }
#pragma unroll
        for (int q = 0; q < 4; ++q)
#pragma unroll
            for (int i = 0; i < 8; ++i) tiles[q * 4160 + (kr + 8 * i) * 65 + j] = v[q][i];
        __syncthreads();
#pragma unroll
        for (int q = 0; q < 4; ++q) {
            const int tix = base + q < t_end ? base + q : t_end - 1;
            const CvtTile t = cvt_decode(p, tix);
            const float* tl = tiles + q * 4160; u32x4 o;
            o.x = pk2(tl[(c8 + 0) * 65 + r], tl[(c8 + 1) * 65 + r]); o.y = pk2(tl[(c8 + 2) * 65 + r], tl[(c8 + 3) * 65 + r]);
            o.z = pk2(tl[(c8 + 4) * 65 + r], tl[(c8 + 5) * 65 + r]); o.w = pk2(tl[(c8 + 6) * 65 + r], tl[(c8 + 7) * 65 + r]);
            *(u32x4*)(t.Wt + (size_t)(t.n0 + r) * t.K + t.k0 + c8) = o;
        }
        __syncthreads();
    }
}
__device__ __forceinline__ void phase_rmsnorm_x(const float* x, const float* w, bf16_t* H) {
    const int lane = threadIdx.x & 63, nw = gridDim.x * 8;
    for (int row = blockIdx.x * 8 + (threadIdx.x >> 6); row < TOK; row += nw) {
        const f32x4* xr = (const f32x4*)(x + (size_t)row * 1024);
        f32x4 v[4]; float ss = 0.f;
#pragma unroll
        for (int i = 0; i < 4; ++i) { v[i] = xr[lane + 64 * i]; ss += v[i][0] * v[i][0] + v[i][1] * v[i][1] + v[i][2] * v[i][2] + v[i][3] * v[i][3]; }
        ss = wave_sum(ss);
        const float rstd = rsqrtf(ss * (1.0f / 1024.0f) + 1e-6f);
#pragma unroll
        for (int i = 0; i < 4; ++i) { const f32x4 w4 = ((const f32x4*)w)[lane + 64 * i]; u32x2 o;
            o.x = pk2(v[i][0] * rstd * w4[0], v[i][1] * rstd * w4[1]); o.y = pk2(v[i][2] * rstd * w4[2], v[i][3] * rstd * w4[3]);
            *(u32x2*)(H + (size_t)row * 1024 + (lane + 64 * i) * 4) = o; }
    }
}
template <bool NEXT>
__device__ __forceinline__ void phase_post(const float* base, const bf16_t* Y, const float* wpost, float* OUT, const float* wpre, bf16_t* H) {
    const int lane = threadIdx.x & 63, nw = gridDim.x * 8;
    for (int row = blockIdx.x * 8 + (threadIdx.x >> 6); row < TOK; row += nw) {
        const u32x2* yr = (const u32x2*)(Y + (size_t)row * 1024); const f32x4* br = (const f32x4*)(base + (size_t)row * 1024);
        f32x4 v[4], xb[4]; float ss = 0.f;
#pragma unroll
        for (int i = 0; i < 4; ++i) { const u32x2 y2 = yr[lane + 64 * i]; v[i] = (f32x4){lo2f(y2.x), hi2f(y2.x), lo2f(y2.y), hi2f(y2.y)}; xb[i] = br[lane + 64 * i]; ss += v[i][0] * v[i][0] + v[i][1] * v[i][1] + v[i][2] * v[i][2] + v[i][3] * v[i][3]; }
        ss = wave_sum(ss);
        const float rstd = rsqrtf(ss * (1.0f / 1024.0f) + 1e-6f);
        float s2 = 0.f;
#pragma unroll
        for (int i = 0; i < 4; ++i) { const f32x4 w4 = ((const f32x4*)wpost)[lane + 64 * i];
#pragma unroll
            for (int e = 0; e < 4; ++e) { v[i][e] = xb[i][e] + v[i][e] * rstd * w4[e]; s2 += v[i][e] * v[i][e]; }
            ((f32x4*)(OUT + (size_t)row * 1024))[lane + 64 * i] = v[i]; }
        if (NEXT) {
            s2 = wave_sum(s2);
            const float r2 = rsqrtf(s2 * (1.0f / 1024.0f) + 1e-6f);
#pragma unroll
            for (int i = 0; i < 4; ++i) { const f32x4 w4 = ((const f32x4*)wpre)[lane + 64 * i]; u32x2 o;
                o.x = pk2(v[i][0] * r2 * w4[0], v[i][1] * r2 * w4[1]); o.y = pk2(v[i][2] * r2 * w4[2], v[i][3] * r2 * w4[3]);
                *(u32x2*)(H + (size_t)row * 1024 + (lane + 64 * i) * 4) = o; }
        }
    }
}


__device__ __forceinline__ void phase_ba(const Prm& p, unsigned char* lds) {
    const int tid = threadIdx.x, wv = tid >> 6, lane = tid & 63, n = lane & 15, kq = lane >> 4, mt = wv & 3, kh = wv >> 2;
    const bf16_t* H = (const bf16_t*)(p.ws + OFF_H); const bf16_t* Wb = (const bf16_t*)(p.ws + OFF_WT1) + (size_t)6144 * 1024; float* BA = (float*)(p.ws + OFF_BA);
    const size_t row0 = (size_t)blockIdx.x * 64 + 16 * mt;
    const bf16_t* ap = H + (row0 + n) * 1024 + 512 * kh + 8 * kq; const bf16_t* bp = Wb + (size_t)n * 1024 + 512 * kh + 8 * kq;
    bf16x8 a[16], b[16];
#pragma unroll
    for (int i = 0; i < 16; ++i) { a[i] = *(const bf16x8*)(ap + i * 32); b[i] = *(const bf16x8*)(bp + i * 32); }
    f32x4 acc = (f32x4){0.f, 0.f, 0.f, 0.f};
#pragma unroll
    for (int i = 0; i < 16; ++i) acc = __builtin_amdgcn_mfma_f32_16x16x32_bf16(a[i], b[i], acc, 0, 0, 0);
    float* part = (float*)lds;
#pragma unroll
    for (int j = 0; j < 4; ++j) part[(kh * 64 + 16 * mt + 4 * kq + j) * 16 + n] = acc[j];
    __syncthreads();
    for (int i = tid; i < 1024; i += 512) BA[(size_t)blockIdx.x * 1024 + i] = part[i] + part[1024 + i];
    __syncthreads();
}
__device__ __forceinline__ void sincos_d(double x, double& s, double& c) {
    const double k = rint(x * 0.6366197723675814);
    const double r = fma(-k, 6.123233995736766e-17, fma(-k, 1.5707963267948966, x)), r2 = r * r;
    double sp = -7.647163731819816e-13; sp = fma(sp, r2, 1.6059043836821613e-10); sp = fma(sp, r2, -2.505210838544172e-8); sp = fma(sp, r2, 2.7557319223985893e-6);
    sp = fma(sp, r2, -1.984126984126984e-4); sp = fma(sp, r2, 8.333333333333333e-3); sp = fma(sp, r2, -1.6666666666666666e-1); sp = fma(sp * r2, r, r);
    double cp = 4.779477332387385e-14; cp = fma(cp, r2, -1.1470745597729725e-11); cp = fma(cp, r2, 2.08767569878681e-9); cp = fma(cp, r2, -2.755731922398589e-7);
    cp = fma(cp, r2, 2.48015873015873e-5); cp = fma(cp, r2, -1.388888888888889e-3); cp = fma(cp, r2, 4.1666666666666664e-2); cp = fma(cp, r2, -0.5); cp = fma(cp, r2, 1.0);
    const int q = ((int)k) & 3;
    const double s0 = (q & 1) ? cp : sp, c0 = (q & 1) ? sp : cp;
    s = (q & 2) ? -s0 : s0; c = ((q + 1) & 2) ? -c0 : c0;
}
__device__ __forceinline__ double exp_d(double x) {
    const double n = rint(x * 1.4426950408889634);
    const double r = fma(-n, 2.3190468138462996e-17, fma(-n, 0.6931471805599453, x));
    double p = 1.6059043836821613e-10; p = fma(p, r, 2.08767569878681e-9); p = fma(p, r, 2.505210838544172e-8); p = fma(p, r, 2.755731922398589e-7); p = fma(p, r, 2.7557319223985893e-6);
    p = fma(p, r, 2.48015873015873e-5); p = fma(p, r, 1.984126984126984e-4); p = fma(p, r, 1.388888888888889e-3); p = fma(p, r, 8.333333333333333e-3); p = fma(p, r, 4.1666666666666664e-2);
    p = fma(p, r, 1.6666666666666666e-1); p = fma(p, r, 0.5); p = fma(p, r, 1.0); p = fma(p, r, 1.0);
    return ldexp(p, (int)n);
}
__device__ __forceinline__ float bcast_lo(float v) { auto r = __builtin_amdgcn_permlane32_swap(__float_as_uint(v), __float_as_uint(v), false, false); return __uint_as_float(r[0]); }
__device__ __forceinline__ float bcast_hi(float v) { auto r = __builtin_amdgcn_permlane32_swap(__float_as_uint(v), __float_as_uint(v), false, false); return __uint_as_float(r[1]); }

struct S5C {
    float ar[2][4], ai[2][4];
    float a512r[2], a512i[2];
    bf16x8 BB[4];
    bf16x8 CC[4];
    float dco;
};

template <bool OUT>
__device__ __forceinline__ void s5_chunk(const S5C& C, bf16_t* UU, int b, int g, int chunk, float (&st)[2][2], bf16_t* sX, int lane) {
    const int n = lane & 31, hh = lane >> 5, fr = lane & 15, fq = lane >> 4;
    const size_t tok0 = (size_t)b * SEQ + (size_t)chunk * 512;
    bf16x8 ua = *(const bf16x8*)(UU + (tok0 + n) * 1024 + 16 * g + 8 * hh);
    bf16_t uo[8];
    if (OUT) {
#pragma unroll
        for (int mt = 0; mt < 2; ++mt)
#pragma unroll
            for (int j = 0; j < 4; ++j) uo[mt * 4 + j] = UU[(tok0 + 16 * mt + 4 * fq + j) * 1024 + 16 * g + fr];
    }
    for (int blk = 0; blk < 16; ++blk) {
        const size_t t0 = tok0 + (size_t)blk * 32;
        const bf16x8 ucur = ua;
        bf16_t ucuro[8];
        if (OUT) {
#pragma unroll
            for (int i = 0; i < 8; ++i) ucuro[i] = uo[i];
        }
        if (blk < 15) {
            ua = *(const bf16x8*)(UU + (t0 + 32 + n) * 1024 + 16 * g + 8 * hh);
            if (OUT) {
#pragma unroll
                for (int mt = 0; mt < 2; ++mt)
#pragma unroll
                    for (int j = 0; j < 4; ++j) uo[mt * 4 + j] = UU[(t0 + 32 + 16 * mt + 4 * fq + j) * 1024 + 16 * g + fr];
            }
        }
        f32x16 acc[4];
#pragma unroll
        for (int tl = 0; tl < 4; ++tl) {
            f32x16 z;
#pragma unroll
            for (int i = 0; i < 16; ++i) z[i] = 0.f;
            acc[tl] = __builtin_amdgcn_mfma_f32_32x32x16_bf16(ucur, C.BB[tl], z, 0, 0, 0);
        }
#pragma unroll
        for (int tp = 0; tp < 2; ++tp) {
            f32x16& re = acc[2 * tp]; f32x16& im = acc[2 * tp + 1];
            const float a1r = C.ar[tp][0], a1i = C.ai[tp][0];
#pragma unroll
            for (int q = 0; q < 4; ++q)
#pragma unroll
                for (int r = 1; r < 4; ++r) {
                    const float pr = re[4 * q + r - 1], pi = im[4 * q + r - 1];
                    re[4 * q + r] += a1r * pr - a1i * pi; im[4 * q + r] += a1r * pi + a1i * pr;
                }
            float cr = st[tp][0], ci = st[tp][1];
            const float a4r = C.ar[tp][3], a4i = C.ai[tp][3];
#pragma unroll
            for (int q = 0; q < 4; ++q) {
                const float tr = re[4 * q + 3] + a4r * cr - a4i * ci, ti = im[4 * q + 3] + a4r * ci + a4i * cr;
                const float o0r = bcast_lo(tr), o0i = bcast_lo(ti);
                const float xr = hh ? o0r : cr, xi = hh ? o0i : ci;
                if (OUT) {
#pragma unroll
                    for (int r = 0; r < 4; ++r) { const float kr = C.ar[tp][r], ki = C.ai[tp][r];
                        re[4 * q + r] += kr * xr - ki * xi; im[4 * q + r] += kr * xi + ki * xr; }
                } else {
                    re[4 * q + 3] += a4r * xr - a4i * xi; im[4 * q + 3] += a4r * xi + a4i * xr;
                }
                cr = bcast_hi(re[4 * q + 3]); ci = bcast_hi(im[4 * q + 3]);
            }
            st[tp][0] = cr; st[tp][1] = ci;
        }
        if (OUT) {
            asm volatile("s_waitcnt lgkmcnt(0)" ::: "memory");
#pragma unroll
            for (int tp = 0; tp < 2; ++tp)
#pragma unroll
                for (int i = 0; i < 16; ++i) {
                    const int t = 8 * (i >> 2) + 4 * hh + (i & 3);
                    *(unsigned*)(sX + t * 136 + 2 * (n + 32 * tp)) = pk2(acc[2 * tp][i], acc[2 * tp + 1][i]);
                }
            asm volatile("s_waitcnt lgkmcnt(0)" ::: "memory");
            __builtin_amdgcn_wave_barrier();
#pragma unroll
            for (int mt = 0; mt < 2; ++mt) {
                f32x4 y = (f32x4){0.f, 0.f, 0.f, 0.f};
#pragma unroll
                for (int ks = 0; ks < 4; ++ks) {
                    const bf16x8 xa = *(const bf16x8*)(sX + (16 * mt + fr) * 136 + 32 * ks + 8 * fq);
                    y = __builtin_amdgcn_mfma_f32_16x16x32_bf16(xa, C.CC[ks], y, 0, 0, 0);
                }
#pragma unroll
                for (int j = 0; j < 4; ++j) {
                    float v = y[j] + C.dco * bf2f(ucuro[mt * 4 + j]);
                    const float inner = 0.7978845608028654f * (v + 0.044715f * v * v * v);
                    v = v / (1.0f + __expf(-2.0f * inner));
                    UU[(t0 + 16 * mt + 4 * fq + j) * 1024 + 16 * g + fr] = f2bf(v);
                }
            }
            asm volatile("s_waitcnt lgkmcnt(0)" ::: "memory");
            __builtin_amdgcn_wave_barrier();
        }
    }
}

__device__ __forceinline__ void phase_s5(const Prm& p, unsigned char* lds, int bg) {
    const int b = bg >> 6, g = bg & 63;
    const int tid = threadIdx.x, wv = tid >> 6, lane = tid & 63, n = lane & 31, hh = lane >> 5, fr = lane & 15, fq = lane >> 4;
    bf16_t* sX = (bf16_t*)(lds + wv * 8704);
    float* sXE = (float*)(lds + 8 * 8704);
    bf16_t* UU = (bf16_t*)(p.ws + OFF_UU);
    const float* lam_re = p.in[8]; const float* lam_im = p.in[9]; const float* b_re = p.in[10]; const float* b_im = p.in[11];
    const float* c_re = p.in[12]; const float* c_im = p.in[13];
    S5C C;
    const double dt = exp_d((double)p.in[14][g]);
    float fre[2], fim[2];
#pragma unroll
    for (int tp = 0; tp < 2; ++tp) {
        const int pp = n + 32 * tp;
        const double lr = (double)fminf(lam_re[g * 64 + pp], -1e-4f), li = (double)lam_im[g * 64 + pp];
#pragma unroll
        for (int k = 0; k < 4; ++k) { double sn, cs; sincos_d(li * dt * (k + 1), sn, cs); const double mag = exp_d(lr * dt * (k + 1)); C.ar[tp][k] = (float)(mag * cs); C.ai[tp][k] = (float)(mag * sn); }
        { double sn, cs; sincos_d(li * dt * 512.0, sn, cs); const double mag = exp_d(lr * dt * 512.0); C.a512r[tp] = (float)(mag * cs); C.a512i[tp] = (float)(mag * sn); }
        double sn, cs; sincos_d(li * dt, sn, cs);
        const double mag = exp_d(lr * dt), abr = mag * cs, abi = mag * sn;
        const double den = lr * lr + li * li, nr = abr - 1.0, ni = abi;
        fre[tp] = (float)((nr * lr + ni * li) / den); fim[tp] = (float)((ni * lr - nr * li) / den);
    }
#pragma unroll
    for (int tl = 0; tl < 4; ++tl) {
        const int tp = tl >> 1, ri = tl & 1, pp = n + 32 * tp;
#pragma unroll
        for (int j = 0; j < 8; ++j) {
            const int ch = 8 * hh + j;
            const float br = b_re[(g * 64 + pp) * 16 + ch], bi = b_im[(g * 64 + pp) * 16 + ch];
            const float v = ri == 0 ? fre[tp] * br - fim[tp] * bi : fre[tp] * bi + fim[tp] * br;
            C.BB[tl][j] = (short)f2bf(v);
        }
    }
#pragma unroll
    for (int ks = 0; ks < 4; ++ks)
#pragma unroll
        for (int j = 0; j < 8; ++j) {
            const int k = 32 * ks + 8 * fq + j, pp = k >> 1, ri = k & 1;
            const float v = ri == 0 ? c_re[(g * 16 + fr) * 64 + pp] : -c_im[(g * 16 + fr) * 64 + pp];
            C.CC[ks][j] = (short)f2bf(v);
        }
    C.dco = p.in[15][16 * g + fr];
    for (int rd = 0; rd < 2; ++rd) {
        const int chunk = wv + 8 * rd;
        float st[2][2] = {{0.f, 0.f}, {0.f, 0.f}};
        s5_chunk<false>(C, UU, b, g, chunk, st, sX, lane);
        if (hh == 0) {
#pragma unroll
            for (int tp = 0; tp < 2; ++tp) { sXE[(chunk * 64 + n + 32 * tp) * 2 + 0] = st[tp][0]; sXE[(chunk * 64 + n + 32 * tp) * 2 + 1] = st[tp][1]; }
        }
    }
    __syncthreads();
    for (int rd = 0; rd < 2; ++rd) {
        const int chunk = wv + 8 * rd;
        float st[2][2] = {{0.f, 0.f}, {0.f, 0.f}};
        for (int c2 = 0; c2 < chunk; ++c2) {
#pragma unroll
            for (int tp = 0; tp < 2; ++tp) {
                const float er = sXE[(c2 * 64 + n + 32 * tp) * 2 + 0], ei = sXE[(c2 * 64 + n + 32 * tp) * 2 + 1];
                const float nr = C.a512r[tp] * st[tp][0] - C.a512i[tp] * st[tp][1] + er, ni = C.a512r[tp] * st[tp][1] + C.a512i[tp] * st[tp][0] + ei;
                st[tp][0] = nr; st[tp][1] = ni;
            }
        }
        s5_chunk<true>(C, UU, b, g, chunk, st, sX, lane);
        if (rd == 0) {
            asm volatile("s_waitcnt vmcnt(0)" ::: "memory");
            __syncthreads();
            if (threadIdx.x == 0) { __builtin_amdgcn_fence(__ATOMIC_RELEASE, "agent"); asm volatile("s_waitcnt vmcnt(0)" ::: "memory");
                __hip_atomic_fetch_add((unsigned*)(p.ws + OFF_BAR) + 3900, 1u, __ATOMIC_RELAXED, __HIP_MEMORY_SCOPE_AGENT); }
        }
    }
    __syncthreads();
}

__device__ __forceinline__ void phase_gdn_prep(const Prm& p, unsigned char* lds, int it0, int nrounds) {
    const int tid0 = threadIdx.x, hb = tid0 >> 8;
    unsigned char* base = lds + hb * 76800;
    bf16_t* sQ = (bf16_t*)base;
    bf16_t* sK = (bf16_t*)(base + 17408);
    bf16_t* sV = (bf16_t*)(base + 2 * 17408);
    float* sL = (float*)(base + 3 * 17408);
    float* sBeta = (float*)(base + 4 * 17408);
    float* sGc = sBeta + 64; float* sEg = sGc + 64; float* sBE = sEg + 64;
    float* sCW = sBE + 64;
    bf16_t* QKV = (bf16_t*)(p.ws + OFF_QKV); const bf16_t* HALO = (const bf16_t*)(p.ws + OFF_HALO);
    const float* BA = (const float*)(p.ws + OFF_BA); float* GL = (float*)(p.ws + OFF_GL);
    bf16_t* WB = (bf16_t*)(p.ws + OFF_WB); bf16_t* ATT = (bf16_t*)(p.ws + OFF_ATT);
    const float* convw = p.in[4];
    for (int rd = 0; rd < nrounds; ++rd) {
        int tid = tid0; asm volatile("" : "+v"(tid));
        const int ht = tid & 255, hw = (tid >> 6) & 3, lane = tid & 63, fr = lane & 15, fq = lane >> 4;
        const int it = it0 + rd * 2 + hb;
        const int b = it >> 10, h = (it >> 7) & 7, nc = it & 127;
        const size_t tokb = (size_t)b * SEQ + (size_t)nc * 64;
#pragma unroll
        for (int i = 0; i < 6; ++i) { const int idx = ht + 256 * i, s3 = idx >> 9, tap = (idx >> 7) & 3, ch = idx & 127; sCW[idx] = convw[tap * 3072 + s3 * 1024 + h * 128 + ch]; }
        __syncthreads();
        {
            const int t0 = (ht >> 4) * 4, cgp = ht & 15;
            u32x4 xall[3][7];
#pragma unroll
            for (int s = 0; s < 3; ++s) {
                const int col = s * 1024 + h * 128 + cgp * 8;
#pragma unroll
                for (int i = 0; i < 7; ++i) {
                    const int tt = t0 - 3 + i;
                    xall[s][i] = (u32x4){0u, 0u, 0u, 0u};
                    if (tt >= 0) xall[s][i] = *(const u32x4*)(QKV + (tokb + tt) * 3072 + col);
                    else if (nc > 0) xall[s][i] = *(const u32x4*)(HALO + ((size_t)(b * 128 + nc - 1) * 3 + (3 + tt)) * 3072 + col);
                }
            }
#pragma unroll
            for (int s = 0; s < 3; ++s) {
                u32x4 xr[7];
#pragma unroll
                for (int i = 0; i < 7; ++i) xr[i] = xall[s][i];
                f32x4 w0[4], w1[4];
#pragma unroll
                for (int j = 0; j < 4; ++j) { w0[j] = *(const f32x4*)(sCW + s * 512 + j * 128 + cgp * 8); w1[j] = *(const f32x4*)(sCW + s * 512 + j * 128 + cgp * 8 + 4); }
                float o[4][8], ss[4];
#pragma unroll
                for (int tk = 0; tk < 4; ++tk) {
                    float a[8];
#pragma unroll
                    for (int e = 0; e < 8; ++e) a[e] = 0.f;
#pragma unroll
                    for (int j = 0; j < 4; ++j) {
                        const u32x4 xv = xr[tk + j];
                        a[0] += w0[j][0] * lo2f(xv.x); a[1] += w0[j][1] * hi2f(xv.x); a[2] += w0[j][2] * lo2f(xv.y); a[3] += w0[j][3] * hi2f(xv.y);
                        a[4] += w1[j][0] * lo2f(xv.z); a[5] += w1[j][1] * hi2f(xv.z); a[6] += w1[j][2] * lo2f(xv.w); a[7] += w1[j][3] * hi2f(xv.w);
                    }
                    float acc2 = 0.f;
#pragma unroll
                    for (int e = 0; e < 8; ++e) { const float v = siluf_(a[e]); o[tk][e] = v; acc2 += v * v; }
                    ss[tk] = acc2;
                }
                bf16_t* dst = (s == 0 ? sQ : (s == 1 ? sK : sV)) + t0 * 136 + cgp * 8;
#pragma unroll
                for (int tk = 0; tk < 4; ++tk) {
                    float sc = 1.0f;
                    if (s < 2) { float q = ss[tk]; q += __shfl_xor(q, 1); q += __shfl_xor(q, 2); q += __shfl_xor(q, 4); q += __shfl_xor(q, 8); sc = rsqrtf(q + 1e-6f) * (s == 0 ? 0.08838834764831845f : 1.0f); }
                    u32x4 pk;
                    pk.x = pk2(o[tk][0] * sc, o[tk][1] * sc); pk.y = pk2(o[tk][2] * sc, o[tk][3] * sc); pk.z = pk2(o[tk][4] * sc, o[tk][5] * sc); pk.w = pk2(o[tk][6] * sc, o[tk][7] * sc);
                    *(u32x4*)(dst + tk * 136) = pk;
                }
            }
        }
        if (hw == 0) {
            const size_t tg = tokb + lane;
            const float braw = BA[tg * 16 + h], araw = BA[tg * 16 + 8 + h];
            const float beta = 1.0f / (1.0f + expf(-braw));
            const float xx = araw + p.in[6][h];
            const float sp = xx > 20.f ? xx : log1pf(expf(xx));
            float gg = -expf(p.in[5][h]) * sp;
#pragma unroll
            for (int off = 1; off < 64; off <<= 1) { const float o = __shfl_up(gg, off); if (lane >= off) gg += o; }
            sBeta[lane] = beta; sGc[lane] = gg; sEg[lane] = expf(gg); sBE[lane] = beta * expf(gg);
            if (lane == 63) GL[it] = expf(gg);
        }
        __syncthreads();
        {
            bf16x8 aK[4], aQ[4];
#pragma unroll
            for (int ks = 0; ks < 4; ++ks) { aK[ks] = *(const bf16x8*)(sK + (16 * hw + fr) * 136 + 32 * ks + 8 * fq); aQ[ks] = *(const bf16x8*)(sQ + (16 * hw + fr) * 136 + 32 * ks + 8 * fq); }
#pragma unroll
            for (int nt = 0; nt < 4; ++nt) {
                f32x4 kk = (f32x4){0.f, 0.f, 0.f, 0.f}, qk = (f32x4){0.f, 0.f, 0.f, 0.f};
#pragma unroll
                for (int ks = 0; ks < 4; ++ks) {
                    const bf16x8 bK = *(const bf16x8*)(sK + (16 * nt + fr) * 136 + 32 * ks + 8 * fq);
                    kk = __builtin_amdgcn_mfma_f32_16x16x32_bf16(aK[ks], bK, kk, 0, 0, 0);
                    qk = __builtin_amdgcn_mfma_f32_16x16x32_bf16(aQ[ks], bK, qk, 0, 0, 0);
                }
                const int mcol = 16 * nt + fr; const float gm = sGc[mcol];
#pragma unroll
                for (int j = 0; j < 4; ++j) {
                    const int c = 16 * hw + 4 * fq + j;
                    const float dec = __expf(fminf(sGc[c] - gm, 0.f));
                    sL[c * 68 + mcol] = (mcol < c) ? kk[j] * sBeta[c] * dec : 0.f;
                    ATT[(size_t)it * 4096 + c * 64 + mcol] = f2bf((mcol <= c) ? qk[j] * dec : 0.f);
                }
            }
        }
        __syncthreads();
        {
            f32x2_t xv[32];
#define X_(i) (xv[(i) >> 1][(i) & 1])
            const bool isU = ht < 128; const int jc = ht & 127;
            const bf16_t* src = isU ? sV : sK;
            const float* fac = isU ? sBeta : sBE;
#pragma unroll
            for (int cb = 0; cb < 16; ++cb) {
                f32x2_t a2[4];
#pragma unroll
                for (int r = 0; r < 4; ++r) { a2[r].x = bf2f(src[(4 * cb + r) * 136 + jc]) * fac[4 * cb + r]; a2[r].y = 0.f; }
                const f32x4 d1 = *(const f32x4*)(sL + (4 * cb + 1) * 68 + 4 * cb), d2 = *(const f32x4*)(sL + (4 * cb + 2) * 68 + 4 * cb), d3 = *(const f32x4*)(sL + (4 * cb + 3) * 68 + 4 * cb);
                const int nb = (cb + 1) / 2;
                f32x4 lb[2][4][2];
#define SOLVE_LOAD(mb_, buf_) do { _Pragma("unroll") for (int q = 0; q < 2; ++q) _Pragma("unroll") for (int r = 0; r < 4; ++r) \
                    if (2 * (mb_) + q < cb) lb[buf_][r][q] = *(const f32x4*)(sL + (4 * cb + r) * 68 + 4 * (2 * (mb_) + q)); } while (0)
                if (nb > 0) SOLVE_LOAD(0, 0);
#pragma unroll
                for (int mb = 0; mb < nb; ++mb) {
                    if (mb + 1 < nb) SOLVE_LOAD(mb + 1, (mb + 1) & 1);
                    __builtin_amdgcn_sched_barrier(0);
#pragma unroll
                    for (int q = 0; q < 2; ++q)
#pragma unroll
                        for (int r = 0; r < 4; ++r)
                            if (2 * mb + q < cb) { const f32x4 l = lb[mb & 1][r][q]; const int m2 = 2 * (2 * mb + q);
                                a2[r] -= (f32x2_t){l[0], l[1]} * xv[m2]; a2[r] -= (f32x2_t){l[2], l[3]} * xv[m2 + 1]; }
                    __builtin_amdgcn_sched_barrier(0);
                }
#undef SOLVE_LOAD
                const float a0 = a2[0].x + a2[0].y, a1 = a2[1].x + a2[1].y, a2s = a2[2].x + a2[2].y, a3 = a2[3].x + a2[3].y;
                const float y0 = a0, y1 = a1 - d1[0] * y0, y2 = a2s - d2[0] * y0 - d2[1] * y1, y3 = a3 - d3[0] * y0 - d3[1] * y1 - d3[2] * y2;
                xv[2 * cb] = (f32x2_t){y0, y1}; xv[2 * cb + 1] = (f32x2_t){y2, y3};
            }
            if (isU) {
                const int w8 = jc >> 4, nn = jc & 15;
#pragma unroll
                for (int rq = 0; rq < 4; ++rq)
#pragma unroll
                    for (int pc = 0; pc < 2; ++pc) {
                        const int c0 = 32 * pc + 8 * rq;
                        u32x4 o; o.x = pk2(X_(c0 + 0), X_(c0 + 1)); o.y = pk2(X_(c0 + 2), X_(c0 + 3)); o.z = pk2(X_(c0 + 4), X_(c0 + 5)); o.w = pk2(X_(c0 + 6), X_(c0 + 7));
                        const int L = ((w8 * 2 + pc) * 64 + rq * 16 + nn) * 8;
                        *(u32x4*)(QKV + (tokb + (L >> 7)) * 3072 + 2048 + h * 128 + (L & 127)) = o;
                    }
            }
            __syncthreads();
            if (!isU) {
                bf16_t* sW2 = (bf16_t*)sL;
#pragma unroll
                for (int c = 0; c < 64; ++c) sW2[c * 136 + jc] = f2bf(-X_(c));
            }
        }
        __syncthreads();
        {
            const bf16_t* sW2 = (const bf16_t*)sL;
#pragma unroll
            for (int i = 0; i < 4; ++i) { const int ch = ht + 256 * i, r = ch >> 4, c8 = (ch & 15) * 8; *(u32x4*)(WB + (size_t)it * 8192 + r * 128 + c8) = *(const u32x4*)(sW2 + r * 136 + c8); }
        }
#undef X_
        {
            const int c = ht >> 2, ds = (ht & 3) * 32; const float eg = sEg[c];
#pragma unroll
            for (int c8 = 0; c8 < 4; ++c8) {
                const u32x4 v = *(const u32x4*)(sQ + c * 136 + ds + c8 * 8); u32x4 o;
                o.x = pk2(lo2f(v.x) * eg, hi2f(v.x) * eg); o.y = pk2(lo2f(v.y) * eg, hi2f(v.y) * eg); o.z = pk2(lo2f(v.z) * eg, hi2f(v.z) * eg); o.w = pk2(lo2f(v.w) * eg, hi2f(v.w) * eg);
                *(u32x4*)(QKV + (tokb + c) * 3072 + h * 128 + ds + c8 * 8) = o;
            }
            const int d = ht >> 1, cs = (ht & 1) * 32; const float gl = sGc[63];
#pragma unroll
            for (int c8 = 0; c8 < 4; ++c8) {
                float v[8];
#pragma unroll
                for (int e = 0; e < 8; ++e) { const int cc = cs + c8 * 8 + e; v[e] = bf2f(sK[cc * 136 + d]) * __expf(gl - sGc[cc]); }
                u32x4 o; o.x = pk2(v[0], v[1]); o.y = pk2(v[2], v[3]); o.z = pk2(v[4], v[5]); o.w = pk2(v[6], v[7]);
                *(u32x4*)(QKV + (tokb + (d >> 1)) * 3072 + 1024 + h * 128 + (d & 1) * 64 + cs + c8 * 8) = o;
            }
        }
        __syncthreads();
    }
}

constexpr int SC_WQ = 32768, SC_KA = 24576, SC_KA0 = 3 * SC_WQ;
static_assert(SC_KA0 + 2 * SC_KA <= LDS_BYTES, "scan LDS layout");
__device__ __forceinline__ bf16x8 pack2(const f32x4& a, const f32x4& b) {
    u32x4 r; r.x = pk2(a[0], a[1]); r.y = pk2(a[2], a[3]); r.z = pk2(b[0], b[1]); r.w = pk2(b[2], b[3]); return __builtin_bit_cast(bf16x8, r);
}
#define MF16(a, b, c) __builtin_amdgcn_mfma_f32_16x16x32_bf16(a, b, c, 0, 0, 0)
#define DMA16(src, dst) __builtin_amdgcn_global_load_lds((const unsigned*)(src), (LAS unsigned*)(dst), 16, 0, 0)
__device__ __forceinline__ void phase_gdn_scan(const Prm& p, LAS unsigned char* lds, int blk) {
    const int tid = threadIdx.x, wv = __builtin_amdgcn_readfirstlane(tid >> 6), lane = tid & 63, n = lane & 15, kq = lane >> 4;
    const int bh = blk & 15, jh = blk >> 4, b = bh >> 3, h = bh & 7;
    const bf16_t* QKV = (const bf16_t*)(p.ws + OFF_QKV); const bf16_t* WB = (const bf16_t*)(p.ws + OFF_WB); const bf16_t* ATT = (const bf16_t*)(p.ws + OFF_ATT);
    const float* GL = (const float*)(p.ws + OFF_GL); bf16_t* O = (bf16_t*)(p.ws + OFF_H);
    const int itb = bh * 128;
    const bf16_t* qkv_b = QKV + (size_t)b * SEQ * 3072;
    if (wv >= 4) {
        const int lw = wv - 4;
        __builtin_amdgcn_s_setprio(3);
        unsigned oW[4], oQ[4], oK[4], oA[2];
#pragma unroll
        for (int i = 0; i < 4; ++i) {
            { const int q = lw * 4 + i, row = 4 * q + (lane >> 4), pg = lane & 15, g = pg ^ ((row & 3) | (((row >> 3) & 3) << 2)); oW[i] = (unsigned)(row * 128 + g * 8); oQ[i] = (unsigned)(row * 3072 + h * 128 + g * 8); }
            { const int q = lw * 4 + i, d = 8 * q + (lane >> 3), pg = lane & 7, g = pg ^ ((d & 3) | (((d >> 3) & 1) << 2)); oK[i] = (unsigned)((d >> 1) * 3072 + 1024 + h * 128 + (d & 1) * 64 + g * 8); }
        }
#pragma unroll
        for (int i = 0; i < 2; ++i) { const int q = lw * 2 + i, c = 8 * q + (lane >> 3), pg = lane & 7, g = pg ^ ((c & 3) | (((c >> 3) & 1) << 2)); oA[i] = (unsigned)(c * 64 + g * 8); }
#define ISSUE_WQ(ck, st) do { const bf16_t* wb_ = WB + (size_t)(itb + (ck)) * 8192; const bf16_t* qb_ = qkv_b + (size_t)(ck) * 64 * 3072; LAS unsigned char* d_ = lds + (st) * SC_WQ + lw * 4096; \
        _Pragma("unroll") for (int i = 0; i < 4; ++i) { DMA16(wb_ + oW[i], d_ + i * 1024); DMA16(qb_ + oQ[i], d_ + 16384 + i * 1024); } } while (0)
#define ISSUE_KA(ck, st) do { const bf16_t* qb_ = qkv_b + (size_t)(ck) * 64 * 3072; const bf16_t* ab_ = ATT + (size_t)(itb + (ck)) * 4096; LAS unsigned char* d_ = lds + SC_KA0 + (st) * SC_KA; \
        _Pragma("unroll") for (int i = 0; i < 4; ++i) DMA16(qb_ + oK[i], d_ + (lw * 4 + i) * 1024); \
        _Pragma("unroll") for (int i = 0; i < 2; ++i) DMA16(ab_ + oA[i], d_ + 16384 + (lw * 2 + i) * 1024); } while (0)
        ISSUE_WQ(0, 0); ISSUE_KA(0, 0); ISSUE_WQ(1, 1);
        asm volatile("s_waitcnt vmcnt(0)" ::: "memory"); __builtin_amdgcn_s_barrier(); asm volatile("" ::: "memory");
        int s3 = 2;
        for (int nc = 0; nc < 128; ++nc) {
            const int c1 = nc + 1 < 128 ? nc + 1 : 127, c2 = nc + 2 < 128 ? nc + 2 : 127;
            ISSUE_WQ(c2, s3);
            ISSUE_KA(c1, (nc + 1) & 1);
            s3 = s3 == 2 ? 0 : s3 + 1;
            asm volatile("s_waitcnt vmcnt(14)" ::: "memory");
            __builtin_amdgcn_s_barrier(); asm volatile("" ::: "memory");
            __builtin_amdgcn_s_barrier(); asm volatile("" ::: "memory");
        }
        asm volatile("s_waitcnt vmcnt(0)" ::: "memory");
        __builtin_amdgcn_s_setprio(0);
#undef ISSUE_WQ
#undef ISSUE_KA
    } else if (wv >= 2) {
        for (int nc = 0; nc < 257; ++nc) { __builtin_amdgcn_s_barrier(); asm volatile("" ::: "memory"); }
    } else {
        const float gl0 = GL[itb + lane], gl1 = GL[itb + 64 + lane];
        f32x4 S[8];
#pragma unroll
        for (int dt = 0; dt < 8; ++dt) S[dt] = (f32x4){0.f, 0.f, 0.f, 0.f};
        const int e = 32 * jh + 16 * wv + n;
        unsigned uo[2];
#pragma unroll
        for (int pc = 0; pc < 2; ++pc) { const int L = (((2 * jh + wv) * 2 + pc) * 64 + lane) * 8; uo[pc] = (unsigned)((L >> 7) * 3072 + 2048 + h * 128 + (L & 127)); }
        u32x4 ua[2], ub[2];
#pragma unroll
        for (int pc = 0; pc < 2; ++pc) { ua[pc] = *(const u32x4*)(qkv_b + uo[pc]); ub[pc] = *(const u32x4*)(qkv_b + (size_t)64 * 3072 + uo[pc]); }
        const int rowb = 8 * (n >> 2) + (n & 3), swk = (n & 3) | (((n >> 2) & 1) << 2);
        unsigned offW[4], offK[2];
#pragma unroll
        for (int ks = 0; ks < 4; ++ks) offW[ks] = (unsigned)(rowb * 256 + (((4 * ks + kq) ^ n) << 4));
#pragma unroll
        for (int k2 = 0; k2 < 2; ++k2) offK[k2] = (unsigned)(rowb * 128 + (((4 * k2 + kq) ^ swk) << 4));
        asm volatile("s_waitcnt lgkmcnt(0)" ::: "memory"); __builtin_amdgcn_s_barrier(); asm volatile("" ::: "memory");
        int s3 = 0;
        for (int nc = 0; nc < 128; ++nc) {
            const LAS unsigned char* sWQ = lds + s3 * SC_WQ; const LAS unsigned char* sKA = lds + SC_KA0 + (nc & 1) * SC_KA;
            s3 = s3 == 2 ? 0 : s3 + 1;
            const float gl = __builtin_bit_cast(float, __builtin_amdgcn_readlane(__builtin_bit_cast(int, nc < 64 ? gl0 : gl1), nc & 63));
            f32x4 V[4], Oa[4];
#pragma unroll
            for (int pc = 0; pc < 2; ++pc) {
                const u32x4 uu = ua[pc];
                V[2 * pc] = (f32x4){lo2f(uu.x), hi2f(uu.x), lo2f(uu.y), hi2f(uu.y)}; V[2 * pc + 1] = (f32x4){lo2f(uu.z), hi2f(uu.z), lo2f(uu.w), hi2f(uu.w)};
                ua[pc] = ub[pc];
            }
            { const int c2 = nc + 2 < 128 ? nc + 2 : 127; const bf16_t* ubase = qkv_b + (size_t)c2 * 64 * 3072;
#pragma unroll
              for (int pc = 0; pc < 2; ++pc) ub[pc] = *(const u32x4*)(ubase + uo[pc]); }
#pragma unroll
            for (int ct = 0; ct < 4; ++ct) Oa[ct] = (f32x4){0.f, 0.f, 0.f, 0.f};
            bf16x8 fa[2][8];
#define TOFF(t, pitch) ((32 * ((t) >> 1) + 4 * ((t) & 1)) * (pitch))
#define LD_WQ(dst, ks_) do { _Pragma("unroll") for (int mt = 0; mt < 4; ++mt) { dst[mt] = *(const LAS bf16x8*)(sWQ + offW[ks_] + TOFF(mt, 256)); dst[4 + mt] = *(const LAS bf16x8*)(sWQ + 16384 + offW[ks_] + TOFF(mt, 256)); } } while (0)
            LD_WQ(fa[0], 0);
#pragma unroll
            for (int ks = 0; ks < 4; ++ks) {
                if (ks < 3) LD_WQ(fa[(ks + 1) & 1], ks + 1);
                const bf16x8 sb8 = pack2(S[2 * ks], S[2 * ks + 1]);
                __builtin_amdgcn_sched_barrier(0);
#pragma unroll
                for (int mt = 0; mt < 4; ++mt) { V[mt] = MF16(fa[ks & 1][mt], sb8, V[mt]); Oa[mt] = MF16(fa[ks & 1][4 + mt], sb8, Oa[mt]); }
                __builtin_amdgcn_sched_barrier(0);
            }
#undef LD_WQ
            asm volatile("s_waitcnt lgkmcnt(0)" ::: "memory"); __builtin_amdgcn_s_barrier(); asm volatile("" ::: "memory");
            bf16x8 fb[2][12];
#define LD_AK(dst, k2_) do { _Pragma("unroll") for (int mt = 0; mt < 4; ++mt) dst[mt] = *(const LAS bf16x8*)(sKA + 16384 + offK[k2_] + TOFF(mt, 128)); \
                             _Pragma("unroll") for (int dt = 0; dt < 8; ++dt) dst[4 + dt] = *(const LAS bf16x8*)(sKA + offK[k2_] + TOFF(dt, 128)); } while (0)
            LD_AK(fb[0], 0);
            bf16x8 Vb[2];
            Vb[0] = pack2(V[0], V[1]); Vb[1] = pack2(V[2], V[3]);
#pragma unroll
            for (int dt = 0; dt < 8; ++dt) S[dt] *= gl;
#pragma unroll
            for (int k2 = 0; k2 < 2; ++k2) {
                if (k2 < 1) LD_AK(fb[1], 1);
                __builtin_amdgcn_sched_barrier(0);
#pragma unroll
                for (int mt = 0; mt < 4; ++mt) Oa[mt] = MF16(fb[k2][mt], Vb[k2], Oa[mt]);
#pragma unroll
                for (int dt = 0; dt < 8; ++dt) S[dt] = MF16(fb[k2][4 + dt], Vb[k2], S[dt]);
                __builtin_amdgcn_sched_barrier(0);
            }
#undef LD_AK
#undef TOFF
            bf16_t* obase = O + (size_t)(itb + nc) * 8192 + e * 64 + 8 * kq;
#pragma unroll
            for (int pc = 0; pc < 2; ++pc) *(u32x4*)(obase + 32 * pc) = pack8(Oa[2 * pc], Oa[2 * pc + 1]);
            asm volatile("s_waitcnt lgkmcnt(0)" ::: "memory"); __builtin_amdgcn_s_barrier(); asm volatile("" ::: "memory");
        }
    }
    __syncthreads();
}

__device__ __forceinline__ void phase_ya(const Prm& p, unsigned char* lds) {
    const bf16_t* OT = (const bf16_t*)(p.ws + OFF_H); bf16_t* SZA = (bf16_t*)p.out;
    const float* gw = p.in[7];
    bf16_t* sT = (bf16_t*)lds;
    float* sPart = (float*)(lds + 16384);
    const int tid = threadIdx.x, w = tid >> 6, c = tid & 63;
    for (int it = blockIdx.x; it < NIT; it += gridDim.x) {
        const int b = it >> 10, h = (it >> 7) & 7, nc = it & 127;
        const size_t tok = (size_t)b * SEQ + (size_t)nc * 64 + c;
#pragma unroll
        for (int i = 0; i < 2; ++i) { const int ch = tid + 512 * i; *(u32x4*)(sT + ch * 8) = *(const u32x4*)(OT + (size_t)it * 8192 + ch * 8); }
        const u32x4 z0 = *(const u32x4*)(SZA + tok * 1024 + h * 128 + 16 * w), z1 = *(const u32x4*)(SZA + tok * 1024 + h * 128 + 16 * w + 8);
        __syncthreads();
        float o[16]; float ss = 0.f;
#pragma unroll
        for (int j = 0; j < 16; ++j) { o[j] = bf2f(sT[(16 * w + j) * 64 + c]); ss += o[j] * o[j]; }
        sPart[w * 64 + c] = ss;
        __syncthreads();
        float tot = 0.f;
#pragma unroll
        for (int k = 0; k < 8; ++k) tot += sPart[k * 64 + c];
        const float rstd = rsqrtf(tot * (1.0f / 128.0f) + 1e-6f);
        const unsigned zz[8] = {z0.x, z0.y, z0.z, z0.w, z1.x, z1.y, z1.z, z1.w};
        unsigned r[8];
#pragma unroll
        for (int j = 0; j < 8; ++j)
            r[j] = pk2(o[2 * j] * rstd * gw[16 * w + 2 * j] * lo2f(zz[j]), o[2 * j + 1] * rstd * gw[16 * w + 2 * j + 1] * hi2f(zz[j]));
        *(u32x4*)(SZA + tok * 1024 + h * 128 + 16 * w) = (u32x4){r[0], r[1], r[2], r[3]};
        *(u32x4*)(SZA + tok * 1024 + h * 128 + 16 * w + 8) = (u32x4){r[4], r[5], r[6], r[7]};
        __syncthreads();
    }
}
__device__ __forceinline__ void phase_conv3(const Prm& p) {
    const bf16_t* P = (const bf16_t*)(p.ws + OFF_P); bf16_t* Q = (bf16_t*)(p.ws + OFF_Q); const float* cw = p.in[19];
    const int nth = gridDim.x * 512;
    for (int idx = blockIdx.x * 512 + threadIdx.x; idx < (TOK / 4) * 256; idx += nth) {
        const int t0 = (idx >> 8) * 4, c8 = (idx & 255) * 8;
        const bool first = (t0 & (SEQ - 1)) == 0;
        u32x4 pr[6], qr[4];
#pragma unroll
        for (int i = 0; i < 6; ++i) pr[i] = (i < 2 && first) ? (u32x4){0u, 0u, 0u, 0u} : *(const u32x4*)(P + (size_t)(t0 - 2 + i) * 2048 + c8);
#pragma unroll
        for (int i = 0; i < 4; ++i) qr[i] = *(const u32x4*)(Q + (size_t)(t0 + i) * 2048 + c8);
        float w0[8], w1[8], w2[8];
#pragma unroll
        for (int e = 0; e < 8; ++e) { w0[e] = cw[c8 + e]; w1[e] = cw[2048 + c8 + e]; w2[e] = cw[4096 + c8 + e]; }
#pragma unroll
        for (int i = 0; i < 4; ++i) {
            const unsigned pa[4] = {pr[i + 2].x, pr[i + 2].y, pr[i + 2].z, pr[i + 2].w}, pb[4] = {pr[i + 1].x, pr[i + 1].y, pr[i + 1].z, pr[i + 1].w}, pc[4] = {pr[i].x, pr[i].y, pr[i].z, pr[i].w};
            const unsigned qa[4] = {qr[i].x, qr[i].y, qr[i].z, qr[i].w};
            unsigned o[4];
#pragma unroll
            for (int e = 0; e < 4; ++e)
                o[e] = pk2(lo2f(qa[e]) * (w0[2 * e] * lo2f(pc[e]) + w1[2 * e] * lo2f(pb[e]) + w2[2 * e] * lo2f(pa[e])),
                           hi2f(qa[e]) * (w0[2 * e + 1] * hi2f(pc[e]) + w1[2 * e + 1] * hi2f(pb[e]) + w2[2 * e + 1] * hi2f(pa[e])));
            *(u32x4*)(Q + (size_t)(t0 + i) * 2048 + c8) = (u32x4){o[0], o[1], o[2], o[3]};
        }
    }
}

#define XB_TMO      128
#define XB_XCNT(j)  (256  + 64 * (j))
#define XB_XSUB(j)  (1280 + 64 * (j))
#define XB_XGEN(j)  (2304 + 64 * (j))
#define XB_TOP      3328
#define XB_TOPGEN   3392
#define XCD_BAR_WORDS 3456
#define XB_SPIN_CAP (1u << 18)

__device__ __forceinline__ unsigned xb_ld(unsigned* p)              { return __hip_atomic_load(p, __ATOMIC_RELAXED, __HIP_MEMORY_SCOPE_AGENT); }
__device__ __forceinline__ unsigned xb_add(unsigned* p, unsigned v) { return __hip_atomic_fetch_add(p, v, __ATOMIC_RELAXED, __HIP_MEMORY_SCOPE_AGENT); }
__device__ __forceinline__ unsigned xb_xcc_id() { return (unsigned)__builtin_amdgcn_s_getreg((3 << 11) | 20) & 0xFu; }
#define XB_SPIN(cond, bar) do { unsigned _sp = 0; while (cond) { __builtin_amdgcn_s_sleep(1); \
    if ((++_sp & 255u) == 0u) { if (xb_ld(&(bar)[XB_TMO])) break; if (_sp > XB_SPIN_CAP) { atomicAdd(&(bar)[XB_TMO], 1u); break; } } } } while (0)

struct XcdBarrier {
    unsigned* bar; unsigned x;
    volatile LAS unsigned* st;
};

__device__ __forceinline__ XcdBarrier xcd_barrier_post(unsigned* bar, volatile LAS unsigned* st) {
    XcdBarrier b; b.bar = bar; b.x = xb_xcc_id(); b.st = st;
    if (threadIdx.x == 0) (void)xb_add(&bar[XB_XCNT(b.x)], 1u);
    return b;
}
__device__ __forceinline__ void xcd_barrier_complete(unsigned* bar, unsigned x, unsigned& nloc, unsigned& nx) {
    const unsigned G = gridDim.x * gridDim.y * gridDim.z;
    unsigned sum, cnt, mine, sp = 0u;
    for (;;) {
        sum = 0u; cnt = 0u; mine = 0u;
#pragma unroll
        for (unsigned j = 0; j < 16; ++j) { const unsigned c = xb_ld(&bar[XB_XCNT(j)]); sum += c; cnt += (c > 0u) ? 1u : 0u; mine = (j == x) ? c : mine; }
        if (sum == G) break;
        __builtin_amdgcn_s_sleep(1);
        if ((++sp & 255u) == 0u) { if (xb_ld(&bar[XB_TMO])) break; if (sp > XB_SPIN_CAP) { atomicAdd(&bar[XB_TMO], 1u); break; } }
    }
    nloc = mine > 0u ? mine : 1u; nx = cnt > 0u ? cnt : 1u;
}

__device__ __forceinline__ void xcd_barrier(const XcdBarrier& b) {
    asm volatile("s_waitcnt vmcnt(0)" ::: "memory");
    __syncthreads();
    if (threadIdx.x == 0) {
        unsigned* bar = b.bar;
        __builtin_amdgcn_s_waitcnt(0);
        unsigned nloc = b.st[0], nx = b.st[1];
        if (nloc == 0u) { xcd_barrier_complete(bar, b.x, nloc, nx); b.st[0] = nloc; b.st[1] = nx; }
        const unsigned old = xb_add(&bar[XB_XSUB(b.x)], 1u);
        const unsigned gen = old / nloc;
        if (old + 1u == (gen + 1u) * nloc) {
            __builtin_amdgcn_fence(__ATOMIC_RELEASE, "agent");
            asm volatile("s_waitcnt vmcnt(0)" ::: "memory");
            const unsigned og = xb_add(&bar[XB_TOP], 1u);
            const unsigned tg = og / nx;
            if (og + 1u == (tg + 1u) * nx) xb_add(&bar[XB_TOPGEN], 1u);
            else XB_SPIN(xb_ld(&bar[XB_TOPGEN]) == tg, bar);
            __builtin_amdgcn_fence(__ATOMIC_ACQUIRE, "agent");
            xb_add(&bar[XB_XGEN(b.x)], 1u);
            asm volatile("s_waitcnt vmcnt(0)" ::: "memory");
        } else {
            XB_SPIN(xb_ld(&bar[XB_XGEN(b.x)]) == gen, bar);
            __builtin_amdgcn_fence(__ATOMIC_ACQUIRE, "agent");
            asm volatile("s_waitcnt vmcnt(0)" ::: "memory");
        }
    }
    __syncthreads();
}

constexpr int NPHASE = 11;
#define REP_GEMM 1
#define REP_SYNC 1
#define REP_SCAN 1
#define SCAN_PROBE 1
#define REP_P0 1
#ifndef PHM
#define PHM 0x7FF
#endif
__global__ void __launch_bounds__(512, 2) mega(Prm p) {
    extern __shared__ __attribute__((aligned(16))) unsigned char shm[];
    LAS unsigned char* lds3 = (LAS unsigned char*)shm;
    unsigned char* ws = p.ws;
    volatile LAS unsigned* xst = (volatile LAS unsigned*)(lds3 + LDS_BYTES);
    if (threadIdx.x == 0) { xst[0] = 0u; xst[1] = 0u; }
    __syncthreads();
    XcdBarrier xb{};
    const bool multi = (p.ph_hi - p.ph_lo) > 1;
    if (multi) xb = xcd_barrier_post((unsigned*)(ws + OFF_BAR), xst);
    if (p.ph_lo < 0) cg::this_grid().sync();
#define PH_BEGIN(i) if (((PHM >> (i)) & 1) && p.ph_lo <= (i) && (i) < p.ph_hi) { if ((i) > p.ph_lo) { xcd_barrier(xb); if (REP_SYNC > 1) xcd_barrier(xb); } pg8::StaticOrder S; (void)S;
#define PH_END }
    PH_BEGIN(0)
        for (int rep = 0; rep < REP_P0; ++rep) {
        phase_convert(p, shm, 0, 1856, gridDim.x, blockIdx.x);
        phase_rmsnorm_x(p.in[0], p.in[1], (bf16_t*)(ws + OFF_H)); __syncthreads(); }
    PH_END
    PH_BEGIN(1)
        phase_ba(p, shm);
        pg8::Gemm g{(const bf16_t*)(ws + OFF_H), (const bf16_t*)(ws + OFF_WT1), TOK, 6144, 1024, (const bf16_t*)(ws + OFF_H), 1024, 64};
        Epi1 E{(bf16_t*)(ws + OFF_QKV), (bf16_t*)p.out, (bf16_t*)(ws + OFF_UU), (bf16_t*)p.out + (size_t)TOK * 1024, (float*)(ws + OFF_BA), (bf16_t*)(ws + OFF_HALO)};
        S.init(TOK, 6144, gridDim.x, blockIdx.x); for (int rep = 0; rep < REP_GEMM; ++rep) { pg8::gemm_phase(lds3, g, S, E); __syncthreads(); }
    PH_END
    PH_BEGIN(2)
        {
            unsigned* ctr = (unsigned*)(ws + OFF_BAR) + 3600;
            volatile LAS unsigned* sIt = xst + 2;
            for (;;) {
                if (threadIdx.x == 0) sIt[0] = __hip_atomic_fetch_add(ctr, 2u, __ATOMIC_RELAXED, __HIP_MEMORY_SCOPE_AGENT);
                __syncthreads();
                const unsigned it0 = sIt[0];
                __syncthreads();
                if (it0 >= (unsigned)NIT) break;
                phase_gdn_prep(p, shm, (int)it0, 1);
            }
        }
    PH_END
    PH_BEGIN(3)
        if (blockIdx.x < 64) phase_gdn_scan(p, lds3, blockIdx.x);
        else {
            const int ob = blockIdx.x - 64;
            pg8::Gemm g{(const bf16_t*)(ws + OFF_UU), (const bf16_t*)(ws + OFF_WTG), TOK, 1024, 1024, (const bf16_t*)(ws + OFF_UU), 1024, 64};
            EpiGlu E{(const bf16_t*)(ws + OFF_UU), (bf16_t*)p.out + (size_t)TOK * 1024};
            unsigned* cw = (unsigned*)(ws + OFF_BAR);
            if (ob < 128) {
                phase_s5(p, shm, ob);
                asm volatile("s_waitcnt vmcnt(0)" ::: "memory");
                __syncthreads();
                if (threadIdx.x == 0) {
                    __builtin_amdgcn_fence(__ATOMIC_RELEASE, "agent");
                    asm volatile("s_waitcnt vmcnt(0)" ::: "memory");
                    __hip_atomic_fetch_add(cw + 3700, 1u, __ATOMIC_RELAXED, __HIP_MEMORY_SCOPE_AGENT);
                    unsigned sp = 0;
                    while (__hip_atomic_load(cw + 3700, __ATOMIC_RELAXED, __HIP_MEMORY_SCOPE_AGENT) < 128u) { __builtin_amdgcn_s_sleep(2); if (++sp > (1u << 22)) break; }
                    __builtin_amdgcn_fence(__ATOMIC_ACQUIRE, "agent");
                    asm volatile("s_waitcnt vmcnt(0)" ::: "memory");
                }
                __syncthreads();
                S.init_list(ob, 1, 1); pg8::gemm_phase(lds3, g, S, E);
            } else {
                const int e = ob - 128;
                phase_convert(p, shm, 1856, 1856 + 2304, 64, e);
                __syncthreads();
                if (threadIdx.x == 0) {
                    unsigned sp = 0;
                    while (__hip_atomic_load(cw + 3900, __ATOMIC_RELAXED, __HIP_MEMORY_SCOPE_AGENT) < 128u) { __builtin_amdgcn_s_sleep(2); if (++sp > (1u << 22)) break; }
                    __builtin_amdgcn_fence(__ATOMIC_ACQUIRE, "agent");
                    asm volatile("s_waitcnt vmcnt(0)" ::: "memory");
                }
                __syncthreads();
                S.init_list(2 * e, 2, 0); pg8::gemm_phase(lds3, g, S, E);
                __syncthreads();
                phase_convert(p, shm, 1856 + 2304, 4928, 64, e);
            }
        }
    PH_END
    PH_BEGIN(4)
        phase_ya(p, shm);
    PH_END
    PH_BEGIN(5)
        pg8::Gemm g{(const bf16_t*)p.out, (const bf16_t*)(ws + OFF_WTO0), TOK, 1024, 2048, (const bf16_t*)p.out + (size_t)TOK * 1024, 1024, 16};
        EpiB16 E{(bf16_t*)(ws + OFF_QKV)};
        S.init(TOK, 1024, gridDim.x, blockIdx.x); for (int rep = 0; rep < REP_GEMM; ++rep) { pg8::gemm_phase(lds3, g, S, E); __syncthreads(); }
    PH_END
    PH_BEGIN(6)
        phase_post<true>(p.in[0], (const bf16_t*)(ws + OFF_QKV), p.in[2], p.out, p.in[1] + 1024, (bf16_t*)(ws + OFF_H));
    PH_END
    PH_BEGIN(7)
        pg8::Gemm g{(const bf16_t*)(ws + OFF_H), (const bf16_t*)(ws + OFF_WT2), TOK, 8192, 1024, (const bf16_t*)(ws + OFF_H), 1024, 64};
        Epi2 E{(bf16_t*)(ws + OFF_P), (bf16_t*)(ws + OFF_Q)};
        S.init(TOK, 8192, gridDim.x, blockIdx.x); for (int rep = 0; rep < REP_GEMM; ++rep) { pg8::gemm_phase(lds3, g, S, E); __syncthreads(); }
    PH_END
    PH_BEGIN(8)
        phase_conv3(p);
    PH_END
    PH_BEGIN(9)
        pg8::Gemm g{(const bf16_t*)(ws + OFF_Q), (const bf16_t*)(ws + OFF_WTO1), TOK, 1024, 2048, (const bf16_t*)(ws + OFF_Q), 2048, 64};
        EpiB16 E{(bf16_t*)(ws + OFF_P)};
        S.init(TOK, 1024, gridDim.x, blockIdx.x); for (int rep = 0; rep < REP_GEMM; ++rep) { pg8::gemm_phase(lds3, g, S, E); __syncthreads(); }
    PH_END
    PH_BEGIN(10)
        phase_post<false>(p.out, (const bf16_t*)(ws + OFF_P), p.in[2] + 1024, p.out, nullptr, nullptr);
    PH_END
}

#ifndef N_LAUNCH_MODE
#define N_LAUNCH_MODE 1
#endif

extern "C" void kernel_launch(void* const* d_in, const int* in_sizes, int n_in, void* d_out, int out_size, void* d_ws, size_t ws_size, hipStream_t stream) {
    static int ready = 0;
    if (!ready) {
        if (n_in != 21 || ws_size < WS_END || out_size != TOK * DM) { fprintf(stderr, "kernel_launch: unexpected shapes (n_in %d ws %zu out %d)\n", n_in, ws_size, out_size); ready = -1; return; }
        if (hipFuncSetAttribute((const void*)mega, hipFuncAttributeMaxDynamicSharedMemorySize, LDS_BYTES + 16) != hipSuccess) { fprintf(stderr, "kernel_launch: hipFuncSetAttribute failed\n"); ready = -1; return; }
        ready = 1;
    }
    if (ready < 0) return;
    Prm p{};
    for (int i = 0; i < 21; ++i) p.in[i] = (const float*)d_in[i];
    p.out = (float*)d_out; p.ws = (unsigned char*)d_ws;
#if N_LAUNCH_MODE == 1
    p.ph_lo = 0; p.ph_hi = NPHASE;
    void* args[] = {&p};
    if (hipMemsetAsync((unsigned char*)d_ws + OFF_BAR, 0, 16384, stream) != hipSuccess) { fprintf(stderr, "memset failed\n"); return; }
    hipError_t e = hipLaunchCooperativeKernel((const void*)mega, dim3(256), dim3(512), args, LDS_BYTES + 16, stream);
    if (e != hipSuccess) fprintf(stderr, "cooperative launch failed: %s\n", hipGetErrorString(e));
#else
    for (int ph = 0; ph < NPHASE; ++ph) {
        p.ph_lo = ph; p.ph_hi = ph + 1;
        hipLaunchKernelGGL(mega, dim3(256), dim3(512), LDS_BYTES + 16, stream, p);
    }
#endif
}
```

```cpp
#include <hip/hip_runtime.h>
#include <hip/hip_cooperative_groups.h>
#include <cstdio>
namespace cg = cooperative_groups;

#define LAS __attribute__((address_space(3)))
typedef unsigned short bf16_t;
typedef short bf16x8 __attribute__((ext_vector_type(8)));
typedef float f32x4 __attribute__((ext_vector_type(4)));
typedef float f32x16 __attribute__((ext_vector_type(16)));
typedef unsigned u32x4 __attribute__((ext_vector_type(4)));
typedef unsigned u32x2 __attribute__((ext_vector_type(2)));

constexpr int TOK = 16384, DM = 1024, SEQ = 8192;
constexpr int NP1 = 6400;
constexpr int NIT = 2048;

constexpr size_t OFF_WT1 = 0;
constexpr size_t OFF_WTG = OFF_WT1 + (size_t)NP1 * 1024 * 2;
constexpr size_t OFF_WTO0 = OFF_WTG + (size_t)1024 * 1024 * 2;
constexpr size_t OFF_WT2 = OFF_WTO0 + (size_t)1024 * 2048 * 2;
constexpr size_t OFF_WTO1 = OFF_WT2 + (size_t)8192 * 1024 * 2;
constexpr size_t OFF_H = OFF_WTO1 + (size_t)1024 * 2048 * 2;
constexpr size_t OFF_QKV = OFF_H + (size_t)TOK * 1024 * 2;
constexpr size_t OFF_UU = OFF_QKV + (size_t)TOK * 3072 * 2;
constexpr size_t OFF_WB = OFF_UU + (size_t)TOK * 1024 * 2;
constexpr size_t OFF_ATT = OFF_WB + (size_t)NIT * 8192 * 2;
constexpr size_t OFF_HALO = OFF_ATT + (size_t)NIT * 4096 * 2;
constexpr size_t OFF_BA = OFF_HALO + (size_t)256 * 3 * 3072 * 2;
constexpr size_t OFF_GL = OFF_BA + (size_t)TOK * 16 * 4;
constexpr size_t OFF_BAR = OFF_GL + (size_t)NIT * 4;
constexpr size_t WS_END = OFF_BAR + 16384;
constexpr size_t OFF_YMIX = OFF_QKV;
constexpr size_t OFF_P = OFF_QKV;
constexpr size_t OFF_Q = OFF_QKV + (size_t)TOK * 2048 * 2;
static_assert(OFF_Q + (size_t)TOK * 2048 * 2 <= OFF_WB, "Q overlaps live data");
static_assert(WS_END <= (size_t)256 * 1024 * 1024, "workspace too big");

constexpr int LDS_BYTES = 157696;

struct Prm {
    const float* in[21];
    float* out;
    unsigned char* ws;
    int ph_lo, ph_hi;
};

__device__ __forceinline__ float bf2f(bf16_t b) { return __uint_as_float(((unsigned)b) << 16); }
__device__ __forceinline__ bf16_t f2bf(float f) { unsigned u = __float_as_uint(f); u += 0x7FFFu + ((u >> 16) & 1u); return (bf16_t)(u >> 16); }
typedef __bf16 bf16v2_t __attribute__((ext_vector_type(2)));
typedef float f32x2_t __attribute__((ext_vector_type(2)));
__device__ __forceinline__ unsigned pk2(float lo, float hi) { const f32x2_t v = {lo, hi}; return __builtin_bit_cast(unsigned, __builtin_convertvector(v, bf16v2_t)); }
__device__ __forceinline__ float lo2f(unsigned u) { return __uint_as_float(u << 16); }
__device__ __forceinline__ float hi2f(unsigned u) { return __uint_as_float(u & 0xFFFF0000u); }
__device__ __forceinline__ float sigmoidf_(float x) { return 1.0f / (1.0f + __expf(-x)); }
__device__ __forceinline__ float siluf_(float x) { return x / (1.0f + __expf(-x)); }
__device__ __forceinline__ float wave_sum(float v) {
#pragma unroll
    for (int o = 32; o >= 1; o >>= 1) v += __shfl_xor(v, o);
    return v;
}
__device__ __forceinline__ u32x4 pack8(f32x4 a, f32x4 b) { u32x4 r; r.x = pk2(a[0], a[1]); r.y = pk2(a[2], a[3]); r.z = pk2(b[0], b[1]); r.w = pk2(b[2], b[3]); return r; }

namespace pg8 {
constexpr int BM = 256, BK = 64, HALF = 128, HTB = HALF * BK * 2, STAGE_BYTES = 8 * HTB, NXCD = 8, WGM = 8;
__device__ __forceinline__ int lds_byte(int r, int c) { const int st = (r >> 4) * 2 + (c >> 5), rr = r & 15, cc = c & 31, ob = rr * 64 + cc * 2; return st * 1024 + (ob ^ (((ob >> 9) & 1) << 5)); }
__device__ __forceinline__ void stage_rc(int b, int& R, int& C) { const int st = b / 1024, sb = b % 1024, swz = sb ^ (((sb >> 9) & 1) << 5); R = (st >> 1) * 16 + swz / 64; C = (st & 1) * 32 + (swz % 64) / 2; }
__device__ __forceinline__ int perm32(int rho) { const int n = rho >> 4, i = rho & 15; return 8 * (i >> 2) + 4 * n + (i & 3); }
struct Unit { int pm, pn; };
struct Gemm { const bf16_t* A; const bf16_t* Bt; int M, N, K; const bf16_t* A2; int lda, ks; };
struct StaticOrder {
    int nM, nN, nwg, G, c;
    int lmode, lbase, lcount, lhalf;
    __device__ void init(int M, int N, int G_, int c_) { nM = M / BM; nN = N / BM; nwg = nM * nN; G = G_; c = c_; lmode = 0; lbase = 0; lcount = 0; lhalf = 0; }
    __device__ void init_list(int base, int count, int half) { nM = 64; nN = 4; nwg = 256; G = 1; c = 0; lmode = 1; lbase = base; lcount = count; lhalf = half; }
    __device__ bool next(int i, Unit& u) const {
        if (lmode) { if (i >= lcount) return false; const int j = lbase + i, bb = j >> 6, r = j & 63; u.pm = 32 * bb + 16 * lhalf + (r >> 2); u.pn = r & 3; return true; }
        const long L = (long)i * G + c; if (L >= nwg) return false;
        int wgid = (int)L; { const int q = nwg / NXCD, r = nwg % NXCD, xcd = wgid % NXCD, off = wgid / NXCD; wgid = (xcd < r ? xcd * (q + 1) : r * (q + 1) + (xcd - r) * q) + off; }
        const int nig = WGM * nN, gid = wgid / nig, fm = gid * WGM, gsz = (nM - fm) < WGM ? (nM - fm) : WGM;
        u.pm = fm + ((wgid % nig) % gsz); u.pn = (wgid % nig) / gsz; return true;
    }
};

template <class Epi>
__device__ __forceinline__ void gemm_phase(LAS unsigned char* lds, const Gemm g, const StaticOrder& S, const Epi& E) {
    const int tid = threadIdx.x, wid = __builtin_amdgcn_readfirstlane(tid >> 6), lane = tid & 63, wr = wid >> 2, wc = wid & 3, fr = lane & 15, fq = lane >> 4;
    const int K = g.K, nt = K / BK;
    unsigned voffA[2], voffB[2];
#pragma unroll
    for (int i = 0; i < 2; ++i) { int R, C; stage_rc(tid * 16 + i * 8192, R, C); const int Rb = Epi::PERM ? ((R & ~31) + perm32(R & 31)) : R;
        voffA[i] = (unsigned)(R * g.lda + C) * 2u; voffB[i] = (unsigned)(Rb * K + C) * 2u; }
    const size_t kstep = (size_t)(BK * 2);
    const size_t hstep = (size_t)HALF * K * 2;
    const size_t tstep = 2 * hstep;
    const size_t hstepA = (size_t)HALF * g.lda * 2, tstepA = 2 * hstepA;
    const int ks = g.ks; const ptrdiff_t a2off = (const char*)g.A2 - (const char*)g.A - (ptrdiff_t)ks * (ptrdiff_t)kstep;
    const unsigned ldsw = (unsigned)wid * 1024u;
    const int aoff = lds_byte(wr * 64 + fr, fq * 8), boff = lds_byte(wc * 32 + fr, fq * 8);
#define PG8_SA(b, h) (((b) * 2 + (h)) * HTB)
#define PG8_SB(b, h) ((4 + (b) * 2 + (h)) * HTB)
#define PG8_STAGE(bufoff, gbase, voff) do { _Pragma("unroll") for (int _i = 0; _i < 2; ++_i) \
        __builtin_amdgcn_global_load_lds((const unsigned*)((const char*)(gbase) + (voff)[_i]), (LAS unsigned*)(lds + (bufoff) + ldsw + _i * 8192), 16, 0, 0); } while (0)
#define PG8_LDA(dst, b, h) do { _Pragma("unroll") for (int m = 0; m < 4; ++m) _Pragma("unroll") for (int k = 0; k < 2; ++k) dst[m][k] = *(const LAS bf16x8*)(lds + PG8_SA(b, h) + aoff + m * 2048 + k * 1024); } while (0)
#define PG8_LDB(dst, b, h) do { _Pragma("unroll") for (int n = 0; n < 2; ++n) _Pragma("unroll") for (int k = 0; k < 2; ++k) dst[n][k] = *(const LAS bf16x8*)(lds + PG8_SB(b, h) + boff + n * 2048 + k * 1024); } while (0)
#define PG8_MMA(ai, bj, At, Bt) do { __builtin_amdgcn_s_setprio(1); _Pragma("unroll") for (int m = 0; m < 4; ++m) _Pragma("unroll") for (int n = 0; n < 2; ++n) _Pragma("unroll") for (int k = 0; k < 2; ++k) \
        acc[ai][bj][m][n] = __builtin_amdgcn_mfma_f32_16x16x32_bf16(Bt[n][k], At[m][k], acc[ai][bj][m][n], 0, 0, 0); __builtin_amdgcn_s_setprio(0); } while (0)
#define PG8_WAIT_V(n) asm volatile("s_waitcnt vmcnt(" #n ")" ::: "memory")
#define PG8_WAIT_L(n) asm volatile("s_waitcnt lgkmcnt(" #n ")" ::: "memory")
#define PG8_BAR __builtin_amdgcn_s_barrier()
#define PG8_SCHED __builtin_amdgcn_sched_barrier(0)
    Unit cur, nxt; int ui = 0;
    if (!S.next(0, cur)) return;
    f32x4 acc[2][2][4][2];
#pragma unroll
    for (int a = 0; a < 2; ++a)
#pragma unroll
        for (int b = 0; b < 2; ++b)
#pragma unroll
            for (int m = 0; m < 4; ++m)
#pragma unroll
                for (int n = 0; n < 2; ++n) acc[a][b][m][n] = (f32x4){0.f, 0.f, 0.f, 0.f};
    bf16x8 At[4][2], B0[2][2], B1[2][2];
    const char* cA = (const char*)g.A + (size_t)cur.pm * tstepA; const char* cB = (const char*)g.Bt + (size_t)cur.pn * tstep;
    PG8_STAGE(PG8_SB(0, 0), cB, voffB); PG8_STAGE(PG8_SA(0, 0), cA, voffA); PG8_STAGE(PG8_SB(0, 1), cB + hstep, voffB); PG8_STAGE(PG8_SA(0, 1), cA + hstepA, voffA);
    if (wr == 1) PG8_BAR;
    PG8_WAIT_V(4); PG8_BAR;
    PG8_STAGE(PG8_SB(1, 0), cB + kstep, voffB); PG8_STAGE(PG8_SA(1, 0), cA + kstep, voffA); PG8_STAGE(PG8_SB(1, 1), cB + hstep + kstep, voffB);
    PG8_WAIT_V(6); PG8_BAR;
    for (;;) {
        const bool has_next = S.next(ui + 1, nxt);
        const char* nA = has_next ? (const char*)g.A + (size_t)nxt.pm * tstepA : cA; const char* nB = has_next ? (const char*)g.Bt + (size_t)nxt.pn * tstep : cB;
        for (int t = 0; t < nt; t += 2) {
            const bool last = (t == nt - 2);
            const char* a1 = cA + (size_t)(t + 1) * kstep + ((t + 1) >= ks ? a2off : 0);
            const char* a2 = last ? nA : cA + (size_t)(t + 2) * kstep + ((t + 2) >= ks ? a2off : 0); const char* b2 = last ? nB : cB + (size_t)(t + 2) * kstep;
            const char* a3 = last ? nA + kstep : cA + (size_t)(t + 3) * kstep + ((t + 3) >= ks ? a2off : 0); const char* b3 = b2 + kstep;
            PG8_LDB(B0, 0, 0); PG8_SCHED; PG8_LDA(At, 0, 0); PG8_STAGE(PG8_SA(1, 1), a1 + hstepA, voffA);
            PG8_WAIT_L(8); PG8_BAR; PG8_WAIT_L(0); PG8_MMA(0, 0, At, B0); PG8_BAR; PG8_SCHED;
            PG8_LDB(B1, 0, 1); PG8_STAGE(PG8_SB(0, 0), b2, voffB);
            PG8_BAR; PG8_WAIT_L(0); PG8_MMA(0, 1, At, B1); PG8_BAR;
            PG8_LDA(At, 0, 1); PG8_STAGE(PG8_SA(0, 0), a2, voffA);
            PG8_BAR; PG8_WAIT_L(0); PG8_MMA(1, 0, At, B0); PG8_BAR; PG8_SCHED;
            PG8_STAGE(PG8_SB(0, 1), b2 + hstep, voffB);
            PG8_WAIT_V(6); PG8_BAR; PG8_MMA(1, 1, At, B1); PG8_BAR;
            PG8_LDB(B0, 1, 0); PG8_SCHED; PG8_LDA(At, 1, 0); PG8_STAGE(PG8_SA(0, 1), a2 + hstepA, voffA);
            PG8_WAIT_L(8); PG8_BAR; PG8_WAIT_L(0); PG8_MMA(0, 0, At, B0); PG8_BAR; PG8_SCHED;
            PG8_LDB(B1, 1, 1); PG8_STAGE(PG8_SB(1, 0), b3, voffB);
            PG8_BAR; PG8_WAIT_L(0); PG8_MMA(0, 1, At, B1); PG8_BAR;
            PG8_LDA(At, 1, 1); PG8_STAGE(PG8_SA(1, 0), a3, voffA);
            PG8_BAR; PG8_WAIT_L(0); PG8_MMA(1, 0, At, B0); PG8_BAR; PG8_SCHED;
            PG8_STAGE(PG8_SB(1, 1), b3 + hstep, voffB);
            PG8_WAIT_V(6); PG8_BAR; PG8_MMA(1, 1, At, B1); PG8_BAR;
        }
        E(acc, cur, wr, wc, fr, fq);
        if (!has_next) break;
#pragma unroll
        for (int a = 0; a < 2; ++a)
#pragma unroll
            for (int b = 0; b < 2; ++b)
#pragma unroll
                for (int m = 0; m < 4; ++m)
#pragma unroll
                    for (int n = 0; n < 2; ++n) acc[a][b][m][n] = (f32x4){0.f, 0.f, 0.f, 0.f};
        cur = nxt; cA = nA; cB = nB; ++ui;
    }
    PG8_WAIT_V(0);
    if (wr == 0) PG8_BAR;
    PG8_BAR;
#undef PG8_SA
#undef PG8_SB
#undef PG8_STAGE
#undef PG8_LDA
#undef PG8_LDB
#undef PG8_MMA
#undef PG8_WAIT_V
#undef PG8_WAIT_L
#undef PG8_BAR
#undef PG8_SCHED
}
}
using pg8::Unit;

struct Epi1 {
    static constexpr bool PERM = true;
    bf16_t* QKV; bf16_t* SZA; bf16_t* UU; bf16_t* SZB; float* BA; bf16_t* HALO;
    __device__ __forceinline__ void operator()(const f32x4 (&acc)[2][2][4][2], const Unit& u, int wr, int wc, int fr_, int fq_) const {
        int lane = (int)(threadIdx.x & 63); asm volatile("" : "+v"(lane));
        const int fr = lane & 15, fq = lane >> 4; (void)fr_; (void)fq_;
        const int row0 = u.pm * 256 + wr * 64 + fr, pn = u.pn;
#pragma unroll
        for (int ai = 0; ai < 2; ++ai)
#pragma unroll
            for (int m = 0; m < 4; ++m) {
                const size_t row = (size_t)(row0 + ai * 128 + m * 16);
#pragma unroll
                for (int bj = 0; bj < 2; ++bj) {
                    const int colt = 128 * bj + 32 * wc + 8 * fq;
                    f32x4 v0 = acc[ai][bj][m][0], v1 = acc[ai][bj][m][1];
                    if (pn < 12) {
                        const int c = pn * 256 + colt; const u32x4 pk = pack8(v0, v1);
                        *(u32x4*)(QKV + row * 3072 + c) = pk;
                        if (m == 3 && fr >= 13) *(u32x4*)(HALO + ((row >> 6) * 3 + (fr - 13)) * 3072 + c) = pk;
                    } else if (pn < 16) {
#pragma unroll
                        for (int e = 0; e < 4; ++e) { v0[e] = siluf_(v0[e]); v1[e] = siluf_(v1[e]); }
                        *(u32x4*)(SZA + row * 1024 + (pn - 12) * 256 + colt) = pack8(v0, v1);
                    } else if (pn < 20) {
                        *(u32x4*)(UU + row * 1024 + (pn - 16) * 256 + colt) = pack8(v0, v1);
                    } else if (pn < 24) {
#pragma unroll
                        for (int e = 0; e < 4; ++e) { v0[e] = siluf_(v0[e]); v1[e] = siluf_(v1[e]); }
                        *(u32x4*)(SZB + row * 1024 + (pn - 20) * 256 + colt) = pack8(v0, v1);
                    } else if (colt < 16) {
                        *(f32x4*)(BA + row * 16 + colt) = v0; *(f32x4*)(BA + row * 16 + colt + 4) = v1;
                    }
                }
            }
    }
};
struct EpiGlu {
    static constexpr bool PERM = true;
    const bf16_t* Y5; bf16_t* SZB;
    __device__ __forceinline__ void operator()(const f32x4 (&acc)[2][2][4][2], const Unit& u, int wr, int wc, int fr, int fq) const {
        const int row0 = u.pm * 256 + wr * 64 + fr;
#pragma unroll
        for (int ai = 0; ai < 2; ++ai)
#pragma unroll
            for (int m = 0; m < 4; ++m) {
                const size_t row = (size_t)(row0 + ai * 128 + m * 16);
#pragma unroll
                for (int bj = 0; bj < 2; ++bj) {
                    const int c = u.pn * 256 + 128 * bj + 32 * wc + 8 * fq;
                    const u32x4 y = *(const u32x4*)(Y5 + row * 1024 + c), z = *(const u32x4*)(SZB + row * 1024 + c);
                    const f32x4 a0 = acc[ai][bj][m][0], a1 = acc[ai][bj][m][1];
                    u32x4 o;
                    o.x = pk2(lo2f(y.x) * sigmoidf_(a0[0]) * lo2f(z.x), hi2f(y.x) * sigmoidf_(a0[1]) * hi2f(z.x));
                    o.y = pk2(lo2f(y.y) * sigmoidf_(a0[2]) * lo2f(z.y), hi2f(y.y) * sigmoidf_(a0[3]) * hi2f(z.y));
                    o.z = pk2(lo2f(y.z) * sigmoidf_(a1[0]) * lo2f(z.z), hi2f(y.z) * sigmoidf_(a1[1]) * hi2f(z.z));
                    o.w = pk2(lo2f(y.w) * sigmoidf_(a1[2]) * lo2f(z.w), hi2f(y.w) * sigmoidf_(a1[3]) * hi2f(z.w));
                    *(u32x4*)(SZB + row * 1024 + c) = o;
                }
            }
    }
};
struct EpiF32 {
    static constexpr bool PERM = false;
    float* C;
    __device__ __forceinline__ void operator()(const f32x4 (&acc)[2][2][4][2], const Unit& u, int wr, int wc, int fr, int fq) const {
        const int row0 = u.pm * 256 + wr * 64 + fr, col0 = u.pn * 256 + wc * 32 + 4 * fq;
#pragma unroll
        for (int ai = 0; ai < 2; ++ai)
#pragma unroll
            for (int m = 0; m < 4; ++m) { float* rowp = C + (size_t)(row0 + ai * 128 + m * 16) * 1024 + col0;
#pragma unroll
                for (int bj = 0; bj < 2; ++bj)
#pragma unroll
                    for (int n = 0; n < 2; ++n) *(f32x4*)(rowp + bj * 128 + n * 16) = acc[ai][bj][m][n]; }
    }
};
struct EpiB16 {
    static constexpr bool PERM = true;
    bf16_t* C;
    __device__ __forceinline__ void operator()(const f32x4 (&acc)[2][2][4][2], const Unit& u, int wr, int wc, int fr, int fq) const {
        const int row0 = u.pm * 256 + wr * 64 + fr, col0 = u.pn * 256 + wc * 32 + 8 * fq;
#pragma unroll
        for (int ai = 0; ai < 2; ++ai)
#pragma unroll
            for (int m = 0; m < 4; ++m) { bf16_t* rowp = C + (size_t)(row0 + ai * 128 + m * 16) * 1024 + col0;
#pragma unroll
                for (int bj = 0; bj < 2; ++bj) *(u32x4*)(rowp + bj * 128) = pack8(acc[ai][bj][m][0], acc[ai][bj][m][1]); }
    }
};
struct Epi2 {
    static constexpr bool PERM = false;
    bf16_t* P; bf16_t* Q;
    __device__ __forceinline__ void operator()(const f32x4 (&acc)[2][2][4][2], const Unit& u, int wr, int wc, int fr, int fq) const {
        const int row0 = u.pm * 256 + wr * 64 + fr, ch = u.pn * 64 + 16 * wc + 4 * fq;
#pragma unroll
        for (int ai = 0; ai < 2; ++ai)
#pragma unroll
            for (int m = 0; m < 4; ++m) {
                const size_t row = (size_t)(row0 + ai * 128 + m * 16);
                const f32x4 gb = acc[ai][0][m][0], gc = acc[ai][0][m][1], hv = acc[ai][1][m][0], z = acc[ai][1][m][1];
                u32x2 pp, qq;
                pp.x = pk2(gc[0] * hv[0], gc[1] * hv[1]); pp.y = pk2(gc[2] * hv[2], gc[3] * hv[3]);
                qq.x = pk2(gb[0] * siluf_(z[0]), gb[1] * siluf_(z[1])); qq.y = pk2(gb[2] * siluf_(z[2]), gb[3] * siluf_(z[3]));
                *(u32x2*)(P + row * 2048 + ch) = pp; *(u32x2*)(Q + row * 2048 + ch) = qq;
            }
    }
};

__device__ __forceinline__ int src_col(int mode, int n, int& pn_unused) {
    (void)pn_unused;
    if (mode == 0) return n;
    if (mode == 1) { if (n < 4096) return n; if (n < 6144) return n + 16; if (n < 6160) return n - 2048; return -1; }
    const int pn = n >> 8, col = n & 255, bj = col >> 7, wc = (col >> 5) & 3, nn = (col >> 4) & 1, lo = col & 15;
    return (2 * bj + nn) * 2048 + pn * 64 + 16 * wc + lo;
}
struct CvtTile { const float* W; bf16_t* Wt; int K, Nsrc, mode, n0, k0; };
__device__ __forceinline__ CvtTile cvt_decode(const Prm& p, int tix) {
    CvtTile t; int tl = tix;
    if (tl < 1600) { t.W = p.in[3]; t.Wt = (bf16_t*)(p.ws + OFF_WT1); t.K = 1024; t.Nsrc = 6160; t.mode = 1; }
    else if ((tl -= 1600) < 256) { t.W = p.in[16]; t.Wt = (bf16_t*)(p.ws + OFF_WTG); t.K = 1024; t.Nsrc = 1024; t.mode = 0; }
    else if ((tl -= 256) < 512) { t.W = p.in[17]; t.Wt = (bf16_t*)(p.ws + OFF_WTO0); t.K = 2048; t.Nsrc = 1024; t.mode = 0; }
    else if ((tl -= 512) < 2048) { t.W = p.in[18]; t.Wt = (bf16_t*)(p.ws + OFF_WT2); t.K = 1024; t.Nsrc = 8192; t.mode = 2; }
    else { tl -= 2048; t.W = p.in[20]; t.Wt = (bf16_t*)(p.ws + OFF_WTO1); t.K = 2048; t.Nsrc = 1024; t.mode = 0; }
    const int ntk = t.K / 64; t.n0 = (tl / ntk) * 64; t.k0 = (tl % ntk) * 64; return t;
}
__device__ __forceinline__ void phase_convert(const Prm& p, unsigned char* lds, int t_begin, int t_end, int nblk, int bidx) {
    float* tiles = (float*)lds;
    const int tid = threadIdx.x, j = tid & 63, kr = tid >> 6, r = tid >> 3, c8 = (tid & 7) * 8;
    for (int base = t_begin + bidx * 4; base < t_end; base += nblk * 4) {
        float v[4][8];
#pragma unroll
        for (int q = 0; q < 4; ++q) {
            const int tix = base + q < t_end ? base + q : t_end - 1;
            const CvtTile t = cvt_decode(p, tix);
            int dummy = 0; const int sc = src_col(t.mode, t.n0 + j, dummy);
#pragma unroll
            for (int i = 0; i < 8; ++i) v[q][i] = sc >= 0 ? t.W[(size_t)(t.k0 + kr + 8 * i) * t.Nsrc + sc] : 0.0f;
        }
#pragma unroll
        for (int q = 0; q < 4; ++q)
#pragma unroll
            for (int i = 0; i < 8; ++i) tiles[q * 4160 + (kr + 8 * i) * 65 + j] = v[q][i];
        __syncthreads();
#pragma unroll
        for (int q = 0; q < 4; ++q) {
            const int tix = base + q < t_end ? base + q : t_end - 1;
            const CvtTile t = cvt_decode(p, tix);
            const float* tl = tiles + q * 4160; u32x4 o;
            o.x = pk2(tl[(c8 + 0) * 65 + r], tl[(c8 + 1) * 65 + r]); o.y = pk2(tl[(c8 + 2) * 65 + r], tl[(c8 + 3) * 65 + r]);
            o.z = pk2(tl[(c8 + 4) * 65 + r], tl[(c8 + 5) * 65 + r]); o.w = pk2(tl[(c8 + 6) * 65 + r], tl[(c8 + 7) * 65 + r]);
            *(u32x4*)(t.Wt + (size_t)(t.n0 + r) * t.K + t.k0 + c8) = o;
        }
        __syncthreads();
    }
}
__device__ __forceinline__ void phase_rmsnorm_x(const float* x, const float* w, bf16_t* H) {
    const int lane = threadIdx.x & 63, nw = gridDim.x * 8;
    for (int row = blockIdx.x * 8 + (threadIdx.x >> 6); row < TOK; row += nw) {
        const f32x4* xr = (const f32x4*)(x + (size_t)row * 1024);
        f32x4 v[4]; float ss = 0.f;
#pragma unroll
        for (int i = 0; i < 4; ++i) { v[i] = xr[lane + 64 * i]; ss += v[i][0] * v[i][0] + v[i][1] * v[i][1] + v[i][2] * v[i][2] + v[i][3] * v[i][3]; }
        ss = wave_sum(ss);
        const float rstd = rsqrtf(ss * (1.0f / 1024.0f) + 1e-6f);
#pragma unroll
        for (int i = 0; i < 4; ++i) { const f32x4 w4 = ((const f32x4*)w)[lane + 64 * i]; u32x2 o;
            o.x = pk2(v[i][0] * rstd * w4[0], v[i][1] * rstd * w4[1]); o.y = pk2(v[i][2] * rstd * w4[2], v[i][3] * rstd * w4[3]);
            *(u32x2*)(H + (size_t)row * 1024 + (lane + 64 * i) * 4) = o; }
    }
}
template <bool NEXT>
__device__ __forceinline__ void phase_post(const float* base, const bf16_t* Y, const float* wpost, float* OUT, const float* wpre, bf16_t* H) {
    const int lane = threadIdx.x & 63, nw = gridDim.x * 8;
    for (int row = blockIdx.x * 8 + (threadIdx.x >> 6); row < TOK; row += nw) {
        const u32x2* yr = (const u32x2*)(Y + (size_t)row * 1024); const f32x4* br = (const f32x4*)(base + (size_t)row * 1024);
        f32x4 v[4], xb[4]; float ss = 0.f;
#pragma unroll
        for (int i = 0; i < 4; ++i) { const u32x2 y2 = yr[lane + 64 * i]; v[i] = (f32x4){lo2f(y2.x), hi2f(y2.x), lo2f(y2.y), hi2f(y2.y)}; xb[i] = br[lane + 64 * i]; ss += v[i][0] * v[i][0] + v[i][1] * v[i][1] + v[i][2] * v[i][2] + v[i][3] * v[i][3]; }
        ss = wave_sum(ss);
        const float rstd = rsqrtf(ss * (1.0f / 1024.0f) + 1e-6f);
        float s2 = 0.f;
#pragma unroll
        for (int i = 0; i < 4; ++i) { const f32x4 w4 = ((const f32x4*)wpost)[lane + 64 * i];
#pragma unroll
            for (int e = 0; e < 4; ++e) { v[i][e] = xb[i][e] + v[i][e] * rstd * w4[e]; s2 += v[i][e] * v[i][e]; }
            ((f32x4*)(OUT + (size_t)row * 1024))[lane + 64 * i] = v[i]; }
        if (NEXT) {
            s2 = wave_sum(s2);
            const float r2 = rsqrtf(s2 * (1.0f / 1024.0f) + 1e-6f);
#pragma unroll
            for (int i = 0; i < 4; ++i) { const f32x4 w4 = ((const f32x4*)wpre)[lane + 64 * i]; u32x2 o;
                o.x = pk2(v[i][0] * r2 * w4[0], v[i][1] * r2 * w4[1]); o.y = pk2(v[i][2] * r2 * w4[2], v[i][3] * r2 * w4[3]);
                *(u32x2*)(H + (size_t)row * 1024 + (lane + 64 * i) * 4) = o; }
        }
    }
}


__device__ __forceinline__ void phase_ba(const Prm& p, unsigned char* lds) {
    const int tid = threadIdx.x, wv = tid >> 6, lane = tid & 63, n = lane & 15, kq = lane >> 4, mt = wv & 3, kh = wv >> 2;
    const bf16_t* H = (const bf16_t*)(p.ws + OFF_H); const bf16_t* Wb = (const bf16_t*)(p.ws + OFF_WT1) + (size_t)6144 * 1024; float* BA = (float*)(p.ws + OFF_BA);
    const size_t row0 = (size_t)blockIdx.x * 64 + 16 * mt;
    const bf16_t* ap = H + (row0 + n) * 1024 + 512 * kh + 8 * kq; const bf16_t* bp = Wb + (size_t)n * 1024 + 512 * kh + 8 * kq;
    bf16x8 a[16], b[16];
#pragma unroll
    for (int i = 0; i < 16; ++i) { a[i] = *(const bf16x8*)(ap + i * 32); b[i] = *(const bf16x8*)(bp + i * 32); }
    f32x4 acc = (f32x4){0.f, 0.f, 0.f, 0.f};
#pragma unroll
    for (int i = 0; i < 16; ++i) acc = __builtin_amdgcn_mfma_f32_16x16x32_bf16(a[i], b[i], acc, 0, 0, 0);
    float* part = (float*)lds;
#pragma unroll
    for (int j = 0; j < 4; ++j) part[(kh * 64 + 16 * mt + 4 * kq + j) * 16 + n] = acc[j];
    __syncthreads();
    for (int i = tid; i < 1024; i += 512) BA[(size_t)blockIdx.x * 1024 + i] = part[i] + part[1024 + i];
    __syncthreads();
}
__device__ __forceinline__ void sincos_d(double x, double& s, double& c) {
    const double k = rint(x * 0.6366197723675814);
    const double r = fma(-k, 6.123233995736766e-17, fma(-k, 1.5707963267948966, x)), r2 = r * r;
    double sp = -7.647163731819816e-13; sp = fma(sp, r2, 1.6059043836821613e-10); sp = fma(sp, r2, -2.505210838544172e-8); sp = fma(sp, r2, 2.7557319223985893e-6);
    sp = fma(sp, r2, -1.984126984126984e-4); sp = fma(sp, r2, 8.333333333333333e-3); sp = fma(sp, r2, -1.6666666666666666e-1); sp = fma(sp * r2, r, r);
    double cp = 4.779477332387385e-14; cp = fma(cp, r2, -1.1470745597729725e-11); cp = fma(cp, r2, 2.08767569878681e-9); cp = fma(cp, r2, -2.755731922398589e-7);
    cp = fma(cp, r2, 2.48015873015873e-5); cp = fma(cp, r2, -1.388888888888889e-3); cp = fma(cp, r2, 4.1666666666666664e-2); cp = fma(cp, r2, -0.5); cp = fma(cp, r2, 1.0);
    const int q = ((int)k) & 3;
    const double s0 = (q & 1) ? cp : sp, c0 = (q & 1) ? sp : cp;
    s = (q & 2) ? -s0 : s0; c = ((q + 1) & 2) ? -c0 : c0;
}
__device__ __forceinline__ double exp_d(double x) {
    const double n = rint(x * 1.4426950408889634);
    const double r = fma(-n, 2.3190468138462996e-17, fma(-n, 0.6931471805599453, x));
    double p = 1.6059043836821613e-10; p = fma(p, r, 2.08767569878681e-9); p = fma(p, r, 2.505210838544172e-8); p = fma(p, r, 2.755731922398589e-7); p = fma(p, r, 2.7557319223985893e-6);
    p = fma(p, r, 2.48015873015873e-5); p = fma(p, r, 1.984126984126984e-4); p = fma(p, r, 1.388888888888889e-3); p = fma(p, r, 8.333333333333333e-3); p = fma(p, r, 4.1666666666666664e-2);
    p = fma(p, r, 1.6666666666666666e-1); p = fma(p, r, 0.5); p = fma(p, r, 1.0); p = fma(p, r, 1.0);
    return ldexp(p, (int)n);
}
__device__ __forceinline__ float bcast_lo(float v) { auto r = __builtin_amdgcn_permlane32_swap(__float_as_uint(v), __float_as_uint(v), false, false); return __uint_as_float(r[0]); }
__device__ __forceinline__ float bcast_hi(float v) { auto r = __builtin_amdgcn_permlane32_swap(__float_as_uint(v), __float_as_uint(v), false, false); return __uint_as_float(r[1]); }

struct S5C {
    float ar[2][4], ai[2][4];
    float a512r[2], a512i[2];
    bf16x8 BB[4];
    bf16x8 CC[4];
    float dco;
};

template <bool OUT>
__device__ __forceinline__ void s5_chunk(const S5C& C, bf16_t* UU, int b, int g, int chunk, float (&st)[2][2], bf16_t* sX, int lane) {
    const int n = lane & 31, hh = lane >> 5, fr = lane & 15, fq = lane >> 4;
    const size_t tok0 = (size_t)b * SEQ + (size_t)chunk * 512;
    bf16x8 ua = *(const bf16x8*)(UU + (tok0 + n) * 1024 + 16 * g + 8 * hh);
    bf16_t uo[8];
    if (OUT) {
#pragma unroll
        for (int mt = 0; mt < 2; ++mt)
#pragma unroll
            for (int j = 0; j < 4; ++j) uo[mt * 4 + j] = UU[(tok0 + 16 * mt + 4 * fq + j) * 1024 + 16 * g + fr];
    }
    for (int blk = 0; blk < 16; ++blk) {
        const size_t t0 = tok0 + (size_t)blk * 32;
        const bf16x8 ucur = ua;
        bf16_t ucuro[8];
        if (OUT) {
#pragma unroll
            for (int i = 0; i < 8; ++i) ucuro[i] = uo[i];
        }
        if (blk < 15) {
            ua = *(const bf16x8*)(UU + (t0 + 32 + n) * 1024 + 16 * g + 8 * hh);
            if (OUT) {
#pragma unroll
                for (int mt = 0; mt < 2; ++mt)
#pragma unroll
                    for (int j = 0; j < 4; ++j) uo[mt * 4 + j] = UU[(t0 + 32 + 16 * mt + 4 * fq + j) * 1024 + 16 * g + fr];
            }
        }
        f32x16 acc[4];
#pragma unroll
        for (int tl = 0; tl < 4; ++tl) {
            f32x16 z;
#pragma unroll
            for (int i = 0; i < 16; ++i) z[i] = 0.f;
            acc[tl] = __builtin_amdgcn_mfma_f32_32x32x16_bf16(ucur, C.BB[tl], z, 0, 0, 0);
        }
#pragma unroll
        for (int tp = 0; tp < 2; ++tp) {
            f32x16& re = acc[2 * tp]; f32x16& im = acc[2 * tp + 1];
            const float a1r = C.ar[tp][0], a1i = C.ai[tp][0];
#pragma unroll
            for (int q = 0; q < 4; ++q)
#pragma unroll
                for (int r = 1; r < 4; ++r) {
                    const float pr = re[4 * q + r - 1], pi = im[4 * q + r - 1];
                    re[4 * q + r] += a1r * pr - a1i * pi; im[4 * q + r] += a1r * pi + a1i * pr;
                }
            float cr = st[tp][0], ci = st[tp][1];
            const float a4r = C.ar[tp][3], a4i = C.ai[tp][3];
#pragma unroll
            for (int q = 0; q < 4; ++q) {
                const float tr = re[4 * q + 3] + a4r * cr - a4i * ci, ti = im[4 * q + 3] + a4r * ci + a4i * cr;
                const float o0r = bcast_lo(tr), o0i = bcast_lo(ti);
                const float xr = hh ? o0r : cr, xi = hh ? o0i : ci;
                if (OUT) {
#pragma unroll
                    for (int r = 0; r < 4; ++r) { const float kr = C.ar[tp][r], ki = C.ai[tp][r];
                        re[4 * q + r] += kr * xr - ki * xi; im[4 * q + r] += kr * xi + ki * xr; }
                } else {
                    re[4 * q + 3] += a4r * xr - a4i * xi; im[4 * q + 3] += a4r * xi + a4i * xr;
                }
                cr = bcast_hi(re[4 * q + 3]); ci = bcast_hi(im[4 * q + 3]);
            }
            st[tp][0] = cr; st[tp][1] = ci;
        }
        if (OUT) {
            asm volatile("s_waitcnt lgkmcnt(0)" ::: "memory");
#pragma unroll
            for (int tp = 0; tp < 2; ++tp)
#pragma unroll
                for (int i = 0; i < 16; ++i) {
                    const int t = 8 * (i >> 2) + 4 * hh + (i & 3);
                    *(unsigned*)(sX + t * 136 + 2 * (n + 32 * tp)) = pk2(acc[2 * tp][i], acc[2 * tp + 1][i]);
                }
            asm volatile("s_waitcnt lgkmcnt(0)" ::: "memory");
            __builtin_amdgcn_wave_barrier();
#pragma unroll
            for (int mt = 0; mt < 2; ++mt) {
                f32x4 y = (f32x4){0.f, 0.f, 0.f, 0.f};
#pragma unroll
                for (int ks = 0; ks < 4; ++ks) {
                    const bf16x8 xa = *(const bf16x8*)(sX + (16 * mt + fr) * 136 + 32 * ks + 8 * fq);
                    y = __builtin_amdgcn_mfma_f32_16x16x32_bf16(xa, C.CC[ks], y, 0, 0, 0);
                }
#pragma unroll
                for (int j = 0; j < 4; ++j) {
                    float v = y[j] + C.dco * bf2f(ucuro[mt * 4 + j]);
                    const float inner = 0.7978845608028654f * (v + 0.044715f * v * v * v);
                    v = v / (1.0f + __expf(-2.0f * inner));
                    UU[(t0 + 16 * mt + 4 * fq + j) * 1024 + 16 * g + fr] = f2bf(v);
                }
            }
            asm volatile("s_waitcnt lgkmcnt(0)" ::: "memory");
            __builtin_amdgcn_wave_barrier();
        }
    }
}

__device__ __forceinline__ void phase_s5(const Prm& p, unsigned char* lds, int bg) {
    const int b = bg >> 6, g = bg & 63;
    const int tid = threadIdx.x, wv = tid >> 6, lane = tid & 63, n = lane & 31, hh = lane >> 5, fr = lane & 15, fq = lane >> 4;
    bf16_t* sX = (bf16_t*)(lds + wv * 8704);
    float* sXE = (float*)(lds + 8 * 8704);
    bf16_t* UU = (bf16_t*)(p.ws + OFF_UU);
    const float* lam_re = p.in[8]; const float* lam_im = p.in[9]; const float* b_re = p.in[10]; const float* b_im = p.in[11];
    const float* c_re = p.in[12]; const float* c_im = p.in[13];
    S5C C;
    const double dt = exp_d((double)p.in[14][g]);
    float fre[2], fim[2];
#pragma unroll
    for (int tp = 0; tp < 2; ++tp) {
        const int pp = n + 32 * tp;
        const double lr = (double)fminf(lam_re[g * 64 + pp], -1e-4f), li = (double)lam_im[g * 64 + pp];
#pragma unroll
        for (int k = 0; k < 4; ++k) { double sn, cs; sincos_d(li * dt * (k + 1), sn, cs); const double mag = exp_d(lr * dt * (k + 1)); C.ar[tp][k] = (float)(mag * cs); C.ai[tp][k] = (float)(mag * sn); }
        { double sn, cs; sincos_d(li * dt * 512.0, sn, cs); const double mag = exp_d(lr * dt * 512.0); C.a512r[tp] = (float)(mag * cs); C.a512i[tp] = (float)(mag * sn); }
        double sn, cs; sincos_d(li * dt, sn, cs);
        const double mag = exp_d(lr * dt), abr = mag * cs, abi = mag * sn;
        const double den = lr * lr + li * li, nr = abr - 1.0, ni = abi;
        fre[tp] = (float)((nr * lr + ni * li) / den); fim[tp] = (float)((ni * lr - nr * li) / den);
    }
#pragma unroll
    for (int tl = 0; tl < 4; ++tl) {
        const int tp = tl >> 1, ri = tl & 1, pp = n + 32 * tp;
#pragma unroll
        for (int j = 0; j < 8; ++j) {
            const int ch = 8 * hh + j;
            const float br = b_re[(g * 64 + pp) * 16 + ch], bi = b_im[(g * 64 + pp) * 16 + ch];
            const float v = ri == 0 ? fre[tp] * br - fim[tp] * bi : fre[tp] * bi + fim[tp] * br;
            C.BB[tl][j] = (short)f2bf(v);
        }
    }
#pragma unroll
    for (int ks = 0; ks < 4; ++ks)
#pragma unroll
        for (int j = 0; j < 8; ++j) {
            const int k = 32 * ks + 8 * fq + j, pp = k >> 1, ri = k & 1;
            const float v = ri == 0 ? c_re[(g * 16 + fr) * 64 + pp] : -c_im[(g * 16 + fr) * 64 + pp];
            C.CC[ks][j] = (short)f2bf(v);
        }
    C.dco = p.in[15][16 * g + fr];
    for (int rd = 0; rd < 2; ++rd) {
        const int chunk = wv + 8 * rd;
        float st[2][2] = {{0.f, 0.f}, {0.f, 0.f}};
        s5_chunk<false>(C, UU, b, g, chunk, st, sX, lane);
        if (hh == 0) {
#pragma unroll
            for (int tp = 0; tp < 2; ++tp) { sXE[(chunk * 64 + n + 32 * tp) * 2 + 0] = st[tp][0]; sXE[(chunk * 64 + n + 32 * tp) * 2 + 1] = st[tp][1]; }
        }
    }
    __syncthreads();
    for (int rd = 0; rd < 2; ++rd) {
        const int chunk = wv + 8 * rd;
        float st[2][2] = {{0.f, 0.f}, {0.f, 0.f}};
        for (int c2 = 0; c2 < chunk; ++c2) {
#pragma unroll
            for (int tp = 0; tp < 2; ++tp) {
                const float er = sXE[(c2 * 64 + n + 32 * tp) * 2 + 0], ei = sXE[(c2 * 64 + n + 32 * tp) * 2 + 1];
                const float nr = C.a512r[tp] * st[tp][0] - C.a512i[tp] * st[tp][1] + er, ni = C.a512r[tp] * st[tp][1] + C.a512i[tp] * st[tp][0] + ei;
                st[tp][0] = nr; st[tp][1] = ni;
            }
        }
        s5_chunk<true>(C, UU, b, g, chunk, st, sX, lane);
        if (rd == 0) {
            asm volatile("s_waitcnt vmcnt(0)" ::: "memory");
            __syncthreads();
            if (threadIdx.x == 0) { __builtin_amdgcn_fence(__ATOMIC_RELEASE, "agent"); asm volatile("s_waitcnt vmcnt(0)" ::: "memory");
                __hip_atomic_fetch_add((unsigned*)(p.ws + OFF_BAR) + 3900, 1u, __ATOMIC_RELAXED, __HIP_MEMORY_SCOPE_AGENT); }
        }
    }
    __syncthreads();
}

__device__ __forceinline__ void phase_gdn_prep(const Prm& p, unsigned char* lds, int it0, int nrounds) {
    const int tid0 = threadIdx.x, hb = tid0 >> 8;
    unsigned char* base = lds + hb * 76800;
    bf16_t* sQ = (bf16_t*)base;
    bf16_t* sK = (bf16_t*)(base + 17408);
    bf16_t* sV = (bf16_t*)(base + 2 * 17408);
    float* sL = (float*)(base + 3 * 17408);
    float* sBeta = (float*)(base + 4 * 17408);
    float* sGc = sBeta + 64; float* sEg = sGc + 64; float* sBE = sEg + 64;
    float* sCW = sBE + 64;
    bf16_t* QKV = (bf16_t*)(p.ws + OFF_QKV); const bf16_t* HALO = (const bf16_t*)(p.ws + OFF_HALO);
    const float* BA = (const float*)(p.ws + OFF_BA); float* GL = (float*)(p.ws + OFF_GL);
    bf16_t* WB = (bf16_t*)(p.ws + OFF_WB); bf16_t* ATT = (bf16_t*)(p.ws + OFF_ATT);
    const float* convw = p.in[4];
    for (int rd = 0; rd < nrounds; ++rd) {
        int tid = tid0; asm volatile("" : "+v"(tid));
        const int ht = tid & 255, hw = (tid >> 6) & 3, lane = tid & 63, fr = lane & 15, fq = lane >> 4;
        const int it = it0 + rd * 2 + hb;
        const int b = it >> 10, h = (it >> 7) & 7, nc = it & 127;
        const size_t tokb = (size_t)b * SEQ + (size_t)nc * 64;
#pragma unroll
        for (int i = 0; i < 6; ++i) { const int idx = ht + 256 * i, s3 = idx >> 9, tap = (idx >> 7) & 3, ch = idx & 127; sCW[idx] = convw[tap * 3072 + s3 * 1024 + h * 128 + ch]; }
        __syncthreads();
        {
            const int t0 = (ht >> 4) * 4, cgp = ht & 15;
            u32x4 xall[3][7];
#pragma unroll
            for (int s = 0; s < 3; ++s) {
                const int col = s * 1024 + h * 128 + cgp * 8;
#pragma unroll
                for (int i = 0; i < 7; ++i) {
                    const int tt = t0 - 3 + i;
                    xall[s][i] = (u32x4){0u, 0u, 0u, 0u};
                    if (tt >= 0) xall[s][i] = *(const u32x4*)(QKV + (tokb + tt) * 3072 + col);
                    else if (nc > 0) xall[s][i] = *(const u32x4*)(HALO + ((size_t)(b * 128 + nc - 1) * 3 + (3 + tt)) * 3072 + col);
                }
            }
#pragma unroll
            for (int s = 0; s < 3; ++s) {
                u32x4 xr[7];
#pragma unroll
                for (int i = 0; i < 7; ++i) xr[i] = xall[s][i];
                f32x4 w0[4], w1[4];
#pragma unroll
                for (int j = 0; j < 4; ++j) { w0[j] = *(const f32x4*)(sCW + s * 512 + j * 128 + cgp * 8); w1[j] = *(const f32x4*)(sCW + s * 512 + j * 128 + cgp * 8 + 4); }
                float o[4][8], ss[4];
#pragma unroll
                for (int tk = 0; tk < 4; ++tk) {
                    float a[8];
#pragma unroll
                    for (int e = 0; e < 8; ++e) a[e] = 0.f;
#pragma unroll
                    for (int j = 0; j < 4; ++j) {
                        const u32x4 xv = xr[tk + j];
                        a[0] += w0[j][0] * lo2f(xv.x); a[1] += w0[j][1] * hi2f(xv.x); a[2] += w0[j][2] * lo2f(xv.y); a[3] += w0[j][3] * hi2f(xv.y);
                        a[4] += w1[j][0] * lo2f(xv.z); a[5] += w1[j][1] * hi2f(xv.z); a[6] += w1[j][2] * lo2f(xv.w); a[7] += w1[j][3] * hi2f(xv.w);
                    }
                    float acc2 = 0.f;
#pragma unroll
                    for (int e = 0; e < 8; ++e) { const float v = siluf_(a[e]); o[tk][e] = v; acc2 += v * v; }
                    ss[tk] = acc2;
                }
                bf16_t* dst = (s == 0 ? sQ : (s == 1 ? sK : sV)) + t0 * 136 + cgp * 8;
#pragma unroll
                for (int tk = 0; tk < 4; ++tk) {
                    float sc = 1.0f;
                    if (s < 2) { float q = ss[tk]; q += __shfl_xor(q, 1); q += __shfl_xor(q, 2); q += __shfl_xor(q, 4); q += __shfl_xor(q, 8); sc = rsqrtf(q + 1e-6f) * (s == 0 ? 0.08838834764831845f : 1.0f); }
                    u32x4 pk;
                    pk.x = pk2(o[tk][0] * sc, o[tk][1] * sc); pk.y = pk2(o[tk][2] * sc, o[tk][3] * sc); pk.z = pk2(o[tk][4] * sc, o[tk][5] * sc); pk.w = pk2(o[tk][6] * sc, o[tk][7] * sc);
                    *(u32x4*)(dst + tk * 136) = pk;
                }
            }
        }
        if (hw == 0) {
            const size_t tg = tokb + lane;
            const float braw = BA[tg * 16 + h], araw = BA[tg * 16 + 8 + h];
            const float beta = 1.0f / (1.0f + expf(-braw));
            const float xx = araw + p.in[6][h];
            const float sp = xx > 20.f ? xx : log1pf(expf(xx));
            float gg = -expf(p.in[5][h]) * sp;
#pragma unroll
            for (int off = 1; off < 64; off <<= 1) { const float o = __shfl_up(gg, off); if (lane >= off) gg += o; }
            sBeta[lane] = beta; sGc[lane] = gg; sEg[lane] = expf(gg); sBE[lane] = beta * expf(gg);
            if (lane == 63) GL[it] = expf(gg);
        }
        __syncthreads();
        {
            bf16x8 aK[4], aQ[4];
#pragma unroll
            for (int ks = 0; ks < 4; ++ks) { aK[ks] = *(const bf16x8*)(sK + (16 * hw + fr) * 136 + 32 * ks + 8 * fq); aQ[ks] = *(const bf16x8*)(sQ + (16 * hw + fr) * 136 + 32 * ks + 8 * fq); }
#pragma unroll
            for (int nt = 0; nt < 4; ++nt) {
                f32x4 kk = (f32x4){0.f, 0.f, 0.f, 0.f}, qk = (f32x4){0.f, 0.f, 0.f, 0.f};
#pragma unroll
                for (int ks = 0; ks < 4; ++ks) {
                    const bf16x8 bK = *(const bf16x8*)(sK + (16 * nt + fr) * 136 + 32 * ks + 8 * fq);
                    kk = __builtin_amdgcn_mfma_f32_16x16x32_bf16(aK[ks], bK, kk, 0, 0, 0);
                    qk = __builtin_amdgcn_mfma_f32_16x16x32_bf16(aQ[ks], bK, qk, 0, 0, 0);
                }
                const int mcol = 16 * nt + fr; const float gm = sGc[mcol];
#pragma unroll
                for (int j = 0; j < 4; ++j) {
                    const int c = 16 * hw + 4 * fq + j;
                    const float dec = __expf(fminf(sGc[c] - gm, 0.f));
                    sL[c * 68 + mcol] = (mcol < c) ? kk[j] * sBeta[c] * dec : 0.f;
                    ATT[(size_t)it * 4096 + c * 64 + mcol] = f2bf((mcol <= c) ? qk[j] * dec : 0.f);
                }
            }
        }
        __syncthreads();
        {
            f32x2_t xv[32];
#define X_(i) (xv[(i) >> 1][(i) & 1])
            const bool isU = ht < 128; const int jc = ht & 127;
            const bf16_t* src = isU ? sV : sK;
            const float* fac = isU ? sBeta : sBE;
#pragma unroll
            for (int cb = 0; cb < 16; ++cb) {
                f32x2_t a2[4];
#pragma unroll
                for (int r = 0; r < 4; ++r) { a2[r].x = bf2f(src[(4 * cb + r) * 136 + jc]) * fac[4 * cb + r]; a2[r].y = 0.f; }
                const f32x4 d1 = *(const f32x4*)(sL + (4 * cb + 1) * 68 + 4 * cb), d2 = *(const f32x4*)(sL + (4 * cb + 2) * 68 + 4 * cb), d3 = *(const f32x4*)(sL + (4 * cb + 3) * 68 + 4 * cb);
                const int nb = (cb + 1) / 2;
                f32x4 lb[2][4][2];
#define SOLVE_LOAD(mb_, buf_) do { _Pragma("unroll") for (int q = 0; q < 2; ++q) _Pragma("unroll") for (int r = 0; r < 4; ++r) \
                    if (2 * (mb_) + q < cb) lb[buf_][r][q] = *(const f32x4*)(sL + (4 * cb + r) * 68 + 4 * (2 * (mb_) + q)); } while (0)
                if (nb > 0) SOLVE_LOAD(0, 0);
#pragma unroll
                for (int mb = 0; mb < nb; ++mb) {
                    if (mb + 1 < nb) SOLVE_LOAD(mb + 1, (mb + 1) & 1);
                    __builtin_amdgcn_sched_barrier(0);
#pragma unroll
                    for (int q = 0; q < 2; ++q)
#pragma unroll
                        for (int r = 0; r < 4; ++r)
                            if (2 * mb + q < cb) { const f32x4 l = lb[mb & 1][r][q]; const int m2 = 2 * (2 * mb + q);
                                a2[r] -= (f32x2_t){l[0], l[1]} * xv[m2]; a2[r] -= (f32x2_t){l[2], l[3]} * xv[m2 + 1]; }
                    __builtin_amdgcn_sched_barrier(0);
                }
#undef SOLVE_LOAD
                const float a0 = a2[0].x + a2[0].y, a1 = a2[1].x + a2[1].y, a2s = a2[2].x + a2[2].y, a3 = a2[3].x + a2[3].y;
                const float y0 = a0, y1 = a1 - d1[0] * y0, y2 = a2s - d2[0] * y0 - d2[1] * y1, y3 = a3 - d3[0] * y0 - d3[1] * y1 - d3[2] * y2;
                xv[2 * cb] = (f32x2_t){y0, y1}; xv[2 * cb + 1] = (f32x2_t){y2, y3};
            }
            if (isU) {
                const int w8 = jc >> 4, nn = jc & 15;
#pragma unroll
                for (int rq = 0; rq < 4; ++rq)
#pragma unroll
                    for (int pc = 0; pc < 2; ++pc) {
                        const int c0 = 32 * pc + 8 * rq;
                        u32x4 o; o.x = pk2(X_(c0 + 0), X_(c0 + 1)); o.y = pk2(X_(c0 + 2), X_(c0 + 3)); o.z = pk2(X_(c0 + 4), X_(c0 + 5)); o.w = pk2(X_(c0 + 6), X_(c0 + 7));
                        const int L = ((w8 * 2 + pc) * 64 + rq * 16 + nn) * 8;
                        *(u32x4*)(QKV + (tokb + (L >> 7)) * 3072 + 2048 + h * 128 + (L & 127)) = o;
                    }
            }
            __syncthreads();
            if (!isU) {
                bf16_t* sW2 = (bf16_t*)sL;
#pragma unroll
                for (int c = 0; c < 64; ++c) sW2[c * 136 + jc] = f2bf(-X_(c));
            }
        }
        __syncthreads();
        {
            const bf16_t* sW2 = (const bf16_t*)sL;
#pragma unroll
            for (int i = 0; i < 4; ++i) { const int ch = ht + 256 * i, r = ch >> 4, c8 = (ch & 15) * 8; *(u32x4*)(WB + (size_t)it * 8192 + r * 128 + c8) = *(const u32x4*)(sW2 + r * 136 + c8); }
        }
#undef X_
        {
            const int c = ht >> 2, ds = (ht & 3) * 32; const float eg = sEg[c];
#pragma unroll
            for (int c8 = 0; c8 < 4; ++c8) {
                const u32x4 v = *(const u32x4*)(sQ + c * 136 + ds + c8 * 8); u32x4 o;
                o.x = pk2(lo2f(v.x) * eg, hi2f(v.x) * eg); o.y = pk2(lo2f(v.y) * eg, hi2f(v.y) * eg); o.z = pk2(lo2f(v.z) * eg, hi2f(v.z) * eg); o.w = pk2(lo2f(v.w) * eg, hi2f(v.w) * eg);
                *(u32x4*)(QKV + (tokb + c) * 3072 + h * 128 + ds + c8 * 8) = o;
            }
            const int d = ht >> 1, cs = (ht & 1) * 32; const float gl = sGc[63];
#pragma unroll
            for (int c8 = 0; c8 < 4; ++c8) {
                float v[8];
#pragma unroll
                for (int e = 0; e < 8; ++e) { const int cc = cs + c8 * 8 + e; v[e] = bf2f(sK[cc * 136 + d]) * __expf(gl - sGc[cc]); }
                u32x4 o; o.x = pk2(v[0], v[1]); o.y = pk2(v[2], v[3]); o.z = pk2(v[4], v[5]); o.w = pk2(v[6], v[7]);
                *(u32x4*)(QKV + (tokb + (d >> 1)) * 3072 + 1024 + h * 128 + (d & 1) * 64 + cs + c8 * 8) = o;
            }
        }
        __syncthreads();
    }
}

constexpr int SC_WQ = 32768, SC_KA = 24576, SC_KA0 = 3 * SC_WQ;
static_assert(SC_KA0 + 2 * SC_KA <= LDS_BYTES, "scan LDS layout");
__device__ __forceinline__ bf16x8 pack2(const f32x4& a, const f32x4& b) {
    u32x4 r; r.x = pk2(a[0], a[1]); r.y = pk2(a[2], a[3]); r.z = pk2(b[0], b[1]); r.w = pk2(b[2], b[3]); return __builtin_bit_cast(bf16x8, r);
}
#define MF16(a, b, c) __builtin_amdgcn_mfma_f32_16x16x32_bf16(a, b, c, 0, 0, 0)
#define DMA16(src, dst) __builtin_amdgcn_global_load_lds((const unsigned*)(src), (LAS unsigned*)(dst), 16, 0, 0)
__device__ __forceinline__ void phase_gdn_scan(const Prm& p, LAS unsigned char* lds, int blk) {
    const int tid = threadIdx.x, wv = __builtin_amdgcn_readfirstlane(tid >> 6), lane = tid & 63, n = lane & 15, kq = lane >> 4;
    const int bh = blk & 15, jh = blk >> 4, b = bh >> 3, h = bh & 7;
    const bf16_t* QKV = (const bf16_t*)(p.ws + OFF_QKV); const bf16_t* WB = (const bf16_t*)(p.ws + OFF_WB); const bf16_t* ATT = (const bf16_t*)(p.ws + OFF_ATT);
    const float* GL = (const float*)(p.ws + OFF_GL); bf16_t* O = (bf16_t*)(p.ws + OFF_H);
    const int itb = bh * 128;
    const bf16_t* qkv_b = QKV + (size_t)b * SEQ * 3072;
    if (wv >= 4) {
        const int lw = wv - 4;
        __builtin_amdgcn_s_setprio(3);
        unsigned oW[4], oQ[4], oK[4], oA[2];
#pragma unroll
        for (int i = 0; i < 4; ++i) {
            { const int q = lw * 4 + i, row = 4 * q + (lane >> 4), pg = lane & 15, g = pg ^ ((row & 3) | (((row >> 3) & 3) << 2)); oW[i] = (unsigned)(row * 128 + g * 8); oQ[i] = (unsigned)(row * 3072 + h * 128 + g * 8); }
            { const int q = lw * 4 + i, d = 8 * q + (lane >> 3), pg = lane & 7, g = pg ^ ((d & 3) | (((d >> 3) & 1) << 2)); oK[i] = (unsigned)((d >> 1) * 3072 + 1024 + h * 128 + (d & 1) * 64 + g * 8); }
        }
#pragma unroll
        for (int i = 0; i < 2; ++i) { const int q = lw * 2 + i, c = 8 * q + (lane >> 3), pg = lane & 7, g = pg ^ ((c & 3) | (((c >> 3) & 1) << 2)); oA[i] = (unsigned)(c * 64 + g * 8); }
#define ISSUE_WQ(ck, st) do { const bf16_t* wb_ = WB + (size_t)(itb + (ck)) * 8192; const bf16_t* qb_ = qkv_b + (size_t)(ck) * 64 * 3072; LAS unsigned char* d_ = lds + (st) * SC_WQ + lw * 4096; \
        _Pragma("unroll") for (int i = 0; i < 4; ++i) { DMA16(wb_ + oW[i], d_ + i * 1024); DMA16(qb_ + oQ[i], d_ + 16384 + i * 1024); } } while (0)
#define ISSUE_KA(ck, st) do { const bf16_t* qb_ = qkv_b + (size_t)(ck) * 64 * 3072; const bf16_t* ab_ = ATT + (size_t)(itb + (ck)) * 4096; LAS unsigned char* d_ = lds + SC_KA0 + (st) * SC_KA; \
        _Pragma("unroll") for (int i = 0; i < 4; ++i) DMA16(qb_ + oK[i], d_ + (lw * 4 + i) * 1024); \
        _Pragma("unroll") for (int i = 0; i < 2; ++i) DMA16(ab_ + oA[i], d_ + 16384 + (lw * 2 + i) * 1024); } while (0)
        ISSUE_WQ(0, 0); ISSUE_KA(0, 0); ISSUE_WQ(1, 1);
        asm volatile("s_waitcnt vmcnt(0)" ::: "memory"); __builtin_amdgcn_s_barrier(); asm volatile("" ::: "memory");
        int s3 = 2;
        for (int nc = 0; nc < 128; ++nc) {
            const int c1 = nc + 1 < 128 ? nc + 1 : 127, c2 = nc + 2 < 128 ? nc + 2 : 127;
            ISSUE_WQ(c2, s3);
            ISSUE_KA(c1, (nc + 1) & 1);
            s3 = s3 == 2 ? 0 : s3 + 1;
            asm volatile("s_waitcnt vmcnt(14)" ::: "memory");
            __builtin_amdgcn_s_barrier(); asm volatile("" ::: "memory");
            __builtin_amdgcn_s_barrier(); asm volatile("" ::: "memory");
        }
        asm volatile("s_waitcnt vmcnt(0)" ::: "memory");
        __builtin_amdgcn_s_setprio(0);
#undef ISSUE_WQ
#undef ISSUE_KA
    } else if (wv >= 2) {
        for (int nc = 0; nc < 257; ++nc) { __builtin_amdgcn_s_barrier(); asm volatile("" ::: "memory"); }
    } else {
        const float gl0 = GL[itb + lane], gl1 = GL[itb + 64 + lane];
        f32x4 S[8];
#pragma unroll
        for (int dt = 0; dt < 8; ++dt) S[dt] = (f32x4){0.f, 0.f, 0.f, 0.f};
        const int e = 32 * jh + 16 * wv + n;
        unsigned uo[2];
#pragma unroll
        for (int pc = 0; pc < 2; ++pc) { const int L = (((2 * jh + wv) * 2 + pc) * 64 + lane) * 8; uo[pc] = (unsigned)((L >> 7) * 3072 + 2048 + h * 128 + (L & 127)); }
        u32x4 ua[2], ub[2];
#pragma unroll
        for (int pc = 0; pc < 2; ++pc) { ua[pc] = *(const u32x4*)(qkv_b + uo[pc]); ub[pc] = *(const u32x4*)(qkv_b + (size_t)64 * 3072 + uo[pc]); }
        const int rowb = 8 * (n >> 2) + (n & 3), swk = (n & 3) | (((n >> 2) & 1) << 2);
        unsigned offW[4], offK[2];
#pragma unroll
        for (int ks = 0; ks < 4; ++ks) offW[ks] = (unsigned)(rowb * 256 + (((4 * ks + kq) ^ n) << 4));
#pragma unroll
        for (int k2 = 0; k2 < 2; ++k2) offK[k2] = (unsigned)(rowb * 128 + (((4 * k2 + kq) ^ swk) << 4));
        asm volatile("s_waitcnt lgkmcnt(0)" ::: "memory"); __builtin_amdgcn_s_barrier(); asm volatile("" ::: "memory");
        int s3 = 0;
        for (int nc = 0; nc < 128; ++nc) {
            const LAS unsigned char* sWQ = lds + s3 * SC_WQ; const LAS unsigned char* sKA = lds + SC_KA0 + (nc & 1) * SC_KA;
            s3 = s3 == 2 ? 0 : s3 + 1;
            const float gl = __builtin_bit_cast(float, __builtin_amdgcn_readlane(__builtin_bit_cast(int, nc < 64 ? gl0 : gl1), nc & 63));
            f32x4 V[4], Oa[4];
#pragma unroll
            for (int pc = 0; pc < 2; ++pc) {
                const u32x4 uu = ua[pc];
                V[2 * pc] = (f32x4){lo2f(uu.x), hi2f(uu.x), lo2f(uu.y), hi2f(uu.y)}; V[2 * pc + 1] = (f32x4){lo2f(uu.z), hi2f(uu.z), lo2f(uu.w), hi2f(uu.w)};
                ua[pc] = ub[pc];
            }
            { const int c2 = nc + 2 < 128 ? nc + 2 : 127; const bf16_t* ubase = qkv_b + (size_t)c2 * 64 * 3072;
#pragma unroll
              for (int pc = 0; pc < 2; ++pc) ub[pc] = *(const u32x4*)(ubase + uo[pc]); }
#pragma unroll
            for (int ct = 0; ct < 4; ++ct) Oa[ct] = (f32x4){0.f, 0.f, 0.f, 0.f};
            bf16x8 fa[2][8];
#define TOFF(t, pitch) ((32 * ((t) >> 1) + 4 * ((t) & 1)) * (pitch))
#define LD_WQ(dst, ks_) do { _Pragma("unroll") for (int mt = 0; mt < 4; ++mt) { dst[mt] = *(const LAS bf16x8*)(sWQ + offW[ks_] + TOFF(mt, 256)); dst[4 + mt] = *(const LAS bf16x8*)(sWQ + 16384 + offW[ks_] + TOFF(mt, 256)); } } while (0)
            LD_WQ(fa[0], 0);
#pragma unroll
            for (int ks = 0; ks < 4; ++ks) {
                if (ks < 3) LD_WQ(fa[(ks + 1) & 1], ks + 1);
                const bf16x8 sb8 = pack2(S[2 * ks], S[2 * ks + 1]);
                __builtin_amdgcn_sched_barrier(0);
#pragma unroll
                for (int mt = 0; mt < 4; ++mt) { V[mt] = MF16(fa[ks & 1][mt], sb8, V[mt]); Oa[mt] = MF16(fa[ks & 1][4 + mt], sb8, Oa[mt]); }
                __builtin_amdgcn_sched_barrier(0);
            }
#undef LD_WQ
            asm volatile("s_waitcnt lgkmcnt(0)" ::: "memory"); __builtin_amdgcn_s_barrier(); asm volatile("" ::: "memory");
            bf16x8 fb[2][12];
#define LD_AK(dst, k2_) do { _Pragma("unroll") for (int mt = 0; mt < 4; ++mt) dst[mt] = *(const LAS bf16x8*)(sKA + 16384 + offK[k2_] + TOFF(mt, 128)); \
                             _Pragma("unroll") for (int dt = 0; dt < 8; ++dt) dst[4 + dt] = *(const LAS bf16x8*)(sKA + offK[k2_] + TOFF(dt, 128)); } while (0)
            LD_AK(fb[0], 0);
            bf16x8 Vb[2];
            Vb[0] = pack2(V[0], V[1]); Vb[1] = pack2(V[2], V[3]);
#pragma unroll
            for (int dt = 0; dt < 8; ++dt) S[dt] *= gl;
#pragma unroll
            for (int k2 = 0; k2 < 2; ++k2) {
                if (k2 < 1) LD_AK(fb[1], 1);
                __builtin_amdgcn_sched_barrier(0);
#pragma unroll
                for (int mt = 0; mt < 4; ++mt) Oa[mt] = MF16(fb[k2][mt], Vb[k2], Oa[mt]);
#pragma unroll
                for (int dt = 0; dt < 8; ++dt) S[dt] = MF16(fb[k2][4 + dt], Vb[k2], S[dt]);
                __builtin_amdgcn_sched_barrier(0);
            }
#undef LD_AK
#undef TOFF
            bf16_t* obase = O + (size_t)(itb + nc) * 8192 + e * 64 + 8 * kq;
#pragma unroll
            for (int pc = 0; pc < 2; ++pc) *(u32x4*)(obase + 32 * pc) = pack8(Oa[2 * pc], Oa[2 * pc + 1]);
            asm volatile("s_waitcnt lgkmcnt(0)" ::: "memory"); __builtin_amdgcn_s_barrier(); asm volatile("" ::: "memory");
        }
    }
    __syncthreads();
}

__device__ __forceinline__ void phase_ya(const Prm& p, unsigned char* lds) {
    const bf16_t* OT = (const bf16_t*)(p.ws + OFF_H); bf16_t* SZA = (bf16_t*)p.out;
    const float* gw = p.in[7];
    bf16_t* sT = (bf16_t*)lds;
    float* sPart = (float*)(lds + 16384);
    const int tid = threadIdx.x, w = tid >> 6, c = tid & 63;
    for (int it = blockIdx.x; it < NIT; it += gridDim.x) {
        const int b = it >> 10, h = (it >> 7) & 7, nc = it & 127;
        const size_t tok = (size_t)b * SEQ + (size_t)nc * 64 + c;
#pragma unroll
        for (int i = 0; i < 2; ++i) { const int ch = tid + 512 * i; *(u32x4*)(sT + ch * 8) = *(const u32x4*)(OT + (size_t)it * 8192 + ch * 8); }
        const u32x4 z0 = *(const u32x4*)(SZA + tok * 1024 + h * 128 + 16 * w), z1 = *(const u32x4*)(SZA + tok * 1024 + h * 128 + 16 * w + 8);
        __syncthreads();
        float o[16]; float ss = 0.f;
#pragma unroll
        for (int j = 0; j < 16; ++j) { o[j] = bf2f(sT[(16 * w + j) * 64 + c]); ss += o[j] * o[j]; }
        sPart[w * 64 + c] = ss;
        __syncthreads();
        float tot = 0.f;
#pragma unroll
        for (int k = 0; k < 8; ++k) tot += sPart[k * 64 + c];
        const float rstd = rsqrtf(tot * (1.0f / 128.0f) + 1e-6f);
        const unsigned zz[8] = {z0.x, z0.y, z0.z, z0.w, z1.x, z1.y, z1.z, z1.w};
        unsigned r[8];
#pragma unroll
        for (int j = 0; j < 8; ++j)
            r[j] = pk2(o[2 * j] * rstd * gw[16 * w + 2 * j] * lo2f(zz[j]), o[2 * j + 1] * rstd * gw[16 * w + 2 * j + 1] * hi2f(zz[j]));
        *(u32x4*)(SZA + tok * 1024 + h * 128 + 16 * w) = (u32x4){r[0], r[1], r[2], r[3]};
        *(u32x4*)(SZA + tok * 1024 + h * 128 + 16 * w + 8) = (u32x4){r[4], r[5], r[6], r[7]};
        __syncthreads();
    }
}
__device__ __forceinline__ void phase_conv3(const Prm& p) {
    const bf16_t* P = (const bf16_t*)(p.ws + OFF_P); bf16_t* Q = (bf16_t*)(p.ws + OFF_Q); const float* cw = p.in[19];
    const int nth = gridDim.x * 512;
    for (int idx = blockIdx.x * 512 + threadIdx.x; idx < (TOK / 4) * 256; idx += nth) {
        const int t0 = (idx >> 8) * 4, c8 = (idx & 255) * 8;
        const bool first = (t0 & (SEQ - 1)) == 0;
        u32x4 pr[6], qr[4];
#pragma unroll
        for (int i = 0; i < 6; ++i) pr[i] = (i < 2 && first) ? (u32x4){0u, 0u, 0u, 0u} : *(const u32x4*)(P + (size_t)(t0 - 2 + i) * 2048 + c8);
#pragma unroll
        for (int i = 0; i < 4; ++i) qr[i] = *(const u32x4*)(Q + (size_t)(t0 + i) * 2048 + c8);
        float w0[8], w1[8], w2[8];
#pragma unroll
        for (int e = 0; e < 8; ++e) { w0[e] = cw[c8 + e]; w1[e] = cw[2048 + c8 + e]; w2[e] = cw[4096 + c8 + e]; }
#pragma unroll
        for (int i = 0; i < 4; ++i) {
            const unsigned pa[4] = {pr[i + 2].x, pr[i + 2].y, pr[i + 2].z, pr[i + 2].w}, pb[4] = {pr[i + 1].x, pr[i + 1].y, pr[i + 1].z, pr[i + 1].w}, pc[4] = {pr[i].x, pr[i].y, pr[i].z, pr[i].w};
            const unsigned qa[4] = {qr[i].x, qr[i].y, qr[i].z, qr[i].w};
            unsigned o[4];
#pragma unroll
            for (int e = 0; e < 4; ++e)
                o[e] = pk2(lo2f(qa[e]) * (w0[2 * e] * lo2f(pc[e]) + w1[2 * e] * lo2f(pb[e]) + w2[2 * e] * lo2f(pa[e])),
                           hi2f(qa[e]) * (w0[2 * e + 1] * hi2f(pc[e]) + w1[2 * e + 1] * hi2f(pb[e]) + w2[2 * e + 1] * hi2f(pa[e])));
            *(u32x4*)(Q + (size_t)(t0 + i) * 2048 + c8) = (u32x4){o[0], o[1], o[2], o[3]};
        }
    }
}

#define XB_TMO      128
#define XB_XCNT(j)  (256  + 64 * (j))
#define XB_XSUB(j)  (1280 + 64 * (j))
#define XB_XGEN(j)  (2304 + 64 * (j))
#define XB_TOP      3328
#define XB_TOPGEN   3392
#define XCD_BAR_WORDS 3456
#define XB_SPIN_CAP (1u << 18)

__device__ __forceinline__ unsigned xb_ld(unsigned* p)              { return __hip_atomic_load(p, __ATOMIC_RELAXED, __HIP_MEMORY_SCOPE_AGENT); }
__device__ __forceinline__ unsigned xb_add(unsigned* p, unsigned v) { return __hip_atomic_fetch_add(p, v, __ATOMIC_RELAXED, __HIP_MEMORY_SCOPE_AGENT); }
__device__ __forceinline__ unsigned xb_xcc_id() { return (unsigned)__builtin_amdgcn_s_getreg((3 << 11) | 20) & 0xFu; }
#define XB_SPIN(cond, bar) do { unsigned _sp = 0; while (cond) { __builtin_amdgcn_s_sleep(1); \
    if ((++_sp & 255u) == 0u) { if (xb_ld(&(bar)[XB_TMO])) break; if (_sp > XB_SPIN_CAP) { atomicAdd(&(bar)[XB_TMO], 1u); break; } } } } while (0)

struct XcdBarrier {
    unsigned* bar; unsigned x;
    volatile LAS unsigned* st;
};

__device__ __forceinline__ XcdBarrier xcd_barrier_post(unsigned* bar, volatile LAS unsigned* st) {
    XcdBarrier b; b.bar = bar; b.x = xb_xcc_id(); b.st = st;
    if (threadIdx.x == 0) (void)xb_add(&bar[XB_XCNT(b.x)], 1u);
    return b;
}
__device__ __forceinline__ void xcd_barrier_complete(unsigned* bar, unsigned x, unsigned& nloc, unsigned& nx) {
    const unsigned G = gridDim.x * gridDim.y * gridDim.z;
    unsigned sum, cnt, mine, sp = 0u;
    for (;;) {
        sum = 0u; cnt = 0u; mine = 0u;
#pragma unroll
        for (unsigned j = 0; j < 16; ++j) { const unsigned c = xb_ld(&bar[XB_XCNT(j)]); sum += c; cnt += (c > 0u) ? 1u : 0u; mine = (j == x) ? c : mine; }
        if (sum == G) break;
        __builtin_amdgcn_s_sleep(1);
        if ((++sp & 255u) == 0u) { if (xb_ld(&bar[XB_TMO])) break; if (sp > XB_SPIN_CAP) { atomicAdd(&bar[XB_TMO], 1u); break; } }
    }
    nloc = mine > 0u ? mine : 1u; nx = cnt > 0u ? cnt : 1u;
}

__device__ __forceinline__ void xcd_barrier(const XcdBarrier& b) {
    asm volatile("s_waitcnt vmcnt(0)" ::: "memory");
    __syncthreads();
    if (threadIdx.x == 0) {
        unsigned* bar = b.bar;
        __builtin_amdgcn_s_waitcnt(0);
        unsigned nloc = b.st[0], nx = b.st[1];
        if (nloc == 0u) { xcd_barrier_complete(bar, b.x, nloc, nx); b.st[0] = nloc; b.st[1] = nx; }
        const unsigned old = xb_add(&bar[XB_XSUB(b.x)], 1u);
        const unsigned gen = old / nloc;
        if (old + 1u == (gen + 1u) * nloc) {
            __builtin_amdgcn_fence(__ATOMIC_RELEASE, "agent");
            asm volatile("s_waitcnt vmcnt(0)" ::: "memory");
            const unsigned og = xb_add(&bar[XB_TOP], 1u);
            const unsigned tg = og / nx;
            if (og + 1u == (tg + 1u) * nx) xb_add(&bar[XB_TOPGEN], 1u);
            else XB_SPIN(xb_ld(&bar[XB_TOPGEN]) == tg, bar);
            __builtin_amdgcn_fence(__ATOMIC_ACQUIRE, "agent");
            xb_add(&bar[XB_XGEN(b.x)], 1u);
            asm volatile("s_waitcnt vmcnt(0)" ::: "memory");
        } else {
            XB_SPIN(xb_ld(&bar[XB_XGEN(b.x)]) == gen, bar);
            __builtin_amdgcn_fence(__ATOMIC_ACQUIRE, "agent");
            asm volatile("s_waitcnt vmcnt(0)" ::: "memory");
        }
    }
    __syncthreads();
}

constexpr int NPHASE = 11;
#define REP_GEMM 1
#define REP_SYNC 1
#define REP_SCAN 1
#define SCAN_PROBE 1
#define REP_P0 1
#ifndef PHM
#define PHM 0x7FF
#endif
__global__ void __launch_bounds__(512, 2) mega(Prm p) {
    extern __shared__ __attribute__((aligned(16))) unsigned char shm[];
    LAS unsigned char* lds3 = (LAS unsigned char*)shm;
    unsigned char* ws = p.ws;
    volatile LAS unsigned* xst = (volatile LAS unsigned*)(lds3 + LDS_BYTES);
    if (threadIdx.x == 0) { xst[0] = 0u; xst[1] = 0u; }
    __syncthreads();
    XcdBarrier xb{};
    const bool multi = (p.ph_hi - p.ph_lo) > 1;
    if (multi) xb = xcd_barrier_post((unsigned*)(ws + OFF_BAR), xst);
    if (p.ph_lo < 0) cg::this_grid().sync();
#define PH_BEGIN(i) if (((PHM >> (i)) & 1) && p.ph_lo <= (i) && (i) < p.ph_hi) { if ((i) > p.ph_lo) { xcd_barrier(xb); if (REP_SYNC > 1) xcd_barrier(xb); } pg8::StaticOrder S; (void)S;
#define PH_END }
    PH_BEGIN(0)
        for (int rep = 0; rep < REP_P0; ++rep) {
        phase_convert(p, shm, 0, 1856, gridDim.x, blockIdx.x);
        phase_rmsnorm_x(p.in[0], p.in[1], (bf16_t*)(ws + OFF_H)); __syncthreads(); }
    PH_END
    PH_BEGIN(1)
        phase_ba(p, shm);
        pg8::Gemm g{(const bf16_t*)(ws + OFF_H), (const bf16_t*)(ws + OFF_WT1), TOK, 6144, 1024, (const bf16_t*)(ws + OFF_H), 1024, 64};
        Epi1 E{(bf16_t*)(ws + OFF_QKV), (bf16_t*)p.out, (bf16_t*)(ws + OFF_UU), (bf16_t*)p.out + (size_t)TOK * 1024, (float*)(ws + OFF_BA), (bf16_t*)(ws + OFF_HALO)};
        S.init(TOK, 6144, gridDim.x, blockIdx.x); for (int rep = 0; rep < REP_GEMM; ++rep) { pg8::gemm_phase(lds3, g, S, E); __syncthreads(); }
    PH_END
    PH_BEGIN(2)
        {
            unsigned* ctr = (unsigned*)(ws + OFF_BAR) + 3600;
            volatile LAS unsigned* sIt = xst + 2;
            for (;;) {
                if (threadIdx.x == 0) sIt[0] = __hip_atomic_fetch_add(ctr, 2u, __ATOMIC_RELAXED, __HIP_MEMORY_SCOPE_AGENT);
                __syncthreads();
                const unsigned it0 = sIt[0];
                __syncthreads();
                if (it0 >= (unsigned)NIT) break;
                phase_gdn_prep(p, shm, (int)it0, 1);
            }
        }
    PH_END
    PH_BEGIN(3)
        if (blockIdx.x < 64) phase_gdn_scan(p, lds3, blockIdx.x);
        else {
            const int ob = blockIdx.x - 64;
            pg8::Gemm g{(const bf16_t*)(ws + OFF_UU), (const bf16_t*)(ws + OFF_WTG), TOK, 1024, 1024, (const bf16_t*)(ws + OFF_UU), 1024, 64};
            EpiGlu E{(const bf16_t*)(ws + OFF_UU), (bf16_t*)p.out + (size_t)TOK * 1024};
            unsigned* cw = (unsigned*)(ws + OFF_BAR);
            if (ob < 128) {
                phase_s5(p, shm, ob);
                asm volatile("s_waitcnt vmcnt(0)" ::: "memory");
                __syncthreads();
                if (threadIdx.x == 0) {
                    __builtin_amdgcn_fence(__ATOMIC_RELEASE, "agent");
                    asm volatile("s_waitcnt vmcnt(0)" ::: "memory");
                    __hip_atomic_fetch_add(cw + 3700, 1u, __ATOMIC_RELAXED, __HIP_MEMORY_SCOPE_AGENT);
                    unsigned sp = 0;
                    while (__hip_atomic_load(cw + 3700, __ATOMIC_RELAXED, __HIP_MEMORY_SCOPE_AGENT) < 128u) { __builtin_amdgcn_s_sleep(2); if (++sp > (1u << 22)) break; }
                    __builtin_amdgcn_fence(__ATOMIC_ACQUIRE, "agent");
                    asm volatile("s_waitcnt vmcnt(0)" ::: "memory");
                }
                __syncthreads();
                S.init_list(ob, 1, 1); pg8::gemm_phase(lds3, g, S, E);
            } else {
                const int e = ob - 128;
                phase_convert(p, shm, 1856, 4928, 64, e);
                __syncthreads();
                if (threadIdx.x == 0) {
                    unsigned sp = 0;
                    while (__hip_atomic_load(cw + 3900, __ATOMIC_RELAXED, __HIP_MEMORY_SCOPE_AGENT) < 128u) { __builtin_amdgcn_s_sleep(2); if (++sp > (1u << 22)) break; }
                    __builtin_amdgcn_fence(__ATOMIC_ACQUIRE, "agent");
                    asm volatile("s_waitcnt vmcnt(0)" ::: "memory");
                }
                __syncthreads();
                S.init_list(2 * e, 2, 0); pg8::gemm_phase(lds3, g, S, E);
            }
        }
    PH_END
    PH_BEGIN(4)
        phase_ya(p, shm);
    PH_END
    PH_BEGIN(5)
        pg8::Gemm g{(const bf16_t*)p.out, (const bf16_t*)(ws + OFF_WTO0), TOK, 1024, 2048, (const bf16_t*)p.out + (size_t)TOK * 1024, 1024, 16};
        EpiB16 E{(bf16_t*)(ws + OFF_QKV)};
        S.init(TOK, 1024, gridDim.x, blockIdx.x); for (int rep = 0; rep < REP_GEMM; ++rep) { pg8::gemm_phase(lds3, g, S, E); __syncthreads(); }
    PH_END
    PH_BEGIN(6)
        phase_post<true>(p.in[0], (const bf16_t*)(ws + OFF_QKV), p.in[2], p.out, p.in[1] + 1024, (bf16_t*)(ws + OFF_H));
    PH_END
    PH_BEGIN(7)
        pg8::Gemm g{(const bf16_t*)(ws + OFF_H), (const bf16_t*)(ws + OFF_WT2), TOK, 8192, 1024, (const bf16_t*)(ws + OFF_H), 1024, 64};
        Epi2 E{(bf16_t*)(ws + OFF_P), (bf16_t*)(ws + OFF_Q)};
        S.init(TOK, 8192, gridDim.x, blockIdx.x); for (int rep = 0; rep < REP_GEMM; ++rep) { pg8::gemm_phase(lds3, g, S, E); __syncthreads(); }
    PH_END
    PH_BEGIN(8)
        phase_conv3(p);
    PH_END
    PH_BEGIN(9)
        pg8::Gemm g{(const bf16_t*)(ws + OFF_Q), (const bf16_t*)(ws + OFF_WTO1), TOK, 1024, 2048, (const bf16_t*)(ws + OFF_Q), 2048, 64};
        EpiB16 E{(bf16_t*)(ws + OFF_P)};
        S.init(TOK, 1024, gridDim.x, blockIdx.x); for (int rep = 0; rep < REP_GEMM; ++rep) { pg8::gemm_phase(lds3, g, S, E); __syncthreads(); }
    PH_END
    PH_BEGIN(10)
        phase_post<false>(p.out, (const bf16_t*)(ws + OFF_P), p.in[2] + 1024, p.out, nullptr, nullptr);
    PH_END
}

#ifndef N_LAUNCH_MODE
#define N_LAUNCH_MODE 1
#endif

extern "C" void kernel_launch(void* const* d_in, const int* in_sizes, int n_in, void* d_out, int out_size, void* d_ws, size_t ws_size, hipStream_t stream) {
    static int ready = 0;
    if (!ready) {
        if (n_in != 21 || ws_size < WS_END || out_size != TOK * DM) { fprintf(stderr, "kernel_launch: unexpected shapes (n_in %d ws %zu out %d)\n", n_in, ws_size, out_size); ready = -1; return; }
        if (hipFuncSetAttribute((const void*)mega, hipFuncAttributeMaxDynamicSharedMemorySize, LDS_BYTES + 16) != hipSuccess) { fprintf(stderr, "kernel_launch: hipFuncSetAttribute failed\n"); ready = -1; return; }
        ready = 1;
    }
    if (ready < 0) return;
    Prm p{};
    for (int i = 0; i < 21; ++i) p.in[i] = (const float*)d_in[i];
    p.out = (float*)d_out; p.ws = (unsigned char*)d_ws;
#if N_LAUNCH_MODE == 1
    p.ph_lo = 0; p.ph_hi = NPHASE;
    void* args[] = {&p};
    if (hipMemsetAsync((unsigned char*)d_ws + OFF_BAR, 0, 16384, stream) != hipSuccess) { fprintf(stderr, "memset failed\n"); return; }
    hipError_t e = hipLaunchCooperativeKernel((const void*)mega, dim3(256), dim3(512), args, LDS_BYTES + 16, stream);
    if (e != hipSuccess) fprintf(stderr, "cooperative launch failed: %s\n", hipGetErrorString(e));
#else
    for (int ph = 0; ph < NPHASE; ++ph) {
        p.ph_lo = ph; p.ph_hi = ph + 1;
        hipLaunchKernelGGL(mega, dim3(256), dim3(512), LDS_BYTES + 16, stream, p);
    }
#endif
}
```

```cpp
#include <hip/hip_runtime.h>
#include <hip/hip_cooperative_groups.h>
#include <cstdio>
namespace cg = cooperative_groups;

#define LAS __attribute__((address_space(3)))
typedef unsigned short bf16_t;
typedef short bf16x8 __attribute__((ext_vector_type(8)));
typedef float f32x4 __attribute__((ext_vector_type(4)));
typedef float f32x16 __attribute__((ext_vector_type(16)));
typedef unsigned u32x4 __attribute__((ext_vector_type(4)));
typedef unsigned u32x2 __attribute__((ext_vector_type(2)));

constexpr int TOK = 16384, DM = 1024, SEQ = 8192;
constexpr int NP1 = 6400;
constexpr int NIT = 2048;

constexpr size_t OFF_WT1 = 0;
constexpr size_t OFF_WTG = OFF_WT1 + (size_t)NP1 * 1024 * 2;
constexpr size_t OFF_WTO0 = OFF_WTG + (size_t)1024 * 1024 * 2;
constexpr size_t OFF_WT2 = OFF_WTO0 + (size_t)1024 * 2048 * 2;
constexpr size_t OFF_WTO1 = OFF_WT2 + (size_t)8192 * 1024 * 2;
constexpr size_t OFF_H = OFF_WTO1 + (size_t)1024 * 2048 * 2;
constexpr size_t OFF_QKV = OFF_H + (size_t)TOK * 1024 * 2;
constexpr size_t OFF_UU = OFF_QKV + (size_t)TOK * 3072 * 2;
constexpr size_t OFF_WB = OFF_UU + (size_t)TOK * 1024 * 2;
constexpr size_t OFF_ATT = OFF_WB + (size_t)NIT * 8192 * 2;
constexpr size_t OFF_HALO = OFF_ATT + (size_t)NIT * 4096 * 2;
constexpr size_t OFF_BA = OFF_HALO + (size_t)256 * 3 * 3072 * 2;
constexpr size_t OFF_GL = OFF_BA + (size_t)TOK * 16 * 4;
constexpr size_t OFF_BAR = OFF_GL + (size_t)NIT * 4;
constexpr size_t WS_END = OFF_BAR + 16384;
constexpr size_t OFF_YMIX = OFF_QKV;
constexpr size_t OFF_P = OFF_QKV;
constexpr size_t OFF_Q = OFF_QKV + (size_t)TOK * 2048 * 2;
static_assert(OFF_Q + (size_t)TOK * 2048 * 2 <= OFF_WB, "Q overlaps live data");
static_assert(WS_END <= (size_t)256 * 1024 * 1024, "workspace too big");

constexpr int LDS_BYTES = 157696;

struct Prm {
    const float* in[21];
    float* out;
    unsigned char* ws;
    int ph_lo, ph_hi;
};

__device__ __forceinline__ float bf2f(bf16_t b) { return __uint_as_float(((unsigned)b) << 16); }
__device__ __forceinline__ bf16_t f2bf(float f) { unsigned u = __float_as_uint(f); u += 0x7FFFu + ((u >> 16) & 1u); return (bf16_t)(u >> 16); }
typedef __bf16 bf16v2_t __attribute__((ext_vector_type(2)));
typedef float f32x2_t __attribute__((ext_vector_type(2)));
__device__ __forceinline__ unsigned pk2(float lo, float hi) { const f32x2_t v = {lo, hi}; return __builtin_bit_cast(unsigned, __builtin_convertvector(v, bf16v2_t)); }
__device__ __forceinline__ float lo2f(unsigned u) { return __uint_as_float(u << 16); }
__device__ __forceinline__ float hi2f(unsigned u) { return __uint_as_float(u & 0xFFFF0000u); }
__device__ __forceinline__ float sigmoidf_(float x) { return __builtin_amdgcn_rcpf(1.0f + __expf(-x)); }
__device__ __forceinline__ float siluf_(float x) { return x * __builtin_amdgcn_rcpf(1.0f + __expf(-x)); }
__device__ __forceinline__ float wave_sum(float v) {
#pragma unroll
    for (int o = 32; o >= 1; o >>= 1) v += __shfl_xor(v, o);
    return v;
}
__device__ __forceinline__ u32x4 pack8(f32x4 a, f32x4 b) { u32x4 r; r.x = pk2(a[0], a[1]); r.y = pk2(a[2], a[3]); r.z = pk2(b[0], b[1]); r.w = pk2(b[2], b[3]); return r; }

namespace pg8 {
constexpr int BM = 256, BK = 64, HALF = 128, HTB = HALF * BK * 2, STAGE_BYTES = 8 * HTB, NXCD = 8, WGM = 8;
__device__ __forceinline__ int lds_byte(int r, int c) { const int st = (r >> 4) * 2 + (c >> 5), rr = r & 15, cc = c & 31, ob = rr * 64 + cc * 2; return st * 1024 + (ob ^ (((ob >> 9) & 1) << 5)); }
__device__ __forceinline__ void stage_rc(int b, int& R, int& C) { const int st = b / 1024, sb = b % 1024, swz = sb ^ (((sb >> 9) & 1) << 5); R = (st >> 1) * 16 + swz / 64; C = (st & 1) * 32 + (swz % 64) / 2; }
__device__ __forceinline__ int perm32(int rho) { const int n = rho >> 4, i = rho & 15; return 8 * (i >> 2) + 4 * n + (i & 3); }
struct Unit { int pm, pn; };
struct Gemm { const bf16_t* A; const bf16_t* Bt; int M, N, K; const bf16_t* A2; int lda, ks; };
struct StaticOrder {
    int nM, nN, nwg, G, c;
    int lmode, lbase, lcount, lhalf;
    __device__ void init(int M, int N, int G_, int c_) { nM = M / BM; nN = N / BM; nwg = nM * nN; G = G_; c = c_; lmode = 0; lbase = 0; lcount = 0; lhalf = 0; }
    __device__ void init_list(int base, int count, int half) { nM = 64; nN = 4; nwg = 256; G = 1; c = 0; lmode = 1; lbase = base; lcount = count; lhalf = half; }
    __device__ bool next(int i, Unit& u) const {
        if (lmode) { if (i >= lcount) return false; const int j = lbase + i, bb = j >> 6, r = j & 63; u.pm = 32 * bb + 16 * lhalf + (r >> 2); u.pn = r & 3; return true; }
        const long L = (long)i * G + c; if (L >= nwg) return false;
        int wgid = (int)L; { const int q = nwg / NXCD, r = nwg % NXCD, xcd = wgid % NXCD, off = wgid / NXCD; wgid = (xcd < r ? xcd * (q + 1) : r * (q + 1) + (xcd - r) * q) + off; }
        const int nig = WGM * nN, gid = wgid / nig, fm = gid * WGM, gsz = (nM - fm) < WGM ? (nM - fm) : WGM;
        u.pm = fm + ((wgid % nig) % gsz); u.pn = (wgid % nig) / gsz; return true;
    }
};

template <class Epi>
__device__ __forceinline__ void gemm_phase(LAS unsigned char* lds, const Gemm g, const StaticOrder& S, const Epi& E) {
    const int tid = threadIdx.x, wid = __builtin_amdgcn_readfirstlane(tid >> 6), lane = tid & 63, wr = wid >> 2, wc = wid & 3, fr = lane & 15, fq = lane >> 4;
    const int K = g.K, nt = K / BK;
    unsigned voffA[2], voffB[2];
#pragma unroll
    for (int i = 0; i < 2; ++i) { int R, C; stage_rc(tid * 16 + i * 8192, R, C); const int Rb = Epi::PERM ? ((R & ~31) + perm32(R & 31)) : R;
        voffA[i] = (unsigned)(R * g.lda + C) * 2u; voffB[i] = (unsigned)(Rb * K + C) * 2u; }
    const size_t kstep = (size_t)(BK * 2);
    const size_t hstep = (size_t)HALF * K * 2;
    const size_t tstep = 2 * hstep;
    const size_t hstepA = (size_t)HALF * g.lda * 2, tstepA = 2 * hstepA;
    const int ks = g.ks; const ptrdiff_t a2off = (const char*)g.A2 - (const char*)g.A - (ptrdiff_t)ks * (ptrdiff_t)kstep;
    const unsigned ldsw = (unsigned)wid * 1024u;
    const int aoff = lds_byte(wr * 64 + fr, fq * 8), boff = lds_byte(wc * 32 + fr, fq * 8);
#define PG8_SA(b, h) (((b) * 2 + (h)) * HTB)
#define PG8_SB(b, h) ((4 + (b) * 2 + (h)) * HTB)
#define PG8_STAGE(bufoff, gbase, voff) do { _Pragma("unroll") for (int _i = 0; _i < 2; ++_i) \
        __builtin_amdgcn_global_load_lds((const unsigned*)((const char*)(gbase) + (voff)[_i]), (LAS unsigned*)(lds + (bufoff) + ldsw + _i * 8192), 16, 0, 0); } while (0)
#define PG8_LDA(dst, b, h) do { _Pragma("unroll") for (int m = 0; m < 4; ++m) _Pragma("unroll") for (int k = 0; k < 2; ++k) dst[m][k] = *(const LAS bf16x8*)(lds + PG8_SA(b, h) + aoff + m * 2048 + k * 1024); } while (0)
#define PG8_LDB(dst, b, h) do { _Pragma("unroll") for (int n = 0; n < 2; ++n) _Pragma("unroll") for (int k = 0; k < 2; ++k) dst[n][k] = *(const LAS bf16x8*)(lds + PG8_SB(b, h) + boff + n * 2048 + k * 1024); } while (0)
#define PG8_MMA(ai, bj, At, Bt) do { __builtin_amdgcn_s_setprio(1); _Pragma("unroll") for (int m = 0; m < 4; ++m) _Pragma("unroll") for (int n = 0; n < 2; ++n) _Pragma("unroll") for (int k = 0; k < 2; ++k) \
        acc[ai][bj][m][n] = __builtin_amdgcn_mfma_f32_16x16x32_bf16(Bt[n][k], At[m][k], acc[ai][bj][m][n], 0, 0, 0); __builtin_amdgcn_s_setprio(0); } while (0)
#define PG8_WAIT_V(n) asm volatile("s_waitcnt vmcnt(" #n ")" ::: "memory")
#define PG8_WAIT_L(n) asm volatile("s_waitcnt lgkmcnt(" #n ")" ::: "memory")
#define PG8_BAR __builtin_amdgcn_s_barrier()
#define PG8_SCHED __builtin_amdgcn_sched_barrier(0)
    Unit cur, nxt; int ui = 0;
    if (!S.next(0, cur)) return;
    f32x4 acc[2][2][4][2];
#pragma unroll
    for (int a = 0; a < 2; ++a)
#pragma unroll
        for (int b = 0; b < 2; ++b)
#pragma unroll
            for (int m = 0; m < 4; ++m)
#pragma unroll
                for (int n = 0; n < 2; ++n) acc[a][b][m][n] = (f32x4){0.f, 0.f, 0.f, 0.f};
    bf16x8 At[4][2], B0[2][2], B1[2][2];
    const char* cA = (const char*)g.A + (size_t)cur.pm * tstepA; const char* cB = (const char*)g.Bt + (size_t)cur.pn * tstep;
    PG8_STAGE(PG8_SB(0, 0), cB, voffB); PG8_STAGE(PG8_SA(0, 0), cA, voffA); PG8_STAGE(PG8_SB(0, 1), cB + hstep, voffB); PG8_STAGE(PG8_SA(0, 1), cA + hstepA, voffA);
    if (wr == 1) PG8_BAR;
    PG8_WAIT_V(4); PG8_BAR;
    PG8_STAGE(PG8_SB(1, 0), cB + kstep, voffB); PG8_STAGE(PG8_SA(1, 0), cA + kstep, voffA); PG8_STAGE(PG8_SB(1, 1), cB + hstep + kstep, voffB);
    PG8_WAIT_V(6); PG8_BAR;
    for (;;) {
        const bool has_next = S.next(ui + 1, nxt);
        const char* nA = has_next ? (const char*)g.A + (size_t)nxt.pm * tstepA : cA; const char* nB = has_next ? (const char*)g.Bt + (size_t)nxt.pn * tstep : cB;
        for (int t = 0; t < nt; t += 2) {
            const bool last = (t == nt - 2);
            const char* a1 = cA + (size_t)(t + 1) * kstep + ((t + 1) >= ks ? a2off : 0);
            const char* a2 = last ? nA : cA + (size_t)(t + 2) * kstep + ((t + 2) >= ks ? a2off : 0); const char* b2 = last ? nB : cB + (size_t)(t + 2) * kstep;
            const char* a3 = last ? nA + kstep : cA + (size_t)(t + 3) * kstep + ((t + 3) >= ks ? a2off : 0); const char* b3 = b2 + kstep;
            PG8_LDB(B0, 0, 0); PG8_SCHED; PG8_LDA(At, 0, 0); PG8_STAGE(PG8_SA(1, 1), a1 + hstepA, voffA);
            PG8_WAIT_L(8); PG8_BAR; PG8_WAIT_L(0); PG8_MMA(0, 0, At, B0); PG8_BAR; PG8_SCHED;
            PG8_LDB(B1, 0, 1); PG8_STAGE(PG8_SB(0, 0), b2, voffB);
            PG8_BAR; PG8_WAIT_L(0); PG8_MMA(0, 1, At, B1); PG8_BAR;
            PG8_LDA(At, 0, 1); PG8_STAGE(PG8_SA(0, 0), a2, voffA);
            PG8_BAR; PG8_WAIT_L(0); PG8_MMA(1, 0, At, B0); PG8_BAR; PG8_SCHED;
            PG8_STAGE(PG8_SB(0, 1), b2 + hstep, voffB);
            PG8_WAIT_V(6); PG8_BAR; PG8_MMA(1, 1, At, B1); PG8_BAR;
            PG8_LDB(B0, 1, 0); PG8_SCHED; PG8_LDA(At, 1, 0); PG8_STAGE(PG8_SA(0, 1), a2 + hstepA, voffA);
            PG8_WAIT_L(8); PG8_BAR; PG8_WAIT_L(0); PG8_MMA(0, 0, At, B0); PG8_BAR; PG8_SCHED;
            PG8_LDB(B1, 1, 1); PG8_STAGE(PG8_SB(1, 0), b3, voffB);
            PG8_BAR; PG8_WAIT_L(0); PG8_MMA(0, 1, At, B1); PG8_BAR;
            PG8_LDA(At, 1, 1); PG8_STAGE(PG8_SA(1, 0), a3, voffA);
            PG8_BAR; PG8_WAIT_L(0); PG8_MMA(1, 0, At, B0); PG8_BAR; PG8_SCHED;
            PG8_STAGE(PG8_SB(1, 1), b3 + hstep, voffB);
            PG8_WAIT_V(6); PG8_BAR; PG8_MMA(1, 1, At, B1); PG8_BAR;
        }
        E(acc, cur, wr, wc, fr, fq);
        if (!has_next) break;
#pragma unroll
        for (int a = 0; a < 2; ++a)
#pragma unroll
            for (int b = 0; b < 2; ++b)
#pragma unroll
                for (int m = 0; m < 4; ++m)
#pragma unroll
                    for (int n = 0; n < 2; ++n) acc[a][b][m][n] = (f32x4){0.f, 0.f, 0.f, 0.f};
        cur = nxt; cA = nA; cB = nB; ++ui;
    }
    PG8_WAIT_V(0);
    if (wr == 0) PG8_BAR;
    PG8_BAR;
#undef PG8_SA
#undef PG8_SB
#undef PG8_STAGE
#undef PG8_LDA
#undef PG8_LDB
#undef PG8_MMA
#undef PG8_WAIT_V
#undef PG8_WAIT_L
#undef PG8_BAR
#undef PG8_SCHED
}
}
using pg8::Unit;

struct Epi1 {
    static constexpr bool PERM = true;
    bf16_t* QKV; bf16_t* SZA; bf16_t* UU; bf16_t* SZB; float* BA; bf16_t* HALO;
    __device__ __forceinline__ void operator()(const f32x4 (&acc)[2][2][4][2], const Unit& u, int wr, int wc, int fr_, int fq_) const {
        int lane = (int)(threadIdx.x & 63); asm volatile("" : "+v"(lane));
        const int fr = lane & 15, fq = lane >> 4; (void)fr_; (void)fq_;
        const int row0 = u.pm * 256 + wr * 64 + fr, pn = u.pn;
#pragma unroll
        for (int ai = 0; ai < 2; ++ai)
#pragma unroll
            for (int m = 0; m < 4; ++m) {
                const size_t row = (size_t)(row0 + ai * 128 + m * 16);
#pragma unroll
                for (int bj = 0; bj < 2; ++bj) {
                    const int colt = 128 * bj + 32 * wc + 8 * fq;
                    f32x4 v0 = acc[ai][bj][m][0], v1 = acc[ai][bj][m][1];
                    if (pn < 12) {
                        const int c = pn * 256 + colt; const u32x4 pk = pack8(v0, v1);
                        *(u32x4*)(QKV + row * 3072 + c) = pk;
                        if (m == 3 && fr >= 13) *(u32x4*)(HALO + ((row >> 6) * 3 + (fr - 13)) * 3072 + c) = pk;
                    } else if (pn < 16) {
#pragma unroll
                        for (int e = 0; e < 4; ++e) { v0[e] = siluf_(v0[e]); v1[e] = siluf_(v1[e]); }
                        *(u32x4*)(SZA + row * 1024 + (pn - 12) * 256 + colt) = pack8(v0, v1);
                    } else if (pn < 20) {
                        *(u32x4*)(UU + row * 1024 + (pn - 16) * 256 + colt) = pack8(v0, v1);
                    } else if (pn < 24) {
#pragma unroll
                        for (int e = 0; e < 4; ++e) { v0[e] = siluf_(v0[e]); v1[e] = siluf_(v1[e]); }
                        *(u32x4*)(SZB + row * 1024 + (pn - 20) * 256 + colt) = pack8(v0, v1);
                    } else if (colt < 16) {
                        *(f32x4*)(BA + row * 16 + colt) = v0; *(f32x4*)(BA + row * 16 + colt + 4) = v1;
                    }
                }
            }
    }
};
struct EpiGlu {
    static constexpr bool PERM = true;
    const bf16_t* Y5; bf16_t* SZB;
    __device__ __forceinline__ void operator()(const f32x4 (&acc)[2][2][4][2], const Unit& u, int wr, int wc, int fr, int fq) const {
        const int row0 = u.pm * 256 + wr * 64 + fr;
#pragma unroll
        for (int ai = 0; ai < 2; ++ai)
#pragma unroll
            for (int m = 0; m < 4; ++m) {
                const size_t row = (size_t)(row0 + ai * 128 + m * 16);
#pragma unroll
                for (int bj = 0; bj < 2; ++bj) {
                    const int c = u.pn * 256 + 128 * bj + 32 * wc + 8 * fq;
                    const u32x4 y = *(const u32x4*)(Y5 + row * 1024 + c), z = *(const u32x4*)(SZB + row * 1024 + c);
                    const f32x4 a0 = acc[ai][bj][m][0], a1 = acc[ai][bj][m][1];
                    u32x4 o;
                    o.x = pk2(lo2f(y.x) * sigmoidf_(a0[0]) * lo2f(z.x), hi2f(y.x) * sigmoidf_(a0[1]) * hi2f(z.x));
                    o.y = pk2(lo2f(y.y) * sigmoidf_(a0[2]) * lo2f(z.y), hi2f(y.y) * sigmoidf_(a0[3]) * hi2f(z.y));
                    o.z = pk2(lo2f(y.z) * sigmoidf_(a1[0]) * lo2f(z.z), hi2f(y.z) * sigmoidf_(a1[1]) * hi2f(z.z));
                    o.w = pk2(lo2f(y.w) * sigmoidf_(a1[2]) * lo2f(z.w), hi2f(y.w) * sigmoidf_(a1[3]) * hi2f(z.w));
                    *(u32x4*)(SZB + row * 1024 + c) = o;
                }
            }
    }
};
struct EpiF32 {
    static constexpr bool PERM = false;
    float* C;
    __device__ __forceinline__ void operator()(const f32x4 (&acc)[2][2][4][2], const Unit& u, int wr, int wc, int fr, int fq) const {
        const int row0 = u.pm * 256 + wr * 64 + fr, col0 = u.pn * 256 + wc * 32 + 4 * fq;
#pragma unroll
        for (int ai = 0; ai < 2; ++ai)
#pragma unroll
            for (int m = 0; m < 4; ++m) { float* rowp = C + (size_t)(row0 + ai * 128 + m * 16) * 1024 + col0;
#pragma unroll
                for (int bj = 0; bj < 2; ++bj)
#pragma unroll
                    for (int n = 0; n < 2; ++n) *(f32x4*)(rowp + bj * 128 + n * 16) = acc[ai][bj][m][n]; }
    }
};
struct EpiB16 {
    static constexpr bool PERM = true;
    bf16_t* C;
    __device__ __forceinline__ void operator()(const f32x4 (&acc)[2][2][4][2], const Unit& u, int wr, int wc, int fr, int fq) const {
        const int row0 = u.pm * 256 + wr * 64 + fr, col0 = u.pn * 256 + wc * 32 + 8 * fq;
#pragma unroll
        for (int ai = 0; ai < 2; ++ai)
#pragma unroll
            for (int m = 0; m < 4; ++m) { bf16_t* rowp = C + (size_t)(row0 + ai * 128 + m * 16) * 1024 + col0;
#pragma unroll
                for (int bj = 0; bj < 2; ++bj) *(u32x4*)(rowp + bj * 128) = pack8(acc[ai][bj][m][0], acc[ai][bj][m][1]); }
    }
};
struct Epi2 {
    static constexpr bool PERM = false;
    bf16_t* P; bf16_t* Q;
    __device__ __forceinline__ void operator()(const f32x4 (&acc)[2][2][4][2], const Unit& u, int wr, int wc, int fr, int fq) const {
        const int row0 = u.pm * 256 + wr * 64 + fr, ch = u.pn * 64 + 16 * wc + 4 * fq;
#pragma unroll
        for (int ai = 0; ai < 2; ++ai)
#pragma unroll
            for (int m = 0; m < 4; ++m) {
                const size_t row = (size_t)(row0 + ai * 128 + m * 16);
                const f32x4 gb = acc[ai][0][m][0], gc = acc[ai][0][m][1], hv = acc[ai][1][m][0], z = acc[ai][1][m][1];
                u32x2 pp, qq;
                pp.x = pk2(gc[0] * hv[0], gc[1] * hv[1]); pp.y = pk2(gc[2] * hv[2], gc[3] * hv[3]);
                qq.x = pk2(gb[0] * siluf_(z[0]), gb[1] * siluf_(z[1])); qq.y = pk2(gb[2] * siluf_(z[2]), gb[3] * siluf_(z[3]));
                *(u32x2*)(P + row * 2048 + ch) = pp; *(u32x2*)(Q + row * 2048 + ch) = qq;
            }
    }
};

__device__ __forceinline__ int src_col(int mode, int n, int& pn_unused) {
    (void)pn_unused;
    if (mode == 0) return n;
    if (mode == 1) { if (n < 4096) return n; if (n < 6144) return n + 16; if (n < 6160) return n - 2048; return -1; }
    const int pn = n >> 8, col = n & 255, bj = col >> 7, wc = (col >> 5) & 3, nn = (col >> 4) & 1, lo = col & 15;
    return (2 * bj + nn) * 2048 + pn * 64 + 16 * wc + lo;
}
struct CvtTile { const float* W; bf16_t* Wt; int K, Nsrc, mode, n0, k0; };
__device__ __forceinline__ CvtTile cvt_decode(const Prm& p, int tix) {
    CvtTile t; int tl = tix;
    if (tl < 1600) { t.W = p.in[3]; t.Wt = (bf16_t*)(p.ws + OFF_WT1); t.K = 1024; t.Nsrc = 6160; t.mode = 1; }
    else if ((tl -= 1600) < 256) { t.W = p.in[16]; t.Wt = (bf16_t*)(p.ws + OFF_WTG); t.K = 1024; t.Nsrc = 1024; t.mode = 0; }
    else if ((tl -= 256) < 512) { t.W = p.in[17]; t.Wt = (bf16_t*)(p.ws + OFF_WTO0); t.K = 2048; t.Nsrc = 1024; t.mode = 0; }
    else if ((tl -= 512) < 2048) { t.W = p.in[18]; t.Wt = (bf16_t*)(p.ws + OFF_WT2); t.K = 1024; t.Nsrc = 8192; t.mode = 2; }
    else { tl -= 2048; t.W = p.in[20]; t.Wt = (bf16_t*)(p.ws + OFF_WTO1); t.K = 2048; t.Nsrc = 1024; t.mode = 0; }
    const int ntk = t.K / 64; t.n0 = (tl / ntk) * 64; t.k0 = (tl % ntk) * 64; return t;
}
__device__ __forceinline__ void phase_convert(const Prm& p, unsigned char* lds, int t_begin, int t_end, int nblk, int bidx) {
    float* tiles = (float*)lds;
    const int tid = threadIdx.x, j = tid & 63, kr = tid >> 6, r = tid >> 3, c8 = (tid & 7) * 8;
    for (int base = t_begin + bidx * 4; base < t_end; base += nblk * 4) {
        float v[4][8];
#pragma unroll
        for (int q = 0; q < 4; ++q) {
            const int tix = base + q < t_end ? base + q : t_end - 1;
            const CvtTile t = cvt_decode(p, tix);
            int dummy = 0; const int sc = src_col(t.mode, t.n0 + j, dummy);
#pragma unroll
            for (int i = 0; i < 8; ++i) v[q][i] = sc >= 0 ? t.W[(size_t)(t.k0 + kr + 8 * i) * t.Nsrc + sc] : 0.0f;
        }
#pragma unroll
        for (int q = 0; q < 4; ++q)
#pragma unroll
            for (int i = 0; i < 8; ++i) tiles[q * 4160 + (kr + 8 * i) * 65 + j] = v[q][i];
        __syncthreads();
#pragma unroll
        for (int q = 0; q < 4; ++q) {
            const int tix = base + q < t_end ? base + q : t_end - 1;
            const CvtTile t = cvt_decode(p, tix);
            const float* tl = tiles + q * 4160; u32x4 o;
            o.x = pk2(tl[(c8 + 0) * 65 + r], tl[(c8 + 1) * 65 + r]); o.y = pk2(tl[(c8 + 2) * 65 + r], tl[(c8 + 3) * 65 + r]);
            o.z = pk2(tl[(c8 + 4) * 65 + r], tl[(c8 + 5) * 65 + r]); o.w = pk2(tl[(c8 + 6) * 65 + r], tl[(c8 + 7) * 65 + r]);
            *(u32x4*)(t.Wt + (size_t)(t.n0 + r) * t.K + t.k0 + c8) = o;
        }
        __syncthreads();
    }
}
__device__ __forceinline__ void phase_rmsnorm_x(const float* x, const float* w, bf16_t* H) {
    const int lane = threadIdx.x & 63, nw = gridDim.x * 8;
    for (int row = blockIdx.x * 8 + (threadIdx.x >> 6); row < TOK; row += nw) {
        const f32x4* xr = (const f32x4*)(x + (size_t)row * 1024);
        f32x4 v[4]; float ss = 0.f;
#pragma unroll
        for (int i = 0; i < 4; ++i) { v[i] = xr[lane + 64 * i]; ss += v[i][0] * v[i][0] + v[i][1] * v[i][1] + v[i][2] * v[i][2] + v[i][3] * v[i][3]; }
        ss = wave_sum(ss);
        const float rstd = rsqrtf(ss * (1.0f / 1024.0f) + 1e-6f);
#pragma unroll
        for (int i = 0; i < 4; ++i) { const f32x4 w4 = ((const f32x4*)w)[lane + 64 * i]; u32x2 o;
            o.x = pk2(v[i][0] * rstd * w4[0], v[i][1] * rstd * w4[1]); o.y = pk2(v[i][2] * rstd * w4[2], v[i][3] * rstd * w4[3]);
            *(u32x2*)(H + (size_t)row * 1024 + (lane + 64 * i) * 4) = o; }
    }
}
template <bool NEXT>
__device__ __forceinline__ void phase_post(const float* base, const bf16_t* Y, const float* wpost, float* OUT, const float* wpre, bf16_t* H) {
    const int lane = threadIdx.x & 63, nw = gridDim.x * 8;
    for (int row = blockIdx.x * 8 + (threadIdx.x >> 6); row < TOK; row += nw) {
        const u32x2* yr = (const u32x2*)(Y + (size_t)row * 1024); const f32x4* br = (const f32x4*)(base + (size_t)row * 1024);
        f32x4 v[4], xb[4]; float ss = 0.f;
#pragma unroll
        for (int i = 0; i < 4; ++i) { const u32x2 y2 = yr[lane + 64 * i]; v[i] = (f32x4){lo2f(y2.x), hi2f(y2.x), lo2f(y2.y), hi2f(y2.y)}; xb[i] = br[lane + 64 * i]; ss += v[i][0] * v[i][0] + v[i][1] * v[i][1] + v[i][2] * v[i][2] + v[i][3] * v[i][3]; }
        ss = wave_sum(ss);
        const float rstd = rsqrtf(ss * (1.0f / 1024.0f) + 1e-6f);
        float s2 = 0.f;
#pragma unroll
        for (int i = 0; i < 4; ++i) { const f32x4 w4 = ((const f32x4*)wpost)[lane + 64 * i];
#pragma unroll
            for (int e = 0; e < 4; ++e) { v[i][e] = xb[i][e] + v[i][e] * rstd * w4[e]; s2 += v[i][e] * v[i][e]; }
            ((f32x4*)(OUT + (size_t)row * 1024))[lane + 64 * i] = v[i]; }
        if (NEXT) {
            s2 = wave_sum(s2);
            const float r2 = rsqrtf(s2 * (1.0f / 1024.0f) + 1e-6f);
#pragma unroll
            for (int i = 0; i < 4; ++i) { const f32x4 w4 = ((const f32x4*)wpre)[lane + 64 * i]; u32x2 o;
                o.x = pk2(v[i][0] * r2 * w4[0], v[i][1] * r2 * w4[1]); o.y = pk2(v[i][2] * r2 * w4[2], v[i][3] * r2 * w4[3]);
                *(u32x2*)(H + (size_t)row * 1024 + (lane + 64 * i) * 4) = o; }
        }
    }
}


__device__ __forceinline__ void phase_ba(const Prm& p, unsigned char* lds) {
    const int tid = threadIdx.x, wv = tid >> 6, lane = tid & 63, n = lane & 15, kq = lane >> 4, mt = wv & 3, kh = wv >> 2;
    const bf16_t* H = (const bf16_t*)(p.ws + OFF_H); const bf16_t* Wb = (const bf16_t*)(p.ws + OFF_WT1) + (size_t)6144 * 1024; float* BA = (float*)(p.ws + OFF_BA);
    const size_t row0 = (size_t)blockIdx.x * 64 + 16 * mt;
    const bf16_t* ap = H + (row0 + n) * 1024 + 512 * kh + 8 * kq; const bf16_t* bp = Wb + (size_t)n * 1024 + 512 * kh + 8 * kq;
    bf16x8 a[16], b[16];
#pragma unroll
    for (int i = 0; i < 16; ++i) { a[i] = *(const bf16x8*)(ap + i * 32); b[i] = *(const bf16x8*)(bp + i * 32); }
    f32x4 acc = (f32x4){0.f, 0.f, 0.f, 0.f};
#pragma unroll
    for (int i = 0; i < 16; ++i) acc = __builtin_amdgcn_mfma_f32_16x16x32_bf16(a[i], b[i], acc, 0, 0, 0);
    float* part = (float*)lds;
#pragma unroll
    for (int j = 0; j < 4; ++j) part[(kh * 64 + 16 * mt + 4 * kq + j) * 16 + n] = acc[j];
    __syncthreads();
    for (int i = tid; i < 1024; i += 512) BA[(size_t)blockIdx.x * 1024 + i] = part[i] + part[1024 + i];
    __syncthreads();
}
__device__ __forceinline__ void sincos_d(double x, double& s, double& c) {
    const double k = rint(x * 0.6366197723675814);
    const double r = fma(-k, 6.123233995736766e-17, fma(-k, 1.5707963267948966, x)), r2 = r * r;
    double sp = -7.647163731819816e-13; sp = fma(sp, r2, 1.6059043836821613e-10); sp = fma(sp, r2, -2.505210838544172e-8); sp = fma(sp, r2, 2.7557319223985893e-6);
    sp = fma(sp, r2, -1.984126984126984e-4); sp = fma(sp, r2, 8.333333333333333e-3); sp = fma(sp, r2, -1.6666666666666666e-1); sp = fma(sp * r2, r, r);
    double cp = 4.779477332387385e-14; cp = fma(cp, r2, -1.1470745597729725e-11); cp = fma(cp, r2, 2.08767569878681e-9); cp = fma(cp, r2, -2.755731922398589e-7);
    cp = fma(cp, r2, 2.48015873015873e-5); cp = fma(cp, r2, -1.388888888888889e-3); cp = fma(cp, r2, 4.1666666666666664e-2); cp = fma(cp, r2, -0.5); cp = fma(cp, r2, 1.0);
    const int q = ((int)k) & 3;
    const double s0 = (q & 1) ? cp : sp, c0 = (q & 1) ? sp : cp;
    s = (q & 2) ? -s0 : s0; c = ((q + 1) & 2) ? -c0 : c0;
}
__device__ __forceinline__ double exp_d(double x) {
    const double n = rint(x * 1.4426950408889634);
    const double r = fma(-n, 2.3190468138462996e-17, fma(-n, 0.6931471805599453, x));
    double p = 1.6059043836821613e-10; p = fma(p, r, 2.08767569878681e-9); p = fma(p, r, 2.505210838544172e-8); p = fma(p, r, 2.755731922398589e-7); p = fma(p, r, 2.7557319223985893e-6);
    p = fma(p, r, 2.48015873015873e-5); p = fma(p, r, 1.984126984126984e-4); p = fma(p, r, 1.388888888888889e-3); p = fma(p, r, 8.333333333333333e-3); p = fma(p, r, 4.1666666666666664e-2);
    p = fma(p, r, 1.6666666666666666e-1); p = fma(p, r, 0.5); p = fma(p, r, 1.0); p = fma(p, r, 1.0);
    return ldexp(p, (int)n);
}
__device__ __forceinline__ float bcast_lo(float v) { auto r = __builtin_amdgcn_permlane32_swap(__float_as_uint(v), __float_as_uint(v), false, false); return __uint_as_float(r[0]); }
__device__ __forceinline__ float bcast_hi(float v) { auto r = __builtin_amdgcn_permlane32_swap(__float_as_uint(v), __float_as_uint(v), false, false); return __uint_as_float(r[1]); }

struct S5C {
    float ar[2][4], ai[2][4];
    float a512r[2], a512i[2];
    bf16x8 BB[4];
    bf16x8 CC[4];
    float dco;
};

template <bool OUT>
__device__ __forceinline__ void s5_chunk(const S5C& C, bf16_t* UU, int b, int g, int chunk, float (&st)[2][2], bf16_t* sX, int lane) {
    const int n = lane & 31, hh = lane >> 5, fr = lane & 15, fq = lane >> 4;
    const size_t tok0 = (size_t)b * SEQ + (size_t)chunk * 512;
    bf16x8 ua = *(const bf16x8*)(UU + (tok0 + n) * 1024 + 16 * g + 8 * hh);
    bf16_t uo[8];
    if (OUT) {
#pragma unroll
        for (int mt = 0; mt < 2; ++mt)
#pragma unroll
            for (int j = 0; j < 4; ++j) uo[mt * 4 + j] = UU[(tok0 + 16 * mt + 4 * fq + j) * 1024 + 16 * g + fr];
    }
    for (int blk = 0; blk < 16; ++blk) {
        const size_t t0 = tok0 + (size_t)blk * 32;
        const bf16x8 ucur = ua;
        bf16_t ucuro[8];
        if (OUT) {
#pragma unroll
            for (int i = 0; i < 8; ++i) ucuro[i] = uo[i];
        }
        if (blk < 15) {
            ua = *(const bf16x8*)(UU + (t0 + 32 + n) * 1024 + 16 * g + 8 * hh);
            if (OUT) {
#pragma unroll
                for (int mt = 0; mt < 2; ++mt)
#pragma unroll
                    for (int j = 0; j < 4; ++j) uo[mt * 4 + j] = UU[(t0 + 32 + 16 * mt + 4 * fq + j) * 1024 + 16 * g + fr];
            }
        }
        f32x16 acc[4];
#pragma unroll
        for (int tl = 0; tl < 4; ++tl) {
            f32x16 z;
#pragma unroll
            for (int i = 0; i < 16; ++i) z[i] = 0.f;
            acc[tl] = __builtin_amdgcn_mfma_f32_32x32x16_bf16(ucur, C.BB[tl], z, 0, 0, 0);
        }
#pragma unroll
        for (int tp = 0; tp < 2; ++tp) {
            f32x16& re = acc[2 * tp]; f32x16& im = acc[2 * tp + 1];
            const float a1r = C.ar[tp][0], a1i = C.ai[tp][0];
#pragma unroll
            for (int q = 0; q < 4; ++q)
#pragma unroll
                for (int r = 1; r < 4; ++r) {
                    const float pr = re[4 * q + r - 1], pi = im[4 * q + r - 1];
                    re[4 * q + r] += a1r * pr - a1i * pi; im[4 * q + r] += a1r * pi + a1i * pr;
                }
            float cr = st[tp][0], ci = st[tp][1];
            const float a4r = C.ar[tp][3], a4i = C.ai[tp][3];
#pragma unroll
            for (int q = 0; q < 4; ++q) {
                const float tr = re[4 * q + 3] + a4r * cr - a4i * ci, ti = im[4 * q + 3] + a4r * ci + a4i * cr;
                const float o0r = bcast_lo(tr), o0i = bcast_lo(ti);
                const float xr = hh ? o0r : cr, xi = hh ? o0i : ci;
                if (OUT) {
#pragma unroll
                    for (int r = 0; r < 4; ++r) { const float kr = C.ar[tp][r], ki = C.ai[tp][r];
                        re[4 * q + r] += kr * xr - ki * xi; im[4 * q + r] += kr * xi + ki * xr; }
                } else {
                    re[4 * q + 3] += a4r * xr - a4i * xi; im[4 * q + 3] += a4r * xi + a4i * xr;
                }
                cr = bcast_hi(re[4 * q + 3]); ci = bcast_hi(im[4 * q + 3]);
            }
            st[tp][0] = cr; st[tp][1] = ci;
        }
        if (OUT) {
            asm volatile("s_waitcnt lgkmcnt(0)" ::: "memory");
#pragma unroll
            for (int tp = 0; tp < 2; ++tp)
#pragma unroll
                for (int i = 0; i < 16; ++i) {
                    const int t = 8 * (i >> 2) + 4 * hh + (i & 3);
                    *(unsigned*)(sX + t * 136 + 2 * (n + 32 * tp)) = pk2(acc[2 * tp][i], acc[2 * tp + 1][i]);
                }
            asm volatile("s_waitcnt lgkmcnt(0)" ::: "memory");
            __builtin_amdgcn_wave_barrier();
#pragma unroll
            for (int mt = 0; mt < 2; ++mt) {
                f32x4 y = (f32x4){0.f, 0.f, 0.f, 0.f};
#pragma unroll
                for (int ks = 0; ks < 4; ++ks) {
                    const bf16x8 xa = *(const bf16x8*)(sX + (16 * mt + fr) * 136 + 32 * ks + 8 * fq);
                    y = __builtin_amdgcn_mfma_f32_16x16x32_bf16(xa, C.CC[ks], y, 0, 0, 0);
                }
#pragma unroll
                for (int j = 0; j < 4; ++j) {
                    float v = y[j] + C.dco * bf2f(ucuro[mt * 4 + j]);
                    const float inner = 0.7978845608028654f * (v + 0.044715f * v * v * v);
                    v = v * __builtin_amdgcn_rcpf(1.0f + __expf(-2.0f * inner));
                    UU[(t0 + 16 * mt + 4 * fq + j) * 1024 + 16 * g + fr] = f2bf(v);
                }
            }
            asm volatile("s_waitcnt lgkmcnt(0)" ::: "memory");
            __builtin_amdgcn_wave_barrier();
        }
    }
}

__device__ __forceinline__ void phase_s5(const Prm& p, unsigned char* lds, int bg) {
    const int b = bg >> 6, g = bg & 63;
    const int tid = threadIdx.x, wv = tid >> 6, lane = tid & 63, n = lane & 31, hh = lane >> 5, fr = lane & 15, fq = lane >> 4;
    bf16_t* sX = (bf16_t*)(lds + wv * 8704);
    float* sXE = (float*)(lds + 8 * 8704);
    bf16_t* UU = (bf16_t*)(p.ws + OFF_UU);
    const float* lam_re = p.in[8]; const float* lam_im = p.in[9]; const float* b_re = p.in[10]; const float* b_im = p.in[11];
    const float* c_re = p.in[12]; const float* c_im = p.in[13];
    S5C C;
    const double dt = exp_d((double)p.in[14][g]);
    float fre[2], fim[2];
#pragma unroll
    for (int tp = 0; tp < 2; ++tp) {
        const int pp = n + 32 * tp;
        const double lr = (double)fminf(lam_re[g * 64 + pp], -1e-4f), li = (double)lam_im[g * 64 + pp];
#pragma unroll
        for (int k = 0; k < 4; ++k) { double sn, cs; sincos_d(li * dt * (k + 1), sn, cs); const double mag = exp_d(lr * dt * (k + 1)); C.ar[tp][k] = (float)(mag * cs); C.ai[tp][k] = (float)(mag * sn); }
        { double sn, cs; sincos_d(li * dt * 512.0, sn, cs); const double mag = exp_d(lr * dt * 512.0); C.a512r[tp] = (float)(mag * cs); C.a512i[tp] = (float)(mag * sn); }
        double sn, cs; sincos_d(li * dt, sn, cs);
        const double mag = exp_d(lr * dt), abr = mag * cs, abi = mag * sn;
        const double den = lr * lr + li * li, nr = abr - 1.0, ni = abi;
        fre[tp] = (float)((nr * lr + ni * li) / den); fim[tp] = (float)((ni * lr - nr * li) / den);
    }
#pragma unroll
    for (int tl = 0; tl < 4; ++tl) {
        const int tp = tl >> 1, ri = tl & 1, pp = n + 32 * tp;
#pragma unroll
        for (int j = 0; j < 8; ++j) {
            const int ch = 8 * hh + j;
            const float br = b_re[(g * 64 + pp) * 16 + ch], bi = b_im[(g * 64 + pp) * 16 + ch];
            const float v = ri == 0 ? fre[tp] * br - fim[tp] * bi : fre[tp] * bi + fim[tp] * br;
            C.BB[tl][j] = (short)f2bf(v);
        }
    }
#pragma unroll
    for (int ks = 0; ks < 4; ++ks)
#pragma unroll
        for (int j = 0; j < 8; ++j) {
            const int k = 32 * ks + 8 * fq + j, pp = k >> 1, ri = k & 1;
            const float v = ri == 0 ? c_re[(g * 16 + fr) * 64 + pp] : -c_im[(g * 16 + fr) * 64 + pp];
            C.CC[ks][j] = (short)f2bf(v);
        }
    C.dco = p.in[15][16 * g + fr];
    for (int rd = 0; rd < 2; ++rd) {
        const int chunk = wv + 8 * rd;
        float st[2][2] = {{0.f, 0.f}, {0.f, 0.f}};
        s5_chunk<false>(C, UU, b, g, chunk, st, sX, lane);
        if (hh == 0) {
#pragma unroll
            for (int tp = 0; tp < 2; ++tp) { sXE[(chunk * 64 + n + 32 * tp) * 2 + 0] = st[tp][0]; sXE[(chunk * 64 + n + 32 * tp) * 2 + 1] = st[tp][1]; }
        }
    }
    __syncthreads();
    for (int rd = 0; rd < 2; ++rd) {
        const int chunk = wv + 8 * rd;
        float st[2][2] = {{0.f, 0.f}, {0.f, 0.f}};
        for (int c2 = 0; c2 < chunk; ++c2) {
#pragma unroll
            for (int tp = 0; tp < 2; ++tp) {
                const float er = sXE[(c2 * 64 + n + 32 * tp) * 2 + 0], ei = sXE[(c2 * 64 + n + 32 * tp) * 2 + 1];
                const float nr = C.a512r[tp] * st[tp][0] - C.a512i[tp] * st[tp][1] + er, ni = C.a512r[tp] * st[tp][1] + C.a512i[tp] * st[tp][0] + ei;
                st[tp][0] = nr; st[tp][1] = ni;
            }
        }
        s5_chunk<true>(C, UU, b, g, chunk, st, sX, lane);
        if (rd == 0) {
            asm volatile("s_waitcnt vmcnt(0)" ::: "memory");
            __syncthreads();
            if (threadIdx.x == 0) { __builtin_amdgcn_fence(__ATOMIC_RELEASE, "agent"); asm volatile("s_waitcnt vmcnt(0)" ::: "memory");
                __hip_atomic_fetch_add((unsigned*)(p.ws + OFF_BAR) + 3900, 1u, __ATOMIC_RELAXED, __HIP_MEMORY_SCOPE_AGENT); }
        }
    }
    __syncthreads();
}

__device__ __forceinline__ void phase_gdn_prep(const Prm& p, unsigned char* lds, int it0, int nrounds) {
    const int tid0 = threadIdx.x, hb = tid0 >> 8;
    unsigned char* base = lds + hb * 76800;
    bf16_t* sQ = (bf16_t*)base;
    bf16_t* sK = (bf16_t*)(base + 17408);
    bf16_t* sV = (bf16_t*)(base + 2 * 17408);
    float* sL = (float*)(base + 3 * 17408);
    float* sBeta = (float*)(base + 4 * 17408);
    float* sGc = sBeta + 64; float* sEg = sGc + 64; float* sBE = sEg + 64;
    float* sCW = sBE + 64;
    bf16_t* QKV = (bf16_t*)(p.ws + OFF_QKV); const bf16_t* HALO = (const bf16_t*)(p.ws + OFF_HALO);
    const float* BA = (const float*)(p.ws + OFF_BA); float* GL = (float*)(p.ws + OFF_GL);
    bf16_t* WB = (bf16_t*)(p.ws + OFF_WB); bf16_t* ATT = (bf16_t*)(p.ws + OFF_ATT);
    const float* convw = p.in[4];
    for (int rd = 0; rd < nrounds; ++rd) {
        int tid = tid0; asm volatile("" : "+v"(tid));
        const int ht = tid & 255, hw = (tid >> 6) & 3, lane = tid & 63, fr = lane & 15, fq = lane >> 4;
        const int it = it0 + rd * 2 + hb;
        const int b = it >> 10, h = (it >> 7) & 7, nc = it & 127;
        const size_t tokb = (size_t)b * SEQ + (size_t)nc * 64;
#pragma unroll
        for (int i = 0; i < 6; ++i) { const int idx = ht + 256 * i, s3 = idx >> 9, tap = (idx >> 7) & 3, ch = idx & 127; sCW[idx] = convw[tap * 3072 + s3 * 1024 + h * 128 + ch]; }
        __syncthreads();
        {
            const int t0 = (ht >> 4) * 4, cgp = ht & 15;
            u32x4 xall[3][7];
#pragma unroll
            for (int s = 0; s < 3; ++s) {
                const int col = s * 1024 + h * 128 + cgp * 8;
#pragma unroll
                for (int i = 0; i < 7; ++i) {
                    const int tt = t0 - 3 + i;
                    xall[s][i] = (u32x4){0u, 0u, 0u, 0u};
                    if (tt >= 0) xall[s][i] = *(const u32x4*)(QKV + (tokb + tt) * 3072 + col);
                    else if (nc > 0) xall[s][i] = *(const u32x4*)(HALO + ((size_t)(b * 128 + nc - 1) * 3 + (3 + tt)) * 3072 + col);
                }
            }
#pragma unroll
            for (int s = 0; s < 3; ++s) {
                u32x4 xr[7];
#pragma unroll
                for (int i = 0; i < 7; ++i) xr[i] = xall[s][i];
                f32x4 w0[4], w1[4];
#pragma unroll
                for (int j = 0; j < 4; ++j) { w0[j] = *(const f32x4*)(sCW + s * 512 + j * 128 + cgp * 8); w1[j] = *(const f32x4*)(sCW + s * 512 + j * 128 + cgp * 8 + 4); }
                float o[4][8], ss[4];
#pragma unroll
                for (int tk = 0; tk < 4; ++tk) {
                    float a[8];
#pragma unroll
                    for (int e = 0; e < 8; ++e) a[e] = 0.f;
#pragma unroll
                    for (int j = 0; j < 4; ++j) {
                        const u32x4 xv = xr[tk + j];
                        a[0] += w0[j][0] * lo2f(xv.x); a[1] += w0[j][1] * hi2f(xv.x); a[2] += w0[j][2] * lo2f(xv.y); a[3] += w0[j][3] * hi2f(xv.y);
                        a[4] += w1[j][0] * lo2f(xv.z); a[5] += w1[j][1] * hi2f(xv.z); a[6] += w1[j][2] * lo2f(xv.w); a[7] += w1[j][3] * hi2f(xv.w);
                    }
                    float acc2 = 0.f;
#pragma unroll
                    for (int e = 0; e < 8; ++e) { const float v = siluf_(a[e]); o[tk][e] = v; acc2 += v * v; }
                    ss[tk] = acc2;
                }
                bf16_t* dst = (s == 0 ? sQ : (s == 1 ? sK : sV)) + t0 * 136 + cgp * 8;
#pragma unroll
                for (int tk = 0; tk < 4; ++tk) {
                    float sc = 1.0f;
                    if (s < 2) { float q = ss[tk]; q += __shfl_xor(q, 1); q += __shfl_xor(q, 2); q += __shfl_xor(q, 4); q += __shfl_xor(q, 8); sc = rsqrtf(q + 1e-6f) * (s == 0 ? 0.08838834764831845f : 1.0f); }
                    u32x4 pk;
                    pk.x = pk2(o[tk][0] * sc, o[tk][1] * sc); pk.y = pk2(o[tk][2] * sc, o[tk][3] * sc); pk.z = pk2(o[tk][4] * sc, o[tk][5] * sc); pk.w = pk2(o[tk][6] * sc, o[tk][7] * sc);
                    *(u32x4*)(dst + tk * 136) = pk;
                }
            }
        }
        if (hw == 0) {
            const size_t tg = tokb + lane;
            const float braw = BA[tg * 16 + h], araw = BA[tg * 16 + 8 + h];
            const float beta = 1.0f / (1.0f + expf(-braw));
            const float xx = araw + p.in[6][h];
            const float sp = xx > 20.f ? xx : log1pf(expf(xx));
            float gg = -expf(p.in[5][h]) * sp;
#pragma unroll
            for (int off = 1; off < 64; off <<= 1) { const float o = __shfl_up(gg, off); if (lane >= off) gg += o; }
            sBeta[lane] = beta; sGc[lane] = gg; sEg[lane] = expf(gg); sBE[lane] = beta * expf(gg);
            if (lane == 63) GL[it] = expf(gg);
        }
        __syncthreads();
        {
            bf16x8 aK[4], aQ[4];
#pragma unroll
            for (int ks = 0; ks < 4; ++ks) { aK[ks] = *(const bf16x8*)(sK + (16 * hw + fr) * 136 + 32 * ks + 8 * fq); aQ[ks] = *(const bf16x8*)(sQ + (16 * hw + fr) * 136 + 32 * ks + 8 * fq); }
#pragma unroll
            for (int nt = 0; nt < 4; ++nt) {
                f32x4 kk = (f32x4){0.f, 0.f, 0.f, 0.f}, qk = (f32x4){0.f, 0.f, 0.f, 0.f};
#pragma unroll
                for (int ks = 0; ks < 4; ++ks) {
                    const bf16x8 bK = *(const bf16x8*)(sK + (16 * nt + fr) * 136 + 32 * ks + 8 * fq);
                    kk = __builtin_amdgcn_mfma_f32_16x16x32_bf16(aK[ks], bK, kk, 0, 0, 0);
                    qk = __builtin_amdgcn_mfma_f32_16x16x32_bf16(aQ[ks], bK, qk, 0, 0, 0);
                }
                const int mcol = 16 * nt + fr; const float gm = sGc[mcol];
#pragma unroll
                for (int j = 0; j < 4; ++j) {
                    const int c = 16 * hw + 4 * fq + j;
                    const float dec = __expf(fminf(sGc[c] - gm, 0.f));
                    sL[c * 68 + mcol] = (mcol < c) ? kk[j] * sBeta[c] * dec : 0.f;
                    ATT[(size_t)it * 4096 + c * 64 + mcol] = f2bf((mcol <= c) ? qk[j] * dec : 0.f);
                }
            }
        }
        __syncthreads();
        {
            f32x2_t xv[32];
#define X_(i) (xv[(i) >> 1][(i) & 1])
            const bool isU = ht < 128; const int jc = ht & 127;
            const bf16_t* src = isU ? sV : sK;
            const float* fac = isU ? sBeta : sBE;
#pragma unroll
            for (int cb = 0; cb < 16; ++cb) {
                f32x2_t a2[4];
#pragma unroll
                for (int r = 0; r < 4; ++r) { a2[r].x = bf2f(src[(4 * cb + r) * 136 + jc]) * fac[4 * cb + r]; a2[r].y = 0.f; }
                const f32x4 d1 = *(const f32x4*)(sL + (4 * cb + 1) * 68 + 4 * cb), d2 = *(const f32x4*)(sL + (4 * cb + 2) * 68 + 4 * cb), d3 = *(const f32x4*)(sL + (4 * cb + 3) * 68 + 4 * cb);
                const int nb = (cb + 1) / 2;
                f32x4 lb[2][4][2];
#define SOLVE_LOAD(mb_, buf_) do { _Pragma("unroll") for (int q = 0; q < 2; ++q) _Pragma("unroll") for (int r = 0; r < 4; ++r) \
                    if (2 * (mb_) + q < cb) lb[buf_][r][q] = *(const f32x4*)(sL + (4 * cb + r) * 68 + 4 * (2 * (mb_) + q)); } while (0)
                if (nb > 0) SOLVE_LOAD(0, 0);
#pragma unroll
                for (int mb = 0; mb < nb; ++mb) {
                    if (mb + 1 < nb) SOLVE_LOAD(mb + 1, (mb + 1) & 1);
                    __builtin_amdgcn_sched_barrier(0);
#pragma unroll
                    for (int q = 0; q < 2; ++q)
#pragma unroll
                        for (int r = 0; r < 4; ++r)
                            if (2 * mb + q < cb) { const f32x4 l = lb[mb & 1][r][q]; const int m2 = 2 * (2 * mb + q);
                                a2[r] -= (f32x2_t){l[0], l[1]} * xv[m2]; a2[r] -= (f32x2_t){l[2], l[3]} * xv[m2 + 1]; }
                    __builtin_amdgcn_sched_barrier(0);
                }
#undef SOLVE_LOAD
                const float a0 = a2[0].x + a2[0].y, a1 = a2[1].x + a2[1].y, a2s = a2[2].x + a2[2].y, a3 = a2[3].x + a2[3].y;
                const float y0 = a0, y1 = a1 - d1[0] * y0, y2 = a2s - d2[0] * y0 - d2[1] * y1, y3 = a3 - d3[0] * y0 - d3[1] * y1 - d3[2] * y2;
                xv[2 * cb] = (f32x2_t){y0, y1}; xv[2 * cb + 1] = (f32x2_t){y2, y3};
            }
            if (isU) {
                const int w8 = jc >> 4, nn = jc & 15;
#pragma unroll
                for (int rq = 0; rq < 4; ++rq)
#pragma unroll
                    for (int pc = 0; pc < 2; ++pc) {
                        const int c0 = 32 * pc + 8 * rq;
                        u32x4 o; o.x = pk2(X_(c0 + 0), X_(c0 + 1)); o.y = pk2(X_(c0 + 2), X_(c0 + 3)); o.z = pk2(X_(c0 + 4), X_(c0 + 5)); o.w = pk2(X_(c0 + 6), X_(c0 + 7));
                        const int L = ((w8 * 2 + pc) * 64 + rq * 16 + nn) * 8;
                        *(u32x4*)(QKV + (tokb + (L >> 7)) * 3072 + 2048 + h * 128 + (L & 127)) = o;
                    }
            }
            __syncthreads();
            if (!isU) {
                bf16_t* sW2 = (bf16_t*)sL;
#pragma unroll
                for (int c = 0; c < 64; ++c) sW2[c * 136 + jc] = f2bf(-X_(c));
            }
        }
        __syncthreads();
        {
            const bf16_t* sW2 = (const bf16_t*)sL;
#pragma unroll
            for (int i = 0; i < 4; ++i) { const int ch = ht + 256 * i, r = ch >> 4, c8 = (ch & 15) * 8; *(u32x4*)(WB + (size_t)it * 8192 + r * 128 + c8) = *(const u32x4*)(sW2 + r * 136 + c8); }
        }
#undef X_
        {
            const int c = ht >> 2, ds = (ht & 3) * 32; const float eg = sEg[c];
#pragma unroll
            for (int c8 = 0; c8 < 4; ++c8) {
                const u32x4 v = *(const u32x4*)(sQ + c * 136 + ds + c8 * 8); u32x4 o;
                o.x = pk2(lo2f(v.x) * eg, hi2f(v.x) * eg); o.y = pk2(lo2f(v.y) * eg, hi2f(v.y) * eg); o.z = pk2(lo2f(v.z) * eg, hi2f(v.z) * eg); o.w = pk2(lo2f(v.w) * eg, hi2f(v.w) * eg);
                *(u32x4*)(QKV + (tokb + c) * 3072 + h * 128 + ds + c8 * 8) = o;
            }
            const int d = ht >> 1, cs = (ht & 1) * 32; const float gl = sGc[63];
#pragma unroll
            for (int c8 = 0; c8 < 4; ++c8) {
                float v[8];
#pragma unroll
                for (int e = 0; e < 8; ++e) { const int cc = cs + c8 * 8 + e; v[e] = bf2f(sK[cc * 136 + d]) * __expf(gl - sGc[cc]); }
                u32x4 o; o.x = pk2(v[0], v[1]); o.y = pk2(v[2], v[3]); o.z = pk2(v[4], v[5]); o.w = pk2(v[6], v[7]);
                *(u32x4*)(QKV + (tokb + (d >> 1)) * 3072 + 1024 + h * 128 + (d & 1) * 64 + cs + c8 * 8) = o;
            }
        }
        __syncthreads();
    }
}

constexpr int SC_WQ = 32768, SC_KA = 24576, SC_KA0 = 3 * SC_WQ;
static_assert(SC_KA0 + 2 * SC_KA <= LDS_BYTES, "scan LDS layout");
__device__ __forceinline__ bf16x8 pack2(const f32x4& a, const f32x4& b) {
    u32x4 r; r.x = pk2(a[0], a[1]); r.y = pk2(a[2], a[3]); r.z = pk2(b[0], b[1]); r.w = pk2(b[2], b[3]); return __builtin_bit_cast(bf16x8, r);
}
#define MF16(a, b, c) __builtin_amdgcn_mfma_f32_16x16x32_bf16(a, b, c, 0, 0, 0)
#define DMA16(src, dst) __builtin_amdgcn_global_load_lds((const unsigned*)(src), (LAS unsigned*)(dst), 16, 0, 0)
__device__ __forceinline__ void phase_gdn_scan(const Prm& p, LAS unsigned char* lds, int blk) {
    const int tid = threadIdx.x, wv = __builtin_amdgcn_readfirstlane(tid >> 6), lane = tid & 63, n = lane & 15, kq = lane >> 4;
    const int bh = blk & 15, jh = blk >> 4, b = bh >> 3, h = bh & 7;
    const bf16_t* QKV = (const bf16_t*)(p.ws + OFF_QKV); const bf16_t* WB = (const bf16_t*)(p.ws + OFF_WB); const bf16_t* ATT = (const bf16_t*)(p.ws + OFF_ATT);
    const float* GL = (const float*)(p.ws + OFF_GL); bf16_t* O = (bf16_t*)(p.ws + OFF_H);
    const int itb = bh * 128;
    const bf16_t* qkv_b = QKV + (size_t)b * SEQ * 3072;
    if (wv >= 4) {
        const int lw = wv - 4;
        __builtin_amdgcn_s_setprio(3);
        unsigned oW[4], oQ[4], oK[4], oA[2];
#pragma unroll
        for (int i = 0; i < 4; ++i) {
            { const int q = lw * 4 + i, row = 4 * q + (lane >> 4), pg = lane & 15, g = pg ^ ((row & 3) | (((row >> 3) & 3) << 2)); oW[i] = (unsigned)(row * 128 + g * 8); oQ[i] = (unsigned)(row * 3072 + h * 128 + g * 8); }
            { const int q = lw * 4 + i, d = 8 * q + (lane >> 3), pg = lane & 7, g = pg ^ ((d & 3) | (((d >> 3) & 1) << 2)); oK[i] = (unsigned)((d >> 1) * 3072 + 1024 + h * 128 + (d & 1) * 64 + g * 8); }
        }
#pragma unroll
        for (int i = 0; i < 2; ++i) { const int q = lw * 2 + i, c = 8 * q + (lane >> 3), pg = lane & 7, g = pg ^ ((c & 3) | (((c >> 3) & 1) << 2)); oA[i] = (unsigned)(c * 64 + g * 8); }
#define ISSUE_WQ(ck, st) do { const bf16_t* wb_ = WB + (size_t)(itb + (ck)) * 8192; const bf16_t* qb_ = qkv_b + (size_t)(ck) * 64 * 3072; LAS unsigned char* d_ = lds + (st) * SC_WQ + lw * 4096; \
        _Pragma("unroll") for (int i = 0; i < 4; ++i) { DMA16(wb_ + oW[i], d_ + i * 1024); DMA16(qb_ + oQ[i], d_ + 16384 + i * 1024); } } while (0)
#define ISSUE_KA(ck, st) do { const bf16_t* qb_ = qkv_b + (size_t)(ck) * 64 * 3072; const bf16_t* ab_ = ATT + (size_t)(itb + (ck)) * 4096; LAS unsigned char* d_ = lds + SC_KA0 + (st) * SC_KA; \
        _Pragma("unroll") for (int i = 0; i < 4; ++i) DMA16(qb_ + oK[i], d_ + (lw * 4 + i) * 1024); \
        _Pragma("unroll") for (int i = 0; i < 2; ++i) DMA16(ab_ + oA[i], d_ + 16384 + (lw * 2 + i) * 1024); } while (0)
        ISSUE_WQ(0, 0); ISSUE_KA(0, 0); ISSUE_WQ(1, 1);
        asm volatile("s_waitcnt vmcnt(0)" ::: "memory"); __builtin_amdgcn_s_barrier(); asm volatile("" ::: "memory");
        int s3 = 2;
        for (int nc = 0; nc < 128; ++nc) {
            const int c1 = nc + 1 < 128 ? nc + 1 : 127, c2 = nc + 2 < 128 ? nc + 2 : 127;
            ISSUE_WQ(c2, s3);
            ISSUE_KA(c1, (nc + 1) & 1);
            s3 = s3 == 2 ? 0 : s3 + 1;
            asm volatile("s_waitcnt vmcnt(14)" ::: "memory");
            __builtin_amdgcn_s_barrier(); asm volatile("" ::: "memory");
            __builtin_amdgcn_s_barrier(); asm volatile("" ::: "memory");
        }
        asm volatile("s_waitcnt vmcnt(0)" ::: "memory");
        __builtin_amdgcn_s_setprio(0);
#undef ISSUE_WQ
#undef ISSUE_KA
    } else if (wv >= 2) {
        for (int nc = 0; nc < 257; ++nc) { __builtin_amdgcn_s_barrier(); asm volatile("" ::: "memory"); }
    } else {
        const float gl0 = GL[itb + lane], gl1 = GL[itb + 64 + lane];
        f32x4 S[8];
#pragma unroll
        for (int dt = 0; dt < 8; ++dt) S[dt] = (f32x4){0.f, 0.f, 0.f, 0.f};
        const int e = 32 * jh + 16 * wv + n;
        unsigned uo[2];
#pragma unroll
        for (int pc = 0; pc < 2; ++pc) { const int L = (((2 * jh + wv) * 2 + pc) * 64 + lane) * 8; uo[pc] = (unsigned)((L >> 7) * 3072 + 2048 + h * 128 + (L & 127)); }
        u32x4 ua[2], ub[2];
#pragma unroll
        for (int pc = 0; pc < 2; ++pc) { ua[pc] = *(const u32x4*)(qkv_b + uo[pc]); ub[pc] = *(const u32x4*)(qkv_b + (size_t)64 * 3072 + uo[pc]); }
        const int rowb = 8 * (n >> 2) + (n & 3), swk = (n & 3) | (((n >> 2) & 1) << 2);
        unsigned offW[4], offK[2];
#pragma unroll
        for (int ks = 0; ks < 4; ++ks) offW[ks] = (unsigned)(rowb * 256 + (((4 * ks + kq) ^ n) << 4));
#pragma unroll
        for (int k2 = 0; k2 < 2; ++k2) offK[k2] = (unsigned)(rowb * 128 + (((4 * k2 + kq) ^ swk) << 4));
        asm volatile("s_waitcnt lgkmcnt(0)" ::: "memory"); __builtin_amdgcn_s_barrier(); asm volatile("" ::: "memory");
        int s3 = 0;
        for (int nc = 0; nc < 128; ++nc) {
            const LAS unsigned char* sWQ = lds + s3 * SC_WQ; const LAS unsigned char* sKA = lds + SC_KA0 + (nc & 1) * SC_KA;
            s3 = s3 == 2 ? 0 : s3 + 1;
            const float gl = __builtin_bit_cast(float, __builtin_amdgcn_readlane(__builtin_bit_cast(int, nc < 64 ? gl0 : gl1), nc & 63));
            f32x4 V[4], Oa[4];
#pragma unroll
            for (int pc = 0; pc < 2; ++pc) {
                const u32x4 uu = ua[pc];
                V[2 * pc] = (f32x4){lo2f(uu.x), hi2f(uu.x), lo2f(uu.y), hi2f(uu.y)}; V[2 * pc + 1] = (f32x4){lo2f(uu.z), hi2f(uu.z), lo2f(uu.w), hi2f(uu.w)};
                ua[pc] = ub[pc];
            }
            { const int c2 = nc + 2 < 128 ? nc + 2 : 127; const bf16_t* ubase = qkv_b + (size_t)c2 * 64 * 3072;
#pragma unroll
              for (int pc = 0; pc < 2; ++pc) ub[pc] = *(const u32x4*)(ubase + uo[pc]); }
#pragma unroll
            for (int ct = 0; ct < 4; ++ct) Oa[ct] = (f32x4){0.f, 0.f, 0.f, 0.f};
            bf16x8 fa[2][8];
#define TOFF(t, pitch) ((32 * ((t) >> 1) + 4 * ((t) & 1)) * (pitch))
#define LD_WQ(dst, ks_) do { _Pragma("unroll") for (int mt = 0; mt < 4; ++mt) { dst[mt] = *(const LAS bf16x8*)(sWQ + offW[ks_] + TOFF(mt, 256)); dst[4 + mt] = *(const LAS bf16x8*)(sWQ + 16384 + offW[ks_] + TOFF(mt, 256)); } } while (0)
            LD_WQ(fa[0], 0);
#pragma unroll
            for (int ks = 0; ks < 4; ++ks) {
                if (ks < 3) LD_WQ(fa[(ks + 1) & 1], ks + 1);
                const bf16x8 sb8 = pack2(S[2 * ks], S[2 * ks + 1]);
                __builtin_amdgcn_sched_barrier(0);
#pragma unroll
                for (int mt = 0; mt < 4; ++mt) { V[mt] = MF16(fa[ks & 1][mt], sb8, V[mt]); Oa[mt] = MF16(fa[ks & 1][4 + mt], sb8, Oa[mt]); }
                __builtin_amdgcn_sched_barrier(0);
            }
#undef LD_WQ
            asm volatile("s_waitcnt lgkmcnt(0)" ::: "memory"); __builtin_amdgcn_s_barrier(); asm volatile("" ::: "memory");
            bf16x8 fb[2][12];
#define LD_AK(dst, k2_) do { _Pragma("unroll") for (int mt = 0; mt < 4; ++mt) dst[mt] = *(const LAS bf16x8*)(sKA + 16384 + offK[k2_] + TOFF(mt, 128)); \
                             _Pragma("unroll") for (int dt = 0; dt < 8; ++dt) dst[4 + dt] = *(const LAS bf16x8*)(sKA + offK[k2_] + TOFF(dt, 128)); } while (0)
            LD_AK(fb[0], 0);
            bf16x8 Vb[2];
            Vb[0] = pack2(V[0], V[1]); Vb[1] = pack2(V[2], V[3]);
#pragma unroll
            for (int dt = 0; dt < 8; ++dt) S[dt] *= gl;
#pragma unroll
            for (int k2 = 0; k2 < 2; ++k2) {
                if (k2 < 1) LD_AK(fb[1], 1);
                __builtin_amdgcn_sched_barrier(0);
#pragma unroll
                for (int mt = 0; mt < 4; ++mt) Oa[mt] = MF16(fb[k2][mt], Vb[k2], Oa[mt]);
#pragma unroll
                for (int dt = 0; dt < 8; ++dt) S[dt] = MF16(fb[k2][4 + dt], Vb[k2], S[dt]);
                __builtin_amdgcn_sched_barrier(0);
            }
#undef LD_AK
#undef TOFF
            bf16_t* obase = O + (size_t)(itb + nc) * 8192 + e * 64 + 8 * kq;
#pragma unroll
            for (int pc = 0; pc < 2; ++pc) *(u32x4*)(obase + 32 * pc) = pack8(Oa[2 * pc], Oa[2 * pc + 1]);
            asm volatile("s_waitcnt lgkmcnt(0)" ::: "memory"); __builtin_amdgcn_s_barrier(); asm volatile("" ::: "memory");
        }
    }
    __syncthreads();
}

__device__ __forceinline__ void phase_ya(const Prm& p, unsigned char* lds) {
    const bf16_t* OT = (const bf16_t*)(p.ws + OFF_H); bf16_t* SZA = (bf16_t*)p.out;
    const float* gw = p.in[7];
    bf16_t* sT = (bf16_t*)lds;
    float* sPart = (float*)(lds + 16384);
    const int tid = threadIdx.x, w = tid >> 6, c = tid & 63;
    for (int it = blockIdx.x; it < NIT; it += gridDim.x) {
        const int b = it >> 10, h = (it >> 7) & 7, nc = it & 127;
        const size_t tok = (size_t)b * SEQ + (size_t)nc * 64 + c;
#pragma unroll
        for (int i = 0; i < 2; ++i) { const int ch = tid + 512 * i; *(u32x4*)(sT + ch * 8) = *(const u32x4*)(OT + (size_t)it * 8192 + ch * 8); }
        const u32x4 z0 = *(const u32x4*)(SZA + tok * 1024 + h * 128 + 16 * w), z1 = *(const u32x4*)(SZA + tok * 1024 + h * 128 + 16 * w + 8);
        __syncthreads();
        float o[16]; float ss = 0.f;
#pragma unroll
        for (int j = 0; j < 16; ++j) { o[j] = bf2f(sT[(16 * w + j) * 64 + c]); ss += o[j] * o[j]; }
        sPart[w * 64 + c] = ss;
        __syncthreads();
        float tot = 0.f;
#pragma unroll
        for (int k = 0; k < 8; ++k) tot += sPart[k * 64 + c];
        const float rstd = rsqrtf(tot * (1.0f / 128.0f) + 1e-6f);
        const unsigned zz[8] = {z0.x, z0.y, z0.z, z0.w, z1.x, z1.y, z1.z, z1.w};
        unsigned r[8];
#pragma unroll
        for (int j = 0; j < 8; ++j)
            r[j] = pk2(o[2 * j] * rstd * gw[16 * w + 2 * j] * lo2f(zz[j]), o[2 * j + 1] * rstd * gw[16 * w + 2 * j + 1] * hi2f(zz[j]));
        *(u32x4*)(SZA + tok * 1024 + h * 128 + 16 * w) = (u32x4){r[0], r[1], r[2], r[3]};
        *(u32x4*)(SZA + tok * 1024 + h * 128 + 16 * w + 8) = (u32x4){r[4], r[5], r[6], r[7]};
        __syncthreads();
    }
}
__device__ __forceinline__ void phase_conv3(const Prm& p) {
    const bf16_t* P = (const bf16_t*)(p.ws + OFF_P); bf16_t* Q = (bf16_t*)(p.ws + OFF_Q); const float* cw = p.in[19];
    const int nth = gridDim.x * 512;
    for (int idx = blockIdx.x * 512 + threadIdx.x; idx < (TOK / 4) * 256; idx += nth) {
        const int t0 = (idx >> 8) * 4, c8 = (idx & 255) * 8;
        const bool first = (t0 & (SEQ - 1)) == 0;
        u32x4 pr[6], qr[4];
#pragma unroll
        for (int i = 0; i < 6; ++i) pr[i] = (i < 2 && first) ? (u32x4){0u, 0u, 0u, 0u} : *(const u32x4*)(P + (size_t)(t0 - 2 + i) * 2048 + c8);
#pragma unroll
        for (int i = 0; i < 4; ++i) qr[i] = *(const u32x4*)(Q + (size_t)(t0 + i) * 2048 + c8);
        float w0[8], w1[8], w2[8];
#pragma unroll
        for (int e = 0; e < 8; ++e) { w0[e] = cw[c8 + e]; w1[e] = cw[2048 + c8 + e]; w2[e] = cw[4096 + c8 + e]; }
#pragma unroll
        for (int i = 0; i < 4; ++i) {
            const unsigned pa[4] = {pr[i + 2].x, pr[i + 2].y, pr[i + 2].z, pr[i + 2].w}, pb[4] = {pr[i + 1].x, pr[i + 1].y, pr[i + 1].z, pr[i + 1].w}, pc[4] = {pr[i].x, pr[i].y, pr[i].z, pr[i].w};
            const unsigned qa[4] = {qr[i].x, qr[i].y, qr[i].z, qr[i].w};
            unsigned o[4];
#pragma unroll
            for (int e = 0; e < 4; ++e)
                o[e] = pk2(lo2f(qa[e]) * (w0[2 * e] * lo2f(pc[e]) + w1[2 * e] * lo2f(pb[e]) + w2[2 * e] * lo2f(pa[e])),
                           hi2f(qa[e]) * (w0[2 * e + 1] * hi2f(pc[e]) + w1[2 * e + 1] * hi2f(pb[e]) + w2[2 * e + 1] * hi2f(pa[e])));
            *(u32x4*)(Q + (size_t)(t0 + i) * 2048 + c8) = (u32x4){o[0], o[1], o[2], o[3]};
        }
    }
}

#define XB_TMO      128
#define XB_XCNT(j)  (256  + 64 * (j))
#define XB_XSUB(j)  (1280 + 64 * (j))
#define XB_XGEN(j)  (2304 + 64 * (j))
#define XB_TOP      3328
#define XB_TOPGEN   3392
#define XCD_BAR_WORDS 3456
#define XB_SPIN_CAP (1u << 18)

__device__ __forceinline__ unsigned xb_ld(unsigned* p)              { return __hip_atomic_load(p, __ATOMIC_RELAXED, __HIP_MEMORY_SCOPE_AGENT); }
__device__ __forceinline__ unsigned xb_add(unsigned* p, unsigned v) { return __hip_atomic_fetch_add(p, v, __ATOMIC_RELAXED, __HIP_MEMORY_SCOPE_AGENT); }
__device__ __forceinline__ unsigned xb_xcc_id() { return (unsigned)__builtin_amdgcn_s_getreg((3 << 11) | 20) & 0xFu; }
#define XB_SPIN(cond, bar) do { unsigned _sp = 0; while (cond) { __builtin_amdgcn_s_sleep(1); \
    if ((++_sp & 255u) == 0u) { if (xb_ld(&(bar)[XB_TMO])) break; if (_sp > XB_SPIN_CAP) { atomicAdd(&(bar)[XB_TMO], 1u); break; } } } } while (0)

struct XcdBarrier {
    unsigned* bar; unsigned x;
    volatile LAS unsigned* st;
};

__device__ __forceinline__ XcdBarrier xcd_barrier_post(unsigned* bar, volatile LAS unsigned* st) {
    XcdBarrier b; b.bar = bar; b.x = xb_xcc_id(); b.st = st;
    if (threadIdx.x == 0) (void)xb_add(&bar[XB_XCNT(b.x)], 1u);
    return b;
}
__device__ __forceinline__ void xcd_barrier_complete(unsigned* bar, unsigned x, unsigned& nloc, unsigned& nx) {
    const unsigned G = gridDim.x * gridDim.y * gridDim.z;
    unsigned sum, cnt, mine, sp = 0u;
    for (;;) {
        sum = 0u; cnt = 0u; mine = 0u;
#pragma unroll
        for (unsigned j = 0; j < 16; ++j) { const unsigned c = xb_ld(&bar[XB_XCNT(j)]); sum += c; cnt += (c > 0u) ? 1u : 0u; mine = (j == x) ? c : mine; }
        if (sum == G) break;
        __builtin_amdgcn_s_sleep(1);
        if ((++sp & 255u) == 0u) { if (xb_ld(&bar[XB_TMO])) break; if (sp > XB_SPIN_CAP) { atomicAdd(&bar[XB_TMO], 1u); break; } }
    }
    nloc = mine > 0u ? mine : 1u; nx = cnt > 0u ? cnt : 1u;
}

__device__ __forceinline__ void xcd_barrier(const XcdBarrier& b) {
    asm volatile("s_waitcnt vmcnt(0)" ::: "memory");
    __syncthreads();
    if (threadIdx.x == 0) {
        unsigned* bar = b.bar;
        __builtin_amdgcn_s_waitcnt(0);
        unsigned nloc = b.st[0], nx = b.st[1];
        if (nloc == 0u) { xcd_barrier_complete(bar, b.x, nloc, nx); b.st[0] = nloc; b.st[1] = nx; }
        const unsigned old = xb_add(&bar[XB_XSUB(b.x)], 1u);
        const unsigned gen = old / nloc;
        if (old + 1u == (gen + 1u) * nloc) {
            __builtin_amdgcn_fence(__ATOMIC_RELEASE, "agent");
            asm volatile("s_waitcnt vmcnt(0)" ::: "memory");
            const unsigned og = xb_add(&bar[XB_TOP], 1u);
            const unsigned tg = og / nx;
            if (og + 1u == (tg + 1u) * nx) xb_add(&bar[XB_TOPGEN], 1u);
            else XB_SPIN(xb_ld(&bar[XB_TOPGEN]) == tg, bar);
            __builtin_amdgcn_fence(__ATOMIC_ACQUIRE, "agent");
            xb_add(&bar[XB_XGEN(b.x)], 1u);
            asm volatile("s_waitcnt vmcnt(0)" ::: "memory");
        } else {
            XB_SPIN(xb_ld(&bar[XB_XGEN(b.x)]) == gen, bar);
            __builtin_amdgcn_fence(__ATOMIC_ACQUIRE, "agent");
            asm volatile("s_waitcnt vmcnt(0)" ::: "memory");
        }
    }
    __syncthreads();
}

constexpr int NPHASE = 11;
#define REP_GEMM 1
#define REP_SYNC 1
#define REP_SCAN 1
#define SCAN_PROBE 1
#define REP_P0 1
#ifndef PHM
#define PHM 0x7FF
#endif
__global__ void __launch_bounds__(512, 2) mega(Prm p) {
    extern __shared__ __attribute__((aligned(16))) unsigned char shm[];
    LAS unsigned char* lds3 = (LAS unsigned char*)shm;
    unsigned char* ws = p.ws;
    volatile LAS unsigned* xst = (volatile LAS unsigned*)(lds3 + LDS_BYTES);
    if (threadIdx.x == 0) { xst[0] = 0u; xst[1] = 0u; }
    __syncthreads();
    XcdBarrier xb{};
    const bool multi = (p.ph_hi - p.ph_lo) > 1;
    if (multi) xb = xcd_barrier_post((unsigned*)(ws + OFF_BAR), xst);
    if (p.ph_lo < 0) cg::this_grid().sync();
#define PH_BEGIN(i) if (((PHM >> (i)) & 1) && p.ph_lo <= (i) && (i) < p.ph_hi) { if ((i) > p.ph_lo) { xcd_barrier(xb); if (REP_SYNC > 1) xcd_barrier(xb); } pg8::StaticOrder S; (void)S;
#define PH_END }
    PH_BEGIN(0)
        for (int rep = 0; rep < REP_P0; ++rep) {
        phase_convert(p, shm, 0, 1856, gridDim.x, blockIdx.x);
        phase_rmsnorm_x(p.in[0], p.in[1], (bf16_t*)(ws + OFF_H)); __syncthreads(); }
    PH_END
    PH_BEGIN(1)
        phase_ba(p, shm);
        pg8::Gemm g{(const bf16_t*)(ws + OFF_H), (const bf16_t*)(ws + OFF_WT1), TOK, 6144, 1024, (const bf16_t*)(ws + OFF_H), 1024, 64};
        Epi1 E{(bf16_t*)(ws + OFF_QKV), (bf16_t*)p.out, (bf16_t*)(ws + OFF_UU), (bf16_t*)p.out + (size_t)TOK * 1024, (float*)(ws + OFF_BA), (bf16_t*)(ws + OFF_HALO)};
        S.init(TOK, 6144, gridDim.x, blockIdx.x); for (int rep = 0; rep < REP_GEMM; ++rep) { pg8::gemm_phase(lds3, g, S, E); __syncthreads(); }
    PH_END
    PH_BEGIN(2)
        {
            unsigned* ctr = (unsigned*)(ws + OFF_BAR) + 3600;
            volatile LAS unsigned* sIt = xst + 2;
            for (;;) {
                if (threadIdx.x == 0) sIt[0] = __hip_atomic_fetch_add(ctr, 2u, __ATOMIC_RELAXED, __HIP_MEMORY_SCOPE_AGENT);
                __syncthreads();
                const unsigned it0 = sIt[0];
                __syncthreads();
                if (it0 >= (unsigned)NIT) break;
                phase_gdn_prep(p, shm, (int)it0, 1);
            }
        }
    PH_END
    PH_BEGIN(3)
        if (blockIdx.x < 64) phase_gdn_scan(p, lds3, blockIdx.x);
        else {
            const int ob = blockIdx.x - 64;
            pg8::Gemm g{(const bf16_t*)(ws + OFF_UU), (const bf16_t*)(ws + OFF_WTG), TOK, 1024, 1024, (const bf16_t*)(ws + OFF_UU), 1024, 64};
            EpiGlu E{(const bf16_t*)(ws + OFF_UU), (bf16_t*)p.out + (size_t)TOK * 1024};
            unsigned* cw = (unsigned*)(ws + OFF_BAR);
            if (ob < 128) {
                phase_s5(p, shm, ob);
                asm volatile("s_waitcnt vmcnt(0)" ::: "memory");
                __syncthreads();
                if (threadIdx.x == 0) {
                    __builtin_amdgcn_fence(__ATOMIC_RELEASE, "agent");
                    asm volatile("s_waitcnt vmcnt(0)" ::: "memory");
                    __hip_atomic_fetch_add(cw + 3700, 1u, __ATOMIC_RELAXED, __HIP_MEMORY_SCOPE_AGENT);
                    unsigned sp = 0;
                    while (__hip_atomic_load(cw + 3700, __ATOMIC_RELAXED, __HIP_MEMORY_SCOPE_AGENT) < 128u) { __builtin_amdgcn_s_sleep(2); if (++sp > (1u << 22)) break; }
                    __builtin_amdgcn_fence(__ATOMIC_ACQUIRE, "agent");
                    asm volatile("s_waitcnt vmcnt(0)" ::: "memory");
                }
                __syncthreads();
                S.init_list(ob, 1, 1); pg8::gemm_phase(lds3, g, S, E);
            } else {
                const int e = ob - 128;
                phase_convert(p, shm, 1856, 4928, 64, e);
                __syncthreads();
                if (threadIdx.x == 0) {
                    unsigned sp = 0;
                    while (__hip_atomic_load(cw + 3900, __ATOMIC_RELAXED, __HIP_MEMORY_SCOPE_AGENT) < 128u) { __builtin_amdgcn_s_sleep(2); if (++sp > (1u << 22)) break; }
                    __builtin_amdgcn_fence(__ATOMIC_ACQUIRE, "agent");
                    asm volatile("s_waitcnt vmcnt(0)" ::: "memory");
                }
                __syncthreads();
                S.init_list(2 * e, 2, 0); pg8::gemm_phase(lds3, g, S, E);
            }
        }
    PH_END
    PH_BEGIN(4)
        phase_ya(p, shm);
    PH_END
    PH_BEGIN(5)
        pg8::Gemm g{(const bf16_t*)p.out, (const bf16_t*)(ws + OFF_WTO0), TOK, 1024, 2048, (const bf16_t*)p.out + (size_t)TOK * 1024, 1024, 16};
        EpiB16 E{(bf16_t*)(ws + OFF_QKV)};
        S.init(TOK, 1024, gridDim.x, blockIdx.x); for (int rep = 0; rep < REP_GEMM; ++rep) { pg8::gemm_phase(lds3, g, S, E); __syncthreads(); }
    PH_END
    PH_BEGIN(6)
        phase_post<true>(p.in[0], (const bf16_t*)(ws + OFF_QKV), p.in[2], p.out, p.in[1] + 1024, (bf16_t*)(ws + OFF_H));
    PH_END
    PH_BEGIN(7)
        pg8::Gemm g{(const bf16_t*)(ws + OFF_H), (const bf16_t*)(ws + OFF_WT2), TOK, 8192, 1024, (const bf16_t*)(ws + OFF_H), 1024, 64};
        Epi2 E{(bf16_t*)(ws + OFF_P), (bf16_t*)(ws + OFF_Q)};
        S.init(TOK, 8192, gridDim.x, blockIdx.x); for (int rep = 0; rep < REP_GEMM; ++rep) { pg8::gemm_phase(lds3, g, S, E); __syncthreads(); }
    PH_END
    PH_BEGIN(8)
        phase_conv3(p);
    PH_END
    PH_BEGIN(9)
        pg8::Gemm g{(const bf16_t*)(ws + OFF_Q), (const bf16_t*)(ws + OFF_WTO1), TOK, 1024, 2048, (const bf16_t*)(ws + OFF_Q), 2048, 64};
        EpiB16 E{(bf16_t*)(ws + OFF_P)};
        S.init(TOK, 1024, gridDim.x, blockIdx.x); for (int rep = 0; rep < REP_GEMM; ++rep) { pg8::gemm_phase(lds3, g, S, E); __syncthreads(); }
    PH_END
    PH_BEGIN(10)
        phase_post<false>(p.out, (const bf16_t*)(ws + OFF_P), p.in[2] + 1024, p.out, nullptr, nullptr);
    PH_END
}

#ifndef N_LAUNCH_MODE
#define N_LAUNCH_MODE 1
#endif

extern "C" void kernel_launch(void* const* d_in, const int* in_sizes, int n_in, void* d_out, int out_size, void* d_ws, size_t ws_size, hipStream_t stream) {
    static int ready = 0;
    if (!ready) {
        if (n_in != 21 || ws_size < WS_END || out_size != TOK * DM) { fprintf(stderr, "kernel_launch: unexpected shapes (n_in %d ws %zu out %d)\n", n_in, ws_size, out_size); ready = -1; return; }
        if (hipFuncSetAttribute((const void*)mega, hipFuncAttributeMaxDynamicSharedMemorySize, LDS_BYTES + 16) != hipSuccess) { fprintf(stderr, "kernel_launch: hipFuncSetAttribute failed\n"); ready = -1; return; }
        ready = 1;
    }
    if (ready < 0) return;
    Prm p{};
    for (int i = 0; i < 21; ++i) p.in[i] = (const float*)d_in[i];
    p.out = (float*)d_out; p.ws = (unsigned char*)d_ws;
#if N_LAUNCH_MODE == 1
    p.ph_lo = 0; p.ph_hi = NPHASE;
    void* args[] = {&p};
    if (hipMemsetAsync((unsigned char*)d_ws + OFF_BAR, 0, 16384, stream) != hipSuccess) { fprintf(stderr, "memset failed\n"); return; }
    hipError_t e = hipLaunchCooperativeKernel((const void*)mega, dim3(256), dim3(512), args, LDS_BYTES + 16, stream);
    if (e != hipSuccess) fprintf(stderr, "cooperative launch failed: %s\n", hipGetErrorString(e));
#else
    for (int ph = 0; ph < NPHASE; ++ph) {
        p.ph_lo = ph; p.ph_hi = ph + 1;
        hipLaunchKernelGGL(mega, dim3(256), dim3(512), LDS_BYTES + 16, stream, p);
    }
#endif
}
```
